# Optimizing an MI355X kernel written in HIP

```python
import math
import jax, jax.numpy as jnp
from jax import lax
import numpy as np

D_MODEL = 1024
BATCH = 2
SEQ = 8192
DEPTH = 2
DEC_BATCH = 128
DEC_SEQ = 8
PAST_LEN = 8192
PAGE_SIZE = 128

N_A = DEPTH // 2
N_B = DEPTH - N_A
POOL_WINDOWS = (2, 4, 8, 16)
POOL_GROUPS = 4
POOL_GC = D_MODEL // POOL_GROUPS
POOL_BUF = max(POOL_WINDOWS) - 1
N_HEADS = D_MODEL // 128
Q_RANK = 3 * D_MODEL // 8
KV_RANK = D_MODEL // 4
QK_NOPE = 128
QK_ROPE = 64
V_DIM = 128
SM_SCALE = 1.0 / math.sqrt(QK_NOPE + QK_ROPE)
ROPE_THETA = 10000.0
D_FF = 4 * D_MODEL
PLE_DIM = 256
Q_BLOCK = 128
NORM_EPS = 1e-6
NEG_INF = -1e30

kernel_name = 'yoco_pool_mla_decoder_step'


def _rmsnorm(x, g):
    xf = x.astype(jnp.float32)
    y = xf * lax.rsqrt(jnp.mean(xf * xf, axis=-1, keepdims=True) + NORM_EPS)
    return (y * g.astype(jnp.float32)).astype(x.dtype)


def _rope(x, pos):
    half = x.shape[-1] // 2
    inv_freq = jnp.power(ROPE_THETA, -jnp.arange(half, dtype=jnp.float32) / half)
    ang = pos.astype(jnp.float32)[:, None] * inv_freq[None, :]
    cos = jnp.cos(ang)[:, None, :]
    sin = jnp.sin(ang)[:, None, :]
    xf = x.astype(jnp.float32)
    x1, x2 = xf[..., :half], xf[..., half:]
    return jnp.concatenate([x1 * cos - x2 * sin, x2 * cos + x1 * sin], axis=-1).astype(x.dtype)


def _pool_mixer(u, buf, start_pos, w_grp, scale):
    T = u.shape[1]
    u_ext = jnp.concatenate([buf.astype(u.dtype), u], axis=1)
    cs = jnp.cumsum(u_ext.astype(jnp.float32), axis=1)
    cs = jnp.concatenate([jnp.zeros_like(cs[:, :1]), cs], axis=1)
    end = cs[:, POOL_BUF + 1:POOL_BUF + 1 + T]
    pos = start_pos + jnp.arange(T)
    uf = u.astype(jnp.float32)
    diffs = []
    for g, w in enumerate(POOL_WINDOWS):
        sl = slice(g * POOL_GC, (g + 1) * POOL_GC)
        win = end[..., sl] - cs[:, POOL_BUF + 1 - w:POOL_BUF + 1 - w + T, sl]
        cnt = jnp.minimum(pos + 1, w).astype(jnp.float32)[None, :, None]
        diffs.append(win / cnt - uf[..., sl])
    d = jnp.stack(diffs, axis=2).astype(u.dtype)
    mixed = jnp.einsum('btgc,gcd->btgd', d, w_grp).reshape(u.shape)
    return mixed * scale, u_ext[:, -POOL_BUF:]


def _shared_kv(h, pos, norm_kv, w_dkv, kv_norm):
    ckr = _rmsnorm(h, norm_kv) @ w_dkv
    c = _rmsnorm(ckr[..., :KV_RANK], kv_norm)
    kr = _rope(ckr[..., KV_RANK:][:, :, None, :], pos)[:, :, 0, :]
    return c, kr


def _mla_queries(u, pos, w_dq, q_norm, w_uq, w_uk):
    cq = _rmsnorm(u @ w_dq, q_norm)
    q = jnp.einsum('btr,rhe->bthe', cq, w_uq)
    q_lat = jnp.einsum('bthn,rhn->bthr', q[..., :QK_NOPE], w_uk)
    return q_lat, _rope(q[..., QK_NOPE:], pos)


def _latent_attend(q_lat, q_rope, parts):
    scores = []
    for c, kr, mask in parts:
        s = (jnp.einsum('bqhr,bkr->bhqk', q_lat, c)
             + jnp.einsum('bqhe,bke->bhqk', q_rope, kr)).astype(jnp.float32) * SM_SCALE
        if mask is not None:
            s = jnp.where(mask, s, NEG_INF)
        scores.append(s)
    probs = jax.nn.softmax(jnp.concatenate(scores, axis=-1), axis=-1)
    outs = []
    off = 0
    for c, _, _ in parts:
        n = c.shape[1]
        outs.append(jnp.einsum('bhqk,bkr->bqhr', probs[..., off:off + n].astype(c.dtype), c))
        off += n
    return sum(outs[1:], outs[0])


def _prompt_attention(q_lat, q_rope, c, kr):
    b, S = q_lat.shape[:2]
    nb = S // Q_BLOCK
    k_pos = jnp.arange(S)

    def blk(args):
        ql, qr, qpos = args
        mask = k_pos[None, :] <= qpos[:, None]
        return _latent_attend(ql, qr, [(c, kr, mask)])

    def split(a):
        return jnp.moveaxis(a.reshape((b, nb, Q_BLOCK) + a.shape[2:]), 1, 0)

    out = lax.map(blk, (split(q_lat), split(q_rope), k_pos.reshape(nb, Q_BLOCK)))
    return jnp.moveaxis(out, 0, 1).reshape((b, S) + out.shape[3:])


def _trunk(x, p, pool_state, past_c, past_kr, start_pos, w):
    T = x.shape[1]
    pos = start_pos + jnp.arange(T)
    h = x
    new_pool = []
    c = kr = None
    for i in range(DEPTH):
        u = _rmsnorm(h, w['norm_mix'][i])
        if i < N_A:
            mix, buf = _pool_mixer(u, pool_state[i], start_pos, w['pool_w'][i], w['pool_scale'][i])
            new_pool.append(buf)
        else:
            j = i - N_A
            q_lat, q_rope = _mla_queries(u, pos, w['w_dq'][j], w['q_norm'][j], w['w_uq'][j], w['w_uk'])
            if past_c is None:
                att = _prompt_attention(q_lat, q_rope, c, kr)
            else:
                causal = jnp.arange(T)[None, :] <= jnp.arange(T)[:, None]
                att = _latent_attend(q_lat, q_rope, [(past_c, past_kr, None), (c, kr, causal)])
            o = jnp.einsum('bqhr,rhv->bqhv', att, w['w_uv'])
            mix = jnp.einsum('bqhv,hvd->bqd', o, w['w_o'][j])
        h = h + mix
        a = jax.nn.relu(_rmsnorm(h, w['norm_mlp'][i]) @ w['w_up'][i])
        h = h + (a * a) @ w['w_down'][i]
        gate = jax.nn.sigmoid(_rmsnorm(h, w['norm_ple'][i]) @ w['w_ple_gate'][i])
        h = h + gate * (p[i] @ w['w_ple_proj'][i])
        if i == N_A - 1:
            c, kr = _shared_kv(h, pos, w['norm_kv'], w['w_dkv'], w['kv_norm'])
    return _rmsnorm(h, w['norm_final']), jnp.stack(new_pool), c, kr


def setup_inputs(seed: int = 0) -> dict:
    key = jax.random.key(seed)
    ks = iter(jax.random.split(key, 40))
    f32 = jnp.float32

    def nrm(shape, scale=1.0):
        return jax.random.normal(next(ks), shape, f32) * scale

    def gain(shape):
        return 1.0 + 0.1 * nrm(shape)

    n_pages = PAST_LEN // PAGE_SIZE
    n_pool = (DEC_BATCH * n_pages * 5) // 4
    page_table = jax.random.permutation(next(ks), n_pool)[:DEC_BATCH * n_pages]
    page_table = page_table.reshape(DEC_BATCH, n_pages).astype(jnp.int32)
    return {
        'x_prompt': nrm((BATCH, SEQ, D_MODEL)),
        'x_sample': nrm((DEC_BATCH, DEC_SEQ, D_MODEL)),
        'p_prompt': nrm((DEPTH, BATCH, SEQ, PLE_DIM)),
        'p_sample': nrm((DEPTH, DEC_BATCH, DEC_SEQ, PLE_DIM)),
        'state_pool': nrm((N_A, DEC_BATCH, POOL_BUF, D_MODEL)),
        'cache_latent': nrm((n_pool, PAGE_SIZE, KV_RANK)),
        'cache_krope': nrm((n_pool, PAGE_SIZE, QK_ROPE)),
        'page_table': page_table,
        'norm_mix': gain((DEPTH, D_MODEL)),
        'norm_mlp': gain((DEPTH, D_MODEL)),
        'norm_ple': gain((DEPTH, D_MODEL)),
        'pool_w': nrm((N_A, POOL_GROUPS, POOL_GC, POOL_GC), POOL_GC ** -0.5),
        'pool_scale': gain((N_A, D_MODEL)),
        'norm_kv': gain((D_MODEL,)),
        'w_dkv': nrm((D_MODEL, KV_RANK + QK_ROPE), D_MODEL ** -0.5),
        'kv_norm': gain((KV_RANK,)),
        'w_uk': nrm((KV_RANK, N_HEADS, QK_NOPE), KV_RANK ** -0.5),
        'w_uv': nrm((KV_RANK, N_HEADS, V_DIM), KV_RANK ** -0.5),
        'w_dq': nrm((N_B, D_MODEL, Q_RANK), D_MODEL ** -0.5),
        'q_norm': gain((N_B, Q_RANK)),
        'w_uq': nrm((N_B, Q_RANK, N_HEADS, QK_NOPE + QK_ROPE), Q_RANK ** -0.5),
        'w_o': nrm((N_B, N_HEADS, V_DIM, D_MODEL), (N_HEADS * V_DIM) ** -0.5),
        'w_up': nrm((DEPTH, D_MODEL, D_FF), D_MODEL ** -0.5),
        'w_down': nrm((DEPTH, D_FF, D_MODEL), D_FF ** -0.5),
        'w_ple_gate': nrm((DEPTH, D_MODEL, D_MODEL), D_MODEL ** -0.5),
        'w_ple_proj': nrm((DEPTH, PLE_DIM, D_MODEL), PLE_DIM ** -0.5),
        'norm_final': gain((D_MODEL,)),
    }


def reference(x_prompt, x_sample, p_prompt, p_sample, state_pool, cache_latent, cache_krope, page_table,
              norm_mix, norm_mlp, norm_ple, pool_w, pool_scale, norm_kv, w_dkv, kv_norm, w_uk, w_uv,
              w_dq, q_norm, w_uq, w_o, w_up, w_down, w_ple_gate, w_ple_proj, norm_final):
    w = dict(norm_mix=norm_mix, norm_mlp=norm_mlp, norm_ple=norm_ple, pool_w=pool_w,
             pool_scale=pool_scale, norm_kv=norm_kv, w_dkv=w_dkv, kv_norm=kv_norm, w_uk=w_uk,
             w_uv=w_uv, w_dq=w_dq, q_norm=q_norm, w_uq=w_uq, w_o=w_o, w_up=w_up, w_down=w_down,
             w_ple_gate=w_ple_gate, w_ple_proj=w_ple_proj, norm_final=norm_final)
    zero_pool = jnp.zeros((N_A, x_prompt.shape[0], POOL_BUF, D_MODEL), x_prompt.dtype)
    y_prompt, pool_prompt, latent_prompt, krope_prompt = _trunk(
        x_prompt, p_prompt, zero_pool, None, None, 0, w)
    b = page_table.shape[0]
    n_past = page_table.shape[1] * PAGE_SIZE
    past_c = cache_latent[page_table].reshape(b, n_past, KV_RANK)
    past_kr = cache_krope[page_table].reshape(b, n_past, QK_ROPE)
    y_sample, pool_sample, latent_sample, krope_sample = _trunk(
        x_sample, p_sample, state_pool, past_c, past_kr, PAST_LEN, w)
    return (y_prompt, y_sample, pool_prompt, pool_sample, latent_prompt, krope_prompt, latent_sample, krope_sample)
```

```cpp
#include <hip/hip_runtime.h>
#include <cstdio>
#include <cstdint>

#ifndef MK_N_LAUNCHES
#define MK_N_LAUNCHES 1
#endif

#define GAS __attribute__((address_space(1)))
#define LAS __attribute__((address_space(3)))
typedef unsigned short bf16_t;
typedef short bf16x8 __attribute__((ext_vector_type(8)));
typedef float f32x4 __attribute__((ext_vector_type(4)));
typedef float f32x16 __attribute__((ext_vector_type(16)));
typedef unsigned u32x2 __attribute__((ext_vector_type(2)));
typedef unsigned u32x4 __attribute__((ext_vector_type(4)));

constexpr int D = 1024, FF = 4096, PLE = 256, SEQ = 8192, NBATCH = 2, DB = 128, DS = 8;
constexpr int MP = NBATCH * SEQ;
constexpr int MS = DB * DS;
constexpr int M = MP + MS;
constexpr int KVR = 256, ROPE = 64, QR = 384, NH = 8, NOPE = 128, VD = 128, QH = NOPE + ROPE;
constexpr int NDKVQ = 768;
constexpr int PAST = 8192, PAGE = 128, NPG = PAST / PAGE;
constexpr float EPS = 1e-6f;
constexpr float SM_SCALE = 0.07216878364870322f;
constexpr float LOG2E = 1.4426950408889634f;
constexpr float CEXP = SM_SCALE * LOG2E;
constexpr int NPOS = PAST + DS;

constexpr size_t O_Y = 0;
constexpr size_t O_PP = (size_t)M * D;
constexpr size_t O_PS = O_PP + (size_t)NBATCH * 15 * D;
constexpr size_t O_LP = O_PS + (size_t)DB * 15 * D;
constexpr size_t O_KP = O_LP + (size_t)MP * KVR;
constexpr size_t O_LS = O_KP + (size_t)MP * ROPE;
constexpr size_t O_KS = O_LS + (size_t)MS * KVR;
constexpr size_t O_END = O_KS + (size_t)MS * ROPE;

constexpr size_t al256(size_t x) { return (x + 255) / 256 * 256; }
constexpr size_t WS_CTL = 0, CTL_BYTES = 1u << 20;
constexpr size_t WS_WPOOL = CTL_BYTES;
constexpr size_t WS_WUP   = WS_WPOOL + al256((size_t)1024 * 256 * 2);
constexpr size_t WS_WDOWN = WS_WUP   + al256((size_t)2 * FF * D * 2);
constexpr size_t WS_WGATE = WS_WDOWN + al256((size_t)2 * FF * D * 2);
constexpr size_t WS_WPROJ = WS_WGATE + al256((size_t)2 * D * D * 2);
constexpr size_t WS_WDKVQ = WS_WPROJ + al256((size_t)2 * D * PLE * 2);
constexpr size_t WS_WUQ   = WS_WDKVQ + al256((size_t)NDKVQ * D * 2);
constexpr size_t WS_WUKT  = WS_WUQ   + al256((size_t)NH * QH * QR * 2);
constexpr size_t WS_WUVT  = WS_WUKT  + al256((size_t)1024 * 256 * 2);
constexpr size_t WS_WUKB  = WS_WUVT  + al256((size_t)1024 * 256 * 2);
constexpr size_t WS_WO    = WS_WUKB  + al256((size_t)1024 * 256 * 2);
constexpr size_t WS_CS    = WS_WO    + al256((size_t)D * D * 2);
constexpr size_t WS_RSTD0 = WS_CS    + al256((size_t)NPOS * 64 * 4);
constexpr size_t WS_DBUF  = WS_RSTD0 + al256((size_t)M * 4);
constexpr size_t WS_PB    = WS_DBUF  + al256((size_t)M * D * 2);
constexpr size_t WS_HBA   = WS_PB    + al256((size_t)2 * M * PLE * 2);
constexpr size_t WS_HBB   = WS_HBA   + al256((size_t)M * D * 2);
constexpr size_t WS_SSQ   = WS_HBB   + al256((size_t)M * D * 2);
constexpr size_t WS_ABUF  = WS_SSQ   + al256((size_t)6 * M * 16 * 4);
constexpr size_t WS_PROJ  = WS_ABUF  + al256((size_t)M * FF * 2);
constexpr size_t WS_RAW   = WS_PROJ  + al256((size_t)2 * M * D * 2);
constexpr size_t WS_CB    = WS_RAW   + al256((size_t)M * NDKVQ * 4);
constexpr size_t WS_KRBS  = WS_CB    + al256((size_t)M * KVR * 2);
constexpr size_t WS_CQB   = WS_KRBS  + al256((size_t)MS * ROPE * 2);
constexpr size_t WS_RSTDQ = WS_CQB   + al256((size_t)M * QR * 2);
constexpr size_t WS_QBUF  = WS_RSTDQ + al256((size_t)M * 4);
constexpr size_t WS_QS    = WS_QBUF  + al256((size_t)M * NH * QH * 2);
constexpr size_t WS_KFULL = WS_QS    + al256((size_t)MS * NH * 320 * 2);
constexpr size_t WS_VT    = WS_KFULL + al256((size_t)16 * SEQ * QH * 2);
constexpr size_t WS_OBUF  = WS_VT    + al256((size_t)16 * VD * SEQ * 2);
constexpr size_t WS_PART  = WS_OBUF  + al256((size_t)M * D * 2);
constexpr size_t WS_ML    = WS_PART  + al256((size_t)DB * 8 * 64 * 256 * 4);
constexpr size_t WS_END   = WS_ML    + al256((size_t)DB * 8 * 64 * 2 * 4);

constexpr int CW_BAR = 4096;

constexpr int RING_BYTES = 131072;
constexpr int LDS_BYTES = 147456;
constexpr int MISC_OFF = LDS_BYTES - 256;

typedef float f32x2 __attribute__((ext_vector_type(2)));
typedef __bf16 nbf16x2 __attribute__((ext_vector_type(2)));
__device__ __forceinline__ unsigned pk2(float lo, float hi) { const f32x2 v = {lo, hi}; return __builtin_bit_cast(unsigned, __builtin_convertvector(v, nbf16x2)); }
__device__ __forceinline__ unsigned f2bf(float f) { return pk2(f, 0.f) & 0xffffu; }
__device__ __forceinline__ float bf2f(unsigned short b) { return __builtin_bit_cast(float, ((unsigned)b) << 16); }
__device__ __forceinline__ f32x4 unpk4(u32x2 w) { f32x4 r; r.x = __builtin_bit_cast(float, w.x << 16); r.y = __builtin_bit_cast(float, w.x & 0xffff0000u); r.z = __builtin_bit_cast(float, w.y << 16); r.w = __builtin_bit_cast(float, w.y & 0xffff0000u); return r; }
__device__ __forceinline__ bf16x8 pack8(const float* v) { u32x4 w; w.x = pk2(v[0], v[1]); w.y = pk2(v[2], v[3]); w.z = pk2(v[4], v[5]); w.w = pk2(v[6], v[7]); return __builtin_bit_cast(bf16x8, w); }
__device__ __forceinline__ bf16x8 pack8v(f32x4 a, f32x4 b) { u32x4 w; w.x = pk2(a.x, a.y); w.y = pk2(a.z, a.w); w.z = pk2(b.x, b.y); w.w = pk2(b.z, b.w); return __builtin_bit_cast(bf16x8, w); }
__device__ __forceinline__ float wave_sum(float v) {
#pragma unroll
    for (int o = 1; o < 64; o <<= 1) v += __shfl_xor(v, o);
    return v;
}
__device__ __forceinline__ int crow(int r, int hi) { return (r & 3) + 8 * (r >> 2) + 4 * hi; }
#define LDS_WAIT() asm volatile("s_waitcnt lgkmcnt(0)" ::: "memory")
#define VM_WAIT() asm volatile("s_waitcnt vmcnt(0)" ::: "memory")

#define XB_TMO      128
#define XB_XCNT(j)  (256  + 64 * (j))
#define XB_XSUB(j)  (1280 + 64 * (j))
#define XB_XGEN(j)  (2304 + 64 * (j))
#define XB_TOP      3328
#define XB_TOPGEN   3392
#define XCD_BAR_WORDS 3456
#define XB_SPIN_CAP (1u << 18)
__device__ __forceinline__ unsigned xb_ld(unsigned* p)              { return __hip_atomic_load(p, __ATOMIC_RELAXED, __HIP_MEMORY_SCOPE_AGENT); }
__device__ __forceinline__ unsigned xb_add(unsigned* p, unsigned v) { return __hip_atomic_fetch_add(p, v, __ATOMIC_RELAXED, __HIP_MEMORY_SCOPE_AGENT); }
__device__ __forceinline__ unsigned xb_xcc_id() { return (unsigned)__builtin_amdgcn_s_getreg((3 << 11) | 20) & 0xFu; }
#define XB_SPIN(cond, bar) do { unsigned _sp = 0; while (cond) { __builtin_amdgcn_s_sleep(1); \
    if ((++_sp & 255u) == 0u) { if (xb_ld(&(bar)[XB_TMO])) break; if (_sp > XB_SPIN_CAP) { atomicAdd(&(bar)[XB_TMO], 1u); break; } } } } while (0)
struct XcdBarrier { unsigned* bar; unsigned x; volatile LAS unsigned* st; };
__device__ __forceinline__ XcdBarrier xcd_barrier_post(unsigned* bar, volatile LAS unsigned* st) {
    XcdBarrier b; b.bar = bar; b.x = xb_xcc_id(); b.st = st;
    if (threadIdx.x == 0) (void)xb_add(&bar[XB_XCNT(b.x)], 1u);
    return b;
}
__device__ __forceinline__ void xcd_barrier_complete(unsigned* bar, unsigned x, unsigned& nloc, unsigned& nx) {
    const unsigned G = gridDim.x * gridDim.y * gridDim.z;
    unsigned sum, cnt, mine, sp = 0u;
    for (;;) {
        sum = 0u; cnt = 0u; mine = 0u;
#pragma unroll
        for (unsigned j = 0; j < 16; ++j) { const unsigned c = xb_ld(&bar[XB_XCNT(j)]); sum += c; cnt += (c > 0u) ? 1u : 0u; mine = (j == x) ? c : mine; }
        if (sum == G) break;
        __builtin_amdgcn_s_sleep(1);
        if ((++sp & 255u) == 0u) { if (xb_ld(&bar[XB_TMO])) break; if (sp > XB_SPIN_CAP) { atomicAdd(&bar[XB_TMO], 1u); break; } }
    }
    nloc = mine > 0u ? mine : 1u; nx = cnt > 0u ? cnt : 1u;
}
__device__ __forceinline__ void xcd_barrier(const XcdBarrier& b) {
    asm volatile("s_waitcnt vmcnt(0)" ::: "memory");
    __syncthreads();
    if (threadIdx.x == 0) {
        unsigned* bar = b.bar;
        __builtin_amdgcn_s_waitcnt(0);
        unsigned nloc = b.st[0], nx = b.st[1];
        if (nloc == 0u) { xcd_barrier_complete(bar, b.x, nloc, nx); b.st[0] = nloc; b.st[1] = nx; }
        const unsigned old = xb_add(&bar[XB_XSUB(b.x)], 1u);
        const unsigned gen = old / nloc;
        if (old + 1u == (gen + 1u) * nloc) {
            __builtin_amdgcn_fence(__ATOMIC_RELEASE, "agent");
            asm volatile("s_waitcnt vmcnt(0)" ::: "memory");
            const unsigned og = xb_add(&bar[XB_TOP], 1u);
            const unsigned tg = og / nx;
            if (og + 1u == (tg + 1u) * nx) xb_add(&bar[XB_TOPGEN], 1u);
            else XB_SPIN(xb_ld(&bar[XB_TOPGEN]) == tg, bar);
            __builtin_amdgcn_fence(__ATOMIC_ACQUIRE, "agent");
            xb_add(&bar[XB_XGEN(b.x)], 1u);
            asm volatile("s_waitcnt vmcnt(0)" ::: "memory");
        } else {
            XB_SPIN(xb_ld(&bar[XB_XGEN(b.x)]) == gen, bar);
            __builtin_amdgcn_fence(__ATOMIC_ACQUIRE, "agent");
            asm volatile("s_waitcnt vmcnt(0)" ::: "memory");
        }
    }
    __syncthreads();
}

namespace pg8 {
constexpr int BM = 256, BK = 64, HALF = 128, HTB = HALF * BK * 2, STAGE_BYTES = 8 * HTB, NXCD = 8, WGM = 8;
__host__ __device__ __forceinline__ int lds_byte(int r, int c) { const int st = (r >> 4) * 2 + (c >> 5), rr = r & 15, cc = c & 31, ob = rr * 64 + cc * 2; return st * 1024 + (ob ^ (((ob >> 9) & 1) << 5)); }
__host__ __device__ __forceinline__ int perm32(int rho) { const int n = rho >> 4, i = rho & 15; return 8 * (i >> 2) + 4 * n + (i & 3); }
__host__ __device__ __forceinline__ void stage_rc(int b, int& R, int& C) { const int st = b / 1024, sb = b % 1024, swz = sb ^ (((sb >> 9) & 1) << 5); R = (st >> 1) * 16 + swz / 64; C = (st & 1) * 32 + (swz % 64) / 2; }
struct Unit { int pm, pn; };
struct Gemm { const bf16_t* A; const bf16_t* Bt; int M, N, K, lda, apn; };
struct StaticOrder {
    int nM, nN, nwg, G, c;
    __device__ void init(int M, int N, int G_, int c_) { nM = M / BM; nN = N / BM; nwg = nM * nN; G = G_; c = c_; }
    __device__ bool next(int i, Unit& u) const {
        const long L = (long)i * G + c; if (L >= nwg) return false;
        int wgid = (int)L; { const int q = nwg / NXCD, r = nwg % NXCD, xcd = wgid % NXCD, off = wgid / NXCD; wgid = (xcd < r ? xcd * (q + 1) : r * (q + 1) + (xcd - r) * q) + off; }
        const int nig = WGM * nN, gid = wgid / nig, fm = gid * WGM, gsz = (nM - fm) < WGM ? (nM - fm) : WGM;
        u.pm = fm + ((wgid % nig) % gsz); u.pn = (wgid % nig) / gsz; return true;
    }
};
template <class Epi>
__device__ __forceinline__ void gemm_phase(LAS unsigned char* lds, const Gemm g, const StaticOrder& S, const Epi& E) {
    const int tid = threadIdx.x, wid = __builtin_amdgcn_readfirstlane(tid >> 6), lane = tid & 63, wr = wid >> 2, wc = wid & 3, fr = lane & 15, fq = lane >> 4;
    const int K = g.K, nt = K / BK, lda = g.lda;
    unsigned voffA[2], voffB[2];
#pragma unroll
    for (int i = 0; i < 2; ++i) { int R, C; stage_rc(tid * 16 + i * 8192, R, C);
        const int Rb = Epi::PERM ? ((R & ~31) + perm32(R & 31)) : R;
        voffA[i] = (unsigned)(R * lda + C) * 2u; voffB[i] = (unsigned)(Rb * K + C) * 2u; }
    const size_t kstep = (size_t)(BK * 2);
    const size_t hstepA = (size_t)HALF * lda * 2, hstepB = (size_t)HALF * K * 2;
    const size_t tstepA = 2 * hstepA, tstepB = 2 * hstepB, pnA = (size_t)g.apn * 2;
    const unsigned ldsw = (unsigned)wid * 1024u;
    const int aoff = lds_byte(wr * 64 + fr, fq * 8), boff = lds_byte(wc * 32 + fr, fq * 8);
#define PG8_SA(b, h) (((b) * 2 + (h)) * HTB)
#define PG8_SB(b, h) ((4 + (b) * 2 + (h)) * HTB)
#define PG8_STAGE(bufoff, gbase, voff) do { _Pragma("unroll") for (int _i = 0; _i < 2; ++_i) \
        __builtin_amdgcn_global_load_lds((const unsigned*)((const char*)(gbase) + (voff)[_i]), (LAS unsigned*)(lds + (bufoff) + ldsw + _i * 8192), 16, 0, 0); } while (0)
#define PG8_LDA(dst, b, h) do { _Pragma("unroll") for (int m = 0; m < 4; ++m) _Pragma("unroll") for (int k = 0; k < 2; ++k) dst[m][k] = *(const LAS bf16x8*)(lds + PG8_SA(b, h) + aoff + m * 2048 + k * 1024); } while (0)
#define PG8_LDB(dst, b, h) do { _Pragma("unroll") for (int n = 0; n < 2; ++n) _Pragma("unroll") for (int k = 0; k < 2; ++k) dst[n][k] = *(const LAS bf16x8*)(lds + PG8_SB(b, h) + boff + n * 2048 + k * 1024); } while (0)
#define PG8_MMA(ai, bj, At, Bt) do { __builtin_amdgcn_s_setprio(1); _Pragma("unroll") for (int m = 0; m < 4; ++m) _Pragma("unroll") for (int n = 0; n < 2; ++n) _Pragma("unroll") for (int k = 0; k < 2; ++k) \
        acc[ai][bj][m][n] = __builtin_amdgcn_mfma_f32_16x16x32_bf16(Bt[n][k], At[m][k], acc[ai][bj][m][n], 0, 0, 0); __builtin_amdgcn_s_setprio(0); } while (0)
#define PG8_WAIT_V(n) asm volatile("s_waitcnt vmcnt(" #n ")" ::: "memory")
#define PG8_WAIT_L(n) asm volatile("s_waitcnt lgkmcnt(" #n ")" ::: "memory")
#define PG8_BAR __builtin_amdgcn_s_barrier()
#define PG8_SCHED __builtin_amdgcn_sched_barrier(0)
    Unit cur, nxt; int ui = 0;
    if (!S.next(0, cur)) return;
    f32x4 acc[2][2][4][2];
#pragma unroll
    for (int a = 0; a < 2; ++a)
#pragma unroll
        for (int b = 0; b < 2; ++b)
#pragma unroll
            for (int m = 0; m < 4; ++m)
#pragma unroll
                for (int n = 0; n < 2; ++n) acc[a][b][m][n] = (f32x4){0.f, 0.f, 0.f, 0.f};
    bf16x8 At[4][2], B0[2][2], B1[2][2];
    const char* cA = (const char*)g.A + (size_t)cur.pm * tstepA + (size_t)cur.pn * pnA; const char* cB = (const char*)g.Bt + (size_t)cur.pn * tstepB;
    PG8_STAGE(PG8_SB(0, 0), cB, voffB); PG8_STAGE(PG8_SB(0, 1), cB + hstepB, voffB); PG8_STAGE(PG8_SA(0, 0), cA, voffA); PG8_STAGE(PG8_SA(0, 1), cA + hstepA, voffA);
    if (wr == 1) PG8_BAR;
    PG8_WAIT_V(2); PG8_BAR;
    PG8_STAGE(PG8_SB(1, 0), cB + kstep, voffB); PG8_STAGE(PG8_SA(1, 0), cA + kstep, voffA); PG8_STAGE(PG8_SB(1, 1), cB + hstepB + kstep, voffB);
    PG8_WAIT_V(6); PG8_BAR;
    for (;;) {
        const bool has_next = S.next(ui + 1, nxt);
        const char* nA = has_next ? (const char*)g.A + (size_t)nxt.pm * tstepA + (size_t)nxt.pn * pnA : cA; const char* nB = has_next ? (const char*)g.Bt + (size_t)nxt.pn * tstepB : cB;
#pragma unroll 1
        for (int t = 0; t < nt; t += 2) {
            const bool last = (t == nt - 2);
            const char* a1 = cA + (size_t)(t + 1) * kstep;
            const char* a2 = last ? nA : cA + (size_t)(t + 2) * kstep; const char* b2 = last ? nB : cB + (size_t)(t + 2) * kstep;
            const char* a3 = a2 + kstep; const char* b3 = b2 + kstep;
            PG8_LDB(B0, 0, 0); PG8_LDB(B1, 0, 1); PG8_SCHED; PG8_LDA(At, 0, 0); PG8_STAGE(PG8_SA(1, 1), a1 + hstepA, voffA);
            PG8_WAIT_V(8); PG8_WAIT_L(0); PG8_BAR; PG8_MMA(0, 0, At, B0); PG8_MMA(0, 1, At, B1); PG8_BAR; PG8_SCHED;
            PG8_LDA(At, 0, 1); PG8_STAGE(PG8_SB(0, 0), b2, voffB); PG8_STAGE(PG8_SB(0, 1), b2 + hstepB, voffB); PG8_STAGE(PG8_SA(0, 0), a2, voffA);
            PG8_WAIT_V(8); PG8_WAIT_L(0); PG8_BAR; PG8_MMA(1, 0, At, B0); PG8_MMA(1, 1, At, B1); PG8_BAR; PG8_SCHED;
            PG8_LDB(B0, 1, 0); PG8_LDB(B1, 1, 1); PG8_SCHED; PG8_LDA(At, 1, 0); PG8_STAGE(PG8_SA(0, 1), a2 + hstepA, voffA);
            PG8_WAIT_V(8); PG8_WAIT_L(0); PG8_BAR; PG8_MMA(0, 0, At, B0); PG8_MMA(0, 1, At, B1); PG8_BAR; PG8_SCHED;
            PG8_LDA(At, 1, 1); PG8_STAGE(PG8_SB(1, 0), b3, voffB); PG8_STAGE(PG8_SB(1, 1), b3 + hstepB, voffB); PG8_STAGE(PG8_SA(1, 0), a3, voffA);
            PG8_WAIT_V(8); PG8_WAIT_L(0); PG8_BAR; PG8_MMA(1, 0, At, B0); PG8_MMA(1, 1, At, B1); PG8_BAR; PG8_SCHED;
        }
        if (wr == 0) PG8_BAR;
        E(acc, cur, wr, wc, fr, fq);
        if (!has_next) break;
#pragma unroll
        for (int a = 0; a < 2; ++a)
#pragma unroll
            for (int b = 0; b < 2; ++b)
#pragma unroll
                for (int m = 0; m < 4; ++m)
#pragma unroll
                    for (int n = 0; n < 2; ++n) acc[a][b][m][n] = (f32x4){0.f, 0.f, 0.f, 0.f};
        cur = nxt; cA = nA; cB = nB; ++ui;
        if (wr == 1) PG8_BAR;
    }
    PG8_WAIT_V(0);
    PG8_BAR;
#undef PG8_SA
#undef PG8_SB
#undef PG8_STAGE
#undef PG8_LDA
#undef PG8_LDB
#undef PG8_MMA
#undef PG8_WAIT_V
#undef PG8_WAIT_L
#undef PG8_BAR
#undef PG8_SCHED
}
}

struct Params { const float* in[27]; float* out; unsigned char* ws; int ph_lo, ph_hi; };
enum { I_XP = 0, I_XS, I_PP, I_PS, I_SPOOL, I_CLAT, I_CKR, I_PT, I_NMIX, I_NMLP, I_NPLE, I_POOLW, I_POOLSC, I_NKV, I_WDKV, I_KVN, I_WUK, I_WUV, I_WDQ, I_QN, I_WUQ, I_WO, I_WUP, I_WDOWN, I_WGATE, I_WPROJ, I_NFIN };

__device__ __forceinline__ void load_rstd(const float* ssq, const pg8::Unit& u, int wr, int fr, int fq, float (&rs)[2][4]) {
#pragma unroll
    for (int ai = 0; ai < 2; ++ai)
#pragma unroll
        for (int m = 0; m < 4; ++m) {
            const int row = u.pm * 256 + ai * 128 + wr * 64 + m * 16 + fr;
            const f32x4 a = ((const f32x4*)(ssq + (size_t)row * 16))[fq];
            float t = (a.x + a.y) + (a.z + a.w);
            t += __shfl_xor(t, 16); t += __shfl_xor(t, 32);
            rs[ai][m] = 1.0f / sqrtf(t * (1.0f / 1024.0f) + EPS);
        }
}
template <int MODE> struct EpiH {
    static constexpr bool PERM = true;
    const float* xp; const float* xs; const float* scale; const float* ssq_in; const bf16_t* proj;
    const bf16_t* hb_in; bf16_t* hb; float* ssq_out;
    __device__ __forceinline__ void operator()(const f32x4 (&acc)[2][2][4][2], const pg8::Unit& u, int wr, int wc, int fr_in, int fq_in) const {
        int fr = fr_in, fq = fq_in; asm volatile("" : "+v"(fr), "+v"(fq));
        float rs[2][4];
        if (MODE == 2) load_rstd(ssq_in, u, wr, fr, fq, rs);
        const int col0 = u.pn * 256 + wc * 32 + 8 * fq;
#pragma unroll
        for (int ai = 0; ai < 2; ++ai)
#pragma unroll
            for (int m = 0; m < 4; ++m) {
                const int row = u.pm * 256 + ai * 128 + wr * 64 + m * 16 + fr;
                float sq = 0.f;
#pragma unroll
                for (int bj = 0; bj < 2; ++bj) {
                    const int col = col0 + bj * 128;
                    f32x4 b0, b1;
                    if (MODE == 0) { const float* xr = (row < MP ? xp + (size_t)row * D : xs + (size_t)(row - MP) * D) + col; b0 = *(const f32x4*)xr; b1 = *(const f32x4*)(xr + 4); }
                    else { const u32x4 hv = *(const u32x4*)(hb_in + (size_t)row * D + col); b0 = unpk4((u32x2){hv.x, hv.y}); b1 = unpk4((u32x2){hv.z, hv.w}); }
                    const f32x4 a0 = acc[ai][bj][m][0], a1 = acc[ai][bj][m][1]; f32x4 o0, o1;
                    if (MODE == 0) { o0 = b0 + *(const f32x4*)(scale + col) * a0; o1 = b1 + *(const f32x4*)(scale + col + 4) * a1; }
                    else if (MODE == 1) { o0 = b0 + a0; o1 = b1 + a1; }
                    else { const u32x4 pv = *(const u32x4*)(proj + (size_t)row * D + col); const f32x4 p0 = unpk4((u32x2){pv.x, pv.y}), p1 = unpk4((u32x2){pv.z, pv.w}); const float r = rs[ai][m];
                        f32x4 g0, g1;
                        g0.x = 1.0f / (1.0f + __expf(-r * a0.x)); g0.y = 1.0f / (1.0f + __expf(-r * a0.y)); g0.z = 1.0f / (1.0f + __expf(-r * a0.z)); g0.w = 1.0f / (1.0f + __expf(-r * a0.w));
                        g1.x = 1.0f / (1.0f + __expf(-r * a1.x)); g1.y = 1.0f / (1.0f + __expf(-r * a1.y)); g1.z = 1.0f / (1.0f + __expf(-r * a1.z)); g1.w = 1.0f / (1.0f + __expf(-r * a1.w));
                        o0 = b0 + g0 * p0; o1 = b1 + g1 * p1; }
                    u32x4 w; w.x = pk2(o0.x, o0.y); w.y = pk2(o0.z, o0.w); w.z = pk2(o1.x, o1.y); w.w = pk2(o1.z, o1.w);
                    *(u32x4*)(hb + (size_t)row * D + col) = w;
                    sq += ((o0.x * o0.x + o0.y * o0.y) + (o0.z * o0.z + o0.w * o0.w)) + ((o1.x * o1.x + o1.y * o1.y) + (o1.z * o1.z + o1.w * o1.w));
                }
                sq += __shfl_xor(sq, 16); sq += __shfl_xor(sq, 32);
                if (fq == 0) ssq_out[(size_t)row * 16 + u.pn * 4 + wc] = sq;
                asm volatile("" ::: "memory");
            }
    }
};
struct EpiUp {
    static constexpr bool PERM = true;
    const float* ssq_in; bf16_t* abuf;
    __device__ __forceinline__ void operator()(const f32x4 (&acc)[2][2][4][2], const pg8::Unit& u, int wr, int wc, int fr_in, int fq_in) const {
        int fr = fr_in, fq = fq_in; asm volatile("" : "+v"(fr), "+v"(fq));
        float rs[2][4]; load_rstd(ssq_in, u, wr, fr, fq, rs);
        const int col0 = u.pn * 256 + wc * 32 + 8 * fq;
#pragma unroll
        for (int ai = 0; ai < 2; ++ai)
#pragma unroll
            for (int m = 0; m < 4; ++m) {
                const int row = u.pm * 256 + ai * 128 + wr * 64 + m * 16 + fr; const float r = rs[ai][m];
#pragma unroll
                for (int bj = 0; bj < 2; ++bj) {
                    f32x4 a = acc[ai][bj][m][0] * r, c = acc[ai][bj][m][1] * r;
                    a.x = fmaxf(a.x, 0.f); a.y = fmaxf(a.y, 0.f); a.z = fmaxf(a.z, 0.f); a.w = fmaxf(a.w, 0.f);
                    c.x = fmaxf(c.x, 0.f); c.y = fmaxf(c.y, 0.f); c.z = fmaxf(c.z, 0.f); c.w = fmaxf(c.w, 0.f);
                    u32x4 w; w.x = pk2(a.x * a.x, a.y * a.y); w.y = pk2(a.z * a.z, a.w * a.w); w.z = pk2(c.x * c.x, c.y * c.y); w.w = pk2(c.z * c.z, c.w * c.w);
                    *(u32x4*)(abuf + (size_t)row * FF + col0 + bj * 128) = w;
                }
            }
    }
};
template <int MODE> struct EpiF32 {
    static constexpr bool PERM = false;
    float* C; int ldc; const float* aux;
    __device__ __forceinline__ void operator()(const f32x4 (&acc)[2][2][4][2], const pg8::Unit& u, int wr, int wc, int fr_in, int fq_in) const {
        int fr = fr_in, fq = fq_in; asm volatile("" : "+v"(fr), "+v"(fq));
        float rs[2][4];
        if (MODE == 1) load_rstd(aux, u, wr, fr, fq, rs);
        const int col0 = u.pn * 256 + wc * 32 + 4 * fq;
#pragma unroll
        for (int ai = 0; ai < 2; ++ai)
#pragma unroll
            for (int m = 0; m < 4; ++m) {
                const int row = u.pm * 256 + ai * 128 + wr * 64 + m * 16 + fr;
                const float r = (MODE == 1) ? rs[ai][m] : (MODE == 2 ? aux[row] : 1.0f);
#pragma unroll
                for (int bj = 0; bj < 2; ++bj)
#pragma unroll
                    for (int n = 0; n < 2; ++n) *(f32x4*)(C + (size_t)row * ldc + col0 + bj * 128 + n * 16) = acc[ai][bj][m][n] * r;
            }
    }
};
struct EpiBf {
    static constexpr bool PERM = true;
    bf16_t* C; int ldc;
    __device__ __forceinline__ void operator()(const f32x4 (&acc)[2][2][4][2], const pg8::Unit& u, int wr, int wc, int fr_in, int fq_in) const {
        int fr = fr_in, fq = fq_in; asm volatile("" : "+v"(fr), "+v"(fq));
        const int col0 = u.pn * 256 + wc * 32 + 8 * fq;
#pragma unroll
        for (int ai = 0; ai < 2; ++ai)
#pragma unroll
            for (int m = 0; m < 4; ++m) {
                const int row = u.pm * 256 + ai * 128 + wr * 64 + m * 16 + fr;
#pragma unroll
                for (int bj = 0; bj < 2; ++bj) { const f32x4 a = acc[ai][bj][m][0], c = acc[ai][bj][m][1]; u32x4 w; w.x = pk2(a.x, a.y); w.y = pk2(a.z, a.w); w.z = pk2(c.x, c.y); w.w = pk2(c.z, c.w);
                    *(u32x4*)(C + (size_t)row * ldc + col0 + bj * 128) = w; }
            }
    }
};
__host__ __device__ __forceinline__ int qperm(int c) { const int e = c % QH; if (e < NOPE) return c; const int r = e - NOPE, i = r & 31, sec = r >> 5; return c - e + NOPE + 32 * (i >> 4) + 16 * sec + (i & 15); }
struct EpiQ {
    static constexpr bool PERM = false;
    const float* rstdq; const float* cs; bf16_t* qbuf;
    __device__ __forceinline__ void operator()(const f32x4 (&acc)[2][2][4][2], const pg8::Unit& u, int wr, int wc, int fr_in, int fq_in) const {
        int fr = fr_in, fq = fq_in; asm volatile("" : "+v"(fr), "+v"(fq));
#pragma unroll
        for (int ai = 0; ai < 2; ++ai)
#pragma unroll
            for (int m = 0; m < 4; ++m) {
                const int row = u.pm * 256 + ai * 128 + wr * 64 + m * 16 + fr; const float r = rstdq[row]; const int pos = row & (SEQ - 1);
                bf16_t* qrow = qbuf + (size_t)row * (NH * QH);
#pragma unroll
                for (int bj = 0; bj < 2; ++bj) {
                    const int Gi = u.pn * 8 + bj * 4 + wc, hh = Gi / 6, gi = Gi - hh * 6;
                    if (gi < 4) {
#pragma unroll
                        for (int n = 0; n < 2; ++n) { const f32x4 a = acc[ai][bj][m][n] * r; u32x2 w; w.x = pk2(a.x, a.y); w.y = pk2(a.z, a.w);
                            *(u32x2*)(qrow + Gi * 32 + n * 16 + 4 * fq) = w; }
                    } else {
                        const int i0 = 16 * (gi - 4) + 4 * fq;
                        const f32x4 x1 = acc[ai][bj][m][0] * r, x2 = acc[ai][bj][m][1] * r;
                        const f32x4 cn = *(const f32x4*)(cs + (size_t)pos * 64 + i0), sn = *(const f32x4*)(cs + (size_t)pos * 64 + 32 + i0);
                        const f32x4 o1 = x1 * cn - x2 * sn, o2 = x2 * cn + x1 * sn;
                        u32x2 w1, w2; w1.x = pk2(o1.x, o1.y); w1.y = pk2(o1.z, o1.w); w2.x = pk2(o2.x, o2.y); w2.y = pk2(o2.z, o2.w);
                        *(u32x2*)(qrow + hh * QH + NOPE + i0) = w1; *(u32x2*)(qrow + hh * QH + NOPE + 32 + i0) = w2;
                    }
                }
                asm volatile("" ::: "memory");
            }
    }
};
struct EpiKup {
    static constexpr bool PERM = true;
    bf16_t* kfull;
    __device__ __forceinline__ void operator()(const f32x4 (&acc)[2][2][4][2], const pg8::Unit& u, int wr, int wc, int fr_in, int fq_in) const {
        int fr = fr_in, fq = fq_in; asm volatile("" : "+v"(fr), "+v"(fq));
        const int col0 = u.pn * 256 + wc * 32 + 8 * fq;
#pragma unroll
        for (int ai = 0; ai < 2; ++ai)
#pragma unroll
            for (int m = 0; m < 4; ++m) {
                const int row = u.pm * 256 + ai * 128 + wr * 64 + m * 16 + fr; const int b = row >> 13, t = row & (SEQ - 1);
#pragma unroll
                for (int bj = 0; bj < 2; ++bj) { const int col = col0 + bj * 128; const int h = col >> 7, nn = col & 127; const f32x4 a = acc[ai][bj][m][0], c = acc[ai][bj][m][1];
                    u32x4 w; w.x = pk2(a.x, a.y); w.y = pk2(a.z, a.w); w.z = pk2(c.x, c.y); w.w = pk2(c.z, c.w);
                    *(u32x4*)(kfull + ((size_t)(b * NH + h) * SEQ + t) * QH + nn) = w; }
                asm volatile("" ::: "memory");
            }
    }
};
struct EpiVup {
    static constexpr bool PERM = true;
    bf16_t* vt;
    __device__ __forceinline__ void operator()(const f32x4 (&acc)[2][2][4][2], const pg8::Unit& u, int wr, int wc, int fr_in, int fq_in) const {
        int fr = fr_in, fq = fq_in; asm volatile("" : "+v"(fr), "+v"(fq));
        const int col0 = u.pn * 256 + wc * 32 + 8 * fq;
#pragma unroll
        for (int ai = 0; ai < 2; ++ai)
#pragma unroll
            for (int m = 0; m < 4; ++m) {
                const int row = u.pm * 256 + ai * 128 + wr * 64 + m * 16 + fr; const int h = row >> 7, v = row & 127;
#pragma unroll
                for (int bj = 0; bj < 2; ++bj) { const int col = col0 + bj * 128; const int b = col >> 13, t = col & (SEQ - 1); const f32x4 a = acc[ai][bj][m][0], c = acc[ai][bj][m][1];
                    u32x4 w; w.x = pk2(a.x, a.y); w.y = pk2(a.z, a.w); w.z = pk2(c.x, c.y); w.w = pk2(c.z, c.w);
                    *(u32x4*)(vt + ((size_t)(b * NH + h) * VD + v) * SEQ + t) = w; }
                asm volatile("" ::: "memory");
            }
    }
};

struct SgALoadBf { const bf16_t* A; int lda;
    __device__ __forceinline__ bf16x8 operator()(int row, int k) const { return *(const bf16x8*)(A + (size_t)row * lda + k); } };
struct SgALoadComb { const float* parto; const float* ml;
    __device__ __forceinline__ bf16x8 operator()(int row, int k) const {
        const int b = row >> 3, tok = row & 7, h = k >> 7, v = k & 127, q = tok * 8 + h;
        const float* m0p = ml + ((size_t)(b * 2 + 0) * 64 + q) * 2; const float* m1p = ml + ((size_t)(b * 2 + 1) * 64 + q) * 2;
        const float m0 = m0p[0], l0 = m0p[1], m1 = m1p[0], l1 = m1p[1], mx = fmaxf(m0, m1);
        float w0 = __builtin_amdgcn_exp2f(m0 - mx), w1 = __builtin_amdgcn_exp2f(m1 - mx); const float inv = 1.0f / (w0 * l0 + w1 * l1); w0 *= inv; w1 *= inv;
        const float* p0 = parto + ((size_t)(b * 2 + 0) * 64 + q) * 128 + v; const float* p1 = parto + ((size_t)(b * 2 + 1) * 64 + q) * 128 + v;
        return pack8v(*(const f32x4*)p0 * w0 + *(const f32x4*)p1 * w1, *(const f32x4*)(p0 + 4) * w0 + *(const f32x4*)(p1 + 4) * w1); } };
template <int NCT, int NCG, class Epi, class ALoad>
__device__ __forceinline__ void sg_gemm_l(LAS unsigned char* lds, const ALoad& AL, int apn256, const bf16_t* __restrict__ Bt, int K, int unit, const Epi& E, int tid, int wave, int lane) {
    constexpr int KS = 8 / NCG, W = NCG * NCT * 16, G4 = W / 4;
    static_assert(KS * 64 * W * 4 <= RING_BYTES, "sg_gemm reduction buffer");
    const int mt = unit >> 4, ntile = unit & 15, m0 = mt * 64, n0 = ntile * W;
    const int cg = wave % NCG, kp = wave / NCG, fr = lane & 15, fq = lane >> 4;
    const int Kw = K / KS;
    const int arow = m0 + fr, acol = (n0 >> 8) * apn256 + kp * Kw + 8 * fq;
    const bf16_t* bp = Bt + (size_t)(n0 + cg * NCT * 16 + fr) * K + kp * Kw + 8 * fq;
    f32x4 acc[4][NCT];
#pragma unroll
    for (int m = 0; m < 4; ++m)
#pragma unroll
        for (int n = 0; n < NCT; ++n) acc[m][n] = (f32x4){0.f, 0.f, 0.f, 0.f};
#pragma unroll 4
    for (int kk = 0; kk < Kw; kk += 32) {
        bf16x8 af[4], bfr[NCT];
#pragma unroll
        for (int m = 0; m < 4; ++m) af[m] = AL(arow + 16 * m, acol + kk);
#pragma unroll
        for (int n = 0; n < NCT; ++n) bfr[n] = *(const bf16x8*)(bp + (size_t)(16 * n) * K + kk);
#pragma unroll
        for (int m = 0; m < 4; ++m)
#pragma unroll
            for (int n = 0; n < NCT; ++n) acc[m][n] = __builtin_amdgcn_mfma_f32_16x16x32_bf16(bfr[n], af[m], acc[m][n], 0, 0, 0);
    }
    LAS float* red = (LAS float*)lds;
#pragma unroll
    for (int m = 0; m < 4; ++m)
#pragma unroll
        for (int n = 0; n < NCT; ++n) { const int row = 16 * m + fr, c4 = (cg * NCT * 16 + 16 * n) / 4 + fq;
            *(LAS f32x4*)(red + (size_t)(kp * 64 + row) * W + 4 * (c4 ^ (row & 3))) = acc[m][n]; }
    __syncthreads();
    for (int it = tid; it < 64 * G4; it += 512) {
        const int row = it / G4, c4 = it % G4;
        f32x4 v = *(const LAS f32x4*)(red + (size_t)row * W + 4 * (c4 ^ (row & 3)));
#pragma unroll
        for (int p = 1; p < KS; ++p) v += *(const LAS f32x4*)(red + (size_t)(p * 64 + row) * W + 4 * (c4 ^ (row & 3)));
        if constexpr (Epi::WHOLE_TILE) *(LAS f32x4*)(red + (size_t)row * W + 4 * (c4 ^ (row & 3))) = v;
        else E(MP + m0 + row, n0 + 4 * c4, v, ntile);
    }
    if constexpr (Epi::WHOLE_TILE) {
        __syncthreads();
        for (int it = tid; it < 64 * G4; it += 512) { const int row = it / G4, c4 = it % G4; E.tile(MP + m0 + row, n0, c4, red + (size_t)row * W, row & 3); }
    }
    __syncthreads();
}
template <int NCT, int NCG, class Epi>
__device__ __forceinline__ void sg_gemm(LAS unsigned char* lds, const bf16_t* __restrict__ A, int lda, int apn256, const bf16_t* __restrict__ Bt, int K, int unit, const Epi& E, int tid, int wave, int lane) {
    const SgALoadBf AL{A, lda}; sg_gemm_l<NCT, NCG>(lds, AL, apn256, Bt, K, unit, E, tid, wave, lane);
}
__device__ __forceinline__ float row_rstd16(const float* ssq, int row) {
    const f32x4* s = (const f32x4*)(ssq + (size_t)row * 16); const f32x4 a = s[0], b = s[1], c = s[2], d = s[3];
    const float t = ((a.x + a.y) + (a.z + a.w)) + ((b.x + b.y) + (b.z + b.w)) + ((c.x + c.y) + (c.z + c.w)) + ((d.x + d.y) + (d.z + d.w));
    return 1.0f / sqrtf(t * (1.0f / 1024.0f) + EPS);
}
template <int MODE> struct SgH {
    static constexpr bool WHOLE_TILE = false;
    const float* xs; const float* scale; const float* ssq_in; const bf16_t* proj; const bf16_t* hb_in; bf16_t* hb; float* ssq_out;
    __device__ __forceinline__ void operator()(int row, int col, f32x4 a, int ntile) const {
        const f32x4 bs = (MODE == 0) ? *(const f32x4*)(xs + (size_t)(row - MP) * D + col) : unpk4(*(const u32x2*)(hb_in + (size_t)row * D + col));
        f32x4 o;
        if (MODE == 0) o = bs + *(const f32x4*)(scale + col) * a;
        else if (MODE == 1) o = bs + a;
        else { const float r = row_rstd16(ssq_in, row); const f32x4 pj = unpk4(*(const u32x2*)(proj + (size_t)row * D + col));
            f32x4 gt; gt.x = 1.0f / (1.0f + __expf(-r * a.x)); gt.y = 1.0f / (1.0f + __expf(-r * a.y)); gt.z = 1.0f / (1.0f + __expf(-r * a.z)); gt.w = 1.0f / (1.0f + __expf(-r * a.w));
            o = bs + gt * pj; }
        u32x2 w; w.x = pk2(o.x, o.y); w.y = pk2(o.z, o.w);
        *(u32x2*)(hb + (size_t)row * D + col) = w;
        float sq = (o.x * o.x + o.y * o.y) + (o.z * o.z + o.w * o.w);
        sq += __shfl_xor(sq, 1); sq += __shfl_xor(sq, 2); sq += __shfl_xor(sq, 4); sq += __shfl_xor(sq, 8);
        if ((col & 63) == 0) ssq_out[(size_t)row * 16 + ntile] = sq;
    }
};
struct SgUp {
    static constexpr bool WHOLE_TILE = false;
    const float* ssq_in; bf16_t* abuf;
    __device__ __forceinline__ void operator()(int row, int col, f32x4 a, int) const {
        const float r = row_rstd16(ssq_in, row); a = a * r;
        a.x = fmaxf(a.x, 0.f); a.y = fmaxf(a.y, 0.f); a.z = fmaxf(a.z, 0.f); a.w = fmaxf(a.w, 0.f);
        u32x2 w; w.x = pk2(a.x * a.x, a.y * a.y); w.y = pk2(a.z * a.z, a.w * a.w);
        *(u32x2*)(abuf + (size_t)row * FF + col) = w;
    }
};
template <int MODE> struct SgF32 {
    static constexpr bool WHOLE_TILE = false;
    float* C; int ldc; const float* aux;
    __device__ __forceinline__ void operator()(int row, int col, f32x4 a, int) const {
        const float r = (MODE == 1) ? row_rstd16(aux, row) : (MODE == 2 ? aux[row] : 1.0f);
        *(f32x4*)(C + (size_t)row * ldc + col) = a * r;
    }
};
struct SgBf {
    static constexpr bool WHOLE_TILE = false;
    bf16_t* C; int ldc;
    __device__ __forceinline__ void operator()(int row, int col, f32x4 a, int) const { u32x2 w; w.x = pk2(a.x, a.y); w.y = pk2(a.z, a.w); *(u32x2*)(C + (size_t)row * ldc + col) = w; }
};
struct SgQ {
    static constexpr bool WHOLE_TILE = true;
    const float* rstdq; const float* cs; bf16_t* qbuf; bf16_t* qs;
    __device__ __forceinline__ void operator()(int, int, f32x4, int) const {}
    __device__ __forceinline__ void tile(int row, int n0, int c4, const LAS float* trow, int sw) const {
        const int c = n0 + 4 * c4, hh = c / QH, e = c - hh * QH; const float r = rstdq[row];
        const f32x4 v = *(const LAS f32x4*)(trow + 4 * (c4 ^ sw)) * r;
        if (e < NOPE) { u32x2 w; w.x = pk2(v.x, v.y); w.y = pk2(v.z, v.w); *(u32x2*)(qbuf + (size_t)row * (NH * QH) + c) = w; }
        else { const int rp = e - NOPE, wi = rp & 31;
            if (wi < 16) { const int i0 = 16 * (rp >> 5) + wi, pos = PAST + ((row - MP) & 7);
                const f32x4 x2 = *(const LAS f32x4*)(trow + 4 * ((c4 + 4) ^ sw)) * r;
                const f32x4 cn = *(const f32x4*)(cs + (size_t)pos * 64 + i0), sn = *(const f32x4*)(cs + (size_t)pos * 64 + 32 + i0);
                const f32x4 o1 = v * cn - x2 * sn, o2 = x2 * cn + v * sn;
                bf16_t* qd = qs + ((size_t)(row - MP) * NH + hh) * 320 + KVR;
                u32x2 w1, w2; w1.x = pk2(o1.x, o1.y); w1.y = pk2(o1.z, o1.w); w2.x = pk2(o2.x, o2.y); w2.y = pk2(o2.z, o2.w);
                *(u32x2*)(qd + i0) = w1; *(u32x2*)(qd + 32 + i0) = w2; } }
    }
};

template <bool QPERM = false>
__device__ __forceinline__ void transpose_item(const float* W, const float* kscale, int K, int N, bf16_t* WT, int row_off, LAS float* scr, int item, int lane) {
    const int nblk = N / 32, kb = item / nblk, nb = item % nblk, k0 = 64 * kb, n0 = 32 * nb;
    { f32x4 v[8];
#pragma unroll
      for (int i = 0; i < 8; ++i) v[i] = *(const f32x4*)(W + (size_t)(k0 + (lane >> 3) + 8 * i) * N + n0 + (lane & 7) * 4);
#pragma unroll
      for (int i = 0; i < 8; ++i) { const int kk = (lane >> 3) + 8 * i; f32x4 x = v[i]; if (kscale) x = x * kscale[k0 + kk];
          LAS float* d = scr + kk * 33 + (lane & 7) * 4; d[0] = x.x; d[1] = x.y; d[2] = x.z; d[3] = x.w; } }
    LDS_WAIT(); asm volatile("" ::: "memory");
    const int c = lane & 7;
#pragma unroll
    for (int j = 0; j < 4; ++j) { const int n = (lane >> 3) + 8 * j; const LAS float* s = scr + (8 * c) * 33 + n;
        u32x4 o; o.x = pk2(s[0 * 33], s[1 * 33]); o.y = pk2(s[2 * 33], s[3 * 33]); o.z = pk2(s[4 * 33], s[5 * 33]); o.w = pk2(s[6 * 33], s[7 * 33]);
        *(u32x4*)(WT + (size_t)(row_off + (QPERM ? qperm(n0 + n) : n0 + n)) * K + k0 + 8 * c) = o; }
    LDS_WAIT(); asm volatile("" ::: "memory");
}

constexpr int AK_PITCH = 400, AK_BUF = 64 * AK_PITCH;
constexpr int AV_PITCH = 136, AV_BUF = 128 * AV_PITCH;
constexpr int AV_OFF = 2 * AK_BUF, AQ_OFF = AV_OFF + 2 * AV_BUF;
static_assert(AQ_OFF + 256 * 144 <= RING_BYTES, "attention LDS");
__device__ __forceinline__ void attn_prompt_unit(const bf16_t* __restrict__ qbuf, const bf16_t* __restrict__ Kf, const bf16_t* __restrict__ Vt, bf16_t* __restrict__ obuf,
                                                 int b, int h, int qb, LAS unsigned char* lds, int tid, int wave, int lane) {
    const int r32 = lane & 31, g = lane >> 5;
    const int t_lo = qb * 256 + wave * 32, trow = t_lo + r32;
    bf16x8 qf[8];
    { const bf16_t* qp = qbuf + (size_t)(b * SEQ + trow) * (NH * QH) + h * QH + 8 * g;
      __syncthreads();
#pragma unroll
      for (int ks = 8; ks < 12; ++ks) *(LAS bf16x8*)(lds + AQ_OFF + (wave * 32 + r32) * 144 + (2 * (ks - 8) + g) * 16) = *(const bf16x8*)(qp + 16 * ks);
#pragma unroll
      for (int ks = 0; ks < 8; ++ks) qf[ks] = *(const bf16x8*)(qp + 16 * ks);
#pragma unroll
      for (int ks = 0; ks < 8; ++ks) asm volatile("" : "+v"(qf[ks])); }
    f32x16 O[4];
#pragma unroll
    for (int i = 0; i < 4; ++i)
#pragma unroll
        for (int j = 0; j < 16; ++j) O[i][j] = 0.f;
    float mrun = -1e30f, lrun = 0.f;
    const bf16_t* Kb = Kf + (size_t)(b * NH + h) * SEQ * QH;
    const bf16_t* Vb = Vt + (size_t)(b * NH + h) * VD * SEQ;
    const int NT = (qb + 1) * 4;
    int kl_off[3], vl_off[2]; size_t vg_off[2];
#pragma unroll
    for (int e = 0; e < 3; ++e) kl_off[e] = (tid >> 3) * AK_PITCH + ((tid & 7) + 8 * e) * 16;
#pragma unroll
    for (int e = 0; e < 2; ++e) { const int c = tid + 512 * e; vl_off[e] = AV_OFF + (c >> 3) * AV_PITCH + (c & 7) * 16; vg_off[e] = (size_t)(c >> 3) * SEQ + (c & 7) * 8; }
    u32x4 kst[3], vst[2];
#define AT_LOAD(j) do { _Pragma("unroll") for (int e = 0; e < 3; ++e) kst[e] = *(const u32x4*)(Kb + (size_t)(64 * (j) + (tid >> 3)) * QH + ((tid & 7) + 8 * e) * 8); \
                        _Pragma("unroll") for (int e = 0; e < 2; ++e) vst[e] = *(const u32x4*)(Vb + vg_off[e] + 64 * (j)); } while (0)
#define AT_WRITE(buf) do { _Pragma("unroll") for (int e = 0; e < 3; ++e) *(LAS u32x4*)(lds + (buf) * AK_BUF + kl_off[e]) = kst[e]; \
                           _Pragma("unroll") for (int e = 0; e < 2; ++e) { *(LAS u32x2*)(lds + (buf) * AV_BUF + vl_off[e]) = (u32x2){vst[e].x, vst[e].y}; *(LAS u32x2*)(lds + (buf) * AV_BUF + vl_off[e] + 8) = (u32x2){vst[e].z, vst[e].w}; } } while (0)
    AT_LOAD(0); AT_WRITE(0);
    __syncthreads();
    for (int j = 0; j < NT; ++j) {
        const int buf = j & 1;
        if (j + 1 < NT) AT_LOAD(j + 1);
        if (64 * j <= t_lo + 31) {
            f32x16 S0, S1;
#pragma unroll
            for (int i = 0; i < 16; ++i) { S0[i] = 0.f; S1[i] = 0.f; }
            const LAS unsigned char* kl = lds + buf * AK_BUF + r32 * AK_PITCH + g * 16;
            const LAS unsigned char* ql = lds + AQ_OFF + (wave * 32 + r32) * 144 + g * 16;
            bf16x8 ka[3][2], qr_[3];
#define AT_KLD(ks) do { ka[(ks) % 3][0] = *(const LAS bf16x8*)(kl + (ks) * 32); ka[(ks) % 3][1] = *(const LAS bf16x8*)(kl + 32 * AK_PITCH + (ks) * 32); \
                        if ((ks) >= 8) qr_[(ks) % 3] = *(const LAS bf16x8*)(ql + ((ks) - 8) * 32); } while (0)
            AT_KLD(0); AT_KLD(1);
#pragma unroll
            for (int ks = 0; ks < 12; ++ks) {
                if (ks + 2 < 12) AT_KLD(ks + 2);
                __builtin_amdgcn_sched_barrier(0);
                const bf16x8 qb_ = (ks < 8) ? qf[ks < 8 ? ks : 0] : qr_[ks % 3];
                S0 = __builtin_amdgcn_mfma_f32_32x32x16_bf16(ka[ks % 3][0], qb_, S0, 0, 0, 0);
                S1 = __builtin_amdgcn_mfma_f32_32x32x16_bf16(ka[ks % 3][1], qb_, S1, 0, 0, 0);
                __builtin_amdgcn_sched_barrier(0);
            }
#undef AT_KLD
            if (64 * j + 63 > t_lo) {
                asm volatile("" ::: "memory");
#pragma unroll
                for (int i = 0; i < 16; ++i) { const int key = 64 * j + crow(i, g); if (key > trow) S0[i] = -1e30f; if (key + 32 > trow) S1[i] = -1e30f; }
            }
            float mx = S0[0];
#pragma unroll
            for (int i = 1; i < 16; ++i) mx = fmaxf(mx, S0[i]);
#pragma unroll
            for (int i = 0; i < 16; ++i) mx = fmaxf(mx, S1[i]);
            mx = fmaxf(mx, __shfl_xor(mx, 32)) * CEXP;
            if (__any(mx > mrun + 11.5f)) {
                const float mnew = fmaxf(mrun, mx), alpha = __builtin_amdgcn_exp2f(mrun - mnew);
                mrun = mnew; lrun *= alpha;
#pragma unroll
                for (int vt = 0; vt < 4; ++vt)
#pragma unroll
                    for (int i = 0; i < 16; ++i) O[vt][i] *= alpha;
            }
            float ps = 0.f;
#pragma unroll
            for (int i = 0; i < 16; ++i) { S0[i] = __builtin_amdgcn_exp2f(S0[i] * CEXP - mrun); S1[i] = __builtin_amdgcn_exp2f(S1[i] * CEXP - mrun); ps += S0[i] + S1[i]; }
            lrun += ps;
            bf16x8 pf[4];
            { float tmp[8];
#pragma unroll
              for (int s2 = 0; s2 < 4; ++s2) {
#pragma unroll
                for (int i = 0; i < 8; ++i) tmp[i] = (s2 < 2) ? S0[8 * (s2 & 1) + i] : S1[8 * (s2 & 1) + i];
                pf[s2] = pack8(tmp); } }
            const LAS unsigned char* vl = lds + AV_OFF + buf * AV_BUF + r32 * AV_PITCH + g * 8;
            u32x4 fa[4], fb[4];
#define AT_VLD(dst, vt) do { _Pragma("unroll") for (int s2 = 0; s2 < 4; ++s2) { const u32x2 lo_ = *(const LAS u32x2*)(vl + (vt) * 32 * AV_PITCH + s2 * 32), hi_ = *(const LAS u32x2*)(vl + (vt) * 32 * AV_PITCH + s2 * 32 + 16); dst[s2] = (u32x4){lo_.x, lo_.y, hi_.x, hi_.y}; } } while (0)
#define AT_VMM(src, vt) do { _Pragma("unroll") for (int s2 = 0; s2 < 4; ++s2) O[vt] = __builtin_amdgcn_mfma_f32_32x32x16_bf16(__builtin_bit_cast(bf16x8, src[s2]), pf[s2], O[vt], 0, 0, 0); } while (0)
            AT_VLD(fa, 0); AT_VLD(fb, 1); __builtin_amdgcn_sched_barrier(0);
            AT_VMM(fa, 0); __builtin_amdgcn_sched_barrier(0);
            AT_VLD(fa, 2); __builtin_amdgcn_sched_barrier(0);
            AT_VMM(fb, 1); __builtin_amdgcn_sched_barrier(0);
            AT_VLD(fb, 3); __builtin_amdgcn_sched_barrier(0);
            AT_VMM(fa, 2); __builtin_amdgcn_sched_barrier(0);
            AT_VMM(fb, 3);
#undef AT_VLD
#undef AT_VMM
        }
        if (j + 1 < NT) AT_WRITE(buf ^ 1);
        __syncthreads();
    }
#undef AT_LOAD
#undef AT_WRITE
    const float ltot = lrun + __shfl_xor(lrun, 32), inv = 1.0f / ltot;
    bf16_t* op = obuf + (size_t)(b * SEQ + trow) * D + h * VD + 4 * g;
#pragma unroll
    for (int vt = 0; vt < 4; ++vt)
#pragma unroll
        for (int jq = 0; jq < 4; ++jq) {
            u32x2 w; w.x = pk2(O[vt][4 * jq] * inv, O[vt][4 * jq + 1] * inv); w.y = pk2(O[vt][4 * jq + 2] * inv, O[vt][4 * jq + 3] * inv);
            *(u32x2*)(op + 32 * vt + 8 * jq) = w;
        }
}

typedef short s16x4 __attribute__((ext_vector_type(4)));
constexpr int SA_KR = 32768, SA_BUF = 32768 + 64 * 144, SA_QR = 2 * SA_BUF, SA_QI = SA_QR + 64 * 144, SA_QI_PITCH = 528, SA_OI = 69632;
static_assert(SA_OI >= 65536 + 1024 && SA_OI + 64 * SA_QI_PITCH <= MISC_OFF, "O image");
static_assert(SA_QI + 64 * SA_QI_PITCH <= MISC_OFF, "sample attention LDS");
__device__ __forceinline__ int sa_off(int row, int ch) { return 256 * row + 16 * (ch ^ (((row & 3) << 2) | ((row >> 2) & 3))); }
__device__ __forceinline__ void sattn_item(const Params& P, int b, int half, LAS unsigned char* lds, int tid, int wave, int lane) {
    unsigned char* ws = P.ws;
    const int r32 = lane & 31, g = lane >> 5;
    const bool is_cmp = wave < 4;
    const int qt = wave & 1, kb = (wave >> 1) & 1;
    f32x4 sA[20], sB[20];
    const int ptv = ((const int*)P.in[I_PT])[b * NPG + half * 32 + (lane & 31)];
    const float* clat = P.in[I_CLAT]; const float* ckr = P.in[I_CKR];
#define SA_GL(e) ((((lz_ + 256 * (e)) >> 5) * KVR) + ((lz_ + 256 * (e)) & 31) * 8)
#define SA_LL(e) (((((lz_ + 256 * (e)) & 31) >> 4) * 16384) + sa_off((lz_ + 256 * (e)) >> 5, (lz_ + 256 * (e)) & 15))
#define SA_GR(e) (((lz_ + 256 * (e)) >> 3) * ROPE + ((lz_ + 256 * (e)) & 7) * 8)
#define SA_LR(e) (SA_KR + ((lz_ + 256 * (e)) >> 3) * 144 + ((lz_ + 256 * (e)) & 7) * 16)
#define SA_LOAD(S, j) do { int lz_ = tid - 256; asm volatile("" : "+v"(lz_)); const int pg_ = __builtin_amdgcn_readlane(ptv, (j) >> 1); const size_t prow_ = (size_t)pg_ * PAGE + (((j) & 1) << 6); \
        const float* lat_ = clat + prow_ * KVR; const float* kro_ = ckr + prow_ * ROPE; \
        _Pragma("unroll") for (int e = 0; e < 8; ++e) { S[2 * e] = *(const f32x4*)(lat_ + SA_GL(e)); S[2 * e + 1] = *(const f32x4*)(lat_ + SA_GL(e) + 4); } \
        _Pragma("unroll") for (int e = 0; e < 2; ++e) { S[16 + 2 * e] = *(const f32x4*)(kro_ + SA_GR(e)); S[17 + 2 * e] = *(const f32x4*)(kro_ + SA_GR(e) + 4); } } while (0)
#define SA_WRITE(S, bufo) do { int lz_ = tid - 256; asm volatile("" : "+v"(lz_)); \
        _Pragma("unroll") for (int e = 0; e < 8; ++e) *(LAS bf16x8*)(lds + (bufo) + SA_LL(e)) = pack8v(S[2 * e], S[2 * e + 1]); \
        _Pragma("unroll") for (int e = 0; e < 2; ++e) *(LAS bf16x8*)(lds + (bufo) + SA_LR(e)) = pack8v(S[16 + 2 * e], S[17 + 2 * e]); } while (0)
    bf16x8 qf[8];

    __syncthreads();
    *(LAS u32x4*)(lds + SA_QR + (tid >> 3) * 144 + (tid & 7) * 16) = *(const u32x4*)((const bf16_t*)(ws + WS_QS) + ((size_t)b * 64 + (tid >> 3)) * 320 + KVR + (tid & 7) * 8);
    if (!is_cmp) { SA_LOAD(sA, 0); }
    {
      const bf16_t* qn = (const bf16_t*)(ws + WS_QBUF) + (size_t)(MP + b * DS + (r32 & 7)) * (NH * QH) + wave * QH + 8 * g;
      bf16x8 an[8];
#pragma unroll
      for (int ks = 0; ks < 8; ++ks) { u32x4 z = {0u, 0u, 0u, 0u}; if (r32 < DS) z = *(const u32x4*)(qn + 16 * ks); an[ks] = __builtin_bit_cast(bf16x8, z); }
      const bf16_t* wk = (const bf16_t*)(ws + WS_WUKB) + (size_t)r32 * 1024 + wave * NOPE + 8 * g;
#pragma unroll 2
      for (int nt = 0; nt < 8; ++nt) {
          f32x16 acc;
#pragma unroll
          for (int i = 0; i < 16; ++i) acc[i] = 0.f;
#pragma unroll
          for (int ks = 0; ks < 8; ++ks) acc = __builtin_amdgcn_mfma_f32_32x32x16_bf16(an[ks], *(const bf16x8*)(wk + (size_t)(32 * nt) * 1024 + 16 * ks), acc, 0, 0, 0);
#pragma unroll
          for (int i = 0; i < 4; ++i) *(LAS bf16_t*)(lds + SA_QI + ((i + 4 * g) * 8 + wave) * SA_QI_PITCH + (32 * nt + r32) * 2) = (bf16_t)f2bf(acc[i]);
      } }
    __syncthreads();
    if (is_cmp) {
#pragma unroll
        for (int ks = 0; ks < 8; ++ks) qf[ks] = *(const LAS bf16x8*)(lds + SA_QI + (32 * qt + r32) * SA_QI_PITCH + (16 * ks + 8 * g) * 2);
#pragma unroll
        for (int ks = 0; ks < 8; ++ks) asm volatile("" : "+v"(qf[ks]));
    } else { SA_LOAD(sB, 1); SA_WRITE(sA, 0); }
    __syncthreads();

#define SA_COMPUTE(j, bufo) do { \
        const LAS unsigned char* kb_ = lds + (bufo); \
        f32x16 S0; \
        _Pragma("unroll") for (int i = 0; i < 16; ++i) S0[i] = 0.f; \
        int r32v = r32; asm volatile("" : "+v"(r32v)); \
        const int x_ = ((r32v & 3) << 2) | ((r32v >> 2) & 3); \
        const int krow = 256 * (r32v + 32 * kb) + 16 * ((g ^ x_) & 1), krope = SA_KR + (r32v + 32 * kb) * 144 + g * 16; \
        const LAS unsigned char* qrl = lds + SA_QR + (32 * qt + r32v) * 144 + g * 16; const LAS unsigned char* qil = lds + SA_QI + (32 * qt + r32v) * SA_QI_PITCH + g * 16; \
        _Pragma("unroll") for (int ks = 0; ks < 20; ++ks) { \
            const int o0 = (ks < 16) ? ((ks >> 3) * 16384 + krow + 32 * ((ks & 7) ^ (x_ >> 1))) : (krope + 32 * (ks - 16)); \
            const bf16x8 a0 = *(const LAS bf16x8*)(kb_ + o0); \
            bf16x8 qb_; if (ks < 8) qb_ = qf[ks < 8 ? ks : 0]; else if (ks < 16) qb_ = *(const LAS bf16x8*)(qil + 32 * ks); else qb_ = *(const LAS bf16x8*)(qrl + 32 * (ks - 16)); \
            S0 = __builtin_amdgcn_mfma_f32_32x32x16_bf16(a0, qb_, S0, 0, 0, 0); } \
        if ((j) == 64) { const int tok = (32 * qt + r32) >> 3; asm volatile("" ::: "memory"); \
            _Pragma("unroll") for (int i = 0; i < 16; ++i) { const int key = 32 * kb + crow(i, g); if (key > tok || key >= DS) S0[i] = -1e30f; } } \
        float mx = S0[0]; \
        _Pragma("unroll") for (int i = 1; i < 16; ++i) mx = fmaxf(mx, S0[i]); \
        mx = fmaxf(mx, __shfl_xor(mx, 32)) * CEXP; \
        if (__any(mx > mrun + 11.5f)) { const float mnew = fmaxf(mrun, mx), alpha = __builtin_amdgcn_exp2f(mrun - mnew); mrun = mnew; lrun *= alpha; \
            _Pragma("unroll") for (int vt = 0; vt < 8; ++vt) _Pragma("unroll") for (int i = 0; i < 16; ++i) O[vt][i] *= alpha; } \
        float ps = 0.f; \
        _Pragma("unroll") for (int i = 0; i < 16; ++i) { S0[i] = __builtin_amdgcn_exp2f(S0[i] * CEXP - mrun); ps += S0[i]; } \
        lrun += ps; \
        bf16x8 pf[2]; \
        { float tmp[8]; \
          _Pragma("unroll") for (int s2 = 0; s2 < 2; ++s2) { \
            _Pragma("unroll") for (int i = 0; i < 8; ++i) tmp[i] = S0[8 * s2 + i]; \
            pf[s2] = pack8(tmp); } } \
        int lnv = lane; asm volatile("" : "+v"(lnv)); \
        const int li = lnv & 15, q_ = li >> 2, p_ = li & 3, vsub = (lnv >> 4) & 1, gg = lnv >> 5; \
        _Pragma("unroll") for (int vt = 0; vt < 8; ++vt) { \
            const LAS unsigned char* vb_ = kb_ + (vt >> 2) * 16384 + 8192 * kb; \
            const int c0 = 4 * (vt & 3) + 2 * vsub + (p_ >> 1); \
            const int blo = 256 * (4 * gg + q_) + 16 * (c0 ^ ((q_ << 2) | gg)) + 8 * (p_ & 1); \
            const int bhi = 256 * (4 * gg + q_ + 8) + 16 * (c0 ^ ((q_ << 2) | (gg + 2))) + 8 * (p_ & 1); \
            _Pragma("unroll") for (int s2 = 0; s2 < 2; ++s2) { \
                const s16x4 lo = __builtin_amdgcn_ds_read_tr16_b64_v4i16((LAS s16x4*)(vb_ + blo + 4096 * s2)); \
                const s16x4 hi = __builtin_amdgcn_ds_read_tr16_b64_v4i16((LAS s16x4*)(vb_ + bhi + 4096 * s2)); \
                const bf16x8 af = {lo[0], lo[1], lo[2], lo[3], hi[0], hi[1], hi[2], hi[3]}; \
                O[vt] = __builtin_amdgcn_mfma_f32_32x32x16_bf16(af, pf[s2], O[vt], 0, 0, 0); } } } while (0)
#define SA_LOADER(j, SF, SN, bufn) do { \
        if ((j) + 2 < 64) SA_LOAD(SF, (j) + 2); \
        if ((j) + 1 < 64) SA_WRITE(SN, bufn); \
        else if ((j) + 1 == 64 && half == 1) { \
            const bf16_t* cbn = (const bf16_t*)(ws + WS_CB) + (size_t)(MP + b * DS) * KVR; const bf16_t* krn = (const bf16_t*)(ws + WS_KRBS) + (size_t)(b * DS) * ROPE; \
            int lz_ = tid - 256; asm volatile("" : "+v"(lz_)); \
            _Pragma("unroll") for (int e = 0; e < 8; ++e) { const int key = (lz_ + 256 * e) >> 5; u32x4 z = {0u, 0u, 0u, 0u}; if (key < DS) z = *(const u32x4*)(cbn + SA_GL(e)); *(LAS u32x4*)(lds + (bufn) + SA_LL(e)) = z; } \
            _Pragma("unroll") for (int e = 0; e < 2; ++e) { const int key = (lz_ + 256 * e) >> 3; u32x4 z = {0u, 0u, 0u, 0u}; if (key < DS) z = *(const u32x4*)(krn + SA_GR(e)); *(LAS u32x4*)(lds + (bufn) + SA_LR(e)) = z; } } } while (0)
#define SA_BAR() do { asm volatile("s_waitcnt lgkmcnt(0)" ::: "memory"); __builtin_amdgcn_s_barrier(); asm volatile("" ::: "memory"); } while (0)
    float* ml = (float*)(ws + WS_ML) + (size_t)(b * 2 + half) * 64 * 2;
    if (is_cmp) {
        f32x16 O[8];
#pragma unroll
        for (int vt = 0; vt < 8; ++vt)
#pragma unroll
            for (int i = 0; i < 16; ++i) O[vt][i] = 0.f;
        float mrun = -1e30f, lrun = 0.f;
        int bo = 0;
        for (int j = 0; j < 64; ++j) {
            SA_COMPUTE(j, bo);
            bo = SA_BUF - bo;
            SA_BAR();
        }
        if (half == 1) { SA_COMPUTE(64, bo); SA_BAR(); }
        LAS float* xo = (LAS float*)(lds + qt * 32768); LAS float* xm = (LAS float*)(lds + 65536 + qt * 512);
        if (kb == 1) { xm[2 * lane] = mrun; xm[2 * lane + 1] = lrun;
#pragma unroll
            for (int vt = 0; vt < 8; ++vt)
#pragma unroll
                for (int i = 0; i < 16; ++i) xo[(vt * 16 + i) * 64 + lane] = O[vt][i]; }
        SA_BAR();
        if (kb == 0) {
            const float m1 = xm[2 * lane], l1 = xm[2 * lane + 1], mm = fmaxf(mrun, m1);
            const float a0 = __builtin_amdgcn_exp2f(mrun - mm), a1 = __builtin_amdgcn_exp2f(m1 - mm);
            const float ll = lrun * a0 + l1 * a1, lt = ll + __shfl_xor(ll, 32);
            const int q = 32 * qt + r32;
            if (g == 0) { ml[q * 2] = mm; ml[q * 2 + 1] = lt; }
#pragma unroll
            for (int vt = 0; vt < 8; ++vt) {
                float o[16];
#pragma unroll
                for (int i = 0; i < 16; ++i) o[i] = O[vt][i] * a0 + xo[(vt * 16 + i) * 64 + lane] * a1;
#pragma unroll
                for (int jq = 0; jq < 4; ++jq) { u32x2 w; w.x = pk2(o[4 * jq], o[4 * jq + 1]); w.y = pk2(o[4 * jq + 2], o[4 * jq + 3]);
                    *(LAS u32x2*)(lds + SA_OI + q * SA_QI_PITCH + (32 * vt + 8 * jq + 4 * g) * 2) = w; }
            }
        }
    } else {
        for (int j = 0; j < 64; j += 2) {
            SA_LOADER(j, sA, sB, SA_BUF);
            SA_BAR();
            SA_LOADER(j + 1, sB, sA, 0);
            SA_BAR();
        }
        if (half == 1) SA_BAR();
        SA_BAR();
    }
#undef SA_BAR
#undef SA_LOAD
#undef SA_WRITE
#undef SA_COMPUTE
#undef SA_LOADER
#undef SA_GL
#undef SA_LL
#undef SA_GR
#undef SA_LR
    float* parto = (float*)(ws + WS_PART) + (size_t)(b * 2 + half) * 64 * 128;
    __syncthreads();
    { bf16x8 ao[16];
#pragma unroll
      for (int ks = 0; ks < 16; ++ks) { u32x4 z = {0u, 0u, 0u, 0u}; if (r32 < DS) z = *(const LAS u32x4*)(lds + SA_OI + (r32 * 8 + wave) * SA_QI_PITCH + (16 * ks + 8 * g) * 2); ao[ks] = __builtin_bit_cast(bf16x8, z); }
      const bf16_t* wv = (const bf16_t*)(ws + WS_WUVT) + (size_t)(wave * VD + r32) * KVR + 8 * g;
#pragma unroll 2
      for (int nt = 0; nt < 4; ++nt) {
          f32x16 acc;
#pragma unroll
          for (int i = 0; i < 16; ++i) acc[i] = 0.f;
#pragma unroll
          for (int ks = 0; ks < 16; ++ks) acc = __builtin_amdgcn_mfma_f32_32x32x16_bf16(ao[ks], *(const bf16x8*)(wv + (size_t)(32 * nt) * KVR + 16 * ks), acc, 0, 0, 0);
#pragma unroll
          for (int i = 0; i < 4; ++i) parto[(size_t)((i + 4 * g) * 8 + wave) * 128 + 32 * nt + r32] = acc[i];
      } }
}

template <int W>
__device__ __forceinline__ void pool_chunk(const float* __restrict__ xr, int rvb, f32x4 gn, int col, int t0, bf16_t* __restrict__ drow) {
    f32x4 ring[W - 1]; f32x4 sum = {0.f, 0.f, 0.f, 0.f};
#pragma unroll
    for (int i = W - 1; i >= 1; --i) { f32x4 u = {0.f, 0.f, 0.f, 0.f};
        if (t0 - i >= 0) u = *(const f32x4*)(xr - (size_t)i * D + col) * __builtin_bit_cast(float, __builtin_amdgcn_readlane(rvb, 15 - i));
        ring[(W - 1 - i) % (W - 1)] = u; sum += u; }
#pragma unroll
    for (int r = 0; r < 16; ++r) {
        const f32x4 u = *(const f32x4*)(xr + (size_t)r * D + col) * __builtin_bit_cast(float, __builtin_amdgcn_readlane(rvb, 15 + r));
        sum += u;
        const int t = t0 + r; const float icnt = 1.0f / (float)((t + 1) < W ? (t + 1) : W);
        const f32x4 dd = (sum * icnt - u) * gn;
        u32x2 o; o.x = pk2(dd.x, dd.y); o.y = pk2(dd.z, dd.w);
        *(u32x2*)(drow + (size_t)r * D + col) = o;
        sum -= ring[r % (W - 1)]; ring[r % (W - 1)] = u;
    }
}
constexpr int NPH = 17;
__global__ void __launch_bounds__(512, 2) yoco_fwd(Params P) {
    extern __shared__ __attribute__((aligned(16))) unsigned char lds_raw[];
    LAS unsigned char* lds = (LAS unsigned char*)lds_raw;
    volatile LAS unsigned* MISC = (volatile LAS unsigned*)(lds + MISC_OFF);
    const int tid = threadIdx.x, lane = tid & 63, wave = __builtin_amdgcn_readfirstlane(tid >> 6);
    const int G = gridDim.x; const int bx = blockIdx.x; const int vcu = (G % 8 == 0) ? (bx % 8) * (G / 8) + bx / 8 : bx;
    unsigned char* ws = P.ws; float* out = P.out;
    for (int u = tid; u < 64; u += 512) MISC[u] = 0u;
    __syncthreads();
    XcdBarrier bar; bar.bar = (unsigned*)(ws + WS_CTL) + CW_BAR; bar.x = 0; bar.st = nullptr;
    if (MK_N_LAUNCHES == 1) bar = xcd_barrier_post((unsigned*)(ws + WS_CTL) + CW_BAR, MISC + 8);
    const int lo = P.ph_lo, hi = P.ph_hi;
#ifndef PH_MASK
#define PH_MASK 0xFFFFFFFFu
#endif
#define IN(k) (((PH_MASK >> (k)) & 1u) && lo <= (k) && (k) < hi)
#define SEAM(k) do { if (IN(k) && IN((k) + 1)) xcd_barrier(bar); } while (0)
#define SEAM2(k, kn) do { if (IN(k) && IN(kn)) xcd_barrier(bar); } while (0)
    const int gw = vcu * 8 + wave, NGW = G * 8;
    const int gtid = vcu * 512 + tid, NGT = G * 512;

#define wpool ((bf16_t*)(ws + WS_WPOOL))
#define wup ((bf16_t*)(ws + WS_WUP))
#define wdown ((bf16_t*)(ws + WS_WDOWN))
#define wgate ((bf16_t*)(ws + WS_WGATE))
#define wproj ((bf16_t*)(ws + WS_WPROJ))
#define wdkvq ((bf16_t*)(ws + WS_WDKVQ))
#define wuq ((bf16_t*)(ws + WS_WUQ))
#define wukt ((bf16_t*)(ws + WS_WUKT))
#define wuvt ((bf16_t*)(ws + WS_WUVT))
#define wukb ((bf16_t*)(ws + WS_WUKB))
#define wo ((bf16_t*)(ws + WS_WO))
#define cs ((float*)(ws + WS_CS))
#define rstd0 ((float*)(ws + WS_RSTD0))
#define dbuf ((bf16_t*)(ws + WS_DBUF))
#define pb ((bf16_t*)(ws + WS_PB))
#define hbA ((bf16_t*)(ws + WS_HBA))
#define hbB ((bf16_t*)(ws + WS_HBB))
#define ssq ((float*)(ws + WS_SSQ))
#define abuf ((bf16_t*)(ws + WS_ABUF))
#define proj ((bf16_t*)(ws + WS_PROJ))
#define raw ((float*)(ws + WS_RAW))
#define cb ((bf16_t*)(ws + WS_CB))
#define krbs ((bf16_t*)(ws + WS_KRBS))
#define cqb ((bf16_t*)(ws + WS_CQB))
#define rstdq ((float*)(ws + WS_RSTDQ))
#define qbuf ((bf16_t*)(ws + WS_QBUF))
#define qs ((bf16_t*)(ws + WS_QS))
#define kfull ((bf16_t*)(ws + WS_KFULL))
#define vt ((bf16_t*)(ws + WS_VT))
#define obuf ((bf16_t*)(ws + WS_OBUF))
    constexpr size_t SSQ_V = (size_t)M * 16;

    if (IN(0)) {
        LAS float* scr = (LAS float*)(lds + wave * 16384);
        int it = gw;
#define TI(W_, ks_, K_, N_, WT_, ro_) { const int n_items = ((K_) / 64) * ((N_) / 32); for (; it < n_items; it += NGW) transpose_item(W_, ks_, K_, N_, WT_, ro_, scr, it, lane); it -= n_items; }
        TI(P.in[I_POOLW] + 0 * 65536, nullptr, 256, 256, wpool, 0) TI(P.in[I_POOLW] + 1 * 65536, nullptr, 256, 256, wpool, 256)
        TI(P.in[I_POOLW] + 2 * 65536, nullptr, 256, 256, wpool, 512) TI(P.in[I_POOLW] + 3 * 65536, nullptr, 256, 256, wpool, 768)
        TI(P.in[I_WUP], P.in[I_NMLP], D, FF, wup, 0) TI(P.in[I_WUP] + (size_t)D * FF, P.in[I_NMLP] + D, D, FF, wup + (size_t)FF * D, 0)
        TI(P.in[I_WDOWN], nullptr, FF, D, wdown, 0) TI(P.in[I_WDOWN] + (size_t)D * FF, nullptr, FF, D, wdown + (size_t)FF * D, 0)
        TI(P.in[I_WGATE], P.in[I_NPLE], D, D, wgate, 0) TI(P.in[I_WGATE] + (size_t)D * D, P.in[I_NPLE] + D, D, D, wgate + (size_t)D * D, 0)
        TI(P.in[I_WPROJ], nullptr, PLE, D, wproj, 0) TI(P.in[I_WPROJ] + (size_t)PLE * D, nullptr, PLE, D, wproj + (size_t)PLE * D, 0)
        TI(P.in[I_WDKV], P.in[I_NKV], D, 320, wdkvq, 0) TI(P.in[I_WDQ], P.in[I_NMIX] + D, D, QR, wdkvq, 320)
        { const int n_items = (QR / 64) * (NH * QH / 32); for (; it < n_items; it += NGW) transpose_item<true>(P.in[I_WUQ], P.in[I_QN], QR, NH * QH, wuq, 0, scr, it, lane); it -= n_items; }
        TI(P.in[I_WUK], nullptr, KVR, 1024, wukt, 0) TI(P.in[I_WUV], nullptr, KVR, 1024, wuvt, 0)
        TI(P.in[I_WO], nullptr, D, D, wo, 0)
#undef TI
        for (int i = gtid; i < 64 * D / 8; i += NGT) *(u32x4*)(wdkvq + (size_t)704 * D + (size_t)i * 8) = (u32x4){0u, 0u, 0u, 0u};
        for (int i = gtid; i < 256 * 1024 / 8; i += NGT) { const f32x4 a = *(const f32x4*)(P.in[I_WUK] + (size_t)i * 8), c = *(const f32x4*)(P.in[I_WUK] + (size_t)i * 8 + 4); *(bf16x8*)(wukb + (size_t)i * 8) = pack8v(a, c); }
        for (int i = gtid; i < NPOS * 32; i += NGT) { const int pos = i >> 5, f = i & 31; const double inv = exp2(-(double)f * (13.287712379549449 / 32.0)); const double ang = (double)pos * inv;
            double sn, cn; sincos(ang, &sn, &cn); cs[(size_t)pos * 64 + f] = (float)cn; cs[(size_t)pos * 64 + 32 + f] = (float)sn; }
        for (int i = gtid; i < 2 * M * PLE / 8; i += NGT) { const int li = i / (M * PLE / 8), r8 = i % (M * PLE / 8); const size_t e = (size_t)r8 * 8; const int row = (int)(e / PLE), c = (int)(e % PLE);
            const float* src = row < MP ? P.in[I_PP] + ((size_t)li * MP + row) * PLE + c : P.in[I_PS] + ((size_t)li * MS + (row - MP)) * PLE + c;
            *(bf16x8*)(pb + ((size_t)li * M + row) * PLE + c) = pack8v(*(const f32x4*)src, *(const f32x4*)(src + 4)); }
        for (int row0 = gw; row0 < M; row0 += 2 * NGW) {
            f32x4 v[2][4];
#pragma unroll
            for (int rr = 0; rr < 2; ++rr) { const int row = row0 + rr * NGW; if (row < M) { const float* xr = row < MP ? P.in[I_XP] + (size_t)row * D : P.in[I_XS] + (size_t)(row - MP) * D;
#pragma unroll
                for (int j = 0; j < 4; ++j) v[rr][j] = ((const f32x4*)xr)[lane + 64 * j]; } }
#pragma unroll
            for (int rr = 0; rr < 2; ++rr) { const int row = row0 + rr * NGW; if (row < M) {
                float s = 0.f;
#pragma unroll
                for (int j = 0; j < 4; ++j) s += (v[rr][j].x * v[rr][j].x + v[rr][j].y * v[rr][j].y) + (v[rr][j].z * v[rr][j].z + v[rr][j].w * v[rr][j].w);
                const float rstd = 1.0f / sqrtf(wave_sum(s) * (1.0f / D) + EPS);
                if (lane == 0) rstd0[row] = rstd;
                float* po = nullptr;
                if (row < MP) { const int b = row >> 13, t = row & (SEQ - 1); if (t >= SEQ - 15) po = out + O_PP + ((size_t)b * 15 + (t - (SEQ - 15))) * D; }
                else { const int rs_ = row - MP, b = rs_ >> 3, t = rs_ & 7; po = out + O_PS + ((size_t)b * 15 + 7 + t) * D; }
                if (po) {
#pragma unroll
                    for (int j = 0; j < 4; ++j) { const f32x4 gn = ((const f32x4*)P.in[I_NMIX])[lane + 64 * j]; ((f32x4*)po)[lane + 64 * j] = v[rr][j] * rstd * gn; } }
            } }
        }
        for (int i = gtid; i < DB * 7 * D / 4; i += NGT) { const int b = i / (7 * D / 4), r = (i / (D / 4)) % 7, c = i % (D / 4);
            ((f32x4*)(out + O_PS + ((size_t)b * 15 + r) * D))[c] = ((const f32x4*)(P.in[I_SPOOL] + ((size_t)b * 15 + 8 + r) * D))[c]; }
    }
    SEAM(0);
    if (IN(1)) {
        for (int it = gw; it < (MP / 16) * 2; it += NGW) {
            const int chunk = it >> 1, hs = it & 1, row0 = chunk * 16, t0 = row0 & (SEQ - 1);
            const float rv = (lane < 31 && t0 - 15 + lane >= 0) ? rstd0[row0 - 15 + lane] : 0.f;
            const int rvb = __builtin_bit_cast(int, rv);
            const float* xr = P.in[I_XP] + (size_t)row0 * D; bf16_t* dr = dbuf + (size_t)row0 * D;
            if (hs == 0) { pool_chunk<2>(xr, rvb, *(const f32x4*)(P.in[I_NMIX] + 4 * lane), 4 * lane, t0, dr);
                           pool_chunk<16>(xr, rvb, *(const f32x4*)(P.in[I_NMIX] + 768 + 4 * lane), 768 + 4 * lane, t0, dr); }
            else         { pool_chunk<4>(xr, rvb, *(const f32x4*)(P.in[I_NMIX] + 256 + 4 * lane), 256 + 4 * lane, t0, dr);
                           pool_chunk<8>(xr, rvb, *(const f32x4*)(P.in[I_NMIX] + 512 + 4 * lane), 512 + 4 * lane, t0, dr); }
        }
        for (int row = MP + gw; row < M; row += NGW) {
            const bool isp = row < MP; const int t = isp ? (row & (SEQ - 1)) : ((row - MP) & 7); const int bs = isp ? 0 : ((row - MP) >> 3);
            const float* sp = P.in[I_SPOOL] + (size_t)bs * 15 * D;
            const float* xr = isp ? P.in[I_XP] + (size_t)row * D : P.in[I_XS] + (size_t)(row - MP) * D;
            const float rv = (lane < 16 && t - lane >= 0) ? rstd0[row - lane] : 0.f;
#pragma unroll
            for (int j = 0; j < 4; ++j) {
                const int w = 2 << j; const int col = 256 * j + 4 * lane;
                const f32x4 gn = *(const f32x4*)(P.in[I_NMIX] + col);
                const f32x4 u0 = *(const f32x4*)(xr + col) * __shfl(rv, 0); f32x4 sum = u0, hist = {0.f, 0.f, 0.f, 0.f};
#pragma unroll
                for (int i = 1; i < w; ++i) { const int tt = t - i; const float ri = __shfl(rv, i);
                    if (tt >= 0) sum += *(const f32x4*)(xr - (size_t)i * D + col) * ri;
                    else if (!isp) hist += *(const f32x4*)(sp + (size_t)(15 + tt) * D + col); }
                const float cnt = isp ? (float)((t + 1) < w ? (t + 1) : w) : (float)w;
                const f32x4 dd = (sum * gn + hist) / cnt - u0 * gn;
                u32x2 o; o.x = pk2(dd.x, dd.y); o.y = pk2(dd.z, dd.w);
                *(u32x2*)(dbuf + (size_t)row * D + col) = o;
            }
        }
    }
    SEAM(1);
    if (IN(2)) {
#ifndef SUBM
#define SUBM 7
#endif
        { SgH<0> E{P.in[I_XS], P.in[I_POOLSC], nullptr, nullptr, nullptr, hbA, ssq + 0 * SSQ_V};
          for (int u = vcu; u < 256; u += G) sg_gemm<4, 1>(lds, dbuf + (size_t)MP * D, D, 256, wpool, 256, u, E, tid, wave, lane); }
        { SgBf E{proj, D};
          for (int u = vcu; u < 256; u += G) sg_gemm<4, 1>(lds, pb + (size_t)MP * PLE, PLE, 0, wproj, PLE, u, E, tid, wave, lane); }
        { SgBf E{proj + (size_t)M * D, D};
          for (int u = vcu; u < 256; u += G) sg_gemm<4, 1>(lds, pb + (size_t)(M + MP) * PLE, PLE, 0, wproj + (size_t)PLE * D, PLE, u, E, tid, wave, lane); }
        if (SUBM & 1) { pg8::Gemm g{dbuf, wpool, MP, D, 256, D, 256}; pg8::StaticOrder S; S.init(MP, D, G, bx);
          EpiH<0> E{P.in[I_XP], P.in[I_XS], P.in[I_POOLSC], nullptr, nullptr, nullptr, hbA, ssq + 0 * SSQ_V};
          pg8::gemm_phase(lds, g, S, E); }
        if (SUBM & 2) { pg8::Gemm g{pb, wproj, MP, D, PLE, PLE, 0}; pg8::StaticOrder S; S.init(MP, D, G, bx);
          EpiBf E{proj, D};
          pg8::gemm_phase(lds, g, S, E); }
        if (SUBM & 4) { pg8::Gemm g{pb + (size_t)M * PLE, wproj + (size_t)PLE * D, MP, D, PLE, PLE, 0}; pg8::StaticOrder S; S.init(MP, D, G, bx);
          EpiBf E{proj + (size_t)M * D, D};
          pg8::gemm_phase(lds, g, S, E); }
    }
    SEAM(2);
    if (IN(3)) {
        { SgUp E{ssq + 0 * SSQ_V, abuf}; for (int u = vcu; u < 256; u += G) sg_gemm<4, 4>(lds, hbA + (size_t)MP * D, D, 0, wup, D, u, E, tid, wave, lane); }
        pg8::Gemm g{hbA, wup, MP, FF, D, D, 0}; pg8::StaticOrder S; S.init(MP, FF, G, bx); EpiUp E{ssq + 0 * SSQ_V, abuf}; pg8::gemm_phase(lds, g, S, E); }
    SEAM(3);
    if (IN(4)) {
        { SgH<1> E{nullptr, nullptr, nullptr, nullptr, hbA, hbB, ssq + 1 * SSQ_V}; for (int u = vcu; u < 256; u += G) sg_gemm<4, 1>(lds, abuf + (size_t)MP * FF, FF, 0, wdown, FF, u, E, tid, wave, lane); }
        pg8::Gemm g{abuf, wdown, MP, D, FF, FF, 0}; pg8::StaticOrder S; S.init(MP, D, G, bx);
        EpiH<1> E{nullptr, nullptr, nullptr, nullptr, nullptr, hbA, hbB, ssq + 1 * SSQ_V}; pg8::gemm_phase(lds, g, S, E); }
    SEAM(4);
    if (IN(5)) {
        { SgH<2> E{nullptr, nullptr, ssq + 1 * SSQ_V, proj, hbB, hbA, ssq + 2 * SSQ_V}; for (int u = vcu; u < 256; u += G) sg_gemm<4, 1>(lds, hbB + (size_t)MP * D, D, 0, wgate, D, u, E, tid, wave, lane); }
        pg8::Gemm g{hbB, wgate, MP, D, D, D, 0}; pg8::StaticOrder S; S.init(MP, D, G, bx);
        EpiH<2> E{nullptr, nullptr, nullptr, ssq + 1 * SSQ_V, proj, hbB, hbA, ssq + 2 * SSQ_V}; pg8::gemm_phase(lds, g, S, E); }
    SEAM(5);
    if (IN(6)) {
        { SgF32<1> E{raw, NDKVQ, ssq + 2 * SSQ_V}; for (int u = vcu; u < 256; u += G) sg_gemm<3, 1>(lds, hbA + (size_t)MP * D, D, 0, wdkvq, D, u, E, tid, wave, lane); }
        pg8::Gemm g{hbA, wdkvq, MP, NDKVQ, D, D, 0}; pg8::StaticOrder S; S.init(MP, NDKVQ, G, bx); EpiF32<1> E{raw, NDKVQ, ssq + 2 * SSQ_V}; pg8::gemm_phase(lds, g, S, E); }
    SEAM(6);
    if (IN(7)) {
        const f32x4 kvn = ((const f32x4*)P.in[I_KVN])[lane];
        for (int row0 = 2 * gw; row0 < M; row0 += 2 * NGW) {
            f32x4 c4[2], k1[2], k2[2], cn_[2], sn_[2]; f32x2 q2[2][3];
            const int l8 = lane & 7, hh = lane >> 3;
#pragma unroll
            for (int e = 0; e < 2; ++e) { const int row = row0 + e; const float* rr = raw + (size_t)row * NDKVQ;
                const int pos = row < MP ? (row & (SEQ - 1)) : PAST + ((row - MP) & 7);
                c4[e] = ((const f32x4*)rr)[lane];
                k1[e] = *(const f32x4*)(rr + 256 + 4 * l8); k2[e] = *(const f32x4*)(rr + 288 + 4 * l8);
                cn_[e] = *(const f32x4*)(cs + (size_t)pos * 64 + 4 * l8); sn_[e] = *(const f32x4*)(cs + (size_t)pos * 64 + 32 + 4 * l8);
#pragma unroll
                for (int k = 0; k < 3; ++k) q2[e][k] = *(const f32x2*)(rr + 320 + 2 * lane + 128 * k); }
#pragma unroll
            for (int e = 0; e < 2; ++e) { const int row = row0 + e; const bool isp = row < MP;
                const float sc = wave_sum((c4[e].x * c4[e].x + c4[e].y * c4[e].y) + (c4[e].z * c4[e].z + c4[e].w * c4[e].w));
                const float rc = 1.0f / sqrtf(sc * (1.0f / KVR) + EPS);
                const f32x4 cn = c4[e] * rc * kvn;
                float* lo_ = isp ? out + O_LP + (size_t)row * KVR : out + O_LS + (size_t)(row - MP) * KVR;
                ((f32x4*)lo_)[lane] = cn;
                { u32x2 o; o.x = pk2(cn.x, cn.y); o.y = pk2(cn.z, cn.w); ((u32x2*)(cb + (size_t)row * KVR))[lane] = o; }
                const f32x4 o1 = k1[e] * cn_[e] - k2[e] * sn_[e], o2 = k2[e] * cn_[e] + k1[e] * sn_[e];
                u32x2 w1, w2; w1.x = pk2(o1.x, o1.y); w1.y = pk2(o1.z, o1.w); w2.x = pk2(o2.x, o2.y); w2.y = pk2(o2.z, o2.w);
                if (hh == 0) { float* ko = isp ? out + O_KP + (size_t)row * ROPE : out + O_KS + (size_t)(row - MP) * ROPE; *(f32x4*)(ko + 4 * l8) = o1; *(f32x4*)(ko + 32 + 4 * l8) = o2;
                    if (!isp) { bf16_t* kd = krbs + (size_t)(row - MP) * ROPE; *(u32x2*)(kd + 4 * l8) = w1; *(u32x2*)(kd + 32 + 4 * l8) = w2; } }
                if (isp) { const int b = row >> 13, t = row & (SEQ - 1); bf16_t* kd = kfull + ((size_t)(b * NH + hh) * SEQ + t) * QH + NOPE; *(u32x2*)(kd + 4 * l8) = w1; *(u32x2*)(kd + 32 + 4 * l8) = w2; }
                float s = 0.f;
#pragma unroll
                for (int k = 0; k < 3; ++k) s += q2[e][k].x * q2[e][k].x + q2[e][k].y * q2[e][k].y;
                s = wave_sum(s);
                if (lane == 0) rstdq[row] = 1.0f / sqrtf(s * (1.0f / QR) + EPS);
#pragma unroll
                for (int k = 0; k < 3; ++k) *(unsigned*)(cqb + (size_t)row * QR + 2 * lane + 128 * k) = pk2(q2[e][k].x, q2[e][k].y); }
        }
    }
    SEAM(7);
    if (IN(8)) {
        { SgQ E{rstdq, cs, qbuf, qs}; for (int u = vcu; u < 256; u += G) sg_gemm<3, 2>(lds, cqb + (size_t)MP * QR, QR, 0, wuq, QR, u, E, tid, wave, lane); }
        if (SUBM & 1) { pg8::Gemm g{cqb, wuq, MP, NH * QH, QR, QR, 0}; pg8::StaticOrder S; S.init(MP, NH * QH, G, bx); EpiQ E{rstdq, cs, qbuf}; pg8::gemm_phase(lds, g, S, E); }
        if (SUBM & 2) { pg8::Gemm g{cb, wukt, MP, 1024, KVR, KVR, 0}; pg8::StaticOrder S; S.init(MP, 1024, G, (bx + 128) % G); EpiKup E{kfull}; pg8::gemm_phase(lds, g, S, E); }
        if (SUBM & 4) { pg8::Gemm g{wuvt, cb, 1024, MP, KVR, KVR, 0}; pg8::StaticOrder S; S.init(1024, MP, G, (bx + 128) % G); EpiVup E{vt}; pg8::gemm_phase(lds, g, S, E); }
    }
    SEAM2(8, 10);
    if (IN(10)) {
        const bool sfirst = (bx >> 3) & 1;
        if (sfirst) for (int it = vcu; it < 2 * DB; it += G) sattn_item(P, it >> 1, it & 1, lds, tid, wave, lane);
        for (int u = vcu; u < 256; u += G) {
            const int bh = u >> 4, p = u & 15;
            attn_prompt_unit(qbuf, kfull, vt, obuf, bh >> 3, bh & 7, 31 - p, lds, tid, wave, lane);
            attn_prompt_unit(qbuf, kfull, vt, obuf, bh >> 3, bh & 7, p, lds, tid, wave, lane);
        }
        if (!sfirst) for (int it = vcu; it < 2 * DB; it += G) sattn_item(P, it >> 1, it & 1, lds, tid, wave, lane);
    }
    SEAM2(10, 12);
    if (IN(12)) {
        { SgH<1> E{nullptr, nullptr, nullptr, nullptr, hbA, hbB, ssq + 3 * SSQ_V}; const SgALoadComb AL{(const float*)(ws + WS_PART), (const float*)(ws + WS_ML)};
          for (int u = vcu; u < 256; u += G) sg_gemm_l<4, 1>(lds, AL, 0, wo, D, u, E, tid, wave, lane); }
        pg8::Gemm g{obuf, wo, MP, D, D, D, 0}; pg8::StaticOrder S; S.init(MP, D, G, bx);
        EpiH<1> E{nullptr, nullptr, nullptr, nullptr, nullptr, hbA, hbB, ssq + 3 * SSQ_V}; pg8::gemm_phase(lds, g, S, E); }
    SEAM(12);
    if (IN(13)) {
        { SgUp E{ssq + 3 * SSQ_V, abuf}; for (int u = vcu; u < 256; u += G) sg_gemm<4, 4>(lds, hbB + (size_t)MP * D, D, 0, wup + (size_t)FF * D, D, u, E, tid, wave, lane); }
        pg8::Gemm g{hbB, wup + (size_t)FF * D, MP, FF, D, D, 0}; pg8::StaticOrder S; S.init(MP, FF, G, bx); EpiUp E{ssq + 3 * SSQ_V, abuf}; pg8::gemm_phase(lds, g, S, E); }
    SEAM(13);
    if (IN(14)) {
        { SgH<1> E{nullptr, nullptr, nullptr, nullptr, hbB, hbA, ssq + 4 * SSQ_V}; for (int u = vcu; u < 256; u += G) sg_gemm<4, 1>(lds, abuf + (size_t)MP * FF, FF, 0, wdown + (size_t)FF * D, FF, u, E, tid, wave, lane); }
        pg8::Gemm g{abuf, wdown + (size_t)FF * D, MP, D, FF, FF, 0}; pg8::StaticOrder S; S.init(MP, D, G, bx);
        EpiH<1> E{nullptr, nullptr, nullptr, nullptr, nullptr, hbB, hbA, ssq + 4 * SSQ_V}; pg8::gemm_phase(lds, g, S, E); }
    SEAM(14);
    if (IN(15)) {
        { SgH<2> E{nullptr, nullptr, ssq + 4 * SSQ_V, proj + (size_t)M * D, hbA, hbB, ssq + 5 * SSQ_V}; for (int u = vcu; u < 256; u += G) sg_gemm<4, 1>(lds, hbA + (size_t)MP * D, D, 0, wgate + (size_t)D * D, D, u, E, tid, wave, lane); }
        pg8::Gemm g{hbA, wgate + (size_t)D * D, MP, D, D, D, 0}; pg8::StaticOrder S; S.init(MP, D, G, bx);
        EpiH<2> E{nullptr, nullptr, nullptr, ssq + 4 * SSQ_V, proj + (size_t)M * D, hbA, hbB, ssq + 5 * SSQ_V}; pg8::gemm_phase(lds, g, S, E); }
    SEAM(15);
    if (IN(16)) {
        f32x4 gn[4];
#pragma unroll
        for (int j = 0; j < 4; ++j) gn[j] = ((const f32x4*)P.in[I_NFIN])[lane + 64 * j];
        for (int row0 = 4 * gw; row0 < M; row0 += 4 * NGW) {
            u32x2 hv[4][4]; float sp[4];
#pragma unroll
            for (int e = 0; e < 4; ++e) { sp[e] = (lane < 16) ? ssq[5 * SSQ_V + (size_t)(row0 + e) * 16 + lane] : 0.f;
#pragma unroll
                for (int j = 0; j < 4; ++j) hv[e][j] = ((const u32x2*)(hbB + (size_t)(row0 + e) * D))[lane + 64 * j]; }
#pragma unroll
            for (int e = 0; e < 4; ++e) { const float rstd = 1.0f / sqrtf(wave_sum(sp[e]) * (1.0f / D) + EPS);
#pragma unroll
                for (int j = 0; j < 4; ++j) ((f32x4*)(out + O_Y + (size_t)(row0 + e) * D))[lane + 64 * j] = unpk4(hv[e][j]) * rstd * gn[j]; }
        }
    }
#undef IN
#undef SEAM
#undef SEAM2
#undef wpool
#undef wup
#undef wdown
#undef wgate
#undef wproj
#undef wdkvq
#undef wuq
#undef wukt
#undef wuvt
#undef wukb
#undef wo
#undef cs
#undef rstd0
#undef dbuf
#undef pb
#undef hbA
#undef hbB
#undef ssq
#undef abuf
#undef proj
#undef raw
#undef cb
#undef krbs
#undef cqb
#undef rstdq
#undef qbuf
#undef qs
#undef kfull
#undef vt
#undef obuf
}

extern "C" void kernel_launch(void* const* d_in, const int* in_sizes, int n_in, void* d_out, int out_size, void* d_ws, size_t ws_size, hipStream_t stream) {
    static int grid = 0;
    if (grid == 0) {
        if (n_in != 27 || (size_t)out_size != O_END || ws_size < WS_END) { fprintf(stderr, "kernel_launch: shape mismatch (n_in %d, out %d, ws %zu; need 27, %zu, %zu)\n", n_in, out_size, ws_size, (size_t)O_END, (size_t)WS_END); grid = -1; return; }
        int dev = 0, cus = 0, per_cu = 0;
        if (hipGetDevice(&dev) != hipSuccess || hipDeviceGetAttribute(&cus, hipDeviceAttributeMultiprocessorCount, dev) != hipSuccess) { grid = -1; return; }
        if (hipFuncSetAttribute((const void*)yoco_fwd, hipFuncAttributeMaxDynamicSharedMemorySize, LDS_BYTES) != hipSuccess) { fprintf(stderr, "kernel_launch: hipFuncSetAttribute failed\n"); grid = -1; return; }
        if (hipOccupancyMaxActiveBlocksPerMultiprocessor(&per_cu, (const void*)yoco_fwd, 512, LDS_BYTES) != hipSuccess || per_cu < 1) fprintf(stderr, "kernel_launch: occupancy query reports %d\n", per_cu);
        (void)hipGetLastError();
        grid = cus;
    }
    if (grid < 0) return;
    (void)hipMemsetAsync((char*)d_ws + WS_CTL, 0, CTL_BYTES, stream);
    Params p{};
    for (int i = 0; i < 27; ++i) p.in[i] = (const float*)d_in[i];
    p.out = (float*)d_out; p.ws = (unsigned char*)d_ws;
#if MK_N_LAUNCHES == 1
    p.ph_lo = 0; p.ph_hi = NPH;
    hipLaunchKernelGGL(yoco_fwd, dim3(grid), dim3(512), LDS_BYTES, stream, p);
#else
    for (int k = 0; k < NPH; ++k) { p.ph_lo = k; p.ph_hi = k + 1; hipLaunchKernelGGL(yoco_fwd, dim3(grid), dim3(512), LDS_BYTES, stream, p); }
#endif
    const hipError_t le = hipPeekAtLastError();
    if (le != hipSuccess) fprintf(stderr, "kernel_launch: launch failed: %s\n", hipGetErrorName(le));
}
```

```cpp
#include <hip/hip_runtime.h>
#include <cstdio>
#include <cstdint>

#ifndef MK_N_LAUNCHES
#define MK_N_LAUNCHES 1
#endif

#define GAS __attribute__((address_space(1)))
#define LAS __attribute__((address_space(3)))
typedef unsigned short bf16_t;
typedef short bf16x8 __attribute__((ext_vector_type(8)));
typedef float f32x4 __attribute__((ext_vector_type(4)));
typedef float f32x16 __attribute__((ext_vector_type(16)));
typedef unsigned u32x2 __attribute__((ext_vector_type(2)));
typedef unsigned u32x4 __attribute__((ext_vector_type(4)));

constexpr int D = 1024, FF = 4096, PLE = 256, SEQ = 8192, NBATCH = 2, DB = 128, DS = 8;
constexpr int MP = NBATCH * SEQ;
constexpr int MS = DB * DS;
constexpr int M = MP + MS;
constexpr int KVR = 256, ROPE = 64, QR = 384, NH = 8, NOPE = 128, VD = 128, QH = NOPE + ROPE;
constexpr int NDKVQ = 768;
constexpr int PAST = 8192, PAGE = 128, NPG = PAST / PAGE;
constexpr float EPS = 1e-6f;
constexpr float SM_SCALE = 0.07216878364870322f;
constexpr float LOG2E = 1.4426950408889634f;
constexpr float CEXP = SM_SCALE * LOG2E;
constexpr int NPOS = PAST + DS;

constexpr size_t O_Y = 0;
constexpr size_t O_PP = (size_t)M * D;
constexpr size_t O_PS = O_PP + (size_t)NBATCH * 15 * D;
constexpr size_t O_LP = O_PS + (size_t)DB * 15 * D;
constexpr size_t O_KP = O_LP + (size_t)MP * KVR;
constexpr size_t O_LS = O_KP + (size_t)MP * ROPE;
constexpr size_t O_KS = O_LS + (size_t)MS * KVR;
constexpr size_t O_END = O_KS + (size_t)MS * ROPE;

constexpr size_t al256(size_t x) { return (x + 255) / 256 * 256; }
constexpr size_t WS_CTL = 0, CTL_BYTES = 1u << 20;
constexpr size_t WS_WPOOL = CTL_BYTES;
constexpr size_t WS_WUP   = WS_WPOOL + al256((size_t)1024 * 256 * 2);
constexpr size_t WS_WDOWN = WS_WUP   + al256((size_t)2 * FF * D * 2);
constexpr size_t WS_WGATE = WS_WDOWN + al256((size_t)2 * FF * D * 2);
constexpr size_t WS_WPROJ = WS_WGATE + al256((size_t)2 * D * D * 2);
constexpr size_t WS_WDKVQ = WS_WPROJ + al256((size_t)2 * D * PLE * 2);
constexpr size_t WS_WUQ   = WS_WDKVQ + al256((size_t)NDKVQ * D * 2);
constexpr size_t WS_WUKT  = WS_WUQ   + al256((size_t)NH * QH * QR * 2);
constexpr size_t WS_WUVT  = WS_WUKT  + al256((size_t)1024 * 256 * 2);
constexpr size_t WS_WUKB  = WS_WUVT  + al256((size_t)1024 * 256 * 2);
constexpr size_t WS_WO    = WS_WUKB  + al256((size_t)1024 * 256 * 2);
constexpr size_t WS_CS    = WS_WO    + al256((size_t)D * D * 2);
constexpr size_t WS_RSTD0 = WS_CS    + al256((size_t)NPOS * 64 * 4);
constexpr size_t WS_DBUF  = WS_RSTD0 + al256((size_t)M * 4);
constexpr size_t WS_PB    = WS_DBUF  + al256((size_t)M * D * 2);
constexpr size_t WS_HBA   = WS_PB    + al256((size_t)2 * M * PLE * 2);
constexpr size_t WS_HBB   = WS_HBA   + al256((size_t)M * D * 2);
constexpr size_t WS_SSQ   = WS_HBB   + al256((size_t)M * D * 2);
constexpr size_t WS_ABUF  = WS_SSQ   + al256((size_t)6 * M * 16 * 4);
constexpr size_t WS_PROJ  = WS_ABUF  + al256((size_t)M * FF * 2);
constexpr size_t WS_RAW   = WS_PROJ  + al256((size_t)2 * M * D * 2);
constexpr size_t WS_CB    = WS_RAW   + al256((size_t)M * NDKVQ * 4);
constexpr size_t WS_KRBS  = WS_CB    + al256((size_t)M * KVR * 2);
constexpr size_t WS_CQB   = WS_KRBS  + al256((size_t)MS * ROPE * 2);
constexpr size_t WS_RSTDQ = WS_CQB   + al256((size_t)M * QR * 2);
constexpr size_t WS_QBUF  = WS_RSTDQ + al256((size_t)M * 4);
constexpr size_t WS_QS    = WS_QBUF  + al256((size_t)M * NH * QH * 2);
constexpr size_t WS_KFULL = WS_QS    + al256((size_t)MS * NH * 320 * 2);
constexpr size_t WS_VT    = WS_KFULL + al256((size_t)16 * SEQ * QH * 2);
constexpr size_t WS_OBUF  = WS_VT    + al256((size_t)16 * VD * SEQ * 2);
constexpr size_t WS_PART  = WS_OBUF  + al256((size_t)M * D * 2);
constexpr size_t WS_ML    = WS_PART  + al256((size_t)DB * 8 * 64 * 256 * 4);
constexpr size_t WS_END   = WS_ML    + al256((size_t)DB * 8 * 64 * 2 * 4);

constexpr int CW_BAR = 4096;

constexpr int RING_BYTES = 131072;
constexpr int LDS_BYTES = 147456;
constexpr int MISC_OFF = LDS_BYTES - 256;

typedef float f32x2 __attribute__((ext_vector_type(2)));
typedef __bf16 nbf16x2 __attribute__((ext_vector_type(2)));
__device__ __forceinline__ unsigned pk2(float lo, float hi) { const f32x2 v = {lo, hi}; return __builtin_bit_cast(unsigned, __builtin_convertvector(v, nbf16x2)); }
__device__ __forceinline__ unsigned f2bf(float f) { return pk2(f, 0.f) & 0xffffu; }
__device__ __forceinline__ float bf2f(unsigned short b) { return __builtin_bit_cast(float, ((unsigned)b) << 16); }
__device__ __forceinline__ f32x4 unpk4(u32x2 w) { f32x4 r; r.x = __builtin_bit_cast(float, w.x << 16); r.y = __builtin_bit_cast(float, w.x & 0xffff0000u); r.z = __builtin_bit_cast(float, w.y << 16); r.w = __builtin_bit_cast(float, w.y & 0xffff0000u); return r; }
__device__ __forceinline__ bf16x8 pack8(const float* v) { u32x4 w; w.x = pk2(v[0], v[1]); w.y = pk2(v[2], v[3]); w.z = pk2(v[4], v[5]); w.w = pk2(v[6], v[7]); return __builtin_bit_cast(bf16x8, w); }
__device__ __forceinline__ bf16x8 pack8v(f32x4 a, f32x4 b) { u32x4 w; w.x = pk2(a.x, a.y); w.y = pk2(a.z, a.w); w.z = pk2(b.x, b.y); w.w = pk2(b.z, b.w); return __builtin_bit_cast(bf16x8, w); }
__device__ __forceinline__ float wave_sum(float v) {
#pragma unroll
    for (int o = 1; o < 64; o <<= 1) v += __shfl_xor(v, o);
    return v;
}
__device__ __forceinline__ int crow(int r, int hi) { return (r & 3) + 8 * (r >> 2) + 4 * hi; }
#define LDS_WAIT() asm volatile("s_waitcnt lgkmcnt(0)" ::: "memory")
#define VM_WAIT() asm volatile("s_waitcnt vmcnt(0)" ::: "memory")

#define XB_TMO      128
#define XB_XCNT(j)  (256  + 64 * (j))
#define XB_XSUB(j)  (1280 + 64 * (j))
#define XB_XGEN(j)  (2304 + 64 * (j))
#define XB_TOP      3328
#define XB_TOPGEN   3392
#define XCD_BAR_WORDS 3456
#define XB_SPIN_CAP (1u << 18)
__device__ __forceinline__ unsigned xb_ld(unsigned* p)              { return __hip_atomic_load(p, __ATOMIC_RELAXED, __HIP_MEMORY_SCOPE_AGENT); }
__device__ __forceinline__ unsigned xb_add(unsigned* p, unsigned v) { return __hip_atomic_fetch_add(p, v, __ATOMIC_RELAXED, __HIP_MEMORY_SCOPE_AGENT); }
__device__ __forceinline__ unsigned xb_xcc_id() { return (unsigned)__builtin_amdgcn_s_getreg((3 << 11) | 20) & 0xFu; }
#define XB_SPIN(cond, bar) do { unsigned _sp = 0; while (cond) { __builtin_amdgcn_s_sleep(1); \
    if ((++_sp & 255u) == 0u) { if (xb_ld(&(bar)[XB_TMO])) break; if (_sp > XB_SPIN_CAP) { atomicAdd(&(bar)[XB_TMO], 1u); break; } } } } while (0)
struct XcdBarrier { unsigned* bar; unsigned x; volatile LAS unsigned* st; };
__device__ __forceinline__ XcdBarrier xcd_barrier_post(unsigned* bar, volatile LAS unsigned* st) {
    XcdBarrier b; b.bar = bar; b.x = xb_xcc_id(); b.st = st;
    if (threadIdx.x == 0) (void)xb_add(&bar[XB_XCNT(b.x)], 1u);
    return b;
}
__device__ __forceinline__ void xcd_barrier_complete(unsigned* bar, unsigned x, unsigned& nloc, unsigned& nx) {
    const unsigned G = gridDim.x * gridDim.y * gridDim.z;
    unsigned sum, cnt, mine, sp = 0u;
    for (;;) {
        sum = 0u; cnt = 0u; mine = 0u;
#pragma unroll
        for (unsigned j = 0; j < 16; ++j) { const unsigned c = xb_ld(&bar[XB_XCNT(j)]); sum += c; cnt += (c > 0u) ? 1u : 0u; mine = (j == x) ? c : mine; }
        if (sum == G) break;
        __builtin_amdgcn_s_sleep(1);
        if ((++sp & 255u) == 0u) { if (xb_ld(&bar[XB_TMO])) break; if (sp > XB_SPIN_CAP) { atomicAdd(&bar[XB_TMO], 1u); break; } }
    }
    nloc = mine > 0u ? mine : 1u; nx = cnt > 0u ? cnt : 1u;
}
__device__ __forceinline__ void xcd_barrier(const XcdBarrier& b) {
    asm volatile("s_waitcnt vmcnt(0)" ::: "memory");
    __syncthreads();
    if (threadIdx.x == 0) {
        unsigned* bar = b.bar;
        __builtin_amdgcn_s_waitcnt(0);
        unsigned nloc = b.st[0], nx = b.st[1];
        if (nloc == 0u) { xcd_barrier_complete(bar, b.x, nloc, nx); b.st[0] = nloc; b.st[1] = nx; }
        const unsigned old = xb_add(&bar[XB_XSUB(b.x)], 1u);
        const unsigned gen = old / nloc;
        if (old + 1u == (gen + 1u) * nloc) {
            __builtin_amdgcn_fence(__ATOMIC_RELEASE, "agent");
            asm volatile("s_waitcnt vmcnt(0)" ::: "memory");
            const unsigned og = xb_add(&bar[XB_TOP], 1u);
            const unsigned tg = og / nx;
            if (og + 1u == (tg + 1u) * nx) xb_add(&bar[XB_TOPGEN], 1u);
            else XB_SPIN(xb_ld(&bar[XB_TOPGEN]) == tg, bar);
            __builtin_amdgcn_fence(__ATOMIC_ACQUIRE, "agent");
            xb_add(&bar[XB_XGEN(b.x)], 1u);
            asm volatile("s_waitcnt vmcnt(0)" ::: "memory");
        } else {
            XB_SPIN(xb_ld(&bar[XB_XGEN(b.x)]) == gen, bar);
            __builtin_amdgcn_fence(__ATOMIC_ACQUIRE, "agent");
            asm volatile("s_waitcnt vmcnt(0)" ::: "memory");
        }
    }
    __syncthreads();
}

namespace pg8 {
constexpr int BM = 256, BK = 64, HALF = 128, HTB = HALF * BK * 2, STAGE_BYTES = 8 * HTB, NXCD = 8, WGM = 8;
__host__ __device__ __forceinline__ int lds_byte(int r, int c) { const int st = (r >> 4) * 2 + (c >> 5), rr = r & 15, cc = c & 31, ob = rr * 64 + cc * 2; return st * 1024 + (ob ^ (((ob >> 9) & 1) << 5)); }
__host__ __device__ __forceinline__ int perm32(int rho) { const int n = rho >> 4, i = rho & 15; return 8 * (i >> 2) + 4 * n + (i & 3); }
__host__ __device__ __forceinline__ void stage_rc(int b, int& R, int& C) { const int st = b / 1024, sb = b % 1024, swz = sb ^ (((sb >> 9) & 1) << 5); R = (st >> 1) * 16 + swz / 64; C = (st & 1) * 32 + (swz % 64) / 2; }
struct Unit { int pm, pn; };
struct Gemm { const bf16_t* A; const bf16_t* Bt; int M, N, K, lda, apn; };
struct StaticOrder {
    int nM, nN, nwg, G, c;
    __device__ void init(int M, int N, int G_, int c_) { nM = M / BM; nN = N / BM; nwg = nM * nN; G = G_; c = c_; }
    __device__ bool next(int i, Unit& u) const {
        const long L = (long)i * G + c; if (L >= nwg) return false;
        int wgid = (int)L; { const int q = nwg / NXCD, r = nwg % NXCD, xcd = wgid % NXCD, off = wgid / NXCD; wgid = (xcd < r ? xcd * (q + 1) : r * (q + 1) + (xcd - r) * q) + off; }
        const int nig = WGM * nN, gid = wgid / nig, fm = gid * WGM, gsz = (nM - fm) < WGM ? (nM - fm) : WGM;
        u.pm = fm + ((wgid % nig) % gsz); u.pn = (wgid % nig) / gsz; return true;
    }
};
template <class Epi>
__device__ __forceinline__ void gemm_phase(LAS unsigned char* lds, const Gemm g, const StaticOrder& S, const Epi& E) {
    const int tid = threadIdx.x, wid = __builtin_amdgcn_readfirstlane(tid >> 6), lane = tid & 63, wr = wid >> 2, wc = wid & 3, fr = lane & 15, fq = lane >> 4;
    const int K = g.K, nt = K / BK, lda = g.lda;
    unsigned voffA[2], voffB[2];
#pragma unroll
    for (int i = 0; i < 2; ++i) { int R, C; stage_rc(tid * 16 + i * 8192, R, C);
        const int Rb = Epi::PERM ? ((R & ~31) + perm32(R & 31)) : R;
        voffA[i] = (unsigned)(R * lda + C) * 2u; voffB[i] = (unsigned)(Rb * K + C) * 2u; }
    const size_t kstep = (size_t)(BK * 2);
    const size_t hstepA = (size_t)HALF * lda * 2, hstepB = (size_t)HALF * K * 2;
    const size_t tstepA = 2 * hstepA, tstepB = 2 * hstepB, pnA = (size_t)g.apn * 2;
    const unsigned ldsw = (unsigned)wid * 1024u;
    const int aoff = lds_byte(wr * 64 + fr, fq * 8), boff = lds_byte(wc * 32 + fr, fq * 8);
#define PG8_SA(b, h) (((b) * 2 + (h)) * HTB)
#define PG8_SB(b, h) ((4 + (b) * 2 + (h)) * HTB)
#define PG8_STAGE(bufoff, gbase, voff) do { _Pragma("unroll") for (int _i = 0; _i < 2; ++_i) \
        __builtin_amdgcn_global_load_lds((const unsigned*)((const char*)(gbase) + (voff)[_i]), (LAS unsigned*)(lds + (bufoff) + ldsw + _i * 8192), 16, 0, 0); } while (0)
#define PG8_LDA(dst, b, h) do { _Pragma("unroll") for (int m = 0; m < 4; ++m) _Pragma("unroll") for (int k = 0; k < 2; ++k) dst[m][k] = *(const LAS bf16x8*)(lds + PG8_SA(b, h) + aoff + m * 2048 + k * 1024); } while (0)
#define PG8_LDB(dst, b, h) do { _Pragma("unroll") for (int n = 0; n < 2; ++n) _Pragma("unroll") for (int k = 0; k < 2; ++k) dst[n][k] = *(const LAS bf16x8*)(lds + PG8_SB(b, h) + boff + n * 2048 + k * 1024); } while (0)
#define PG8_MMA(ai, bj, At, Bt) do { __builtin_amdgcn_s_setprio(1); _Pragma("unroll") for (int m = 0; m < 4; ++m) _Pragma("unroll") for (int n = 0; n < 2; ++n) _Pragma("unroll") for (int k = 0; k < 2; ++k) \
        acc[ai][bj][m][n] = __builtin_amdgcn_mfma_f32_16x16x32_bf16(Bt[n][k], At[m][k], acc[ai][bj][m][n], 0, 0, 0); __builtin_amdgcn_s_setprio(0); } while (0)
#define PG8_WAIT_V(n) asm volatile("s_waitcnt vmcnt(" #n ")" ::: "memory")
#define PG8_WAIT_L(n) asm volatile("s_waitcnt lgkmcnt(" #n ")" ::: "memory")
#define PG8_BAR __builtin_amdgcn_s_barrier()
#define PG8_SCHED __builtin_amdgcn_sched_barrier(0)
    Unit cur, nxt; int ui = 0;
    if (!S.next(0, cur)) return;
    f32x4 acc[2][2][4][2];
#pragma unroll
    for (int a = 0; a < 2; ++a)
#pragma unroll
        for (int b = 0; b < 2; ++b)
#pragma unroll
            for (int m = 0; m < 4; ++m)
#pragma unroll
                for (int n = 0; n < 2; ++n) acc[a][b][m][n] = (f32x4){0.f, 0.f, 0.f, 0.f};
    bf16x8 At[4][2], B0[2][2], B1[2][2];
    const char* cA = (const char*)g.A + (size_t)cur.pm * tstepA + (size_t)cur.pn * pnA; const char* cB = (const char*)g.Bt + (size_t)cur.pn * tstepB;
    PG8_STAGE(PG8_SB(0, 0), cB, voffB); PG8_STAGE(PG8_SB(0, 1), cB + hstepB, voffB); PG8_STAGE(PG8_SA(0, 0), cA, voffA); PG8_STAGE(PG8_SA(0, 1), cA + hstepA, voffA);
    if (wr == 1) PG8_BAR;
    PG8_WAIT_V(2); PG8_BAR;
    PG8_STAGE(PG8_SB(1, 0), cB + kstep, voffB); PG8_STAGE(PG8_SA(1, 0), cA + kstep, voffA); PG8_STAGE(PG8_SB(1, 1), cB + hstepB + kstep, voffB);
    PG8_WAIT_V(6); PG8_BAR;
    for (;;) {
        const bool has_next = S.next(ui + 1, nxt);
        const char* nA = has_next ? (const char*)g.A + (size_t)nxt.pm * tstepA + (size_t)nxt.pn * pnA : cA; const char* nB = has_next ? (const char*)g.Bt + (size_t)nxt.pn * tstepB : cB;
#pragma unroll 1
        for (int t = 0; t < nt; t += 2) {
            const bool last = (t == nt - 2);
            const char* a1 = cA + (size_t)(t + 1) * kstep;
            const char* a2 = last ? nA : cA + (size_t)(t + 2) * kstep; const char* b2 = last ? nB : cB + (size_t)(t + 2) * kstep;
            const char* a3 = a2 + kstep; const char* b3 = b2 + kstep;
            PG8_LDB(B0, 0, 0); PG8_LDB(B1, 0, 1); PG8_SCHED; PG8_LDA(At, 0, 0); PG8_STAGE(PG8_SA(1, 1), a1 + hstepA, voffA);
            PG8_WAIT_V(8); PG8_WAIT_L(0); PG8_BAR; PG8_MMA(0, 0, At, B0); PG8_MMA(0, 1, At, B1); PG8_BAR; PG8_SCHED;
            PG8_LDA(At, 0, 1); PG8_STAGE(PG8_SB(0, 0), b2, voffB); PG8_STAGE(PG8_SB(0, 1), b2 + hstepB, voffB); PG8_STAGE(PG8_SA(0, 0), a2, voffA);
            PG8_WAIT_V(8); PG8_WAIT_L(0); PG8_BAR; PG8_MMA(1, 0, At, B0); PG8_MMA(1, 1, At, B1); PG8_BAR; PG8_SCHED;
            PG8_LDB(B0, 1, 0); PG8_LDB(B1, 1, 1); PG8_SCHED; PG8_LDA(At, 1, 0); PG8_STAGE(PG8_SA(0, 1), a2 + hstepA, voffA);
            PG8_WAIT_V(8); PG8_WAIT_L(0); PG8_BAR; PG8_MMA(0, 0, At, B0); PG8_MMA(0, 1, At, B1); PG8_BAR; PG8_SCHED;
            PG8_LDA(At, 1, 1); PG8_STAGE(PG8_SB(1, 0), b3, voffB); PG8_STAGE(PG8_SB(1, 1), b3 + hstepB, voffB); PG8_STAGE(PG8_SA(1, 0), a3, voffA);
            PG8_WAIT_V(8); PG8_WAIT_L(0); PG8_BAR; PG8_MMA(1, 0, At, B0); PG8_MMA(1, 1, At, B1); PG8_BAR; PG8_SCHED;
        }
        if (wr == 0) PG8_BAR;
        E(acc, cur, wr, wc, fr, fq);
        if (!has_next) break;
#pragma unroll
        for (int a = 0; a < 2; ++a)
#pragma unroll
            for (int b = 0; b < 2; ++b)
#pragma unroll
                for (int m = 0; m < 4; ++m)
#pragma unroll
                    for (int n = 0; n < 2; ++n) acc[a][b][m][n] = (f32x4){0.f, 0.f, 0.f, 0.f};
        cur = nxt; cA = nA; cB = nB; ++ui;
        if (wr == 1) PG8_BAR;
    }
    PG8_WAIT_V(0);
    PG8_BAR;
#undef PG8_SA
#undef PG8_SB
#undef PG8_STAGE
#undef PG8_LDA
#undef PG8_LDB
#undef PG8_MMA
#undef PG8_WAIT_V
#undef PG8_WAIT_L
#undef PG8_BAR
#undef PG8_SCHED
}
}

struct Params { const float* in[27]; float* out; unsigned char* ws; int ph_lo, ph_hi; };
enum { I_XP = 0, I_XS, I_PP, I_PS, I_SPOOL, I_CLAT, I_CKR, I_PT, I_NMIX, I_NMLP, I_NPLE, I_POOLW, I_POOLSC, I_NKV, I_WDKV, I_KVN, I_WUK, I_WUV, I_WDQ, I_QN, I_WUQ, I_WO, I_WUP, I_WDOWN, I_WGATE, I_WPROJ, I_NFIN };

__device__ __forceinline__ void load_rstd(const float* ssq, const pg8::Unit& u, int wr, int fr, int fq, float (&rs)[2][4]) {
#pragma unroll
    for (int ai = 0; ai < 2; ++ai)
#pragma unroll
        for (int m = 0; m < 4; ++m) {
            const int row = u.pm * 256 + ai * 128 + wr * 64 + m * 16 + fr;
            const f32x4 a = ((const f32x4*)(ssq + (size_t)row * 16))[fq];
            float t = (a.x + a.y) + (a.z + a.w);
            t += __shfl_xor(t, 16); t += __shfl_xor(t, 32);
            rs[ai][m] = 1.0f / sqrtf(t * (1.0f / 1024.0f) + EPS);
        }
}
template <int MODE> struct EpiH {
    static constexpr bool PERM = true;
    const float* xp; const float* xs; const float* scale; const float* ssq_in; const bf16_t* proj;
    const bf16_t* hb_in; bf16_t* hb; float* ssq_out;
    __device__ __forceinline__ void operator()(const f32x4 (&acc)[2][2][4][2], const pg8::Unit& u, int wr, int wc, int fr_in, int fq_in) const {
        int fr = fr_in, fq = fq_in; asm volatile("" : "+v"(fr), "+v"(fq));
        float rs[2][4];
        if (MODE == 2) load_rstd(ssq_in, u, wr, fr, fq, rs);
        const int col0 = u.pn * 256 + wc * 32 + 8 * fq;
#pragma unroll
        for (int ai = 0; ai < 2; ++ai)
#pragma unroll
            for (int m = 0; m < 4; ++m) {
                const int row = u.pm * 256 + ai * 128 + wr * 64 + m * 16 + fr;
                float sq = 0.f;
#pragma unroll
                for (int bj = 0; bj < 2; ++bj) {
                    const int col = col0 + bj * 128;
                    f32x4 b0, b1;
                    if (MODE == 0) { const float* xr = (row < MP ? xp + (size_t)row * D : xs + (size_t)(row - MP) * D) + col; b0 = *(const f32x4*)xr; b1 = *(const f32x4*)(xr + 4); }
                    else { const u32x4 hv = *(const u32x4*)(hb_in + (size_t)row * D + col); b0 = unpk4((u32x2){hv.x, hv.y}); b1 = unpk4((u32x2){hv.z, hv.w}); }
                    const f32x4 a0 = acc[ai][bj][m][0], a1 = acc[ai][bj][m][1]; f32x4 o0, o1;
                    if (MODE == 0) { o0 = b0 + *(const f32x4*)(scale + col) * a0; o1 = b1 + *(const f32x4*)(scale + col + 4) * a1; }
                    else if (MODE == 1) { o0 = b0 + a0; o1 = b1 + a1; }
                    else { const u32x4 pv = *(const u32x4*)(proj + (size_t)row * D + col); const f32x4 p0 = unpk4((u32x2){pv.x, pv.y}), p1 = unpk4((u32x2){pv.z, pv.w}); const float r = rs[ai][m];
                        f32x4 g0, g1;
                        g0.x = 1.0f / (1.0f + __expf(-r * a0.x)); g0.y = 1.0f / (1.0f + __expf(-r * a0.y)); g0.z = 1.0f / (1.0f + __expf(-r * a0.z)); g0.w = 1.0f / (1.0f + __expf(-r * a0.w));
                        g1.x = 1.0f / (1.0f + __expf(-r * a1.x)); g1.y = 1.0f / (1.0f + __expf(-r * a1.y)); g1.z = 1.0f / (1.0f + __expf(-r * a1.z)); g1.w = 1.0f / (1.0f + __expf(-r * a1.w));
                        o0 = b0 + g0 * p0; o1 = b1 + g1 * p1; }
                    u32x4 w; w.x = pk2(o0.x, o0.y); w.y = pk2(o0.z, o0.w); w.z = pk2(o1.x, o1.y); w.w = pk2(o1.z, o1.w);
                    *(u32x4*)(hb + (size_t)row * D + col) = w;
                    sq += ((o0.x * o0.x + o0.y * o0.y) + (o0.z * o0.z + o0.w * o0.w)) + ((o1.x * o1.x + o1.y * o1.y) + (o1.z * o1.z + o1.w * o1.w));
                }
                sq += __shfl_xor(sq, 16); sq += __shfl_xor(sq, 32);
                if (fq == 0) ssq_out[(size_t)row * 16 + u.pn * 4 + wc] = sq;
                asm volatile("" ::: "memory");
            }
    }
};
struct EpiUp {
    static constexpr bool PERM = true;
    const float* ssq_in; bf16_t* abuf;
    __device__ __forceinline__ void operator()(const f32x4 (&acc)[2][2][4][2], const pg8::Unit& u, int wr, int wc, int fr_in, int fq_in) const {
        int fr = fr_in, fq = fq_in; asm volatile("" : "+v"(fr), "+v"(fq));
        float rs[2][4]; load_rstd(ssq_in, u, wr, fr, fq, rs);
        const int col0 = u.pn * 256 + wc * 32 + 8 * fq;
#pragma unroll
        for (int ai = 0; ai < 2; ++ai)
#pragma unroll
            for (int m = 0; m < 4; ++m) {
                const int row = u.pm * 256 + ai * 128 + wr * 64 + m * 16 + fr; const float r = rs[ai][m];
#pragma unroll
                for (int bj = 0; bj < 2; ++bj) {
                    f32x4 a = acc[ai][bj][m][0] * r, c = acc[ai][bj][m][1] * r;
                    a.x = fmaxf(a.x, 0.f); a.y = fmaxf(a.y, 0.f); a.z = fmaxf(a.z, 0.f); a.w = fmaxf(a.w, 0.f);
                    c.x = fmaxf(c.x, 0.f); c.y = fmaxf(c.y, 0.f); c.z = fmaxf(c.z, 0.f); c.w = fmaxf(c.w, 0.f);
                    u32x4 w; w.x = pk2(a.x * a.x, a.y * a.y); w.y = pk2(a.z * a.z, a.w * a.w); w.z = pk2(c.x * c.x, c.y * c.y); w.w = pk2(c.z * c.z, c.w * c.w);
                    *(u32x4*)(abuf + (size_t)row * FF + col0 + bj * 128) = w;
                }
            }
    }
};
template <int MODE> struct EpiF32 {
    static constexpr bool PERM = false;
    float* C; int ldc; const float* aux;
    __device__ __forceinline__ void operator()(const f32x4 (&acc)[2][2][4][2], const pg8::Unit& u, int wr, int wc, int fr_in, int fq_in) const {
        int fr = fr_in, fq = fq_in; asm volatile("" : "+v"(fr), "+v"(fq));
        float rs[2][4];
        if (MODE == 1) load_rstd(aux, u, wr, fr, fq, rs);
        const int col0 = u.pn * 256 + wc * 32 + 4 * fq;
#pragma unroll
        for (int ai = 0; ai < 2; ++ai)
#pragma unroll
            for (int m = 0; m < 4; ++m) {
                const int row = u.pm * 256 + ai * 128 + wr * 64 + m * 16 + fr;
                const float r = (MODE == 1) ? rs[ai][m] : (MODE == 2 ? aux[row] : 1.0f);
#pragma unroll
                for (int bj = 0; bj < 2; ++bj)
#pragma unroll
                    for (int n = 0; n < 2; ++n) *(f32x4*)(C + (size_t)row * ldc + col0 + bj * 128 + n * 16) = acc[ai][bj][m][n] * r;
            }
    }
};
struct EpiBf {
    static constexpr bool PERM = true;
    bf16_t* C; int ldc;
    __device__ __forceinline__ void operator()(const f32x4 (&acc)[2][2][4][2], const pg8::Unit& u, int wr, int wc, int fr_in, int fq_in) const {
        int fr = fr_in, fq = fq_in; asm volatile("" : "+v"(fr), "+v"(fq));
        const int col0 = u.pn * 256 + wc * 32 + 8 * fq;
#pragma unroll
        for (int ai = 0; ai < 2; ++ai)
#pragma unroll
            for (int m = 0; m < 4; ++m) {
                const int row = u.pm * 256 + ai * 128 + wr * 64 + m * 16 + fr;
#pragma unroll
                for (int bj = 0; bj < 2; ++bj) { const f32x4 a = acc[ai][bj][m][0], c = acc[ai][bj][m][1]; u32x4 w; w.x = pk2(a.x, a.y); w.y = pk2(a.z, a.w); w.z = pk2(c.x, c.y); w.w = pk2(c.z, c.w);
                    *(u32x4*)(C + (size_t)row * ldc + col0 + bj * 128) = w; }
            }
    }
};
__host__ __device__ __forceinline__ int qperm(int c) { const int e = c % QH; if (e < NOPE) return c; const int r = e - NOPE, i = r & 31, sec = r >> 5; return c - e + NOPE + 32 * (i >> 4) + 16 * sec + (i & 15); }
struct EpiQ {
    static constexpr bool PERM = false;
    const float* rstdq; const float* cs; bf16_t* qbuf;
    __device__ __forceinline__ void operator()(const f32x4 (&acc)[2][2][4][2], const pg8::Unit& u, int wr, int wc, int fr_in, int fq_in) const {
        int fr = fr_in, fq = fq_in; asm volatile("" : "+v"(fr), "+v"(fq));
#pragma unroll
        for (int ai = 0; ai < 2; ++ai)
#pragma unroll
            for (int m = 0; m < 4; ++m) {
                const int row = u.pm * 256 + ai * 128 + wr * 64 + m * 16 + fr; const float r = rstdq[row]; const int pos = row & (SEQ - 1);
                bf16_t* qrow = qbuf + (size_t)row * (NH * QH);
#pragma unroll
                for (int bj = 0; bj < 2; ++bj) {
                    const int Gi = u.pn * 8 + bj * 4 + wc, hh = Gi / 6, gi = Gi - hh * 6;
                    if (gi < 4) {
#pragma unroll
                        for (int n = 0; n < 2; ++n) { const f32x4 a = acc[ai][bj][m][n] * r; u32x2 w; w.x = pk2(a.x, a.y); w.y = pk2(a.z, a.w);
                            *(u32x2*)(qrow + Gi * 32 + n * 16 + 4 * fq) = w; }
                    } else {
                        const int i0 = 16 * (gi - 4) + 4 * fq;
                        const f32x4 x1 = acc[ai][bj][m][0] * r, x2 = acc[ai][bj][m][1] * r;
                        const f32x4 cn = *(const f32x4*)(cs + (size_t)pos * 64 + i0), sn = *(const f32x4*)(cs + (size_t)pos * 64 + 32 + i0);
                        const f32x4 o1 = x1 * cn - x2 * sn, o2 = x2 * cn + x1 * sn;
                        u32x2 w1, w2; w1.x = pk2(o1.x, o1.y); w1.y = pk2(o1.z, o1.w); w2.x = pk2(o2.x, o2.y); w2.y = pk2(o2.z, o2.w);
                        *(u32x2*)(qrow + hh * QH + NOPE + i0) = w1; *(u32x2*)(qrow + hh * QH + NOPE + 32 + i0) = w2;
                    }
                }
                asm volatile("" ::: "memory");
            }
    }
};
struct EpiKup {
    static constexpr bool PERM = true;
    bf16_t* kfull;
    __device__ __forceinline__ void operator()(const f32x4 (&acc)[2][2][4][2], const pg8::Unit& u, int wr, int wc, int fr_in, int fq_in) const {
        int fr = fr_in, fq = fq_in; asm volatile("" : "+v"(fr), "+v"(fq));
        const int col0 = u.pn * 256 + wc * 32 + 8 * fq;
#pragma unroll
        for (int ai = 0; ai < 2; ++ai)
#pragma unroll
            for (int m = 0; m < 4; ++m) {
                const int row = u.pm * 256 + ai * 128 + wr * 64 + m * 16 + fr; const int b = row >> 13, t = row & (SEQ - 1);
#pragma unroll
                for (int bj = 0; bj < 2; ++bj) { const int col = col0 + bj * 128; const int h = col >> 7, nn = col & 127; const f32x4 a = acc[ai][bj][m][0], c = acc[ai][bj][m][1];
                    u32x4 w; w.x = pk2(a.x, a.y); w.y = pk2(a.z, a.w); w.z = pk2(c.x, c.y); w.w = pk2(c.z, c.w);
                    *(u32x4*)(kfull + ((size_t)(b * NH + h) * SEQ + t) * QH + nn) = w; }
                asm volatile("" ::: "memory");
            }
    }
};
struct EpiVup {
    static constexpr bool PERM = true;
    bf16_t* vt;
    __device__ __forceinline__ void operator()(const f32x4 (&acc)[2][2][4][2], const pg8::Unit& u, int wr, int wc, int fr_in, int fq_in) const {
        int fr = fr_in, fq = fq_in; asm volatile("" : "+v"(fr), "+v"(fq));
        const int col0 = u.pn * 256 + wc * 32 + 8 * fq;
#pragma unroll
        for (int ai = 0; ai < 2; ++ai)
#pragma unroll
            for (int m = 0; m < 4; ++m) {
                const int row = u.pm * 256 + ai * 128 + wr * 64 + m * 16 + fr; const int h = row >> 7, v = row & 127;
#pragma unroll
                for (int bj = 0; bj < 2; ++bj) { const int col = col0 + bj * 128; const int b = col >> 13, t = col & (SEQ - 1); const f32x4 a = acc[ai][bj][m][0], c = acc[ai][bj][m][1];
                    u32x4 w; w.x = pk2(a.x, a.y); w.y = pk2(a.z, a.w); w.z = pk2(c.x, c.y); w.w = pk2(c.z, c.w);
                    *(u32x4*)(vt + ((size_t)(b * NH + h) * VD + v) * SEQ + t) = w; }
                asm volatile("" ::: "memory");
            }
    }
};

struct SgALoadBf { const bf16_t* A; int lda;
    __device__ __forceinline__ bf16x8 operator()(int row, int k) const { return *(const bf16x8*)(A + (size_t)row * lda + k); } };
struct SgALoadComb { const float* parto; const float* ml;
    __device__ __forceinline__ bf16x8 operator()(int row, int k) const {
        const int b = row >> 3, tok = row & 7, h = k >> 7, v = k & 127, q = tok * 8 + h;
        const float* m0p = ml + ((size_t)(b * 2 + 0) * 64 + q) * 2; const float* m1p = ml + ((size_t)(b * 2 + 1) * 64 + q) * 2;
        const float m0 = m0p[0], l0 = m0p[1], m1 = m1p[0], l1 = m1p[1], mx = fmaxf(m0, m1);
        float w0 = __builtin_amdgcn_exp2f(m0 - mx), w1 = __builtin_amdgcn_exp2f(m1 - mx); const float inv = 1.0f / (w0 * l0 + w1 * l1); w0 *= inv; w1 *= inv;
        const float* p0 = parto + ((size_t)(b * 2 + 0) * 64 + q) * 128 + v; const float* p1 = parto + ((size_t)(b * 2 + 1) * 64 + q) * 128 + v;
        return pack8v(*(const f32x4*)p0 * w0 + *(const f32x4*)p1 * w1, *(const f32x4*)(p0 + 4) * w0 + *(const f32x4*)(p1 + 4) * w1); } };
template <int NCT, int NCG, class Epi, class ALoad>
__device__ __forceinline__ void sg_gemm_l(LAS unsigned char* lds, const ALoad& AL, int apn256, const bf16_t* __restrict__ Bt, int K, int unit, const Epi& E, int tid, int wave, int lane) {
    constexpr int KS = 8 / NCG, W = NCG * NCT * 16, G4 = W / 4;
    static_assert(KS * 64 * W * 4 <= RING_BYTES, "sg_gemm reduction buffer");
    const int mt = unit >> 4, ntile = unit & 15, m0 = mt * 64, n0 = ntile * W;
    const int cg = wave % NCG, kp = wave / NCG, fr = lane & 15, fq = lane >> 4;
    const int Kw = K / KS;
    const int arow = m0 + fr, acol = (n0 >> 8) * apn256 + kp * Kw + 8 * fq;
    const bf16_t* bp = Bt + (size_t)(n0 + cg * NCT * 16 + fr) * K + kp * Kw + 8 * fq;
    f32x4 acc[4][NCT];
#pragma unroll
    for (int m = 0; m < 4; ++m)
#pragma unroll
        for (int n = 0; n < NCT; ++n) acc[m][n] = (f32x4){0.f, 0.f, 0.f, 0.f};
#pragma unroll 4
    for (int kk = 0; kk < Kw; kk += 32) {
        bf16x8 af[4], bfr[NCT];
#pragma unroll
        for (int m = 0; m < 4; ++m) af[m] = AL(arow + 16 * m, acol + kk);
#pragma unroll
        for (int n = 0; n < NCT; ++n) bfr[n] = *(const bf16x8*)(bp + (size_t)(16 * n) * K + kk);
#pragma unroll
        for (int m = 0; m < 4; ++m)
#pragma unroll
            for (int n = 0; n < NCT; ++n) acc[m][n] = __builtin_amdgcn_mfma_f32_16x16x32_bf16(bfr[n], af[m], acc[m][n], 0, 0, 0);
    }
    LAS float* red = (LAS float*)lds;
#pragma unroll
    for (int m = 0; m < 4; ++m)
#pragma unroll
        for (int n = 0; n < NCT; ++n) { const int row = 16 * m + fr, c4 = (cg * NCT * 16 + 16 * n) / 4 + fq;
            *(LAS f32x4*)(red + (size_t)(kp * 64 + row) * W + 4 * (c4 ^ (row & 3))) = acc[m][n]; }
    __syncthreads();
    for (int it = tid; it < 64 * G4; it += 512) {
        const int row = it / G4, c4 = it % G4;
        f32x4 v = *(const LAS f32x4*)(red + (size_t)row * W + 4 * (c4 ^ (row & 3)));
#pragma unroll
        for (int p = 1; p < KS; ++p) v += *(const LAS f32x4*)(red + (size_t)(p * 64 + row) * W + 4 * (c4 ^ (row & 3)));
        if constexpr (Epi::WHOLE_TILE) *(LAS f32x4*)(red + (size_t)row * W + 4 * (c4 ^ (row & 3))) = v;
        else E(MP + m0 + row, n0 + 4 * c4, v, ntile);
    }
    if constexpr (Epi::WHOLE_TILE) {
        __syncthreads();
        for (int it = tid; it < 64 * G4; it += 512) { const int row = it / G4, c4 = it % G4; E.tile(MP + m0 + row, n0, c4, red + (size_t)row * W, row & 3); }
    }
    __syncthreads();
}
template <int NCT, int NCG, class Epi>
__device__ __forceinline__ void sg_gemm(LAS unsigned char* lds, const bf16_t* __restrict__ A, int lda, int apn256, const bf16_t* __restrict__ Bt, int K, int unit, const Epi& E, int tid, int wave, int lane) {
    const SgALoadBf AL{A, lda}; sg_gemm_l<NCT, NCG>(lds, AL, apn256, Bt, K, unit, E, tid, wave, lane);
}
__device__ __forceinline__ float row_rstd16(const float* ssq, int row) {
    const f32x4* s = (const f32x4*)(ssq + (size_t)row * 16); const f32x4 a = s[0], b = s[1], c = s[2], d = s[3];
    const float t = ((a.x + a.y) + (a.z + a.w)) + ((b.x + b.y) + (b.z + b.w)) + ((c.x + c.y) + (c.z + c.w)) + ((d.x + d.y) + (d.z + d.w));
    return 1.0f / sqrtf(t * (1.0f / 1024.0f) + EPS);
}
template <int MODE> struct SgH {
    static constexpr bool WHOLE_TILE = false;
    const float* xs; const float* scale; const float* ssq_in; const bf16_t* proj; const bf16_t* hb_in; bf16_t* hb; float* ssq_out;
    __device__ __forceinline__ void operator()(int row, int col, f32x4 a, int ntile) const {
        const f32x4 bs = (MODE == 0) ? *(const f32x4*)(xs + (size_t)(row - MP) * D + col) : unpk4(*(const u32x2*)(hb_in + (size_t)row * D + col));
        f32x4 o;
        if (MODE == 0) o = bs + *(const f32x4*)(scale + col) * a;
        else if (MODE == 1) o = bs + a;
        else { const float r = row_rstd16(ssq_in, row); const f32x4 pj = unpk4(*(const u32x2*)(proj + (size_t)row * D + col));
            f32x4 gt; gt.x = 1.0f / (1.0f + __expf(-r * a.x)); gt.y = 1.0f / (1.0f + __expf(-r * a.y)); gt.z = 1.0f / (1.0f + __expf(-r * a.z)); gt.w = 1.0f / (1.0f + __expf(-r * a.w));
            o = bs + gt * pj; }
        u32x2 w; w.x = pk2(o.x, o.y); w.y = pk2(o.z, o.w);
        *(u32x2*)(hb + (size_t)row * D + col) = w;
        float sq = (o.x * o.x + o.y * o.y) + (o.z * o.z + o.w * o.w);
        sq += __shfl_xor(sq, 1); sq += __shfl_xor(sq, 2); sq += __shfl_xor(sq, 4); sq += __shfl_xor(sq, 8);
        if ((col & 63) == 0) ssq_out[(size_t)row * 16 + ntile] = sq;
    }
};
struct SgUp {
    static constexpr bool WHOLE_TILE = false;
    const float* ssq_in; bf16_t* abuf;
    __device__ __forceinline__ void operator()(int row, int col, f32x4 a, int) const {
        const float r = row_rstd16(ssq_in, row); a = a * r;
        a.x = fmaxf(a.x, 0.f); a.y = fmaxf(a.y, 0.f); a.z = fmaxf(a.z, 0.f); a.w = fmaxf(a.w, 0.f);
        u32x2 w; w.x = pk2(a.x * a.x, a.y * a.y); w.y = pk2(a.z * a.z, a.w * a.w);
        *(u32x2*)(abuf + (size_t)row * FF + col) = w;
    }
};
template <int MODE> struct SgF32 {
    static constexpr bool WHOLE_TILE = false;
    float* C; int ldc; const float* aux;
    __device__ __forceinline__ void operator()(int row, int col, f32x4 a, int) const {
        const float r = (MODE == 1) ? row_rstd16(aux, row) : (MODE == 2 ? aux[row] : 1.0f);
        *(f32x4*)(C + (size_t)row * ldc + col) = a * r;
    }
};
struct SgBf {
    static constexpr bool WHOLE_TILE = false;
    bf16_t* C; int ldc;
    __device__ __forceinline__ void operator()(int row, int col, f32x4 a, int) const { u32x2 w; w.x = pk2(a.x, a.y); w.y = pk2(a.z, a.w); *(u32x2*)(C + (size_t)row * ldc + col) = w; }
};
struct SgQ {
    static constexpr bool WHOLE_TILE = true;
    const float* rstdq; const float* cs; bf16_t* qbuf; bf16_t* qs;
    __device__ __forceinline__ void operator()(int, int, f32x4, int) const {}
    __device__ __forceinline__ void tile(int row, int n0, int c4, const LAS float* trow, int sw) const {
        const int c = n0 + 4 * c4, hh = c / QH, e = c - hh * QH; const float r = rstdq[row];
        const f32x4 v = *(const LAS f32x4*)(trow + 4 * (c4 ^ sw)) * r;
        if (e < NOPE) { u32x2 w; w.x = pk2(v.x, v.y); w.y = pk2(v.z, v.w); *(u32x2*)(qbuf + (size_t)row * (NH * QH) + c) = w; }
        else { const int rp = e - NOPE, wi = rp & 31;
            if (wi < 16) { const int i0 = 16 * (rp >> 5) + wi, pos = PAST + ((row - MP) & 7);
                const f32x4 x2 = *(const LAS f32x4*)(trow + 4 * ((c4 + 4) ^ sw)) * r;
                const f32x4 cn = *(const f32x4*)(cs + (size_t)pos * 64 + i0), sn = *(const f32x4*)(cs + (size_t)pos * 64 + 32 + i0);
                const f32x4 o1 = v * cn - x2 * sn, o2 = x2 * cn + v * sn;
                bf16_t* qd = qs + ((size_t)(row - MP) * NH + hh) * 320 + KVR;
                u32x2 w1, w2; w1.x = pk2(o1.x, o1.y); w1.y = pk2(o1.z, o1.w); w2.x = pk2(o2.x, o2.y); w2.y = pk2(o2.z, o2.w);
                *(u32x2*)(qd + i0) = w1; *(u32x2*)(qd + 32 + i0) = w2; } }
    }
};

template <bool QPERM = false>
__device__ __forceinline__ void transpose_item(const float* W, const float* kscale, int K, int N, bf16_t* WT, int row_off, LAS float* scr, int item, int lane) {
    const int nblk = N / 32, kb = item / nblk, nb = item % nblk, k0 = 64 * kb, n0 = 32 * nb;
    { f32x4 v[8];
#pragma unroll
      for (int i = 0; i < 8; ++i) v[i] = *(const f32x4*)(W + (size_t)(k0 + (lane >> 3) + 8 * i) * N + n0 + (lane & 7) * 4);
#pragma unroll
      for (int i = 0; i < 8; ++i) { const int kk = (lane >> 3) + 8 * i; f32x4 x = v[i]; if (kscale) x = x * kscale[k0 + kk];
          LAS float* d = scr + kk * 33 + (lane & 7) * 4; d[0] = x.x; d[1] = x.y; d[2] = x.z; d[3] = x.w; } }
    LDS_WAIT(); asm volatile("" ::: "memory");
    const int c = lane & 7;
#pragma unroll
    for (int j = 0; j < 4; ++j) { const int n = (lane >> 3) + 8 * j; const LAS float* s = scr + (8 * c) * 33 + n;
        u32x4 o; o.x = pk2(s[0 * 33], s[1 * 33]); o.y = pk2(s[2 * 33], s[3 * 33]); o.z = pk2(s[4 * 33], s[5 * 33]); o.w = pk2(s[6 * 33], s[7 * 33]);
        *(u32x4*)(WT + (size_t)(row_off + (QPERM ? qperm(n0 + n) : n0 + n)) * K + k0 + 8 * c) = o; }
    LDS_WAIT(); asm volatile("" ::: "memory");
}

constexpr int AK_PITCH = 400, AK_BUF = 64 * AK_PITCH;
constexpr int AV_PITCH = 136, AV_BUF = 128 * AV_PITCH;
constexpr int AV_OFF = 2 * AK_BUF, AQ_OFF = AV_OFF + 2 * AV_BUF;
static_assert(AQ_OFF + 256 * 144 <= RING_BYTES, "attention LDS");
__device__ __forceinline__ void attn_prompt_unit(const bf16_t* __restrict__ qbuf, const bf16_t* __restrict__ Kf, const bf16_t* __restrict__ Vt, bf16_t* __restrict__ obuf,
                                                 int b, int h, int qb, LAS unsigned char* lds, int tid, int wave, int lane) {
    const int r32 = lane & 31, g = lane >> 5;
    const int t_lo = qb * 256 + wave * 32, trow = t_lo + r32;
    bf16x8 qf[8];
    { const bf16_t* qp = qbuf + (size_t)(b * SEQ + trow) * (NH * QH) + h * QH + 8 * g;
      __syncthreads();
#pragma unroll
      for (int ks = 8; ks < 12; ++ks) *(LAS bf16x8*)(lds + AQ_OFF + (wave * 32 + r32) * 144 + (2 * (ks - 8) + g) * 16) = *(const bf16x8*)(qp + 16 * ks);
#pragma unroll
      for (int ks = 0; ks < 8; ++ks) qf[ks] = *(const bf16x8*)(qp + 16 * ks);
#pragma unroll
      for (int ks = 0; ks < 8; ++ks) asm volatile("" : "+v"(qf[ks])); }
    f32x16 O[4];
#pragma unroll
    for (int i = 0; i < 4; ++i)
#pragma unroll
        for (int j = 0; j < 16; ++j) O[i][j] = 0.f;
    float mrun = -1e30f, lrun = 0.f;
    const bf16_t* Kb = Kf + (size_t)(b * NH + h) * SEQ * QH;
    const bf16_t* Vb = Vt + (size_t)(b * NH + h) * VD * SEQ;
    const int NT = (qb + 1) * 4;
    int kl_off[3], vl_off[2]; size_t vg_off[2];
#pragma unroll
    for (int e = 0; e < 3; ++e) kl_off[e] = (tid >> 3) * AK_PITCH + ((tid & 7) + 8 * e) * 16;
#pragma unroll
    for (int e = 0; e < 2; ++e) { const int c = tid + 512 * e; vl_off[e] = AV_OFF + (c >> 3) * AV_PITCH + (c & 7) * 16; vg_off[e] = (size_t)(c >> 3) * SEQ + (c & 7) * 8; }
    u32x4 kst[3], vst[2];
#define AT_LOAD(j) do { _Pragma("unroll") for (int e = 0; e < 3; ++e) kst[e] = *(const u32x4*)(Kb + (size_t)(64 * (j) + (tid >> 3)) * QH + ((tid & 7) + 8 * e) * 8); \
                        _Pragma("unroll") for (int e = 0; e < 2; ++e) vst[e] = *(const u32x4*)(Vb + vg_off[e] + 64 * (j)); } while (0)
#define AT_WRITE(buf) do { _Pragma("unroll") for (int e = 0; e < 3; ++e) *(LAS u32x4*)(lds + (buf) * AK_BUF + kl_off[e]) = kst[e]; \
                           _Pragma("unroll") for (int e = 0; e < 2; ++e) { *(LAS u32x2*)(lds + (buf) * AV_BUF + vl_off[e]) = (u32x2){vst[e].x, vst[e].y}; *(LAS u32x2*)(lds + (buf) * AV_BUF + vl_off[e] + 8) = (u32x2){vst[e].z, vst[e].w}; } } while (0)
    AT_LOAD(0); AT_WRITE(0);
    __syncthreads();
    for (int j = 0; j < NT; ++j) {
        const int buf = j & 1;
        if (j + 1 < NT) AT_LOAD(j + 1);
        if (64 * j <= t_lo + 31) {
            f32x16 S0, S1;
#pragma unroll
            for (int i = 0; i < 16; ++i) { S0[i] = 0.f; S1[i] = 0.f; }
            const LAS unsigned char* kl = lds + buf * AK_BUF + r32 * AK_PITCH + g * 16;
            const LAS unsigned char* ql = lds + AQ_OFF + (wave * 32 + r32) * 144 + g * 16;
            bf16x8 ka[3][2], qr_[3];
#define AT_KLD(ks) do { ka[(ks) % 3][0] = *(const LAS bf16x8*)(kl + (ks) * 32); ka[(ks) % 3][1] = *(const LAS bf16x8*)(kl + 32 * AK_PITCH + (ks) * 32); \
                        if ((ks) >= 8) qr_[(ks) % 3] = *(const LAS bf16x8*)(ql + ((ks) - 8) * 32); } while (0)
            AT_KLD(0); AT_KLD(1);
#pragma unroll
            for (int ks = 0; ks < 12; ++ks) {
                if (ks + 2 < 12) AT_KLD(ks + 2);
                __builtin_amdgcn_sched_barrier(0);
                const bf16x8 qb_ = (ks < 8) ? qf[ks < 8 ? ks : 0] : qr_[ks % 3];
                S0 = __builtin_amdgcn_mfma_f32_32x32x16_bf16(ka[ks % 3][0], qb_, S0, 0, 0, 0);
                S1 = __builtin_amdgcn_mfma_f32_32x32x16_bf16(ka[ks % 3][1], qb_, S1, 0, 0, 0);
                __builtin_amdgcn_sched_barrier(0);
            }
#undef AT_KLD
            if (64 * j + 63 > t_lo) {
                asm volatile("" ::: "memory");
#pragma unroll
                for (int i = 0; i < 16; ++i) { const int key = 64 * j + crow(i, g); if (key > trow) S0[i] = -1e30f; if (key + 32 > trow) S1[i] = -1e30f; }
            }
            float mx = S0[0];
#pragma unroll
            for (int i = 1; i < 16; ++i) mx = fmaxf(mx, S0[i]);
#pragma unroll
            for (int i = 0; i < 16; ++i) mx = fmaxf(mx, S1[i]);
            mx = fmaxf(mx, __shfl_xor(mx, 32)) * CEXP;
            if (__any(mx > mrun + 11.5f)) {
                const float mnew = fmaxf(mrun, mx), alpha = __builtin_amdgcn_exp2f(mrun - mnew);
                mrun = mnew; lrun *= alpha;
#pragma unroll
                for (int vt = 0; vt < 4; ++vt)
#pragma unroll
                    for (int i = 0; i < 16; ++i) O[vt][i] *= alpha;
            }
            float ps = 0.f;
#pragma unroll
            for (int i = 0; i < 16; ++i) { S0[i] = __builtin_amdgcn_exp2f(S0[i] * CEXP - mrun); S1[i] = __builtin_amdgcn_exp2f(S1[i] * CEXP - mrun); ps += S0[i] + S1[i]; }
            lrun += ps;
            bf16x8 pf[4];
            { float tmp[8];
#pragma unroll
              for (int s2 = 0; s2 < 4; ++s2) {
#pragma unroll
                for (int i = 0; i < 8; ++i) tmp[i] = (s2 < 2) ? S0[8 * (s2 & 1) + i] : S1[8 * (s2 & 1) + i];
                pf[s2] = pack8(tmp); } }
            const LAS unsigned char* vl = lds + AV_OFF + buf * AV_BUF + r32 * AV_PITCH + g * 8;
            u32x4 fa[4], fb[4];
#define AT_VLD(dst, vt) do { _Pragma("unroll") for (int s2 = 0; s2 < 4; ++s2) { const u32x2 lo_ = *(const LAS u32x2*)(vl + (vt) * 32 * AV_PITCH + s2 * 32), hi_ = *(const LAS u32x2*)(vl + (vt) * 32 * AV_PITCH + s2 * 32 + 16); dst[s2] = (u32x4){lo_.x, lo_.y, hi_.x, hi_.y}; } } while (0)
#define AT_VMM(src, vt) do { _Pragma("unroll") for (int s2 = 0; s2 < 4; ++s2) O[vt] = __builtin_amdgcn_mfma_f32_32x32x16_bf16(__builtin_bit_cast(bf16x8, src[s2]), pf[s2], O[vt], 0, 0, 0); } while (0)
            AT_VLD(fa, 0); AT_VLD(fb, 1); __builtin_amdgcn_sched_barrier(0);
            AT_VMM(fa, 0); __builtin_amdgcn_sched_barrier(0);
            AT_VLD(fa, 2); __builtin_amdgcn_sched_barrier(0);
            AT_VMM(fb, 1); __builtin_amdgcn_sched_barrier(0);
            AT_VLD(fb, 3); __builtin_amdgcn_sched_barrier(0);
            AT_VMM(fa, 2); __builtin_amdgcn_sched_barrier(0);
            AT_VMM(fb, 3);
#undef AT_VLD
#undef AT_VMM
        }
        if (j + 1 < NT) AT_WRITE(buf ^ 1);
        __syncthreads();
    }
#undef AT_LOAD
#undef AT_WRITE
    const float ltot = lrun + __shfl_xor(lrun, 32), inv = 1.0f / ltot;
    bf16_t* op = obuf + (size_t)(b * SEQ + trow) * D + h * VD + 4 * g;
#pragma unroll
    for (int vt = 0; vt < 4; ++vt)
#pragma unroll
        for (int jq = 0; jq < 4; ++jq) {
            u32x2 w; w.x = pk2(O[vt][4 * jq] * inv, O[vt][4 * jq + 1] * inv); w.y = pk2(O[vt][4 * jq + 2] * inv, O[vt][4 * jq + 3] * inv);
            *(u32x2*)(op + 32 * vt + 8 * jq) = w;
        }
}

typedef short s16x4 __attribute__((ext_vector_type(4)));
constexpr int SA_KR = 32768, SA_BUF = 32768 + 64 * 144, SA_QR = 2 * SA_BUF, SA_QI = SA_QR + 64 * 144, SA_QI_PITCH = 528, SA_OI = 69632;
static_assert(SA_OI >= 65536 + 1024 && SA_OI + 64 * SA_QI_PITCH <= MISC_OFF, "O image");
static_assert(SA_QI + 64 * SA_QI_PITCH <= MISC_OFF, "sample attention LDS");
__device__ __forceinline__ int sa_off(int row, int ch) { return 256 * row + 16 * (ch ^ (((row & 3) << 2) | ((row >> 2) & 3))); }
__device__ __forceinline__ void sattn_item(const Params& P, int b, int half, LAS unsigned char* lds, int tid, int wave, int lane) {
    unsigned char* ws = P.ws;
    const int r32 = lane & 31, g = lane >> 5;
    const bool is_cmp = wave < 4;
    const int qt = wave & 1, kb = (wave >> 1) & 1;
    const int ptv = ((const int*)P.in[I_PT])[b * NPG + half * 32 + (lane & 31)];
    const float* clat = P.in[I_CLAT]; const float* ckr = P.in[I_CKR];
#define SA_LOAD(S, h) do { const int pg_ = __builtin_amdgcn_readlane(ptv, (h) >> 2); const size_t prow_ = (size_t)pg_ * PAGE + (((h) & 3) << 5); \
        const char* lat_ = (const char*)(clat + prow_ * KVR); const char* kro_ = (const char*)(ckr + prow_ * ROPE); \
        _Pragma("unroll") for (int e = 0; e < 4; ++e) { S[2 * e] = *(const f32x4*)(lat_ + glb[e]); S[2 * e + 1] = *(const f32x4*)(lat_ + glb[e] + 16); } \
        S[8] = *(const f32x4*)(kro_ + grb); S[9] = *(const f32x4*)(kro_ + grb + 16); } while (0)
#define SA_WRITE(S, bufo, hh) do { \
        _Pragma("unroll") for (int e = 0; e < 4; ++e) *(LAS bf16x8*)(lds + (bufo) + llb[e][hh]) = pack8v(S[2 * e], S[2 * e + 1]); \
        *(LAS bf16x8*)(lds + (bufo) + lrb[hh]) = pack8v(S[8], S[9]); asm volatile("" ::: "memory"); } while (0)
    __syncthreads();
    *(LAS u32x4*)(lds + SA_QR + (tid >> 3) * 144 + (tid & 7) * 16) = *(const u32x4*)((const bf16_t*)(ws + WS_QS) + ((size_t)b * 64 + (tid >> 3)) * 320 + KVR + (tid & 7) * 8);
    {
      const bf16_t* qn = (const bf16_t*)(ws + WS_QBUF) + (size_t)(MP + b * DS + (r32 & 7)) * (NH * QH) + wave * QH + 8 * g;
      bf16x8 an[8];
#pragma unroll
      for (int ks = 0; ks < 8; ++ks) { u32x4 z = {0u, 0u, 0u, 0u}; if (r32 < DS) z = *(const u32x4*)(qn + 16 * ks); an[ks] = __builtin_bit_cast(bf16x8, z); }
      const bf16_t* wk = (const bf16_t*)(ws + WS_WUKB) + (size_t)r32 * 1024 + wave * NOPE + 8 * g;
#pragma unroll 2
      for (int nt = 0; nt < 8; ++nt) {
          f32x16 acc;
#pragma unroll
          for (int i = 0; i < 16; ++i) acc[i] = 0.f;
#pragma unroll
          for (int ks = 0; ks < 8; ++ks) acc = __builtin_amdgcn_mfma_f32_32x32x16_bf16(an[ks], *(const bf16x8*)(wk + (size_t)(32 * nt) * 1024 + 16 * ks), acc, 0, 0, 0);
#pragma unroll
          for (int i = 0; i < 4; ++i) *(LAS bf16_t*)(lds + SA_QI + ((i + 4 * g) * 8 + wave) * SA_QI_PITCH + (32 * nt + r32) * 2) = (bf16_t)f2bf(acc[i]);
      } }
    __syncthreads();
#define SA_KLD(ks) do { const int o0_ = ((ks) < 16) ? (((ks) >> 3) * 16384 + krow + 32 * (((ks) & 7) ^ (x_ >> 1))) : (krope + 32 * ((ks) - 16)); \
        ka_[(ks) & 3] = *(const LAS bf16x8*)(kb_ + o0_); \
        qa_[(ks) & 3] = ((ks) < 16) ? *(const LAS bf16x8*)(qil + 32 * (ks)) : *(const LAS bf16x8*)(qrl + 32 * ((ks) - 16)); } while (0)
#define SA_VLD(dst, vt) do { const LAS unsigned char* vb_ = kb_ + ((vt) >> 2) * 16384 + 8192 * kb; \
        const int c0_ = 4 * ((vt) & 3) + 2 * vsub + (p_ >> 1); \
        const int blo_ = 256 * (4 * gg + q_) + 16 * (c0_ ^ ((q_ << 2) | gg)) + 8 * (p_ & 1); \
        const int bhi_ = 256 * (4 * gg + q_ + 8) + 16 * (c0_ ^ ((q_ << 2) | (gg + 2))) + 8 * (p_ & 1); \
        _Pragma("unroll") for (int s2 = 0; s2 < 2; ++s2) { \
            const s16x4 lo_ = __builtin_amdgcn_ds_read_tr16_b64_v4i16((LAS s16x4*)(vb_ + blo_ + 4096 * s2)); \
            const s16x4 hi_ = __builtin_amdgcn_ds_read_tr16_b64_v4i16((LAS s16x4*)(vb_ + bhi_ + 4096 * s2)); \
            dst[s2] = (bf16x8){lo_[0], lo_[1], lo_[2], lo_[3], hi_[0], hi_[1], hi_[2], hi_[3]}; } } while (0)
#define SA_VMM(src, vt) do { _Pragma("unroll") for (int s2 = 0; s2 < 2; ++s2) O[vt] = __builtin_amdgcn_mfma_f32_32x32x16_bf16(src[s2], pf[s2], O[vt], 0, 0, 0); } while (0)
#define SA_COMPUTE(j, bufo) do { \
        const LAS unsigned char* kb_ = lds + (bufo); \
        f32x16 S0; \
        _Pragma("unroll") for (int i = 0; i < 16; ++i) S0[i] = 0.f; \
        int r32v = r32; asm volatile("" : "+v"(r32v)); \
        const int x_ = ((r32v & 3) << 2) | ((r32v >> 2) & 3); \
        const int krow = 256 * (r32v + 32 * kb) + 16 * ((g ^ x_) & 1), krope = SA_KR + (r32v + 32 * kb) * 144 + g * 16; \
        const LAS unsigned char* qrl = lds + SA_QR + (32 * qt + r32v) * 144 + g * 16; const LAS unsigned char* qil = lds + SA_QI + (32 * qt + r32v) * SA_QI_PITCH + g * 16; \
        bf16x8 ka_[4], qa_[4]; \
        SA_KLD(0); SA_KLD(1); SA_KLD(2); \
        _Pragma("unroll") for (int ks = 0; ks < 20; ++ks) { \
            if (ks + 3 < 20) SA_KLD(ks + 3); \
            __builtin_amdgcn_sched_barrier(0); \
            S0 = __builtin_amdgcn_mfma_f32_32x32x16_bf16(ka_[ks & 3], qa_[ks & 3], S0, 0, 0, 0); \
            __builtin_amdgcn_sched_barrier(0); } \
        if ((j) == 64) { const int tok = (32 * qt + r32) >> 3; asm volatile("" ::: "memory"); \
            _Pragma("unroll") for (int i = 0; i < 16; ++i) { const int key = 32 * kb + crow(i, g); if (key > tok || key >= DS) S0[i] = -1e30f; } } \
        float mx = S0[0]; \
        _Pragma("unroll") for (int i = 1; i < 16; ++i) mx = fmaxf(mx, S0[i]); \
        mx = fmaxf(mx, __shfl_xor(mx, 32)) * CEXP; \
        if (__any(mx > mrun + 11.5f)) { const float mnew = fmaxf(mrun, mx), alpha = __builtin_amdgcn_exp2f(mrun - mnew); mrun = mnew; lrun *= alpha; \
            _Pragma("unroll") for (int vt = 0; vt < 8; ++vt) _Pragma("unroll") for (int i = 0; i < 16; ++i) O[vt][i] *= alpha; } \
        int lnv = lane; asm volatile("" : "+v"(lnv)); \
        const int li = lnv & 15, q_ = li >> 2, p_ = li & 3, vsub = (lnv >> 4) & 1, gg = lnv >> 5; \
        bf16x8 fa_[2], fb_[2]; \
        SA_VLD(fa_, 0); SA_VLD(fb_, 1);                        \
        float ps = 0.f; \
        _Pragma("unroll") for (int i = 0; i < 16; ++i) { S0[i] = __builtin_amdgcn_exp2f(S0[i] * CEXP - mrun); ps += S0[i]; } \
        lrun += ps; \
        bf16x8 pf[2]; \
        { float tmp[8]; \
          _Pragma("unroll") for (int s2 = 0; s2 < 2; ++s2) { \
            _Pragma("unroll") for (int i = 0; i < 8; ++i) tmp[i] = S0[8 * s2 + i]; \
            pf[s2] = pack8(tmp); } } \
        __builtin_amdgcn_sched_barrier(0); \
        SA_VMM(fa_, 0); __builtin_amdgcn_sched_barrier(0); SA_VLD(fa_, 2); __builtin_amdgcn_sched_barrier(0); \
        SA_VMM(fb_, 1); __builtin_amdgcn_sched_barrier(0); SA_VLD(fb_, 3); __builtin_amdgcn_sched_barrier(0); \
        SA_VMM(fa_, 2); __builtin_amdgcn_sched_barrier(0); SA_VLD(fa_, 4); __builtin_amdgcn_sched_barrier(0); \
        SA_VMM(fb_, 3); __builtin_amdgcn_sched_barrier(0); SA_VLD(fb_, 5); __builtin_amdgcn_sched_barrier(0); \
        SA_VMM(fa_, 4); __builtin_amdgcn_sched_barrier(0); SA_VLD(fa_, 6); __builtin_amdgcn_sched_barrier(0); \
        SA_VMM(fb_, 5); __builtin_amdgcn_sched_barrier(0); SA_VLD(fb_, 7); __builtin_amdgcn_sched_barrier(0); \
        SA_VMM(fa_, 6); __builtin_amdgcn_sched_barrier(0); \
        SA_VMM(fb_, 7); } while (0)
#define SA_LOADER(j, SX, SY, bufn) do { \
        if ((j) + 1 < 64) { SA_WRITE(SX, bufn, 0); if (2 * (j) + 6 < 128) SA_LOAD(SX, 2 * (j) + 6); SA_WRITE(SY, bufn, 1); if (2 * (j) + 7 < 128) SA_LOAD(SY, 2 * (j) + 7); } \
        else if ((j) + 1 == 64 && half == 1) { \
            const char* cbn = (const char*)((const bf16_t*)(ws + WS_CB) + (size_t)(MP + b * DS) * KVR); const char* krn = (const char*)((const bf16_t*)(ws + WS_KRBS) + (size_t)(b * DS) * ROPE); \
            const int lz_ = tid - 256; \
            _Pragma("unroll") for (int hh = 0; hh < 2; ++hh) { \
                _Pragma("unroll") for (int e = 0; e < 4; ++e) { const int key = ((lz_ + 256 * e) >> 5) + 32 * hh; u32x4 z = {0u, 0u, 0u, 0u}; if (key < DS) z = *(const u32x4*)(cbn + (glb[e] >> 1)); *(LAS u32x4*)(lds + (bufn) + llb[e][hh]) = z; } \
                { const int key = (lz_ >> 3) + 32 * hh; u32x4 z = {0u, 0u, 0u, 0u}; if (key < DS) z = *(const u32x4*)(krn + (grb >> 1)); *(LAS u32x4*)(lds + (bufn) + lrb[hh]) = z; } } } } while (0)
#define SA_BAR() do { asm volatile("s_waitcnt lgkmcnt(0)" ::: "memory"); __builtin_amdgcn_s_barrier(); asm volatile("" ::: "memory"); } while (0)
    float* ml = (float*)(ws + WS_ML) + (size_t)(b * 2 + half) * 64 * 2;
    if (is_cmp) {
        SA_BAR();
        f32x16 O[8];
#pragma unroll
        for (int vt = 0; vt < 8; ++vt)
#pragma unroll
            for (int i = 0; i < 16; ++i) O[vt][i] = 0.f;
        float mrun = -1e30f, lrun = 0.f;
        int bo = 0;
        for (int j = 0; j < 64; ++j) {
            SA_COMPUTE(j, bo);
            bo = SA_BUF - bo;
            SA_BAR();
        }
        if (half == 1) { SA_COMPUTE(64, bo); SA_BAR(); }
        LAS float* xo = (LAS float*)(lds + qt * 32768); LAS float* xm = (LAS float*)(lds + 65536 + qt * 512);
        if (kb == 1) { xm[2 * lane] = mrun; xm[2 * lane + 1] = lrun;
#pragma unroll
            for (int vt = 0; vt < 8; ++vt)
#pragma unroll
                for (int i = 0; i < 16; ++i) xo[(vt * 16 + i) * 64 + lane] = O[vt][i]; }
        SA_BAR();
        if (kb == 0) {
            const float m1 = xm[2 * lane], l1 = xm[2 * lane + 1], mm = fmaxf(mrun, m1);
            const float a0 = __builtin_amdgcn_exp2f(mrun - mm), a1 = __builtin_amdgcn_exp2f(m1 - mm);
            const float ll = lrun * a0 + l1 * a1, lt = ll + __shfl_xor(ll, 32);
            const int q = 32 * qt + r32;
            if (g == 0) { ml[q * 2] = mm; ml[q * 2 + 1] = lt; }
#pragma unroll
            for (int vt = 0; vt < 8; ++vt) {
                float o[16];
#pragma unroll
                for (int i = 0; i < 16; ++i) o[i] = O[vt][i] * a0 + xo[(vt * 16 + i) * 64 + lane] * a1;
#pragma unroll
                for (int jq = 0; jq < 4; ++jq) { u32x2 w; w.x = pk2(o[4 * jq], o[4 * jq + 1]); w.y = pk2(o[4 * jq + 2], o[4 * jq + 3]);
                    *(LAS u32x2*)(lds + SA_OI + q * SA_QI_PITCH + (32 * vt + 8 * jq + 4 * g) * 2) = w; }
            }
        }
    } else {
        unsigned glb[4], llb[4][2], grb, lrb[2];
        { const int lz_ = tid - 256;
#pragma unroll
          for (int e = 0; e < 4; ++e) { const int gi = lz_ + 256 * e, key = gi >> 5, cg = gi & 31; glb[e] = (unsigned)(key * KVR + cg * 8) * 4u;
#pragma unroll
              for (int hh = 0; hh < 2; ++hh) llb[e][hh] = (unsigned)((cg >> 4) * 16384 + sa_off(key + 32 * hh, cg & 15)); }
          grb = (unsigned)((lz_ >> 3) * ROPE + (lz_ & 7) * 8) * 4u;
#pragma unroll
          for (int hh = 0; hh < 2; ++hh) lrb[hh] = (unsigned)(SA_KR + ((lz_ >> 3) + 32 * hh) * 144 + (lz_ & 7) * 16); }
        f32x4 s0[10], s1[10], s2[10], s3[10];
        SA_LOAD(s0, 0); SA_LOAD(s1, 1); SA_LOAD(s2, 2); SA_LOAD(s3, 3);
        SA_WRITE(s0, 0, 0); SA_LOAD(s0, 4); SA_WRITE(s1, 0, 1); SA_LOAD(s1, 5);
        SA_BAR();
        for (int j = 0; j < 64; j += 2) {
            SA_LOADER(j, s2, s3, SA_BUF);
            SA_BAR();
            SA_LOADER(j + 1, s0, s1, 0);
            SA_BAR();
        }
        if (half == 1) SA_BAR();
        SA_BAR();
    }
#undef SA_BAR
#undef SA_LOAD
#undef SA_WRITE
#undef SA_COMPUTE
#undef SA_KLD
#undef SA_VLD
#undef SA_VMM
#undef SA_LOADER

    float* parto = (float*)(ws + WS_PART) + (size_t)(b * 2 + half) * 64 * 128;
    __syncthreads();
    { bf16x8 ao[16];
#pragma unroll
      for (int ks = 0; ks < 16; ++ks) { u32x4 z = {0u, 0u, 0u, 0u}; if (r32 < DS) z = *(const LAS u32x4*)(lds + SA_OI + (r32 * 8 + wave) * SA_QI_PITCH + (16 * ks + 8 * g) * 2); ao[ks] = __builtin_bit_cast(bf16x8, z); }
      const bf16_t* wv = (const bf16_t*)(ws + WS_WUVT) + (size_t)(wave * VD + r32) * KVR + 8 * g;
#pragma unroll 2
      for (int nt = 0; nt < 4; ++nt) {
          f32x16 acc;
#pragma unroll
          for (int i = 0; i < 16; ++i) acc[i] = 0.f;
#pragma unroll
          for (int ks = 0; ks < 16; ++ks) acc = __builtin_amdgcn_mfma_f32_32x32x16_bf16(ao[ks], *(const bf16x8*)(wv + (size_t)(32 * nt) * KVR + 16 * ks), acc, 0, 0, 0);
#pragma unroll
          for (int i = 0; i < 4; ++i) parto[(size_t)((i + 4 * g) * 8 + wave) * 128 + 32 * nt + r32] = acc[i];
      } }
}

template <int W>
__device__ __forceinline__ void pool_chunk(const float* __restrict__ xr, int rvb, f32x4 gn, int col, int t0, bf16_t* __restrict__ drow) {
    f32x4 ring[W - 1]; f32x4 sum = {0.f, 0.f, 0.f, 0.f};
#pragma unroll
    for (int i = W - 1; i >= 1; --i) { f32x4 u = {0.f, 0.f, 0.f, 0.f};
        if (t0 - i >= 0) u = *(const f32x4*)(xr - (size_t)i * D + col) * __builtin_bit_cast(float, __builtin_amdgcn_readlane(rvb, 15 - i));
        ring[(W - 1 - i) % (W - 1)] = u; sum += u; }
#pragma unroll
    for (int r = 0; r < 16; ++r) {
        const f32x4 u = *(const f32x4*)(xr + (size_t)r * D + col) * __builtin_bit_cast(float, __builtin_amdgcn_readlane(rvb, 15 + r));
        sum += u;
        const int t = t0 + r; const float icnt = 1.0f / (float)((t + 1) < W ? (t + 1) : W);
        const f32x4 dd = (sum * icnt - u) * gn;
        u32x2 o; o.x = pk2(dd.x, dd.y); o.y = pk2(dd.z, dd.w);
        *(u32x2*)(drow + (size_t)r * D + col) = o;
        sum -= ring[r % (W - 1)]; ring[r % (W - 1)] = u;
    }
}
constexpr int NPH = 17;
__global__ void __launch_bounds__(512, 2) yoco_fwd(Params P) {
    extern __shared__ __attribute__((aligned(16))) unsigned char lds_raw[];
    LAS unsigned char* lds = (LAS unsigned char*)lds_raw;
    volatile LAS unsigned* MISC = (volatile LAS unsigned*)(lds + MISC_OFF);
    const int tid = threadIdx.x, lane = tid & 63, wave = __builtin_amdgcn_readfirstlane(tid >> 6);
    const int G = gridDim.x; const int bx = blockIdx.x; const int vcu = (G % 8 == 0) ? (bx % 8) * (G / 8) + bx / 8 : bx;
    unsigned char* ws = P.ws; float* out = P.out;
    for (int u = tid; u < 64; u += 512) MISC[u] = 0u;
    __syncthreads();
    XcdBarrier bar; bar.bar = (unsigned*)(ws + WS_CTL) + CW_BAR; bar.x = 0; bar.st = nullptr;
    if (MK_N_LAUNCHES == 1) bar = xcd_barrier_post((unsigned*)(ws + WS_CTL) + CW_BAR, MISC + 8);
    const int lo = P.ph_lo, hi = P.ph_hi;
#ifndef PH_MASK
#define PH_MASK 0xFFFFFFFFu
#endif
#define IN(k) (((PH_MASK >> (k)) & 1u) && lo <= (k) && (k) < hi)
#define SEAM(k) do { if (IN(k) && IN((k) + 1)) xcd_barrier(bar); } while (0)
#define SEAM2(k, kn) do { if (IN(k) && IN(kn)) xcd_barrier(bar); } while (0)
    const int gw = vcu * 8 + wave, NGW = G * 8;
    const int gtid = vcu * 512 + tid, NGT = G * 512;

#define wpool ((bf16_t*)(ws + WS_WPOOL))
#define wup ((bf16_t*)(ws + WS_WUP))
#define wdown ((bf16_t*)(ws + WS_WDOWN))
#define wgate ((bf16_t*)(ws + WS_WGATE))
#define wproj ((bf16_t*)(ws + WS_WPROJ))
#define wdkvq ((bf16_t*)(ws + WS_WDKVQ))
#define wuq ((bf16_t*)(ws + WS_WUQ))
#define wukt ((bf16_t*)(ws + WS_WUKT))
#define wuvt ((bf16_t*)(ws + WS_WUVT))
#define wukb ((bf16_t*)(ws + WS_WUKB))
#define wo ((bf16_t*)(ws + WS_WO))
#define cs ((float*)(ws + WS_CS))
#define rstd0 ((float*)(ws + WS_RSTD0))
#define dbuf ((bf16_t*)(ws + WS_DBUF))
#define pb ((bf16_t*)(ws + WS_PB))
#define hbA ((bf16_t*)(ws + WS_HBA))
#define hbB ((bf16_t*)(ws + WS_HBB))
#define ssq ((float*)(ws + WS_SSQ))
#define abuf ((bf16_t*)(ws + WS_ABUF))
#define proj ((bf16_t*)(ws + WS_PROJ))
#define raw ((float*)(ws + WS_RAW))
#define cb ((bf16_t*)(ws + WS_CB))
#define krbs ((bf16_t*)(ws + WS_KRBS))
#define cqb ((bf16_t*)(ws + WS_CQB))
#define rstdq ((float*)(ws + WS_RSTDQ))
#define qbuf ((bf16_t*)(ws + WS_QBUF))
#define qs ((bf16_t*)(ws + WS_QS))
#define kfull ((bf16_t*)(ws + WS_KFULL))
#define vt ((bf16_t*)(ws + WS_VT))
#define obuf ((bf16_t*)(ws + WS_OBUF))
    constexpr size_t SSQ_V = (size_t)M * 16;

    if (IN(0)) {
        LAS float* scr = (LAS float*)(lds + wave * 16384);
        int it = gw;
#define TI(W_, ks_, K_, N_, WT_, ro_) { const int n_items = ((K_) / 64) * ((N_) / 32); for (; it < n_items; it += NGW) transpose_item(W_, ks_, K_, N_, WT_, ro_, scr, it, lane); it -= n_items; }
        TI(P.in[I_POOLW] + 0 * 65536, nullptr, 256, 256, wpool, 0) TI(P.in[I_POOLW] + 1 * 65536, nullptr, 256, 256, wpool, 256)
        TI(P.in[I_POOLW] + 2 * 65536, nullptr, 256, 256, wpool, 512) TI(P.in[I_POOLW] + 3 * 65536, nullptr, 256, 256, wpool, 768)
        TI(P.in[I_WUP], P.in[I_NMLP], D, FF, wup, 0) TI(P.in[I_WUP] + (size_t)D * FF, P.in[I_NMLP] + D, D, FF, wup + (size_t)FF * D, 0)
        TI(P.in[I_WDOWN], nullptr, FF, D, wdown, 0) TI(P.in[I_WDOWN] + (size_t)D * FF, nullptr, FF, D, wdown + (size_t)FF * D, 0)
        TI(P.in[I_WGATE], P.in[I_NPLE], D, D, wgate, 0) TI(P.in[I_WGATE] + (size_t)D * D, P.in[I_NPLE] + D, D, D, wgate + (size_t)D * D, 0)
        TI(P.in[I_WPROJ], nullptr, PLE, D, wproj, 0) TI(P.in[I_WPROJ] + (size_t)PLE * D, nullptr, PLE, D, wproj + (size_t)PLE * D, 0)
        TI(P.in[I_WDKV], P.in[I_NKV], D, 320, wdkvq, 0) TI(P.in[I_WDQ], P.in[I_NMIX] + D, D, QR, wdkvq, 320)
        { const int n_items = (QR / 64) * (NH * QH / 32); for (; it < n_items; it += NGW) transpose_item<true>(P.in[I_WUQ], P.in[I_QN], QR, NH * QH, wuq, 0, scr, it, lane); it -= n_items; }
        TI(P.in[I_WUK], nullptr, KVR, 1024, wukt, 0) TI(P.in[I_WUV], nullptr, KVR, 1024, wuvt, 0)
        TI(P.in[I_WO], nullptr, D, D, wo, 0)
#undef TI
        for (int i = gtid; i < 64 * D / 8; i += NGT) *(u32x4*)(wdkvq + (size_t)704 * D + (size_t)i * 8) = (u32x4){0u, 0u, 0u, 0u};
        for (int i = gtid; i < 256 * 1024 / 8; i += NGT) { const f32x4 a = *(const f32x4*)(P.in[I_WUK] + (size_t)i * 8), c = *(const f32x4*)(P.in[I_WUK] + (size_t)i * 8 + 4); *(bf16x8*)(wukb + (size_t)i * 8) = pack8v(a, c); }
        for (int i = gtid; i < NPOS * 32; i += NGT) { const int pos = i >> 5, f = i & 31; const double inv = exp2(-(double)f * (13.287712379549449 / 32.0)); const double ang = (double)pos * inv;
            double sn, cn; sincos(ang, &sn, &cn); cs[(size_t)pos * 64 + f] = (float)cn; cs[(size_t)pos * 64 + 32 + f] = (float)sn; }
        for (int i = gtid; i < 2 * M * PLE / 8; i += NGT) { const int li = i / (M * PLE / 8), r8 = i % (M * PLE / 8); const size_t e = (size_t)r8 * 8; const int row = (int)(e / PLE), c = (int)(e % PLE);
            const float* src = row < MP ? P.in[I_PP] + ((size_t)li * MP + row) * PLE + c : P.in[I_PS] + ((size_t)li * MS + (row - MP)) * PLE + c;
            *(bf16x8*)(pb + ((size_t)li * M + row) * PLE + c) = pack8v(*(const f32x4*)src, *(const f32x4*)(src + 4)); }
        for (int row0 = gw; row0 < M; row0 += 2 * NGW) {
            f32x4 v[2][4];
#pragma unroll
            for (int rr = 0; rr < 2; ++rr) { const int row = row0 + rr * NGW; if (row < M) { const float* xr = row < MP ? P.in[I_XP] + (size_t)row * D : P.in[I_XS] + (size_t)(row - MP) * D;
#pragma unroll
                for (int j = 0; j < 4; ++j) v[rr][j] = ((const f32x4*)xr)[lane + 64 * j]; } }
#pragma unroll
            for (int rr = 0; rr < 2; ++rr) { const int row = row0 + rr * NGW; if (row < M) {
                float s = 0.f;
#pragma unroll
                for (int j = 0; j < 4; ++j) s += (v[rr][j].x * v[rr][j].x + v[rr][j].y * v[rr][j].y) + (v[rr][j].z * v[rr][j].z + v[rr][j].w * v[rr][j].w);
                const float rstd = 1.0f / sqrtf(wave_sum(s) * (1.0f / D) + EPS);
                if (lane == 0) rstd0[row] = rstd;
                float* po = nullptr;
                if (row < MP) { const int b = row >> 13, t = row & (SEQ - 1); if (t >= SEQ - 15) po = out + O_PP + ((size_t)b * 15 + (t - (SEQ - 15))) * D; }
                else { const int rs_ = row - MP, b = rs_ >> 3, t = rs_ & 7; po = out + O_PS + ((size_t)b * 15 + 7 + t) * D; }
                if (po) {
#pragma unroll
                    for (int j = 0; j < 4; ++j) { const f32x4 gn = ((const f32x4*)P.in[I_NMIX])[lane + 64 * j]; ((f32x4*)po)[lane + 64 * j] = v[rr][j] * rstd * gn; } }
            } }
        }
        for (int i = gtid; i < DB * 7 * D / 4; i += NGT) { const int b = i / (7 * D / 4), r = (i / (D / 4)) % 7, c = i % (D / 4);
            ((f32x4*)(out + O_PS + ((size_t)b * 15 + r) * D))[c] = ((const f32x4*)(P.in[I_SPOOL] + ((size_t)b * 15 + 8 + r) * D))[c]; }
    }
    SEAM(0);
    if (IN(1)) {
        for (int it = gw; it < (MP / 16) * 2; it += NGW) {
            const int chunk = it >> 1, hs = it & 1, row0 = chunk * 16, t0 = row0 & (SEQ - 1);
            const float rv = (lane < 31 && t0 - 15 + lane >= 0) ? rstd0[row0 - 15 + lane] : 0.f;
            const int rvb = __builtin_bit_cast(int, rv);
            const float* xr = P.in[I_XP] + (size_t)row0 * D; bf16_t* dr = dbuf + (size_t)row0 * D;
            if (hs == 0) { pool_chunk<2>(xr, rvb, *(const f32x4*)(P.in[I_NMIX] + 4 * lane), 4 * lane, t0, dr);
                           pool_chunk<16>(xr, rvb, *(const f32x4*)(P.in[I_NMIX] + 768 + 4 * lane), 768 + 4 * lane, t0, dr); }
            else         { pool_chunk<4>(xr, rvb, *(const f32x4*)(P.in[I_NMIX] + 256 + 4 * lane), 256 + 4 * lane, t0, dr);
                           pool_chunk<8>(xr, rvb, *(const f32x4*)(P.in[I_NMIX] + 512 + 4 * lane), 512 + 4 * lane, t0, dr); }
        }
        for (int row = MP + gw; row < M; row += NGW) {
            const bool isp = row < MP; const int t = isp ? (row & (SEQ - 1)) : ((row - MP) & 7); const int bs = isp ? 0 : ((row - MP) >> 3);
            const float* sp = P.in[I_SPOOL] + (size_t)bs * 15 * D;
            const float* xr = isp ? P.in[I_XP] + (size_t)row * D : P.in[I_XS] + (size_t)(row - MP) * D;
            const float rv = (lane < 16 && t - lane >= 0) ? rstd0[row - lane] : 0.f;
#pragma unroll
            for (int j = 0; j < 4; ++j) {
                const int w = 2 << j; const int col = 256 * j + 4 * lane;
                const f32x4 gn = *(const f32x4*)(P.in[I_NMIX] + col);
                const f32x4 u0 = *(const f32x4*)(xr + col) * __shfl(rv, 0); f32x4 sum = u0, hist = {0.f, 0.f, 0.f, 0.f};
#pragma unroll
                for (int i = 1; i < w; ++i) { const int tt = t - i; const float ri = __shfl(rv, i);
                    if (tt >= 0) sum += *(const f32x4*)(xr - (size_t)i * D + col) * ri;
                    else if (!isp) hist += *(const f32x4*)(sp + (size_t)(15 + tt) * D + col); }
                const float cnt = isp ? (float)((t + 1) < w ? (t + 1) : w) : (float)w;
                const f32x4 dd = (sum * gn + hist) / cnt - u0 * gn;
                u32x2 o; o.x = pk2(dd.x, dd.y); o.y = pk2(dd.z, dd.w);
                *(u32x2*)(dbuf + (size_t)row * D + col) = o;
            }
        }
    }
    SEAM(1);
    if (IN(2)) {
#ifndef SUBM
#define SUBM 7
#endif
        { SgH<0> E{P.in[I_XS], P.in[I_POOLSC], nullptr, nullptr, nullptr, hbA, ssq + 0 * SSQ_V};
          for (int u = vcu; u < 256; u += G) sg_gemm<4, 1>(lds, dbuf + (size_t)MP * D, D, 256, wpool, 256, u, E, tid, wave, lane); }
        { SgBf E{proj, D};
          for (int u = vcu; u < 256; u += G) sg_gemm<4, 1>(lds, pb + (size_t)MP * PLE, PLE, 0, wproj, PLE, u, E, tid, wave, lane); }
        { SgBf E{proj + (size_t)M * D, D};
          for (int u = vcu; u < 256; u += G) sg_gemm<4, 1>(lds, pb + (size_t)(M + MP) * PLE, PLE, 0, wproj + (size_t)PLE * D, PLE, u, E, tid, wave, lane); }
        if (SUBM & 1) { pg8::Gemm g{dbuf, wpool, MP, D, 256, D, 256}; pg8::StaticOrder S; S.init(MP, D, G, bx);
          EpiH<0> E{P.in[I_XP], P.in[I_XS], P.in[I_POOLSC], nullptr, nullptr, nullptr, hbA, ssq + 0 * SSQ_V};
          pg8::gemm_phase(lds, g, S, E); }
        if (SUBM & 2) { pg8::Gemm g{pb, wproj, MP, D, PLE, PLE, 0}; pg8::StaticOrder S; S.init(MP, D, G, bx);
          EpiBf E{proj, D};
          pg8::gemm_phase(lds, g, S, E); }
        if (SUBM & 4) { pg8::Gemm g{pb + (size_t)M * PLE, wproj + (size_t)PLE * D, MP, D, PLE, PLE, 0}; pg8::StaticOrder S; S.init(MP, D, G, bx);
          EpiBf E{proj + (size_t)M * D, D};
          pg8::gemm_phase(lds, g, S, E); }
    }
    SEAM(2);
    if (IN(3)) {
        { SgUp E{ssq + 0 * SSQ_V, abuf}; for (int u = vcu; u < 256; u += G) sg_gemm<4, 4>(lds, hbA + (size_t)MP * D, D, 0, wup, D, u, E, tid, wave, lane); }
        pg8::Gemm g{hbA, wup, MP, FF, D, D, 0}; pg8::StaticOrder S; S.init(MP, FF, G, bx); EpiUp E{ssq + 0 * SSQ_V, abuf}; pg8::gemm_phase(lds, g, S, E); }
    SEAM(3);
    if (IN(4)) {
        { SgH<1> E{nullptr, nullptr, nullptr, nullptr, hbA, hbB, ssq + 1 * SSQ_V}; for (int u = vcu; u < 256; u += G) sg_gemm<4, 1>(lds, abuf + (size_t)MP * FF, FF, 0, wdown, FF, u, E, tid, wave, lane); }
        pg8::Gemm g{abuf, wdown, MP, D, FF, FF, 0}; pg8::StaticOrder S; S.init(MP, D, G, bx);
        EpiH<1> E{nullptr, nullptr, nullptr, nullptr, nullptr, hbA, hbB, ssq + 1 * SSQ_V}; pg8::gemm_phase(lds, g, S, E); }
    SEAM(4);
    if (IN(5)) {
        { SgH<2> E{nullptr, nullptr, ssq + 1 * SSQ_V, proj, hbB, hbA, ssq + 2 * SSQ_V}; for (int u = vcu; u < 256; u += G) sg_gemm<4, 1>(lds, hbB + (size_t)MP * D, D, 0, wgate, D, u, E, tid, wave, lane); }
        pg8::Gemm g{hbB, wgate, MP, D, D, D, 0}; pg8::StaticOrder S; S.init(MP, D, G, bx);
        EpiH<2> E{nullptr, nullptr, nullptr, ssq + 1 * SSQ_V, proj, hbB, hbA, ssq + 2 * SSQ_V}; pg8::gemm_phase(lds, g, S, E); }
    SEAM(5);
    if (IN(6)) {
        { SgF32<1> E{raw, NDKVQ, ssq + 2 * SSQ_V}; for (int u = vcu; u < 256; u += G) sg_gemm<3, 1>(lds, hbA + (size_t)MP * D, D, 0, wdkvq, D, u, E, tid, wave, lane); }
        pg8::Gemm g{hbA, wdkvq, MP, NDKVQ, D, D, 0}; pg8::StaticOrder S; S.init(MP, NDKVQ, G, bx); EpiF32<1> E{raw, NDKVQ, ssq + 2 * SSQ_V}; pg8::gemm_phase(lds, g, S, E); }
    SEAM(6);
    if (IN(7)) {
        const f32x4 kvn = ((const f32x4*)P.in[I_KVN])[lane];
        for (int row0 = 2 * gw; row0 < M; row0 += 2 * NGW) {
            f32x4 c4[2], k1[2], k2[2], cn_[2], sn_[2]; f32x2 q2[2][3];
            const int l8 = lane & 7, hh = lane >> 3;
#pragma unroll
            for (int e = 0; e < 2; ++e) { const int row = row0 + e; const float* rr = raw + (size_t)row * NDKVQ;
                const int pos = row < MP ? (row & (SEQ - 1)) : PAST + ((row - MP) & 7);
                c4[e] = ((const f32x4*)rr)[lane];
                k1[e] = *(const f32x4*)(rr + 256 + 4 * l8); k2[e] = *(const f32x4*)(rr + 288 + 4 * l8);
                cn_[e] = *(const f32x4*)(cs + (size_t)pos * 64 + 4 * l8); sn_[e] = *(const f32x4*)(cs + (size_t)pos * 64 + 32 + 4 * l8);
#pragma unroll
                for (int k = 0; k < 3; ++k) q2[e][k] = *(const f32x2*)(rr + 320 + 2 * lane + 128 * k); }
#pragma unroll
            for (int e = 0; e < 2; ++e) { const int row = row0 + e; const bool isp = row < MP;
                const float sc = wave_sum((c4[e].x * c4[e].x + c4[e].y * c4[e].y) + (c4[e].z * c4[e].z + c4[e].w * c4[e].w));
                const float rc = 1.0f / sqrtf(sc * (1.0f / KVR) + EPS);
                const f32x4 cn = c4[e] * rc * kvn;
                float* lo_ = isp ? out + O_LP + (size_t)row * KVR : out + O_LS + (size_t)(row - MP) * KVR;
                ((f32x4*)lo_)[lane] = cn;
                { u32x2 o; o.x = pk2(cn.x, cn.y); o.y = pk2(cn.z, cn.w); ((u32x2*)(cb + (size_t)row * KVR))[lane] = o; }
                const f32x4 o1 = k1[e] * cn_[e] - k2[e] * sn_[e], o2 = k2[e] * cn_[e] + k1[e] * sn_[e];
                u32x2 w1, w2; w1.x = pk2(o1.x, o1.y); w1.y = pk2(o1.z, o1.w); w2.x = pk2(o2.x, o2.y); w2.y = pk2(o2.z, o2.w);
                if (hh == 0) { float* ko = isp ? out + O_KP + (size_t)row * ROPE : out + O_KS + (size_t)(row - MP) * ROPE; *(f32x4*)(ko + 4 * l8) = o1; *(f32x4*)(ko + 32 + 4 * l8) = o2;
                    if (!isp) { bf16_t* kd = krbs + (size_t)(row - MP) * ROPE; *(u32x2*)(kd + 4 * l8) = w1; *(u32x2*)(kd + 32 + 4 * l8) = w2; } }
                if (isp) { const int b = row >> 13, t = row & (SEQ - 1); bf16_t* kd = kfull + ((size_t)(b * NH + hh) * SEQ + t) * QH + NOPE; *(u32x2*)(kd + 4 * l8) = w1; *(u32x2*)(kd + 32 + 4 * l8) = w2; }
                float s = 0.f;
#pragma unroll
                for (int k = 0; k < 3; ++k) s += q2[e][k].x * q2[e][k].x + q2[e][k].y * q2[e][k].y;
                s = wave_sum(s);
                if (lane == 0) rstdq[row] = 1.0f / sqrtf(s * (1.0f / QR) + EPS);
#pragma unroll
                for (int k = 0; k < 3; ++k) *(unsigned*)(cqb + (size_t)row * QR + 2 * lane + 128 * k) = pk2(q2[e][k].x, q2[e][k].y); }
        }
    }
    SEAM(7);
    if (IN(8)) {
        { SgQ E{rstdq, cs, qbuf, qs}; for (int u = vcu; u < 256; u += G) sg_gemm<3, 2>(lds, cqb + (size_t)MP * QR, QR, 0, wuq, QR, u, E, tid, wave, lane); }
        if (SUBM & 1) { pg8::Gemm g{cqb, wuq, MP, NH * QH, QR, QR, 0}; pg8::StaticOrder S; S.init(MP, NH * QH, G, bx); EpiQ E{rstdq, cs, qbuf}; pg8::gemm_phase(lds, g, S, E); }
        if (SUBM & 2) { pg8::Gemm g{cb, wukt, MP, 1024, KVR, KVR, 0}; pg8::StaticOrder S; S.init(MP, 1024, G, (bx + 128) % G); EpiKup E{kfull}; pg8::gemm_phase(lds, g, S, E); }
        if (SUBM & 4) { pg8::Gemm g{wuvt, cb, 1024, MP, KVR, KVR, 0}; pg8::StaticOrder S; S.init(1024, MP, G, (bx + 128) % G); EpiVup E{vt}; pg8::gemm_phase(lds, g, S, E); }
    }
    SEAM2(8, 10);
    if (IN(10)) {
        const bool sfirst = (bx >> 3) & 1;
        if (sfirst) for (int it = vcu; it < 2 * DB; it += G) sattn_item(P, it >> 1, it & 1, lds, tid, wave, lane);
        for (int u = vcu; u < 256; u += G) {
            const int bh = u >> 4, p = u & 15;
            attn_prompt_unit(qbuf, kfull, vt, obuf, bh >> 3, bh & 7, 31 - p, lds, tid, wave, lane);
            attn_prompt_unit(qbuf, kfull, vt, obuf, bh >> 3, bh & 7, p, lds, tid, wave, lane);
        }
        if (!sfirst) for (int it = vcu; it < 2 * DB; it += G) sattn_item(P, it >> 1, it & 1, lds, tid, wave, lane);
    }
    SEAM2(10, 12);
    if (IN(12)) {
        { SgH<1> E{nullptr, nullptr, nullptr, nullptr, hbA, hbB, ssq + 3 * SSQ_V}; const SgALoadComb AL{(const float*)(ws + WS_PART), (const float*)(ws + WS_ML)};
          for (int u = vcu; u < 256; u += G) sg_gemm_l<4, 1>(lds, AL, 0, wo, D, u, E, tid, wave, lane); }
        pg8::Gemm g{obuf, wo, MP, D, D, D, 0}; pg8::StaticOrder S; S.init(MP, D, G, bx);
        EpiH<1> E{nullptr, nullptr, nullptr, nullptr, nullptr, hbA, hbB, ssq + 3 * SSQ_V}; pg8::gemm_phase(lds, g, S, E); }
    SEAM(12);
    if (IN(13)) {
        { SgUp E{ssq + 3 * SSQ_V, abuf}; for (int u = vcu; u < 256; u += G) sg_gemm<4, 4>(lds, hbB + (size_t)MP * D, D, 0, wup + (size_t)FF * D, D, u, E, tid, wave, lane); }
        pg8::Gemm g{hbB, wup + (size_t)FF * D, MP, FF, D, D, 0}; pg8::StaticOrder S; S.init(MP, FF, G, bx); EpiUp E{ssq + 3 * SSQ_V, abuf}; pg8::gemm_phase(lds, g, S, E); }
    SEAM(13);
    if (IN(14)) {
        { SgH<1> E{nullptr, nullptr, nullptr, nullptr, hbB, hbA, ssq + 4 * SSQ_V}; for (int u = vcu; u < 256; u += G) sg_gemm<4, 1>(lds, abuf + (size_t)MP * FF, FF, 0, wdown + (size_t)FF * D, FF, u, E, tid, wave, lane); }
        pg8::Gemm g{abuf, wdown + (size_t)FF * D, MP, D, FF, FF, 0}; pg8::StaticOrder S; S.init(MP, D, G, bx);
        EpiH<1> E{nullptr, nullptr, nullptr, nullptr, nullptr, hbB, hbA, ssq + 4 * SSQ_V}; pg8::gemm_phase(lds, g, S, E); }
    SEAM(14);
    if (IN(15)) {
        { SgH<2> E{nullptr, nullptr, ssq + 4 * SSQ_V, proj + (size_t)M * D, hbA, hbB, ssq + 5 * SSQ_V}; for (int u = vcu; u < 256; u += G) sg_gemm<4, 1>(lds, hbA + (size_t)MP * D, D, 0, wgate + (size_t)D * D, D, u, E, tid, wave, lane); }
        pg8::Gemm g{hbA, wgate + (size_t)D * D, MP, D, D, D, 0}; pg8::StaticOrder S; S.init(MP, D, G, bx);
        EpiH<2> E{nullptr, nullptr, nullptr, ssq + 4 * SSQ_V, proj + (size_t)M * D, hbA, hbB, ssq + 5 * SSQ_V}; pg8::gemm_phase(lds, g, S, E); }
    SEAM(15);
    if (IN(16)) {
        f32x4 gn[4];
#pragma unroll
        for (int j = 0; j < 4; ++j) gn[j] = ((const f32x4*)P.in[I_NFIN])[lane + 64 * j];
        for (int row0 = 4 * gw; row0 < M; row0 += 4 * NGW) {
            u32x2 hv[4][4]; float sp[4];
#pragma unroll
            for (int e = 0; e < 4; ++e) { sp[e] = (lane < 16) ? ssq[5 * SSQ_V + (size_t)(row0 + e) * 16 + lane] : 0.f;
#pragma unroll
                for (int j = 0; j < 4; ++j) hv[e][j] = ((const u32x2*)(hbB + (size_t)(row0 + e) * D))[lane + 64 * j]; }
#pragma unroll
            for (int e = 0; e < 4; ++e) { const float rstd = 1.0f / sqrtf(wave_sum(sp[e]) * (1.0f / D) + EPS);
#pragma unroll
                for (int j = 0; j < 4; ++j) ((f32x4*)(out + O_Y + (size_t)(row0 + e) * D))[lane + 64 * j] = unpk4(hv[e][j]) * rstd * gn[j]; }
        }
    }
#undef IN
#undef SEAM
#undef SEAM2
#undef wpool
#undef wup
#undef wdown
#undef wgate
#undef wproj
#undef wdkvq
#undef wuq
#undef wukt
#undef wuvt
#undef wukb
#undef wo
#undef cs
#undef rstd0
#undef dbuf
#undef pb
#undef hbA
#undef hbB
#undef ssq
#undef abuf
#undef proj
#undef raw
#undef cb
#undef krbs
#undef cqb
#undef rstdq
#undef qbuf
#undef qs
#undef kfull
#undef vt
#undef obuf
}

extern "C" void kernel_launch(void* const* d_in, const int* in_sizes, int n_in, void* d_out, int out_size, void* d_ws, size_t ws_size, hipStream_t stream) {
    static int grid = 0;
    if (grid == 0) {
        if (n_in != 27 || (size_t)out_size != O_END || ws_size < WS_END) { fprintf(stderr, "kernel_launch: shape mismatch (n_in %d, out %d, ws %zu; need 27, %zu, %zu)\n", n_in, out_size, ws_size, (size_t)O_END, (size_t)WS_END); grid = -1; return; }
        int dev = 0, cus = 0, per_cu = 0;
        if (hipGetDevice(&dev) != hipSuccess || hipDeviceGetAttribute(&cus, hipDeviceAttributeMultiprocessorCount, dev) != hipSuccess) { grid = -1; return; }
        if (hipFuncSetAttribute((const void*)yoco_fwd, hipFuncAttributeMaxDynamicSharedMemorySize, LDS_BYTES) != hipSuccess) { fprintf(stderr, "kernel_launch: hipFuncSetAttribute failed\n"); grid = -1; return; }
        if (hipOccupancyMaxActiveBlocksPerMultiprocessor(&per_cu, (const void*)yoco_fwd, 512, LDS_BYTES) != hipSuccess || per_cu < 1) fprintf(stderr, "kernel_launch: occupancy query reports %d\n", per_cu);
        (void)hipGetLastError();
        grid = cus;
    }
    if (grid < 0) return;
    (void)hipMemsetAsync((char*)d_ws + WS_CTL, 0, CTL_BYTES, stream);
    Params p{};
    for (int i = 0; i < 27; ++i) p.in[i] = (const float*)d_in[i];
    p.out = (float*)d_out; p.ws = (unsigned char*)d_ws;
#if MK_N_LAUNCHES == 1
    p.ph_lo = 0; p.ph_hi = NPH;
    hipLaunchKernelGGL(yoco_fwd, dim3(grid), dim3(512), LDS_BYTES, stream, p);
#else
    for (int k = 0; k < NPH; ++k) { p.ph_lo = k; p.ph_hi = k + 1; hipLaunchKernelGGL(yoco_fwd, dim3(grid), dim3(512), LDS_BYTES, stream, p); }
#endif
    const hipError_t le = hipPeekAtLastError();
    if (le != hipSuccess) fprintf(stderr, "kernel_launch: launch failed: %s\n", hipGetErrorName(le));
}
```

```cpp
#include <hip/hip_runtime.h>
#include <cstdio>
#include <cstdint>

#ifndef MK_N_LAUNCHES
#define MK_N_LAUNCHES 1
#endif

#define GAS __attribute__((address_space(1)))
#define LAS __attribute__((address_space(3)))
typedef unsigned short bf16_t;
typedef short bf16x8 __attribute__((ext_vector_type(8)));
typedef float f32x4 __attribute__((ext_vector_type(4)));
typedef float f32x16 __attribute__((ext_vector_type(16)));
typedef unsigned u32x2 __attribute__((ext_vector_type(2)));
typedef unsigned u32x4 __attribute__((ext_vector_type(4)));

constexpr int D = 1024, FF = 4096, PLE = 256, SEQ = 8192, NBATCH = 2, DB = 128, DS = 8;
constexpr int MP = NBATCH * SEQ;
constexpr int MS = DB * DS;
constexpr int M = MP + MS;
constexpr int KVR = 256, ROPE = 64, QR = 384, NH = 8, NOPE = 128, VD = 128, QH = NOPE + ROPE;
constexpr int NDKVQ = 768;
constexpr int PAST = 8192, PAGE = 128, NPG = PAST / PAGE;
constexpr float EPS = 1e-6f;
constexpr float SM_SCALE = 0.07216878364870322f;
constexpr float LOG2E = 1.4426950408889634f;
constexpr float CEXP = SM_SCALE * LOG2E;
constexpr int NPOS = PAST + DS;

constexpr size_t O_Y = 0;
constexpr size_t O_PP = (size_t)M * D;
constexpr size_t O_PS = O_PP + (size_t)NBATCH * 15 * D;
constexpr size_t O_LP = O_PS + (size_t)DB * 15 * D;
constexpr size_t O_KP = O_LP + (size_t)MP * KVR;
constexpr size_t O_LS = O_KP + (size_t)MP * ROPE;
constexpr size_t O_KS = O_LS + (size_t)MS * KVR;
constexpr size_t O_END = O_KS + (size_t)MS * ROPE;

constexpr size_t al256(size_t x) { return (x + 255) / 256 * 256; }
constexpr size_t WS_CTL = 0, CTL_BYTES = 1u << 20;
constexpr size_t WS_WPOOL = CTL_BYTES;
constexpr size_t WS_WUP   = WS_WPOOL + al256((size_t)1024 * 256 * 2);
constexpr size_t WS_WDOWN = WS_WUP   + al256((size_t)2 * FF * D * 2);
constexpr size_t WS_WGATE = WS_WDOWN + al256((size_t)2 * FF * D * 2);
constexpr size_t WS_WPROJ = WS_WGATE + al256((size_t)2 * D * D * 2);
constexpr size_t WS_WDKVQ = WS_WPROJ + al256((size_t)2 * D * PLE * 2);
constexpr size_t WS_WUQ   = WS_WDKVQ + al256((size_t)NDKVQ * D * 2);
constexpr size_t WS_WUKT  = WS_WUQ   + al256((size_t)NH * QH * QR * 2);
constexpr size_t WS_WUVT  = WS_WUKT  + al256((size_t)1024 * 256 * 2);
constexpr size_t WS_WUKB  = WS_WUVT  + al256((size_t)1024 * 256 * 2);
constexpr size_t WS_WO    = WS_WUKB  + al256((size_t)1024 * 256 * 2);
constexpr size_t WS_CS    = WS_WO    + al256((size_t)D * D * 2);
constexpr size_t WS_RSTD0 = WS_CS    + al256((size_t)NPOS * 64 * 4);
constexpr size_t WS_DBUF  = WS_RSTD0 + al256((size_t)M * 4);
constexpr size_t WS_PB    = WS_DBUF  + al256((size_t)M * D * 2);
constexpr size_t WS_HBA   = WS_PB    + al256((size_t)2 * M * PLE * 2);
constexpr size_t WS_HBB   = WS_HBA   + al256((size_t)M * D * 2);
constexpr size_t WS_SSQ   = WS_HBB   + al256((size_t)M * D * 2);
constexpr size_t WS_ABUF  = WS_SSQ   + al256((size_t)6 * M * 16 * 4);
constexpr size_t WS_PROJ  = WS_ABUF  + al256((size_t)M * FF * 2);
constexpr size_t WS_RAW   = WS_PROJ  + al256((size_t)2 * M * D * 2);
constexpr size_t WS_CB    = WS_RAW   + al256((size_t)M * NDKVQ * 4);
constexpr size_t WS_KRBS  = WS_CB    + al256((size_t)M * KVR * 2);
constexpr size_t WS_CQB   = WS_KRBS  + al256((size_t)MS * ROPE * 2);
constexpr size_t WS_RSTDQ = WS_CQB   + al256((size_t)M * QR * 2);
constexpr size_t WS_QBUF  = WS_RSTDQ + al256((size_t)M * 4);
constexpr size_t WS_QS    = WS_QBUF  + al256((size_t)M * NH * QH * 2);
constexpr size_t WS_KFULL = WS_QS    + al256((size_t)MS * NH * 320 * 2);
constexpr size_t WS_VT    = WS_KFULL + al256((size_t)16 * SEQ * QH * 2);
constexpr size_t WS_OBUF  = WS_VT    + al256((size_t)16 * VD * SEQ * 2);
constexpr size_t WS_PART  = WS_OBUF  + al256((size_t)M * D * 2);
constexpr size_t WS_ML    = WS_PART  + al256((size_t)DB * 8 * 64 * 256 * 4);
constexpr size_t WS_END   = WS_ML    + al256((size_t)DB * 8 * 64 * 2 * 4);

constexpr int CW_BAR = 4096;

constexpr int RING_BYTES = 131072;
constexpr int LDS_BYTES = 147456;
constexpr int MISC_OFF = LDS_BYTES - 256;

typedef float f32x2 __attribute__((ext_vector_type(2)));
typedef __bf16 nbf16x2 __attribute__((ext_vector_type(2)));
__device__ __forceinline__ unsigned pk2(float lo, float hi) { const f32x2 v = {lo, hi}; return __builtin_bit_cast(unsigned, __builtin_convertvector(v, nbf16x2)); }
__device__ __forceinline__ unsigned f2bf(float f) { return pk2(f, 0.f) & 0xffffu; }
__device__ __forceinline__ float bf2f(unsigned short b) { return __builtin_bit_cast(float, ((unsigned)b) << 16); }
__device__ __forceinline__ f32x4 unpk4(u32x2 w) { f32x4 r; r.x = __builtin_bit_cast(float, w.x << 16); r.y = __builtin_bit_cast(float, w.x & 0xffff0000u); r.z = __builtin_bit_cast(float, w.y << 16); r.w = __builtin_bit_cast(float, w.y & 0xffff0000u); return r; }
__device__ __forceinline__ bf16x8 pack8(const float* v) { u32x4 w; w.x = pk2(v[0], v[1]); w.y = pk2(v[2], v[3]); w.z = pk2(v[4], v[5]); w.w = pk2(v[6], v[7]); return __builtin_bit_cast(bf16x8, w); }
__device__ __forceinline__ bf16x8 pack8v(f32x4 a, f32x4 b) { u32x4 w; w.x = pk2(a.x, a.y); w.y = pk2(a.z, a.w); w.z = pk2(b.x, b.y); w.w = pk2(b.z, b.w); return __builtin_bit_cast(bf16x8, w); }
__device__ __forceinline__ float wave_sum(float v) {
#pragma unroll
    for (int o = 1; o < 64; o <<= 1) v += __shfl_xor(v, o);
    return v;
}
__device__ __forceinline__ int crow(int r, int hi) { return (r & 3) + 8 * (r >> 2) + 4 * hi; }
#define LDS_WAIT() asm volatile("s_waitcnt lgkmcnt(0)" ::: "memory")
#define VM_WAIT() asm volatile("s_waitcnt vmcnt(0)" ::: "memory")

#define XB_TMO      128
#define XB_XCNT(j)  (256  + 64 * (j))
#define XB_XSUB(j)  (1280 + 64 * (j))
#define XB_XGEN(j)  (2304 + 64 * (j))
#define XB_TOP      3328
#define XB_TOPGEN   3392
#define XCD_BAR_WORDS 3456
#define XB_SPIN_CAP (1u << 18)
__device__ __forceinline__ unsigned xb_ld(unsigned* p)              { return __hip_atomic_load(p, __ATOMIC_RELAXED, __HIP_MEMORY_SCOPE_AGENT); }
__device__ __forceinline__ unsigned xb_add(unsigned* p, unsigned v) { return __hip_atomic_fetch_add(p, v, __ATOMIC_RELAXED, __HIP_MEMORY_SCOPE_AGENT); }
__device__ __forceinline__ unsigned xb_xcc_id() { return (unsigned)__builtin_amdgcn_s_getreg((3 << 11) | 20) & 0xFu; }
#define XB_SPIN(cond, bar) do { unsigned _sp = 0; while (cond) { __builtin_amdgcn_s_sleep(1); \
    if ((++_sp & 255u) == 0u) { if (xb_ld(&(bar)[XB_TMO])) break; if (_sp > XB_SPIN_CAP) { atomicAdd(&(bar)[XB_TMO], 1u); break; } } } } while (0)
struct XcdBarrier { unsigned* bar; unsigned x; volatile LAS unsigned* st; };
__device__ __forceinline__ XcdBarrier xcd_barrier_post(unsigned* bar, volatile LAS unsigned* st) {
    XcdBarrier b; b.bar = bar; b.x = xb_xcc_id(); b.st = st;
    if (threadIdx.x == 0) (void)xb_add(&bar[XB_XCNT(b.x)], 1u);
    return b;
}
__device__ __forceinline__ void xcd_barrier_complete(unsigned* bar, unsigned x, unsigned& nloc, unsigned& nx) {
    const unsigned G = gridDim.x * gridDim.y * gridDim.z;
    unsigned sum, cnt, mine, sp = 0u;
    for (;;) {
        sum = 0u; cnt = 0u; mine = 0u;
#pragma unroll
        for (unsigned j = 0; j < 16; ++j) { const unsigned c = xb_ld(&bar[XB_XCNT(j)]); sum += c; cnt += (c > 0u) ? 1u : 0u; mine = (j == x) ? c : mine; }
        if (sum == G) break;
        __builtin_amdgcn_s_sleep(1);
        if ((++sp & 255u) == 0u) { if (xb_ld(&bar[XB_TMO])) break; if (sp > XB_SPIN_CAP) { atomicAdd(&bar[XB_TMO], 1u); break; } }
    }
    nloc = mine > 0u ? mine : 1u; nx = cnt > 0u ? cnt : 1u;
}
__device__ __forceinline__ void xcd_barrier(const XcdBarrier& b) {
    asm volatile("s_waitcnt vmcnt(0)" ::: "memory");
    __syncthreads();
    if (threadIdx.x == 0) {
        unsigned* bar = b.bar;
        __builtin_amdgcn_s_waitcnt(0);
        unsigned nloc = b.st[0], nx = b.st[1];
        if (nloc == 0u) { xcd_barrier_complete(bar, b.x, nloc, nx); b.st[0] = nloc; b.st[1] = nx; }
        const unsigned old = xb_add(&bar[XB_XSUB(b.x)], 1u);
        const unsigned gen = old / nloc;
        if (old + 1u == (gen + 1u) * nloc) {
            __builtin_amdgcn_fence(__ATOMIC_RELEASE, "agent");
            asm volatile("s_waitcnt vmcnt(0)" ::: "memory");
            const unsigned og = xb_add(&bar[XB_TOP], 1u);
            const unsigned tg = og / nx;
            if (og + 1u == (tg + 1u) * nx) xb_add(&bar[XB_TOPGEN], 1u);
            else XB_SPIN(xb_ld(&bar[XB_TOPGEN]) == tg, bar);
            __builtin_amdgcn_fence(__ATOMIC_ACQUIRE, "agent");
            xb_add(&bar[XB_XGEN(b.x)], 1u);
            asm volatile("s_waitcnt vmcnt(0)" ::: "memory");
        } else {
            XB_SPIN(xb_ld(&bar[XB_XGEN(b.x)]) == gen, bar);
            __builtin_amdgcn_fence(__ATOMIC_ACQUIRE, "agent");
            asm volatile("s_waitcnt vmcnt(0)" ::: "memory");
        }
    }
    __syncthreads();
}

namespace pg8 {
constexpr int BM = 256, BK = 64, HALF = 128, HTB = HALF * BK * 2, STAGE_BYTES = 8 * HTB, NXCD = 8, WGM = 8;
__host__ __device__ __forceinline__ int lds_byte(int r, int c) { const int st = (r >> 4) * 2 + (c >> 5), rr = r & 15, cc = c & 31, ob = rr * 64 + cc * 2; return st * 1024 + (ob ^ (((ob >> 9) & 1) << 5)); }
__host__ __device__ __forceinline__ int perm32(int rho) { const int n = rho >> 4, i = rho & 15; return 8 * (i >> 2) + 4 * n + (i & 3); }
__host__ __device__ __forceinline__ void stage_rc(int b, int& R, int& C) { const int st = b / 1024, sb = b % 1024, swz = sb ^ (((sb >> 9) & 1) << 5); R = (st >> 1) * 16 + swz / 64; C = (st & 1) * 32 + (swz % 64) / 2; }
struct Unit { int pm, pn; };
struct Gemm { const bf16_t* A; const bf16_t* Bt; int M, N, K, lda, apn; };
struct StaticOrder {
    int nM, nN, nwg, G, c;
    __device__ void init(int M, int N, int G_, int c_) { nM = M / BM; nN = N / BM; nwg = nM * nN; G = G_; c = c_; }
    __device__ bool next(int i, Unit& u) const {
        const long L = (long)i * G + c; if (L >= nwg) return false;
        int wgid = (int)L; { const int q = nwg / NXCD, r = nwg % NXCD, xcd = wgid % NXCD, off = wgid / NXCD; wgid = (xcd < r ? xcd * (q + 1) : r * (q + 1) + (xcd - r) * q) + off; }
        const int nig = WGM * nN, gid = wgid / nig, fm = gid * WGM, gsz = (nM - fm) < WGM ? (nM - fm) : WGM;
        u.pm = fm + ((wgid % nig) % gsz); u.pn = (wgid % nig) / gsz; return true;
    }
};
template <class Epi>
__device__ __forceinline__ void gemm_phase(LAS unsigned char* lds, const Gemm g, const StaticOrder& S, const Epi& E) {
    const int tid = threadIdx.x, wid = __builtin_amdgcn_readfirstlane(tid >> 6), lane = tid & 63, wr = wid >> 2, wc = wid & 3, fr = lane & 15, fq = lane >> 4;
    const int K = g.K, nt = K / BK, lda = g.lda;
    unsigned voffA[2], voffB[2];
#pragma unroll
    for (int i = 0; i < 2; ++i) { int R, C; stage_rc(tid * 16 + i * 8192, R, C);
        const int Rb = Epi::PERM ? ((R & ~31) + perm32(R & 31)) : R;
        voffA[i] = (unsigned)(R * lda + C) * 2u; voffB[i] = (unsigned)(Rb * K + C) * 2u; }
    const size_t kstep = (size_t)(BK * 2);
    const size_t hstepA = (size_t)HALF * lda * 2, hstepB = (size_t)HALF * K * 2;
    const size_t tstepA = 2 * hstepA, tstepB = 2 * hstepB, pnA = (size_t)g.apn * 2;
    const unsigned ldsw = (unsigned)wid * 1024u;
    const int aoff = lds_byte(wr * 64 + fr, fq * 8), boff = lds_byte(wc * 32 + fr, fq * 8);
#define PG8_SA(b, h) (((b) * 2 + (h)) * HTB)
#define PG8_SB(b, h) ((4 + (b) * 2 + (h)) * HTB)
#define PG8_STAGE(bufoff, gbase, voff) do { _Pragma("unroll") for (int _i = 0; _i < 2; ++_i) \
        __builtin_amdgcn_global_load_lds((const unsigned*)((const char*)(gbase) + (voff)[_i]), (LAS unsigned*)(lds + (bufoff) + ldsw + _i * 8192), 16, 0, 0); } while (0)
#define PG8_LDA(dst, b, h) do { _Pragma("unroll") for (int m = 0; m < 4; ++m) _Pragma("unroll") for (int k = 0; k < 2; ++k) dst[m][k] = *(const LAS bf16x8*)(lds + PG8_SA(b, h) + aoff + m * 2048 + k * 1024); } while (0)
#define PG8_LDB(dst, b, h) do { _Pragma("unroll") for (int n = 0; n < 2; ++n) _Pragma("unroll") for (int k = 0; k < 2; ++k) dst[n][k] = *(const LAS bf16x8*)(lds + PG8_SB(b, h) + boff + n * 2048 + k * 1024); } while (0)
#define PG8_MMA(ai, bj, At, Bt) do { __builtin_amdgcn_s_setprio(1); _Pragma("unroll") for (int m = 0; m < 4; ++m) _Pragma("unroll") for (int n = 0; n < 2; ++n) _Pragma("unroll") for (int k = 0; k < 2; ++k) \
        acc[ai][bj][m][n] = __builtin_amdgcn_mfma_f32_16x16x32_bf16(Bt[n][k], At[m][k], acc[ai][bj][m][n], 0, 0, 0); __builtin_amdgcn_s_setprio(0); } while (0)
#define PG8_WAIT_V(n) asm volatile("s_waitcnt vmcnt(" #n ")" ::: "memory")
#define PG8_WAIT_L(n) asm volatile("s_waitcnt lgkmcnt(" #n ")" ::: "memory")
#define PG8_BAR __builtin_amdgcn_s_barrier()
#define PG8_SCHED __builtin_amdgcn_sched_barrier(0)
    Unit cur, nxt; int ui = 0;
    if (!S.next(0, cur)) return;
    f32x4 acc[2][2][4][2];
#pragma unroll
    for (int a = 0; a < 2; ++a)
#pragma unroll
        for (int b = 0; b < 2; ++b)
#pragma unroll
            for (int m = 0; m < 4; ++m)
#pragma unroll
                for (int n = 0; n < 2; ++n) acc[a][b][m][n] = (f32x4){0.f, 0.f, 0.f, 0.f};
    bf16x8 At[4][2], B0[2][2], B1[2][2];
    const char* cA = (const char*)g.A + (size_t)cur.pm * tstepA + (size_t)cur.pn * pnA; const char* cB = (const char*)g.Bt + (size_t)cur.pn * tstepB;
    PG8_STAGE(PG8_SB(0, 0), cB, voffB); PG8_STAGE(PG8_SB(0, 1), cB + hstepB, voffB); PG8_STAGE(PG8_SA(0, 0), cA, voffA); PG8_STAGE(PG8_SA(0, 1), cA + hstepA, voffA);
    if (wr == 1) PG8_BAR;
    PG8_WAIT_V(2); PG8_BAR;
    PG8_STAGE(PG8_SB(1, 0), cB + kstep, voffB); PG8_STAGE(PG8_SA(1, 0), cA + kstep, voffA); PG8_STAGE(PG8_SB(1, 1), cB + hstepB + kstep, voffB);
    PG8_WAIT_V(6); PG8_BAR;
    for (;;) {
        const bool has_next = S.next(ui + 1, nxt);
        const char* nA = has_next ? (const char*)g.A + (size_t)nxt.pm * tstepA + (size_t)nxt.pn * pnA : cA; const char* nB = has_next ? (const char*)g.Bt + (size_t)nxt.pn * tstepB : cB;
#pragma unroll 1
        for (int t = 0; t < nt; t += 2) {
            const bool last = (t == nt - 2);
            const char* a1 = cA + (size_t)(t + 1) * kstep;
            const char* a2 = last ? nA : cA + (size_t)(t + 2) * kstep; const char* b2 = last ? nB : cB + (size_t)(t + 2) * kstep;
            const char* a3 = a2 + kstep; const char* b3 = b2 + kstep;
            PG8_LDB(B0, 0, 0); PG8_LDB(B1, 0, 1); PG8_SCHED; PG8_LDA(At, 0, 0); PG8_STAGE(PG8_SA(1, 1), a1 + hstepA, voffA);
            PG8_WAIT_V(8); PG8_WAIT_L(0); PG8_BAR; PG8_MMA(0, 0, At, B0); PG8_MMA(0, 1, At, B1); PG8_BAR; PG8_SCHED;
            PG8_LDA(At, 0, 1); PG8_STAGE(PG8_SB(0, 0), b2, voffB); PG8_STAGE(PG8_SB(0, 1), b2 + hstepB, voffB); PG8_STAGE(PG8_SA(0, 0), a2, voffA);
            PG8_WAIT_V(8); PG8_WAIT_L(0); PG8_BAR; PG8_MMA(1, 0, At, B0); PG8_MMA(1, 1, At, B1); PG8_BAR; PG8_SCHED;
            PG8_LDB(B0, 1, 0); PG8_LDB(B1, 1, 1); PG8_SCHED; PG8_LDA(At, 1, 0); PG8_STAGE(PG8_SA(0, 1), a2 + hstepA, voffA);
            PG8_WAIT_V(8); PG8_WAIT_L(0); PG8_BAR; PG8_MMA(0, 0, At, B0); PG8_MMA(0, 1, At, B1); PG8_BAR; PG8_SCHED;
            PG8_LDA(At, 1, 1); PG8_STAGE(PG8_SB(1, 0), b3, voffB); PG8_STAGE(PG8_SB(1, 1), b3 + hstepB, voffB); PG8_STAGE(PG8_SA(1, 0), a3, voffA);
            PG8_WAIT_V(8); PG8_WAIT_L(0); PG8_BAR; PG8_MMA(1, 0, At, B0); PG8_MMA(1, 1, At, B1); PG8_BAR; PG8_SCHED;
        }
        if (wr == 0) PG8_BAR;
        E(acc, cur, wr, wc, fr, fq);
        if (!has_next) break;
#pragma unroll
        for (int a = 0; a < 2; ++a)
#pragma unroll
            for (int b = 0; b < 2; ++b)
#pragma unroll
                for (int m = 0; m < 4; ++m)
#pragma unroll
                    for (int n = 0; n < 2; ++n) acc[a][b][m][n] = (f32x4){0.f, 0.f, 0.f, 0.f};
        cur = nxt; cA = nA; cB = nB; ++ui;
        if (wr == 1) PG8_BAR;
    }
    PG8_WAIT_V(0);
    PG8_BAR;
#undef PG8_SA
#undef PG8_SB
#undef PG8_STAGE
#undef PG8_LDA
#undef PG8_LDB
#undef PG8_MMA
#undef PG8_WAIT_V
#undef PG8_WAIT_L
#undef PG8_BAR
#undef PG8_SCHED
}
}

struct Params { const float* in[27]; float* out; unsigned char* ws; int ph_lo, ph_hi; };
enum { I_XP = 0, I_XS, I_PP, I_PS, I_SPOOL, I_CLAT, I_CKR, I_PT, I_NMIX, I_NMLP, I_NPLE, I_POOLW, I_POOLSC, I_NKV, I_WDKV, I_KVN, I_WUK, I_WUV, I_WDQ, I_QN, I_WUQ, I_WO, I_WUP, I_WDOWN, I_WGATE, I_WPROJ, I_NFIN };

__device__ __forceinline__ void load_rstd(const float* ssq, const pg8::Unit& u, int wr, int fr, int fq, float (&rs)[2][4]) {
#pragma unroll
    for (int ai = 0; ai < 2; ++ai)
#pragma unroll
        for (int m = 0; m < 4; ++m) {
            const int row = u.pm * 256 + ai * 128 + wr * 64 + m * 16 + fr;
            const f32x4 a = ((const f32x4*)(ssq + (size_t)row * 16))[fq];
            float t = (a.x + a.y) + (a.z + a.w);
            t += __shfl_xor(t, 16); t += __shfl_xor(t, 32);
            rs[ai][m] = 1.0f / sqrtf(t * (1.0f / 1024.0f) + EPS);
        }
}
template <int MODE> struct EpiH {
    static constexpr bool PERM = true;
    const float* xp; const float* xs; const float* scale; const float* ssq_in; const bf16_t* proj;
    const bf16_t* hb_in; bf16_t* hb; float* ssq_out;
    __device__ __forceinline__ void operator()(const f32x4 (&acc)[2][2][4][2], const pg8::Unit& u, int wr, int wc, int fr_in, int fq_in) const {
        int fr = fr_in, fq = fq_in; asm volatile("" : "+v"(fr), "+v"(fq));
        float rs[2][4];
        if (MODE == 2) load_rstd(ssq_in, u, wr, fr, fq, rs);
        const int col0 = u.pn * 256 + wc * 32 + 8 * fq;
#pragma unroll
        for (int ai = 0; ai < 2; ++ai)
#pragma unroll
            for (int m = 0; m < 4; ++m) {
                const int row = u.pm * 256 + ai * 128 + wr * 64 + m * 16 + fr;
                float sq = 0.f;
#pragma unroll
                for (int bj = 0; bj < 2; ++bj) {
                    const int col = col0 + bj * 128;
                    f32x4 b0, b1;
                    if (MODE == 0) { const float* xr = (row < MP ? xp + (size_t)row * D : xs + (size_t)(row - MP) * D) + col; b0 = *(const f32x4*)xr; b1 = *(const f32x4*)(xr + 4); }
                    else { const u32x4 hv = *(const u32x4*)(hb_in + (size_t)row * D + col); b0 = unpk4((u32x2){hv.x, hv.y}); b1 = unpk4((u32x2){hv.z, hv.w}); }
                    const f32x4 a0 = acc[ai][bj][m][0], a1 = acc[ai][bj][m][1]; f32x4 o0, o1;
                    if (MODE == 0) { o0 = b0 + *(const f32x4*)(scale + col) * a0; o1 = b1 + *(const f32x4*)(scale + col + 4) * a1; }
                    else if (MODE == 1) { o0 = b0 + a0; o1 = b1 + a1; }
                    else { const u32x4 pv = *(const u32x4*)(proj + (size_t)row * D + col); const f32x4 p0 = unpk4((u32x2){pv.x, pv.y}), p1 = unpk4((u32x2){pv.z, pv.w}); const float r = rs[ai][m];
                        f32x4 g0, g1;
                        g0.x = 1.0f / (1.0f + __expf(-r * a0.x)); g0.y = 1.0f / (1.0f + __expf(-r * a0.y)); g0.z = 1.0f / (1.0f + __expf(-r * a0.z)); g0.w = 1.0f / (1.0f + __expf(-r * a0.w));
                        g1.x = 1.0f / (1.0f + __expf(-r * a1.x)); g1.y = 1.0f / (1.0f + __expf(-r * a1.y)); g1.z = 1.0f / (1.0f + __expf(-r * a1.z)); g1.w = 1.0f / (1.0f + __expf(-r * a1.w));
                        o0 = b0 + g0 * p0; o1 = b1 + g1 * p1; }
                    u32x4 w; w.x = pk2(o0.x, o0.y); w.y = pk2(o0.z, o0.w); w.z = pk2(o1.x, o1.y); w.w = pk2(o1.z, o1.w);
                    *(u32x4*)(hb + (size_t)row * D + col) = w;
                    sq += ((o0.x * o0.x + o0.y * o0.y) + (o0.z * o0.z + o0.w * o0.w)) + ((o1.x * o1.x + o1.y * o1.y) + (o1.z * o1.z + o1.w * o1.w));
                }
                sq += __shfl_xor(sq, 16); sq += __shfl_xor(sq, 32);
                if (fq == 0) ssq_out[(size_t)row * 16 + u.pn * 4 + wc] = sq;
                asm volatile("" ::: "memory");
            }
    }
};
struct EpiUp {
    static constexpr bool PERM = true;
    const float* ssq_in; bf16_t* abuf;
    __device__ __forceinline__ void operator()(const f32x4 (&acc)[2][2][4][2], const pg8::Unit& u, int wr, int wc, int fr_in, int fq_in) const {
        int fr = fr_in, fq = fq_in; asm volatile("" : "+v"(fr), "+v"(fq));
        float rs[2][4]; load_rstd(ssq_in, u, wr, fr, fq, rs);
        const int col0 = u.pn * 256 + wc * 32 + 8 * fq;
#pragma unroll
        for (int ai = 0; ai < 2; ++ai)
#pragma unroll
            for (int m = 0; m < 4; ++m) {
                const int row = u.pm * 256 + ai * 128 + wr * 64 + m * 16 + fr; const float r = rs[ai][m];
#pragma unroll
                for (int bj = 0; bj < 2; ++bj) {
                    f32x4 a = acc[ai][bj][m][0] * r, c = acc[ai][bj][m][1] * r;
                    a.x = fmaxf(a.x, 0.f); a.y = fmaxf(a.y, 0.f); a.z = fmaxf(a.z, 0.f); a.w = fmaxf(a.w, 0.f);
                    c.x = fmaxf(c.x, 0.f); c.y = fmaxf(c.y, 0.f); c.z = fmaxf(c.z, 0.f); c.w = fmaxf(c.w, 0.f);
                    u32x4 w; w.x = pk2(a.x * a.x, a.y * a.y); w.y = pk2(a.z * a.z, a.w * a.w); w.z = pk2(c.x * c.x, c.y * c.y); w.w = pk2(c.z * c.z, c.w * c.w);
                    *(u32x4*)(abuf + (size_t)row * FF + col0 + bj * 128) = w;
                }
            }
    }
};
template <int MODE> struct EpiF32 {
    static constexpr bool PERM = false;
    float* C; int ldc; const float* aux;
    __device__ __forceinline__ void operator()(const f32x4 (&acc)[2][2][4][2], const pg8::Unit& u, int wr, int wc, int fr_in, int fq_in) const {
        int fr = fr_in, fq = fq_in; asm volatile("" : "+v"(fr), "+v"(fq));
        float rs[2][4];
        if (MODE == 1) load_rstd(aux, u, wr, fr, fq, rs);
        const int col0 = u.pn * 256 + wc * 32 + 4 * fq;
#pragma unroll
        for (int ai = 0; ai < 2; ++ai)
#pragma unroll
            for (int m = 0; m < 4; ++m) {
                const int row = u.pm * 256 + ai * 128 + wr * 64 + m * 16 + fr;
                const float r = (MODE == 1) ? rs[ai][m] : (MODE == 2 ? aux[row] : 1.0f);
#pragma unroll
                for (int bj = 0; bj < 2; ++bj)
#pragma unroll
                    for (int n = 0; n < 2; ++n) *(f32x4*)(C + (size_t)row * ldc + col0 + bj * 128 + n * 16) = acc[ai][bj][m][n] * r;
            }
    }
};
struct EpiBf {
    static constexpr bool PERM = true;
    bf16_t* C; int ldc;
    __device__ __forceinline__ void operator()(const f32x4 (&acc)[2][2][4][2], const pg8::Unit& u, int wr, int wc, int fr_in, int fq_in) const {
        int fr = fr_in, fq = fq_in; asm volatile("" : "+v"(fr), "+v"(fq));
        const int col0 = u.pn * 256 + wc * 32 + 8 * fq;
#pragma unroll
        for (int ai = 0; ai < 2; ++ai)
#pragma unroll
            for (int m = 0; m < 4; ++m) {
                const int row = u.pm * 256 + ai * 128 + wr * 64 + m * 16 + fr;
#pragma unroll
                for (int bj = 0; bj < 2; ++bj) { const f32x4 a = acc[ai][bj][m][0], c = acc[ai][bj][m][1]; u32x4 w; w.x = pk2(a.x, a.y); w.y = pk2(a.z, a.w); w.z = pk2(c.x, c.y); w.w = pk2(c.z, c.w);
                    *(u32x4*)(C + (size_t)row * ldc + col0 + bj * 128) = w; }
            }
    }
};
__host__ __device__ __forceinline__ int qperm(int c) { const int e = c % QH; if (e < NOPE) return c; const int r = e - NOPE, i = r & 31, sec = r >> 5; return c - e + NOPE + 32 * (i >> 4) + 16 * sec + (i & 15); }
struct EpiQ {
    static constexpr bool PERM = false;
    const float* rstdq; const float* cs; bf16_t* qbuf; bf16_t* qs;
    __device__ __forceinline__ void operator()(const f32x4 (&acc)[2][2][4][2], const pg8::Unit& u, int wr, int wc, int fr_in, int fq_in) const {
        int fr = fr_in, fq = fq_in; asm volatile("" : "+v"(fr), "+v"(fq));
        const bool smp = u.pm >= MP / 256;
#pragma unroll
        for (int ai = 0; ai < 2; ++ai)
#pragma unroll
            for (int m = 0; m < 4; ++m) {
                const int row = u.pm * 256 + ai * 128 + wr * 64 + m * 16 + fr; const float r = rstdq[row]; const int pos = smp ? PAST + ((row - MP) & 7) : (row & (SEQ - 1));
                bf16_t* qrow = qbuf + (size_t)row * (NH * QH);
#pragma unroll
                for (int bj = 0; bj < 2; ++bj) {
                    const int Gi = u.pn * 8 + bj * 4 + wc, hh = Gi / 6, gi = Gi - hh * 6;
                    if (gi < 4) {
#pragma unroll
                        for (int n = 0; n < 2; ++n) { const f32x4 a = acc[ai][bj][m][n] * r; u32x2 w; w.x = pk2(a.x, a.y); w.y = pk2(a.z, a.w);
                            *(u32x2*)(qrow + Gi * 32 + n * 16 + 4 * fq) = w; }
                    } else {
                        const int i0 = 16 * (gi - 4) + 4 * fq;
                        const f32x4 x1 = acc[ai][bj][m][0] * r, x2 = acc[ai][bj][m][1] * r;
                        const f32x4 cn = *(const f32x4*)(cs + (size_t)pos * 64 + i0), sn = *(const f32x4*)(cs + (size_t)pos * 64 + 32 + i0);
                        const f32x4 o1 = x1 * cn - x2 * sn, o2 = x2 * cn + x1 * sn;
                        u32x2 w1, w2; w1.x = pk2(o1.x, o1.y); w1.y = pk2(o1.z, o1.w); w2.x = pk2(o2.x, o2.y); w2.y = pk2(o2.z, o2.w);
                        bf16_t* qd = smp ? qs + ((size_t)(row - MP) * NH + hh) * 320 + KVR : qrow + hh * QH + NOPE;
                        *(u32x2*)(qd + i0) = w1; *(u32x2*)(qd + 32 + i0) = w2;
                    }
                }
                asm volatile("" ::: "memory");
            }
    }
};
struct EpiKup {
    static constexpr bool PERM = true;
    bf16_t* kfull;
    __device__ __forceinline__ void operator()(const f32x4 (&acc)[2][2][4][2], const pg8::Unit& u, int wr, int wc, int fr_in, int fq_in) const {
        int fr = fr_in, fq = fq_in; asm volatile("" : "+v"(fr), "+v"(fq));
        const int col0 = u.pn * 256 + wc * 32 + 8 * fq;
#pragma unroll
        for (int ai = 0; ai < 2; ++ai)
#pragma unroll
            for (int m = 0; m < 4; ++m) {
                const int row = u.pm * 256 + ai * 128 + wr * 64 + m * 16 + fr; const int b = row >> 13, t = row & (SEQ - 1);
#pragma unroll
                for (int bj = 0; bj < 2; ++bj) { const int col = col0 + bj * 128; const int h = col >> 7, nn = col & 127; const f32x4 a = acc[ai][bj][m][0], c = acc[ai][bj][m][1];
                    u32x4 w; w.x = pk2(a.x, a.y); w.y = pk2(a.z, a.w); w.z = pk2(c.x, c.y); w.w = pk2(c.z, c.w);
                    *(u32x4*)(kfull + ((size_t)(b * NH + h) * SEQ + t) * QH + nn) = w; }
                asm volatile("" ::: "memory");
            }
    }
};
struct EpiVup {
    static constexpr bool PERM = true;
    bf16_t* vt;
    __device__ __forceinline__ void operator()(const f32x4 (&acc)[2][2][4][2], const pg8::Unit& u, int wr, int wc, int fr_in, int fq_in) const {
        int fr = fr_in, fq = fq_in; asm volatile("" : "+v"(fr), "+v"(fq));
        const int col0 = u.pn * 256 + wc * 32 + 8 * fq;
#pragma unroll
        for (int ai = 0; ai < 2; ++ai)
#pragma unroll
            for (int m = 0; m < 4; ++m) {
                const int row = u.pm * 256 + ai * 128 + wr * 64 + m * 16 + fr; const int h = row >> 7, v = row & 127;
#pragma unroll
                for (int bj = 0; bj < 2; ++bj) { const int col = col0 + bj * 128; const int b = col >> 13, t = col & (SEQ - 1); const f32x4 a = acc[ai][bj][m][0], c = acc[ai][bj][m][1];
                    u32x4 w; w.x = pk2(a.x, a.y); w.y = pk2(a.z, a.w); w.z = pk2(c.x, c.y); w.w = pk2(c.z, c.w);
                    *(u32x4*)(vt + ((size_t)(b * NH + h) * VD + v) * SEQ + t) = w; }
                asm volatile("" ::: "memory");
            }
    }
};

struct SgALoadBf { const bf16_t* A; int lda;
    __device__ __forceinline__ bf16x8 operator()(int row, int k) const { return *(const bf16x8*)(A + (size_t)row * lda + k); } };
struct SgALoadComb { const float* parto; const float* ml;
    __device__ __forceinline__ bf16x8 operator()(int row, int k) const {
        const int b = row >> 3, tok = row & 7, h = k >> 7, v = k & 127, q = tok * 8 + h;
        const float* m0p = ml + ((size_t)(b * 2 + 0) * 64 + q) * 2; const float* m1p = ml + ((size_t)(b * 2 + 1) * 64 + q) * 2;
        const float m0 = m0p[0], l0 = m0p[1], m1 = m1p[0], l1 = m1p[1], mx = fmaxf(m0, m1);
        float w0 = __builtin_amdgcn_exp2f(m0 - mx), w1 = __builtin_amdgcn_exp2f(m1 - mx); const float inv = 1.0f / (w0 * l0 + w1 * l1); w0 *= inv; w1 *= inv;
        const float* p0 = parto + ((size_t)(b * 2 + 0) * 64 + q) * 128 + v; const float* p1 = parto + ((size_t)(b * 2 + 1) * 64 + q) * 128 + v;
        return pack8v(*(const f32x4*)p0 * w0 + *(const f32x4*)p1 * w1, *(const f32x4*)(p0 + 4) * w0 + *(const f32x4*)(p1 + 4) * w1); } };
template <int NCT, int NCG, class Epi, class ALoad>
__device__ __forceinline__ void sg_gemm_l(LAS unsigned char* lds, const ALoad& AL, int apn256, const bf16_t* __restrict__ Bt, int K, int unit, const Epi& E, int tid, int wave, int lane) {
    constexpr int KS = 8 / NCG, W = NCG * NCT * 16, G4 = W / 4;
    static_assert(KS * 64 * W * 4 <= RING_BYTES, "sg_gemm reduction buffer");
    const int mt = unit >> 4, ntile = unit & 15, m0 = mt * 64, n0 = ntile * W;
    const int cg = wave % NCG, kp = wave / NCG, fr = lane & 15, fq = lane >> 4;
    const int Kw = K / KS;
    const int arow = m0 + fr, acol = (n0 >> 8) * apn256 + kp * Kw + 8 * fq;
    const bf16_t* bp = Bt + (size_t)(n0 + cg * NCT * 16 + fr) * K + kp * Kw + 8 * fq;
    f32x4 acc[4][NCT];
#pragma unroll
    for (int m = 0; m < 4; ++m)
#pragma unroll
        for (int n = 0; n < NCT; ++n) acc[m][n] = (f32x4){0.f, 0.f, 0.f, 0.f};
#pragma unroll 4
    for (int kk = 0; kk < Kw; kk += 32) {
        bf16x8 af[4], bfr[NCT];
#pragma unroll
        for (int m = 0; m < 4; ++m) af[m] = AL(arow + 16 * m, acol + kk);
#pragma unroll
        for (int n = 0; n < NCT; ++n) bfr[n] = *(const bf16x8*)(bp + (size_t)(16 * n) * K + kk);
#pragma unroll
        for (int m = 0; m < 4; ++m)
#pragma unroll
            for (int n = 0; n < NCT; ++n) acc[m][n] = __builtin_amdgcn_mfma_f32_16x16x32_bf16(bfr[n], af[m], acc[m][n], 0, 0, 0);
    }
    LAS float* red = (LAS float*)lds;
#pragma unroll
    for (int m = 0; m < 4; ++m)
#pragma unroll
        for (int n = 0; n < NCT; ++n) { const int row = 16 * m + fr, c4 = (cg * NCT * 16 + 16 * n) / 4 + fq;
            *(LAS f32x4*)(red + (size_t)(kp * 64 + row) * W + 4 * (c4 ^ (row & 3))) = acc[m][n]; }
    __syncthreads();
    for (int it = tid; it < 64 * G4; it += 512) {
        const int row = it / G4, c4 = it % G4;
        f32x4 v = *(const LAS f32x4*)(red + (size_t)row * W + 4 * (c4 ^ (row & 3)));
#pragma unroll
        for (int p = 1; p < KS; ++p) v += *(const LAS f32x4*)(red + (size_t)(p * 64 + row) * W + 4 * (c4 ^ (row & 3)));
        if constexpr (Epi::WHOLE_TILE) *(LAS f32x4*)(red + (size_t)row * W + 4 * (c4 ^ (row & 3))) = v;
        else E(MP + m0 + row, n0 + 4 * c4, v, ntile);
    }
    if constexpr (Epi::WHOLE_TILE) {
        __syncthreads();
        for (int it = tid; it < 64 * G4; it += 512) { const int row = it / G4, c4 = it % G4; E.tile(MP + m0 + row, n0, c4, red + (size_t)row * W, row & 3); }
    }
    __syncthreads();
}
template <int NCT, int NCG, class Epi>
__device__ __forceinline__ void sg_gemm(LAS unsigned char* lds, const bf16_t* __restrict__ A, int lda, int apn256, const bf16_t* __restrict__ Bt, int K, int unit, const Epi& E, int tid, int wave, int lane) {
    const SgALoadBf AL{A, lda}; sg_gemm_l<NCT, NCG>(lds, AL, apn256, Bt, K, unit, E, tid, wave, lane);
}
__device__ __forceinline__ float row_rstd16(const float* ssq, int row) {
    const f32x4* s = (const f32x4*)(ssq + (size_t)row * 16); const f32x4 a = s[0], b = s[1], c = s[2], d = s[3];
    const float t = ((a.x + a.y) + (a.z + a.w)) + ((b.x + b.y) + (b.z + b.w)) + ((c.x + c.y) + (c.z + c.w)) + ((d.x + d.y) + (d.z + d.w));
    return 1.0f / sqrtf(t * (1.0f / 1024.0f) + EPS);
}
template <int MODE> struct SgH {
    static constexpr bool WHOLE_TILE = false;
    const float* xs; const float* scale; const float* ssq_in; const bf16_t* proj; const bf16_t* hb_in; bf16_t* hb; float* ssq_out;
    __device__ __forceinline__ void operator()(int row, int col, f32x4 a, int ntile) const {
        const f32x4 bs = (MODE == 0) ? *(const f32x4*)(xs + (size_t)(row - MP) * D + col) : unpk4(*(const u32x2*)(hb_in + (size_t)row * D + col));
        f32x4 o;
        if (MODE == 0) o = bs + *(const f32x4*)(scale + col) * a;
        else if (MODE == 1) o = bs + a;
        else { const float r = row_rstd16(ssq_in, row); const f32x4 pj = unpk4(*(const u32x2*)(proj + (size_t)row * D + col));
            f32x4 gt; gt.x = 1.0f / (1.0f + __expf(-r * a.x)); gt.y = 1.0f / (1.0f + __expf(-r * a.y)); gt.z = 1.0f / (1.0f + __expf(-r * a.z)); gt.w = 1.0f / (1.0f + __expf(-r * a.w));
            o = bs + gt * pj; }
        u32x2 w; w.x = pk2(o.x, o.y); w.y = pk2(o.z, o.w);
        *(u32x2*)(hb + (size_t)row * D + col) = w;
        float sq = (o.x * o.x + o.y * o.y) + (o.z * o.z + o.w * o.w);
        sq += __shfl_xor(sq, 1); sq += __shfl_xor(sq, 2); sq += __shfl_xor(sq, 4); sq += __shfl_xor(sq, 8);
        if ((col & 63) == 0) ssq_out[(size_t)row * 16 + ntile] = sq;
    }
};
struct SgUp {
    static constexpr bool WHOLE_TILE = false;
    const float* ssq_in; bf16_t* abuf;
    __device__ __forceinline__ void operator()(int row, int col, f32x4 a, int) const {
        const float r = row_rstd16(ssq_in, row); a = a * r;
        a.x = fmaxf(a.x, 0.f); a.y = fmaxf(a.y, 0.f); a.z = fmaxf(a.z, 0.f); a.w = fmaxf(a.w, 0.f);
        u32x2 w; w.x = pk2(a.x * a.x, a.y * a.y); w.y = pk2(a.z * a.z, a.w * a.w);
        *(u32x2*)(abuf + (size_t)row * FF + col) = w;
    }
};
template <int MODE> struct SgF32 {
    static constexpr bool WHOLE_TILE = false;
    float* C; int ldc; const float* aux;
    __device__ __forceinline__ void operator()(int row, int col, f32x4 a, int) const {
        const float r = (MODE == 1) ? row_rstd16(aux, row) : (MODE == 2 ? aux[row] : 1.0f);
        *(f32x4*)(C + (size_t)row * ldc + col) = a * r;
    }
};
struct SgBf {
    static constexpr bool WHOLE_TILE = false;
    bf16_t* C; int ldc;
    __device__ __forceinline__ void operator()(int row, int col, f32x4 a, int) const { u32x2 w; w.x = pk2(a.x, a.y); w.y = pk2(a.z, a.w); *(u32x2*)(C + (size_t)row * ldc + col) = w; }
};
struct SgQ {
    static constexpr bool WHOLE_TILE = true;
    const float* rstdq; const float* cs; bf16_t* qbuf; bf16_t* qs;
    __device__ __forceinline__ void operator()(int, int, f32x4, int) const {}
    __device__ __forceinline__ void tile(int row, int n0, int c4, const LAS float* trow, int sw) const {
        const int c = n0 + 4 * c4, hh = c / QH, e = c - hh * QH; const float r = rstdq[row];
        const f32x4 v = *(const LAS f32x4*)(trow + 4 * (c4 ^ sw)) * r;
        if (e < NOPE) { u32x2 w; w.x = pk2(v.x, v.y); w.y = pk2(v.z, v.w); *(u32x2*)(qbuf + (size_t)row * (NH * QH) + c) = w; }
        else { const int rp = e - NOPE, wi = rp & 31;
            if (wi < 16) { const int i0 = 16 * (rp >> 5) + wi, pos = PAST + ((row - MP) & 7);
                const f32x4 x2 = *(const LAS f32x4*)(trow + 4 * ((c4 + 4) ^ sw)) * r;
                const f32x4 cn = *(const f32x4*)(cs + (size_t)pos * 64 + i0), sn = *(const f32x4*)(cs + (size_t)pos * 64 + 32 + i0);
                const f32x4 o1 = v * cn - x2 * sn, o2 = x2 * cn + v * sn;
                bf16_t* qd = qs + ((size_t)(row - MP) * NH + hh) * 320 + KVR;
                u32x2 w1, w2; w1.x = pk2(o1.x, o1.y); w1.y = pk2(o1.z, o1.w); w2.x = pk2(o2.x, o2.y); w2.y = pk2(o2.z, o2.w);
                *(u32x2*)(qd + i0) = w1; *(u32x2*)(qd + 32 + i0) = w2; } }
    }
};

template <bool QPERM = false>
__device__ __forceinline__ void transpose_item(const float* W, const float* kscale, int K, int N, bf16_t* WT, int row_off, LAS float* scr, int item, int lane) {
    const int nblk = N / 32, kb = item / nblk, nb = item % nblk, k0 = 64 * kb, n0 = 32 * nb;
    { f32x4 v[8];
#pragma unroll
      for (int i = 0; i < 8; ++i) v[i] = *(const f32x4*)(W + (size_t)(k0 + (lane >> 3) + 8 * i) * N + n0 + (lane & 7) * 4);
#pragma unroll
      for (int i = 0; i < 8; ++i) { const int kk = (lane >> 3) + 8 * i; f32x4 x = v[i]; if (kscale) x = x * kscale[k0 + kk];
          LAS float* d = scr + kk * 33 + (lane & 7) * 4; d[0] = x.x; d[1] = x.y; d[2] = x.z; d[3] = x.w; } }
    LDS_WAIT(); asm volatile("" ::: "memory");
    const int c = lane & 7;
#pragma unroll
    for (int j = 0; j < 4; ++j) { const int n = (lane >> 3) + 8 * j; const LAS float* s = scr + (8 * c) * 33 + n;
        u32x4 o; o.x = pk2(s[0 * 33], s[1 * 33]); o.y = pk2(s[2 * 33], s[3 * 33]); o.z = pk2(s[4 * 33], s[5 * 33]); o.w = pk2(s[6 * 33], s[7 * 33]);
        *(u32x4*)(WT + (size_t)(row_off + (QPERM ? qperm(n0 + n) : n0 + n)) * K + k0 + 8 * c) = o; }
    LDS_WAIT(); asm volatile("" ::: "memory");
}

constexpr int AK_PITCH = 400, AK_BUF = 64 * AK_PITCH;
constexpr int AV_PITCH = 136, AV_BUF = 128 * AV_PITCH;
constexpr int AV_OFF = 2 * AK_BUF, AQ_OFF = AV_OFF + 2 * AV_BUF;
static_assert(AQ_OFF + 256 * 144 <= RING_BYTES, "attention LDS");
__device__ __forceinline__ void attn_prompt_unit(const bf16_t* __restrict__ qbuf, const bf16_t* __restrict__ Kf, const bf16_t* __restrict__ Vt, bf16_t* __restrict__ obuf,
                                                 int b, int h, int qb, LAS unsigned char* lds, int tid, int wave, int lane) {
    const int r32 = lane & 31, g = lane >> 5;
    const int t_lo = qb * 256 + wave * 32, trow = t_lo + r32;
    bf16x8 qf[8];
    { const bf16_t* qp = qbuf + (size_t)(b * SEQ + trow) * (NH * QH) + h * QH + 8 * g;
      __syncthreads();
#pragma unroll
      for (int ks = 8; ks < 12; ++ks) *(LAS bf16x8*)(lds + AQ_OFF + (wave * 32 + r32) * 144 + (2 * (ks - 8) + g) * 16) = *(const bf16x8*)(qp + 16 * ks);
#pragma unroll
      for (int ks = 0; ks < 8; ++ks) qf[ks] = *(const bf16x8*)(qp + 16 * ks);
#pragma unroll
      for (int ks = 0; ks < 8; ++ks) asm volatile("" : "+v"(qf[ks])); }
    f32x16 O[4];
#pragma unroll
    for (int i = 0; i < 4; ++i)
#pragma unroll
        for (int j = 0; j < 16; ++j) O[i][j] = 0.f;
    float mrun = -1e30f, lrun = 0.f;
    const bf16_t* Kb = Kf + (size_t)(b * NH + h) * SEQ * QH;
    const bf16_t* Vb = Vt + (size_t)(b * NH + h) * VD * SEQ;
    const int NT = (qb + 1) * 4;
    int kl_off[3], vl_off[2]; size_t vg_off[2];
#pragma unroll
    for (int e = 0; e < 3; ++e) kl_off[e] = (tid >> 3) * AK_PITCH + ((tid & 7) + 8 * e) * 16;
#pragma unroll
    for (int e = 0; e < 2; ++e) { const int c = tid + 512 * e; vl_off[e] = AV_OFF + (c >> 3) * AV_PITCH + (c & 7) * 16; vg_off[e] = (size_t)(c >> 3) * SEQ + (c & 7) * 8; }
    u32x4 kst[3], vst[2];
#define AT_LOAD(j) do { _Pragma("unroll") for (int e = 0; e < 3; ++e) kst[e] = *(const u32x4*)(Kb + (size_t)(64 * (j) + (tid >> 3)) * QH + ((tid & 7) + 8 * e) * 8); \
                        _Pragma("unroll") for (int e = 0; e < 2; ++e) vst[e] = *(const u32x4*)(Vb + vg_off[e] + 64 * (j)); } while (0)
#define AT_WRITE(buf) do { _Pragma("unroll") for (int e = 0; e < 3; ++e) *(LAS u32x4*)(lds + (buf) * AK_BUF + kl_off[e]) = kst[e]; \
                           _Pragma("unroll") for (int e = 0; e < 2; ++e) { *(LAS u32x2*)(lds + (buf) * AV_BUF + vl_off[e]) = (u32x2){vst[e].x, vst[e].y}; *(LAS u32x2*)(lds + (buf) * AV_BUF + vl_off[e] + 8) = (u32x2){vst[e].z, vst[e].w}; } } while (0)
    AT_LOAD(0); AT_WRITE(0);
    __syncthreads();
    for (int j = 0; j < NT; ++j) {
        const int buf = j & 1;
        if (j + 1 < NT) AT_LOAD(j + 1);
        if (64 * j <= t_lo + 31) {
            f32x16 S0, S1;
#pragma unroll
            for (int i = 0; i < 16; ++i) { S0[i] = 0.f; S1[i] = 0.f; }
            const LAS unsigned char* kl = lds + buf * AK_BUF + r32 * AK_PITCH + g * 16;
            const LAS unsigned char* ql = lds + AQ_OFF + (wave * 32 + r32) * 144 + g * 16;
            bf16x8 ka[3][2], qr_[3];
#define AT_KLD(ks) do { ka[(ks) % 3][0] = *(const LAS bf16x8*)(kl + (ks) * 32); ka[(ks) % 3][1] = *(const LAS bf16x8*)(kl + 32 * AK_PITCH + (ks) * 32); \
                        if ((ks) >= 8) qr_[(ks) % 3] = *(const LAS bf16x8*)(ql + ((ks) - 8) * 32); } while (0)
            AT_KLD(0); AT_KLD(1);
#pragma unroll
            for (int ks = 0; ks < 12; ++ks) {
                if (ks + 2 < 12) AT_KLD(ks + 2);
                __builtin_amdgcn_sched_barrier(0);
                const bf16x8 qb_ = (ks < 8) ? qf[ks < 8 ? ks : 0] : qr_[ks % 3];
                S0 = __builtin_amdgcn_mfma_f32_32x32x16_bf16(ka[ks % 3][0], qb_, S0, 0, 0, 0);
                S1 = __builtin_amdgcn_mfma_f32_32x32x16_bf16(ka[ks % 3][1], qb_, S1, 0, 0, 0);
                __builtin_amdgcn_sched_barrier(0);
            }
#undef AT_KLD
            if (64 * j + 63 > t_lo) {
                asm volatile("" ::: "memory");
#pragma unroll
                for (int i = 0; i < 16; ++i) { const int key = 64 * j + crow(i, g); if (key > trow) S0[i] = -1e30f; if (key + 32 > trow) S1[i] = -1e30f; }
            }
            float mx = S0[0];
#pragma unroll
            for (int i = 1; i < 16; ++i) mx = fmaxf(mx, S0[i]);
#pragma unroll
            for (int i = 0; i < 16; ++i) mx = fmaxf(mx, S1[i]);
            mx = fmaxf(mx, __shfl_xor(mx, 32)) * CEXP;
            if (__any(mx > mrun + 11.5f)) {
                const float mnew = fmaxf(mrun, mx), alpha = __builtin_amdgcn_exp2f(mrun - mnew);
                mrun = mnew; lrun *= alpha;
#pragma unroll
                for (int vt = 0; vt < 4; ++vt)
#pragma unroll
                    for (int i = 0; i < 16; ++i) O[vt][i] *= alpha;
            }
            float ps = 0.f;
#pragma unroll
            for (int i = 0; i < 16; ++i) { S0[i] = __builtin_amdgcn_exp2f(S0[i] * CEXP - mrun); S1[i] = __builtin_amdgcn_exp2f(S1[i] * CEXP - mrun); ps += S0[i] + S1[i]; }
            lrun += ps;
            bf16x8 pf[4];
            { float tmp[8];
#pragma unroll
              for (int s2 = 0; s2 < 4; ++s2) {
#pragma unroll
                for (int i = 0; i < 8; ++i) tmp[i] = (s2 < 2) ? S0[8 * (s2 & 1) + i] : S1[8 * (s2 & 1) + i];
                pf[s2] = pack8(tmp); } }
            const LAS unsigned char* vl = lds + AV_OFF + buf * AV_BUF + r32 * AV_PITCH + g * 8;
            u32x4 fa[4], fb[4];
#define AT_VLD(dst, vt) do { _Pragma("unroll") for (int s2 = 0; s2 < 4; ++s2) { const u32x2 lo_ = *(const LAS u32x2*)(vl + (vt) * 32 * AV_PITCH + s2 * 32), hi_ = *(const LAS u32x2*)(vl + (vt) * 32 * AV_PITCH + s2 * 32 + 16); dst[s2] = (u32x4){lo_.x, lo_.y, hi_.x, hi_.y}; } } while (0)
#define AT_VMM(src, vt) do { _Pragma("unroll") for (int s2 = 0; s2 < 4; ++s2) O[vt] = __builtin_amdgcn_mfma_f32_32x32x16_bf16(__builtin_bit_cast(bf16x8, src[s2]), pf[s2], O[vt], 0, 0, 0); } while (0)
            AT_VLD(fa, 0); AT_VLD(fb, 1); __builtin_amdgcn_sched_barrier(0);
            AT_VMM(fa, 0); __builtin_amdgcn_sched_barrier(0);
            AT_VLD(fa, 2); __builtin_amdgcn_sched_barrier(0);
            AT_VMM(fb, 1); __builtin_amdgcn_sched_barrier(0);
            AT_VLD(fb, 3); __builtin_amdgcn_sched_barrier(0);
            AT_VMM(fa, 2); __builtin_amdgcn_sched_barrier(0);
            AT_VMM(fb, 3);
#undef AT_VLD
#undef AT_VMM
        }
        if (j + 1 < NT) AT_WRITE(buf ^ 1);
        __syncthreads();
    }
#undef AT_LOAD
#undef AT_WRITE
    const float ltot = lrun + __shfl_xor(lrun, 32), inv = 1.0f / ltot;
    bf16_t* op = obuf + (size_t)(b * SEQ + trow) * D + h * VD + 4 * g;
#pragma unroll
    for (int vt = 0; vt < 4; ++vt)
#pragma unroll
        for (int jq = 0; jq < 4; ++jq) {
            u32x2 w; w.x = pk2(O[vt][4 * jq] * inv, O[vt][4 * jq + 1] * inv); w.y = pk2(O[vt][4 * jq + 2] * inv, O[vt][4 * jq + 3] * inv);
            *(u32x2*)(op + 32 * vt + 8 * jq) = w;
        }
}

typedef short s16x4 __attribute__((ext_vector_type(4)));
constexpr int SA_KR = 32768, SA_BUF = 32768 + 64 * 144, SA_QR = 2 * SA_BUF, SA_QI = SA_QR + 64 * 144, SA_QI_PITCH = 528, SA_OI = 69632;
static_assert(SA_OI >= 65536 + 1024 && SA_OI + 64 * SA_QI_PITCH <= MISC_OFF, "O image");
static_assert(SA_QI + 64 * SA_QI_PITCH <= MISC_OFF, "sample attention LDS");
__device__ __forceinline__ int sa_off(int row, int ch) { return 256 * row + 16 * (ch ^ (((row & 3) << 2) | ((row >> 2) & 3))); }
__device__ __forceinline__ void sattn_item(const Params& P, int b, int half, LAS unsigned char* lds, int tid, int wave, int lane) {
    unsigned char* ws = P.ws;
    const int r32 = lane & 31, g = lane >> 5;
    const bool is_cmp = wave < 4;
    const int qt = wave & 1, kb = (wave >> 1) & 1;
    const int ptv = ((const int*)P.in[I_PT])[b * NPG + half * 32 + (lane & 31)];
    const float* clat = P.in[I_CLAT]; const float* ckr = P.in[I_CKR];
#define SA_LOAD(S, h) do { const int pg_ = __builtin_amdgcn_readlane(ptv, (h) >> 2); const size_t prow_ = (size_t)pg_ * PAGE + (((h) & 3) << 5); \
        const char* lat_ = (const char*)(clat + prow_ * KVR); const char* kro_ = (const char*)(ckr + prow_ * ROPE); \
        _Pragma("unroll") for (int e = 0; e < 4; ++e) { S[2 * e] = *(const f32x4*)(lat_ + glb[e]); S[2 * e + 1] = *(const f32x4*)(lat_ + glb[e] + 16); } \
        S[8] = *(const f32x4*)(kro_ + grb); S[9] = *(const f32x4*)(kro_ + grb + 16); } while (0)
#define SA_WRITE(S, bufo, hh) do { \
        _Pragma("unroll") for (int e = 0; e < 4; ++e) *(LAS bf16x8*)(lds + (bufo) + llb[e][hh]) = pack8v(S[2 * e], S[2 * e + 1]); \
        *(LAS bf16x8*)(lds + (bufo) + lrb[hh]) = pack8v(S[8], S[9]); asm volatile("" ::: "memory"); } while (0)
    __syncthreads();
    *(LAS u32x4*)(lds + SA_QR + (tid >> 3) * 144 + (tid & 7) * 16) = *(const u32x4*)((const bf16_t*)(ws + WS_QS) + ((size_t)b * 64 + (tid >> 3)) * 320 + KVR + (tid & 7) * 8);
    {
      const bf16_t* qn = (const bf16_t*)(ws + WS_QBUF) + (size_t)(MP + b * DS + (r32 & 7)) * (NH * QH) + wave * QH + 8 * g;
      bf16x8 an[8];
#pragma unroll
      for (int ks = 0; ks < 8; ++ks) { u32x4 z = {0u, 0u, 0u, 0u}; if (r32 < DS) z = *(const u32x4*)(qn + 16 * ks); an[ks] = __builtin_bit_cast(bf16x8, z); }
      const bf16_t* wk = (const bf16_t*)(ws + WS_WUKB) + (size_t)r32 * 1024 + wave * NOPE + 8 * g;
#pragma unroll 2
      for (int nt = 0; nt < 8; ++nt) {
          f32x16 acc;
#pragma unroll
          for (int i = 0; i < 16; ++i) acc[i] = 0.f;
#pragma unroll
          for (int ks = 0; ks < 8; ++ks) acc = __builtin_amdgcn_mfma_f32_32x32x16_bf16(an[ks], *(const bf16x8*)(wk + (size_t)(32 * nt) * 1024 + 16 * ks), acc, 0, 0, 0);
#pragma unroll
          for (int i = 0; i < 4; ++i) *(LAS bf16_t*)(lds + SA_QI + ((i + 4 * g) * 8 + wave) * SA_QI_PITCH + (32 * nt + r32) * 2) = (bf16_t)f2bf(acc[i]);
      } }
    __syncthreads();
#define SA_KLD(ks) do { const int o0_ = ((ks) < 16) ? (((ks) >> 3) * 16384 + krow + 32 * (((ks) & 7) ^ (x_ >> 1))) : (krope + 32 * ((ks) - 16)); \
        ka_[(ks) & 3] = *(const LAS bf16x8*)(kb_ + o0_); \
        qa_[(ks) & 3] = ((ks) < 16) ? *(const LAS bf16x8*)(qil + 32 * (ks)) : *(const LAS bf16x8*)(qrl + 32 * ((ks) - 16)); } while (0)
#define SA_VLD(dst, vt) do { const LAS unsigned char* vb_ = kb_ + ((vt) >> 2) * 16384 + 8192 * kb; \
        const int c0_ = 4 * ((vt) & 3) + 2 * vsub + (p_ >> 1); \
        const int blo_ = 256 * (4 * gg + q_) + 16 * (c0_ ^ ((q_ << 2) | gg)) + 8 * (p_ & 1); \
        const int bhi_ = 256 * (4 * gg + q_ + 8) + 16 * (c0_ ^ ((q_ << 2) | (gg + 2))) + 8 * (p_ & 1); \
        _Pragma("unroll") for (int s2 = 0; s2 < 2; ++s2) { \
            const s16x4 lo_ = __builtin_amdgcn_ds_read_tr16_b64_v4i16((LAS s16x4*)(vb_ + blo_ + 4096 * s2)); \
            const s16x4 hi_ = __builtin_amdgcn_ds_read_tr16_b64_v4i16((LAS s16x4*)(vb_ + bhi_ + 4096 * s2)); \
            dst[s2] = (bf16x8){lo_[0], lo_[1], lo_[2], lo_[3], hi_[0], hi_[1], hi_[2], hi_[3]}; } } while (0)
#define SA_VMM(src, vt) do { _Pragma("unroll") for (int s2 = 0; s2 < 2; ++s2) O[vt] = __builtin_amdgcn_mfma_f32_32x32x16_bf16(src[s2], pf[s2], O[vt], 0, 0, 0); } while (0)
#define SA_COMPUTE(j, bufo) do { \
        const LAS unsigned char* kb_ = lds + (bufo); \
        f32x16 S0; \
        _Pragma("unroll") for (int i = 0; i < 16; ++i) S0[i] = 0.f; \
        int r32v = r32; asm volatile("" : "+v"(r32v)); \
        const int x_ = ((r32v & 3) << 2) | ((r32v >> 2) & 3); \
        const int krow = 256 * (r32v + 32 * kb) + 16 * ((g ^ x_) & 1), krope = SA_KR + (r32v + 32 * kb) * 144 + g * 16; \
        const LAS unsigned char* qrl = lds + SA_QR + (32 * qt + r32v) * 144 + g * 16; const LAS unsigned char* qil = lds + SA_QI + (32 * qt + r32v) * SA_QI_PITCH + g * 16; \
        bf16x8 ka_[4], qa_[4]; \
        SA_KLD(0); SA_KLD(1); SA_KLD(2); \
        _Pragma("unroll") for (int ks = 0; ks < 20; ++ks) { \
            if (ks + 3 < 20) SA_KLD(ks + 3); \
            __builtin_amdgcn_sched_barrier(0); \
            S0 = __builtin_amdgcn_mfma_f32_32x32x16_bf16(ka_[ks & 3], qa_[ks & 3], S0, 0, 0, 0); \
            __builtin_amdgcn_sched_barrier(0); } \
        if ((j) == 64) { const int tok = (32 * qt + r32) >> 3; asm volatile("" ::: "memory"); \
            _Pragma("unroll") for (int i = 0; i < 16; ++i) { const int key = 32 * kb + crow(i, g); if (key > tok || key >= DS) S0[i] = -1e30f; } } \
        float mx = S0[0]; \
        _Pragma("unroll") for (int i = 1; i < 16; ++i) mx = fmaxf(mx, S0[i]); \
        mx = fmaxf(mx, __shfl_xor(mx, 32)) * CEXP; \
        if (__any(mx > mrun + 11.5f)) { const float mnew = fmaxf(mrun, mx), alpha = __builtin_amdgcn_exp2f(mrun - mnew); mrun = mnew; lrun *= alpha; \
            _Pragma("unroll") for (int vt = 0; vt < 8; ++vt) _Pragma("unroll") for (int i = 0; i < 16; ++i) O[vt][i] *= alpha; } \
        int lnv = lane; asm volatile("" : "+v"(lnv)); \
        const int li = lnv & 15, q_ = li >> 2, p_ = li & 3, vsub = (lnv >> 4) & 1, gg = lnv >> 5; \
        bf16x8 fa_[2], fb_[2]; \
        SA_VLD(fa_, 0); SA_VLD(fb_, 1);                        \
        float ps = 0.f; \
        _Pragma("unroll") for (int i = 0; i < 16; ++i) { S0[i] = __builtin_amdgcn_exp2f(S0[i] * CEXP - mrun); ps += S0[i]; } \
        lrun += ps; \
        bf16x8 pf[2]; \
        { float tmp[8]; \
          _Pragma("unroll") for (int s2 = 0; s2 < 2; ++s2) { \
            _Pragma("unroll") for (int i = 0; i < 8; ++i) tmp[i] = S0[8 * s2 + i]; \
            pf[s2] = pack8(tmp); } } \
        __builtin_amdgcn_sched_barrier(0); \
        SA_VMM(fa_, 0); __builtin_amdgcn_sched_barrier(0); SA_VLD(fa_, 2); __builtin_amdgcn_sched_barrier(0); \
        SA_VMM(fb_, 1); __builtin_amdgcn_sched_barrier(0); SA_VLD(fb_, 3); __builtin_amdgcn_sched_barrier(0); \
        SA_VMM(fa_, 2); __builtin_amdgcn_sched_barrier(0); SA_VLD(fa_, 4); __builtin_amdgcn_sched_barrier(0); \
        SA_VMM(fb_, 3); __builtin_amdgcn_sched_barrier(0); SA_VLD(fb_, 5); __builtin_amdgcn_sched_barrier(0); \
        SA_VMM(fa_, 4); __builtin_amdgcn_sched_barrier(0); SA_VLD(fa_, 6); __builtin_amdgcn_sched_barrier(0); \
        SA_VMM(fb_, 5); __builtin_amdgcn_sched_barrier(0); SA_VLD(fb_, 7); __builtin_amdgcn_sched_barrier(0); \
        SA_VMM(fa_, 6); __builtin_amdgcn_sched_barrier(0); \
        SA_VMM(fb_, 7); } while (0)
#define SA_LOADER(j, SX, SY, bufn) do { \
        if ((j) + 1 < 64) { SA_WRITE(SX, bufn, 0); if (2 * (j) + 6 < 128) SA_LOAD(SX, 2 * (j) + 6); SA_WRITE(SY, bufn, 1); if (2 * (j) + 7 < 128) SA_LOAD(SY, 2 * (j) + 7); } \
        else if ((j) + 1 == 64 && half == 1) { \
            const char* cbn = (const char*)((const bf16_t*)(ws + WS_CB) + (size_t)(MP + b * DS) * KVR); const char* krn = (const char*)((const bf16_t*)(ws + WS_KRBS) + (size_t)(b * DS) * ROPE); \
            const int lz_ = tid - 256; \
            _Pragma("unroll") for (int hh = 0; hh < 2; ++hh) { \
                _Pragma("unroll") for (int e = 0; e < 4; ++e) { const int key = ((lz_ + 256 * e) >> 5) + 32 * hh; u32x4 z = {0u, 0u, 0u, 0u}; if (key < DS) z = *(const u32x4*)(cbn + (glb[e] >> 1)); *(LAS u32x4*)(lds + (bufn) + llb[e][hh]) = z; } \
                { const int key = (lz_ >> 3) + 32 * hh; u32x4 z = {0u, 0u, 0u, 0u}; if (key < DS) z = *(const u32x4*)(krn + (grb >> 1)); *(LAS u32x4*)(lds + (bufn) + lrb[hh]) = z; } } } } while (0)
#define SA_BAR() do { asm volatile("s_waitcnt lgkmcnt(0)" ::: "memory"); __builtin_amdgcn_s_barrier(); asm volatile("" ::: "memory"); } while (0)
    float* ml = (float*)(ws + WS_ML) + (size_t)(b * 2 + half) * 64 * 2;
    if (is_cmp) {
        SA_BAR();
        f32x16 O[8];
#pragma unroll
        for (int vt = 0; vt < 8; ++vt)
#pragma unroll
            for (int i = 0; i < 16; ++i) O[vt][i] = 0.f;
        float mrun = -1e30f, lrun = 0.f;
        int bo = 0;
        for (int j = 0; j < 64; ++j) {
            SA_COMPUTE(j, bo);
            bo = SA_BUF - bo;
            SA_BAR();
        }
        if (half == 1) { SA_COMPUTE(64, bo); SA_BAR(); }
        LAS float* xo = (LAS float*)(lds + qt * 32768); LAS float* xm = (LAS float*)(lds + 65536 + qt * 512);
        if (kb == 1) { xm[2 * lane] = mrun; xm[2 * lane + 1] = lrun;
#pragma unroll
            for (int vt = 0; vt < 8; ++vt)
#pragma unroll
                for (int i = 0; i < 16; ++i) xo[(vt * 16 + i) * 64 + lane] = O[vt][i]; }
        SA_BAR();
        if (kb == 0) {
            const float m1 = xm[2 * lane], l1 = xm[2 * lane + 1], mm = fmaxf(mrun, m1);
            const float a0 = __builtin_amdgcn_exp2f(mrun - mm), a1 = __builtin_amdgcn_exp2f(m1 - mm);
            const float ll = lrun * a0 + l1 * a1, lt = ll + __shfl_xor(ll, 32);
            const int q = 32 * qt + r32;
            if (g == 0) { ml[q * 2] = mm; ml[q * 2 + 1] = lt; }
#pragma unroll
            for (int vt = 0; vt < 8; ++vt) {
                float o[16];
#pragma unroll
                for (int i = 0; i < 16; ++i) o[i] = O[vt][i] * a0 + xo[(vt * 16 + i) * 64 + lane] * a1;
#pragma unroll
                for (int jq = 0; jq < 4; ++jq) { u32x2 w; w.x = pk2(o[4 * jq], o[4 * jq + 1]); w.y = pk2(o[4 * jq + 2], o[4 * jq + 3]);
                    *(LAS u32x2*)(lds + SA_OI + q * SA_QI_PITCH + (32 * vt + 8 * jq + 4 * g) * 2) = w; }
            }
        }
    } else {
        unsigned glb[4], llb[4][2], grb, lrb[2];
        { const int lz_ = tid - 256;
#pragma unroll
          for (int e = 0; e < 4; ++e) { const int gi = lz_ + 256 * e, key = gi >> 5, cg = gi & 31; glb[e] = (unsigned)(key * KVR + cg * 8) * 4u;
#pragma unroll
              for (int hh = 0; hh < 2; ++hh) llb[e][hh] = (unsigned)((cg >> 4) * 16384 + sa_off(key + 32 * hh, cg & 15)); }
          grb = (unsigned)((lz_ >> 3) * ROPE + (lz_ & 7) * 8) * 4u;
#pragma unroll
          for (int hh = 0; hh < 2; ++hh) lrb[hh] = (unsigned)(SA_KR + ((lz_ >> 3) + 32 * hh) * 144 + (lz_ & 7) * 16); }
        f32x4 s0[10], s1[10], s2[10], s3[10];
        SA_LOAD(s0, 0); SA_LOAD(s1, 1); SA_LOAD(s2, 2); SA_LOAD(s3, 3);
        SA_WRITE(s0, 0, 0); SA_LOAD(s0, 4); SA_WRITE(s1, 0, 1); SA_LOAD(s1, 5);
        SA_BAR();
        for (int j = 0; j < 64; j += 2) {
            SA_LOADER(j, s2, s3, SA_BUF);
            SA_BAR();
            SA_LOADER(j + 1, s0, s1, 0);
            SA_BAR();
        }
        if (half == 1) SA_BAR();
        SA_BAR();
    }
#undef SA_BAR
#undef SA_LOAD
#undef SA_WRITE
#undef SA_COMPUTE
#undef SA_KLD
#undef SA_VLD
#undef SA_VMM
#undef SA_LOADER

    float* parto = (float*)(ws + WS_PART) + (size_t)(b * 2 + half) * 64 * 128;
    __syncthreads();
    { bf16x8 ao[16];
#pragma unroll
      for (int ks = 0; ks < 16; ++ks) { u32x4 z = {0u, 0u, 0u, 0u}; if (r32 < DS) z = *(const LAS u32x4*)(lds + SA_OI + (r32 * 8 + wave) * SA_QI_PITCH + (16 * ks + 8 * g) * 2); ao[ks] = __builtin_bit_cast(bf16x8, z); }
      const bf16_t* wv = (const bf16_t*)(ws + WS_WUVT) + (size_t)(wave * VD + r32) * KVR + 8 * g;
#pragma unroll 2
      for (int nt = 0; nt < 4; ++nt) {
          f32x16 acc;
#pragma unroll
          for (int i = 0; i < 16; ++i) acc[i] = 0.f;
#pragma unroll
          for (int ks = 0; ks < 16; ++ks) acc = __builtin_amdgcn_mfma_f32_32x32x16_bf16(ao[ks], *(const bf16x8*)(wv + (size_t)(32 * nt) * KVR + 16 * ks), acc, 0, 0, 0);
#pragma unroll
          for (int i = 0; i < 4; ++i) parto[(size_t)((i + 4 * g) * 8 + wave) * 128 + 32 * nt + r32] = acc[i];
      } }
}

template <int W>
__device__ __forceinline__ void pool_chunk(const float* __restrict__ xr, int rvb, f32x4 gn, int col, int t0, bf16_t* __restrict__ drow) {
    f32x4 ring[W - 1]; f32x4 sum = {0.f, 0.f, 0.f, 0.f};
#pragma unroll
    for (int i = W - 1; i >= 1; --i) { f32x4 u = {0.f, 0.f, 0.f, 0.f};
        if (t0 - i >= 0) u = *(const f32x4*)(xr - (size_t)i * D + col) * __builtin_bit_cast(float, __builtin_amdgcn_readlane(rvb, 15 - i));
        ring[(W - 1 - i) % (W - 1)] = u; sum += u; }
#pragma unroll
    for (int r = 0; r < 16; ++r) {
        const f32x4 u = *(const f32x4*)(xr + (size_t)r * D + col) * __builtin_bit_cast(float, __builtin_amdgcn_readlane(rvb, 15 + r));
        sum += u;
        const int t = t0 + r; const float icnt = 1.0f / (float)((t + 1) < W ? (t + 1) : W);
        const f32x4 dd = (sum * icnt - u) * gn;
        u32x2 o; o.x = pk2(dd.x, dd.y); o.y = pk2(dd.z, dd.w);
        *(u32x2*)(drow + (size_t)r * D + col) = o;
        sum -= ring[r % (W - 1)]; ring[r % (W - 1)] = u;
    }
}
constexpr int NPH = 17;
__global__ void __launch_bounds__(512, 2) yoco_fwd(Params P) {
    extern __shared__ __attribute__((aligned(16))) unsigned char lds_raw[];
    LAS unsigned char* lds = (LAS unsigned char*)lds_raw;
    volatile LAS unsigned* MISC = (volatile LAS unsigned*)(lds + MISC_OFF);
    const int tid = threadIdx.x, lane = tid & 63, wave = __builtin_amdgcn_readfirstlane(tid >> 6);
    const int G = gridDim.x; const int bx = blockIdx.x; const int vcu = (G % 8 == 0) ? (bx % 8) * (G / 8) + bx / 8 : bx;
    unsigned char* ws = P.ws; float* out = P.out;
    for (int u = tid; u < 64; u += 512) MISC[u] = 0u;
    __syncthreads();
    XcdBarrier bar; bar.bar = (unsigned*)(ws + WS_CTL) + CW_BAR; bar.x = 0; bar.st = nullptr;
    if (MK_N_LAUNCHES == 1) bar = xcd_barrier_post((unsigned*)(ws + WS_CTL) + CW_BAR, MISC + 8);
    const int lo = P.ph_lo, hi = P.ph_hi;
#ifndef PH_MASK
#define PH_MASK 0xFFFFFFFFu
#endif
#define IN(k) (((PH_MASK >> (k)) & 1u) && lo <= (k) && (k) < hi)
#define SEAM(k) do { if (IN(k) && IN((k) + 1)) xcd_barrier(bar); } while (0)
#define SEAM2(k, kn) do { if (IN(k) && IN(kn)) xcd_barrier(bar); } while (0)
    const int gw = vcu * 8 + wave, NGW = G * 8;
    const int gtid = vcu * 512 + tid, NGT = G * 512;

#define wpool ((bf16_t*)(ws + WS_WPOOL))
#define wup ((bf16_t*)(ws + WS_WUP))
#define wdown ((bf16_t*)(ws + WS_WDOWN))
#define wgate ((bf16_t*)(ws + WS_WGATE))
#define wproj ((bf16_t*)(ws + WS_WPROJ))
#define wdkvq ((bf16_t*)(ws + WS_WDKVQ))
#define wuq ((bf16_t*)(ws + WS_WUQ))
#define wukt ((bf16_t*)(ws + WS_WUKT))
#define wuvt ((bf16_t*)(ws + WS_WUVT))
#define wukb ((bf16_t*)(ws + WS_WUKB))
#define wo ((bf16_t*)(ws + WS_WO))
#define cs ((float*)(ws + WS_CS))
#define rstd0 ((float*)(ws + WS_RSTD0))
#define dbuf ((bf16_t*)(ws + WS_DBUF))
#define pb ((bf16_t*)(ws + WS_PB))
#define hbA ((bf16_t*)(ws + WS_HBA))
#define hbB ((bf16_t*)(ws + WS_HBB))
#define ssq ((float*)(ws + WS_SSQ))
#define abuf ((bf16_t*)(ws + WS_ABUF))
#define proj ((bf16_t*)(ws + WS_PROJ))
#define raw ((float*)(ws + WS_RAW))
#define cb ((bf16_t*)(ws + WS_CB))
#define krbs ((bf16_t*)(ws + WS_KRBS))
#define cqb ((bf16_t*)(ws + WS_CQB))
#define rstdq ((float*)(ws + WS_RSTDQ))
#define qbuf ((bf16_t*)(ws + WS_QBUF))
#define qs ((bf16_t*)(ws + WS_QS))
#define kfull ((bf16_t*)(ws + WS_KFULL))
#define vt ((bf16_t*)(ws + WS_VT))
#define obuf ((bf16_t*)(ws + WS_OBUF))
    constexpr size_t SSQ_V = (size_t)M * 16;

    if (IN(0)) {
        LAS float* scr = (LAS float*)(lds + wave * 16384);
        int it = gw;
#define TI(W_, ks_, K_, N_, WT_, ro_) { const int n_items = ((K_) / 64) * ((N_) / 32); for (; it < n_items; it += NGW) transpose_item(W_, ks_, K_, N_, WT_, ro_, scr, it, lane); it -= n_items; }
        TI(P.in[I_POOLW] + 0 * 65536, nullptr, 256, 256, wpool, 0) TI(P.in[I_POOLW] + 1 * 65536, nullptr, 256, 256, wpool, 256)
        TI(P.in[I_POOLW] + 2 * 65536, nullptr, 256, 256, wpool, 512) TI(P.in[I_POOLW] + 3 * 65536, nullptr, 256, 256, wpool, 768)
        TI(P.in[I_WUP], P.in[I_NMLP], D, FF, wup, 0) TI(P.in[I_WUP] + (size_t)D * FF, P.in[I_NMLP] + D, D, FF, wup + (size_t)FF * D, 0)
        TI(P.in[I_WDOWN], nullptr, FF, D, wdown, 0) TI(P.in[I_WDOWN] + (size_t)D * FF, nullptr, FF, D, wdown + (size_t)FF * D, 0)
        TI(P.in[I_WGATE], P.in[I_NPLE], D, D, wgate, 0) TI(P.in[I_WGATE] + (size_t)D * D, P.in[I_NPLE] + D, D, D, wgate + (size_t)D * D, 0)
        TI(P.in[I_WPROJ], nullptr, PLE, D, wproj, 0) TI(P.in[I_WPROJ] + (size_t)PLE * D, nullptr, PLE, D, wproj + (size_t)PLE * D, 0)
        TI(P.in[I_WDKV], P.in[I_NKV], D, 320, wdkvq, 0) TI(P.in[I_WDQ], P.in[I_NMIX] + D, D, QR, wdkvq, 320)
        { const int n_items = (QR / 64) * (NH * QH / 32); for (; it < n_items; it += NGW) transpose_item<true>(P.in[I_WUQ], P.in[I_QN], QR, NH * QH, wuq, 0, scr, it, lane); it -= n_items; }
        TI(P.in[I_WUK], nullptr, KVR, 1024, wukt, 0) TI(P.in[I_WUV], nullptr, KVR, 1024, wuvt, 0)
        TI(P.in[I_WO], nullptr, D, D, wo, 0)
#undef TI
        for (int i = gtid; i < 64 * D / 8; i += NGT) *(u32x4*)(wdkvq + (size_t)704 * D + (size_t)i * 8) = (u32x4){0u, 0u, 0u, 0u};
        for (int i = gtid; i < 256 * 1024 / 8; i += NGT) { const f32x4 a = *(const f32x4*)(P.in[I_WUK] + (size_t)i * 8), c = *(const f32x4*)(P.in[I_WUK] + (size_t)i * 8 + 4); *(bf16x8*)(wukb + (size_t)i * 8) = pack8v(a, c); }
        for (int i = gtid; i < NPOS * 32; i += NGT) { const int pos = i >> 5, f = i & 31; const double inv = exp2(-(double)f * (13.287712379549449 / 32.0)); const double ang = (double)pos * inv;
            double sn, cn; sincos(ang, &sn, &cn); cs[(size_t)pos * 64 + f] = (float)cn; cs[(size_t)pos * 64 + 32 + f] = (float)sn; }
        for (int i = gtid; i < 2 * M * PLE / 8; i += NGT) { const int li = i / (M * PLE / 8), r8 = i % (M * PLE / 8); const size_t e = (size_t)r8 * 8; const int row = (int)(e / PLE), c = (int)(e % PLE);
            const float* src = row < MP ? P.in[I_PP] + ((size_t)li * MP + row) * PLE + c : P.in[I_PS] + ((size_t)li * MS + (row - MP)) * PLE + c;
            *(bf16x8*)(pb + ((size_t)li * M + row) * PLE + c) = pack8v(*(const f32x4*)src, *(const f32x4*)(src + 4)); }
        for (int row0 = gw; row0 < M; row0 += 2 * NGW) {
            f32x4 v[2][4];
#pragma unroll
            for (int rr = 0; rr < 2; ++rr) { const int row = row0 + rr * NGW; if (row < M) { const float* xr = row < MP ? P.in[I_XP] + (size_t)row * D : P.in[I_XS] + (size_t)(row - MP) * D;
#pragma unroll
                for (int j = 0; j < 4; ++j) v[rr][j] = ((const f32x4*)xr)[lane + 64 * j]; } }
#pragma unroll
            for (int rr = 0; rr < 2; ++rr) { const int row = row0 + rr * NGW; if (row < M) {
                float s = 0.f;
#pragma unroll
                for (int j = 0; j < 4; ++j) s += (v[rr][j].x * v[rr][j].x + v[rr][j].y * v[rr][j].y) + (v[rr][j].z * v[rr][j].z + v[rr][j].w * v[rr][j].w);
                const float rstd = 1.0f / sqrtf(wave_sum(s) * (1.0f / D) + EPS);
                if (lane == 0) rstd0[row] = rstd;
                float* po = nullptr;
                if (row < MP) { const int b = row >> 13, t = row & (SEQ - 1); if (t >= SEQ - 15) po = out + O_PP + ((size_t)b * 15 + (t - (SEQ - 15))) * D; }
                else { const int rs_ = row - MP, b = rs_ >> 3, t = rs_ & 7; po = out + O_PS + ((size_t)b * 15 + 7 + t) * D; }
                if (po) {
#pragma unroll
                    for (int j = 0; j < 4; ++j) { const f32x4 gn = ((const f32x4*)P.in[I_NMIX])[lane + 64 * j]; ((f32x4*)po)[lane + 64 * j] = v[rr][j] * rstd * gn; } }
            } }
        }
        for (int i = gtid; i < DB * 7 * D / 4; i += NGT) { const int b = i / (7 * D / 4), r = (i / (D / 4)) % 7, c = i % (D / 4);
            ((f32x4*)(out + O_PS + ((size_t)b * 15 + r) * D))[c] = ((const f32x4*)(P.in[I_SPOOL] + ((size_t)b * 15 + 8 + r) * D))[c]; }
    }
    SEAM(0);
    if (IN(1)) {
        for (int it = gw; it < (MP / 16) * 2; it += NGW) {
            const int chunk = it >> 1, hs = it & 1, row0 = chunk * 16, t0 = row0 & (SEQ - 1);
            const float rv = (lane < 31 && t0 - 15 + lane >= 0) ? rstd0[row0 - 15 + lane] : 0.f;
            const int rvb = __builtin_bit_cast(int, rv);
            const float* xr = P.in[I_XP] + (size_t)row0 * D; bf16_t* dr = dbuf + (size_t)row0 * D;
            if (hs == 0) { pool_chunk<2>(xr, rvb, *(const f32x4*)(P.in[I_NMIX] + 4 * lane), 4 * lane, t0, dr);
                           pool_chunk<16>(xr, rvb, *(const f32x4*)(P.in[I_NMIX] + 768 + 4 * lane), 768 + 4 * lane, t0, dr); }
            else         { pool_chunk<4>(xr, rvb, *(const f32x4*)(P.in[I_NMIX] + 256 + 4 * lane), 256 + 4 * lane, t0, dr);
                           pool_chunk<8>(xr, rvb, *(const f32x4*)(P.in[I_NMIX] + 512 + 4 * lane), 512 + 4 * lane, t0, dr); }
        }
        for (int row = MP + gw; row < M; row += NGW) {
            const bool isp = row < MP; const int t = isp ? (row & (SEQ - 1)) : ((row - MP) & 7); const int bs = isp ? 0 : ((row - MP) >> 3);
            const float* sp = P.in[I_SPOOL] + (size_t)bs * 15 * D;
            const float* xr = isp ? P.in[I_XP] + (size_t)row * D : P.in[I_XS] + (size_t)(row - MP) * D;
            const float rv = (lane < 16 && t - lane >= 0) ? rstd0[row - lane] : 0.f;
#pragma unroll
            for (int j = 0; j < 4; ++j) {
                const int w = 2 << j; const int col = 256 * j + 4 * lane;
                const f32x4 gn = *(const f32x4*)(P.in[I_NMIX] + col);
                const f32x4 u0 = *(const f32x4*)(xr + col) * __shfl(rv, 0); f32x4 sum = u0, hist = {0.f, 0.f, 0.f, 0.f};
#pragma unroll
                for (int i = 1; i < w; ++i) { const int tt = t - i; const float ri = __shfl(rv, i);
                    if (tt >= 0) sum += *(const f32x4*)(xr - (size_t)i * D + col) * ri;
                    else if (!isp) hist += *(const f32x4*)(sp + (size_t)(15 + tt) * D + col); }
                const float cnt = isp ? (float)((t + 1) < w ? (t + 1) : w) : (float)w;
                const f32x4 dd = (sum * gn + hist) / cnt - u0 * gn;
                u32x2 o; o.x = pk2(dd.x, dd.y); o.y = pk2(dd.z, dd.w);
                *(u32x2*)(dbuf + (size_t)row * D + col) = o;
            }
        }
    }
    SEAM(1);
    if (IN(2)) {
#ifndef SUBM
#define SUBM 7
#endif
        { SgH<0> E{P.in[I_XS], P.in[I_POOLSC], nullptr, nullptr, nullptr, hbA, ssq + 0 * SSQ_V};
          for (int u = vcu; u < 256; u += G) sg_gemm<4, 1>(lds, dbuf + (size_t)MP * D, D, 256, wpool, 256, u, E, tid, wave, lane); }
        { SgBf E{proj, D};
          for (int u = vcu; u < 256; u += G) sg_gemm<4, 1>(lds, pb + (size_t)MP * PLE, PLE, 0, wproj, PLE, u, E, tid, wave, lane); }
        { SgBf E{proj + (size_t)M * D, D};
          for (int u = vcu; u < 256; u += G) sg_gemm<4, 1>(lds, pb + (size_t)(M + MP) * PLE, PLE, 0, wproj + (size_t)PLE * D, PLE, u, E, tid, wave, lane); }
        if (SUBM & 1) { pg8::Gemm g{dbuf, wpool, MP, D, 256, D, 256}; pg8::StaticOrder S; S.init(MP, D, G, bx);
          EpiH<0> E{P.in[I_XP], P.in[I_XS], P.in[I_POOLSC], nullptr, nullptr, nullptr, hbA, ssq + 0 * SSQ_V};
          pg8::gemm_phase(lds, g, S, E); }
        if (SUBM & 2) { pg8::Gemm g{pb, wproj, MP, D, PLE, PLE, 0}; pg8::StaticOrder S; S.init(MP, D, G, bx);
          EpiBf E{proj, D};
          pg8::gemm_phase(lds, g, S, E); }
        if (SUBM & 4) { pg8::Gemm g{pb + (size_t)M * PLE, wproj + (size_t)PLE * D, MP, D, PLE, PLE, 0}; pg8::StaticOrder S; S.init(MP, D, G, bx);
          EpiBf E{proj + (size_t)M * D, D};
          pg8::gemm_phase(lds, g, S, E); }
    }
    SEAM(2);
    if (IN(3)) {
        { SgUp E{ssq + 0 * SSQ_V, abuf}; for (int u = vcu; u < 256; u += G) sg_gemm<4, 4>(lds, hbA + (size_t)MP * D, D, 0, wup, D, u, E, tid, wave, lane); }
        pg8::Gemm g{hbA, wup, MP, FF, D, D, 0}; pg8::StaticOrder S; S.init(MP, FF, G, bx); EpiUp E{ssq + 0 * SSQ_V, abuf}; pg8::gemm_phase(lds, g, S, E); }
    SEAM(3);
    if (IN(4)) {
        { SgH<1> E{nullptr, nullptr, nullptr, nullptr, hbA, hbB, ssq + 1 * SSQ_V}; for (int u = vcu; u < 256; u += G) sg_gemm<4, 1>(lds, abuf + (size_t)MP * FF, FF, 0, wdown, FF, u, E, tid, wave, lane); }
        pg8::Gemm g{abuf, wdown, MP, D, FF, FF, 0}; pg8::StaticOrder S; S.init(MP, D, G, bx);
        EpiH<1> E{nullptr, nullptr, nullptr, nullptr, nullptr, hbA, hbB, ssq + 1 * SSQ_V}; pg8::gemm_phase(lds, g, S, E); }
    SEAM(4);
    if (IN(5)) {
        { SgH<2> E{nullptr, nullptr, ssq + 1 * SSQ_V, proj, hbB, hbA, ssq + 2 * SSQ_V}; for (int u = vcu; u < 256; u += G) sg_gemm<4, 1>(lds, hbB + (size_t)MP * D, D, 0, wgate, D, u, E, tid, wave, lane); }
        pg8::Gemm g{hbB, wgate, MP, D, D, D, 0}; pg8::StaticOrder S; S.init(MP, D, G, bx);
        EpiH<2> E{nullptr, nullptr, nullptr, ssq + 1 * SSQ_V, proj, hbB, hbA, ssq + 2 * SSQ_V}; pg8::gemm_phase(lds, g, S, E); }
    SEAM(5);
    if (IN(6)) {
        pg8::Gemm g{hbA, wdkvq, M, NDKVQ, D, D, 0}; pg8::StaticOrder S; S.init(M, NDKVQ, G, bx); EpiF32<1> E{raw, NDKVQ, ssq + 2 * SSQ_V}; pg8::gemm_phase(lds, g, S, E); }
    SEAM(6);
    if (IN(7)) {
        const f32x4 kvn = ((const f32x4*)P.in[I_KVN])[lane];
        for (int row0 = 2 * gw; row0 < M; row0 += 2 * NGW) {
            f32x4 c4[2], k1[2], k2[2], cn_[2], sn_[2]; f32x2 q2[2][3];
            const int l8 = lane & 7, hh = lane >> 3;
#pragma unroll
            for (int e = 0; e < 2; ++e) { const int row = row0 + e; const float* rr = raw + (size_t)row * NDKVQ;
                const int pos = row < MP ? (row & (SEQ - 1)) : PAST + ((row - MP) & 7);
                c4[e] = ((const f32x4*)rr)[lane];
                k1[e] = *(const f32x4*)(rr + 256 + 4 * l8); k2[e] = *(const f32x4*)(rr + 288 + 4 * l8);
                cn_[e] = *(const f32x4*)(cs + (size_t)pos * 64 + 4 * l8); sn_[e] = *(const f32x4*)(cs + (size_t)pos * 64 + 32 + 4 * l8);
#pragma unroll
                for (int k = 0; k < 3; ++k) q2[e][k] = *(const f32x2*)(rr + 320 + 2 * lane + 128 * k); }
#pragma unroll
            for (int e = 0; e < 2; ++e) { const int row = row0 + e; const bool isp = row < MP;
                const float sc = wave_sum((c4[e].x * c4[e].x + c4[e].y * c4[e].y) + (c4[e].z * c4[e].z + c4[e].w * c4[e].w));
                const float rc = 1.0f / sqrtf(sc * (1.0f / KVR) + EPS);
                const f32x4 cn = c4[e] * rc * kvn;
                float* lo_ = isp ? out + O_LP + (size_t)row * KVR : out + O_LS + (size_t)(row - MP) * KVR;
                ((f32x4*)lo_)[lane] = cn;
                { u32x2 o; o.x = pk2(cn.x, cn.y); o.y = pk2(cn.z, cn.w); ((u32x2*)(cb + (size_t)row * KVR))[lane] = o; }
                const f32x4 o1 = k1[e] * cn_[e] - k2[e] * sn_[e], o2 = k2[e] * cn_[e] + k1[e] * sn_[e];
                u32x2 w1, w2; w1.x = pk2(o1.x, o1.y); w1.y = pk2(o1.z, o1.w); w2.x = pk2(o2.x, o2.y); w2.y = pk2(o2.z, o2.w);
                if (hh == 0) { float* ko = isp ? out + O_KP + (size_t)row * ROPE : out + O_KS + (size_t)(row - MP) * ROPE; *(f32x4*)(ko + 4 * l8) = o1; *(f32x4*)(ko + 32 + 4 * l8) = o2;
                    if (!isp) { bf16_t* kd = krbs + (size_t)(row - MP) * ROPE; *(u32x2*)(kd + 4 * l8) = w1; *(u32x2*)(kd + 32 + 4 * l8) = w2; } }
                if (isp) { const int b = row >> 13, t = row & (SEQ - 1); bf16_t* kd = kfull + ((size_t)(b * NH + hh) * SEQ + t) * QH + NOPE; *(u32x2*)(kd + 4 * l8) = w1; *(u32x2*)(kd + 32 + 4 * l8) = w2; }
                float s = 0.f;
#pragma unroll
                for (int k = 0; k < 3; ++k) s += q2[e][k].x * q2[e][k].x + q2[e][k].y * q2[e][k].y;
                s = wave_sum(s);
                if (lane == 0) rstdq[row] = 1.0f / sqrtf(s * (1.0f / QR) + EPS);
#pragma unroll
                for (int k = 0; k < 3; ++k) *(unsigned*)(cqb + (size_t)row * QR + 2 * lane + 128 * k) = pk2(q2[e][k].x, q2[e][k].y); }
        }
    }
    SEAM(7);
    if (IN(8)) {
        if (SUBM & 1) { pg8::Gemm g{cqb, wuq, M, NH * QH, QR, QR, 0}; pg8::StaticOrder S; S.init(M, NH * QH, G, bx); EpiQ E{rstdq, cs, qbuf, qs}; pg8::gemm_phase(lds, g, S, E); }
        if (SUBM & 2) { pg8::Gemm g{cb, wukt, MP, 1024, KVR, KVR, 0}; pg8::StaticOrder S; S.init(MP, 1024, G, (bx + 128) % G); EpiKup E{kfull}; pg8::gemm_phase(lds, g, S, E); }
        if (SUBM & 4) { pg8::Gemm g{wuvt, cb, 1024, MP, KVR, KVR, 0}; pg8::StaticOrder S; S.init(1024, MP, G, (bx + 128) % G); EpiVup E{vt}; pg8::gemm_phase(lds, g, S, E); }
    }
    SEAM2(8, 10);
    if (IN(10)) {
        const bool sfirst = (bx >> 3) & 1;
        if (sfirst) for (int it = vcu; it < 2 * DB; it += G) sattn_item(P, it >> 1, it & 1, lds, tid, wave, lane);
        for (int u = vcu; u < 256; u += G) {
            const int bh = u >> 4, p = u & 15;
            attn_prompt_unit(qbuf, kfull, vt, obuf, bh >> 3, bh & 7, 31 - p, lds, tid, wave, lane);
            attn_prompt_unit(qbuf, kfull, vt, obuf, bh >> 3, bh & 7, p, lds, tid, wave, lane);
        }
        if (!sfirst) for (int it = vcu; it < 2 * DB; it += G) sattn_item(P, it >> 1, it & 1, lds, tid, wave, lane);
    }
    SEAM2(10, 12);
    if (IN(12)) {
        { SgH<1> E{nullptr, nullptr, nullptr, nullptr, hbA, hbB, ssq + 3 * SSQ_V}; const SgALoadComb AL{(const float*)(ws + WS_PART), (const float*)(ws + WS_ML)};
          for (int u = vcu; u < 256; u += G) sg_gemm_l<4, 1>(lds, AL, 0, wo, D, u, E, tid, wave, lane); }
        pg8::Gemm g{obuf, wo, MP, D, D, D, 0}; pg8::StaticOrder S; S.init(MP, D, G, bx);
        EpiH<1> E{nullptr, nullptr, nullptr, nullptr, nullptr, hbA, hbB, ssq + 3 * SSQ_V}; pg8::gemm_phase(lds, g, S, E); }
    SEAM(12);
    if (IN(13)) {
        { SgUp E{ssq + 3 * SSQ_V, abuf}; for (int u = vcu; u < 256; u += G) sg_gemm<4, 4>(lds, hbB + (size_t)MP * D, D, 0, wup + (size_t)FF * D, D, u, E, tid, wave, lane); }
        pg8::Gemm g{hbB, wup + (size_t)FF * D, MP, FF, D, D, 0}; pg8::StaticOrder S; S.init(MP, FF, G, bx); EpiUp E{ssq + 3 * SSQ_V, abuf}; pg8::gemm_phase(lds, g, S, E); }
    SEAM(13);
    if (IN(14)) {
        { SgH<1> E{nullptr, nullptr, nullptr, nullptr, hbB, hbA, ssq + 4 * SSQ_V}; for (int u = vcu; u < 256; u += G) sg_gemm<4, 1>(lds, abuf + (size_t)MP * FF, FF, 0, wdown + (size_t)FF * D, FF, u, E, tid, wave, lane); }
        pg8::Gemm g{abuf, wdown + (size_t)FF * D, MP, D, FF, FF, 0}; pg8::StaticOrder S; S.init(MP, D, G, bx);
        EpiH<1> E{nullptr, nullptr, nullptr, nullptr, nullptr, hbB, hbA, ssq + 4 * SSQ_V}; pg8::gemm_phase(lds, g, S, E); }
    SEAM(14);
    if (IN(15)) {
        { SgH<2> E{nullptr, nullptr, ssq + 4 * SSQ_V, proj + (size_t)M * D, hbA, hbB, ssq + 5 * SSQ_V}; for (int u = vcu; u < 256; u += G) sg_gemm<4, 1>(lds, hbA + (size_t)MP * D, D, 0, wgate + (size_t)D * D, D, u, E, tid, wave, lane); }
        pg8::Gemm g{hbA, wgate + (size_t)D * D, MP, D, D, D, 0}; pg8::StaticOrder S; S.init(MP, D, G, bx);
        EpiH<2> E{nullptr, nullptr, nullptr, ssq + 4 * SSQ_V, proj + (size_t)M * D, hbA, hbB, ssq + 5 * SSQ_V}; pg8::gemm_phase(lds, g, S, E); }
    SEAM(15);
    if (IN(16)) {
        f32x4 gn[4];
#pragma unroll
        for (int j = 0; j < 4; ++j) gn[j] = ((const f32x4*)P.in[I_NFIN])[lane + 64 * j];
        for (int row0 = 4 * gw; row0 < M; row0 += 4 * NGW) {
            u32x2 hv[4][4]; float sp[4];
#pragma unroll
            for (int e = 0; e < 4; ++e) { sp[e] = (lane < 16) ? ssq[5 * SSQ_V + (size_t)(row0 + e) * 16 + lane] : 0.f;
#pragma unroll
                for (int j = 0; j < 4; ++j) hv[e][j] = ((const u32x2*)(hbB + (size_t)(row0 + e) * D))[lane + 64 * j]; }
#pragma unroll
            for (int e = 0; e < 4; ++e) { const float rstd = 1.0f / sqrtf(wave_sum(sp[e]) * (1.0f / D) + EPS);
#pragma unroll
                for (int j = 0; j < 4; ++j) ((f32x4*)(out + O_Y + (size_t)(row0 + e) * D))[lane + 64 * j] = unpk4(hv[e][j]) * rstd * gn[j]; }
        }
    }
#undef IN
#undef SEAM
#undef SEAM2
#undef wpool
#undef wup
#undef wdown
#undef wgate
#undef wproj
#undef wdkvq
#undef wuq
#undef wukt
#undef wuvt
#undef wukb
#undef wo
#undef cs
#undef rstd0
#undef dbuf
#undef pb
#undef hbA
#undef hbB
#undef ssq
#undef abuf
#undef proj
#undef raw
#undef cb
#undef krbs
#undef cqb
#undef rstdq
#undef qbuf
#undef qs
#undef kfull
#undef vt
#undef obuf
}

extern "C" void kernel_launch(void* const* d_in, const int* in_sizes, int n_in, void* d_out, int out_size, void* d_ws, size_t ws_size, hipStream_t stream) {
    static int grid = 0;
    if (grid == 0) {
        if (n_in != 27 || (size_t)out_size != O_END || ws_size < WS_END) { fprintf(stderr, "kernel_launch: shape mismatch (n_in %d, out %d, ws %zu; need 27, %zu, %zu)\n", n_in, out_size, ws_size, (size_t)O_END, (size_t)WS_END); grid = -1; return; }
        int dev = 0, cus = 0, per_cu = 0;
        if (hipGetDevice(&dev) != hipSuccess || hipDeviceGetAttribute(&cus, hipDeviceAttributeMultiprocessorCount, dev) != hipSuccess) { grid = -1; return; }
        if (hipFuncSetAttribute((const void*)yoco_fwd, hipFuncAttributeMaxDynamicSharedMemorySize, LDS_BYTES) != hipSuccess) { fprintf(stderr, "kernel_launch: hipFuncSetAttribute failed\n"); grid = -1; return; }
        if (hipOccupancyMaxActiveBlocksPerMultiprocessor(&per_cu, (const void*)yoco_fwd, 512, LDS_BYTES) != hipSuccess || per_cu < 1) fprintf(stderr, "kernel_launch: occupancy query reports %d\n", per_cu);
        (void)hipGetLastError();
        grid = cus;
    }
    if (grid < 0) return;
    (void)hipMemsetAsync((char*)d_ws + WS_CTL, 0, CTL_BYTES, stream);
    Params p{};
    for (int i = 0; i < 27; ++i) p.in[i] = (const float*)d_in[i];
    p.out = (float*)d_out; p.ws = (unsigned char*)d_ws;
#if MK_N_LAUNCHES == 1
    p.ph_lo = 0; p.ph_hi = NPH;
    hipLaunchKernelGGL(yoco_fwd, dim3(grid), dim3(512), LDS_BYTES, stream, p);
#else
    for (int k = 0; k < NPH; ++k) { p.ph_lo = k; p.ph_hi = k + 1; hipLaunchKernelGGL(yoco_fwd, dim3(grid), dim3(512), LDS_BYTES, stream, p); }
#endif
    const hipError_t le = hipPeekAtLastError();
    if (le != hipSuccess) fprintf(stderr, "kernel_launch: launch failed: %s\n", hipGetErrorName(le));
}
```

```cpp
#include <hip/hip_runtime.h>
#include <cstdio>
#include <cstdint>

#ifndef MK_N_LAUNCHES
#define MK_N_LAUNCHES 1
#endif

#define GAS __attribute__((address_space(1)))
#define LAS __attribute__((address_space(3)))
typedef unsigned short bf16_t;
typedef short bf16x8 __attribute__((ext_vector_type(8)));
typedef float f32x4 __attribute__((ext_vector_type(4)));
typedef float f32x16 __attribute__((ext_vector_type(16)));
typedef unsigned u32x2 __attribute__((ext_vector_type(2)));
typedef unsigned u32x4 __attribute__((ext_vector_type(4)));

constexpr int D = 1024, FF = 4096, PLE = 256, SEQ = 8192, NBATCH = 2, DB = 128, DS = 8;
constexpr int MP = NBATCH * SEQ;
constexpr int MS = DB * DS;
constexpr int M = MP + MS;
constexpr int KVR = 256, ROPE = 64, QR = 384, NH = 8, NOPE = 128, VD = 128, QH = NOPE + ROPE;
constexpr int NDKVQ = 768;
constexpr int PAST = 8192, PAGE = 128, NPG = PAST / PAGE;
constexpr float EPS = 1e-6f;
constexpr float SM_SCALE = 0.07216878364870322f;
constexpr float LOG2E = 1.4426950408889634f;
constexpr float CEXP = SM_SCALE * LOG2E;
constexpr int NPOS = PAST + DS;

constexpr size_t O_Y = 0;
constexpr size_t O_PP = (size_t)M * D;
constexpr size_t O_PS = O_PP + (size_t)NBATCH * 15 * D;
constexpr size_t O_LP = O_PS + (size_t)DB * 15 * D;
constexpr size_t O_KP = O_LP + (size_t)MP * KVR;
constexpr size_t O_LS = O_KP + (size_t)MP * ROPE;
constexpr size_t O_KS = O_LS + (size_t)MS * KVR;
constexpr size_t O_END = O_KS + (size_t)MS * ROPE;

constexpr size_t al256(size_t x) { return (x + 255) / 256 * 256; }
constexpr size_t WS_CTL = 0, CTL_BYTES = 1u << 20;
constexpr size_t WS_WPOOL = CTL_BYTES;
constexpr size_t WS_WUP   = WS_WPOOL + al256((size_t)1024 * 256 * 2);
constexpr size_t WS_WDOWN = WS_WUP   + al256((size_t)2 * FF * D * 2);
constexpr size_t WS_WGATE = WS_WDOWN + al256((size_t)2 * FF * D * 2);
constexpr size_t WS_WPROJ = WS_WGATE + al256((size_t)2 * D * D * 2);
constexpr size_t WS_WDKVQ = WS_WPROJ + al256((size_t)2 * D * PLE * 2);
constexpr size_t WS_WUQ   = WS_WDKVQ + al256((size_t)NDKVQ * D * 2);
constexpr size_t WS_WUKT  = WS_WUQ   + al256((size_t)NH * QH * QR * 2);
constexpr size_t WS_WUVT  = WS_WUKT  + al256((size_t)1024 * 256 * 2);
constexpr size_t WS_WUKB  = WS_WUVT  + al256((size_t)1024 * 256 * 2);
constexpr size_t WS_WO    = WS_WUKB  + al256((size_t)1024 * 256 * 2);
constexpr size_t WS_CS    = WS_WO    + al256((size_t)D * D * 2);
constexpr size_t WS_RSTD0 = WS_CS    + al256((size_t)NPOS * 64 * 4);
constexpr size_t WS_DBUF  = WS_RSTD0 + al256((size_t)M * 4);
constexpr size_t WS_PB    = WS_DBUF  + al256((size_t)M * D * 2);
constexpr size_t WS_HBA   = WS_PB    + al256((size_t)2 * M * PLE * 2);
constexpr size_t WS_HBB   = WS_HBA   + al256((size_t)M * D * 2);
constexpr size_t WS_SSQ   = WS_HBB   + al256((size_t)M * D * 2);
constexpr size_t WS_ABUF  = WS_SSQ   + al256((size_t)6 * M * 16 * 4);
constexpr size_t WS_PROJ  = WS_ABUF  + al256((size_t)M * FF * 2);
constexpr size_t WS_RAW   = WS_PROJ  + al256((size_t)2 * M * D * 2);
constexpr size_t WS_CB    = WS_RAW   + al256((size_t)M * NDKVQ * 4);
constexpr size_t WS_KRBS  = WS_CB    + al256((size_t)M * KVR * 2);
constexpr size_t WS_CQB   = WS_KRBS  + al256((size_t)MS * ROPE * 2);
constexpr size_t WS_RSTDQ = WS_CQB   + al256((size_t)M * QR * 2);
constexpr size_t WS_QBUF  = WS_RSTDQ + al256((size_t)M * 4);
constexpr size_t WS_QS    = WS_QBUF  + al256((size_t)M * NH * QH * 2);
constexpr size_t WS_KFULL = WS_QS    + al256((size_t)MS * NH * 320 * 2);
constexpr size_t WS_VT    = WS_KFULL + al256((size_t)16 * SEQ * QH * 2);
constexpr size_t WS_OBUF  = WS_VT    + al256((size_t)16 * VD * SEQ * 2);
constexpr size_t WS_PART  = WS_OBUF  + al256((size_t)M * D * 2);
constexpr size_t WS_ML    = WS_PART  + al256((size_t)DB * 8 * 64 * 256 * 4);
constexpr size_t WS_END   = WS_ML    + al256((size_t)DB * 8 * 64 * 2 * 4);

constexpr int CW_BAR = 4096;

constexpr int RING_BYTES = 131072;
constexpr int LDS_BYTES = 147456;
constexpr int MISC_OFF = LDS_BYTES - 256;

typedef float f32x2 __attribute__((ext_vector_type(2)));
typedef __bf16 nbf16x2 __attribute__((ext_vector_type(2)));
__device__ __forceinline__ unsigned pk2(float lo, float hi) { const f32x2 v = {lo, hi}; return __builtin_bit_cast(unsigned, __builtin_convertvector(v, nbf16x2)); }
__device__ __forceinline__ unsigned f2bf(float f) { return pk2(f, 0.f) & 0xffffu; }
__device__ __forceinline__ float bf2f(unsigned short b) { return __builtin_bit_cast(float, ((unsigned)b) << 16); }
__device__ __forceinline__ f32x4 unpk4(u32x2 w) { f32x4 r; r.x = __builtin_bit_cast(float, w.x << 16); r.y = __builtin_bit_cast(float, w.x & 0xffff0000u); r.z = __builtin_bit_cast(float, w.y << 16); r.w = __builtin_bit_cast(float, w.y & 0xffff0000u); return r; }
__device__ __forceinline__ bf16x8 pack8(const float* v) { u32x4 w; w.x = pk2(v[0], v[1]); w.y = pk2(v[2], v[3]); w.z = pk2(v[4], v[5]); w.w = pk2(v[6], v[7]); return __builtin_bit_cast(bf16x8, w); }
__device__ __forceinline__ bf16x8 pack8v(f32x4 a, f32x4 b) { u32x4 w; w.x = pk2(a.x, a.y); w.y = pk2(a.z, a.w); w.z = pk2(b.x, b.y); w.w = pk2(b.z, b.w); return __builtin_bit_cast(bf16x8, w); }
__device__ __forceinline__ float wave_sum(float v) {
#pragma unroll
    for (int o = 1; o < 64; o <<= 1) v += __shfl_xor(v, o);
    return v;
}
__device__ __forceinline__ int crow(int r, int hi) { return (r & 3) + 8 * (r >> 2) + 4 * hi; }
#define LDS_WAIT() asm volatile("s_waitcnt lgkmcnt(0)" ::: "memory")
#define VM_WAIT() asm volatile("s_waitcnt vmcnt(0)" ::: "memory")

#define XB_TMO      128
#define XB_XCNT(j)  (256  + 64 * (j))
#define XB_XSUB(j)  (1280 + 64 * (j))
#define XB_XGEN(j)  (2304 + 64 * (j))
#define XB_TOP      3328
#define XB_TOPGEN   3392
#define XCD_BAR_WORDS 3456
#define XB_SPIN_CAP (1u << 18)
__device__ __forceinline__ unsigned xb_ld(unsigned* p)              { return __hip_atomic_load(p, __ATOMIC_RELAXED, __HIP_MEMORY_SCOPE_AGENT); }
__device__ __forceinline__ unsigned xb_add(unsigned* p, unsigned v) { return __hip_atomic_fetch_add(p, v, __ATOMIC_RELAXED, __HIP_MEMORY_SCOPE_AGENT); }
__device__ __forceinline__ unsigned xb_xcc_id() { return (unsigned)__builtin_amdgcn_s_getreg((3 << 11) | 20) & 0xFu; }
#define XB_SPIN(cond, bar) do { unsigned _sp = 0; while (cond) { __builtin_amdgcn_s_sleep(1); \
    if ((++_sp & 255u) == 0u) { if (xb_ld(&(bar)[XB_TMO])) break; if (_sp > XB_SPIN_CAP) { atomicAdd(&(bar)[XB_TMO], 1u); break; } } } } while (0)
struct XcdBarrier { unsigned* bar; unsigned x; volatile LAS unsigned* st; };
__device__ __forceinline__ XcdBarrier xcd_barrier_post(unsigned* bar, volatile LAS unsigned* st) {
    XcdBarrier b; b.bar = bar; b.x = xb_xcc_id(); b.st = st;
    if (threadIdx.x == 0) (void)xb_add(&bar[XB_XCNT(b.x)], 1u);
    return b;
}
__device__ __forceinline__ void xcd_barrier_complete(unsigned* bar, unsigned x, unsigned& nloc, unsigned& nx) {
    const unsigned G = gridDim.x * gridDim.y * gridDim.z;
    unsigned sum, cnt, mine, sp = 0u;
    for (;;) {
        sum = 0u; cnt = 0u; mine = 0u;
#pragma unroll
        for (unsigned j = 0; j < 16; ++j) { const unsigned c = xb_ld(&bar[XB_XCNT(j)]); sum += c; cnt += (c > 0u) ? 1u : 0u; mine = (j == x) ? c : mine; }
        if (sum == G) break;
        __builtin_amdgcn_s_sleep(1);
        if ((++sp & 255u) == 0u) { if (xb_ld(&bar[XB_TMO])) break; if (sp > XB_SPIN_CAP) { atomicAdd(&bar[XB_TMO], 1u); break; } }
    }
    nloc = mine > 0u ? mine : 1u; nx = cnt > 0u ? cnt : 1u;
}
__device__ __forceinline__ void xcd_barrier(const XcdBarrier& b) {
    asm volatile("s_waitcnt vmcnt(0)" ::: "memory");
    __syncthreads();
    if (threadIdx.x == 0) {
        unsigned* bar = b.bar;
        __builtin_amdgcn_s_waitcnt(0);
        unsigned nloc = b.st[0], nx = b.st[1];
        if (nloc == 0u) { xcd_barrier_complete(bar, b.x, nloc, nx); b.st[0] = nloc; b.st[1] = nx; }
        const unsigned old = xb_add(&bar[XB_XSUB(b.x)], 1u);
        const unsigned gen = old / nloc;
        if (old + 1u == (gen + 1u) * nloc) {
            __builtin_amdgcn_fence(__ATOMIC_RELEASE, "agent");
            asm volatile("s_waitcnt vmcnt(0)" ::: "memory");
            const unsigned og = xb_add(&bar[XB_TOP], 1u);
            const unsigned tg = og / nx;
            if (og + 1u == (tg + 1u) * nx) xb_add(&bar[XB_TOPGEN], 1u);
            else XB_SPIN(xb_ld(&bar[XB_TOPGEN]) == tg, bar);
            __builtin_amdgcn_fence(__ATOMIC_ACQUIRE, "agent");
            xb_add(&bar[XB_XGEN(b.x)], 1u);
            asm volatile("s_waitcnt vmcnt(0)" ::: "memory");
        } else {
            XB_SPIN(xb_ld(&bar[XB_XGEN(b.x)]) == gen, bar);
            __builtin_amdgcn_fence(__ATOMIC_ACQUIRE, "agent");
            asm volatile("s_waitcnt vmcnt(0)" ::: "memory");
        }
    }
    __syncthreads();
}

namespace pg8 {
constexpr int BM = 256, BK = 64, HALF = 128, HTB = HALF * BK * 2, STAGE_BYTES = 8 * HTB, NXCD = 8, WGM = 8;
__host__ __device__ __forceinline__ int lds_byte(int r, int c) { const int st = (r >> 4) * 2 + (c >> 5), rr = r & 15, cc = c & 31, ob = rr * 64 + cc * 2; return st * 1024 + (ob ^ (((ob >> 9) & 1) << 5)); }
__host__ __device__ __forceinline__ int perm32(int rho) { const int n = rho >> 4, i = rho & 15; return 8 * (i >> 2) + 4 * n + (i & 3); }
__host__ __device__ __forceinline__ void stage_rc(int b, int& R, int& C) { const int st = b / 1024, sb = b % 1024, swz = sb ^ (((sb >> 9) & 1) << 5); R = (st >> 1) * 16 + swz / 64; C = (st & 1) * 32 + (swz % 64) / 2; }
struct Unit { int pm, pn; };
struct Gemm { const bf16_t* A; const bf16_t* Bt; int M, N, K, lda, apn; };
struct StaticOrder {
    int nM, nN, nwg, G, c;
    __device__ __forceinline__ void init(int M, int N, int G_, int c_) { nM = M / BM; nN = N / BM; nwg = nM * nN; G = G_; c = c_; }
    __device__ __forceinline__ bool next(int i, Unit& u) const {
        const long L = (long)i * G + c; if (L >= nwg) return false;
        int wgid = (int)L; { const int q = nwg / NXCD, r = nwg % NXCD, xcd = wgid % NXCD, off = wgid / NXCD; wgid = (xcd < r ? xcd * (q + 1) : r * (q + 1) + (xcd - r) * q) + off; }
        const int nig = WGM * nN, gid = wgid / nig, fm = gid * WGM, gsz = (nM - fm) < WGM ? (nM - fm) : WGM;
        u.pm = fm + ((wgid % nig) % gsz); u.pn = (wgid % nig) / gsz; return true;
    }
};
template <class Epi>
__device__ __forceinline__ void gemm_phase(LAS unsigned char* lds, const Gemm g, const StaticOrder& S, const Epi& E) {
    const int tid = threadIdx.x, wid = __builtin_amdgcn_readfirstlane(tid >> 6), lane = tid & 63, wr = wid >> 2, wc = wid & 3, fr = lane & 15, fq = lane >> 4;
    const int K = g.K, nt = K / BK, lda = g.lda;
    unsigned voffA[2], voffB[2];
#pragma unroll
    for (int i = 0; i < 2; ++i) { int R, C; stage_rc(tid * 16 + i * 8192, R, C);
        const int Rb = Epi::PERM ? ((R & ~31) + perm32(R & 31)) : R;
        voffA[i] = (unsigned)(R * lda + C) * 2u; voffB[i] = (unsigned)(Rb * K + C) * 2u; }
    const size_t kstep = (size_t)(BK * 2);
    const size_t hstepA = (size_t)HALF * lda * 2, hstepB = (size_t)HALF * K * 2;
    const size_t tstepA = 2 * hstepA, tstepB = 2 * hstepB, pnA = (size_t)g.apn * 2;
    const unsigned ldsw = (unsigned)wid * 1024u;
    const int aoff = lds_byte(wr * 64 + fr, fq * 8), boff = lds_byte(wc * 32 + fr, fq * 8);
#define PG8_SA(b, h) (((b) * 2 + (h)) * HTB)
#define PG8_SB(b, h) ((4 + (b) * 2 + (h)) * HTB)
#define PG8_STAGE(bufoff, gbase, voff) do { _Pragma("unroll") for (int _i = 0; _i < 2; ++_i) \
        __builtin_amdgcn_global_load_lds((const unsigned*)((const char*)(gbase) + (voff)[_i]), (LAS unsigned*)(lds + (bufoff) + ldsw + _i * 8192), 16, 0, 0); } while (0)
#define PG8_LDA(dst, b, h) do { _Pragma("unroll") for (int m = 0; m < 4; ++m) _Pragma("unroll") for (int k = 0; k < 2; ++k) dst[m][k] = *(const LAS bf16x8*)(lds + PG8_SA(b, h) + aoff + m * 2048 + k * 1024); } while (0)
#define PG8_LDB(dst, b, h) do { _Pragma("unroll") for (int n = 0; n < 2; ++n) _Pragma("unroll") for (int k = 0; k < 2; ++k) dst[n][k] = *(const LAS bf16x8*)(lds + PG8_SB(b, h) + boff + n * 2048 + k * 1024); } while (0)
#define PG8_MMA(ai, bj, At, Bt) do { __builtin_amdgcn_s_setprio(1); _Pragma("unroll") for (int m = 0; m < 4; ++m) _Pragma("unroll") for (int n = 0; n < 2; ++n) _Pragma("unroll") for (int k = 0; k < 2; ++k) \
        acc[ai][bj][m][n] = __builtin_amdgcn_mfma_f32_16x16x32_bf16(Bt[n][k], At[m][k], acc[ai][bj][m][n], 0, 0, 0); __builtin_amdgcn_s_setprio(0); } while (0)
#define PG8_WAIT_V(n) asm volatile("s_waitcnt vmcnt(" #n ")" ::: "memory")
#define PG8_WAIT_L(n) asm volatile("s_waitcnt lgkmcnt(" #n ")" ::: "memory")
#define PG8_BAR __builtin_amdgcn_s_barrier()
#define PG8_SCHED __builtin_amdgcn_sched_barrier(0)
    Unit cur, nxt; int ui = 0;
    if (!S.next(0, cur)) return;
    f32x4 acc[2][2][4][2];
#pragma unroll
    for (int a = 0; a < 2; ++a)
#pragma unroll
        for (int b = 0; b < 2; ++b)
#pragma unroll
            for (int m = 0; m < 4; ++m)
#pragma unroll
                for (int n = 0; n < 2; ++n) acc[a][b][m][n] = (f32x4){0.f, 0.f, 0.f, 0.f};
    bf16x8 At[4][2], B0[2][2], B1[2][2];
    const char* cA = (const char*)g.A + (size_t)cur.pm * tstepA + (size_t)cur.pn * pnA; const char* cB = (const char*)g.Bt + (size_t)cur.pn * tstepB;
    PG8_STAGE(PG8_SB(0, 0), cB, voffB); PG8_STAGE(PG8_SB(0, 1), cB + hstepB, voffB); PG8_STAGE(PG8_SA(0, 0), cA, voffA); PG8_STAGE(PG8_SA(0, 1), cA + hstepA, voffA);
    if (wr == 1) PG8_BAR;
    PG8_WAIT_V(2); PG8_BAR;
    PG8_STAGE(PG8_SB(1, 0), cB + kstep, voffB); PG8_STAGE(PG8_SA(1, 0), cA + kstep, voffA); PG8_STAGE(PG8_SB(1, 1), cB + hstepB + kstep, voffB);
    PG8_WAIT_V(6); PG8_BAR;
    for (;;) {
        const bool has_next = S.next(ui + 1, nxt);
        const char* nA = has_next ? (const char*)g.A + (size_t)nxt.pm * tstepA + (size_t)nxt.pn * pnA : cA; const char* nB = has_next ? (const char*)g.Bt + (size_t)nxt.pn * tstepB : cB;
#pragma unroll 1
        for (int t = 0; t < nt; t += 2) {
            const bool last = (t == nt - 2);
            const char* a1 = cA + (size_t)(t + 1) * kstep;
            const char* a2 = last ? nA : cA + (size_t)(t + 2) * kstep; const char* b2 = last ? nB : cB + (size_t)(t + 2) * kstep;
            const char* a3 = a2 + kstep; const char* b3 = b2 + kstep;
            PG8_LDB(B0, 0, 0); PG8_LDB(B1, 0, 1); PG8_SCHED; PG8_LDA(At, 0, 0); PG8_STAGE(PG8_SA(1, 1), a1 + hstepA, voffA);
            PG8_WAIT_V(8); PG8_WAIT_L(0); PG8_BAR; PG8_MMA(0, 0, At, B0); PG8_MMA(0, 1, At, B1); PG8_BAR; PG8_SCHED;
            PG8_LDA(At, 0, 1); PG8_STAGE(PG8_SB(0, 0), b2, voffB); PG8_STAGE(PG8_SB(0, 1), b2 + hstepB, voffB); PG8_STAGE(PG8_SA(0, 0), a2, voffA);
            PG8_WAIT_V(8); PG8_WAIT_L(0); PG8_BAR; PG8_MMA(1, 0, At, B0); PG8_MMA(1, 1, At, B1); PG8_BAR; PG8_SCHED;
            PG8_LDB(B0, 1, 0); PG8_LDB(B1, 1, 1); PG8_SCHED; PG8_LDA(At, 1, 0); PG8_STAGE(PG8_SA(0, 1), a2 + hstepA, voffA);
            PG8_WAIT_V(8); PG8_WAIT_L(0); PG8_BAR; PG8_MMA(0, 0, At, B0); PG8_MMA(0, 1, At, B1); PG8_BAR; PG8_SCHED;
            PG8_LDA(At, 1, 1); PG8_STAGE(PG8_SB(1, 0), b3, voffB); PG8_STAGE(PG8_SB(1, 1), b3 + hstepB, voffB); PG8_STAGE(PG8_SA(1, 0), a3, voffA);
            PG8_WAIT_V(8); PG8_WAIT_L(0); PG8_BAR; PG8_MMA(1, 0, At, B0); PG8_MMA(1, 1, At, B1); PG8_BAR; PG8_SCHED;
        }
        if (wr == 0) PG8_BAR;
        E(acc, cur, wr, wc, fr, fq);
        if (!has_next) break;
#pragma unroll
        for (int a = 0; a < 2; ++a)
#pragma unroll
            for (int b = 0; b < 2; ++b)
#pragma unroll
                for (int m = 0; m < 4; ++m)
#pragma unroll
                    for (int n = 0; n < 2; ++n) acc[a][b][m][n] = (f32x4){0.f, 0.f, 0.f, 0.f};
        cur = nxt; cA = nA; cB = nB; ++ui;
        if (wr == 1) PG8_BAR;
    }
    PG8_WAIT_V(0);
    PG8_BAR;
#undef PG8_SA
#undef PG8_SB
#undef PG8_STAGE
#undef PG8_LDA
#undef PG8_LDB
#undef PG8_MMA
#undef PG8_WAIT_V
#undef PG8_WAIT_L
#undef PG8_BAR
#undef PG8_SCHED
}
}

struct Params { const float* in[27]; float* out; unsigned char* ws; int ph_lo, ph_hi; };
enum { I_XP = 0, I_XS, I_PP, I_PS, I_SPOOL, I_CLAT, I_CKR, I_PT, I_NMIX, I_NMLP, I_NPLE, I_POOLW, I_POOLSC, I_NKV, I_WDKV, I_KVN, I_WUK, I_WUV, I_WDQ, I_QN, I_WUQ, I_WO, I_WUP, I_WDOWN, I_WGATE, I_WPROJ, I_NFIN };

__device__ __forceinline__ void load_rstd(const float* ssq, const pg8::Unit& u, int wr, int fr, int fq, float (&rs)[2][4]) {
#pragma unroll
    for (int ai = 0; ai < 2; ++ai)
#pragma unroll
        for (int m = 0; m < 4; ++m) {
            const int row = u.pm * 256 + ai * 128 + wr * 64 + m * 16 + fr;
            const f32x4 a = ((const f32x4*)(ssq + (size_t)row * 16))[fq];
            float t = (a.x + a.y) + (a.z + a.w);
            t += __shfl_xor(t, 16); t += __shfl_xor(t, 32);
            rs[ai][m] = 1.0f / sqrtf(t * (1.0f / 1024.0f) + EPS);
        }
}
template <int MODE> struct EpiH {
    static constexpr bool PERM = true;
    const float* xp; const float* xs; const float* scale; const float* ssq_in; const bf16_t* proj;
    const bf16_t* hb_in; bf16_t* hb; float* ssq_out;
    __device__ __forceinline__ void operator()(const f32x4 (&acc)[2][2][4][2], const pg8::Unit& u, int wr, int wc, int fr_in, int fq_in) const {
        int fr = fr_in, fq = fq_in; asm volatile("" : "+v"(fr), "+v"(fq));
        float rs[2][4];
        if (MODE == 2) load_rstd(ssq_in, u, wr, fr, fq, rs);
        const int col0 = u.pn * 256 + wc * 32 + 8 * fq;
#pragma unroll
        for (int ai = 0; ai < 2; ++ai)
#pragma unroll
            for (int m = 0; m < 4; ++m) {
                const int row = u.pm * 256 + ai * 128 + wr * 64 + m * 16 + fr;
                float sq = 0.f;
#pragma unroll
                for (int bj = 0; bj < 2; ++bj) {
                    const int col = col0 + bj * 128;
                    f32x4 b0, b1;
                    if (MODE == 0) { const float* xr = (row < MP ? xp + (size_t)row * D : xs + (size_t)(row - MP) * D) + col; b0 = *(const f32x4*)xr; b1 = *(const f32x4*)(xr + 4); }
                    else { const u32x4 hv = *(const u32x4*)(hb_in + (size_t)row * D + col); b0 = unpk4((u32x2){hv.x, hv.y}); b1 = unpk4((u32x2){hv.z, hv.w}); }
                    const f32x4 a0 = acc[ai][bj][m][0], a1 = acc[ai][bj][m][1]; f32x4 o0, o1;
                    if (MODE == 0) { o0 = b0 + *(const f32x4*)(scale + col) * a0; o1 = b1 + *(const f32x4*)(scale + col + 4) * a1; }
                    else if (MODE == 1) { o0 = b0 + a0; o1 = b1 + a1; }
                    else { const u32x4 pv = *(const u32x4*)(proj + (size_t)row * D + col); const f32x4 p0 = unpk4((u32x2){pv.x, pv.y}), p1 = unpk4((u32x2){pv.z, pv.w}); const float r = rs[ai][m];
                        f32x4 g0, g1;
                        g0.x = 1.0f / (1.0f + __expf(-r * a0.x)); g0.y = 1.0f / (1.0f + __expf(-r * a0.y)); g0.z = 1.0f / (1.0f + __expf(-r * a0.z)); g0.w = 1.0f / (1.0f + __expf(-r * a0.w));
                        g1.x = 1.0f / (1.0f + __expf(-r * a1.x)); g1.y = 1.0f / (1.0f + __expf(-r * a1.y)); g1.z = 1.0f / (1.0f + __expf(-r * a1.z)); g1.w = 1.0f / (1.0f + __expf(-r * a1.w));
                        o0 = b0 + g0 * p0; o1 = b1 + g1 * p1; }
                    u32x4 w; w.x = pk2(o0.x, o0.y); w.y = pk2(o0.z, o0.w); w.z = pk2(o1.x, o1.y); w.w = pk2(o1.z, o1.w);
                    *(u32x4*)(hb + (size_t)row * D + col) = w;
                    sq += ((o0.x * o0.x + o0.y * o0.y) + (o0.z * o0.z + o0.w * o0.w)) + ((o1.x * o1.x + o1.y * o1.y) + (o1.z * o1.z + o1.w * o1.w));
                }
                sq += __shfl_xor(sq, 16); sq += __shfl_xor(sq, 32);
                if (fq == 0) ssq_out[(size_t)row * 16 + u.pn * 4 + wc] = sq;
                asm volatile("" ::: "memory");
            }
    }
};
struct EpiUp {
    static constexpr bool PERM = true;
    const float* ssq_in; bf16_t* abuf;
    __device__ __forceinline__ void operator()(const f32x4 (&acc)[2][2][4][2], const pg8::Unit& u, int wr, int wc, int fr_in, int fq_in) const {
        int fr = fr_in, fq = fq_in; asm volatile("" : "+v"(fr), "+v"(fq));
        float rs[2][4]; load_rstd(ssq_in, u, wr, fr, fq, rs);
        const int col0 = u.pn * 256 + wc * 32 + 8 * fq;
#pragma unroll
        for (int ai = 0; ai < 2; ++ai)
#pragma unroll
            for (int m = 0; m < 4; ++m) {
                const int row = u.pm * 256 + ai * 128 + wr * 64 + m * 16 + fr; const float r = rs[ai][m];
#pragma unroll
                for (int bj = 0; bj < 2; ++bj) {
                    f32x4 a = acc[ai][bj][m][0] * r, c = acc[ai][bj][m][1] * r;
                    a.x = fmaxf(a.x, 0.f); a.y = fmaxf(a.y, 0.f); a.z = fmaxf(a.z, 0.f); a.w = fmaxf(a.w, 0.f);
                    c.x = fmaxf(c.x, 0.f); c.y = fmaxf(c.y, 0.f); c.z = fmaxf(c.z, 0.f); c.w = fmaxf(c.w, 0.f);
                    u32x4 w; w.x = pk2(a.x * a.x, a.y * a.y); w.y = pk2(a.z * a.z, a.w * a.w); w.z = pk2(c.x * c.x, c.y * c.y); w.w = pk2(c.z * c.z, c.w * c.w);
                    *(u32x4*)(abuf + (size_t)row * FF + col0 + bj * 128) = w;
                }
            }
    }
};
template <int MODE> struct EpiF32 {
    static constexpr bool PERM = false;
    float* C; int ldc; const float* aux;
    __device__ __forceinline__ void operator()(const f32x4 (&acc)[2][2][4][2], const pg8::Unit& u, int wr, int wc, int fr_in, int fq_in) const {
        int fr = fr_in, fq = fq_in; asm volatile("" : "+v"(fr), "+v"(fq));
        float rs[2][4];
        if (MODE == 1) load_rstd(aux, u, wr, fr, fq, rs);
        const int col0 = u.pn * 256 + wc * 32 + 4 * fq;
#pragma unroll
        for (int ai = 0; ai < 2; ++ai)
#pragma unroll
            for (int m = 0; m < 4; ++m) {
                const int row = u.pm * 256 + ai * 128 + wr * 64 + m * 16 + fr;
                const float r = (MODE == 1) ? rs[ai][m] : (MODE == 2 ? aux[row] : 1.0f);
#pragma unroll
                for (int bj = 0; bj < 2; ++bj)
#pragma unroll
                    for (int n = 0; n < 2; ++n) *(f32x4*)(C + (size_t)row * ldc + col0 + bj * 128 + n * 16) = acc[ai][bj][m][n] * r;
            }
    }
};
struct EpiBf {
    static constexpr bool PERM = true;
    bf16_t* C; int ldc;
    __device__ __forceinline__ void operator()(const f32x4 (&acc)[2][2][4][2], const pg8::Unit& u, int wr, int wc, int fr_in, int fq_in) const {
        int fr = fr_in, fq = fq_in; asm volatile("" : "+v"(fr), "+v"(fq));
        const int col0 = u.pn * 256 + wc * 32 + 8 * fq;
#pragma unroll
        for (int ai = 0; ai < 2; ++ai)
#pragma unroll
            for (int m = 0; m < 4; ++m) {
                const int row = u.pm * 256 + ai * 128 + wr * 64 + m * 16 + fr;
#pragma unroll
                for (int bj = 0; bj < 2; ++bj) { const f32x4 a = acc[ai][bj][m][0], c = acc[ai][bj][m][1]; u32x4 w; w.x = pk2(a.x, a.y); w.y = pk2(a.z, a.w); w.z = pk2(c.x, c.y); w.w = pk2(c.z, c.w);
                    *(u32x4*)(C + (size_t)row * ldc + col0 + bj * 128) = w; }
            }
    }
};
__host__ __device__ __forceinline__ int qperm(int c) { const int e = c % QH; if (e < NOPE) return c; const int r = e - NOPE, i = r & 31, sec = r >> 5; return c - e + NOPE + 32 * (i >> 4) + 16 * sec + (i & 15); }
struct EpiQ {
    static constexpr bool PERM = false;
    const float* rstdq; const float* cs; bf16_t* qbuf; bf16_t* qs;
    __device__ __forceinline__ void operator()(const f32x4 (&acc)[2][2][4][2], const pg8::Unit& u, int wr, int wc, int fr_in, int fq_in) const {
        int fr = fr_in, fq = fq_in; asm volatile("" : "+v"(fr), "+v"(fq));
        const bool smp = u.pm >= MP / 256;
#pragma unroll
        for (int ai = 0; ai < 2; ++ai)
#pragma unroll
            for (int m = 0; m < 4; ++m) {
                const int row = u.pm * 256 + ai * 128 + wr * 64 + m * 16 + fr; const float r = rstdq[row]; const int pos = smp ? PAST + ((row - MP) & 7) : (row & (SEQ - 1));
                bf16_t* qrow = qbuf + (size_t)row * (NH * QH);
#pragma unroll
                for (int bj = 0; bj < 2; ++bj) {
                    const int Gi = u.pn * 8 + bj * 4 + wc, hh = Gi / 6, gi = Gi - hh * 6;
                    if (gi < 4) {
#pragma unroll
                        for (int n = 0; n < 2; ++n) { const f32x4 a = acc[ai][bj][m][n] * r; u32x2 w; w.x = pk2(a.x, a.y); w.y = pk2(a.z, a.w);
                            *(u32x2*)(qrow + Gi * 32 + n * 16 + 4 * fq) = w; }
                    } else {
                        const int i0 = 16 * (gi - 4) + 4 * fq;
                        const f32x4 x1 = acc[ai][bj][m][0] * r, x2 = acc[ai][bj][m][1] * r;
                        const f32x4 cn = *(const f32x4*)(cs + (size_t)pos * 64 + i0), sn = *(const f32x4*)(cs + (size_t)pos * 64 + 32 + i0);
                        const f32x4 o1 = x1 * cn - x2 * sn, o2 = x2 * cn + x1 * sn;
                        u32x2 w1, w2; w1.x = pk2(o1.x, o1.y); w1.y = pk2(o1.z, o1.w); w2.x = pk2(o2.x, o2.y); w2.y = pk2(o2.z, o2.w);
                        bf16_t* qd = smp ? qs + ((size_t)(row - MP) * NH + hh) * 320 + KVR : qrow + hh * QH + NOPE;
                        *(u32x2*)(qd + i0) = w1; *(u32x2*)(qd + 32 + i0) = w2;
                    }
                }
                asm volatile("" ::: "memory");
            }
    }
};
struct EpiKup {
    static constexpr bool PERM = true;
    bf16_t* kfull;
    __device__ __forceinline__ void operator()(const f32x4 (&acc)[2][2][4][2], const pg8::Unit& u, int wr, int wc, int fr_in, int fq_in) const {
        int fr = fr_in, fq = fq_in; asm volatile("" : "+v"(fr), "+v"(fq));
        const int col0 = u.pn * 256 + wc * 32 + 8 * fq;
#pragma unroll
        for (int ai = 0; ai < 2; ++ai)
#pragma unroll
            for (int m = 0; m < 4; ++m) {
                const int row = u.pm * 256 + ai * 128 + wr * 64 + m * 16 + fr; const int b = row >> 13, t = row & (SEQ - 1);
#pragma unroll
                for (int bj = 0; bj < 2; ++bj) { const int col = col0 + bj * 128; const int h = col >> 7, nn = col & 127; const f32x4 a = acc[ai][bj][m][0], c = acc[ai][bj][m][1];
                    u32x4 w; w.x = pk2(a.x, a.y); w.y = pk2(a.z, a.w); w.z = pk2(c.x, c.y); w.w = pk2(c.z, c.w);
                    *(u32x4*)(kfull + ((size_t)(b * NH + h) * SEQ + t) * QH + nn) = w; }
                asm volatile("" ::: "memory");
            }
    }
};
struct EpiVup {
    static constexpr bool PERM = true;
    bf16_t* vt;
    __device__ __forceinline__ void operator()(const f32x4 (&acc)[2][2][4][2], const pg8::Unit& u, int wr, int wc, int fr_in, int fq_in) const {
        int fr = fr_in, fq = fq_in; asm volatile("" : "+v"(fr), "+v"(fq));
        const int col0 = u.pn * 256 + wc * 32 + 8 * fq;
#pragma unroll
        for (int ai = 0; ai < 2; ++ai)
#pragma unroll
            for (int m = 0; m < 4; ++m) {
                const int row = u.pm * 256 + ai * 128 + wr * 64 + m * 16 + fr; const int h = row >> 7, v = row & 127;
#pragma unroll
                for (int bj = 0; bj < 2; ++bj) { const int col = col0 + bj * 128; const int b = col >> 13, t = col & (SEQ - 1); const f32x4 a = acc[ai][bj][m][0], c = acc[ai][bj][m][1];
                    u32x4 w; w.x = pk2(a.x, a.y); w.y = pk2(a.z, a.w); w.z = pk2(c.x, c.y); w.w = pk2(c.z, c.w);
                    *(u32x4*)(vt + ((size_t)(b * NH + h) * VD + v) * SEQ + t) = w; }
                asm volatile("" ::: "memory");
            }
    }
};

struct SgALoadBf { const bf16_t* A; int lda;
    __device__ __forceinline__ bf16x8 operator()(int row, int k) const { return *(const bf16x8*)(A + (size_t)row * lda + k); } };
struct SgALoadComb { const float* parto; const float* ml;
    __device__ __forceinline__ bf16x8 operator()(int row, int k) const {
        const int b = row >> 3, tok = row & 7, h = k >> 7, v = k & 127, q = tok * 8 + h;
        const float* m0p = ml + ((size_t)(b * 2 + 0) * 64 + q) * 2; const float* m1p = ml + ((size_t)(b * 2 + 1) * 64 + q) * 2;
        const float m0 = m0p[0], l0 = m0p[1], m1 = m1p[0], l1 = m1p[1], mx = fmaxf(m0, m1);
        float w0 = __builtin_amdgcn_exp2f(m0 - mx), w1 = __builtin_amdgcn_exp2f(m1 - mx); const float inv = 1.0f / (w0 * l0 + w1 * l1); w0 *= inv; w1 *= inv;
        const float* p0 = parto + ((size_t)(b * 2 + 0) * 64 + q) * 128 + v; const float* p1 = parto + ((size_t)(b * 2 + 1) * 64 + q) * 128 + v;
        return pack8v(*(const f32x4*)p0 * w0 + *(const f32x4*)p1 * w1, *(const f32x4*)(p0 + 4) * w0 + *(const f32x4*)(p1 + 4) * w1); } };
template <int NCT, int NCG, class Epi, class ALoad>
__device__ __forceinline__ void sg_gemm_l(LAS unsigned char* lds, const ALoad& AL, int apn256, const bf16_t* __restrict__ Bt, int K, int unit, const Epi& E, int tid, int wave, int lane) {
    constexpr int KS = 8 / NCG, W = NCG * NCT * 16, G4 = W / 4;
    static_assert(KS * 64 * W * 4 <= RING_BYTES, "sg_gemm reduction buffer");
    const int mt = unit >> 4, ntile = unit & 15, m0 = mt * 64, n0 = ntile * W;
    const int cg = wave % NCG, kp = wave / NCG, fr = lane & 15, fq = lane >> 4;
    const int Kw = K / KS;
    const int arow = m0 + fr, acol = (n0 >> 8) * apn256 + kp * Kw + 8 * fq;
    const bf16_t* bp = Bt + (size_t)(n0 + cg * NCT * 16 + fr) * K + kp * Kw + 8 * fq;
    f32x4 acc[4][NCT];
#pragma unroll
    for (int m = 0; m < 4; ++m)
#pragma unroll
        for (int n = 0; n < NCT; ++n) acc[m][n] = (f32x4){0.f, 0.f, 0.f, 0.f};
#pragma unroll 4
    for (int kk = 0; kk < Kw; kk += 32) {
        bf16x8 af[4], bfr[NCT];
#pragma unroll
        for (int m = 0; m < 4; ++m) af[m] = AL(arow + 16 * m, acol + kk);
#pragma unroll
        for (int n = 0; n < NCT; ++n) bfr[n] = *(const bf16x8*)(bp + (size_t)(16 * n) * K + kk);
#pragma unroll
        for (int m = 0; m < 4; ++m)
#pragma unroll
            for (int n = 0; n < NCT; ++n) acc[m][n] = __builtin_amdgcn_mfma_f32_16x16x32_bf16(bfr[n], af[m], acc[m][n], 0, 0, 0);
    }
    LAS float* red = (LAS float*)lds;
#pragma unroll
    for (int m = 0; m < 4; ++m)
#pragma unroll
        for (int n = 0; n < NCT; ++n) { const int row = 16 * m + fr, c4 = (cg * NCT * 16 + 16 * n) / 4 + fq;
            *(LAS f32x4*)(red + (size_t)(kp * 64 + row) * W + 4 * (c4 ^ (row & 3))) = acc[m][n]; }
    __syncthreads();
    for (int it = tid; it < 64 * G4; it += 512) {
        const int row = it / G4, c4 = it % G4;
        f32x4 v = *(const LAS f32x4*)(red + (size_t)row * W + 4 * (c4 ^ (row & 3)));
#pragma unroll
        for (int p = 1; p < KS; ++p) v += *(const LAS f32x4*)(red + (size_t)(p * 64 + row) * W + 4 * (c4 ^ (row & 3)));
        if constexpr (Epi::WHOLE_TILE) *(LAS f32x4*)(red + (size_t)row * W + 4 * (c4 ^ (row & 3))) = v;
        else E(MP + m0 + row, n0 + 4 * c4, v, ntile);
    }
    if constexpr (Epi::WHOLE_TILE) {
        __syncthreads();
        for (int it = tid; it < 64 * G4; it += 512) { const int row = it / G4, c4 = it % G4; E.tile(MP + m0 + row, n0, c4, red + (size_t)row * W, row & 3); }
    }
    __syncthreads();
}
template <int NCT, int NCG, class Epi>
__device__ __forceinline__ void sg_gemm(LAS unsigned char* lds, const bf16_t* __restrict__ A, int lda, int apn256, const bf16_t* __restrict__ Bt, int K, int unit, const Epi& E, int tid, int wave, int lane) {
    const SgALoadBf AL{A, lda}; sg_gemm_l<NCT, NCG>(lds, AL, apn256, Bt, K, unit, E, tid, wave, lane);
}
__device__ __forceinline__ float row_rstd16(const float* ssq, int row) {
    const f32x4* s = (const f32x4*)(ssq + (size_t)row * 16); const f32x4 a = s[0], b = s[1], c = s[2], d = s[3];
    const float t = ((a.x + a.y) + (a.z + a.w)) + ((b.x + b.y) + (b.z + b.w)) + ((c.x + c.y) + (c.z + c.w)) + ((d.x + d.y) + (d.z + d.w));
    return 1.0f / sqrtf(t * (1.0f / 1024.0f) + EPS);
}
template <int MODE> struct SgH {
    static constexpr bool WHOLE_TILE = false;
    const float* xs; const float* scale; const float* ssq_in; const bf16_t* proj; const bf16_t* hb_in; bf16_t* hb; float* ssq_out;
    __device__ __forceinline__ void operator()(int row, int col, f32x4 a, int ntile) const {
        const f32x4 bs = (MODE == 0) ? *(const f32x4*)(xs + (size_t)(row - MP) * D + col) : unpk4(*(const u32x2*)(hb_in + (size_t)row * D + col));
        f32x4 o;
        if (MODE == 0) o = bs + *(const f32x4*)(scale + col) * a;
        else if (MODE == 1) o = bs + a;
        else { const float r = row_rstd16(ssq_in, row); const f32x4 pj = unpk4(*(const u32x2*)(proj + (size_t)row * D + col));
            f32x4 gt; gt.x = 1.0f / (1.0f + __expf(-r * a.x)); gt.y = 1.0f / (1.0f + __expf(-r * a.y)); gt.z = 1.0f / (1.0f + __expf(-r * a.z)); gt.w = 1.0f / (1.0f + __expf(-r * a.w));
            o = bs + gt * pj; }
        u32x2 w; w.x = pk2(o.x, o.y); w.y = pk2(o.z, o.w);
        *(u32x2*)(hb + (size_t)row * D + col) = w;
        float sq = (o.x * o.x + o.y * o.y) + (o.z * o.z + o.w * o.w);
        sq += __shfl_xor(sq, 1); sq += __shfl_xor(sq, 2); sq += __shfl_xor(sq, 4); sq += __shfl_xor(sq, 8);
        if ((col & 63) == 0) ssq_out[(size_t)row * 16 + ntile] = sq;
    }
};
struct SgUp {
    static constexpr bool WHOLE_TILE = false;
    const float* ssq_in; bf16_t* abuf;
    __device__ __forceinline__ void operator()(int row, int col, f32x4 a, int) const {
        const float r = row_rstd16(ssq_in, row); a = a * r;
        a.x = fmaxf(a.x, 0.f); a.y = fmaxf(a.y, 0.f); a.z = fmaxf(a.z, 0.f); a.w = fmaxf(a.w, 0.f);
        u32x2 w; w.x = pk2(a.x * a.x, a.y * a.y); w.y = pk2(a.z * a.z, a.w * a.w);
        *(u32x2*)(abuf + (size_t)row * FF + col) = w;
    }
};
template <int MODE> struct SgF32 {
    static constexpr bool WHOLE_TILE = false;
    float* C; int ldc; const float* aux;
    __device__ __forceinline__ void operator()(int row, int col, f32x4 a, int) const {
        const float r = (MODE == 1) ? row_rstd16(aux, row) : (MODE == 2 ? aux[row] : 1.0f);
        *(f32x4*)(C + (size_t)row * ldc + col) = a * r;
    }
};
struct SgBf {
    static constexpr bool WHOLE_TILE = false;
    bf16_t* C; int ldc;
    __device__ __forceinline__ void operator()(int row, int col, f32x4 a, int) const { u32x2 w; w.x = pk2(a.x, a.y); w.y = pk2(a.z, a.w); *(u32x2*)(C + (size_t)row * ldc + col) = w; }
};
struct SgQ {
    static constexpr bool WHOLE_TILE = true;
    const float* rstdq; const float* cs; bf16_t* qbuf; bf16_t* qs;
    __device__ __forceinline__ void operator()(int, int, f32x4, int) const {}
    __device__ __forceinline__ void tile(int row, int n0, int c4, const LAS float* trow, int sw) const {
        const int c = n0 + 4 * c4, hh = c / QH, e = c - hh * QH; const float r = rstdq[row];
        const f32x4 v = *(const LAS f32x4*)(trow + 4 * (c4 ^ sw)) * r;
        if (e < NOPE) { u32x2 w; w.x = pk2(v.x, v.y); w.y = pk2(v.z, v.w); *(u32x2*)(qbuf + (size_t)row * (NH * QH) + c) = w; }
        else { const int rp = e - NOPE, wi = rp & 31;
            if (wi < 16) { const int i0 = 16 * (rp >> 5) + wi, pos = PAST + ((row - MP) & 7);
                const f32x4 x2 = *(const LAS f32x4*)(trow + 4 * ((c4 + 4) ^ sw)) * r;
                const f32x4 cn = *(const f32x4*)(cs + (size_t)pos * 64 + i0), sn = *(const f32x4*)(cs + (size_t)pos * 64 + 32 + i0);
                const f32x4 o1 = v * cn - x2 * sn, o2 = x2 * cn + v * sn;
                bf16_t* qd = qs + ((size_t)(row - MP) * NH + hh) * 320 + KVR;
                u32x2 w1, w2; w1.x = pk2(o1.x, o1.y); w1.y = pk2(o1.z, o1.w); w2.x = pk2(o2.x, o2.y); w2.y = pk2(o2.z, o2.w);
                *(u32x2*)(qd + i0) = w1; *(u32x2*)(qd + 32 + i0) = w2; } }
    }
};

template <bool QPERM = false>
__device__ __forceinline__ void transpose_item(const float* W, const float* kscale, int K, int N, bf16_t* WT, int row_off, LAS float* scr, int item, int lane) {
    const int nblk = N / 32, kb = item / nblk, nb = item % nblk, k0 = 64 * kb, n0 = 32 * nb;
    { f32x4 v[8];
#pragma unroll
      for (int i = 0; i < 8; ++i) v[i] = *(const f32x4*)(W + (size_t)(k0 + (lane >> 3) + 8 * i) * N + n0 + (lane & 7) * 4);
#pragma unroll
      for (int i = 0; i < 8; ++i) { const int kk = (lane >> 3) + 8 * i; f32x4 x = v[i]; if (kscale) x = x * kscale[k0 + kk];
          LAS float* d = scr + kk * 33 + (lane & 7) * 4; d[0] = x.x; d[1] = x.y; d[2] = x.z; d[3] = x.w; } }
    LDS_WAIT(); asm volatile("" ::: "memory");
    const int c = lane & 7;
#pragma unroll
    for (int j = 0; j < 4; ++j) { const int n = (lane >> 3) + 8 * j; const LAS float* s = scr + (8 * c) * 33 + n;
        u32x4 o; o.x = pk2(s[0 * 33], s[1 * 33]); o.y = pk2(s[2 * 33], s[3 * 33]); o.z = pk2(s[4 * 33], s[5 * 33]); o.w = pk2(s[6 * 33], s[7 * 33]);
        *(u32x4*)(WT + (size_t)(row_off + (QPERM ? qperm(n0 + n) : n0 + n)) * K + k0 + 8 * c) = o; }
    LDS_WAIT(); asm volatile("" ::: "memory");
}

constexpr int AK_PITCH = 400, AK_BUF = 64 * AK_PITCH;
constexpr int AV_PITCH = 136, AV_BUF = 128 * AV_PITCH;
constexpr int AV_OFF = 2 * AK_BUF, AQ_OFF = AV_OFF + 2 * AV_BUF;
static_assert(AQ_OFF + 256 * 144 <= RING_BYTES, "attention LDS");
__device__ __forceinline__ void attn_prompt_unit(const bf16_t* __restrict__ qbuf, const bf16_t* __restrict__ Kf, const bf16_t* __restrict__ Vt, bf16_t* __restrict__ obuf,
                                                 int b, int h, int qb, LAS unsigned char* lds, int tid, int wave, int lane) {
    const int r32 = lane & 31, g = lane >> 5;
    const int t_lo = qb * 256 + wave * 32, trow = t_lo + r32;
    bf16x8 qf[8];
    { const bf16_t* qp = qbuf + (size_t)(b * SEQ + trow) * (NH * QH) + h * QH + 8 * g;
      __syncthreads();
#pragma unroll
      for (int ks = 8; ks < 12; ++ks) *(LAS bf16x8*)(lds + AQ_OFF + (wave * 32 + r32) * 144 + (2 * (ks - 8) + g) * 16) = *(const bf16x8*)(qp + 16 * ks);
#pragma unroll
      for (int ks = 0; ks < 8; ++ks) qf[ks] = *(const bf16x8*)(qp + 16 * ks);
#pragma unroll
      for (int ks = 0; ks < 8; ++ks) asm volatile("" : "+v"(qf[ks])); }
    f32x16 O[4];
#pragma unroll
    for (int i = 0; i < 4; ++i)
#pragma unroll
        for (int j = 0; j < 16; ++j) O[i][j] = 0.f;
    float mrun = -1e30f, lrun = 0.f;
    const bf16_t* Kb = Kf + (size_t)(b * NH + h) * SEQ * QH;
    const bf16_t* Vb = Vt + (size_t)(b * NH + h) * VD * SEQ;
    const int NT = (qb + 1) * 4;
    int kl_off[3], vl_off[2]; size_t vg_off[2];
#pragma unroll
    for (int e = 0; e < 3; ++e) kl_off[e] = (tid >> 3) * AK_PITCH + ((tid & 7) + 8 * e) * 16;
#pragma unroll
    for (int e = 0; e < 2; ++e) { const int c = tid + 512 * e; vl_off[e] = AV_OFF + (c >> 3) * AV_PITCH + (c & 7) * 16; vg_off[e] = (size_t)(c >> 3) * SEQ + (c & 7) * 8; }
    u32x4 kst[3], vst[2];
#define AT_LOAD(j) do { _Pragma("unroll") for (int e = 0; e < 3; ++e) kst[e] = *(const u32x4*)(Kb + (size_t)(64 * (j) + (tid >> 3)) * QH + ((tid & 7) + 8 * e) * 8); \
                        _Pragma("unroll") for (int e = 0; e < 2; ++e) vst[e] = *(const u32x4*)(Vb + vg_off[e] + 64 * (j)); } while (0)
#define AT_WRITE(buf) do { _Pragma("unroll") for (int e = 0; e < 3; ++e) *(LAS u32x4*)(lds + (buf) * AK_BUF + kl_off[e]) = kst[e]; \
                           _Pragma("unroll") for (int e = 0; e < 2; ++e) { *(LAS u32x2*)(lds + (buf) * AV_BUF + vl_off[e]) = (u32x2){vst[e].x, vst[e].y}; *(LAS u32x2*)(lds + (buf) * AV_BUF + vl_off[e] + 8) = (u32x2){vst[e].z, vst[e].w}; } } while (0)
    AT_LOAD(0); AT_WRITE(0);
    __syncthreads();
    for (int j = 0; j < NT; ++j) {
        const int buf = j & 1;
        if (j + 1 < NT) AT_LOAD(j + 1);
        if (64 * j <= t_lo + 31) {
            f32x16 S0, S1;
#pragma unroll
            for (int i = 0; i < 16; ++i) { S0[i] = 0.f; S1[i] = 0.f; }
            const LAS unsigned char* kl = lds + buf * AK_BUF + r32 * AK_PITCH + g * 16;
            const LAS unsigned char* ql = lds + AQ_OFF + (wave * 32 + r32) * 144 + g * 16;
            bf16x8 ka[3][2], qr_[3];
#define AT_KLD(ks) do { ka[(ks) % 3][0] = *(const LAS bf16x8*)(kl + (ks) * 32); ka[(ks) % 3][1] = *(const LAS bf16x8*)(kl + 32 * AK_PITCH + (ks) * 32); \
                        if ((ks) >= 8) qr_[(ks) % 3] = *(const LAS bf16x8*)(ql + ((ks) - 8) * 32); } while (0)
            AT_KLD(0); AT_KLD(1);
#pragma unroll
            for (int ks = 0; ks < 12; ++ks) {
                if (ks + 2 < 12) AT_KLD(ks + 2);
                __builtin_amdgcn_sched_barrier(0);
                const bf16x8 qb_ = (ks < 8) ? qf[ks < 8 ? ks : 0] : qr_[ks % 3];
                S0 = __builtin_amdgcn_mfma_f32_32x32x16_bf16(ka[ks % 3][0], qb_, S0, 0, 0, 0);
                S1 = __builtin_amdgcn_mfma_f32_32x32x16_bf16(ka[ks % 3][1], qb_, S1, 0, 0, 0);
                __builtin_amdgcn_sched_barrier(0);
            }
#undef AT_KLD
            if (64 * j + 63 > t_lo) {
                asm volatile("" ::: "memory");
#pragma unroll
                for (int i = 0; i < 16; ++i) { const int key = 64 * j + crow(i, g); if (key > trow) S0[i] = -1e30f; if (key + 32 > trow) S1[i] = -1e30f; }
            }
            float mx = S0[0];
#pragma unroll
            for (int i = 1; i < 16; ++i) mx = fmaxf(mx, S0[i]);
#pragma unroll
            for (int i = 0; i < 16; ++i) mx = fmaxf(mx, S1[i]);
            mx = fmaxf(mx, __shfl_xor(mx, 32)) * CEXP;
            if (__any(mx > mrun + 11.5f)) {
                const float mnew = fmaxf(mrun, mx), alpha = __builtin_amdgcn_exp2f(mrun - mnew);
                mrun = mnew; lrun *= alpha;
#pragma unroll
                for (int vt = 0; vt < 4; ++vt)
#pragma unroll
                    for (int i = 0; i < 16; ++i) O[vt][i] *= alpha;
            }
            float ps = 0.f;
#pragma unroll
            for (int i = 0; i < 16; ++i) { S0[i] = __builtin_amdgcn_exp2f(S0[i] * CEXP - mrun); S1[i] = __builtin_amdgcn_exp2f(S1[i] * CEXP - mrun); ps += S0[i] + S1[i]; }
            lrun += ps;
            bf16x8 pf[4];
            { float tmp[8];
#pragma unroll
              for (int s2 = 0; s2 < 4; ++s2) {
#pragma unroll
                for (int i = 0; i < 8; ++i) tmp[i] = (s2 < 2) ? S0[8 * (s2 & 1) + i] : S1[8 * (s2 & 1) + i];
                pf[s2] = pack8(tmp); } }
            const LAS unsigned char* vl = lds + AV_OFF + buf * AV_BUF + r32 * AV_PITCH + g * 8;
            u32x4 fa[4], fb[4];
#define AT_VLD(dst, vt) do { _Pragma("unroll") for (int s2 = 0; s2 < 4; ++s2) { const u32x2 lo_ = *(const LAS u32x2*)(vl + (vt) * 32 * AV_PITCH + s2 * 32), hi_ = *(const LAS u32x2*)(vl + (vt) * 32 * AV_PITCH + s2 * 32 + 16); dst[s2] = (u32x4){lo_.x, lo_.y, hi_.x, hi_.y}; } } while (0)
#define AT_VMM(src, vt) do { _Pragma("unroll") for (int s2 = 0; s2 < 4; ++s2) O[vt] = __builtin_amdgcn_mfma_f32_32x32x16_bf16(__builtin_bit_cast(bf16x8, src[s2]), pf[s2], O[vt], 0, 0, 0); } while (0)
            AT_VLD(fa, 0); AT_VLD(fb, 1); __builtin_amdgcn_sched_barrier(0);
            AT_VMM(fa, 0); __builtin_amdgcn_sched_barrier(0);
            AT_VLD(fa, 2); __builtin_amdgcn_sched_barrier(0);
            AT_VMM(fb, 1); __builtin_amdgcn_sched_barrier(0);
            AT_VLD(fb, 3); __builtin_amdgcn_sched_barrier(0);
            AT_VMM(fa, 2); __builtin_amdgcn_sched_barrier(0);
            AT_VMM(fb, 3);
#undef AT_VLD
#undef AT_VMM
        }
        if (j + 1 < NT) AT_WRITE(buf ^ 1);
        __syncthreads();
    }
#undef AT_LOAD
#undef AT_WRITE
    const float ltot = lrun + __shfl_xor(lrun, 32), inv = 1.0f / ltot;
    bf16_t* op = obuf + (size_t)(b * SEQ + trow) * D + h * VD + 4 * g;
#pragma unroll
    for (int vt = 0; vt < 4; ++vt)
#pragma unroll
        for (int jq = 0; jq < 4; ++jq) {
            u32x2 w; w.x = pk2(O[vt][4 * jq] * inv, O[vt][4 * jq + 1] * inv); w.y = pk2(O[vt][4 * jq + 2] * inv, O[vt][4 * jq + 3] * inv);
            *(u32x2*)(op + 32 * vt + 8 * jq) = w;
        }
}

typedef short s16x4 __attribute__((ext_vector_type(4)));
constexpr int SA_KR = 32768, SA_BUF = 32768 + 64 * 144, SA_QR = 2 * SA_BUF, SA_QI = SA_QR + 64 * 144, SA_QI_PITCH = 528, SA_OI = 69632;
static_assert(SA_OI >= 65536 + 1024 && SA_OI + 64 * SA_QI_PITCH <= MISC_OFF, "O image");
static_assert(SA_QI + 64 * SA_QI_PITCH <= MISC_OFF, "sample attention LDS");
__device__ __forceinline__ int sa_off(int row, int ch) { return 256 * row + 16 * (ch ^ (((row & 3) << 2) | ((row >> 2) & 3))); }
__device__ __forceinline__ void sattn_item(const Params& P, int b, int half, LAS unsigned char* lds, int tid, int wave, int lane) {
    unsigned char* ws = P.ws;
    const int r32 = lane & 31, g = lane >> 5;
    const bool is_cmp = wave < 4;
    const int qt = wave & 1, kb = (wave >> 1) & 1;
    const int ptv = ((const int*)P.in[I_PT])[b * NPG + half * 32 + (lane & 31)];
    const float* clat = P.in[I_CLAT]; const float* ckr = P.in[I_CKR];
#define SA_LOAD(S, h) do { const int pg_ = __builtin_amdgcn_readlane(ptv, (h) >> 2); const size_t prow_ = (size_t)pg_ * PAGE + (((h) & 3) << 5); \
        const char* lat_ = (const char*)(clat + prow_ * KVR); const char* kro_ = (const char*)(ckr + prow_ * ROPE); \
        _Pragma("unroll") for (int e = 0; e < 4; ++e) { S[2 * e] = *(const f32x4*)(lat_ + glb[e]); S[2 * e + 1] = *(const f32x4*)(lat_ + glb[e] + 16); } \
        S[8] = *(const f32x4*)(kro_ + grb); S[9] = *(const f32x4*)(kro_ + grb + 16); } while (0)
#define SA_WRITE(S, bufo, hh) do { \
        _Pragma("unroll") for (int e = 0; e < 4; ++e) *(LAS bf16x8*)(lds + (bufo) + llb[e][hh]) = pack8v(S[2 * e], S[2 * e + 1]); \
        *(LAS bf16x8*)(lds + (bufo) + lrb[hh]) = pack8v(S[8], S[9]); asm volatile("" ::: "memory"); } while (0)
    __syncthreads();
    *(LAS u32x4*)(lds + SA_QR + (tid >> 3) * 144 + (tid & 7) * 16) = *(const u32x4*)((const bf16_t*)(ws + WS_QS) + ((size_t)b * 64 + (tid >> 3)) * 320 + KVR + (tid & 7) * 8);
    {
      const bf16_t* qn = (const bf16_t*)(ws + WS_QBUF) + (size_t)(MP + b * DS + (r32 & 7)) * (NH * QH) + wave * QH + 8 * g;
      bf16x8 an[8];
#pragma unroll
      for (int ks = 0; ks < 8; ++ks) { u32x4 z = {0u, 0u, 0u, 0u}; if (r32 < DS) z = *(const u32x4*)(qn + 16 * ks); an[ks] = __builtin_bit_cast(bf16x8, z); }
      const bf16_t* wk = (const bf16_t*)(ws + WS_WUKB) + (size_t)r32 * 1024 + wave * NOPE + 8 * g;
#pragma unroll 2
      for (int nt = 0; nt < 8; ++nt) {
          f32x16 acc;
#pragma unroll
          for (int i = 0; i < 16; ++i) acc[i] = 0.f;
#pragma unroll
          for (int ks = 0; ks < 8; ++ks) acc = __builtin_amdgcn_mfma_f32_32x32x16_bf16(an[ks], *(const bf16x8*)(wk + (size_t)(32 * nt) * 1024 + 16 * ks), acc, 0, 0, 0);
#pragma unroll
          for (int i = 0; i < 4; ++i) *(LAS bf16_t*)(lds + SA_QI + ((i + 4 * g) * 8 + wave) * SA_QI_PITCH + (32 * nt + r32) * 2) = (bf16_t)f2bf(acc[i]);
      } }
    __syncthreads();
#define SA_KLD(ks) do { const int o0_ = ((ks) < 16) ? (((ks) >> 3) * 16384 + krow + 32 * (((ks) & 7) ^ (x_ >> 1))) : (krope + 32 * ((ks) - 16)); \
        ka_[(ks) & 3] = *(const LAS bf16x8*)(kb_ + o0_); \
        qa_[(ks) & 3] = ((ks) < 16) ? *(const LAS bf16x8*)(qil + 32 * (ks)) : *(const LAS bf16x8*)(qrl + 32 * ((ks) - 16)); } while (0)
#define SA_VLD(dst, vt) do { const LAS unsigned char* vb_ = kb_ + ((vt) >> 2) * 16384 + 8192 * kb; \
        const int c0_ = 4 * ((vt) & 3) + 2 * vsub + (p_ >> 1); \
        const int blo_ = 256 * (4 * gg + q_) + 16 * (c0_ ^ ((q_ << 2) | gg)) + 8 * (p_ & 1); \
        const int bhi_ = 256 * (4 * gg + q_ + 8) + 16 * (c0_ ^ ((q_ << 2) | (gg + 2))) + 8 * (p_ & 1); \
        _Pragma("unroll") for (int s2 = 0; s2 < 2; ++s2) { \
            const s16x4 lo_ = __builtin_amdgcn_ds_read_tr16_b64_v4i16((LAS s16x4*)(vb_ + blo_ + 4096 * s2)); \
            const s16x4 hi_ = __builtin_amdgcn_ds_read_tr16_b64_v4i16((LAS s16x4*)(vb_ + bhi_ + 4096 * s2)); \
            dst[s2] = (bf16x8){lo_[0], lo_[1], lo_[2], lo_[3], hi_[0], hi_[1], hi_[2], hi_[3]}; } } while (0)
#define SA_VMM(src, vt) do { _Pragma("unroll") for (int s2 = 0; s2 < 2; ++s2) O[vt] = __builtin_amdgcn_mfma_f32_32x32x16_bf16(src[s2], pf[s2], O[vt], 0, 0, 0); } while (0)
#define SA_COMPUTE(j, bufo) do { \
        const LAS unsigned char* kb_ = lds + (bufo); \
        f32x16 S0; \
        _Pragma("unroll") for (int i = 0; i < 16; ++i) S0[i] = 0.f; \
        int r32v = r32; asm volatile("" : "+v"(r32v)); \
        const int x_ = ((r32v & 3) << 2) | ((r32v >> 2) & 3); \
        const int krow = 256 * (r32v + 32 * kb) + 16 * ((g ^ x_) & 1), krope = SA_KR + (r32v + 32 * kb) * 144 + g * 16; \
        const LAS unsigned char* qrl = lds + SA_QR + (32 * qt + r32v) * 144 + g * 16; const LAS unsigned char* qil = lds + SA_QI + (32 * qt + r32v) * SA_QI_PITCH + g * 16; \
        bf16x8 ka_[4], qa_[4]; \
        SA_KLD(0); SA_KLD(1); SA_KLD(2); \
        _Pragma("unroll") for (int ks = 0; ks < 20; ++ks) { \
            if (ks + 3 < 20) SA_KLD(ks + 3); \
            __builtin_amdgcn_sched_barrier(0); \
            S0 = __builtin_amdgcn_mfma_f32_32x32x16_bf16(ka_[ks & 3], qa_[ks & 3], S0, 0, 0, 0); \
            __builtin_amdgcn_sched_barrier(0); } \
        if ((j) == 64) { const int tok = (32 * qt + r32) >> 3; asm volatile("" ::: "memory"); \
            _Pragma("unroll") for (int i = 0; i < 16; ++i) { const int key = 32 * kb + crow(i, g); if (key > tok || key >= DS) S0[i] = -1e30f; } } \
        float mx = S0[0]; \
        _Pragma("unroll") for (int i = 1; i < 16; ++i) mx = fmaxf(mx, S0[i]); \
        mx = fmaxf(mx, __shfl_xor(mx, 32)) * CEXP; \
        if (__any(mx > mrun + 11.5f)) { const float mnew = fmaxf(mrun, mx), alpha = __builtin_amdgcn_exp2f(mrun - mnew); mrun = mnew; lrun *= alpha; \
            _Pragma("unroll") for (int vt = 0; vt < 8; ++vt) _Pragma("unroll") for (int i = 0; i < 16; ++i) O[vt][i] *= alpha; } \
        int lnv = lane; asm volatile("" : "+v"(lnv)); \
        const int li = lnv & 15, q_ = li >> 2, p_ = li & 3, vsub = (lnv >> 4) & 1, gg = lnv >> 5; \
        bf16x8 fa_[2], fb_[2]; \
        SA_VLD(fa_, 0); SA_VLD(fb_, 1);                        \
        float ps = 0.f; \
        _Pragma("unroll") for (int i = 0; i < 16; ++i) { S0[i] = __builtin_amdgcn_exp2f(S0[i] * CEXP - mrun); ps += S0[i]; } \
        lrun += ps; \
        bf16x8 pf[2]; \
        { float tmp[8]; \
          _Pragma("unroll") for (int s2 = 0; s2 < 2; ++s2) { \
            _Pragma("unroll") for (int i = 0; i < 8; ++i) tmp[i] = S0[8 * s2 + i]; \
            pf[s2] = pack8(tmp); } } \
        __builtin_amdgcn_sched_barrier(0); \
        SA_VMM(fa_, 0); __builtin_amdgcn_sched_barrier(0); SA_VLD(fa_, 2); __builtin_amdgcn_sched_barrier(0); \
        SA_VMM(fb_, 1); __builtin_amdgcn_sched_barrier(0); SA_VLD(fb_, 3); __builtin_amdgcn_sched_barrier(0); \
        SA_VMM(fa_, 2); __builtin_amdgcn_sched_barrier(0); SA_VLD(fa_, 4); __builtin_amdgcn_sched_barrier(0); \
        SA_VMM(fb_, 3); __builtin_amdgcn_sched_barrier(0); SA_VLD(fb_, 5); __builtin_amdgcn_sched_barrier(0); \
        SA_VMM(fa_, 4); __builtin_amdgcn_sched_barrier(0); SA_VLD(fa_, 6); __builtin_amdgcn_sched_barrier(0); \
        SA_VMM(fb_, 5); __builtin_amdgcn_sched_barrier(0); SA_VLD(fb_, 7); __builtin_amdgcn_sched_barrier(0); \
        SA_VMM(fa_, 6); __builtin_amdgcn_sched_barrier(0); \
        SA_VMM(fb_, 7); } while (0)
#define SA_LOADER(j, SX, SY, bufn) do { \
        if ((j) + 1 < 64) { SA_WRITE(SX, bufn, 0); if (2 * (j) + 6 < 128) SA_LOAD(SX, 2 * (j) + 6); SA_WRITE(SY, bufn, 1); if (2 * (j) + 7 < 128) SA_LOAD(SY, 2 * (j) + 7); } \
        else if ((j) + 1 == 64 && half == 1) { \
            const char* cbn = (const char*)((const bf16_t*)(ws + WS_CB) + (size_t)(MP + b * DS) * KVR); const char* krn = (const char*)((const bf16_t*)(ws + WS_KRBS) + (size_t)(b * DS) * ROPE); \
            const int lz_ = tid - 256; \
            _Pragma("unroll") for (int hh = 0; hh < 2; ++hh) { \
                _Pragma("unroll") for (int e = 0; e < 4; ++e) { const int key = ((lz_ + 256 * e) >> 5) + 32 * hh; u32x4 z = {0u, 0u, 0u, 0u}; if (key < DS) z = *(const u32x4*)(cbn + (glb[e] >> 1)); *(LAS u32x4*)(lds + (bufn) + llb[e][hh]) = z; } \
                { const int key = (lz_ >> 3) + 32 * hh; u32x4 z = {0u, 0u, 0u, 0u}; if (key < DS) z = *(const u32x4*)(krn + (grb >> 1)); *(LAS u32x4*)(lds + (bufn) + lrb[hh]) = z; } } } } while (0)
#define SA_BAR() do { asm volatile("s_waitcnt lgkmcnt(0)" ::: "memory"); __builtin_amdgcn_s_barrier(); asm volatile("" ::: "memory"); } while (0)
    float* ml = (float*)(ws + WS_ML) + (size_t)(b * 2 + half) * 64 * 2;
    if (is_cmp) {
        SA_BAR();
        f32x16 O[8];
#pragma unroll
        for (int vt = 0; vt < 8; ++vt)
#pragma unroll
            for (int i = 0; i < 16; ++i) O[vt][i] = 0.f;
        float mrun = -1e30f, lrun = 0.f;
        int bo = 0;
        for (int j = 0; j < 64; ++j) {
            SA_COMPUTE(j, bo);
            bo = SA_BUF - bo;
            SA_BAR();
        }
        if (half == 1) { SA_COMPUTE(64, bo); SA_BAR(); }
        LAS float* xo = (LAS float*)(lds + qt * 32768); LAS float* xm = (LAS float*)(lds + 65536 + qt * 512);
        if (kb == 1) { xm[2 * lane] = mrun; xm[2 * lane + 1] = lrun;
#pragma unroll
            for (int vt = 0; vt < 8; ++vt)
#pragma unroll
                for (int i = 0; i < 16; ++i) xo[(vt * 16 + i) * 64 + lane] = O[vt][i]; }
        SA_BAR();
        if (kb == 0) {
            const float m1 = xm[2 * lane], l1 = xm[2 * lane + 1], mm = fmaxf(mrun, m1);
            const float a0 = __builtin_amdgcn_exp2f(mrun - mm), a1 = __builtin_amdgcn_exp2f(m1 - mm);
            const float ll = lrun * a0 + l1 * a1, lt = ll + __shfl_xor(ll, 32);
            const int q = 32 * qt + r32;
            if (g == 0) { ml[q * 2] = mm; ml[q * 2 + 1] = lt; }
#pragma unroll
            for (int vt = 0; vt < 8; ++vt) {
                float o[16];
#pragma unroll
                for (int i = 0; i < 16; ++i) o[i] = O[vt][i] * a0 + xo[(vt * 16 + i) * 64 + lane] * a1;
#pragma unroll
                for (int jq = 0; jq < 4; ++jq) { u32x2 w; w.x = pk2(o[4 * jq], o[4 * jq + 1]); w.y = pk2(o[4 * jq + 2], o[4 * jq + 3]);
                    *(LAS u32x2*)(lds + SA_OI + q * SA_QI_PITCH + (32 * vt + 8 * jq + 4 * g) * 2) = w; }
            }
        }
    } else {
        unsigned glb[4], llb[4][2], grb, lrb[2];
        { const int lz_ = tid - 256;
#pragma unroll
          for (int e = 0; e < 4; ++e) { const int gi = lz_ + 256 * e, key = gi >> 5, cg = gi & 31; glb[e] = (unsigned)(key * KVR + cg * 8) * 4u;
#pragma unroll
              for (int hh = 0; hh < 2; ++hh) llb[e][hh] = (unsigned)((cg >> 4) * 16384 + sa_off(key + 32 * hh, cg & 15)); }
          grb = (unsigned)((lz_ >> 3) * ROPE + (lz_ & 7) * 8) * 4u;
#pragma unroll
          for (int hh = 0; hh < 2; ++hh) lrb[hh] = (unsigned)(SA_KR + ((lz_ >> 3) + 32 * hh) * 144 + (lz_ & 7) * 16); }
        f32x4 s0[10], s1[10], s2[10], s3[10];
        SA_LOAD(s0, 0); SA_LOAD(s1, 1); SA_LOAD(s2, 2); SA_LOAD(s3, 3);
        SA_WRITE(s0, 0, 0); SA_LOAD(s0, 4); SA_WRITE(s1, 0, 1); SA_LOAD(s1, 5);
        SA_BAR();
        for (int j = 0; j < 64; j += 2) {
            SA_LOADER(j, s2, s3, SA_BUF);
            SA_BAR();
            SA_LOADER(j + 1, s0, s1, 0);
            SA_BAR();
        }
        if (half == 1) SA_BAR();
        SA_BAR();
    }
#undef SA_BAR
#undef SA_LOAD
#undef SA_WRITE
#undef SA_COMPUTE
#undef SA_KLD
#undef SA_VLD
#undef SA_VMM
#undef SA_LOADER

    float* parto = (float*)(ws + WS_PART) + (size_t)(b * 2 + half) * 64 * 128;
    __syncthreads();
    { bf16x8 ao[16];
#pragma unroll
      for (int ks = 0; ks < 16; ++ks) { u32x4 z = {0u, 0u, 0u, 0u}; if (r32 < DS) z = *(const LAS u32x4*)(lds + SA_OI + (r32 * 8 + wave) * SA_QI_PITCH + (16 * ks + 8 * g) * 2); ao[ks] = __builtin_bit_cast(bf16x8, z); }
      const bf16_t* wv = (const bf16_t*)(ws + WS_WUVT) + (size_t)(wave * VD + r32) * KVR + 8 * g;
#pragma unroll 2
      for (int nt = 0; nt < 4; ++nt) {
          f32x16 acc;
#pragma unroll
          for (int i = 0; i < 16; ++i) acc[i] = 0.f;
#pragma unroll
          for (int ks = 0; ks < 16; ++ks) acc = __builtin_amdgcn_mfma_f32_32x32x16_bf16(ao[ks], *(const bf16x8*)(wv + (size_t)(32 * nt) * KVR + 16 * ks), acc, 0, 0, 0);
#pragma unroll
          for (int i = 0; i < 4; ++i) parto[(size_t)((i + 4 * g) * 8 + wave) * 128 + 32 * nt + r32] = acc[i];
      } }
}

template <int W>
__device__ __forceinline__ void pool_chunk(const float* __restrict__ xr, int rvb, f32x4 gn, int col, int t0, bf16_t* __restrict__ drow) {
    f32x4 ring[W - 1]; f32x4 sum = {0.f, 0.f, 0.f, 0.f};
#pragma unroll
    for (int i = W - 1; i >= 1; --i) { f32x4 u = {0.f, 0.f, 0.f, 0.f};
        if (t0 - i >= 0) u = *(const f32x4*)(xr - (size_t)i * D + col) * __builtin_bit_cast(float, __builtin_amdgcn_readlane(rvb, 15 - i));
        ring[(W - 1 - i) % (W - 1)] = u; sum += u; }
#pragma unroll
    for (int r = 0; r < 16; ++r) {
        const f32x4 u = *(const f32x4*)(xr + (size_t)r * D + col) * __builtin_bit_cast(float, __builtin_amdgcn_readlane(rvb, 15 + r));
        sum += u;
        const int t = t0 + r; const float icnt = 1.0f / (float)((t + 1) < W ? (t + 1) : W);
        const f32x4 dd = (sum * icnt - u) * gn;
        u32x2 o; o.x = pk2(dd.x, dd.y); o.y = pk2(dd.z, dd.w);
        *(u32x2*)(drow + (size_t)r * D + col) = o;
        sum -= ring[r % (W - 1)]; ring[r % (W - 1)] = u;
    }
}
constexpr int NPH = 17;
__global__ void __launch_bounds__(512, 2) yoco_fwd(Params P) {
    extern __shared__ __attribute__((aligned(16))) unsigned char lds_raw[];
    LAS unsigned char* lds = (LAS unsigned char*)lds_raw;
    volatile LAS unsigned* MISC = (volatile LAS unsigned*)(lds + MISC_OFF);
    const int tid = threadIdx.x, lane = tid & 63, wave = __builtin_amdgcn_readfirstlane(tid >> 6);
    const int G = gridDim.x; const int bx = blockIdx.x; const int vcu = (G % 8 == 0) ? (bx % 8) * (G / 8) + bx / 8 : bx;
    unsigned char* ws = P.ws; float* out = P.out;
    for (int u = tid; u < 64; u += 512) MISC[u] = 0u;
    __syncthreads();
    XcdBarrier bar; bar.bar = (unsigned*)(ws + WS_CTL) + CW_BAR; bar.x = 0; bar.st = nullptr;
    if (MK_N_LAUNCHES == 1) bar = xcd_barrier_post((unsigned*)(ws + WS_CTL) + CW_BAR, MISC + 8);
    const int lo = P.ph_lo, hi = P.ph_hi;
#ifndef PH_MASK
#define PH_MASK 0xFFFFFFFFu
#endif
#define IN(k) (((PH_MASK >> (k)) & 1u) && lo <= (k) && (k) < hi)
#define SEAM(k) do { if (IN(k) && IN((k) + 1)) xcd_barrier(bar); } while (0)
#define SEAM2(k, kn) do { if (IN(k) && IN(kn)) xcd_barrier(bar); } while (0)
    const int gw = vcu * 8 + wave, NGW = G * 8;
    const int gtid = vcu * 512 + tid, NGT = G * 512;

#define wpool ((bf16_t*)(ws + WS_WPOOL))
#define wup ((bf16_t*)(ws + WS_WUP))
#define wdown ((bf16_t*)(ws + WS_WDOWN))
#define wgate ((bf16_t*)(ws + WS_WGATE))
#define wproj ((bf16_t*)(ws + WS_WPROJ))
#define wdkvq ((bf16_t*)(ws + WS_WDKVQ))
#define wuq ((bf16_t*)(ws + WS_WUQ))
#define wukt ((bf16_t*)(ws + WS_WUKT))
#define wuvt ((bf16_t*)(ws + WS_WUVT))
#define wukb ((bf16_t*)(ws + WS_WUKB))
#define wo ((bf16_t*)(ws + WS_WO))
#define cs ((float*)(ws + WS_CS))
#define rstd0 ((float*)(ws + WS_RSTD0))
#define dbuf ((bf16_t*)(ws + WS_DBUF))
#define pb ((bf16_t*)(ws + WS_PB))
#define hbA ((bf16_t*)(ws + WS_HBA))
#define hbB ((bf16_t*)(ws + WS_HBB))
#define ssq ((float*)(ws + WS_SSQ))
#define abuf ((bf16_t*)(ws + WS_ABUF))
#define proj ((bf16_t*)(ws + WS_PROJ))
#define raw ((float*)(ws + WS_RAW))
#define cb ((bf16_t*)(ws + WS_CB))
#define krbs ((bf16_t*)(ws + WS_KRBS))
#define cqb ((bf16_t*)(ws + WS_CQB))
#define rstdq ((float*)(ws + WS_RSTDQ))
#define qbuf ((bf16_t*)(ws + WS_QBUF))
#define qs ((bf16_t*)(ws + WS_QS))
#define kfull ((bf16_t*)(ws + WS_KFULL))
#define vt ((bf16_t*)(ws + WS_VT))
#define obuf ((bf16_t*)(ws + WS_OBUF))
    constexpr size_t SSQ_V = (size_t)M * 16;

    if (IN(0)) {
        LAS float* scr = (LAS float*)(lds + wave * 16384);
        int it = gw;
#define TI(W_, ks_, K_, N_, WT_, ro_) { const int n_items = ((K_) / 64) * ((N_) / 32); for (; it < n_items; it += NGW) transpose_item(W_, ks_, K_, N_, WT_, ro_, scr, it, lane); it -= n_items; }
        TI(P.in[I_POOLW] + 0 * 65536, nullptr, 256, 256, wpool, 0) TI(P.in[I_POOLW] + 1 * 65536, nullptr, 256, 256, wpool, 256)
        TI(P.in[I_POOLW] + 2 * 65536, nullptr, 256, 256, wpool, 512) TI(P.in[I_POOLW] + 3 * 65536, nullptr, 256, 256, wpool, 768)
        TI(P.in[I_WUP], P.in[I_NMLP], D, FF, wup, 0) TI(P.in[I_WUP] + (size_t)D * FF, P.in[I_NMLP] + D, D, FF, wup + (size_t)FF * D, 0)
        TI(P.in[I_WDOWN], nullptr, FF, D, wdown, 0) TI(P.in[I_WDOWN] + (size_t)D * FF, nullptr, FF, D, wdown + (size_t)FF * D, 0)
        TI(P.in[I_WGATE], P.in[I_NPLE], D, D, wgate, 0) TI(P.in[I_WGATE] + (size_t)D * D, P.in[I_NPLE] + D, D, D, wgate + (size_t)D * D, 0)
        TI(P.in[I_WPROJ], nullptr, PLE, D, wproj, 0) TI(P.in[I_WPROJ] + (size_t)PLE * D, nullptr, PLE, D, wproj + (size_t)PLE * D, 0)
        TI(P.in[I_WDKV], P.in[I_NKV], D, 320, wdkvq, 0) TI(P.in[I_WDQ], P.in[I_NMIX] + D, D, QR, wdkvq, 320)
        { const int n_items = (QR / 64) * (NH * QH / 32); for (; it < n_items; it += NGW) transpose_item<true>(P.in[I_WUQ], P.in[I_QN], QR, NH * QH, wuq, 0, scr, it, lane); it -= n_items; }
        TI(P.in[I_WUK], nullptr, KVR, 1024, wukt, 0) TI(P.in[I_WUV], nullptr, KVR, 1024, wuvt, 0)
        TI(P.in[I_WO], nullptr, D, D, wo, 0)
#undef TI
        for (int i = gtid; i < 64 * D / 8; i += NGT) *(u32x4*)(wdkvq + (size_t)704 * D + (size_t)i * 8) = (u32x4){0u, 0u, 0u, 0u};
        for (int i = gtid; i < 256 * 1024 / 8; i += NGT) { const f32x4 a = *(const f32x4*)(P.in[I_WUK] + (size_t)i * 8), c = *(const f32x4*)(P.in[I_WUK] + (size_t)i * 8 + 4); *(bf16x8*)(wukb + (size_t)i * 8) = pack8v(a, c); }
        for (int i = gtid; i < NPOS * 32; i += NGT) { const int pos = i >> 5, f = i & 31; const double inv = exp2(-(double)f * (13.287712379549449 / 32.0)); const double ang = (double)pos * inv;
            double sn, cn; sincos(ang, &sn, &cn); cs[(size_t)pos * 64 + f] = (float)cn; cs[(size_t)pos * 64 + 32 + f] = (float)sn; }
        for (int i = gtid; i < 2 * M * PLE / 8; i += NGT) { const int li = i / (M * PLE / 8), r8 = i % (M * PLE / 8); const size_t e = (size_t)r8 * 8; const int row = (int)(e / PLE), c = (int)(e % PLE);
            const float* src = row < MP ? P.in[I_PP] + ((size_t)li * MP + row) * PLE + c : P.in[I_PS] + ((size_t)li * MS + (row - MP)) * PLE + c;
            *(bf16x8*)(pb + ((size_t)li * M + row) * PLE + c) = pack8v(*(const f32x4*)src, *(const f32x4*)(src + 4)); }
        for (int row0 = gw; row0 < M; row0 += 2 * NGW) {
            f32x4 v[2][4];
#pragma unroll
            for (int rr = 0; rr < 2; ++rr) { const int row = row0 + rr * NGW; if (row < M) { const float* xr = row < MP ? P.in[I_XP] + (size_t)row * D : P.in[I_XS] + (size_t)(row - MP) * D;
#pragma unroll
                for (int j = 0; j < 4; ++j) v[rr][j] = ((const f32x4*)xr)[lane + 64 * j]; } }
#pragma unroll
            for (int rr = 0; rr < 2; ++rr) { const int row = row0 + rr * NGW; if (row < M) {
                float s = 0.f;
#pragma unroll
                for (int j = 0; j < 4; ++j) s += (v[rr][j].x * v[rr][j].x + v[rr][j].y * v[rr][j].y) + (v[rr][j].z * v[rr][j].z + v[rr][j].w * v[rr][j].w);
                const float rstd = 1.0f / sqrtf(wave_sum(s) * (1.0f / D) + EPS);
                if (lane == 0) rstd0[row] = rstd;
                float* po = nullptr;
                if (row < MP) { const int b = row >> 13, t = row & (SEQ - 1); if (t >= SEQ - 15) po = out + O_PP + ((size_t)b * 15 + (t - (SEQ - 15))) * D; }
                else { const int rs_ = row - MP, b = rs_ >> 3, t = rs_ & 7; po = out + O_PS + ((size_t)b * 15 + 7 + t) * D; }
                if (po) {
#pragma unroll
                    for (int j = 0; j < 4; ++j) { const f32x4 gn = ((const f32x4*)P.in[I_NMIX])[lane + 64 * j]; ((f32x4*)po)[lane + 64 * j] = v[rr][j] * rstd * gn; } }
            } }
        }
        for (int i = gtid; i < DB * 7 * D / 4; i += NGT) { const int b = i / (7 * D / 4), r = (i / (D / 4)) % 7, c = i % (D / 4);
            ((f32x4*)(out + O_PS + ((size_t)b * 15 + r) * D))[c] = ((const f32x4*)(P.in[I_SPOOL] + ((size_t)b * 15 + 8 + r) * D))[c]; }
    }
    SEAM2(0, 2);
    if (IN(2)) {
#ifndef SUBM
#define SUBM 7
#endif
        { SgH<0> E{P.in[I_XS], P.in[I_POOLSC], nullptr, nullptr, nullptr, hbA, ssq + 0 * SSQ_V};
          for (int u = vcu; u < 256; u += G) {
              const int mt = u >> 4, gq = (u & 15) >> 2, w = 2 << gq, col = 256 * gq + 4 * lane, bs = mt * 8 + wave;
              const float* sp = P.in[I_SPOOL] + (size_t)bs * 15 * D; const float* xs0 = P.in[I_XS] + (size_t)(bs * DS) * D;
              const float rv = (lane < DS) ? rstd0[MP + bs * DS + lane] : 0.f;
              const f32x4 gn = *(const f32x4*)(P.in[I_NMIX] + col);
#pragma unroll
              for (int t = 0; t < DS; ++t) {
                  const f32x4 u0 = *(const f32x4*)(xs0 + (size_t)t * D + col) * __shfl(rv, t); f32x4 sum = u0, hist = {0.f, 0.f, 0.f, 0.f};
#pragma unroll
                  for (int i = 1; i < 16; ++i) if (i < w) { const int tt = t - i;
                      if (tt >= 0) sum += *(const f32x4*)(xs0 + (size_t)tt * D + col) * __shfl(rv, tt >= 0 ? tt : 0);
                      else hist += *(const f32x4*)(sp + (size_t)(15 + tt) * D + col); }
                  const f32x4 dd = (sum * gn + hist) / (float)w - u0 * gn;
                  u32x2 o; o.x = pk2(dd.x, dd.y); o.y = pk2(dd.z, dd.w);
                  *(u32x2*)(dbuf + (size_t)(MP + bs * DS + t) * D + col) = o;
              }
              asm volatile("s_waitcnt vmcnt(0)" ::: "memory"); __syncthreads();
              sg_gemm<4, 1>(lds, dbuf + (size_t)MP * D, D, 256, wpool, 256, u, E, tid, wave, lane); } }
        { SgBf E{proj, D};
          for (int u = vcu; u < 256; u += G) sg_gemm<4, 1>(lds, pb + (size_t)MP * PLE, PLE, 0, wproj, PLE, u, E, tid, wave, lane); }
        { SgBf E{proj + (size_t)M * D, D};
          for (int u = vcu; u < 256; u += G) sg_gemm<4, 1>(lds, pb + (size_t)(M + MP) * PLE, PLE, 0, wproj + (size_t)PLE * D, PLE, u, E, tid, wave, lane); }
        if (SUBM & 1) { pg8::Gemm g{dbuf, wpool, MP, D, 256, D, 256}; pg8::StaticOrder S; S.init(MP, D, G, bx);
          {
            pg8::Unit uu;
            for (int i = 0; S.next(i, uu); ++i) {
#pragma unroll 1
                for (int cc = 0; cc < 2; ++cc) {
                    const int row0 = uu.pm * 256 + (2 * wave + cc) * 16, t0 = row0 & (SEQ - 1), col = 256 * uu.pn + 4 * lane;
                    const float rv = (lane < 31 && t0 - 15 + lane >= 0) ? rstd0[row0 - 15 + lane] : 0.f;
                    const int rvb = __builtin_bit_cast(int, rv);
                    const float* xr = P.in[I_XP] + (size_t)row0 * D; bf16_t* dr = dbuf + (size_t)row0 * D; const f32x4 gn = *(const f32x4*)(P.in[I_NMIX] + col);
                    if (uu.pn == 0) pool_chunk<2>(xr, rvb, gn, col, t0, dr); else if (uu.pn == 1) pool_chunk<4>(xr, rvb, gn, col, t0, dr);
                    else if (uu.pn == 2) pool_chunk<8>(xr, rvb, gn, col, t0, dr); else pool_chunk<16>(xr, rvb, gn, col, t0, dr);
                } }
            asm volatile("s_waitcnt vmcnt(0)" ::: "memory"); __syncthreads(); }
          EpiH<0> E{P.in[I_XP], P.in[I_XS], P.in[I_POOLSC], nullptr, nullptr, nullptr, hbA, ssq + 0 * SSQ_V};
          pg8::gemm_phase(lds, g, S, E); }
        if (SUBM & 2) { pg8::Gemm g{pb, wproj, MP, D, PLE, PLE, 0}; pg8::StaticOrder S; S.init(MP, D, G, bx);
          EpiBf E{proj, D};
          pg8::gemm_phase(lds, g, S, E); }
        if (SUBM & 4) { pg8::Gemm g{pb + (size_t)M * PLE, wproj + (size_t)PLE * D, MP, D, PLE, PLE, 0}; pg8::StaticOrder S; S.init(MP, D, G, bx);
          EpiBf E{proj + (size_t)M * D, D};
          pg8::gemm_phase(lds, g, S, E); }
    }
    SEAM(2);
    if (IN(3)) {
        { SgUp E{ssq + 0 * SSQ_V, abuf}; for (int u = vcu; u < 256; u += G) sg_gemm<4, 4>(lds, hbA + (size_t)MP * D, D, 0, wup, D, u, E, tid, wave, lane); }
        pg8::Gemm g{hbA, wup, MP, FF, D, D, 0}; pg8::StaticOrder S; S.init(MP, FF, G, bx); EpiUp E{ssq + 0 * SSQ_V, abuf}; pg8::gemm_phase(lds, g, S, E); }
    SEAM(3);
    if (IN(4)) {
        { SgH<1> E{nullptr, nullptr, nullptr, nullptr, hbA, hbB, ssq + 1 * SSQ_V}; for (int u = vcu; u < 256; u += G) sg_gemm<4, 1>(lds, abuf + (size_t)MP * FF, FF, 0, wdown, FF, u, E, tid, wave, lane); }
        pg8::Gemm g{abuf, wdown, MP, D, FF, FF, 0}; pg8::StaticOrder S; S.init(MP, D, G, bx);
        EpiH<1> E{nullptr, nullptr, nullptr, nullptr, nullptr, hbA, hbB, ssq + 1 * SSQ_V}; pg8::gemm_phase(lds, g, S, E); }
    SEAM(4);
    if (IN(5)) {
        { SgH<2> E{nullptr, nullptr, ssq + 1 * SSQ_V, proj, hbB, hbA, ssq + 2 * SSQ_V}; for (int u = vcu; u < 256; u += G) sg_gemm<4, 1>(lds, hbB + (size_t)MP * D, D, 0, wgate, D, u, E, tid, wave, lane); }
        pg8::Gemm g{hbB, wgate, MP, D, D, D, 0}; pg8::StaticOrder S; S.init(MP, D, G, bx);
        EpiH<2> E{nullptr, nullptr, nullptr, ssq + 1 * SSQ_V, proj, hbB, hbA, ssq + 2 * SSQ_V}; pg8::gemm_phase(lds, g, S, E); }
    SEAM(5);
    if (IN(6)) {
        pg8::Gemm g{hbA, wdkvq, M, NDKVQ, D, D, 0}; pg8::StaticOrder S; S.init(M, NDKVQ, G, bx); EpiF32<1> E{raw, NDKVQ, ssq + 2 * SSQ_V}; pg8::gemm_phase(lds, g, S, E); }
    SEAM(6);
    if (IN(7)) {
        const f32x4 kvn = ((const f32x4*)P.in[I_KVN])[lane];
        for (int row0 = 2 * gw; row0 < M; row0 += 2 * NGW) {
            f32x4 c4[2], k1[2], k2[2], cn_[2], sn_[2]; f32x2 q2[2][3];
            const int l8 = lane & 7, hh = lane >> 3;
#pragma unroll
            for (int e = 0; e < 2; ++e) { const int row = row0 + e; const float* rr = raw + (size_t)row * NDKVQ;
                const int pos = row < MP ? (row & (SEQ - 1)) : PAST + ((row - MP) & 7);
                c4[e] = ((const f32x4*)rr)[lane];
                k1[e] = *(const f32x4*)(rr + 256 + 4 * l8); k2[e] = *(const f32x4*)(rr + 288 + 4 * l8);
                cn_[e] = *(const f32x4*)(cs + (size_t)pos * 64 + 4 * l8); sn_[e] = *(const f32x4*)(cs + (size_t)pos * 64 + 32 + 4 * l8);
#pragma unroll
                for (int k = 0; k < 3; ++k) q2[e][k] = *(const f32x2*)(rr + 320 + 2 * lane + 128 * k); }
#pragma unroll
            for (int e = 0; e < 2; ++e) { const int row = row0 + e; const bool isp = row < MP;
                const float sc = wave_sum((c4[e].x * c4[e].x + c4[e].y * c4[e].y) + (c4[e].z * c4[e].z + c4[e].w * c4[e].w));
                const float rc = 1.0f / sqrtf(sc * (1.0f / KVR) + EPS);
                const f32x4 cn = c4[e] * rc * kvn;
                float* lo_ = isp ? out + O_LP + (size_t)row * KVR : out + O_LS + (size_t)(row - MP) * KVR;
                ((f32x4*)lo_)[lane] = cn;
                { u32x2 o; o.x = pk2(cn.x, cn.y); o.y = pk2(cn.z, cn.w); ((u32x2*)(cb + (size_t)row * KVR))[lane] = o; }
                const f32x4 o1 = k1[e] * cn_[e] - k2[e] * sn_[e], o2 = k2[e] * cn_[e] + k1[e] * sn_[e];
                u32x2 w1, w2; w1.x = pk2(o1.x, o1.y); w1.y = pk2(o1.z, o1.w); w2.x = pk2(o2.x, o2.y); w2.y = pk2(o2.z, o2.w);
                if (hh == 0) { float* ko = isp ? out + O_KP + (size_t)row * ROPE : out + O_KS + (size_t)(row - MP) * ROPE; *(f32x4*)(ko + 4 * l8) = o1; *(f32x4*)(ko + 32 + 4 * l8) = o2;
                    if (!isp) { bf16_t* kd = krbs + (size_t)(row - MP) * ROPE; *(u32x2*)(kd + 4 * l8) = w1; *(u32x2*)(kd + 32 + 4 * l8) = w2; } }
                if (isp) { const int b = row >> 13, t = row & (SEQ - 1); bf16_t* kd = kfull + ((size_t)(b * NH + hh) * SEQ + t) * QH + NOPE; *(u32x2*)(kd + 4 * l8) = w1; *(u32x2*)(kd + 32 + 4 * l8) = w2; }
                float s = 0.f;
#pragma unroll
                for (int k = 0; k < 3; ++k) s += q2[e][k].x * q2[e][k].x + q2[e][k].y * q2[e][k].y;
                s = wave_sum(s);
                if (lane == 0) rstdq[row] = 1.0f / sqrtf(s * (1.0f / QR) + EPS);
#pragma unroll
                for (int k = 0; k < 3; ++k) *(unsigned*)(cqb + (size_t)row * QR + 2 * lane + 128 * k) = pk2(q2[e][k].x, q2[e][k].y); }
        }
    }
    SEAM(7);
    if (IN(8)) {
        if (SUBM & 1) { pg8::Gemm g{cqb, wuq, M, NH * QH, QR, QR, 0}; pg8::StaticOrder S; S.init(M, NH * QH, G, bx); EpiQ E{rstdq, cs, qbuf, qs}; pg8::gemm_phase(lds, g, S, E); }
        if (SUBM & 2) { pg8::Gemm g{cb, wukt, MP, 1024, KVR, KVR, 0}; pg8::StaticOrder S; S.init(MP, 1024, G, (bx + 128) % G); EpiKup E{kfull}; pg8::gemm_phase(lds, g, S, E); }
        if (SUBM & 4) { pg8::Gemm g{wuvt, cb, 1024, MP, KVR, KVR, 0}; pg8::StaticOrder S; S.init(1024, MP, G, (bx + 128) % G); EpiVup E{vt}; pg8::gemm_phase(lds, g, S, E); }
    }
    SEAM2(8, 10);
    if (IN(10)) {
        const bool sfirst = (bx >> 3) & 1;
        if (sfirst) for (int it = vcu; it < 2 * DB; it += G) sattn_item(P, it >> 1, it & 1, lds, tid, wave, lane);
        for (int u = vcu; u < 256; u += G) {
            const int bh = u >> 4, p = u & 15;
            attn_prompt_unit(qbuf, kfull, vt, obuf, bh >> 3, bh & 7, 31 - p, lds, tid, wave, lane);
            attn_prompt_unit(qbuf, kfull, vt, obuf, bh >> 3, bh & 7, p, lds, tid, wave, lane);
        }
        if (!sfirst) for (int it = vcu; it < 2 * DB; it += G) sattn_item(P, it >> 1, it & 1, lds, tid, wave, lane);
    }
    SEAM2(10, 12);
    if (IN(12)) {
        { SgH<1> E{nullptr, nullptr, nullptr, nullptr, hbA, hbB, ssq + 3 * SSQ_V}; const SgALoadComb AL{(const float*)(ws + WS_PART), (const float*)(ws + WS_ML)};
          for (int u = vcu; u < 256; u += G) sg_gemm_l<4, 1>(lds, AL, 0, wo, D, u, E, tid, wave, lane); }
        pg8::Gemm g{obuf, wo, MP, D, D, D, 0}; pg8::StaticOrder S; S.init(MP, D, G, bx);
        EpiH<1> E{nullptr, nullptr, nullptr, nullptr, nullptr, hbA, hbB, ssq + 3 * SSQ_V}; pg8::gemm_phase(lds, g, S, E); }
    SEAM(12);
    if (IN(13)) {
        { SgUp E{ssq + 3 * SSQ_V, abuf}; for (int u = vcu; u < 256; u += G) sg_gemm<4, 4>(lds, hbB + (size_t)MP * D, D, 0, wup + (size_t)FF * D, D, u, E, tid, wave, lane); }
        pg8::Gemm g{hbB, wup + (size_t)FF * D, MP, FF, D, D, 0}; pg8::StaticOrder S; S.init(MP, FF, G, bx); EpiUp E{ssq + 3 * SSQ_V, abuf}; pg8::gemm_phase(lds, g, S, E); }
    SEAM(13);
    if (IN(14)) {
        { SgH<1> E{nullptr, nullptr, nullptr, nullptr, hbB, hbA, ssq + 4 * SSQ_V}; for (int u = vcu; u < 256; u += G) sg_gemm<4, 1>(lds, abuf + (size_t)MP * FF, FF, 0, wdown + (size_t)FF * D, FF, u, E, tid, wave, lane); }
        pg8::Gemm g{abuf, wdown + (size_t)FF * D, MP, D, FF, FF, 0}; pg8::StaticOrder S; S.init(MP, D, G, bx);
        EpiH<1> E{nullptr, nullptr, nullptr, nullptr, nullptr, hbB, hbA, ssq + 4 * SSQ_V}; pg8::gemm_phase(lds, g, S, E); }
    SEAM(14);
    if (IN(15)) {
        { SgH<2> E{nullptr, nullptr, ssq + 4 * SSQ_V, proj + (size_t)M * D, hbA, hbB, ssq + 5 * SSQ_V}; for (int u = vcu; u < 256; u += G) sg_gemm<4, 1>(lds, hbA + (size_t)MP * D, D, 0, wgate + (size_t)D * D, D, u, E, tid, wave, lane); }
        pg8::Gemm g{hbA, wgate + (size_t)D * D, MP, D, D, D, 0}; pg8::StaticOrder S; S.init(MP, D, G, bx);
        EpiH<2> E{nullptr, nullptr, nullptr, ssq + 4 * SSQ_V, proj + (size_t)M * D, hbA, hbB, ssq + 5 * SSQ_V}; pg8::gemm_phase(lds, g, S, E); }
    SEAM(15);
    if (IN(16)) {
        f32x4 gn[4];
#pragma unroll
        for (int j = 0; j < 4; ++j) gn[j] = ((const f32x4*)P.in[I_NFIN])[lane + 64 * j];
        for (int row0 = 4 * gw; row0 < M; row0 += 4 * NGW) {
            u32x2 hv[4][4]; float sp[4];
#pragma unroll
            for (int e = 0; e < 4; ++e) { sp[e] = (lane < 16) ? ssq[5 * SSQ_V + (size_t)(row0 + e) * 16 + lane] : 0.f;
#pragma unroll
                for (int j = 0; j < 4; ++j) hv[e][j] = ((const u32x2*)(hbB + (size_t)(row0 + e) * D))[lane + 64 * j]; }
#pragma unroll
            for (int e = 0; e < 4; ++e) { const float rstd = 1.0f / sqrtf(wave_sum(sp[e]) * (1.0f / D) + EPS);
#pragma unroll
                for (int j = 0; j < 4; ++j) ((f32x4*)(out + O_Y + (size_t)(row0 + e) * D))[lane + 64 * j] = unpk4(hv[e][j]) * rstd * gn[j]; }
        }
    }
#undef IN
#undef SEAM
#undef SEAM2
#undef wpool
#undef wup
#undef wdown
#undef wgate
#undef wproj
#undef wdkvq
#undef wuq
#undef wukt
#undef wuvt
#undef wukb
#undef wo
#undef cs
#undef rstd0
#undef dbuf
#undef pb
#undef hbA
#undef hbB
#undef ssq
#undef abuf
#undef proj
#undef raw
#undef cb
#undef krbs
#undef cqb
#undef rstdq
#undef qbuf
#undef qs
#undef kfull
#undef vt
#undef obuf
}

extern "C" void kernel_launch(void* const* d_in, const int* in_sizes, int n_in, void* d_out, int out_size, void* d_ws, size_t ws_size, hipStream_t stream) {
    static int grid = 0;
    if (grid == 0) {
        if (n_in != 27 || (size_t)out_size != O_END || ws_size < WS_END) { fprintf(stderr, "kernel_launch: shape mismatch (n_in %d, out %d, ws %zu; need 27, %zu, %zu)\n", n_in, out_size, ws_size, (size_t)O_END, (size_t)WS_END); grid = -1; return; }
        int dev = 0, cus = 0, per_cu = 0;
        if (hipGetDevice(&dev) != hipSuccess || hipDeviceGetAttribute(&cus, hipDeviceAttributeMultiprocessorCount, dev) != hipSuccess) { grid = -1; return; }
        if (hipFuncSetAttribute((const void*)yoco_fwd, hipFuncAttributeMaxDynamicSharedMemorySize, LDS_BYTES) != hipSuccess) { fprintf(stderr, "kernel_launch: hipFuncSetAttribute failed\n"); grid = -1; return; }
        if (hipOccupancyMaxActiveBlocksPerMultiprocessor(&per_cu, (const void*)yoco_fwd, 512, LDS_BYTES) != hipSuccess || per_cu < 1) fprintf(stderr, "kernel_launch: occupancy query reports %d\n", per_cu);
        (void)hipGetLastError();
        grid = cus;
    }
    if (grid < 0) return;
    (void)hipMemsetAsync((char*)d_ws + WS_CTL, 0, CTL_BYTES, stream);
    Params p{};
    for (int i = 0; i < 27; ++i) p.in[i] = (const float*)d_in[i];
    p.out = (float*)d_out; p.ws = (unsigned char*)d_ws;
#if MK_N_LAUNCHES == 1
    p.ph_lo = 0; p.ph_hi = NPH;
    hipLaunchKernelGGL(yoco_fwd, dim3(grid), dim3(512), LDS_BYTES, stream, p);
#else
    for (int k = 0; k < NPH; ++k) { p.ph_lo = k; p.ph_hi = k + 1; hipLaunchKernelGGL(yoco_fwd, dim3(grid), dim3(512), LDS_BYTES, stream, p); }
#endif
    const hipError_t le = hipPeekAtLastError();
    if (le != hipSuccess) fprintf(stderr, "kernel_launch: launch failed: %s\n", hipGetErrorName(le));
}
```

```cpp
#include <hip/hip_runtime.h>
#include <cstdio>
#include <cstdint>

#ifndef MK_N_LAUNCHES
#define MK_N_LAUNCHES 1
#endif

#define GAS __attribute__((address_space(1)))
#define LAS __attribute__((address_space(3)))
typedef unsigned short bf16_t;
typedef short bf16x8 __attribute__((ext_vector_type(8)));
typedef float f32x4 __attribute__((ext_vector_type(4)));
typedef float f32x16 __attribute__((ext_vector_type(16)));
typedef unsigned u32x2 __attribute__((ext_vector_type(2)));
typedef unsigned u32x4 __attribute__((ext_vector_type(4)));

constexpr int D = 1024, FF = 4096, PLE = 256, SEQ = 8192, NBATCH = 2, DB = 128, DS = 8;
constexpr int MP = NBATCH * SEQ;
constexpr int MS = DB * DS;
constexpr int M = MP + MS;
constexpr int KVR = 256, ROPE = 64, QR = 384, NH = 8, NOPE = 128, VD = 128, QH = NOPE + ROPE;
constexpr int NDKVQ = 768;
constexpr int PAST = 8192, PAGE = 128, NPG = PAST / PAGE;
constexpr float EPS = 1e-6f;
constexpr float SM_SCALE = 0.07216878364870322f;
constexpr float LOG2E = 1.4426950408889634f;
constexpr float CEXP = SM_SCALE * LOG2E;
constexpr int NPOS = PAST + DS;

constexpr size_t O_Y = 0;
constexpr size_t O_PP = (size_t)M * D;
constexpr size_t O_PS = O_PP + (size_t)NBATCH * 15 * D;
constexpr size_t O_LP = O_PS + (size_t)DB * 15 * D;
constexpr size_t O_KP = O_LP + (size_t)MP * KVR;
constexpr size_t O_LS = O_KP + (size_t)MP * ROPE;
constexpr size_t O_KS = O_LS + (size_t)MS * KVR;
constexpr size_t O_END = O_KS + (size_t)MS * ROPE;

constexpr size_t al256(size_t x) { return (x + 255) / 256 * 256; }
constexpr size_t WS_CTL = 0, CTL_BYTES = 1u << 20;
constexpr size_t WS_WPOOL = CTL_BYTES;
constexpr size_t WS_WUP   = WS_WPOOL + al256((size_t)1024 * 256 * 2);
constexpr size_t WS_WDOWN = WS_WUP   + al256((size_t)2 * FF * D * 2);
constexpr size_t WS_WGATE = WS_WDOWN + al256((size_t)2 * FF * D * 2);
constexpr size_t WS_WPROJ = WS_WGATE + al256((size_t)2 * D * D * 2);
constexpr size_t WS_WDKVQ = WS_WPROJ + al256((size_t)2 * D * PLE * 2);
constexpr size_t WS_WUQ   = WS_WDKVQ + al256((size_t)NDKVQ * D * 2);
constexpr size_t WS_WUKT  = WS_WUQ   + al256((size_t)NH * QH * QR * 2);
constexpr size_t WS_WUVT  = WS_WUKT  + al256((size_t)1024 * 256 * 2);
constexpr size_t WS_WUVP  = WS_WUVT  + al256((size_t)1024 * 256 * 2);
constexpr size_t WS_WUKB  = WS_WUVP  + al256((size_t)1024 * 256 * 2);
constexpr size_t WS_WO    = WS_WUKB  + al256((size_t)1024 * 256 * 2);
constexpr size_t WS_CS    = WS_WO    + al256((size_t)D * D * 2);
constexpr size_t WS_RSTD0 = WS_CS    + al256((size_t)NPOS * 64 * 4);
constexpr size_t WS_DBUF  = WS_RSTD0 + al256((size_t)M * 4);
constexpr size_t WS_PB    = WS_DBUF  + al256((size_t)M * D * 2);
constexpr size_t WS_HBA   = WS_PB    + al256((size_t)2 * M * PLE * 2);
constexpr size_t WS_HBB   = WS_HBA   + al256((size_t)M * D * 2);
constexpr size_t WS_SSQ   = WS_HBB   + al256((size_t)M * D * 2);
constexpr size_t WS_ABUF  = WS_SSQ   + al256((size_t)6 * M * 16 * 4);
constexpr size_t WS_PROJ  = WS_ABUF  + al256((size_t)M * FF * 2);
constexpr size_t WS_RAW   = WS_PROJ  + al256((size_t)2 * M * D * 2);
constexpr size_t WS_CB    = WS_RAW   + al256((size_t)M * NDKVQ * 4);
constexpr size_t WS_KRBS  = WS_CB    + al256((size_t)M * KVR * 2);
constexpr size_t WS_CQB   = WS_KRBS  + al256((size_t)MS * ROPE * 2);
constexpr size_t WS_RSTDQ = WS_CQB   + al256((size_t)M * QR * 2);
constexpr size_t WS_QBUF  = WS_RSTDQ + al256((size_t)M * 4);
constexpr size_t WS_QS    = WS_QBUF  + al256((size_t)M * NH * QH * 2);
constexpr size_t WS_KFULL = WS_QS    + al256((size_t)MS * NH * 320 * 2);
constexpr size_t WS_VT    = WS_KFULL + al256((size_t)16 * SEQ * QH * 2);
constexpr size_t WS_OBUF  = WS_VT    + al256((size_t)16 * VD * SEQ * 2);
constexpr size_t WS_PART  = WS_OBUF  + al256((size_t)M * D * 2);
constexpr size_t WS_ML    = WS_PART  + al256((size_t)DB * 8 * 64 * 256 * 4);
constexpr size_t WS_END   = WS_ML    + al256((size_t)DB * 8 * 64 * 2 * 4);

constexpr int CW_BAR = 4096;

constexpr int RING_BYTES = 131072;
constexpr int LDS_BYTES = 147456;
constexpr int MISC_OFF = LDS_BYTES - 256;

typedef float f32x2 __attribute__((ext_vector_type(2)));
typedef __bf16 nbf16x2 __attribute__((ext_vector_type(2)));
__device__ __forceinline__ unsigned pk2(float lo, float hi) { const f32x2 v = {lo, hi}; return __builtin_bit_cast(unsigned, __builtin_convertvector(v, nbf16x2)); }
__device__ __forceinline__ unsigned f2bf(float f) { return pk2(f, 0.f) & 0xffffu; }
__device__ __forceinline__ float bf2f(unsigned short b) { return __builtin_bit_cast(float, ((unsigned)b) << 16); }
__device__ __forceinline__ f32x4 unpk4(u32x2 w) { f32x4 r; r.x = __builtin_bit_cast(float, w.x << 16); r.y = __builtin_bit_cast(float, w.x & 0xffff0000u); r.z = __builtin_bit_cast(float, w.y << 16); r.w = __builtin_bit_cast(float, w.y & 0xffff0000u); return r; }
__device__ __forceinline__ bf16x8 pack8(const float* v) { u32x4 w; w.x = pk2(v[0], v[1]); w.y = pk2(v[2], v[3]); w.z = pk2(v[4], v[5]); w.w = pk2(v[6], v[7]); return __builtin_bit_cast(bf16x8, w); }
__device__ __forceinline__ bf16x8 pack8v(f32x4 a, f32x4 b) { u32x4 w; w.x = pk2(a.x, a.y); w.y = pk2(a.z, a.w); w.z = pk2(b.x, b.y); w.w = pk2(b.z, b.w); return __builtin_bit_cast(bf16x8, w); }
__device__ __forceinline__ float wave_sum(float v) {
#pragma unroll
    for (int o = 1; o < 64; o <<= 1) v += __shfl_xor(v, o);
    return v;
}
__device__ __forceinline__ int crow(int r, int hi) { return (r & 3) + 8 * (r >> 2) + 4 * hi; }
#define LDS_WAIT() asm volatile("s_waitcnt lgkmcnt(0)" ::: "memory")
#define VM_WAIT() asm volatile("s_waitcnt vmcnt(0)" ::: "memory")

#define XB_TMO      128
#define XB_XCNT(j)  (256  + 64 * (j))
#define XB_XSUB(j)  (1280 + 64 * (j))
#define XB_XGEN(j)  (2304 + 64 * (j))
#define XB_TOP      3328
#define XB_TOPGEN   3392
#define XCD_BAR_WORDS 3456
#define XB_SPIN_CAP (1u << 18)
__device__ __forceinline__ unsigned xb_ld(unsigned* p)              { return __hip_atomic_load(p, __ATOMIC_RELAXED, __HIP_MEMORY_SCOPE_AGENT); }
__device__ __forceinline__ unsigned xb_add(unsigned* p, unsigned v) { return __hip_atomic_fetch_add(p, v, __ATOMIC_RELAXED, __HIP_MEMORY_SCOPE_AGENT); }
__device__ __forceinline__ unsigned xb_xcc_id() { return (unsigned)__builtin_amdgcn_s_getreg((3 << 11) | 20) & 0xFu; }
#define XB_SPIN(cond, bar) do { unsigned _sp = 0; while (cond) { __builtin_amdgcn_s_sleep(1); \
    if ((++_sp & 255u) == 0u) { if (xb_ld(&(bar)[XB_TMO])) break; if (_sp > XB_SPIN_CAP) { atomicAdd(&(bar)[XB_TMO], 1u); break; } } } } while (0)
struct XcdBarrier { unsigned* bar; unsigned x; volatile LAS unsigned* st; };
__device__ __forceinline__ XcdBarrier xcd_barrier_post(unsigned* bar, volatile LAS unsigned* st) {
    XcdBarrier b; b.bar = bar; b.x = xb_xcc_id(); b.st = st;
    if (threadIdx.x == 0) (void)xb_add(&bar[XB_XCNT(b.x)], 1u);
    return b;
}
__device__ __forceinline__ void xcd_barrier_complete(unsigned* bar, unsigned x, unsigned& nloc, unsigned& nx) {
    const unsigned G = gridDim.x * gridDim.y * gridDim.z;
    unsigned sum, cnt, mine, sp = 0u;
    for (;;) {
        sum = 0u; cnt = 0u; mine = 0u;
#pragma unroll
        for (unsigned j = 0; j < 16; ++j) { const unsigned c = xb_ld(&bar[XB_XCNT(j)]); sum += c; cnt += (c > 0u) ? 1u : 0u; mine = (j == x) ? c : mine; }
        if (sum == G) break;
        __builtin_amdgcn_s_sleep(1);
        if ((++sp & 255u) == 0u) { if (xb_ld(&bar[XB_TMO])) break; if (sp > XB_SPIN_CAP) { atomicAdd(&bar[XB_TMO], 1u); break; } }
    }
    nloc = mine > 0u ? mine : 1u; nx = cnt > 0u ? cnt : 1u;
}
__device__ __forceinline__ void xcd_barrier(const XcdBarrier& b) {
    asm volatile("s_waitcnt vmcnt(0)" ::: "memory");
    __syncthreads();
    if (threadIdx.x == 0) {
        unsigned* bar = b.bar;
        __builtin_amdgcn_s_waitcnt(0);
        unsigned nloc = b.st[0], nx = b.st[1];
        if (nloc == 0u) { xcd_barrier_complete(bar, b.x, nloc, nx); b.st[0] = nloc; b.st[1] = nx; }
        const unsigned old = xb_add(&bar[XB_XSUB(b.x)], 1u);
        const unsigned gen = old / nloc;
        if (old + 1u == (gen + 1u) * nloc) {
            __builtin_amdgcn_fence(__ATOMIC_RELEASE, "agent");
            asm volatile("s_waitcnt vmcnt(0)" ::: "memory");
            const unsigned og = xb_add(&bar[XB_TOP], 1u);
            const unsigned tg = og / nx;
            if (og + 1u == (tg + 1u) * nx) xb_add(&bar[XB_TOPGEN], 1u);
            else XB_SPIN(xb_ld(&bar[XB_TOPGEN]) == tg, bar);
            __builtin_amdgcn_fence(__ATOMIC_ACQUIRE, "agent");
            xb_add(&bar[XB_XGEN(b.x)], 1u);
            asm volatile("s_waitcnt vmcnt(0)" ::: "memory");
        } else {
            XB_SPIN(xb_ld(&bar[XB_XGEN(b.x)]) == gen, bar);
            __builtin_amdgcn_fence(__ATOMIC_ACQUIRE, "agent");
            asm volatile("s_waitcnt vmcnt(0)" ::: "memory");
        }
    }
    __syncthreads();
}

namespace pg8 {
constexpr int BM = 256, BK = 64, HALF = 128, HTB = HALF * BK * 2, STAGE_BYTES = 8 * HTB, NXCD = 8, WGM = 8;
__host__ __device__ __forceinline__ int lds_byte(int r, int c) { const int st = (r >> 4) * 2 + (c >> 5), rr = r & 15, cc = c & 31, ob = rr * 64 + cc * 2; return st * 1024 + (ob ^ (((ob >> 9) & 1) << 5)); }
__host__ __device__ __forceinline__ int perm32(int rho) { const int n = rho >> 4, i = rho & 15; return 8 * (i >> 2) + 4 * n + (i & 3); }
__host__ __device__ __forceinline__ void stage_rc(int b, int& R, int& C) { const int st = b / 1024, sb = b % 1024, swz = sb ^ (((sb >> 9) & 1) << 5); R = (st >> 1) * 16 + swz / 64; C = (st & 1) * 32 + (swz % 64) / 2; }
struct Unit { int pm, pn; };
struct Gemm { const bf16_t* A; const bf16_t* Bt; int M, N, K, lda, apn; };
struct StaticOrder {
    int nM, nN, nwg, G, c;
    __device__ __forceinline__ void init(int M, int N, int G_, int c_) { nM = M / BM; nN = N / BM; nwg = nM * nN; G = G_; c = c_; }
    __device__ __forceinline__ bool next(int i, Unit& u) const {
        const long L = (long)i * G + c; if (L >= nwg) return false;
        int wgid = (int)L; { const int q = nwg / NXCD, r = nwg % NXCD, xcd = wgid % NXCD, off = wgid / NXCD; wgid = (xcd < r ? xcd * (q + 1) : r * (q + 1) + (xcd - r) * q) + off; }
        const int nig = WGM * nN, gid = wgid / nig, fm = gid * WGM, gsz = (nM - fm) < WGM ? (nM - fm) : WGM;
        u.pm = fm + ((wgid % nig) % gsz); u.pn = (wgid % nig) / gsz; return true;
    }
};
template <class Epi>
__device__ __forceinline__ void gemm_phase(LAS unsigned char* lds, const Gemm g, const StaticOrder& S, const Epi& E) {
    const int tid = threadIdx.x, wid = __builtin_amdgcn_readfirstlane(tid >> 6), lane = tid & 63, wr = wid >> 2, wc = wid & 3, fr = lane & 15, fq = lane >> 4;
    const int K = g.K, nt = K / BK, lda = g.lda;
    unsigned voffA[2], voffB[2];
#pragma unroll
    for (int i = 0; i < 2; ++i) { int R, C; stage_rc(tid * 16 + i * 8192, R, C);
        const int Rb = Epi::PERM ? ((R & ~31) + perm32(R & 31)) : R;
        voffA[i] = (unsigned)(R * lda + C) * 2u; voffB[i] = (unsigned)(Rb * K + C) * 2u; }
    const size_t kstep = (size_t)(BK * 2);
    const size_t hstepA = (size_t)HALF * lda * 2, hstepB = (size_t)HALF * K * 2;
    const size_t tstepA = 2 * hstepA, tstepB = 2 * hstepB, pnA = (size_t)g.apn * 2;
    const unsigned ldsw = (unsigned)wid * 1024u;
    const int aoff = lds_byte(wr * 64 + fr, fq * 8), boff = lds_byte(wc * 32 + fr, fq * 8);
#define PG8_SA(b, h) (((b) * 2 + (h)) * HTB)
#define PG8_SB(b, h) ((4 + (b) * 2 + (h)) * HTB)
#define PG8_STAGE(bufoff, gbase, voff) do { _Pragma("unroll") for (int _i = 0; _i < 2; ++_i) \
        __builtin_amdgcn_global_load_lds((const unsigned*)((const char*)(gbase) + (voff)[_i]), (LAS unsigned*)(lds + (bufoff) + ldsw + _i * 8192), 16, 0, 0); } while (0)
#define PG8_LDA(dst, b, h) do { _Pragma("unroll") for (int m = 0; m < 4; ++m) _Pragma("unroll") for (int k = 0; k < 2; ++k) dst[m][k] = *(const LAS bf16x8*)(lds + PG8_SA(b, h) + aoff + m * 2048 + k * 1024); } while (0)
#define PG8_LDB(dst, b, h) do { _Pragma("unroll") for (int n = 0; n < 2; ++n) _Pragma("unroll") for (int k = 0; k < 2; ++k) dst[n][k] = *(const LAS bf16x8*)(lds + PG8_SB(b, h) + boff + n * 2048 + k * 1024); } while (0)
#define PG8_MMA(ai, bj, At, Bt) do { __builtin_amdgcn_s_setprio(1); _Pragma("unroll") for (int m = 0; m < 4; ++m) _Pragma("unroll") for (int n = 0; n < 2; ++n) _Pragma("unroll") for (int k = 0; k < 2; ++k) \
        acc[ai][bj][m][n] = __builtin_amdgcn_mfma_f32_16x16x32_bf16(Bt[n][k], At[m][k], acc[ai][bj][m][n], 0, 0, 0); __builtin_amdgcn_s_setprio(0); } while (0)
#define PG8_WAIT_V(n) asm volatile("s_waitcnt vmcnt(" #n ")" ::: "memory")
#define PG8_WAIT_L(n) asm volatile("s_waitcnt lgkmcnt(" #n ")" ::: "memory")
#define PG8_BAR __builtin_amdgcn_s_barrier()
#define PG8_SCHED __builtin_amdgcn_sched_barrier(0)
    Unit cur, nxt; int ui = 0;
    if (!S.next(0, cur)) return;
    f32x4 acc[2][2][4][2];
#pragma unroll
    for (int a = 0; a < 2; ++a)
#pragma unroll
        for (int b = 0; b < 2; ++b)
#pragma unroll
            for (int m = 0; m < 4; ++m)
#pragma unroll
                for (int n = 0; n < 2; ++n) acc[a][b][m][n] = (f32x4){0.f, 0.f, 0.f, 0.f};
    bf16x8 At[4][2], B0[2][2], B1[2][2];
    const char* cA = (const char*)g.A + (size_t)cur.pm * tstepA + (size_t)cur.pn * pnA; const char* cB = (const char*)g.Bt + (size_t)cur.pn * tstepB;
    PG8_STAGE(PG8_SB(0, 0), cB, voffB); PG8_STAGE(PG8_SB(0, 1), cB + hstepB, voffB); PG8_STAGE(PG8_SA(0, 0), cA, voffA); PG8_STAGE(PG8_SA(0, 1), cA + hstepA, voffA);
    if (wr == 1) PG8_BAR;
    PG8_WAIT_V(2); PG8_BAR;
    PG8_STAGE(PG8_SB(1, 0), cB + kstep, voffB); PG8_STAGE(PG8_SA(1, 0), cA + kstep, voffA); PG8_STAGE(PG8_SB(1, 1), cB + hstepB + kstep, voffB);
    PG8_WAIT_V(6); PG8_BAR;
    for (;;) {
        const bool has_next = S.next(ui + 1, nxt);
        const char* nA = has_next ? (const char*)g.A + (size_t)nxt.pm * tstepA + (size_t)nxt.pn * pnA : cA; const char* nB = has_next ? (const char*)g.Bt + (size_t)nxt.pn * tstepB : cB;
#pragma unroll 1
        for (int t = 0; t < nt; t += 2) {
            const bool last = (t == nt - 2);
            const char* a1 = cA + (size_t)(t + 1) * kstep;
            const char* a2 = last ? nA : cA + (size_t)(t + 2) * kstep; const char* b2 = last ? nB : cB + (size_t)(t + 2) * kstep;
            const char* a3 = a2 + kstep; const char* b3 = b2 + kstep;
            PG8_LDB(B0, 0, 0); PG8_LDB(B1, 0, 1); PG8_SCHED; PG8_LDA(At, 0, 0); PG8_STAGE(PG8_SA(1, 1), a1 + hstepA, voffA);
            PG8_WAIT_V(8); PG8_WAIT_L(0); PG8_BAR; PG8_MMA(0, 0, At, B0); PG8_MMA(0, 1, At, B1); PG8_BAR; PG8_SCHED;
            PG8_LDA(At, 0, 1); PG8_STAGE(PG8_SB(0, 0), b2, voffB); PG8_STAGE(PG8_SB(0, 1), b2 + hstepB, voffB); PG8_STAGE(PG8_SA(0, 0), a2, voffA);
            PG8_WAIT_V(8); PG8_WAIT_L(0); PG8_BAR; PG8_MMA(1, 0, At, B0); PG8_MMA(1, 1, At, B1); PG8_BAR; PG8_SCHED;
            PG8_LDB(B0, 1, 0); PG8_LDB(B1, 1, 1); PG8_SCHED; PG8_LDA(At, 1, 0); PG8_STAGE(PG8_SA(0, 1), a2 + hstepA, voffA);
            PG8_WAIT_V(8); PG8_WAIT_L(0); PG8_BAR; PG8_MMA(0, 0, At, B0); PG8_MMA(0, 1, At, B1); PG8_BAR; PG8_SCHED;
            PG8_LDA(At, 1, 1); PG8_STAGE(PG8_SB(1, 0), b3, voffB); PG8_STAGE(PG8_SB(1, 1), b3 + hstepB, voffB); PG8_STAGE(PG8_SA(1, 0), a3, voffA);
            PG8_WAIT_V(8); PG8_WAIT_L(0); PG8_BAR; PG8_MMA(1, 0, At, B0); PG8_MMA(1, 1, At, B1); PG8_BAR; PG8_SCHED;
        }
        if (wr == 0) PG8_BAR;
        E(acc, cur, wr, wc, fr, fq);
        if (!has_next) break;
#pragma unroll
        for (int a = 0; a < 2; ++a)
#pragma unroll
            for (int b = 0; b < 2; ++b)
#pragma unroll
                for (int m = 0; m < 4; ++m)
#pragma unroll
                    for (int n = 0; n < 2; ++n) acc[a][b][m][n] = (f32x4){0.f, 0.f, 0.f, 0.f};
        cur = nxt; cA = nA; cB = nB; ++ui;
        if (wr == 1) PG8_BAR;
    }
    PG8_WAIT_V(0);
    PG8_BAR;
#undef PG8_SA
#undef PG8_SB
#undef PG8_STAGE
#undef PG8_LDA
#undef PG8_LDB
#undef PG8_MMA
#undef PG8_WAIT_V
#undef PG8_WAIT_L
#undef PG8_BAR
#undef PG8_SCHED
}
}

struct Params { const float* in[27]; float* out; unsigned char* ws; int ph_lo, ph_hi; };
enum { I_XP = 0, I_XS, I_PP, I_PS, I_SPOOL, I_CLAT, I_CKR, I_PT, I_NMIX, I_NMLP, I_NPLE, I_POOLW, I_POOLSC, I_NKV, I_WDKV, I_KVN, I_WUK, I_WUV, I_WDQ, I_QN, I_WUQ, I_WO, I_WUP, I_WDOWN, I_WGATE, I_WPROJ, I_NFIN };

__device__ __forceinline__ void load_rstd(const float* ssq, const pg8::Unit& u, int wr, int fr, int fq, float (&rs)[2][4]) {
#pragma unroll
    for (int ai = 0; ai < 2; ++ai)
#pragma unroll
        for (int m = 0; m < 4; ++m) {
            const int row = u.pm * 256 + ai * 128 + wr * 64 + m * 16 + fr;
            const f32x4 a = ((const f32x4*)(ssq + (size_t)row * 16))[fq];
            float t = (a.x + a.y) + (a.z + a.w);
            t += __shfl_xor(t, 16); t += __shfl_xor(t, 32);
            rs[ai][m] = 1.0f / sqrtf(t * (1.0f / 1024.0f) + EPS);
        }
}
template <int NS> __device__ __forceinline__ void load_rstd_p(const float* ssqp, float inv_n, const pg8::Unit& u, int wr, int fr, int fq, float (&rs)[2][4]) {
#pragma unroll
    for (int ai = 0; ai < 2; ++ai)
#pragma unroll
        for (int m = 0; m < 4; ++m) {
            const int row = u.pm * 256 + ai * 128 + wr * 64 + m * 16 + fr;
            float t;
            if (NS == 4) t = ssqp[(size_t)row * 4 + fq]; else { const f32x2 a = ((const f32x2*)(ssqp + (size_t)row * 8))[fq]; t = a.x + a.y; }
            t += __shfl_xor(t, 16); t += __shfl_xor(t, 32);
            rs[ai][m] = 1.0f / sqrtf(t * inv_n + EPS);
        }
}
template <int MODE> struct EpiH {
    static constexpr bool PERM = true;
    const float* xp; const float* xs; const float* scale; const float* ssq_in; const bf16_t* proj;
    const bf16_t* hb_in; bf16_t* hb; float* ssq_out;
    __device__ __forceinline__ void operator()(const f32x4 (&acc)[2][2][4][2], const pg8::Unit& u, int wr, int wc, int fr_in, int fq_in) const {
        int fr = fr_in, fq = fq_in; asm volatile("" : "+v"(fr), "+v"(fq));
        float rs[2][4];
        if (MODE == 2) load_rstd(ssq_in, u, wr, fr, fq, rs);
        const int col0 = u.pn * 256 + wc * 32 + 8 * fq;
#pragma unroll
        for (int ai = 0; ai < 2; ++ai)
#pragma unroll
            for (int m = 0; m < 4; ++m) {
                const int row = u.pm * 256 + ai * 128 + wr * 64 + m * 16 + fr;
                float sq = 0.f;
#pragma unroll
                for (int bj = 0; bj < 2; ++bj) {
                    const int col = col0 + bj * 128;
                    f32x4 b0, b1;
                    if (MODE == 0) { const float* xr = (row < MP ? xp + (size_t)row * D : xs + (size_t)(row - MP) * D) + col; b0 = *(const f32x4*)xr; b1 = *(const f32x4*)(xr + 4); }
                    else { const u32x4 hv = *(const u32x4*)(hb_in + (size_t)row * D + col); b0 = unpk4((u32x2){hv.x, hv.y}); b1 = unpk4((u32x2){hv.z, hv.w}); }
                    const f32x4 a0 = acc[ai][bj][m][0], a1 = acc[ai][bj][m][1]; f32x4 o0, o1;
                    if (MODE == 0) { o0 = b0 + *(const f32x4*)(scale + col) * a0; o1 = b1 + *(const f32x4*)(scale + col + 4) * a1; }
                    else if (MODE == 1) { o0 = b0 + a0; o1 = b1 + a1; }
                    else { const u32x4 pv = *(const u32x4*)(proj + (size_t)row * D + col); const f32x4 p0 = unpk4((u32x2){pv.x, pv.y}), p1 = unpk4((u32x2){pv.z, pv.w}); const float r = rs[ai][m];
                        f32x4 g0, g1;
                        g0.x = 1.0f / (1.0f + __expf(-r * a0.x)); g0.y = 1.0f / (1.0f + __expf(-r * a0.y)); g0.z = 1.0f / (1.0f + __expf(-r * a0.z)); g0.w = 1.0f / (1.0f + __expf(-r * a0.w));
                        g1.x = 1.0f / (1.0f + __expf(-r * a1.x)); g1.y = 1.0f / (1.0f + __expf(-r * a1.y)); g1.z = 1.0f / (1.0f + __expf(-r * a1.z)); g1.w = 1.0f / (1.0f + __expf(-r * a1.w));
                        o0 = b0 + g0 * p0; o1 = b1 + g1 * p1; }
                    u32x4 w; w.x = pk2(o0.x, o0.y); w.y = pk2(o0.z, o0.w); w.z = pk2(o1.x, o1.y); w.w = pk2(o1.z, o1.w);
                    *(u32x4*)(hb + (size_t)row * D + col) = w;
                    sq += ((o0.x * o0.x + o0.y * o0.y) + (o0.z * o0.z + o0.w * o0.w)) + ((o1.x * o1.x + o1.y * o1.y) + (o1.z * o1.z + o1.w * o1.w));
                }
                sq += __shfl_xor(sq, 16); sq += __shfl_xor(sq, 32);
                if (fq == 0) ssq_out[(size_t)row * 16 + u.pn * 4 + wc] = sq;
                asm volatile("" ::: "memory");
            }
    }
};
struct EpiUp {
    static constexpr bool PERM = true;
    const float* ssq_in; bf16_t* abuf;
    __device__ __forceinline__ void operator()(const f32x4 (&acc)[2][2][4][2], const pg8::Unit& u, int wr, int wc, int fr_in, int fq_in) const {
        int fr = fr_in, fq = fq_in; asm volatile("" : "+v"(fr), "+v"(fq));
        float rs[2][4]; load_rstd(ssq_in, u, wr, fr, fq, rs);
        const int col0 = u.pn * 256 + wc * 32 + 8 * fq;
#pragma unroll
        for (int ai = 0; ai < 2; ++ai)
#pragma unroll
            for (int m = 0; m < 4; ++m) {
                const int row = u.pm * 256 + ai * 128 + wr * 64 + m * 16 + fr; const float r = rs[ai][m];
#pragma unroll
                for (int bj = 0; bj < 2; ++bj) {
                    f32x4 a = acc[ai][bj][m][0] * r, c = acc[ai][bj][m][1] * r;
                    a.x = fmaxf(a.x, 0.f); a.y = fmaxf(a.y, 0.f); a.z = fmaxf(a.z, 0.f); a.w = fmaxf(a.w, 0.f);
                    c.x = fmaxf(c.x, 0.f); c.y = fmaxf(c.y, 0.f); c.z = fmaxf(c.z, 0.f); c.w = fmaxf(c.w, 0.f);
                    u32x4 w; w.x = pk2(a.x * a.x, a.y * a.y); w.y = pk2(a.z * a.z, a.w * a.w); w.z = pk2(c.x * c.x, c.y * c.y); w.w = pk2(c.z * c.z, c.w * c.w);
                    *(u32x4*)(abuf + (size_t)row * FF + col0 + bj * 128) = w;
                }
            }
    }
};
template <int MODE> struct EpiF32 {
    static constexpr bool PERM = false;
    float* C; int ldc; const float* aux;
    __device__ __forceinline__ void operator()(const f32x4 (&acc)[2][2][4][2], const pg8::Unit& u, int wr, int wc, int fr_in, int fq_in) const {
        int fr = fr_in, fq = fq_in; asm volatile("" : "+v"(fr), "+v"(fq));
        float rs[2][4];
        if (MODE == 1) load_rstd(aux, u, wr, fr, fq, rs);
        const int col0 = u.pn * 256 + wc * 32 + 4 * fq;
#pragma unroll
        for (int ai = 0; ai < 2; ++ai)
#pragma unroll
            for (int m = 0; m < 4; ++m) {
                const int row = u.pm * 256 + ai * 128 + wr * 64 + m * 16 + fr;
                const float r = (MODE == 1) ? rs[ai][m] : (MODE == 2 ? aux[row] : 1.0f);
#pragma unroll
                for (int bj = 0; bj < 2; ++bj)
#pragma unroll
                    for (int n = 0; n < 2; ++n) *(f32x4*)(C + (size_t)row * ldc + col0 + bj * 128 + n * 16) = acc[ai][bj][m][n] * r;
            }
    }
};
struct EpiBf {
    static constexpr bool PERM = true;
    bf16_t* C; int ldc;
    __device__ __forceinline__ void operator()(const f32x4 (&acc)[2][2][4][2], const pg8::Unit& u, int wr, int wc, int fr_in, int fq_in) const {
        int fr = fr_in, fq = fq_in; asm volatile("" : "+v"(fr), "+v"(fq));
        const int col0 = u.pn * 256 + wc * 32 + 8 * fq;
#pragma unroll
        for (int ai = 0; ai < 2; ++ai)
#pragma unroll
            for (int m = 0; m < 4; ++m) {
                const int row = u.pm * 256 + ai * 128 + wr * 64 + m * 16 + fr;
#pragma unroll
                for (int bj = 0; bj < 2; ++bj) { const f32x4 a = acc[ai][bj][m][0], c = acc[ai][bj][m][1]; u32x4 w; w.x = pk2(a.x, a.y); w.y = pk2(a.z, a.w); w.z = pk2(c.x, c.y); w.w = pk2(c.z, c.w);
                    *(u32x4*)(C + (size_t)row * ldc + col0 + bj * 128) = w; }
            }
    }
};
__host__ __device__ __forceinline__ int kperm(int c) { if (c < KVR) return c; const int r = c - KVR, i = r & 31, sec = r >> 5; return KVR + 32 * (i >> 4) + 16 * sec + (i & 15); }
__host__ __device__ __forceinline__ int qperm(int c) { const int e = c % QH; if (e < NOPE) return c; const int r = e - NOPE, i = r & 31, sec = r >> 5; return c - e + NOPE + 32 * (i >> 4) + 16 * sec + (i & 15); }
struct EpiQ {
    static constexpr bool PERM = false;
    const float* ssqq_; const float* cs; bf16_t* qbuf; bf16_t* qs;
    __device__ __forceinline__ void operator()(const f32x4 (&acc)[2][2][4][2], const pg8::Unit& u, int wr, int wc, int fr_in, int fq_in) const {
        int fr = fr_in, fq = fq_in; asm volatile("" : "+v"(fr), "+v"(fq));
        const bool smp = u.pm >= MP / 256;
        float rq[2][4]; load_rstd_p<8>(ssqq_, 1.0f / QR, u, wr, fr, fq, rq);
#pragma unroll
        for (int ai = 0; ai < 2; ++ai)
#pragma unroll
            for (int m = 0; m < 4; ++m) {
                const int row = u.pm * 256 + ai * 128 + wr * 64 + m * 16 + fr; const float r = rq[ai][m]; const int pos = smp ? PAST + ((row - MP) & 7) : (row & (SEQ - 1));
                bf16_t* qrow = qbuf + (size_t)row * (NH * QH);
#pragma unroll
                for (int bj = 0; bj < 2; ++bj) {
                    const int Gi = u.pn * 8 + bj * 4 + wc, hh = Gi / 6, gi = Gi - hh * 6;
                    if (gi < 4) {
#pragma unroll
                        for (int n = 0; n < 2; ++n) { const f32x4 a = acc[ai][bj][m][n] * r; u32x2 w; w.x = pk2(a.x, a.y); w.y = pk2(a.z, a.w);
                            *(u32x2*)(qrow + Gi * 32 + n * 16 + 4 * fq) = w; }
                    } else {
                        const int i0 = 16 * (gi - 4) + 4 * fq;
                        const f32x4 x1 = acc[ai][bj][m][0] * r, x2 = acc[ai][bj][m][1] * r;
                        const f32x4 cn = *(const f32x4*)(cs + (size_t)pos * 64 + i0), sn = *(const f32x4*)(cs + (size_t)pos * 64 + 32 + i0);
                        const f32x4 o1 = x1 * cn - x2 * sn, o2 = x2 * cn + x1 * sn;
                        u32x2 w1, w2; w1.x = pk2(o1.x, o1.y); w1.y = pk2(o1.z, o1.w); w2.x = pk2(o2.x, o2.y); w2.y = pk2(o2.z, o2.w);
                        bf16_t* qd = smp ? qs + ((size_t)(row - MP) * NH + hh) * 320 + KVR : qrow + hh * QH + NOPE;
                        *(u32x2*)(qd + i0) = w1; *(u32x2*)(qd + 32 + i0) = w2;
                    }
                }
                asm volatile("" ::: "memory");
            }
    }
};
struct EpiDkvq {
    static constexpr bool PERM = false;
    const float* ssq_in; const float* cs; float* craw_; bf16_t* cb_; bf16_t* cqb_; float* ssqc_; float* ssqq_; float* out; bf16_t* kfull_; bf16_t* krbs_;
    __device__ __forceinline__ void operator()(const f32x4 (&acc)[2][2][4][2], const pg8::Unit& u, int wr, int wc, int fr_in, int fq_in) const {
        int fr = fr_in, fq = fq_in; asm volatile("" : "+v"(fr), "+v"(fq));
        float rs[2][4]; load_rstd(ssq_in, u, wr, fr, fq, rs);
        const bool smp = u.pm >= MP / 256;
#pragma unroll
        for (int ai = 0; ai < 2; ++ai)
#pragma unroll
            for (int m = 0; m < 4; ++m) {
                const int row = u.pm * 256 + ai * 128 + wr * 64 + m * 16 + fr; const float r = rs[ai][m];
                float sq = 0.f;
                if (u.pn == 0) {
#pragma unroll
                    for (int bj = 0; bj < 2; ++bj)
#pragma unroll
                        for (int n = 0; n < 2; ++n) { const int col = bj * 128 + wc * 32 + n * 16 + 4 * fq; const f32x4 v = acc[ai][bj][m][n] * r;
                            *(f32x4*)(craw_ + (size_t)row * KVR + col) = v; u32x2 w; w.x = pk2(v.x, v.y); w.y = pk2(v.z, v.w); *(u32x2*)(cb_ + (size_t)row * KVR + col) = w;
                            sq += (v.x * v.x + v.y * v.y) + (v.z * v.z + v.w * v.w); }
                    sq += __shfl_xor(sq, 16); sq += __shfl_xor(sq, 32);
                    if (fq == 0) ssqc_[(size_t)row * 4 + wc] = sq;
                } else {
#pragma unroll
                    for (int bj = 0; bj < 2; ++bj) {
                        const int g0 = (u.pn - 1) * 256 + bj * 128 + wc * 32;
                        if (g0 < ROPE) {
                            const int i0 = 16 * (g0 >> 5) + 4 * fq, pos = smp ? PAST + ((row - MP) & 7) : (row & (SEQ - 1));
                            const f32x4 x1 = acc[ai][bj][m][0] * r, x2 = acc[ai][bj][m][1] * r;
                            const f32x4 cn = *(const f32x4*)(cs + (size_t)pos * 64 + i0), sn = *(const f32x4*)(cs + (size_t)pos * 64 + 32 + i0);
                            const f32x4 o1 = x1 * cn - x2 * sn, o2 = x2 * cn + x1 * sn;
                            float* ko = smp ? out + O_KS + (size_t)(row - MP) * ROPE : out + O_KP + (size_t)row * ROPE;
                            *(f32x4*)(ko + i0) = o1; *(f32x4*)(ko + 32 + i0) = o2;
                            u32x2 w1, w2; w1.x = pk2(o1.x, o1.y); w1.y = pk2(o1.z, o1.w); w2.x = pk2(o2.x, o2.y); w2.y = pk2(o2.z, o2.w);
                            if (smp) { bf16_t* kd = krbs_ + (size_t)(row - MP) * ROPE; *(u32x2*)(kd + i0) = w1; *(u32x2*)(kd + 32 + i0) = w2; }
                            else { const int b = row >> 13, t = row & (SEQ - 1);
#pragma unroll
                                for (int h = 0; h < NH; ++h) { bf16_t* kd = kfull_ + ((size_t)(b * NH + h) * SEQ + t) * QH + NOPE; *(u32x2*)(kd + i0) = w1; *(u32x2*)(kd + 32 + i0) = w2; } }
                        } else if (g0 < ROPE + QR) {
#pragma unroll
                            for (int n = 0; n < 2; ++n) { const int qi = g0 - ROPE + n * 16 + 4 * fq; const f32x4 v = acc[ai][bj][m][n] * r;
                                u32x2 w; w.x = pk2(v.x, v.y); w.y = pk2(v.z, v.w); *(u32x2*)(cqb_ + (size_t)row * QR + qi) = w;
                                sq += (v.x * v.x + v.y * v.y) + (v.z * v.z + v.w * v.w); }
                        }
                    }
                    sq += __shfl_xor(sq, 16); sq += __shfl_xor(sq, 32);
                    if (fq == 0) ssqq_[(size_t)row * 8 + (u.pn - 1) * 4 + wc] = sq;
                }
                asm volatile("" ::: "memory");
            }
    }
};
struct EpiKup {
    static constexpr bool PERM = true;
    bf16_t* kfull; const float* ssqc_;
    __device__ __forceinline__ void operator()(const f32x4 (&acc)[2][2][4][2], const pg8::Unit& u, int wr, int wc, int fr_in, int fq_in) const {
        int fr = fr_in, fq = fq_in; asm volatile("" : "+v"(fr), "+v"(fq));
        const int col0 = u.pn * 256 + wc * 32 + 8 * fq;
        float rc[2][4]; load_rstd_p<4>(ssqc_, 1.0f / KVR, u, wr, fr, fq, rc);
#pragma unroll
        for (int ai = 0; ai < 2; ++ai)
#pragma unroll
            for (int m = 0; m < 4; ++m) {
                const int row = u.pm * 256 + ai * 128 + wr * 64 + m * 16 + fr; const int b = row >> 13, t = row & (SEQ - 1); const float r = rc[ai][m];
#pragma unroll
                for (int bj = 0; bj < 2; ++bj) { const int col = col0 + bj * 128; const int h = col >> 7, nn = col & 127; const f32x4 a = acc[ai][bj][m][0] * r, c = acc[ai][bj][m][1] * r;
                    u32x4 w; w.x = pk2(a.x, a.y); w.y = pk2(a.z, a.w); w.z = pk2(c.x, c.y); w.w = pk2(c.z, c.w);
                    *(u32x4*)(kfull + ((size_t)(b * NH + h) * SEQ + t) * QH + nn) = w; }
                asm volatile("" ::: "memory");
            }
    }
};
struct EpiVup {
    static constexpr bool PERM = true;
    bf16_t* vt; const float* ssqc_;
    __device__ __forceinline__ void operator()(const f32x4 (&acc)[2][2][4][2], const pg8::Unit& u, int wr, int wc, int fr_in, int fq_in) const {
        int fr = fr_in, fq = fq_in; asm volatile("" : "+v"(fr), "+v"(fq));
        const int col0 = u.pn * 256 + wc * 32 + 8 * fq;
        f32x4 rt[2][2];
#pragma unroll
        for (int bj = 0; bj < 2; ++bj)
#pragma unroll
            for (int k = 0; k < 8; ++k) { const f32x4 p4 = *(const f32x4*)(ssqc_ + (size_t)(col0 + bj * 128 + k) * 4); rt[bj][k >> 2][k & 3] = 1.0f / sqrtf(((p4.x + p4.y) + (p4.z + p4.w)) * (1.0f / KVR) + EPS); }
#pragma unroll
        for (int ai = 0; ai < 2; ++ai)
#pragma unroll
            for (int m = 0; m < 4; ++m) {
                const int row = u.pm * 256 + ai * 128 + wr * 64 + m * 16 + fr; const int h = row >> 7, v = row & 127;
#pragma unroll
                for (int bj = 0; bj < 2; ++bj) { const int col = col0 + bj * 128; const int b = col >> 13, t = col & (SEQ - 1); const f32x4 a = acc[ai][bj][m][0] * rt[bj][0], c = acc[ai][bj][m][1] * rt[bj][1];
                    u32x4 w; w.x = pk2(a.x, a.y); w.y = pk2(a.z, a.w); w.z = pk2(c.x, c.y); w.w = pk2(c.z, c.w);
                    *(u32x4*)(vt + ((size_t)(b * NH + h) * VD + v) * SEQ + t) = w; }
                asm volatile("" ::: "memory");
            }
    }
};

struct SgALoadBf { const bf16_t* A; int lda;
    __device__ __forceinline__ bf16x8 operator()(int row, int k) const { return *(const bf16x8*)(A + (size_t)row * lda + k); } };
struct SgALoadComb { const float* parto; const float* ml;
    __device__ __forceinline__ bf16x8 operator()(int row, int k) const {
        const int b = row >> 3, tok = row & 7, h = k >> 7, v = k & 127, q = tok * 8 + h;
        const float* m0p = ml + ((size_t)(b * 2 + 0) * 64 + q) * 2; const float* m1p = ml + ((size_t)(b * 2 + 1) * 64 + q) * 2;
        const float m0 = m0p[0], l0 = m0p[1], m1 = m1p[0], l1 = m1p[1], mx = fmaxf(m0, m1);
        float w0 = __builtin_amdgcn_exp2f(m0 - mx), w1 = __builtin_amdgcn_exp2f(m1 - mx); const float inv = 1.0f / (w0 * l0 + w1 * l1); w0 *= inv; w1 *= inv;
        const float* p0 = parto + ((size_t)(b * 2 + 0) * 64 + q) * 128 + v; const float* p1 = parto + ((size_t)(b * 2 + 1) * 64 + q) * 128 + v;
        return pack8v(*(const f32x4*)p0 * w0 + *(const f32x4*)p1 * w1, *(const f32x4*)(p0 + 4) * w0 + *(const f32x4*)(p1 + 4) * w1); } };
template <int NCT, int NCG, class Epi, class ALoad>
__device__ __forceinline__ void sg_gemm_l(LAS unsigned char* lds, const ALoad& AL, int apn256, const bf16_t* __restrict__ Bt, int K, int unit, const Epi& E, int tid, int wave, int lane) {
    constexpr int KS = 8 / NCG, W = NCG * NCT * 16, G4 = W / 4;
    static_assert(KS * 64 * W * 4 <= RING_BYTES, "sg_gemm reduction buffer");
    const int mt = unit >> 4, ntile = unit & 15, m0 = mt * 64, n0 = ntile * W;
    const int cg = wave % NCG, kp = wave / NCG, fr = lane & 15, fq = lane >> 4;
    const int Kw = K / KS;
    const int arow = m0 + fr, acol = (n0 >> 8) * apn256 + kp * Kw + 8 * fq;
    const bf16_t* bp = Bt + (size_t)(n0 + cg * NCT * 16 + fr) * K + kp * Kw + 8 * fq;
    f32x4 acc[4][NCT];
#pragma unroll
    for (int m = 0; m < 4; ++m)
#pragma unroll
        for (int n = 0; n < NCT; ++n) acc[m][n] = (f32x4){0.f, 0.f, 0.f, 0.f};
#pragma unroll 4
    for (int kk = 0; kk < Kw; kk += 32) {
        bf16x8 af[4], bfr[NCT];
#pragma unroll
        for (int m = 0; m < 4; ++m) af[m] = AL(arow + 16 * m, acol + kk);
#pragma unroll
        for (int n = 0; n < NCT; ++n) bfr[n] = *(const bf16x8*)(bp + (size_t)(16 * n) * K + kk);
#pragma unroll
        for (int m = 0; m < 4; ++m)
#pragma unroll
            for (int n = 0; n < NCT; ++n) acc[m][n] = __builtin_amdgcn_mfma_f32_16x16x32_bf16(bfr[n], af[m], acc[m][n], 0, 0, 0);
    }
    LAS float* red = (LAS float*)lds;
#pragma unroll
    for (int m = 0; m < 4; ++m)
#pragma unroll
        for (int n = 0; n < NCT; ++n) { const int row = 16 * m + fr, c4 = (cg * NCT * 16 + 16 * n) / 4 + fq;
            *(LAS f32x4*)(red + (size_t)(kp * 64 + row) * W + 4 * (c4 ^ (row & 3))) = acc[m][n]; }
    __syncthreads();
    for (int it = tid; it < 64 * G4; it += 512) {
        const int row = it / G4, c4 = it % G4;
        f32x4 v = *(const LAS f32x4*)(red + (size_t)row * W + 4 * (c4 ^ (row & 3)));
#pragma unroll
        for (int p = 1; p < KS; ++p) v += *(const LAS f32x4*)(red + (size_t)(p * 64 + row) * W + 4 * (c4 ^ (row & 3)));
        if constexpr (Epi::WHOLE_TILE) *(LAS f32x4*)(red + (size_t)row * W + 4 * (c4 ^ (row & 3))) = v;
        else E(MP + m0 + row, n0 + 4 * c4, v, ntile);
    }
    if constexpr (Epi::WHOLE_TILE) {
        __syncthreads();
        for (int it = tid; it < 64 * G4; it += 512) { const int row = it / G4, c4 = it % G4; E.tile(MP + m0 + row, n0, c4, red + (size_t)row * W, row & 3); }
    }
    __syncthreads();
}
template <int NCT, int NCG, class Epi>
__device__ __forceinline__ void sg_gemm(LAS unsigned char* lds, const bf16_t* __restrict__ A, int lda, int apn256, const bf16_t* __restrict__ Bt, int K, int unit, const Epi& E, int tid, int wave, int lane) {
    const SgALoadBf AL{A, lda}; sg_gemm_l<NCT, NCG>(lds, AL, apn256, Bt, K, unit, E, tid, wave, lane);
}
__device__ __forceinline__ float row_rstd16(const float* ssq, int row) {
    const f32x4* s = (const f32x4*)(ssq + (size_t)row * 16); const f32x4 a = s[0], b = s[1], c = s[2], d = s[3];
    const float t = ((a.x + a.y) + (a.z + a.w)) + ((b.x + b.y) + (b.z + b.w)) + ((c.x + c.y) + (c.z + c.w)) + ((d.x + d.y) + (d.z + d.w));
    return 1.0f / sqrtf(t * (1.0f / 1024.0f) + EPS);
}
template <int MODE> struct SgH {
    static constexpr bool WHOLE_TILE = false;
    const float* xs; const float* scale; const float* ssq_in; const bf16_t* proj; const bf16_t* hb_in; bf16_t* hb; float* ssq_out;
    __device__ __forceinline__ void operator()(int row, int col, f32x4 a, int ntile) const {
        const f32x4 bs = (MODE == 0) ? *(const f32x4*)(xs + (size_t)(row - MP) * D + col) : unpk4(*(const u32x2*)(hb_in + (size_t)row * D + col));
        f32x4 o;
        if (MODE == 0) o = bs + *(const f32x4*)(scale + col) * a;
        else if (MODE == 1) o = bs + a;
        else { const float r = row_rstd16(ssq_in, row); const f32x4 pj = unpk4(*(const u32x2*)(proj + (size_t)row * D + col));
            f32x4 gt; gt.x = 1.0f / (1.0f + __expf(-r * a.x)); gt.y = 1.0f / (1.0f + __expf(-r * a.y)); gt.z = 1.0f / (1.0f + __expf(-r * a.z)); gt.w = 1.0f / (1.0f + __expf(-r * a.w));
            o = bs + gt * pj; }
        u32x2 w; w.x = pk2(o.x, o.y); w.y = pk2(o.z, o.w);
        *(u32x2*)(hb + (size_t)row * D + col) = w;
        float sq = (o.x * o.x + o.y * o.y) + (o.z * o.z + o.w * o.w);
        sq += __shfl_xor(sq, 1); sq += __shfl_xor(sq, 2); sq += __shfl_xor(sq, 4); sq += __shfl_xor(sq, 8);
        if ((col & 63) == 0) ssq_out[(size_t)row * 16 + ntile] = sq;
    }
};
struct SgUp {
    static constexpr bool WHOLE_TILE = false;
    const float* ssq_in; bf16_t* abuf;
    __device__ __forceinline__ void operator()(int row, int col, f32x4 a, int) const {
        const float r = row_rstd16(ssq_in, row); a = a * r;
        a.x = fmaxf(a.x, 0.f); a.y = fmaxf(a.y, 0.f); a.z = fmaxf(a.z, 0.f); a.w = fmaxf(a.w, 0.f);
        u32x2 w; w.x = pk2(a.x * a.x, a.y * a.y); w.y = pk2(a.z * a.z, a.w * a.w);
        *(u32x2*)(abuf + (size_t)row * FF + col) = w;
    }
};
template <int MODE> struct SgF32 {
    static constexpr bool WHOLE_TILE = false;
    float* C; int ldc; const float* aux;
    __device__ __forceinline__ void operator()(int row, int col, f32x4 a, int) const {
        const float r = (MODE == 1) ? row_rstd16(aux, row) : (MODE == 2 ? aux[row] : 1.0f);
        *(f32x4*)(C + (size_t)row * ldc + col) = a * r;
    }
};
struct SgBf {
    static constexpr bool WHOLE_TILE = false;
    bf16_t* C; int ldc;
    __device__ __forceinline__ void operator()(int row, int col, f32x4 a, int) const { u32x2 w; w.x = pk2(a.x, a.y); w.y = pk2(a.z, a.w); *(u32x2*)(C + (size_t)row * ldc + col) = w; }
};
struct SgQ {
    static constexpr bool WHOLE_TILE = true;
    const float* rstdq; const float* cs; bf16_t* qbuf; bf16_t* qs;
    __device__ __forceinline__ void operator()(int, int, f32x4, int) const {}
    __device__ __forceinline__ void tile(int row, int n0, int c4, const LAS float* trow, int sw) const {
        const int c = n0 + 4 * c4, hh = c / QH, e = c - hh * QH; const float r = rstdq[row];
        const f32x4 v = *(const LAS f32x4*)(trow + 4 * (c4 ^ sw)) * r;
        if (e < NOPE) { u32x2 w; w.x = pk2(v.x, v.y); w.y = pk2(v.z, v.w); *(u32x2*)(qbuf + (size_t)row * (NH * QH) + c) = w; }
        else { const int rp = e - NOPE, wi = rp & 31;
            if (wi < 16) { const int i0 = 16 * (rp >> 5) + wi, pos = PAST + ((row - MP) & 7);
                const f32x4 x2 = *(const LAS f32x4*)(trow + 4 * ((c4 + 4) ^ sw)) * r;
                const f32x4 cn = *(const f32x4*)(cs + (size_t)pos * 64 + i0), sn = *(const f32x4*)(cs + (size_t)pos * 64 + 32 + i0);
                const f32x4 o1 = v * cn - x2 * sn, o2 = x2 * cn + v * sn;
                bf16_t* qd = qs + ((size_t)(row - MP) * NH + hh) * 320 + KVR;
                u32x2 w1, w2; w1.x = pk2(o1.x, o1.y); w1.y = pk2(o1.z, o1.w); w2.x = pk2(o2.x, o2.y); w2.y = pk2(o2.z, o2.w);
                *(u32x2*)(qd + i0) = w1; *(u32x2*)(qd + 32 + i0) = w2; } }
    }
};

template <int PMODE = 0>
__device__ __forceinline__ void transpose_item(const float* W, const float* kscale, int K, int N, bf16_t* WT, int row_off, LAS float* scr, int item, int lane) {
    const int nblk = N / 32, kb = item / nblk, nb = item % nblk, k0 = 64 * kb, n0 = 32 * nb;
    { f32x4 v[8];
#pragma unroll
      for (int i = 0; i < 8; ++i) v[i] = *(const f32x4*)(W + (size_t)(k0 + (lane >> 3) + 8 * i) * N + n0 + (lane & 7) * 4);
#pragma unroll
      for (int i = 0; i < 8; ++i) { const int kk = (lane >> 3) + 8 * i; f32x4 x = v[i]; if (kscale) x = x * kscale[k0 + kk];
          LAS float* d = scr + kk * 33 + (lane & 7) * 4; d[0] = x.x; d[1] = x.y; d[2] = x.z; d[3] = x.w; } }
    LDS_WAIT(); asm volatile("" ::: "memory");
    const int c = lane & 7;
#pragma unroll
    for (int j = 0; j < 4; ++j) { const int n = (lane >> 3) + 8 * j; const LAS float* s = scr + (8 * c) * 33 + n;
        u32x4 o; o.x = pk2(s[0 * 33], s[1 * 33]); o.y = pk2(s[2 * 33], s[3 * 33]); o.z = pk2(s[4 * 33], s[5 * 33]); o.w = pk2(s[6 * 33], s[7 * 33]);
        *(u32x4*)(WT + (size_t)(row_off + (PMODE == 1 ? qperm(n0 + n) : (PMODE == 2 ? kperm(n0 + n) : n0 + n))) * K + k0 + 8 * c) = o; }
    LDS_WAIT(); asm volatile("" ::: "memory");
}

constexpr int AK_PITCH = 400, AK_BUF = 64 * AK_PITCH;
constexpr int AV_PITCH = 136, AV_BUF = 128 * AV_PITCH;
constexpr int AV_OFF = 2 * AK_BUF, AQ_OFF = AV_OFF + 2 * AV_BUF;
static_assert(AQ_OFF + 256 * 144 <= RING_BYTES, "attention LDS");
__device__ __forceinline__ void attn_prompt_unit(const bf16_t* __restrict__ qbuf, const bf16_t* __restrict__ Kf, const bf16_t* __restrict__ Vt, bf16_t* __restrict__ obuf,
                                                 int b, int h, int qb, LAS unsigned char* lds, int tid, int wave, int lane) {
    const int r32 = lane & 31, g = lane >> 5;
    const int t_lo = qb * 256 + wave * 32, trow = t_lo + r32;
    bf16x8 qf[8];
    { const bf16_t* qp = qbuf + (size_t)(b * SEQ + trow) * (NH * QH) + h * QH + 8 * g;
      __syncthreads();
#pragma unroll
      for (int ks = 8; ks < 12; ++ks) *(LAS bf16x8*)(lds + AQ_OFF + (wave * 32 + r32) * 144 + (2 * (ks - 8) + g) * 16) = *(const bf16x8*)(qp + 16 * ks);
#pragma unroll
      for (int ks = 0; ks < 8; ++ks) qf[ks] = *(const bf16x8*)(qp + 16 * ks);
#pragma unroll
      for (int ks = 0; ks < 8; ++ks) asm volatile("" : "+v"(qf[ks])); }
    f32x16 O[4];
#pragma unroll
    for (int i = 0; i < 4; ++i)
#pragma unroll
        for (int j = 0; j < 16; ++j) O[i][j] = 0.f;
    float mrun = -1e30f, lrun = 0.f;
    const bf16_t* Kb = Kf + (size_t)(b * NH + h) * SEQ * QH;
    const bf16_t* Vb = Vt + (size_t)(b * NH + h) * VD * SEQ;
    const int NT = (qb + 1) * 4;
    int kl_off[3], vl_off[2]; size_t vg_off[2];
#pragma unroll
    for (int e = 0; e < 3; ++e) kl_off[e] = (tid >> 3) * AK_PITCH + ((tid & 7) + 8 * e) * 16;
#pragma unroll
    for (int e = 0; e < 2; ++e) { const int c = tid + 512 * e; vl_off[e] = AV_OFF + (c >> 3) * AV_PITCH + (c & 7) * 16; vg_off[e] = (size_t)(c >> 3) * SEQ + (c & 7) * 8; }
    u32x4 kst[3], vst[2];
#define AT_LOAD(j) do { _Pragma("unroll") for (int e = 0; e < 3; ++e) kst[e] = *(const u32x4*)(Kb + (size_t)(64 * (j) + (tid >> 3)) * QH + ((tid & 7) + 8 * e) * 8); \
                        _Pragma("unroll") for (int e = 0; e < 2; ++e) vst[e] = *(const u32x4*)(Vb + vg_off[e] + 64 * (j)); } while (0)
#define AT_WRITE(buf) do { _Pragma("unroll") for (int e = 0; e < 3; ++e) *(LAS u32x4*)(lds + (buf) * AK_BUF + kl_off[e]) = kst[e]; \
                           _Pragma("unroll") for (int e = 0; e < 2; ++e) { *(LAS u32x2*)(lds + (buf) * AV_BUF + vl_off[e]) = (u32x2){vst[e].x, vst[e].y}; *(LAS u32x2*)(lds + (buf) * AV_BUF + vl_off[e] + 8) = (u32x2){vst[e].z, vst[e].w}; } } while (0)
    AT_LOAD(0); AT_WRITE(0);
    __syncthreads();
    for (int j = 0; j < NT; ++j) {
        const int buf = j & 1;
        if (j + 1 < NT) AT_LOAD(j + 1);
        if (64 * j <= t_lo + 31) {
            f32x16 S0, S1;
#pragma unroll
            for (int i = 0; i < 16; ++i) { S0[i] = 0.f; S1[i] = 0.f; }
            const LAS unsigned char* kl = lds + buf * AK_BUF + r32 * AK_PITCH + g * 16;
            const LAS unsigned char* ql = lds + AQ_OFF + (wave * 32 + r32) * 144 + g * 16;
            bf16x8 ka[3][2], qr_[3];
#define AT_KLD(ks) do { ka[(ks) % 3][0] = *(const LAS bf16x8*)(kl + (ks) * 32); ka[(ks) % 3][1] = *(const LAS bf16x8*)(kl + 32 * AK_PITCH + (ks) * 32); \
                        if ((ks) >= 8) qr_[(ks) % 3] = *(const LAS bf16x8*)(ql + ((ks) - 8) * 32); } while (0)
            AT_KLD(0); AT_KLD(1);
#pragma unroll
            for (int ks = 0; ks < 12; ++ks) {
                if (ks + 2 < 12) AT_KLD(ks + 2);
                __builtin_amdgcn_sched_barrier(0);
                const bf16x8 qb_ = (ks < 8) ? qf[ks < 8 ? ks : 0] : qr_[ks % 3];
                S0 = __builtin_amdgcn_mfma_f32_32x32x16_bf16(ka[ks % 3][0], qb_, S0, 0, 0, 0);
                S1 = __builtin_amdgcn_mfma_f32_32x32x16_bf16(ka[ks % 3][1], qb_, S1, 0, 0, 0);
                __builtin_amdgcn_sched_barrier(0);
            }
#undef AT_KLD
            if (64 * j + 63 > t_lo) {
                asm volatile("" ::: "memory");
#pragma unroll
                for (int i = 0; i < 16; ++i) { const int key = 64 * j + crow(i, g); if (key > trow) S0[i] = -1e30f; if (key + 32 > trow) S1[i] = -1e30f; }
            }
            float mx = S0[0];
#pragma unroll
            for (int i = 1; i < 16; ++i) mx = fmaxf(mx, S0[i]);
#pragma unroll
            for (int i = 0; i < 16; ++i) mx = fmaxf(mx, S1[i]);
            mx = fmaxf(mx, __shfl_xor(mx, 32)) * CEXP;
            if (__any(mx > mrun + 11.5f)) {
                const float mnew = fmaxf(mrun, mx), alpha = __builtin_amdgcn_exp2f(mrun - mnew);
                mrun = mnew; lrun *= alpha;
#pragma unroll
                for (int vt = 0; vt < 4; ++vt)
#pragma unroll
                    for (int i = 0; i < 16; ++i) O[vt][i] *= alpha;
            }
            float ps = 0.f;
#pragma unroll
            for (int i = 0; i < 16; ++i) { S0[i] = __builtin_amdgcn_exp2f(S0[i] * CEXP - mrun); S1[i] = __builtin_amdgcn_exp2f(S1[i] * CEXP - mrun); ps += S0[i] + S1[i]; }
            lrun += ps;
            bf16x8 pf[4];
            { float tmp[8];
#pragma unroll
              for (int s2 = 0; s2 < 4; ++s2) {
#pragma unroll
                for (int i = 0; i < 8; ++i) tmp[i] = (s2 < 2) ? S0[8 * (s2 & 1) + i] : S1[8 * (s2 & 1) + i];
                pf[s2] = pack8(tmp); } }
            const LAS unsigned char* vl = lds + AV_OFF + buf * AV_BUF + r32 * AV_PITCH + g * 8;
            u32x4 fa[4], fb[4];
#define AT_VLD(dst, vt) do { _Pragma("unroll") for (int s2 = 0; s2 < 4; ++s2) { const u32x2 lo_ = *(const LAS u32x2*)(vl + (vt) * 32 * AV_PITCH + s2 * 32), hi_ = *(const LAS u32x2*)(vl + (vt) * 32 * AV_PITCH + s2 * 32 + 16); dst[s2] = (u32x4){lo_.x, lo_.y, hi_.x, hi_.y}; } } while (0)
#define AT_VMM(src, vt) do { _Pragma("unroll") for (int s2 = 0; s2 < 4; ++s2) O[vt] = __builtin_amdgcn_mfma_f32_32x32x16_bf16(__builtin_bit_cast(bf16x8, src[s2]), pf[s2], O[vt], 0, 0, 0); } while (0)
            AT_VLD(fa, 0); AT_VLD(fb, 1); __builtin_amdgcn_sched_barrier(0);
            AT_VMM(fa, 0); __builtin_amdgcn_sched_barrier(0);
            AT_VLD(fa, 2); __builtin_amdgcn_sched_barrier(0);
            AT_VMM(fb, 1); __builtin_amdgcn_sched_barrier(0);
            AT_VLD(fb, 3); __builtin_amdgcn_sched_barrier(0);
            AT_VMM(fa, 2); __builtin_amdgcn_sched_barrier(0);
            AT_VMM(fb, 3);
#undef AT_VLD
#undef AT_VMM
        }
        if (j + 1 < NT) AT_WRITE(buf ^ 1);
        __syncthreads();
    }
#undef AT_LOAD
#undef AT_WRITE
    const float ltot = lrun + __shfl_xor(lrun, 32), inv = 1.0f / ltot;
    bf16_t* op = obuf + (size_t)(b * SEQ + trow) * D + h * VD + 4 * g;
#pragma unroll
    for (int vt = 0; vt < 4; ++vt)
#pragma unroll
        for (int jq = 0; jq < 4; ++jq) {
            u32x2 w; w.x = pk2(O[vt][4 * jq] * inv, O[vt][4 * jq + 1] * inv); w.y = pk2(O[vt][4 * jq + 2] * inv, O[vt][4 * jq + 3] * inv);
            *(u32x2*)(op + 32 * vt + 8 * jq) = w;
        }
}

typedef short s16x4 __attribute__((ext_vector_type(4)));
constexpr int SA_KR = 32768, SA_BUF = 32768 + 64 * 144, SA_QR = 2 * SA_BUF, SA_QI = SA_QR + 64 * 144, SA_QI_PITCH = 528, SA_OI = 69632;
static_assert(SA_OI >= 65536 + 1024 && SA_OI + 64 * SA_QI_PITCH <= MISC_OFF, "O image");
static_assert(SA_QI + 64 * SA_QI_PITCH <= MISC_OFF, "sample attention LDS");
__device__ __forceinline__ int sa_off(int row, int ch) { return 256 * row + 16 * (ch ^ (((row & 3) << 2) | ((row >> 2) & 3))); }
__device__ __forceinline__ void sattn_item(const Params& P, int b, int half, LAS unsigned char* lds, int tid, int wave, int lane) {
    unsigned char* ws = P.ws;
    const int r32 = lane & 31, g = lane >> 5;
    const bool is_cmp = wave < 4;
    const int qt = wave & 1, kb = (wave >> 1) & 1;
    const int ptv = ((const int*)P.in[I_PT])[b * NPG + half * 32 + (lane & 31)];
    const float* clat = P.in[I_CLAT]; const float* ckr = P.in[I_CKR];
#define SA_LOAD(S, h) do { const int pg_ = __builtin_amdgcn_readlane(ptv, (h) >> 2); const size_t prow_ = (size_t)pg_ * PAGE + (((h) & 3) << 5); \
        const char* lat_ = (const char*)(clat + prow_ * KVR); const char* kro_ = (const char*)(ckr + prow_ * ROPE); \
        _Pragma("unroll") for (int e = 0; e < 4; ++e) { S[2 * e] = *(const f32x4*)(lat_ + glb[e]); S[2 * e + 1] = *(const f32x4*)(lat_ + glb[e] + 16); } \
        S[8] = *(const f32x4*)(kro_ + grb); S[9] = *(const f32x4*)(kro_ + grb + 16); } while (0)
#define SA_WRITE(S, bufo, hh) do { \
        _Pragma("unroll") for (int e = 0; e < 4; ++e) *(LAS bf16x8*)(lds + (bufo) + llb[e][hh]) = pack8v(S[2 * e], S[2 * e + 1]); \
        *(LAS bf16x8*)(lds + (bufo) + lrb[hh]) = pack8v(S[8], S[9]); asm volatile("" ::: "memory"); } while (0)
    __syncthreads();
    *(LAS u32x4*)(lds + SA_QR + (tid >> 3) * 144 + (tid & 7) * 16) = *(const u32x4*)((const bf16_t*)(ws + WS_QS) + ((size_t)b * 64 + (tid >> 3)) * 320 + KVR + (tid & 7) * 8);
    {
      const bf16_t* qn = (const bf16_t*)(ws + WS_QBUF) + (size_t)(MP + b * DS + (r32 & 7)) * (NH * QH) + wave * QH + 8 * g;
      bf16x8 an[8];
#pragma unroll
      for (int ks = 0; ks < 8; ++ks) { u32x4 z = {0u, 0u, 0u, 0u}; if (r32 < DS) z = *(const u32x4*)(qn + 16 * ks); an[ks] = __builtin_bit_cast(bf16x8, z); }
      const bf16_t* wk = (const bf16_t*)(ws + WS_WUKB) + (size_t)r32 * 1024 + wave * NOPE + 8 * g;
#pragma unroll 2
      for (int nt = 0; nt < 8; ++nt) {
          f32x16 acc;
#pragma unroll
          for (int i = 0; i < 16; ++i) acc[i] = 0.f;
#pragma unroll
          for (int ks = 0; ks < 8; ++ks) acc = __builtin_amdgcn_mfma_f32_32x32x16_bf16(an[ks], *(const bf16x8*)(wk + (size_t)(32 * nt) * 1024 + 16 * ks), acc, 0, 0, 0);
#pragma unroll
          for (int i = 0; i < 4; ++i) *(LAS bf16_t*)(lds + SA_QI + ((i + 4 * g) * 8 + wave) * SA_QI_PITCH + (32 * nt + r32) * 2) = (bf16_t)f2bf(acc[i]);
      } }
    __syncthreads();
#define SA_KLD(ks) do { const int o0_ = ((ks) < 16) ? (((ks) >> 3) * 16384 + krow + 32 * (((ks) & 7) ^ (x_ >> 1))) : (krope + 32 * ((ks) - 16)); \
        ka_[(ks) & 3] = *(const LAS bf16x8*)(kb_ + o0_); \
        qa_[(ks) & 3] = ((ks) < 16) ? *(const LAS bf16x8*)(qil + 32 * (ks)) : *(const LAS bf16x8*)(qrl + 32 * ((ks) - 16)); } while (0)
#define SA_VLD(dst, vt) do { const LAS unsigned char* vb_ = kb_ + ((vt) >> 2) * 16384 + 8192 * kb; \
        const int c0_ = 4 * ((vt) & 3) + 2 * vsub + (p_ >> 1); \
        const int blo_ = 256 * (4 * gg + q_) + 16 * (c0_ ^ ((q_ << 2) | gg)) + 8 * (p_ & 1); \
        const int bhi_ = 256 * (4 * gg + q_ + 8) + 16 * (c0_ ^ ((q_ << 2) | (gg + 2))) + 8 * (p_ & 1); \
        _Pragma("unroll") for (int s2 = 0; s2 < 2; ++s2) { \
            const s16x4 lo_ = __builtin_amdgcn_ds_read_tr16_b64_v4i16((LAS s16x4*)(vb_ + blo_ + 4096 * s2)); \
            const s16x4 hi_ = __builtin_amdgcn_ds_read_tr16_b64_v4i16((LAS s16x4*)(vb_ + bhi_ + 4096 * s2)); \
            dst[s2] = (bf16x8){lo_[0], lo_[1], lo_[2], lo_[3], hi_[0], hi_[1], hi_[2], hi_[3]}; } } while (0)
#define SA_VMM(src, vt) do { _Pragma("unroll") for (int s2 = 0; s2 < 2; ++s2) O[vt] = __builtin_amdgcn_mfma_f32_32x32x16_bf16(src[s2], pf[s2], O[vt], 0, 0, 0); } while (0)
#define SA_COMPUTE(j, bufo) do { \
        const LAS unsigned char* kb_ = lds + (bufo); \
        f32x16 S0; \
        _Pragma("unroll") for (int i = 0; i < 16; ++i) S0[i] = 0.f; \
        int r32v = r32; asm volatile("" : "+v"(r32v)); \
        const int x_ = ((r32v & 3) << 2) | ((r32v >> 2) & 3); \
        const int krow = 256 * (r32v + 32 * kb) + 16 * ((g ^ x_) & 1), krope = SA_KR + (r32v + 32 * kb) * 144 + g * 16; \
        const LAS unsigned char* qrl = lds + SA_QR + (32 * qt + r32v) * 144 + g * 16; const LAS unsigned char* qil = lds + SA_QI + (32 * qt + r32v) * SA_QI_PITCH + g * 16; \
        bf16x8 ka_[4], qa_[4]; \
        SA_KLD(0); SA_KLD(1); SA_KLD(2); \
        _Pragma("unroll") for (int ks = 0; ks < 20; ++ks) { \
            if (ks + 3 < 20) SA_KLD(ks + 3); \
            __builtin_amdgcn_sched_barrier(0); \
            S0 = __builtin_amdgcn_mfma_f32_32x32x16_bf16(ka_[ks & 3], qa_[ks & 3], S0, 0, 0, 0); \
            __builtin_amdgcn_sched_barrier(0); } \
        if ((j) == 64) { const int tok = (32 * qt + r32) >> 3; asm volatile("" ::: "memory"); \
            _Pragma("unroll") for (int i = 0; i < 16; ++i) { const int key = 32 * kb + crow(i, g); if (key > tok || key >= DS) S0[i] = -1e30f; } } \
        float mx = S0[0]; \
        _Pragma("unroll") for (int i = 1; i < 16; ++i) mx = fmaxf(mx, S0[i]); \
        mx = fmaxf(mx, __shfl_xor(mx, 32)) * CEXP; \
        if (__any(mx > mrun + 11.5f)) { const float mnew = fmaxf(mrun, mx), alpha = __builtin_amdgcn_exp2f(mrun - mnew); mrun = mnew; lrun *= alpha; \
            _Pragma("unroll") for (int vt = 0; vt < 8; ++vt) _Pragma("unroll") for (int i = 0; i < 16; ++i) O[vt][i] *= alpha; } \
        int lnv = lane; asm volatile("" : "+v"(lnv)); \
        const int li = lnv & 15, q_ = li >> 2, p_ = li & 3, vsub = (lnv >> 4) & 1, gg = lnv >> 5; \
        bf16x8 fa_[2], fb_[2]; \
        SA_VLD(fa_, 0); SA_VLD(fb_, 1);                        \
        float ps = 0.f; \
        _Pragma("unroll") for (int i = 0; i < 16; ++i) { S0[i] = __builtin_amdgcn_exp2f(S0[i] * CEXP - mrun); ps += S0[i]; } \
        lrun += ps; \
        bf16x8 pf[2]; \
        { float tmp[8]; \
          _Pragma("unroll") for (int s2 = 0; s2 < 2; ++s2) { \
            _Pragma("unroll") for (int i = 0; i < 8; ++i) tmp[i] = S0[8 * s2 + i]; \
            pf[s2] = pack8(tmp); } } \
        __builtin_amdgcn_sched_barrier(0); \
        SA_VMM(fa_, 0); __builtin_amdgcn_sched_barrier(0); SA_VLD(fa_, 2); __builtin_amdgcn_sched_barrier(0); \
        SA_VMM(fb_, 1); __builtin_amdgcn_sched_barrier(0); SA_VLD(fb_, 3); __builtin_amdgcn_sched_barrier(0); \
        SA_VMM(fa_, 2); __builtin_amdgcn_sched_barrier(0); SA_VLD(fa_, 4); __builtin_amdgcn_sched_barrier(0); \
        SA_VMM(fb_, 3); __builtin_amdgcn_sched_barrier(0); SA_VLD(fb_, 5); __builtin_amdgcn_sched_barrier(0); \
        SA_VMM(fa_, 4); __builtin_amdgcn_sched_barrier(0); SA_VLD(fa_, 6); __builtin_amdgcn_sched_barrier(0); \
        SA_VMM(fb_, 5); __builtin_amdgcn_sched_barrier(0); SA_VLD(fb_, 7); __builtin_amdgcn_sched_barrier(0); \
        SA_VMM(fa_, 6); __builtin_amdgcn_sched_barrier(0); \
        SA_VMM(fb_, 7); } while (0)
#define SA_LOADER(j, SX, SY, bufn) do { \
        if ((j) + 1 < 64) { SA_WRITE(SX, bufn, 0); if (2 * (j) + 6 < 128) SA_LOAD(SX, 2 * (j) + 6); SA_WRITE(SY, bufn, 1); if (2 * (j) + 7 < 128) SA_LOAD(SY, 2 * (j) + 7); } \
        else if ((j) + 1 == 64 && half == 1) { \
            const char* cbn = (const char*)((const bf16_t*)(ws + WS_CB) + (size_t)(MP + b * DS) * KVR); const char* krn = (const char*)((const bf16_t*)(ws + WS_KRBS) + (size_t)(b * DS) * ROPE); \
            const int lz_ = tid - 256; \
            _Pragma("unroll") for (int hh = 0; hh < 2; ++hh) { \
                _Pragma("unroll") for (int e = 0; e < 4; ++e) { const int key = ((lz_ + 256 * e) >> 5) + 32 * hh; u32x4 z = {0u, 0u, 0u, 0u}; if (key < DS) z = *(const u32x4*)(cbn + (glb[e] >> 1)); *(LAS u32x4*)(lds + (bufn) + llb[e][hh]) = z; } \
                { const int key = (lz_ >> 3) + 32 * hh; u32x4 z = {0u, 0u, 0u, 0u}; if (key < DS) z = *(const u32x4*)(krn + (grb >> 1)); *(LAS u32x4*)(lds + (bufn) + lrb[hh]) = z; } } } } while (0)
#define SA_BAR() do { asm volatile("s_waitcnt lgkmcnt(0)" ::: "memory"); __builtin_amdgcn_s_barrier(); asm volatile("" ::: "memory"); } while (0)
    float* ml = (float*)(ws + WS_ML) + (size_t)(b * 2 + half) * 64 * 2;
    if (is_cmp) {
        SA_BAR();
        f32x16 O[8];
#pragma unroll
        for (int vt = 0; vt < 8; ++vt)
#pragma unroll
            for (int i = 0; i < 16; ++i) O[vt][i] = 0.f;
        float mrun = -1e30f, lrun = 0.f;
        int bo = 0;
        for (int j = 0; j < 64; ++j) {
            SA_COMPUTE(j, bo);
            bo = SA_BUF - bo;
            SA_BAR();
        }
        if (half == 1) { SA_COMPUTE(64, bo); SA_BAR(); }
        LAS float* xo = (LAS float*)(lds + qt * 32768); LAS float* xm = (LAS float*)(lds + 65536 + qt * 512);
        if (kb == 1) { xm[2 * lane] = mrun; xm[2 * lane + 1] = lrun;
#pragma unroll
            for (int vt = 0; vt < 8; ++vt)
#pragma unroll
                for (int i = 0; i < 16; ++i) xo[(vt * 16 + i) * 64 + lane] = O[vt][i]; }
        SA_BAR();
        if (kb == 0) {
            const float m1 = xm[2 * lane], l1 = xm[2 * lane + 1], mm = fmaxf(mrun, m1);
            const float a0 = __builtin_amdgcn_exp2f(mrun - mm), a1 = __builtin_amdgcn_exp2f(m1 - mm);
            const float ll = lrun * a0 + l1 * a1, lt = ll + __shfl_xor(ll, 32);
            const int q = 32 * qt + r32;
            if (g == 0) { ml[q * 2] = mm; ml[q * 2 + 1] = lt; }
#pragma unroll
            for (int vt = 0; vt < 8; ++vt) {
                float o[16];
#pragma unroll
                for (int i = 0; i < 16; ++i) o[i] = O[vt][i] * a0 + xo[(vt * 16 + i) * 64 + lane] * a1;
#pragma unroll
                for (int jq = 0; jq < 4; ++jq) { u32x2 w; w.x = pk2(o[4 * jq], o[4 * jq + 1]); w.y = pk2(o[4 * jq + 2], o[4 * jq + 3]);
                    *(LAS u32x2*)(lds + SA_OI + q * SA_QI_PITCH + (32 * vt + 8 * jq + 4 * g) * 2) = w; }
            }
        }
    } else {
        unsigned glb[4], llb[4][2], grb, lrb[2];
        { const int lz_ = tid - 256;
#pragma unroll
          for (int e = 0; e < 4; ++e) { const int gi = lz_ + 256 * e, key = gi >> 5, cg = gi & 31; glb[e] = (unsigned)(key * KVR + cg * 8) * 4u;
#pragma unroll
              for (int hh = 0; hh < 2; ++hh) llb[e][hh] = (unsigned)((cg >> 4) * 16384 + sa_off(key + 32 * hh, cg & 15)); }
          grb = (unsigned)((lz_ >> 3) * ROPE + (lz_ & 7) * 8) * 4u;
#pragma unroll
          for (int hh = 0; hh < 2; ++hh) lrb[hh] = (unsigned)(SA_KR + ((lz_ >> 3) + 32 * hh) * 144 + (lz_ & 7) * 16); }
        f32x4 s0[10], s1[10], s2[10], s3[10];
        SA_LOAD(s0, 0); SA_LOAD(s1, 1); SA_LOAD(s2, 2); SA_LOAD(s3, 3);
        SA_WRITE(s0, 0, 0); SA_LOAD(s0, 4); SA_WRITE(s1, 0, 1); SA_LOAD(s1, 5);
        SA_BAR();
        for (int j = 0; j < 64; j += 2) {
            SA_LOADER(j, s2, s3, SA_BUF);
            SA_BAR();
            SA_LOADER(j + 1, s0, s1, 0);
            SA_BAR();
        }
        if (half == 1) SA_BAR();
        SA_BAR();
    }
#undef SA_BAR
#undef SA_LOAD
#undef SA_WRITE
#undef SA_COMPUTE
#undef SA_KLD
#undef SA_VLD
#undef SA_VMM
#undef SA_LOADER

    float* parto = (float*)(ws + WS_PART) + (size_t)(b * 2 + half) * 64 * 128;
    __syncthreads();
    { bf16x8 ao[16];
#pragma unroll
      for (int ks = 0; ks < 16; ++ks) { u32x4 z = {0u, 0u, 0u, 0u}; if (r32 < DS) z = *(const LAS u32x4*)(lds + SA_OI + (r32 * 8 + wave) * SA_QI_PITCH + (16 * ks + 8 * g) * 2); ao[ks] = __builtin_bit_cast(bf16x8, z); }
      const bf16_t* wv = (const bf16_t*)(ws + WS_WUVP) + (size_t)(wave * VD + r32) * KVR + 8 * g;
#pragma unroll 2
      for (int nt = 0; nt < 4; ++nt) {
          f32x16 acc;
#pragma unroll
          for (int i = 0; i < 16; ++i) acc[i] = 0.f;
#pragma unroll
          for (int ks = 0; ks < 16; ++ks) acc = __builtin_amdgcn_mfma_f32_32x32x16_bf16(ao[ks], *(const bf16x8*)(wv + (size_t)(32 * nt) * KVR + 16 * ks), acc, 0, 0, 0);
#pragma unroll
          for (int i = 0; i < 4; ++i) parto[(size_t)((i + 4 * g) * 8 + wave) * 128 + 32 * nt + r32] = acc[i];
      } }
}

template <int W>
__device__ __forceinline__ void pool_chunk(const float* __restrict__ xr, int rvb, f32x4 gn, int col, int t0, bf16_t* __restrict__ drow) {
    f32x4 ring[W - 1]; f32x4 sum = {0.f, 0.f, 0.f, 0.f};
#pragma unroll
    for (int i = W - 1; i >= 1; --i) { f32x4 u = {0.f, 0.f, 0.f, 0.f};
        if (t0 - i >= 0) u = *(const f32x4*)(xr - (size_t)i * D + col) * __builtin_bit_cast(float, __builtin_amdgcn_readlane(rvb, 15 - i));
        ring[(W - 1 - i) % (W - 1)] = u; sum += u; }
#pragma unroll
    for (int r = 0; r < 16; ++r) {
        const f32x4 u = *(const f32x4*)(xr + (size_t)r * D + col) * __builtin_bit_cast(float, __builtin_amdgcn_readlane(rvb, 15 + r));
        sum += u;
        const int t = t0 + r; const float icnt = 1.0f / (float)((t + 1) < W ? (t + 1) : W);
        const f32x4 dd = (sum * icnt - u) * gn;
        u32x2 o; o.x = pk2(dd.x, dd.y); o.y = pk2(dd.z, dd.w);
        *(u32x2*)(drow + (size_t)r * D + col) = o;
        sum -= ring[r % (W - 1)]; ring[r % (W - 1)] = u;
    }
}
constexpr int NPH = 17;
__global__ void __launch_bounds__(512, 2) yoco_fwd(Params P) {
    extern __shared__ __attribute__((aligned(16))) unsigned char lds_raw[];
    LAS unsigned char* lds = (LAS unsigned char*)lds_raw;
    volatile LAS unsigned* MISC = (volatile LAS unsigned*)(lds + MISC_OFF);
    const int tid = threadIdx.x, lane = tid & 63, wave = __builtin_amdgcn_readfirstlane(tid >> 6);
    const int G = gridDim.x; const int bx = blockIdx.x; const int vcu = (G % 8 == 0) ? (bx % 8) * (G / 8) + bx / 8 : bx;
    unsigned char* ws = P.ws; float* out = P.out;
    for (int u = tid; u < 64; u += 512) MISC[u] = 0u;
    __syncthreads();
    XcdBarrier bar; bar.bar = (unsigned*)(ws + WS_CTL) + CW_BAR; bar.x = 0; bar.st = nullptr;
    if (MK_N_LAUNCHES == 1) bar = xcd_barrier_post((unsigned*)(ws + WS_CTL) + CW_BAR, MISC + 8);
    const int lo = P.ph_lo, hi = P.ph_hi;
#ifndef PH_MASK
#define PH_MASK 0xFFFFFFFFu
#endif
#define IN(k) (((PH_MASK >> (k)) & 1u) && lo <= (k) && (k) < hi)
#define SEAM(k) do { if (IN(k) && IN((k) + 1)) xcd_barrier(bar); } while (0)
#define SEAM2(k, kn) do { if (IN(k) && IN(kn)) xcd_barrier(bar); } while (0)
    const int gw = vcu * 8 + wave, NGW = G * 8;
    const int gtid = vcu * 512 + tid, NGT = G * 512;

#define wpool ((bf16_t*)(ws + WS_WPOOL))
#define wup ((bf16_t*)(ws + WS_WUP))
#define wdown ((bf16_t*)(ws + WS_WDOWN))
#define wgate ((bf16_t*)(ws + WS_WGATE))
#define wproj ((bf16_t*)(ws + WS_WPROJ))
#define wdkvq ((bf16_t*)(ws + WS_WDKVQ))
#define wuq ((bf16_t*)(ws + WS_WUQ))
#define wukt ((bf16_t*)(ws + WS_WUKT))
#define wuvt ((bf16_t*)(ws + WS_WUVT))
#define wukb ((bf16_t*)(ws + WS_WUKB))
#define wo ((bf16_t*)(ws + WS_WO))
#define cs ((float*)(ws + WS_CS))
#define rstd0 ((float*)(ws + WS_RSTD0))
#define dbuf ((bf16_t*)(ws + WS_DBUF))
#define pb ((bf16_t*)(ws + WS_PB))
#define hbA ((bf16_t*)(ws + WS_HBA))
#define hbB ((bf16_t*)(ws + WS_HBB))
#define ssq ((float*)(ws + WS_SSQ))
#define abuf ((bf16_t*)(ws + WS_ABUF))
#define proj ((bf16_t*)(ws + WS_PROJ))
#define craw ((float*)(ws + WS_RAW))
#define ssqc ((float*)(ws + WS_RAW + (size_t)M * KVR * 4))
#define ssqq ((float*)(ws + WS_RAW + (size_t)M * KVR * 4 + (size_t)M * 16))
#define cb ((bf16_t*)(ws + WS_CB))
#define krbs ((bf16_t*)(ws + WS_KRBS))
#define cqb ((bf16_t*)(ws + WS_CQB))
#define qbuf ((bf16_t*)(ws + WS_QBUF))
#define qs ((bf16_t*)(ws + WS_QS))
#define kfull ((bf16_t*)(ws + WS_KFULL))
#define vt ((bf16_t*)(ws + WS_VT))
#define obuf ((bf16_t*)(ws + WS_OBUF))
    constexpr size_t SSQ_V = (size_t)M * 16;

    if (IN(0)) {
        LAS float* scr = (LAS float*)(lds + wave * 16384);
        int it = gw;
#define TI(W_, ks_, K_, N_, WT_, ro_) { const int n_items = ((K_) / 64) * ((N_) / 32); for (; it < n_items; it += NGW) transpose_item(W_, ks_, K_, N_, WT_, ro_, scr, it, lane); it -= n_items; }
        TI(P.in[I_POOLW] + 0 * 65536, nullptr, 256, 256, wpool, 0) TI(P.in[I_POOLW] + 1 * 65536, nullptr, 256, 256, wpool, 256)
        TI(P.in[I_POOLW] + 2 * 65536, nullptr, 256, 256, wpool, 512) TI(P.in[I_POOLW] + 3 * 65536, nullptr, 256, 256, wpool, 768)
        TI(P.in[I_WUP], P.in[I_NMLP], D, FF, wup, 0) TI(P.in[I_WUP] + (size_t)D * FF, P.in[I_NMLP] + D, D, FF, wup + (size_t)FF * D, 0)
        TI(P.in[I_WDOWN], nullptr, FF, D, wdown, 0) TI(P.in[I_WDOWN] + (size_t)D * FF, nullptr, FF, D, wdown + (size_t)FF * D, 0)
        TI(P.in[I_WGATE], P.in[I_NPLE], D, D, wgate, 0) TI(P.in[I_WGATE] + (size_t)D * D, P.in[I_NPLE] + D, D, D, wgate + (size_t)D * D, 0)
        TI(P.in[I_WPROJ], nullptr, PLE, D, wproj, 0) TI(P.in[I_WPROJ] + (size_t)PLE * D, nullptr, PLE, D, wproj + (size_t)PLE * D, 0)
        { const int n_items = (D / 64) * (320 / 32); for (; it < n_items; it += NGW) transpose_item<2>(P.in[I_WDKV], P.in[I_NKV], D, 320, wdkvq, 0, scr, it, lane); it -= n_items; }
        TI(P.in[I_WDQ], P.in[I_NMIX] + D, D, QR, wdkvq, 320)
        { const int n_items = (QR / 64) * (NH * QH / 32); for (; it < n_items; it += NGW) transpose_item<1>(P.in[I_WUQ], P.in[I_QN], QR, NH * QH, wuq, 0, scr, it, lane); it -= n_items; }
        TI(P.in[I_WUK], P.in[I_KVN], KVR, 1024, wukt, 0) TI(P.in[I_WUV], P.in[I_KVN], KVR, 1024, wuvt, 0) TI(P.in[I_WUV], nullptr, KVR, 1024, (bf16_t*)(ws + WS_WUVP), 0)
        TI(P.in[I_WO], nullptr, D, D, wo, 0)
#undef TI
        for (int i = gtid; i < 64 * D / 8; i += NGT) *(u32x4*)(wdkvq + (size_t)704 * D + (size_t)i * 8) = (u32x4){0u, 0u, 0u, 0u};
        for (int i = gtid; i < 256 * 1024 / 8; i += NGT) { const f32x4 a = *(const f32x4*)(P.in[I_WUK] + (size_t)i * 8), c = *(const f32x4*)(P.in[I_WUK] + (size_t)i * 8 + 4); *(bf16x8*)(wukb + (size_t)i * 8) = pack8v(a, c); }
        for (int i = gtid; i < NPOS * 32; i += NGT) { const int pos = i >> 5, f = i & 31; const double inv = exp2(-(double)f * (13.287712379549449 / 32.0)); const double ang = (double)pos * inv;
            double sn, cn; sincos(ang, &sn, &cn); cs[(size_t)pos * 64 + f] = (float)cn; cs[(size_t)pos * 64 + 32 + f] = (float)sn; }
        for (int i = gtid; i < 2 * M * PLE / 8; i += NGT) { const int li = i / (M * PLE / 8), r8 = i % (M * PLE / 8); const size_t e = (size_t)r8 * 8; const int row = (int)(e / PLE), c = (int)(e % PLE);
            const float* src = row < MP ? P.in[I_PP] + ((size_t)li * MP + row) * PLE + c : P.in[I_PS] + ((size_t)li * MS + (row - MP)) * PLE + c;
            *(bf16x8*)(pb + ((size_t)li * M + row) * PLE + c) = pack8v(*(const f32x4*)src, *(const f32x4*)(src + 4)); }
        for (int row0 = gw; row0 < M; row0 += 2 * NGW) {
            f32x4 v[2][4];
#pragma unroll
            for (int rr = 0; rr < 2; ++rr) { const int row = row0 + rr * NGW; if (row < M) { const float* xr = row < MP ? P.in[I_XP] + (size_t)row * D : P.in[I_XS] + (size_t)(row - MP) * D;
#pragma unroll
                for (int j = 0; j < 4; ++j) v[rr][j] = ((const f32x4*)xr)[lane + 64 * j]; } }
#pragma unroll
            for (int rr = 0; rr < 2; ++rr) { const int row = row0 + rr * NGW; if (row < M) {
                float s = 0.f;
#pragma unroll
                for (int j = 0; j < 4; ++j) s += (v[rr][j].x * v[rr][j].x + v[rr][j].y * v[rr][j].y) + (v[rr][j].z * v[rr][j].z + v[rr][j].w * v[rr][j].w);
                const float rstd = 1.0f / sqrtf(wave_sum(s) * (1.0f / D) + EPS);
                if (lane == 0) rstd0[row] = rstd;
                float* po = nullptr;
                if (row < MP) { const int b = row >> 13, t = row & (SEQ - 1); if (t >= SEQ - 15) po = out + O_PP + ((size_t)b * 15 + (t - (SEQ - 15))) * D; }
                else { const int rs_ = row - MP, b = rs_ >> 3, t = rs_ & 7; po = out + O_PS + ((size_t)b * 15 + 7 + t) * D; }
                if (po) {
#pragma unroll
                    for (int j = 0; j < 4; ++j) { const f32x4 gn = ((const f32x4*)P.in[I_NMIX])[lane + 64 * j]; ((f32x4*)po)[lane + 64 * j] = v[rr][j] * rstd * gn; } }
            } }
        }
        for (int i = gtid; i < DB * 7 * D / 4; i += NGT) { const int b = i / (7 * D / 4), r = (i / (D / 4)) % 7, c = i % (D / 4);
            ((f32x4*)(out + O_PS + ((size_t)b * 15 + r) * D))[c] = ((const f32x4*)(P.in[I_SPOOL] + ((size_t)b * 15 + 8 + r) * D))[c]; }
    }
    SEAM2(0, 2);
    if (IN(2)) {
#ifndef SUBM
#define SUBM 7
#endif
        { SgH<0> E{P.in[I_XS], P.in[I_POOLSC], nullptr, nullptr, nullptr, hbA, ssq + 0 * SSQ_V};
          for (int u = vcu; u < 256; u += G) {
              const int mt = u >> 4, gq = (u & 15) >> 2, w = 2 << gq, col = 256 * gq + 4 * lane, bs = mt * 8 + wave;
              const float* sp = P.in[I_SPOOL] + (size_t)bs * 15 * D; const float* xs0 = P.in[I_XS] + (size_t)(bs * DS) * D;
              const float rv = (lane < DS) ? rstd0[MP + bs * DS + lane] : 0.f;
              const f32x4 gn = *(const f32x4*)(P.in[I_NMIX] + col);
#pragma unroll
              for (int t = 0; t < DS; ++t) {
                  const f32x4 u0 = *(const f32x4*)(xs0 + (size_t)t * D + col) * __shfl(rv, t); f32x4 sum = u0, hist = {0.f, 0.f, 0.f, 0.f};
#pragma unroll
                  for (int i = 1; i < 16; ++i) if (i < w) { const int tt = t - i;
                      if (tt >= 0) sum += *(const f32x4*)(xs0 + (size_t)tt * D + col) * __shfl(rv, tt >= 0 ? tt : 0);
                      else hist += *(const f32x4*)(sp + (size_t)(15 + tt) * D + col); }
                  const f32x4 dd = (sum * gn + hist) / (float)w - u0 * gn;
                  u32x2 o; o.x = pk2(dd.x, dd.y); o.y = pk2(dd.z, dd.w);
                  *(u32x2*)(dbuf + (size_t)(MP + bs * DS + t) * D + col) = o;
              }
              asm volatile("s_waitcnt vmcnt(0)" ::: "memory"); __syncthreads();
              sg_gemm<4, 1>(lds, dbuf + (size_t)MP * D, D, 256, wpool, 256, u, E, tid, wave, lane); } }
        { SgBf E{proj, D};
          for (int u = vcu; u < 256; u += G) sg_gemm<4, 1>(lds, pb + (size_t)MP * PLE, PLE, 0, wproj, PLE, u, E, tid, wave, lane); }
        { SgBf E{proj + (size_t)M * D, D};
          for (int u = vcu; u < 256; u += G) sg_gemm<4, 1>(lds, pb + (size_t)(M + MP) * PLE, PLE, 0, wproj + (size_t)PLE * D, PLE, u, E, tid, wave, lane); }
        if (SUBM & 1) { pg8::Gemm g{dbuf, wpool, MP, D, 256, D, 256}; pg8::StaticOrder S; S.init(MP, D, G, bx);
          {
            pg8::Unit uu;
            for (int i = 0; S.next(i, uu); ++i) {
#pragma unroll 1
                for (int cc = 0; cc < 2; ++cc) {
                    const int row0 = uu.pm * 256 + (2 * wave + cc) * 16, t0 = row0 & (SEQ - 1), col = 256 * uu.pn + 4 * lane;
                    const float rv = (lane < 31 && t0 - 15 + lane >= 0) ? rstd0[row0 - 15 + lane] : 0.f;
                    const int rvb = __builtin_bit_cast(int, rv);
                    const float* xr = P.in[I_XP] + (size_t)row0 * D; bf16_t* dr = dbuf + (size_t)row0 * D; const f32x4 gn = *(const f32x4*)(P.in[I_NMIX] + col);
                    if (uu.pn == 0) pool_chunk<2>(xr, rvb, gn, col, t0, dr); else if (uu.pn == 1) pool_chunk<4>(xr, rvb, gn, col, t0, dr);
                    else if (uu.pn == 2) pool_chunk<8>(xr, rvb, gn, col, t0, dr); else pool_chunk<16>(xr, rvb, gn, col, t0, dr);
                } }
            asm volatile("s_waitcnt vmcnt(0)" ::: "memory"); __syncthreads(); }
          EpiH<0> E{P.in[I_XP], P.in[I_XS], P.in[I_POOLSC], nullptr, nullptr, nullptr, hbA, ssq + 0 * SSQ_V};
          pg8::gemm_phase(lds, g, S, E); }
        if (SUBM & 2) { pg8::Gemm g{pb, wproj, MP, D, PLE, PLE, 0}; pg8::StaticOrder S; S.init(MP, D, G, bx);
          EpiBf E{proj, D};
          pg8::gemm_phase(lds, g, S, E); }
        if (SUBM & 4) { pg8::Gemm g{pb + (size_t)M * PLE, wproj + (size_t)PLE * D, MP, D, PLE, PLE, 0}; pg8::StaticOrder S; S.init(MP, D, G, bx);
          EpiBf E{proj + (size_t)M * D, D};
          pg8::gemm_phase(lds, g, S, E); }
    }
    SEAM(2);
    if (IN(3)) {
        { SgUp E{ssq + 0 * SSQ_V, abuf}; for (int u = vcu; u < 256; u += G) sg_gemm<4, 4>(lds, hbA + (size_t)MP * D, D, 0, wup, D, u, E, tid, wave, lane); }
        pg8::Gemm g{hbA, wup, MP, FF, D, D, 0}; pg8::StaticOrder S; S.init(MP, FF, G, bx); EpiUp E{ssq + 0 * SSQ_V, abuf}; pg8::gemm_phase(lds, g, S, E); }
    SEAM(3);
    if (IN(4)) {
        { SgH<1> E{nullptr, nullptr, nullptr, nullptr, hbA, hbB, ssq + 1 * SSQ_V}; for (int u = vcu; u < 256; u += G) sg_gemm<4, 1>(lds, abuf + (size_t)MP * FF, FF, 0, wdown, FF, u, E, tid, wave, lane); }
        pg8::Gemm g{abuf, wdown, MP, D, FF, FF, 0}; pg8::StaticOrder S; S.init(MP, D, G, bx);
        EpiH<1> E{nullptr, nullptr, nullptr, nullptr, nullptr, hbA, hbB, ssq + 1 * SSQ_V}; pg8::gemm_phase(lds, g, S, E); }
    SEAM(4);
    if (IN(5)) {
        { SgH<2> E{nullptr, nullptr, ssq + 1 * SSQ_V, proj, hbB, hbA, ssq + 2 * SSQ_V}; for (int u = vcu; u < 256; u += G) sg_gemm<4, 1>(lds, hbB + (size_t)MP * D, D, 0, wgate, D, u, E, tid, wave, lane); }
        pg8::Gemm g{hbB, wgate, MP, D, D, D, 0}; pg8::StaticOrder S; S.init(MP, D, G, bx);
        EpiH<2> E{nullptr, nullptr, nullptr, ssq + 1 * SSQ_V, proj, hbB, hbA, ssq + 2 * SSQ_V}; pg8::gemm_phase(lds, g, S, E); }
    SEAM(5);
    if (IN(6)) {
        pg8::Gemm g{hbA, wdkvq, M, NDKVQ, D, D, 0}; pg8::StaticOrder S; S.init(M, NDKVQ, G, bx); EpiDkvq E{ssq + 2 * SSQ_V, cs, craw, cb, cqb, ssqc, ssqq, out, kfull, krbs}; pg8::gemm_phase(lds, g, S, E); }
    SEAM2(6, 8);
    if (IN(8)) {
        if (SUBM & 1) { pg8::Gemm g{cqb, wuq, M, NH * QH, QR, QR, 0}; pg8::StaticOrder S; S.init(M, NH * QH, G, bx); EpiQ E{ssqq, cs, qbuf, qs}; pg8::gemm_phase(lds, g, S, E); }
        if (SUBM & 2) { pg8::Gemm g{cb, wukt, MP, 1024, KVR, KVR, 0}; pg8::StaticOrder S; S.init(MP, 1024, G, (bx + 128) % G); EpiKup E{kfull, ssqc}; pg8::gemm_phase(lds, g, S, E); }
        if (SUBM & 4) { pg8::Gemm g{wuvt, cb, 1024, MP, KVR, KVR, 0}; pg8::StaticOrder S; S.init(1024, MP, G, (bx + 128) % G); EpiVup E{vt, ssqc}; pg8::gemm_phase(lds, g, S, E); }
        { const f32x4 kvn = ((const f32x4*)P.in[I_KVN])[lane];
          for (int row0 = 2 * gw; row0 < M; row0 += 2 * NGW) {
              f32x4 c4[2], p4[2];
#pragma unroll
              for (int e = 0; e < 2; ++e) { c4[e] = ((const f32x4*)(craw + (size_t)(row0 + e) * KVR))[lane]; p4[e] = *(const f32x4*)(ssqc + (size_t)(row0 + e) * 4); }
#pragma unroll
              for (int e = 0; e < 2; ++e) { const int row = row0 + e; const bool isp = row < MP;
                  const float rc = 1.0f / sqrtf(((p4[e].x + p4[e].y) + (p4[e].z + p4[e].w)) * (1.0f / KVR) + EPS);
                  const f32x4 cn = c4[e] * rc * kvn;
                  float* lo_ = isp ? out + O_LP + (size_t)row * KVR : out + O_LS + (size_t)(row - MP) * KVR;
                  ((f32x4*)lo_)[lane] = cn;
                  if (!isp) { u32x2 o; o.x = pk2(cn.x, cn.y); o.y = pk2(cn.z, cn.w); ((u32x2*)(cb + (size_t)row * KVR))[lane] = o; } } } }
    }
    SEAM2(8, 10);
    if (IN(10)) {
        const bool sfirst = (bx >> 3) & 1;
        if (sfirst) for (int it = vcu; it < 2 * DB; it += G) sattn_item(P, it >> 1, it & 1, lds, tid, wave, lane);
        for (int u = vcu; u < 256; u += G) {
            const int bh = u >> 4, p = u & 15;
            attn_prompt_unit(qbuf, kfull, vt, obuf, bh >> 3, bh & 7, 31 - p, lds, tid, wave, lane);
            attn_prompt_unit(qbuf, kfull, vt, obuf, bh >> 3, bh & 7, p, lds, tid, wave, lane);
        }
        if (!sfirst) for (int it = vcu; it < 2 * DB; it += G) sattn_item(P, it >> 1, it & 1, lds, tid, wave, lane);
    }
    SEAM2(10, 12);
    if (IN(12)) {
        { SgH<1> E{nullptr, nullptr, nullptr, nullptr, hbA, hbB, ssq + 3 * SSQ_V}; const SgALoadComb AL{(const float*)(ws + WS_PART), (const float*)(ws + WS_ML)};
          for (int u = vcu; u < 256; u += G) sg_gemm_l<4, 1>(lds, AL, 0, wo, D, u, E, tid, wave, lane); }
        pg8::Gemm g{obuf, wo, MP, D, D, D, 0}; pg8::StaticOrder S; S.init(MP, D, G, bx);
        EpiH<1> E{nullptr, nullptr, nullptr, nullptr, nullptr, hbA, hbB, ssq + 3 * SSQ_V}; pg8::gemm_phase(lds, g, S, E); }
    SEAM(12);
    if (IN(13)) {
        { SgUp E{ssq + 3 * SSQ_V, abuf}; for (int u = vcu; u < 256; u += G) sg_gemm<4, 4>(lds, hbB + (size_t)MP * D, D, 0, wup + (size_t)FF * D, D, u, E, tid, wave, lane); }
        pg8::Gemm g{hbB, wup + (size_t)FF * D, MP, FF, D, D, 0}; pg8::StaticOrder S; S.init(MP, FF, G, bx); EpiUp E{ssq + 3 * SSQ_V, abuf}; pg8::gemm_phase(lds, g, S, E); }
    SEAM(13);
    if (IN(14)) {
        { SgH<1> E{nullptr, nullptr, nullptr, nullptr, hbB, hbA, ssq + 4 * SSQ_V}; for (int u = vcu; u < 256; u += G) sg_gemm<4, 1>(lds, abuf + (size_t)MP * FF, FF, 0, wdown + (size_t)FF * D, FF, u, E, tid, wave, lane); }
        pg8::Gemm g{abuf, wdown + (size_t)FF * D, MP, D, FF, FF, 0}; pg8::StaticOrder S; S.init(MP, D, G, bx);
        EpiH<1> E{nullptr, nullptr, nullptr, nullptr, nullptr, hbB, hbA, ssq + 4 * SSQ_V}; pg8::gemm_phase(lds, g, S, E); }
    SEAM(14);
    if (IN(15)) {
        { SgH<2> E{nullptr, nullptr, ssq + 4 * SSQ_V, proj + (size_t)M * D, hbA, hbB, ssq + 5 * SSQ_V}; for (int u = vcu; u < 256; u += G) sg_gemm<4, 1>(lds, hbA + (size_t)MP * D, D, 0, wgate + (size_t)D * D, D, u, E, tid, wave, lane); }
        pg8::Gemm g{hbA, wgate + (size_t)D * D, MP, D, D, D, 0}; pg8::StaticOrder S; S.init(MP, D, G, bx);
        EpiH<2> E{nullptr, nullptr, nullptr, ssq + 4 * SSQ_V, proj + (size_t)M * D, hbA, hbB, ssq + 5 * SSQ_V}; pg8::gemm_phase(lds, g, S, E); }
    SEAM(15);
    if (IN(16)) {
        f32x4 gn[4];
#pragma unroll
        for (int j = 0; j < 4; ++j) gn[j] = ((const f32x4*)P.in[I_NFIN])[lane + 64 * j];
        for (int row0 = 4 * gw; row0 < M; row0 += 4 * NGW) {
            u32x2 hv[4][4]; float sp[4];
#pragma unroll
            for (int e = 0; e < 4; ++e) { sp[e] = (lane < 16) ? ssq[5 * SSQ_V + (size_t)(row0 + e) * 16 + lane] : 0.f;
#pragma unroll
                for (int j = 0; j < 4; ++j) hv[e][j] = ((const u32x2*)(hbB + (size_t)(row0 + e) * D))[lane + 64 * j]; }
#pragma unroll
            for (int e = 0; e < 4; ++e) { const float rstd = 1.0f / sqrtf(wave_sum(sp[e]) * (1.0f / D) + EPS);
#pragma unroll
                for (int j = 0; j < 4; ++j) ((f32x4*)(out + O_Y + (size_t)(row0 + e) * D))[lane + 64 * j] = unpk4(hv[e][j]) * rstd * gn[j]; }
        }
    }
#undef IN
#undef SEAM
#undef SEAM2
#undef wpool
#undef wup
#undef wdown
#undef wgate
#undef wproj
#undef wdkvq
#undef wuq
#undef wukt
#undef wuvt
#undef wukb
#undef wo
#undef cs
#undef rstd0
#undef dbuf
#undef pb
#undef hbA
#undef hbB
#undef ssq
#undef abuf
#undef proj
#undef craw
#undef ssqc
#undef ssqq
#undef cb
#undef krbs
#undef cqb
#undef qbuf
#undef qs
#undef kfull
#undef vt
#undef obuf
}

extern "C" void kernel_launch(void* const* d_in, const int* in_sizes, int n_in, void* d_out, int out_size, void* d_ws, size_t ws_size, hipStream_t stream) {
    static int grid = 0;
    if (grid == 0) {
        if (n_in != 27 || (size_t)out_size != O_END || ws_size < WS_END) { fprintf(stderr, "kernel_launch: shape mismatch (n_in %d, out %d, ws %zu; need 27, %zu, %zu)\n", n_in, out_size, ws_size, (size_t)O_END, (size_t)WS_END); grid = -1; return; }
        int dev = 0, cus = 0, per_cu = 0;
        if (hipGetDevice(&dev) != hipSuccess || hipDeviceGetAttribute(&cus, hipDeviceAttributeMultiprocessorCount, dev) != hipSuccess) { grid = -1; return; }
        if (hipFuncSetAttribute((const void*)yoco_fwd, hipFuncAttributeMaxDynamicSharedMemorySize, LDS_BYTES) != hipSuccess) { fprintf(stderr, "kernel_launch: hipFuncSetAttribute failed\n"); grid = -1; return; }
        if (hipOccupancyMaxActiveBlocksPerMultiprocessor(&per_cu, (const void*)yoco_fwd, 512, LDS_BYTES) != hipSuccess || per_cu < 1) fprintf(stderr, "kernel_launch: occupancy query reports %d\n", per_cu);
        (void)hipGetLastError();
        grid = cus;
    }
    if (grid < 0) return;
    (void)hipMemsetAsync((char*)d_ws + WS_CTL, 0, CTL_BYTES, stream);
    Params p{};
    for (int i = 0; i < 27; ++i) p.in[i] = (const float*)d_in[i];
    p.out = (float*)d_out; p.ws = (unsigned char*)d_ws;
#if MK_N_LAUNCHES == 1
    p.ph_lo = 0; p.ph_hi = NPH;
    hipLaunchKernelGGL(yoco_fwd, dim3(grid), dim3(512), LDS_BYTES, stream, p);
#else
    for (int k = 0; k < NPH; ++k) { p.ph_lo = k; p.ph_hi = k + 1; hipLaunchKernelGGL(yoco_fwd, dim3(grid), dim3(512), LDS_BYTES, stream, p); }
#endif
    const hipError_t le = hipPeekAtLastError();
    if (le != hipSuccess) fprintf(stderr, "kernel_launch: launch failed: %s\n", hipGetErrorName(le));
}
```

```cpp
#include <hip/hip_runtime.h>
#include <cstdio>
#include <cstdint>

#ifndef MK_N_LAUNCHES
#define MK_N_LAUNCHES 1
#endif

#define GAS __attribute__((address_space(1)))
#define LAS __attribute__((address_space(3)))
typedef unsigned short bf16_t;
typedef short bf16x8 __attribute__((ext_vector_type(8)));
typedef float f32x4 __attribute__((ext_vector_type(4)));
typedef float f32x16 __attribute__((ext_vector_type(16)));
typedef unsigned u32x2 __attribute__((ext_vector_type(2)));
typedef unsigned u32x4 __attribute__((ext_vector_type(4)));

constexpr int D = 1024, FF = 4096, PLE = 256, SEQ = 8192, NBATCH = 2, DB = 128, DS = 8;
constexpr int MP = NBATCH * SEQ;
constexpr int MS = DB * DS;
constexpr int M = MP + MS;
constexpr int KVR = 256, ROPE = 64, QR = 384, NH = 8, NOPE = 128, VD = 128, QH = NOPE + ROPE;
constexpr int NDKVQ = 768;
constexpr int PAST = 8192, PAGE = 128, NPG = PAST / PAGE;
constexpr float EPS = 1e-6f;
constexpr float SM_SCALE = 0.07216878364870322f;
constexpr float LOG2E = 1.4426950408889634f;
constexpr float CEXP = SM_SCALE * LOG2E;
constexpr int NPOS = PAST + DS;

constexpr size_t O_Y = 0;
constexpr size_t O_PP = (size_t)M * D;
constexpr size_t O_PS = O_PP + (size_t)NBATCH * 15 * D;
constexpr size_t O_LP = O_PS + (size_t)DB * 15 * D;
constexpr size_t O_KP = O_LP + (size_t)MP * KVR;
constexpr size_t O_LS = O_KP + (size_t)MP * ROPE;
constexpr size_t O_KS = O_LS + (size_t)MS * KVR;
constexpr size_t O_END = O_KS + (size_t)MS * ROPE;

constexpr size_t al256(size_t x) { return (x + 255) / 256 * 256; }
constexpr size_t WS_CTL = 0, CTL_BYTES = 1u << 20;
constexpr size_t WS_WPOOL = CTL_BYTES;
constexpr size_t WS_WUP   = WS_WPOOL + al256((size_t)1024 * 256 * 2);
constexpr size_t WS_WDOWN = WS_WUP   + al256((size_t)2 * FF * D * 2);
constexpr size_t WS_WGATE = WS_WDOWN + al256((size_t)2 * FF * D * 2);
constexpr size_t WS_WPROJ = WS_WGATE + al256((size_t)2 * D * D * 2);
constexpr size_t WS_WDKVQ = WS_WPROJ + al256((size_t)2 * D * PLE * 2);
constexpr size_t WS_WUQ   = WS_WDKVQ + al256((size_t)NDKVQ * D * 2);
constexpr size_t WS_WUKT  = WS_WUQ   + al256((size_t)NH * QH * QR * 2);
constexpr size_t WS_WUVT  = WS_WUKT  + al256((size_t)1024 * 256 * 2);
constexpr size_t WS_WUVP  = WS_WUVT  + al256((size_t)1024 * 256 * 2);
constexpr size_t WS_WUKB  = WS_WUVP  + al256((size_t)1024 * 256 * 2);
constexpr size_t WS_WO    = WS_WUKB  + al256((size_t)1024 * 256 * 2);
constexpr size_t WS_CS    = WS_WO    + al256((size_t)D * D * 2);
constexpr size_t WS_RSTD0 = WS_CS    + al256((size_t)NPOS * 64 * 4);
constexpr size_t WS_DBUF  = WS_RSTD0 + al256((size_t)M * 4);
constexpr size_t WS_PB    = WS_DBUF  + al256((size_t)M * D * 2);
constexpr size_t WS_HBA   = WS_PB    + al256((size_t)2 * M * PLE * 2);
constexpr size_t WS_HBB   = WS_HBA   + al256((size_t)M * D * 2);
constexpr size_t WS_SSQ   = WS_HBB   + al256((size_t)M * D * 2);
constexpr size_t WS_ABUF  = WS_SSQ   + al256((size_t)6 * M * 16 * 4);
constexpr size_t WS_PROJ  = WS_ABUF  + al256((size_t)M * FF * 2);
constexpr size_t WS_RAW   = WS_PROJ  + al256((size_t)2 * M * D * 2);
constexpr size_t WS_CB    = WS_RAW   + al256((size_t)M * NDKVQ * 4);
constexpr size_t WS_KRBS  = WS_CB    + al256((size_t)M * KVR * 2);
constexpr size_t WS_CQB   = WS_KRBS  + al256((size_t)MS * ROPE * 2);
constexpr size_t WS_RSTDQ = WS_CQB   + al256((size_t)M * QR * 2);
constexpr size_t WS_QBUF  = WS_RSTDQ + al256((size_t)M * 4);
constexpr size_t WS_QS    = WS_QBUF  + al256((size_t)M * NH * QH * 2);
constexpr size_t WS_KFULL = WS_QS    + al256((size_t)MS * NH * 320 * 2);
constexpr size_t WS_VT    = WS_KFULL + al256((size_t)16 * SEQ * QH * 2);
constexpr size_t WS_OBUF  = WS_VT    + al256((size_t)16 * VD * SEQ * 2);
constexpr size_t WS_PART  = WS_OBUF  + al256((size_t)M * D * 2);
constexpr size_t WS_ML    = WS_PART  + al256((size_t)DB * 8 * 64 * 256 * 4);
constexpr size_t WS_END   = WS_ML    + al256((size_t)DB * 8 * 64 * 2 * 4);

constexpr int CW_BAR = 4096;

constexpr int RING_BYTES = 131072;
constexpr int LDS_BYTES = 147456;
constexpr int MISC_OFF = LDS_BYTES - 256;

typedef float f32x2 __attribute__((ext_vector_type(2)));
typedef __bf16 nbf16x2 __attribute__((ext_vector_type(2)));
__device__ __forceinline__ unsigned pk2(float lo, float hi) { const f32x2 v = {lo, hi}; return __builtin_bit_cast(unsigned, __builtin_convertvector(v, nbf16x2)); }
__device__ __forceinline__ unsigned f2bf(float f) { return pk2(f, 0.f) & 0xffffu; }
__device__ __forceinline__ float bf2f(unsigned short b) { return __builtin_bit_cast(float, ((unsigned)b) << 16); }
__device__ __forceinline__ f32x4 unpk4(u32x2 w) { f32x4 r; r.x = __builtin_bit_cast(float, w.x << 16); r.y = __builtin_bit_cast(float, w.x & 0xffff0000u); r.z = __builtin_bit_cast(float, w.y << 16); r.w = __builtin_bit_cast(float, w.y & 0xffff0000u); return r; }
__device__ __forceinline__ bf16x8 pack8(const float* v) { u32x4 w; w.x = pk2(v[0], v[1]); w.y = pk2(v[2], v[3]); w.z = pk2(v[4], v[5]); w.w = pk2(v[6], v[7]); return __builtin_bit_cast(bf16x8, w); }
__device__ __forceinline__ bf16x8 pack8v(f32x4 a, f32x4 b) { u32x4 w; w.x = pk2(a.x, a.y); w.y = pk2(a.z, a.w); w.z = pk2(b.x, b.y); w.w = pk2(b.z, b.w); return __builtin_bit_cast(bf16x8, w); }
__device__ __forceinline__ float wave_sum(float v) {
#pragma unroll
    for (int o = 1; o < 64; o <<= 1) v += __shfl_xor(v, o);
    return v;
}
__device__ __forceinline__ int crow(int r, int hi) { return (r & 3) + 8 * (r >> 2) + 4 * hi; }
#define LDS_WAIT() asm volatile("s_waitcnt lgkmcnt(0)" ::: "memory")
#define VM_WAIT() asm volatile("s_waitcnt vmcnt(0)" ::: "memory")

#define XB_TMO      128
#define XB_XCNT(j)  (256  + 64 * (j))
#define XB_XSUB(j)  (1280 + 64 * (j))
#define XB_XGEN(j)  (2304 + 64 * (j))
#define XB_TOP      3328
#define XB_TOPGEN   3392
#define XCD_BAR_WORDS 3456
#define XB_SPIN_CAP (1u << 18)
__device__ __forceinline__ unsigned xb_ld(unsigned* p)              { return __hip_atomic_load(p, __ATOMIC_RELAXED, __HIP_MEMORY_SCOPE_AGENT); }
__device__ __forceinline__ unsigned xb_add(unsigned* p, unsigned v) { return __hip_atomic_fetch_add(p, v, __ATOMIC_RELAXED, __HIP_MEMORY_SCOPE_AGENT); }
__device__ __forceinline__ unsigned xb_xcc_id() { return (unsigned)__builtin_amdgcn_s_getreg((3 << 11) | 20) & 0xFu; }
#define XB_SPIN(cond, bar) do { unsigned _sp = 0; while (cond) { __builtin_amdgcn_s_sleep(1); \
    if ((++_sp & 255u) == 0u) { if (xb_ld(&(bar)[XB_TMO])) break; if (_sp > XB_SPIN_CAP) { atomicAdd(&(bar)[XB_TMO], 1u); break; } } } } while (0)
struct XcdBarrier { unsigned* bar; unsigned x; volatile LAS unsigned* st; };
__device__ __forceinline__ XcdBarrier xcd_barrier_post(unsigned* bar, volatile LAS unsigned* st) {
    XcdBarrier b; b.bar = bar; b.x = xb_xcc_id(); b.st = st;
    if (threadIdx.x == 0) (void)xb_add(&bar[XB_XCNT(b.x)], 1u);
    return b;
}
__device__ __forceinline__ void xcd_barrier_complete(unsigned* bar, unsigned x, unsigned& nloc, unsigned& nx) {
    const unsigned G = gridDim.x * gridDim.y * gridDim.z;
    unsigned sum, cnt, mine, sp = 0u;
    for (;;) {
        sum = 0u; cnt = 0u; mine = 0u;
#pragma unroll
        for (unsigned j = 0; j < 16; ++j) { const unsigned c = xb_ld(&bar[XB_XCNT(j)]); sum += c; cnt += (c > 0u) ? 1u : 0u; mine = (j == x) ? c : mine; }
        if (sum == G) break;
        __builtin_amdgcn_s_sleep(1);
        if ((++sp & 255u) == 0u) { if (xb_ld(&bar[XB_TMO])) break; if (sp > XB_SPIN_CAP) { atomicAdd(&bar[XB_TMO], 1u); break; } }
    }
    nloc = mine > 0u ? mine : 1u; nx = cnt > 0u ? cnt : 1u;
}
__device__ __forceinline__ void xcd_barrier(const XcdBarrier& b) {
    asm volatile("s_waitcnt vmcnt(0)" ::: "memory");
    __syncthreads();
    if (threadIdx.x == 0) {
        unsigned* bar = b.bar;
        __builtin_amdgcn_s_waitcnt(0);
        unsigned nloc = b.st[0], nx = b.st[1];
        if (nloc == 0u) { xcd_barrier_complete(bar, b.x, nloc, nx); b.st[0] = nloc; b.st[1] = nx; }
        const unsigned old = xb_add(&bar[XB_XSUB(b.x)], 1u);
        const unsigned gen = old / nloc;
        if (old + 1u == (gen + 1u) * nloc) {
            __builtin_amdgcn_fence(__ATOMIC_RELEASE, "agent");
            asm volatile("s_waitcnt vmcnt(0)" ::: "memory");
            const unsigned og = xb_add(&bar[XB_TOP], 1u);
            const unsigned tg = og / nx;
            if (og + 1u == (tg + 1u) * nx) xb_add(&bar[XB_TOPGEN], 1u);
            else XB_SPIN(xb_ld(&bar[XB_TOPGEN]) == tg, bar);
            __builtin_amdgcn_fence(__ATOMIC_ACQUIRE, "agent");
            xb_add(&bar[XB_XGEN(b.x)], 1u);
            asm volatile("s_waitcnt vmcnt(0)" ::: "memory");
        } else {
            XB_SPIN(xb_ld(&bar[XB_XGEN(b.x)]) == gen, bar);
            __builtin_amdgcn_fence(__ATOMIC_ACQUIRE, "agent");
            asm volatile("s_waitcnt vmcnt(0)" ::: "memory");
        }
    }
    __syncthreads();
}

namespace pg8 {
constexpr int BM = 256, BK = 64, HALF = 128, HTB = HALF * BK * 2, STAGE_BYTES = 8 * HTB, NXCD = 8, WGM = 8;
__host__ __device__ __forceinline__ int lds_byte(int r, int c) { const int st = (r >> 4) * 2 + (c >> 5), rr = r & 15, cc = c & 31, ob = rr * 64 + cc * 2; return st * 1024 + (ob ^ (((ob >> 9) & 1) << 5)); }
__host__ __device__ __forceinline__ int perm32(int rho) { const int n = rho >> 4, i = rho & 15; return 8 * (i >> 2) + 4 * n + (i & 3); }
__host__ __device__ __forceinline__ void stage_rc(int b, int& R, int& C) { const int st = b / 1024, sb = b % 1024, swz = sb ^ (((sb >> 9) & 1) << 5); R = (st >> 1) * 16 + swz / 64; C = (st & 1) * 32 + (swz % 64) / 2; }
struct Unit { int pm, pn; };
struct Gemm { const bf16_t* A; const bf16_t* Bt; int M, N, K, lda, apn; };
struct StaticOrder {
    int nM, nN, nwg, G, c;
    __device__ __forceinline__ void init(int M, int N, int G_, int c_) { nM = M / BM; nN = N / BM; nwg = nM * nN; G = G_; c = c_; }
    __device__ __forceinline__ bool next(int i, Unit& u) const {
        const long L = (long)i * G + c; if (L >= nwg) return false;
        int wgid = (int)L; { const int q = nwg / NXCD, r = nwg % NXCD, xcd = wgid % NXCD, off = wgid / NXCD; wgid = (xcd < r ? xcd * (q + 1) : r * (q + 1) + (xcd - r) * q) + off; }
        const int nig = WGM * nN, gid = wgid / nig, fm = gid * WGM, gsz = (nM - fm) < WGM ? (nM - fm) : WGM;
        u.pm = fm + ((wgid % nig) % gsz); u.pn = (wgid % nig) / gsz; return true;
    }
};
template <class Epi>
__device__ __forceinline__ void gemm_phase(LAS unsigned char* lds, const Gemm g, const StaticOrder& S, const Epi& E) {
    const int tid = threadIdx.x, wid = __builtin_amdgcn_readfirstlane(tid >> 6), lane = tid & 63, wr = wid >> 2, wc = wid & 3, fr = lane & 15, fq = lane >> 4;
    const int K = g.K, nt = K / BK, lda = g.lda;
    unsigned voffA[2], voffB[2];
#pragma unroll
    for (int i = 0; i < 2; ++i) { int R, C; stage_rc(tid * 16 + i * 8192, R, C);
        const int Rb = Epi::PERM ? ((R & ~31) + perm32(R & 31)) : R;
        voffA[i] = (unsigned)(R * lda + C) * 2u; voffB[i] = (unsigned)(Rb * K + C) * 2u; }
    const size_t kstep = (size_t)(BK * 2);
    const size_t hstepA = (size_t)HALF * lda * 2, hstepB = (size_t)HALF * K * 2;
    const size_t tstepA = 2 * hstepA, tstepB = 2 * hstepB, pnA = (size_t)g.apn * 2;
    const unsigned ldsw = (unsigned)wid * 1024u;
    const int aoff = lds_byte(wr * 64 + fr, fq * 8), boff = lds_byte(wc * 32 + fr, fq * 8);
#define PG8_SA(b, h) (((b) * 2 + (h)) * HTB)
#define PG8_SB(b, h) ((4 + (b) * 2 + (h)) * HTB)
#define PG8_STAGE(bufoff, gbase, voff) do { _Pragma("unroll") for (int _i = 0; _i < 2; ++_i) \
        __builtin_amdgcn_global_load_lds((const unsigned*)((const char*)(gbase) + (voff)[_i]), (LAS unsigned*)(lds + (bufoff) + ldsw + _i * 8192), 16, 0, 0); } while (0)
#define PG8_LDA(dst, b, h) do { _Pragma("unroll") for (int m = 0; m < 4; ++m) _Pragma("unroll") for (int k = 0; k < 2; ++k) dst[m][k] = *(const LAS bf16x8*)(lds + PG8_SA(b, h) + aoff + m * 2048 + k * 1024); } while (0)
#define PG8_LDB(dst, b, h) do { _Pragma("unroll") for (int n = 0; n < 2; ++n) _Pragma("unroll") for (int k = 0; k < 2; ++k) dst[n][k] = *(const LAS bf16x8*)(lds + PG8_SB(b, h) + boff + n * 2048 + k * 1024); } while (0)
#define PG8_MMA(ai, bj, At, Bt) do { __builtin_amdgcn_s_setprio(1); _Pragma("unroll") for (int m = 0; m < 4; ++m) _Pragma("unroll") for (int n = 0; n < 2; ++n) _Pragma("unroll") for (int k = 0; k < 2; ++k) \
        acc[ai][bj][m][n] = __builtin_amdgcn_mfma_f32_16x16x32_bf16(Bt[n][k], At[m][k], acc[ai][bj][m][n], 0, 0, 0); __builtin_amdgcn_s_setprio(0); } while (0)
#define PG8_WAIT_V(n) asm volatile("s_waitcnt vmcnt(" #n ")" ::: "memory")
#define PG8_WAIT_L(n) asm volatile("s_waitcnt lgkmcnt(" #n ")" ::: "memory")
#define PG8_BAR __builtin_amdgcn_s_barrier()
#define PG8_SCHED __builtin_amdgcn_sched_barrier(0)
    Unit cur, nxt; int ui = 0;
    if (!S.next(0, cur)) return;
    f32x4 acc[2][2][4][2];
#pragma unroll
    for (int a = 0; a < 2; ++a)
#pragma unroll
        for (int b = 0; b < 2; ++b)
#pragma unroll
            for (int m = 0; m < 4; ++m)
#pragma unroll
                for (int n = 0; n < 2; ++n) acc[a][b][m][n] = (f32x4){0.f, 0.f, 0.f, 0.f};
    bf16x8 At[4][2], B0[2][2], B1[2][2];
    const char* cA = (const char*)g.A + (size_t)cur.pm * tstepA + (size_t)cur.pn * pnA; const char* cB = (const char*)g.Bt + (size_t)cur.pn * tstepB;
    PG8_STAGE(PG8_SB(0, 0), cB, voffB); PG8_STAGE(PG8_SB(0, 1), cB + hstepB, voffB); PG8_STAGE(PG8_SA(0, 0), cA, voffA); PG8_STAGE(PG8_SA(0, 1), cA + hstepA, voffA);
    if (wr == 1) PG8_BAR;
    PG8_WAIT_V(2); PG8_BAR;
    PG8_STAGE(PG8_SB(1, 0), cB + kstep, voffB); PG8_STAGE(PG8_SA(1, 0), cA + kstep, voffA); PG8_STAGE(PG8_SB(1, 1), cB + hstepB + kstep, voffB);
    PG8_WAIT_V(6); PG8_BAR;
    for (;;) {
        const bool has_next = S.next(ui + 1, nxt);
        const char* nA = has_next ? (const char*)g.A + (size_t)nxt.pm * tstepA + (size_t)nxt.pn * pnA : cA; const char* nB = has_next ? (const char*)g.Bt + (size_t)nxt.pn * tstepB : cB;
#pragma unroll 1
        for (int t = 0; t < nt; t += 2) {
            const bool last = (t == nt - 2);
            const char* a1 = cA + (size_t)(t + 1) * kstep;
            const char* a2 = last ? nA : cA + (size_t)(t + 2) * kstep; const char* b2 = last ? nB : cB + (size_t)(t + 2) * kstep;
            const char* a3 = a2 + kstep; const char* b3 = b2 + kstep;
            PG8_LDB(B0, 0, 0); PG8_LDB(B1, 0, 1); PG8_SCHED; PG8_LDA(At, 0, 0); PG8_STAGE(PG8_SA(1, 1), a1 + hstepA, voffA);
            PG8_WAIT_V(8); PG8_WAIT_L(0); PG8_BAR; PG8_MMA(0, 0, At, B0); PG8_MMA(0, 1, At, B1); PG8_BAR; PG8_SCHED;
            PG8_LDA(At, 0, 1); PG8_STAGE(PG8_SB(0, 0), b2, voffB); PG8_STAGE(PG8_SB(0, 1), b2 + hstepB, voffB); PG8_STAGE(PG8_SA(0, 0), a2, voffA);
            PG8_WAIT_V(8); PG8_WAIT_L(0); PG8_BAR; PG8_MMA(1, 0, At, B0); PG8_MMA(1, 1, At, B1); PG8_BAR; PG8_SCHED;
            PG8_LDB(B0, 1, 0); PG8_LDB(B1, 1, 1); PG8_SCHED; PG8_LDA(At, 1, 0); PG8_STAGE(PG8_SA(0, 1), a2 + hstepA, voffA);
            PG8_WAIT_V(8); PG8_WAIT_L(0); PG8_BAR; PG8_MMA(0, 0, At, B0); PG8_MMA(0, 1, At, B1); PG8_BAR; PG8_SCHED;
            PG8_LDA(At, 1, 1); PG8_STAGE(PG8_SB(1, 0), b3, voffB); PG8_STAGE(PG8_SB(1, 1), b3 + hstepB, voffB); PG8_STAGE(PG8_SA(1, 0), a3, voffA);
            PG8_WAIT_V(8); PG8_WAIT_L(0); PG8_BAR; PG8_MMA(1, 0, At, B0); PG8_MMA(1, 1, At, B1); PG8_BAR; PG8_SCHED;
        }
        if (wr == 0) PG8_BAR;
        E(acc, cur, wr, wc, fr, fq);
        if (!has_next) break;
#pragma unroll
        for (int a = 0; a < 2; ++a)
#pragma unroll
            for (int b = 0; b < 2; ++b)
#pragma unroll
                for (int m = 0; m < 4; ++m)
#pragma unroll
                    for (int n = 0; n < 2; ++n) acc[a][b][m][n] = (f32x4){0.f, 0.f, 0.f, 0.f};
        cur = nxt; cA = nA; cB = nB; ++ui;
        if (wr == 1) PG8_BAR;
    }
    PG8_WAIT_V(0);
    PG8_BAR;
#undef PG8_SA
#undef PG8_SB
#undef PG8_STAGE
#undef PG8_LDA
#undef PG8_LDB
#undef PG8_MMA
#undef PG8_WAIT_V
#undef PG8_WAIT_L
#undef PG8_BAR
#undef PG8_SCHED
}
}

struct Params { const float* in[27]; float* out; unsigned char* ws; int ph_lo, ph_hi; };
enum { I_XP = 0, I_XS, I_PP, I_PS, I_SPOOL, I_CLAT, I_CKR, I_PT, I_NMIX, I_NMLP, I_NPLE, I_POOLW, I_POOLSC, I_NKV, I_WDKV, I_KVN, I_WUK, I_WUV, I_WDQ, I_QN, I_WUQ, I_WO, I_WUP, I_WDOWN, I_WGATE, I_WPROJ, I_NFIN };

__device__ __forceinline__ void load_rstd(const float* ssq, const pg8::Unit& u, int wr, int fr, int fq, float (&rs)[2][4]) {
#pragma unroll
    for (int ai = 0; ai < 2; ++ai)
#pragma unroll
        for (int m = 0; m < 4; ++m) {
            const int row = u.pm * 256 + ai * 128 + wr * 64 + m * 16 + fr;
            const f32x4 a = ((const f32x4*)(ssq + (size_t)row * 16))[fq];
            float t = (a.x + a.y) + (a.z + a.w);
            t += __shfl_xor(t, 16); t += __shfl_xor(t, 32);
            rs[ai][m] = 1.0f / sqrtf(t * (1.0f / 1024.0f) + EPS);
        }
}
template <int NS> __device__ __forceinline__ void load_rstd_p(const float* ssqp, float inv_n, const pg8::Unit& u, int wr, int fr, int fq, float (&rs)[2][4]) {
#pragma unroll
    for (int ai = 0; ai < 2; ++ai)
#pragma unroll
        for (int m = 0; m < 4; ++m) {
            const int row = u.pm * 256 + ai * 128 + wr * 64 + m * 16 + fr;
            float t;
            if (NS == 4) t = ssqp[(size_t)row * 4 + fq]; else { const f32x2 a = ((const f32x2*)(ssqp + (size_t)row * 8))[fq]; t = a.x + a.y; }
            t += __shfl_xor(t, 16); t += __shfl_xor(t, 32);
            rs[ai][m] = 1.0f / sqrtf(t * inv_n + EPS);
        }
}
template <int MODE> struct EpiH {
    static constexpr bool PERM = true;
    const float* xp; const float* xs; const float* scale; const float* ssq_in; const bf16_t* proj;
    const bf16_t* hb_in; bf16_t* hb; float* ssq_out;
    __device__ __forceinline__ void operator()(const f32x4 (&acc)[2][2][4][2], const pg8::Unit& u, int wr, int wc, int fr_in, int fq_in) const {
        int fr = fr_in, fq = fq_in; asm volatile("" : "+v"(fr), "+v"(fq));
        float rs[2][4];
        if (MODE == 2) load_rstd(ssq_in, u, wr, fr, fq, rs);
        const int col0 = u.pn * 256 + wc * 32 + 8 * fq;
#pragma unroll
        for (int ai = 0; ai < 2; ++ai)
#pragma unroll
            for (int m = 0; m < 4; ++m) {
                const int row = u.pm * 256 + ai * 128 + wr * 64 + m * 16 + fr;
                float sq = 0.f;
#pragma unroll
                for (int bj = 0; bj < 2; ++bj) {
                    const int col = col0 + bj * 128;
                    f32x4 b0, b1;
                    if (MODE == 0) { const float* xr = (row < MP ? xp + (size_t)row * D : xs + (size_t)(row - MP) * D) + col; b0 = *(const f32x4*)xr; b1 = *(const f32x4*)(xr + 4); }
                    else { const u32x4 hv = *(const u32x4*)(hb_in + (size_t)row * D + col); b0 = unpk4((u32x2){hv.x, hv.y}); b1 = unpk4((u32x2){hv.z, hv.w}); }
                    const f32x4 a0 = acc[ai][bj][m][0], a1 = acc[ai][bj][m][1]; f32x4 o0, o1;
                    if (MODE == 0) { o0 = b0 + *(const f32x4*)(scale + col) * a0; o1 = b1 + *(const f32x4*)(scale + col + 4) * a1; }
                    else if (MODE == 1) { o0 = b0 + a0; o1 = b1 + a1; }
                    else { const u32x4 pv = *(const u32x4*)(proj + (size_t)row * D + col); const f32x4 p0 = unpk4((u32x2){pv.x, pv.y}), p1 = unpk4((u32x2){pv.z, pv.w}); const float r = rs[ai][m];
                        f32x4 g0, g1;
                        g0.x = 1.0f / (1.0f + __expf(-r * a0.x)); g0.y = 1.0f / (1.0f + __expf(-r * a0.y)); g0.z = 1.0f / (1.0f + __expf(-r * a0.z)); g0.w = 1.0f / (1.0f + __expf(-r * a0.w));
                        g1.x = 1.0f / (1.0f + __expf(-r * a1.x)); g1.y = 1.0f / (1.0f + __expf(-r * a1.y)); g1.z = 1.0f / (1.0f + __expf(-r * a1.z)); g1.w = 1.0f / (1.0f + __expf(-r * a1.w));
                        o0 = b0 + g0 * p0; o1 = b1 + g1 * p1; }
                    u32x4 w; w.x = pk2(o0.x, o0.y); w.y = pk2(o0.z, o0.w); w.z = pk2(o1.x, o1.y); w.w = pk2(o1.z, o1.w);
                    *(u32x4*)(hb + (size_t)row * D + col) = w;
                    sq += ((o0.x * o0.x + o0.y * o0.y) + (o0.z * o0.z + o0.w * o0.w)) + ((o1.x * o1.x + o1.y * o1.y) + (o1.z * o1.z + o1.w * o1.w));
                }
                sq += __shfl_xor(sq, 16); sq += __shfl_xor(sq, 32);
                if (fq == 0) ssq_out[(size_t)row * 16 + u.pn * 4 + wc] = sq;
                asm volatile("" ::: "memory");
            }
    }
};
struct EpiUp {
    static constexpr bool PERM = true;
    const float* ssq_in; bf16_t* abuf;
    __device__ __forceinline__ void operator()(const f32x4 (&acc)[2][2][4][2], const pg8::Unit& u, int wr, int wc, int fr_in, int fq_in) const {
        int fr = fr_in, fq = fq_in; asm volatile("" : "+v"(fr), "+v"(fq));
        float rs[2][4]; load_rstd(ssq_in, u, wr, fr, fq, rs);
        const int col0 = u.pn * 256 + wc * 32 + 8 * fq;
#pragma unroll
        for (int ai = 0; ai < 2; ++ai)
#pragma unroll
            for (int m = 0; m < 4; ++m) {
                const int row = u.pm * 256 + ai * 128 + wr * 64 + m * 16 + fr; const float r = rs[ai][m];
#pragma unroll
                for (int bj = 0; bj < 2; ++bj) {
                    f32x4 a = acc[ai][bj][m][0] * r, c = acc[ai][bj][m][1] * r;
                    a.x = fmaxf(a.x, 0.f); a.y = fmaxf(a.y, 0.f); a.z = fmaxf(a.z, 0.f); a.w = fmaxf(a.w, 0.f);
                    c.x = fmaxf(c.x, 0.f); c.y = fmaxf(c.y, 0.f); c.z = fmaxf(c.z, 0.f); c.w = fmaxf(c.w, 0.f);
                    u32x4 w; w.x = pk2(a.x * a.x, a.y * a.y); w.y = pk2(a.z * a.z, a.w * a.w); w.z = pk2(c.x * c.x, c.y * c.y); w.w = pk2(c.z * c.z, c.w * c.w);
                    *(u32x4*)(abuf + (size_t)row * FF + col0 + bj * 128) = w;
                }
            }
    }
};
template <int MODE> struct EpiF32 {
    static constexpr bool PERM = false;
    float* C; int ldc; const float* aux;
    __device__ __forceinline__ void operator()(const f32x4 (&acc)[2][2][4][2], const pg8::Unit& u, int wr, int wc, int fr_in, int fq_in) const {
        int fr = fr_in, fq = fq_in; asm volatile("" : "+v"(fr), "+v"(fq));
        float rs[2][4];
        if (MODE == 1) load_rstd(aux, u, wr, fr, fq, rs);
        const int col0 = u.pn * 256 + wc * 32 + 4 * fq;
#pragma unroll
        for (int ai = 0; ai < 2; ++ai)
#pragma unroll
            for (int m = 0; m < 4; ++m) {
                const int row = u.pm * 256 + ai * 128 + wr * 64 + m * 16 + fr;
                const float r = (MODE == 1) ? rs[ai][m] : (MODE == 2 ? aux[row] : 1.0f);
#pragma unroll
                for (int bj = 0; bj < 2; ++bj)
#pragma unroll
                    for (int n = 0; n < 2; ++n) *(f32x4*)(C + (size_t)row * ldc + col0 + bj * 128 + n * 16) = acc[ai][bj][m][n] * r;
            }
    }
};
struct EpiBf {
    static constexpr bool PERM = true;
    bf16_t* C; int ldc;
    __device__ __forceinline__ void operator()(const f32x4 (&acc)[2][2][4][2], const pg8::Unit& u, int wr, int wc, int fr_in, int fq_in) const {
        int fr = fr_in, fq = fq_in; asm volatile("" : "+v"(fr), "+v"(fq));
        const int col0 = u.pn * 256 + wc * 32 + 8 * fq;
#pragma unroll
        for (int ai = 0; ai < 2; ++ai)
#pragma unroll
            for (int m = 0; m < 4; ++m) {
                const int row = u.pm * 256 + ai * 128 + wr * 64 + m * 16 + fr;
#pragma unroll
                for (int bj = 0; bj < 2; ++bj) { const f32x4 a = acc[ai][bj][m][0], c = acc[ai][bj][m][1]; u32x4 w; w.x = pk2(a.x, a.y); w.y = pk2(a.z, a.w); w.z = pk2(c.x, c.y); w.w = pk2(c.z, c.w);
                    *(u32x4*)(C + (size_t)row * ldc + col0 + bj * 128) = w; }
            }
    }
};
__host__ __device__ __forceinline__ int kperm(int c) { if (c < KVR) return c; const int r = c - KVR, i = r & 31, sec = r >> 5; return KVR + 32 * (i >> 4) + 16 * sec + (i & 15); }
__host__ __device__ __forceinline__ int qperm(int c) { const int e = c % QH; if (e < NOPE) return c; const int r = e - NOPE, i = r & 31, sec = r >> 5; return c - e + NOPE + 32 * (i >> 4) + 16 * sec + (i & 15); }
struct EpiQ {
    static constexpr bool PERM = false;
    const float* ssqq_; const float* cs; bf16_t* qbuf; bf16_t* qs;
    __device__ __forceinline__ void operator()(const f32x4 (&acc)[2][2][4][2], const pg8::Unit& u, int wr, int wc, int fr_in, int fq_in) const {
        int fr = fr_in, fq = fq_in; asm volatile("" : "+v"(fr), "+v"(fq));
        const bool smp = u.pm >= MP / 256;
        float rq[2][4]; load_rstd_p<8>(ssqq_, 1.0f / QR, u, wr, fr, fq, rq);
#pragma unroll
        for (int ai = 0; ai < 2; ++ai)
#pragma unroll
            for (int m = 0; m < 4; ++m) {
                const int row = u.pm * 256 + ai * 128 + wr * 64 + m * 16 + fr; const float r = rq[ai][m]; const int pos = smp ? PAST + ((row - MP) & 7) : (row & (SEQ - 1));
                bf16_t* qrow = qbuf + (size_t)row * (NH * QH);
#pragma unroll
                for (int bj = 0; bj < 2; ++bj) {
                    const int Gi = u.pn * 8 + bj * 4 + wc, hh = Gi / 6, gi = Gi - hh * 6;
                    if (gi < 4) {
#pragma unroll
                        for (int n = 0; n < 2; ++n) { const f32x4 a = acc[ai][bj][m][n] * r; u32x2 w; w.x = pk2(a.x, a.y); w.y = pk2(a.z, a.w);
                            *(u32x2*)(qrow + Gi * 32 + n * 16 + 4 * fq) = w; }
                    } else {
                        const int i0 = 16 * (gi - 4) + 4 * fq;
                        const f32x4 x1 = acc[ai][bj][m][0] * r, x2 = acc[ai][bj][m][1] * r;
                        const f32x4 cn = *(const f32x4*)(cs + (size_t)pos * 64 + i0), sn = *(const f32x4*)(cs + (size_t)pos * 64 + 32 + i0);
                        const f32x4 o1 = x1 * cn - x2 * sn, o2 = x2 * cn + x1 * sn;
                        u32x2 w1, w2; w1.x = pk2(o1.x, o1.y); w1.y = pk2(o1.z, o1.w); w2.x = pk2(o2.x, o2.y); w2.y = pk2(o2.z, o2.w);
                        bf16_t* qd = smp ? qs + ((size_t)(row - MP) * NH + hh) * 320 + KVR : qrow + hh * QH + NOPE;
                        *(u32x2*)(qd + i0) = w1; *(u32x2*)(qd + 32 + i0) = w2;
                    }
                }
                asm volatile("" ::: "memory");
            }
    }
};
struct EpiDkvq {
    static constexpr bool PERM = false;
    const float* ssq_in; const float* cs; float* craw_; bf16_t* cb_; bf16_t* cqb_; float* ssqc_; float* ssqq_; float* out; bf16_t* kfull_; bf16_t* krbs_;
    __device__ __forceinline__ void operator()(const f32x4 (&acc)[2][2][4][2], const pg8::Unit& u, int wr, int wc, int fr_in, int fq_in) const {
        int fr = fr_in, fq = fq_in; asm volatile("" : "+v"(fr), "+v"(fq));
        float rs[2][4]; load_rstd(ssq_in, u, wr, fr, fq, rs);
        const bool smp = u.pm >= MP / 256;
#pragma unroll
        for (int ai = 0; ai < 2; ++ai)
#pragma unroll
            for (int m = 0; m < 4; ++m) {
                const int row = u.pm * 256 + ai * 128 + wr * 64 + m * 16 + fr; const float r = rs[ai][m];
                float sq = 0.f;
                if (u.pn == 0) {
#pragma unroll
                    for (int bj = 0; bj < 2; ++bj)
#pragma unroll
                        for (int n = 0; n < 2; ++n) { const int col = bj * 128 + wc * 32 + n * 16 + 4 * fq; const f32x4 v = acc[ai][bj][m][n] * r;
                            *(f32x4*)(craw_ + (size_t)row * KVR + col) = v; u32x2 w; w.x = pk2(v.x, v.y); w.y = pk2(v.z, v.w); *(u32x2*)(cb_ + (size_t)row * KVR + col) = w;
                            sq += (v.x * v.x + v.y * v.y) + (v.z * v.z + v.w * v.w); }
                    sq += __shfl_xor(sq, 16); sq += __shfl_xor(sq, 32);
                    if (fq == 0) ssqc_[(size_t)row * 4 + wc] = sq;
                } else {
#pragma unroll
                    for (int bj = 0; bj < 2; ++bj) {
                        const int g0 = (u.pn - 1) * 256 + bj * 128 + wc * 32;
                        if (g0 < ROPE) {
                            const int i0 = 16 * (g0 >> 5) + 4 * fq, pos = smp ? PAST + ((row - MP) & 7) : (row & (SEQ - 1));
                            const f32x4 x1 = acc[ai][bj][m][0] * r, x2 = acc[ai][bj][m][1] * r;
                            const f32x4 cn = *(const f32x4*)(cs + (size_t)pos * 64 + i0), sn = *(const f32x4*)(cs + (size_t)pos * 64 + 32 + i0);
                            const f32x4 o1 = x1 * cn - x2 * sn, o2 = x2 * cn + x1 * sn;
                            float* ko = smp ? out + O_KS + (size_t)(row - MP) * ROPE : out + O_KP + (size_t)row * ROPE;
                            *(f32x4*)(ko + i0) = o1; *(f32x4*)(ko + 32 + i0) = o2;
                            u32x2 w1, w2; w1.x = pk2(o1.x, o1.y); w1.y = pk2(o1.z, o1.w); w2.x = pk2(o2.x, o2.y); w2.y = pk2(o2.z, o2.w);
                            if (smp) { bf16_t* kd = krbs_ + (size_t)(row - MP) * ROPE; *(u32x2*)(kd + i0) = w1; *(u32x2*)(kd + 32 + i0) = w2; }
                            else { const int b = row >> 13, t = row & (SEQ - 1);
#pragma unroll
                                for (int h = 0; h < NH; ++h) { bf16_t* kd = kfull_ + ((size_t)(b * NH + h) * SEQ + t) * QH + NOPE; *(u32x2*)(kd + i0) = w1; *(u32x2*)(kd + 32 + i0) = w2; } }
                        } else if (g0 < ROPE + QR) {
#pragma unroll
                            for (int n = 0; n < 2; ++n) { const int qi = g0 - ROPE + n * 16 + 4 * fq; const f32x4 v = acc[ai][bj][m][n] * r;
                                u32x2 w; w.x = pk2(v.x, v.y); w.y = pk2(v.z, v.w); *(u32x2*)(cqb_ + (size_t)row * QR + qi) = w;
                                sq += (v.x * v.x + v.y * v.y) + (v.z * v.z + v.w * v.w); }
                        }
                    }
                    sq += __shfl_xor(sq, 16); sq += __shfl_xor(sq, 32);
                    if (fq == 0) ssqq_[(size_t)row * 8 + (u.pn - 1) * 4 + wc] = sq;
                }
                asm volatile("" ::: "memory");
            }
    }
};
struct EpiKup {
    static constexpr bool PERM = true;
    bf16_t* kfull; const float* ssqc_;
    __device__ __forceinline__ void operator()(const f32x4 (&acc)[2][2][4][2], const pg8::Unit& u, int wr, int wc, int fr_in, int fq_in) const {
        int fr = fr_in, fq = fq_in; asm volatile("" : "+v"(fr), "+v"(fq));
        const int col0 = u.pn * 256 + wc * 32 + 8 * fq;
        float rc[2][4]; load_rstd_p<4>(ssqc_, 1.0f / KVR, u, wr, fr, fq, rc);
#pragma unroll
        for (int ai = 0; ai < 2; ++ai)
#pragma unroll
            for (int m = 0; m < 4; ++m) {
                const int row = u.pm * 256 + ai * 128 + wr * 64 + m * 16 + fr; const int b = row >> 13, t = row & (SEQ - 1); const float r = rc[ai][m];
#pragma unroll
                for (int bj = 0; bj < 2; ++bj) { const int col = col0 + bj * 128; const int h = col >> 7, nn = col & 127; const f32x4 a = acc[ai][bj][m][0] * r, c = acc[ai][bj][m][1] * r;
                    u32x4 w; w.x = pk2(a.x, a.y); w.y = pk2(a.z, a.w); w.z = pk2(c.x, c.y); w.w = pk2(c.z, c.w);
                    *(u32x4*)(kfull + ((size_t)(b * NH + h) * SEQ + t) * QH + nn) = w; }
                asm volatile("" ::: "memory");
            }
    }
};
struct EpiVup {
    static constexpr bool PERM = true;
    bf16_t* vt; const float* ssqc_;
    __device__ __forceinline__ void operator()(const f32x4 (&acc)[2][2][4][2], const pg8::Unit& u, int wr, int wc, int fr_in, int fq_in) const {
        int fr = fr_in, fq = fq_in; asm volatile("" : "+v"(fr), "+v"(fq));
        const int col0 = u.pn * 256 + wc * 32 + 8 * fq;
        f32x4 rt[2][2];
#pragma unroll
        for (int bj = 0; bj < 2; ++bj)
#pragma unroll
            for (int k = 0; k < 8; ++k) { const f32x4 p4 = *(const f32x4*)(ssqc_ + (size_t)(col0 + bj * 128 + k) * 4); rt[bj][k >> 2][k & 3] = 1.0f / sqrtf(((p4.x + p4.y) + (p4.z + p4.w)) * (1.0f / KVR) + EPS); }
#pragma unroll
        for (int ai = 0; ai < 2; ++ai)
#pragma unroll
            for (int m = 0; m < 4; ++m) {
                const int row = u.pm * 256 + ai * 128 + wr * 64 + m * 16 + fr; const int h = row >> 7, v = row & 127;
#pragma unroll
                for (int bj = 0; bj < 2; ++bj) { const int col = col0 + bj * 128; const int b = col >> 13, t = col & (SEQ - 1); const f32x4 a = acc[ai][bj][m][0] * rt[bj][0], c = acc[ai][bj][m][1] * rt[bj][1];
                    u32x4 w; w.x = pk2(a.x, a.y); w.y = pk2(a.z, a.w); w.z = pk2(c.x, c.y); w.w = pk2(c.z, c.w);
                    *(u32x4*)(vt + ((size_t)(b * NH + h) * VD + v) * SEQ + t) = w; }
                asm volatile("" ::: "memory");
            }
    }
};

struct SgALoadBf { const bf16_t* A; int lda;
    __device__ __forceinline__ bf16x8 operator()(int row, int k) const { return *(const bf16x8*)(A + (size_t)row * lda + k); } };
struct SgALoadComb { const float* parto; const float* ml;
    __device__ __forceinline__ bf16x8 operator()(int row, int k) const {
        const int b = row >> 3, tok = row & 7, h = k >> 7, v = k & 127, q = tok * 8 + h;
        const float* m0p = ml + ((size_t)(b * 2 + 0) * 64 + q) * 2; const float* m1p = ml + ((size_t)(b * 2 + 1) * 64 + q) * 2;
        const float m0 = m0p[0], l0 = m0p[1], m1 = m1p[0], l1 = m1p[1], mx = fmaxf(m0, m1);
        float w0 = __builtin_amdgcn_exp2f(m0 - mx), w1 = __builtin_amdgcn_exp2f(m1 - mx); const float inv = 1.0f / (w0 * l0 + w1 * l1); w0 *= inv; w1 *= inv;
        const float* p0 = parto + ((size_t)(b * 2 + 0) * 64 + q) * 128 + v; const float* p1 = parto + ((size_t)(b * 2 + 1) * 64 + q) * 128 + v;
        return pack8v(*(const f32x4*)p0 * w0 + *(const f32x4*)p1 * w1, *(const f32x4*)(p0 + 4) * w0 + *(const f32x4*)(p1 + 4) * w1); } };
template <int NCT, int NCG, class Epi, class ALoad>
__device__ __forceinline__ void sg_gemm_l(LAS unsigned char* lds, const ALoad& AL, int apn256, const bf16_t* __restrict__ Bt, int K, int unit, const Epi& E, int tid, int wave, int lane) {
    constexpr int KS = 8 / NCG, W = NCG * NCT * 16, G4 = W / 4;
    static_assert(KS * 64 * W * 4 <= RING_BYTES, "sg_gemm reduction buffer");
    const int mt = unit >> 4, ntile = unit & 15, m0 = mt * 64, n0 = ntile * W;
    const int cg = wave % NCG, kp = wave / NCG, fr = lane & 15, fq = lane >> 4;
    const int Kw = K / KS;
    const int arow = m0 + fr, acol = (n0 >> 8) * apn256 + kp * Kw + 8 * fq;
    const bf16_t* bp = Bt + (size_t)(n0 + cg * NCT * 16 + fr) * K + kp * Kw + 8 * fq;
    f32x4 acc[4][NCT];
#pragma unroll
    for (int m = 0; m < 4; ++m)
#pragma unroll
        for (int n = 0; n < NCT; ++n) acc[m][n] = (f32x4){0.f, 0.f, 0.f, 0.f};
#pragma unroll 4
    for (int kk = 0; kk < Kw; kk += 32) {
        bf16x8 af[4], bfr[NCT];
#pragma unroll
        for (int m = 0; m < 4; ++m) af[m] = AL(arow + 16 * m, acol + kk);
#pragma unroll
        for (int n = 0; n < NCT; ++n) bfr[n] = *(const bf16x8*)(bp + (size_t)(16 * n) * K + kk);
#pragma unroll
        for (int m = 0; m < 4; ++m)
#pragma unroll
            for (int n = 0; n < NCT; ++n) acc[m][n] = __builtin_amdgcn_mfma_f32_16x16x32_bf16(bfr[n], af[m], acc[m][n], 0, 0, 0);
    }
    LAS float* red = (LAS float*)lds;
#pragma unroll
    for (int m = 0; m < 4; ++m)
#pragma unroll
        for (int n = 0; n < NCT; ++n) { const int row = 16 * m + fr, c4 = (cg * NCT * 16 + 16 * n) / 4 + fq;
            *(LAS f32x4*)(red + (size_t)(kp * 64 + row) * W + 4 * (c4 ^ (row & 3))) = acc[m][n]; }
    __syncthreads();
    for (int it = tid; it < 64 * G4; it += 512) {
        const int row = it / G4, c4 = it % G4;
        f32x4 v = *(const LAS f32x4*)(red + (size_t)row * W + 4 * (c4 ^ (row & 3)));
#pragma unroll
        for (int p = 1; p < KS; ++p) v += *(const LAS f32x4*)(red + (size_t)(p * 64 + row) * W + 4 * (c4 ^ (row & 3)));
        if constexpr (Epi::WHOLE_TILE) *(LAS f32x4*)(red + (size_t)row * W + 4 * (c4 ^ (row & 3))) = v;
        else E(MP + m0 + row, n0 + 4 * c4, v, ntile);
    }
    if constexpr (Epi::WHOLE_TILE) {
        __syncthreads();
        for (int it = tid; it < 64 * G4; it += 512) { const int row = it / G4, c4 = it % G4; E.tile(MP + m0 + row, n0, c4, red + (size_t)row * W, row & 3); }
    }
    __syncthreads();
}
template <int NCT, int NCG, class Epi>
__device__ __forceinline__ void sg_gemm(LAS unsigned char* lds, const bf16_t* __restrict__ A, int lda, int apn256, const bf16_t* __restrict__ Bt, int K, int unit, const Epi& E, int tid, int wave, int lane) {
    const SgALoadBf AL{A, lda}; sg_gemm_l<NCT, NCG>(lds, AL, apn256, Bt, K, unit, E, tid, wave, lane);
}
constexpr int SK_STG = 32768;
template <class Epi>
__device__ __forceinline__ void sk_gemm(LAS unsigned char* lds, const bf16_t* __restrict__ A, int lda, const bf16_t* __restrict__ Bt, int K, int m0, int n0, int ntile, const Epi& E, int tid, int wave, int lane) {
    const int nk = K >> 7, fr = lane & 15, fq = lane >> 4, mi = wave >> 1, nh = wave & 1;
    unsigned goA[2], goB[2];
#pragma unroll
    for (int e = 0; e < 2; ++e) { const int r = 4 * (wave + 8 * e) + (lane >> 4), c = (lane & 15) ^ (r & 15); goA[e] = (unsigned)(r * lda + c * 8) * 2u; goB[e] = (unsigned)(r * K + c * 8) * 2u; }
    const unsigned ldsw = (unsigned)wave * 1024u;
#define SK_STAGE(kc) do { const unsigned so_ = (unsigned)((kc) & 3) * SK_STG + ldsw; const size_t ko_ = (size_t)(kc) * 256; \
        _Pragma("unroll") for (int e = 0; e < 2; ++e) { \
            __builtin_amdgcn_global_load_lds((const unsigned*)((const char*)A + ko_ + goA[e]), (LAS unsigned*)(lds + so_ + e * 8192), 16, 0, 0); \
            __builtin_amdgcn_global_load_lds((const unsigned*)((const char*)Bt + ko_ + goB[e]), (LAS unsigned*)(lds + so_ + 16384 + e * 8192), 16, 0, 0); } } while (0)
    int co[4];
#pragma unroll
    for (int ks = 0; ks < 4; ++ks) co[ks] = ((4 * ks + fq) ^ fr) << 4;
    const int aro = (16 * mi + fr) * 256, bro = 16384 + (32 * nh + fr) * 256;
    f32x4 acc[2] = {(f32x4){0.f, 0.f, 0.f, 0.f}, (f32x4){0.f, 0.f, 0.f, 0.f}};
    asm volatile("s_waitcnt vmcnt(0)" ::: "memory");
    SK_STAGE(0); if (nk > 1) SK_STAGE(1); if (nk > 2) SK_STAGE(2);
#pragma unroll 1
    for (int kc = 0; kc < nk; ++kc) {
        if (kc + 2 < nk) asm volatile("s_waitcnt vmcnt(8)" ::: "memory"); else if (kc + 1 < nk) asm volatile("s_waitcnt vmcnt(4)" ::: "memory"); else asm volatile("s_waitcnt vmcnt(0)" ::: "memory");
        asm volatile("s_waitcnt lgkmcnt(0)" ::: "memory"); __builtin_amdgcn_s_barrier(); asm volatile("" ::: "memory");
        if (kc + 3 < nk) SK_STAGE(kc + 3);
        const LAS unsigned char* sp = lds + (kc & 3) * SK_STG;
        bf16x8 af[4], b0[4], b1[4];
#pragma unroll
        for (int ks = 0; ks < 4; ++ks) { af[ks] = *(const LAS bf16x8*)(sp + aro + co[ks]); b0[ks] = *(const LAS bf16x8*)(sp + bro + co[ks]); b1[ks] = *(const LAS bf16x8*)(sp + bro + 4096 + co[ks]); }
#pragma unroll
        for (int ks = 0; ks < 4; ++ks) { acc[0] = __builtin_amdgcn_mfma_f32_16x16x32_bf16(b0[ks], af[ks], acc[0], 0, 0, 0); acc[1] = __builtin_amdgcn_mfma_f32_16x16x32_bf16(b1[ks], af[ks], acc[1], 0, 0, 0); }
    }
#undef SK_STAGE
    asm volatile("s_waitcnt lgkmcnt(0)" ::: "memory"); __builtin_amdgcn_s_barrier(); asm volatile("" ::: "memory");
    LAS float* red = (LAS float*)lds;
    { const int row = 16 * mi + fr;
#pragma unroll
      for (int n = 0; n < 2; ++n) { const int c4 = 4 * (2 * nh + n) + fq; *(LAS f32x4*)(red + row * 64 + 4 * (c4 ^ (row & 3))) = acc[n]; } }
    __syncthreads();
#pragma unroll
    for (int it = tid; it < 1024; it += 512) { const int row = it >> 4, c4 = it & 15; const f32x4 v = *(const LAS f32x4*)(red + row * 64 + 4 * (c4 ^ (row & 3))); E(MP + m0 + row, n0 + 4 * c4, v, ntile); }
    __syncthreads();
}
__device__ __forceinline__ float row_rstd16(const float* ssq, int row) {
    const f32x4* s = (const f32x4*)(ssq + (size_t)row * 16); const f32x4 a = s[0], b = s[1], c = s[2], d = s[3];
    const float t = ((a.x + a.y) + (a.z + a.w)) + ((b.x + b.y) + (b.z + b.w)) + ((c.x + c.y) + (c.z + c.w)) + ((d.x + d.y) + (d.z + d.w));
    return 1.0f / sqrtf(t * (1.0f / 1024.0f) + EPS);
}
template <int MODE> struct SgH {
    static constexpr bool WHOLE_TILE = false;
    const float* xs; const float* scale; const float* ssq_in; const bf16_t* proj; const bf16_t* hb_in; bf16_t* hb; float* ssq_out;
    __device__ __forceinline__ void operator()(int row, int col, f32x4 a, int ntile) const {
        const f32x4 bs = (MODE == 0) ? *(const f32x4*)(xs + (size_t)(row - MP) * D + col) : unpk4(*(const u32x2*)(hb_in + (size_t)row * D + col));
        f32x4 o;
        if (MODE == 0) o = bs + *(const f32x4*)(scale + col) * a;
        else if (MODE == 1) o = bs + a;
        else { const float r = row_rstd16(ssq_in, row); const f32x4 pj = unpk4(*(const u32x2*)(proj + (size_t)row * D + col));
            f32x4 gt; gt.x = 1.0f / (1.0f + __expf(-r * a.x)); gt.y = 1.0f / (1.0f + __expf(-r * a.y)); gt.z = 1.0f / (1.0f + __expf(-r * a.z)); gt.w = 1.0f / (1.0f + __expf(-r * a.w));
            o = bs + gt * pj; }
        u32x2 w; w.x = pk2(o.x, o.y); w.y = pk2(o.z, o.w);
        *(u32x2*)(hb + (size_t)row * D + col) = w;
        float sq = (o.x * o.x + o.y * o.y) + (o.z * o.z + o.w * o.w);
        sq += __shfl_xor(sq, 1); sq += __shfl_xor(sq, 2); sq += __shfl_xor(sq, 4); sq += __shfl_xor(sq, 8);
        if ((col & 63) == 0) ssq_out[(size_t)row * 16 + ntile] = sq;
    }
};
struct SgUp {
    static constexpr bool WHOLE_TILE = false;
    const float* ssq_in; bf16_t* abuf;
    __device__ __forceinline__ void operator()(int row, int col, f32x4 a, int) const {
        const float r = row_rstd16(ssq_in, row); a = a * r;
        a.x = fmaxf(a.x, 0.f); a.y = fmaxf(a.y, 0.f); a.z = fmaxf(a.z, 0.f); a.w = fmaxf(a.w, 0.f);
        u32x2 w; w.x = pk2(a.x * a.x, a.y * a.y); w.y = pk2(a.z * a.z, a.w * a.w);
        *(u32x2*)(abuf + (size_t)row * FF + col) = w;
    }
};
template <int MODE> struct SgF32 {
    static constexpr bool WHOLE_TILE = false;
    float* C; int ldc; const float* aux;
    __device__ __forceinline__ void operator()(int row, int col, f32x4 a, int) const {
        const float r = (MODE == 1) ? row_rstd16(aux, row) : (MODE == 2 ? aux[row] : 1.0f);
        *(f32x4*)(C + (size_t)row * ldc + col) = a * r;
    }
};
struct SgBf {
    static constexpr bool WHOLE_TILE = false;
    bf16_t* C; int ldc;
    __device__ __forceinline__ void operator()(int row, int col, f32x4 a, int) const { u32x2 w; w.x = pk2(a.x, a.y); w.y = pk2(a.z, a.w); *(u32x2*)(C + (size_t)row * ldc + col) = w; }
};
struct SgQ {
    static constexpr bool WHOLE_TILE = true;
    const float* rstdq; const float* cs; bf16_t* qbuf; bf16_t* qs;
    __device__ __forceinline__ void operator()(int, int, f32x4, int) const {}
    __device__ __forceinline__ void tile(int row, int n0, int c4, const LAS float* trow, int sw) const {
        const int c = n0 + 4 * c4, hh = c / QH, e = c - hh * QH; const float r = rstdq[row];
        const f32x4 v = *(const LAS f32x4*)(trow + 4 * (c4 ^ sw)) * r;
        if (e < NOPE) { u32x2 w; w.x = pk2(v.x, v.y); w.y = pk2(v.z, v.w); *(u32x2*)(qbuf + (size_t)row * (NH * QH) + c) = w; }
        else { const int rp = e - NOPE, wi = rp & 31;
            if (wi < 16) { const int i0 = 16 * (rp >> 5) + wi, pos = PAST + ((row - MP) & 7);
                const f32x4 x2 = *(const LAS f32x4*)(trow + 4 * ((c4 + 4) ^ sw)) * r;
                const f32x4 cn = *(const f32x4*)(cs + (size_t)pos * 64 + i0), sn = *(const f32x4*)(cs + (size_t)pos * 64 + 32 + i0);
                const f32x4 o1 = v * cn - x2 * sn, o2 = x2 * cn + v * sn;
                bf16_t* qd = qs + ((size_t)(row - MP) * NH + hh) * 320 + KVR;
                u32x2 w1, w2; w1.x = pk2(o1.x, o1.y); w1.y = pk2(o1.z, o1.w); w2.x = pk2(o2.x, o2.y); w2.y = pk2(o2.z, o2.w);
                *(u32x2*)(qd + i0) = w1; *(u32x2*)(qd + 32 + i0) = w2; } }
    }
};

template <int PMODE = 0>
__device__ __forceinline__ void transpose_item(const float* W, const float* kscale, int K, int N, bf16_t* WT, int row_off, LAS float* scr, int item, int lane) {
    const int nblk = N / 32, kb = item / nblk, nb = item % nblk, k0 = 64 * kb, n0 = 32 * nb;
    { f32x4 v[8];
#pragma unroll
      for (int i = 0; i < 8; ++i) v[i] = *(const f32x4*)(W + (size_t)(k0 + (lane >> 3) + 8 * i) * N + n0 + (lane & 7) * 4);
#pragma unroll
      for (int i = 0; i < 8; ++i) { const int kk = (lane >> 3) + 8 * i; f32x4 x = v[i]; if (kscale) x = x * kscale[k0 + kk];
          LAS float* d = scr + kk * 33 + (lane & 7) * 4; d[0] = x.x; d[1] = x.y; d[2] = x.z; d[3] = x.w; } }
    LDS_WAIT(); asm volatile("" ::: "memory");
    const int c = lane & 7;
#pragma unroll
    for (int j = 0; j < 4; ++j) { const int n = (lane >> 3) + 8 * j; const LAS float* s = scr + (8 * c) * 33 + n;
        u32x4 o; o.x = pk2(s[0 * 33], s[1 * 33]); o.y = pk2(s[2 * 33], s[3 * 33]); o.z = pk2(s[4 * 33], s[5 * 33]); o.w = pk2(s[6 * 33], s[7 * 33]);
        *(u32x4*)(WT + (size_t)(row_off + (PMODE == 1 ? qperm(n0 + n) : (PMODE == 2 ? kperm(n0 + n) : n0 + n))) * K + k0 + 8 * c) = o; }
    LDS_WAIT(); asm volatile("" ::: "memory");
}

constexpr int AK_PITCH = 400, AK_BUF = 64 * AK_PITCH;
constexpr int AV_PITCH = 136, AV_BUF = 128 * AV_PITCH;
constexpr int AV_OFF = 2 * AK_BUF, AQ_OFF = AV_OFF + 2 * AV_BUF;
static_assert(AQ_OFF + 256 * 144 <= RING_BYTES, "attention LDS");
__device__ __forceinline__ void attn_prompt_unit(const bf16_t* __restrict__ qbuf, const bf16_t* __restrict__ Kf, const bf16_t* __restrict__ Vt, bf16_t* __restrict__ obuf,
                                                 int b, int h, int qb, LAS unsigned char* lds, int tid, int wave, int lane) {
    const int r32 = lane & 31, g = lane >> 5;
    const int t_lo = qb * 256 + wave * 32, trow = t_lo + r32;
    bf16x8 qf[8];
    { const bf16_t* qp = qbuf + (size_t)(b * SEQ + trow) * (NH * QH) + h * QH + 8 * g;
      __syncthreads();
#pragma unroll
      for (int ks = 8; ks < 12; ++ks) *(LAS bf16x8*)(lds + AQ_OFF + (wave * 32 + r32) * 144 + (2 * (ks - 8) + g) * 16) = *(const bf16x8*)(qp + 16 * ks);
#pragma unroll
      for (int ks = 0; ks < 8; ++ks) qf[ks] = *(const bf16x8*)(qp + 16 * ks);
#pragma unroll
      for (int ks = 0; ks < 8; ++ks) asm volatile("" : "+v"(qf[ks])); }
    f32x16 O[4];
#pragma unroll
    for (int i = 0; i < 4; ++i)
#pragma unroll
        for (int j = 0; j < 16; ++j) O[i][j] = 0.f;
    float mrun = -1e30f, lrun = 0.f;
    const bf16_t* Kb = Kf + (size_t)(b * NH + h) * SEQ * QH;
    const bf16_t* Vb = Vt + (size_t)(b * NH + h) * VD * SEQ;
    const int NT = (qb + 1) * 4;
    int kl_off[3], vl_off[2]; size_t vg_off[2];
#pragma unroll
    for (int e = 0; e < 3; ++e) kl_off[e] = (tid >> 3) * AK_PITCH + ((tid & 7) + 8 * e) * 16;
#pragma unroll
    for (int e = 0; e < 2; ++e) { const int c = tid + 512 * e; vl_off[e] = AV_OFF + (c >> 3) * AV_PITCH + (c & 7) * 16; vg_off[e] = (size_t)(c >> 3) * SEQ + (c & 7) * 8; }
    u32x4 kst[3], vst[2];
#define AT_LOAD(j) do { _Pragma("unroll") for (int e = 0; e < 3; ++e) kst[e] = *(const u32x4*)(Kb + (size_t)(64 * (j) + (tid >> 3)) * QH + ((tid & 7) + 8 * e) * 8); \
                        _Pragma("unroll") for (int e = 0; e < 2; ++e) vst[e] = *(const u32x4*)(Vb + vg_off[e] + 64 * (j)); } while (0)
#define AT_WRITE(buf) do { _Pragma("unroll") for (int e = 0; e < 3; ++e) *(LAS u32x4*)(lds + (buf) * AK_BUF + kl_off[e]) = kst[e]; \
                           _Pragma("unroll") for (int e = 0; e < 2; ++e) { *(LAS u32x2*)(lds + (buf) * AV_BUF + vl_off[e]) = (u32x2){vst[e].x, vst[e].y}; *(LAS u32x2*)(lds + (buf) * AV_BUF + vl_off[e] + 8) = (u32x2){vst[e].z, vst[e].w}; } } while (0)
    AT_LOAD(0); AT_WRITE(0);
    __syncthreads();
    for (int j = 0; j < NT; ++j) {
        const int buf = j & 1;
        if (j + 1 < NT) AT_LOAD(j + 1);
        if (64 * j <= t_lo + 31) {
            f32x16 S0, S1;
#pragma unroll
            for (int i = 0; i < 16; ++i) { S0[i] = 0.f; S1[i] = 0.f; }
            const LAS unsigned char* kl = lds + buf * AK_BUF + r32 * AK_PITCH + g * 16;
            const LAS unsigned char* ql = lds + AQ_OFF + (wave * 32 + r32) * 144 + g * 16;
            bf16x8 ka[3][2], qr_[3];
#define AT_KLD(ks) do { ka[(ks) % 3][0] = *(const LAS bf16x8*)(kl + (ks) * 32); ka[(ks) % 3][1] = *(const LAS bf16x8*)(kl + 32 * AK_PITCH + (ks) * 32); \
                        if ((ks) >= 8) qr_[(ks) % 3] = *(const LAS bf16x8*)(ql + ((ks) - 8) * 32); } while (0)
            AT_KLD(0); AT_KLD(1);
#pragma unroll
            for (int ks = 0; ks < 12; ++ks) {
                if (ks + 2 < 12) AT_KLD(ks + 2);
                __builtin_amdgcn_sched_barrier(0);
                const bf16x8 qb_ = (ks < 8) ? qf[ks < 8 ? ks : 0] : qr_[ks % 3];
                S0 = __builtin_amdgcn_mfma_f32_32x32x16_bf16(ka[ks % 3][0], qb_, S0, 0, 0, 0);
                S1 = __builtin_amdgcn_mfma_f32_32x32x16_bf16(ka[ks % 3][1], qb_, S1, 0, 0, 0);
                __builtin_amdgcn_sched_barrier(0);
            }
#undef AT_KLD
            if (64 * j + 63 > t_lo) {
                asm volatile("" ::: "memory");
#pragma unroll
                for (int i = 0; i < 16; ++i) { const int key = 64 * j + crow(i, g); if (key > trow) S0[i] = -1e30f; if (key + 32 > trow) S1[i] = -1e30f; }
            }
            float mx = S0[0];
#pragma unroll
            for (int i = 1; i < 16; ++i) mx = fmaxf(mx, S0[i]);
#pragma unroll
            for (int i = 0; i < 16; ++i) mx = fmaxf(mx, S1[i]);
            mx = fmaxf(mx, __shfl_xor(mx, 32)) * CEXP;
            if (__any(mx > mrun + 11.5f)) {
                const float mnew = fmaxf(mrun, mx), alpha = __builtin_amdgcn_exp2f(mrun - mnew);
                mrun = mnew; lrun *= alpha;
#pragma unroll
                for (int vt = 0; vt < 4; ++vt)
#pragma unroll
                    for (int i = 0; i < 16; ++i) O[vt][i] *= alpha;
            }
            float ps = 0.f;
#pragma unroll
            for (int i = 0; i < 16; ++i) { S0[i] = __builtin_amdgcn_exp2f(S0[i] * CEXP - mrun); S1[i] = __builtin_amdgcn_exp2f(S1[i] * CEXP - mrun); ps += S0[i] + S1[i]; }
            lrun += ps;
            bf16x8 pf[4];
            { float tmp[8];
#pragma unroll
              for (int s2 = 0; s2 < 4; ++s2) {
#pragma unroll
                for (int i = 0; i < 8; ++i) tmp[i] = (s2 < 2) ? S0[8 * (s2 & 1) + i] : S1[8 * (s2 & 1) + i];
                pf[s2] = pack8(tmp); } }
            const LAS unsigned char* vl = lds + AV_OFF + buf * AV_BUF + r32 * AV_PITCH + g * 8;
            u32x4 fa[4], fb[4];
#define AT_VLD(dst, vt) do { _Pragma("unroll") for (int s2 = 0; s2 < 4; ++s2) { const u32x2 lo_ = *(const LAS u32x2*)(vl + (vt) * 32 * AV_PITCH + s2 * 32), hi_ = *(const LAS u32x2*)(vl + (vt) * 32 * AV_PITCH + s2 * 32 + 16); dst[s2] = (u32x4){lo_.x, lo_.y, hi_.x, hi_.y}; } } while (0)
#define AT_VMM(src, vt) do { _Pragma("unroll") for (int s2 = 0; s2 < 4; ++s2) O[vt] = __builtin_amdgcn_mfma_f32_32x32x16_bf16(__builtin_bit_cast(bf16x8, src[s2]), pf[s2], O[vt], 0, 0, 0); } while (0)
            AT_VLD(fa, 0); AT_VLD(fb, 1); __builtin_amdgcn_sched_barrier(0);
            AT_VMM(fa, 0); __builtin_amdgcn_sched_barrier(0);
            AT_VLD(fa, 2); __builtin_amdgcn_sched_barrier(0);
            AT_VMM(fb, 1); __builtin_amdgcn_sched_barrier(0);
            AT_VLD(fb, 3); __builtin_amdgcn_sched_barrier(0);
            AT_VMM(fa, 2); __builtin_amdgcn_sched_barrier(0);
            AT_VMM(fb, 3);
#undef AT_VLD
#undef AT_VMM
        }
        if (j + 1 < NT) AT_WRITE(buf ^ 1);
        __syncthreads();
    }
#undef AT_LOAD
#undef AT_WRITE
    const float ltot = lrun + __shfl_xor(lrun, 32), inv = 1.0f / ltot;
    bf16_t* op = obuf + (size_t)(b * SEQ + trow) * D + h * VD + 4 * g;
#pragma unroll
    for (int vt = 0; vt < 4; ++vt)
#pragma unroll
        for (int jq = 0; jq < 4; ++jq) {
            u32x2 w; w.x = pk2(O[vt][4 * jq] * inv, O[vt][4 * jq + 1] * inv); w.y = pk2(O[vt][4 * jq + 2] * inv, O[vt][4 * jq + 3] * inv);
            *(u32x2*)(op + 32 * vt + 8 * jq) = w;
        }
}

typedef short s16x4 __attribute__((ext_vector_type(4)));
constexpr int SA_KR = 32768, SA_BUF = 32768 + 64 * 144, SA_QR = 2 * SA_BUF, SA_QI = SA_QR + 64 * 144, SA_QI_PITCH = 528, SA_OI = 69632;
static_assert(SA_OI >= 65536 + 1024 && SA_OI + 64 * SA_QI_PITCH <= MISC_OFF, "O image");
static_assert(SA_QI + 64 * SA_QI_PITCH <= MISC_OFF, "sample attention LDS");
__device__ __forceinline__ int sa_off(int row, int ch) { return 256 * row + 16 * (ch ^ (((row & 3) << 2) | ((row >> 2) & 3))); }
__device__ __forceinline__ void sattn_item(const Params& P, int b, int half, LAS unsigned char* lds, int tid, int wave, int lane) {
    unsigned char* ws = P.ws;
    const int r32 = lane & 31, g = lane >> 5;
    const bool is_cmp = wave < 4;
    const int qt = wave & 1, kb = (wave >> 1) & 1;
    const int ptv = ((const int*)P.in[I_PT])[b * NPG + half * 32 + (lane & 31)];
    const float* clat = P.in[I_CLAT]; const float* ckr = P.in[I_CKR];
#define SA_LOAD(S, h) do { const int pg_ = __builtin_amdgcn_readlane(ptv, (h) >> 2); const size_t prow_ = (size_t)pg_ * PAGE + (((h) & 3) << 5); \
        const char* lat_ = (const char*)(clat + prow_ * KVR); const char* kro_ = (const char*)(ckr + prow_ * ROPE); \
        _Pragma("unroll") for (int e = 0; e < 4; ++e) { S[2 * e] = *(const f32x4*)(lat_ + glb[e]); S[2 * e + 1] = *(const f32x4*)(lat_ + glb[e] + 16); } \
        S[8] = *(const f32x4*)(kro_ + grb); S[9] = *(const f32x4*)(kro_ + grb + 16); } while (0)
#define SA_WRITE(S, bufo, hh) do { \
        _Pragma("unroll") for (int e = 0; e < 4; ++e) *(LAS bf16x8*)(lds + (bufo) + llb[e][hh]) = pack8v(S[2 * e], S[2 * e + 1]); \
        *(LAS bf16x8*)(lds + (bufo) + lrb[hh]) = pack8v(S[8], S[9]); asm volatile("" ::: "memory"); } while (0)
    __syncthreads();
    *(LAS u32x4*)(lds + SA_QR + (tid >> 3) * 144 + (tid & 7) * 16) = *(const u32x4*)((const bf16_t*)(ws + WS_QS) + ((size_t)b * 64 + (tid >> 3)) * 320 + KVR + (tid & 7) * 8);
    {
      const bf16_t* qn = (const bf16_t*)(ws + WS_QBUF) + (size_t)(MP + b * DS + (r32 & 7)) * (NH * QH) + wave * QH + 8 * g;
      bf16x8 an[8];
#pragma unroll
      for (int ks = 0; ks < 8; ++ks) { u32x4 z = {0u, 0u, 0u, 0u}; if (r32 < DS) z = *(const u32x4*)(qn + 16 * ks); an[ks] = __builtin_bit_cast(bf16x8, z); }
      const bf16_t* wk = (const bf16_t*)(ws + WS_WUKB) + (size_t)r32 * 1024 + wave * NOPE + 8 * g;
#pragma unroll 2
      for (int nt = 0; nt < 8; ++nt) {
          f32x16 acc;
#pragma unroll
          for (int i = 0; i < 16; ++i) acc[i] = 0.f;
#pragma unroll
          for (int ks = 0; ks < 8; ++ks) acc = __builtin_amdgcn_mfma_f32_32x32x16_bf16(an[ks], *(const bf16x8*)(wk + (size_t)(32 * nt) * 1024 + 16 * ks), acc, 0, 0, 0);
#pragma unroll
          for (int i = 0; i < 4; ++i) *(LAS bf16_t*)(lds + SA_QI + ((i + 4 * g) * 8 + wave) * SA_QI_PITCH + (32 * nt + r32) * 2) = (bf16_t)f2bf(acc[i]);
      } }
    __syncthreads();
#define SA_KLD(ks) do { const int o0_ = ((ks) < 16) ? (((ks) >> 3) * 16384 + krow + 32 * (((ks) & 7) ^ (x_ >> 1))) : (krope + 32 * ((ks) - 16)); \
        ka_[(ks) & 3] = *(const LAS bf16x8*)(kb_ + o0_); \
        qa_[(ks) & 3] = ((ks) < 16) ? *(const LAS bf16x8*)(qil + 32 * (ks)) : *(const LAS bf16x8*)(qrl + 32 * ((ks) - 16)); } while (0)
#define SA_VLD(dst, vt) do { const LAS unsigned char* vb_ = kb_ + ((vt) >> 2) * 16384 + 8192 * kb; \
        const int c0_ = 4 * ((vt) & 3) + 2 * vsub + (p_ >> 1); \
        const int blo_ = 256 * (4 * gg + q_) + 16 * (c0_ ^ ((q_ << 2) | gg)) + 8 * (p_ & 1); \
        const int bhi_ = 256 * (4 * gg + q_ + 8) + 16 * (c0_ ^ ((q_ << 2) | (gg + 2))) + 8 * (p_ & 1); \
        _Pragma("unroll") for (int s2 = 0; s2 < 2; ++s2) { \
            const s16x4 lo_ = __builtin_amdgcn_ds_read_tr16_b64_v4i16((LAS s16x4*)(vb_ + blo_ + 4096 * s2)); \
            const s16x4 hi_ = __builtin_amdgcn_ds_read_tr16_b64_v4i16((LAS s16x4*)(vb_ + bhi_ + 4096 * s2)); \
            dst[s2] = (bf16x8){lo_[0], lo_[1], lo_[2], lo_[3], hi_[0], hi_[1], hi_[2], hi_[3]}; } } while (0)
#define SA_VMM(src, vt) do { _Pragma("unroll") for (int s2 = 0; s2 < 2; ++s2) O[vt] = __builtin_amdgcn_mfma_f32_32x32x16_bf16(src[s2], pf[s2], O[vt], 0, 0, 0); } while (0)
#define SA_COMPUTE(j, bufo) do { \
        const LAS unsigned char* kb_ = lds + (bufo); \
        f32x16 S0; \
        _Pragma("unroll") for (int i = 0; i < 16; ++i) S0[i] = 0.f; \
        int r32v = r32; asm volatile("" : "+v"(r32v)); \
        const int x_ = ((r32v & 3) << 2) | ((r32v >> 2) & 3); \
        const int krow = 256 * (r32v + 32 * kb) + 16 * ((g ^ x_) & 1), krope = SA_KR + (r32v + 32 * kb) * 144 + g * 16; \
        const LAS unsigned char* qrl = lds + SA_QR + (32 * qt + r32v) * 144 + g * 16; const LAS unsigned char* qil = lds + SA_QI + (32 * qt + r32v) * SA_QI_PITCH + g * 16; \
        bf16x8 ka_[4], qa_[4]; \
        SA_KLD(0); SA_KLD(1); SA_KLD(2); \
        _Pragma("unroll") for (int ks = 0; ks < 20; ++ks) { \
            if (ks + 3 < 20) SA_KLD(ks + 3); \
            __builtin_amdgcn_sched_barrier(0); \
            S0 = __builtin_amdgcn_mfma_f32_32x32x16_bf16(ka_[ks & 3], qa_[ks & 3], S0, 0, 0, 0); \
            __builtin_amdgcn_sched_barrier(0); } \
        if ((j) == 64) { const int tok = (32 * qt + r32) >> 3; asm volatile("" ::: "memory"); \
            _Pragma("unroll") for (int i = 0; i < 16; ++i) { const int key = 32 * kb + crow(i, g); if (key > tok || key >= DS) S0[i] = -1e30f; } } \
        float mx = S0[0]; \
        _Pragma("unroll") for (int i = 1; i < 16; ++i) mx = fmaxf(mx, S0[i]); \
        mx = fmaxf(mx, __shfl_xor(mx, 32)) * CEXP; \
        if (__any(mx > mrun + 11.5f)) { const float mnew = fmaxf(mrun, mx), alpha = __builtin_amdgcn_exp2f(mrun - mnew); mrun = mnew; lrun *= alpha; \
            _Pragma("unroll") for (int vt = 0; vt < 8; ++vt) _Pragma("unroll") for (int i = 0; i < 16; ++i) O[vt][i] *= alpha; } \
        int lnv = lane; asm volatile("" : "+v"(lnv)); \
        const int li = lnv & 15, q_ = li >> 2, p_ = li & 3, vsub = (lnv >> 4) & 1, gg = lnv >> 5; \
        bf16x8 fa_[2], fb_[2]; \
        SA_VLD(fa_, 0); SA_VLD(fb_, 1);                        \
        float ps = 0.f; \
        _Pragma("unroll") for (int i = 0; i < 16; ++i) { S0[i] = __builtin_amdgcn_exp2f(S0[i] * CEXP - mrun); ps += S0[i]; } \
        lrun += ps; \
        bf16x8 pf[2]; \
        { float tmp[8]; \
          _Pragma("unroll") for (int s2 = 0; s2 < 2; ++s2) { \
            _Pragma("unroll") for (int i = 0; i < 8; ++i) tmp[i] = S0[8 * s2 + i]; \
            pf[s2] = pack8(tmp); } } \
        __builtin_amdgcn_sched_barrier(0); \
        SA_VMM(fa_, 0); __builtin_amdgcn_sched_barrier(0); SA_VLD(fa_, 2); __builtin_amdgcn_sched_barrier(0); \
        SA_VMM(fb_, 1); __builtin_amdgcn_sched_barrier(0); SA_VLD(fb_, 3); __builtin_amdgcn_sched_barrier(0); \
        SA_VMM(fa_, 2); __builtin_amdgcn_sched_barrier(0); SA_VLD(fa_, 4); __builtin_amdgcn_sched_barrier(0); \
        SA_VMM(fb_, 3); __builtin_amdgcn_sched_barrier(0); SA_VLD(fb_, 5); __builtin_amdgcn_sched_barrier(0); \
        SA_VMM(fa_, 4); __builtin_amdgcn_sched_barrier(0); SA_VLD(fa_, 6); __builtin_amdgcn_sched_barrier(0); \
        SA_VMM(fb_, 5); __builtin_amdgcn_sched_barrier(0); SA_VLD(fb_, 7); __builtin_amdgcn_sched_barrier(0); \
        SA_VMM(fa_, 6); __builtin_amdgcn_sched_barrier(0); \
        SA_VMM(fb_, 7); } while (0)
#define SA_LOADER(j, SX, SY, bufn) do { const int h0_ = 2 * (j) + 6 < 127 ? 2 * (j) + 6 : 127, h1_ = 2 * (j) + 7 < 127 ? 2 * (j) + 7 : 127; \
        __builtin_amdgcn_sched_barrier(0); SA_WRITE(SX, bufn, 0); SA_LOAD(SX, h0_); __builtin_amdgcn_sched_barrier(0); SA_WRITE(SY, bufn, 1); SA_LOAD(SY, h1_); __builtin_amdgcn_sched_barrier(0); } while (0)
#define SA_TAIL64(bufn) do { if (half == 1) { \
            const char* cbn = (const char*)((const bf16_t*)(ws + WS_CB) + (size_t)(MP + b * DS) * KVR); const char* krn = (const char*)((const bf16_t*)(ws + WS_KRBS) + (size_t)(b * DS) * ROPE); \
            const int lz_ = tid - 256; \
            _Pragma("unroll") for (int hh = 0; hh < 2; ++hh) { \
                _Pragma("unroll") for (int e = 0; e < 4; ++e) { const int key = ((lz_ + 256 * e) >> 5) + 32 * hh; u32x4 z = {0u, 0u, 0u, 0u}; if (key < DS) z = *(const u32x4*)(cbn + (glb[e] >> 1)); *(LAS u32x4*)(lds + (bufn) + llb[e][hh]) = z; } \
                { const int key = (lz_ >> 3) + 32 * hh; u32x4 z = {0u, 0u, 0u, 0u}; if (key < DS) z = *(const u32x4*)(krn + (grb >> 1)); *(LAS u32x4*)(lds + (bufn) + lrb[hh]) = z; } } } } while (0)
#define SA_BAR() do { asm volatile("s_waitcnt lgkmcnt(0)" ::: "memory"); __builtin_amdgcn_s_barrier(); asm volatile("" ::: "memory"); } while (0)
    float* ml = (float*)(ws + WS_ML) + (size_t)(b * 2 + half) * 64 * 2;
    if (is_cmp) {
        SA_BAR();
        f32x16 O[8];
#pragma unroll
        for (int vt = 0; vt < 8; ++vt)
#pragma unroll
            for (int i = 0; i < 16; ++i) O[vt][i] = 0.f;
        float mrun = -1e30f, lrun = 0.f;
        int bo = 0;
        for (int j = 0; j < 64; ++j) {
            SA_COMPUTE(j, bo);
            bo = SA_BUF - bo;
            SA_BAR();
        }
        if (half == 1) { SA_COMPUTE(64, bo); SA_BAR(); }
        LAS float* xo = (LAS float*)(lds + qt * 32768); LAS float* xm = (LAS float*)(lds + 65536 + qt * 512);
        if (kb == 1) { xm[2 * lane] = mrun; xm[2 * lane + 1] = lrun;
#pragma unroll
            for (int vt = 0; vt < 8; ++vt)
#pragma unroll
                for (int i = 0; i < 16; ++i) xo[(vt * 16 + i) * 64 + lane] = O[vt][i]; }
        SA_BAR();
        if (kb == 0) {
            const float m1 = xm[2 * lane], l1 = xm[2 * lane + 1], mm = fmaxf(mrun, m1);
            const float a0 = __builtin_amdgcn_exp2f(mrun - mm), a1 = __builtin_amdgcn_exp2f(m1 - mm);
            const float ll = lrun * a0 + l1 * a1, lt = ll + __shfl_xor(ll, 32);
            const int q = 32 * qt + r32;
            if (g == 0) { ml[q * 2] = mm; ml[q * 2 + 1] = lt; }
#pragma unroll
            for (int vt = 0; vt < 8; ++vt) {
                float o[16];
#pragma unroll
                for (int i = 0; i < 16; ++i) o[i] = O[vt][i] * a0 + xo[(vt * 16 + i) * 64 + lane] * a1;
#pragma unroll
                for (int jq = 0; jq < 4; ++jq) { u32x2 w; w.x = pk2(o[4 * jq], o[4 * jq + 1]); w.y = pk2(o[4 * jq + 2], o[4 * jq + 3]);
                    *(LAS u32x2*)(lds + SA_OI + q * SA_QI_PITCH + (32 * vt + 8 * jq + 4 * g) * 2) = w; }
            }
        }
    } else {
        unsigned glb[4], llb[4][2], grb, lrb[2];
        { const int lz_ = tid - 256;
#pragma unroll
          for (int e = 0; e < 4; ++e) { const int gi = lz_ + 256 * e, key = gi >> 5, cg = gi & 31; glb[e] = (unsigned)(key * KVR + cg * 8) * 4u;
#pragma unroll
              for (int hh = 0; hh < 2; ++hh) llb[e][hh] = (unsigned)((cg >> 4) * 16384 + sa_off(key + 32 * hh, cg & 15)); }
          grb = (unsigned)((lz_ >> 3) * ROPE + (lz_ & 7) * 8) * 4u;
#pragma unroll
          for (int hh = 0; hh < 2; ++hh) lrb[hh] = (unsigned)(SA_KR + ((lz_ >> 3) + 32 * hh) * 144 + (lz_ & 7) * 16); }
        f32x4 s0[10], s1[10], s2[10], s3[10];
        SA_LOAD(s0, 0); SA_LOAD(s1, 1); SA_LOAD(s2, 2); SA_LOAD(s3, 3);
        SA_WRITE(s0, 0, 0); SA_LOAD(s0, 4); SA_WRITE(s1, 0, 1); SA_LOAD(s1, 5);
        SA_BAR();
        for (int j = 0; j < 62; j += 2) {
            SA_LOADER(j, s2, s3, SA_BUF);
            SA_BAR();
            SA_LOADER(j + 1, s0, s1, 0);
            SA_BAR();
        }
        SA_LOADER(62, s2, s3, SA_BUF);
        SA_BAR();
        SA_TAIL64(0);
        SA_BAR();
        if (half == 1) SA_BAR();
        SA_BAR();
    }
#undef SA_BAR
#undef SA_LOAD
#undef SA_WRITE
#undef SA_COMPUTE
#undef SA_KLD
#undef SA_VLD
#undef SA_VMM
#undef SA_LOADER
#undef SA_TAIL64

    float* parto = (float*)(ws + WS_PART) + (size_t)(b * 2 + half) * 64 * 128;
    __syncthreads();
    { bf16x8 ao[16];
#pragma unroll
      for (int ks = 0; ks < 16; ++ks) { u32x4 z = {0u, 0u, 0u, 0u}; if (r32 < DS) z = *(const LAS u32x4*)(lds + SA_OI + (r32 * 8 + wave) * SA_QI_PITCH + (16 * ks + 8 * g) * 2); ao[ks] = __builtin_bit_cast(bf16x8, z); }
      const bf16_t* wv = (const bf16_t*)(ws + WS_WUVP) + (size_t)(wave * VD + r32) * KVR + 8 * g;
#pragma unroll 2
      for (int nt = 0; nt < 4; ++nt) {
          f32x16 acc;
#pragma unroll
          for (int i = 0; i < 16; ++i) acc[i] = 0.f;
#pragma unroll
          for (int ks = 0; ks < 16; ++ks) acc = __builtin_amdgcn_mfma_f32_32x32x16_bf16(ao[ks], *(const bf16x8*)(wv + (size_t)(32 * nt) * KVR + 16 * ks), acc, 0, 0, 0);
#pragma unroll
          for (int i = 0; i < 4; ++i) parto[(size_t)((i + 4 * g) * 8 + wave) * 128 + 32 * nt + r32] = acc[i];
      } }
}

template <int W>
__device__ __forceinline__ void pool_chunk(const float* __restrict__ xr, int rvb, f32x4 gn, int col, int t0, bf16_t* __restrict__ drow) {
    f32x4 ring[W - 1]; f32x4 sum = {0.f, 0.f, 0.f, 0.f};
#pragma unroll
    for (int i = W - 1; i >= 1; --i) { f32x4 u = {0.f, 0.f, 0.f, 0.f};
        if (t0 - i >= 0) u = *(const f32x4*)(xr - (size_t)i * D + col) * __builtin_bit_cast(float, __builtin_amdgcn_readlane(rvb, 15 - i));
        ring[(W - 1 - i) % (W - 1)] = u; sum += u; }
#pragma unroll
    for (int r = 0; r < 16; ++r) {
        const f32x4 u = *(const f32x4*)(xr + (size_t)r * D + col) * __builtin_bit_cast(float, __builtin_amdgcn_readlane(rvb, 15 + r));
        sum += u;
        const int t = t0 + r; const float icnt = 1.0f / (float)((t + 1) < W ? (t + 1) : W);
        const f32x4 dd = (sum * icnt - u) * gn;
        u32x2 o; o.x = pk2(dd.x, dd.y); o.y = pk2(dd.z, dd.w);
        *(u32x2*)(drow + (size_t)r * D + col) = o;
        sum -= ring[r % (W - 1)]; ring[r % (W - 1)] = u;
    }
}
constexpr int NPH = 17;
__global__ void __launch_bounds__(512, 2) yoco_fwd(Params P) {
    extern __shared__ __attribute__((aligned(16))) unsigned char lds_raw[];
    LAS unsigned char* lds = (LAS unsigned char*)lds_raw;
    volatile LAS unsigned* MISC = (volatile LAS unsigned*)(lds + MISC_OFF);
    const int tid = threadIdx.x, lane = tid & 63, wave = __builtin_amdgcn_readfirstlane(tid >> 6);
    const int G = gridDim.x; const int bx = blockIdx.x; const int vcu = (G % 8 == 0) ? (bx % 8) * (G / 8) + bx / 8 : bx;
    unsigned char* ws = P.ws; float* out = P.out;
    for (int u = tid; u < 64; u += 512) MISC[u] = 0u;
    __syncthreads();
    XcdBarrier bar; bar.bar = (unsigned*)(ws + WS_CTL) + CW_BAR; bar.x = 0; bar.st = nullptr;
    if (MK_N_LAUNCHES == 1) bar = xcd_barrier_post((unsigned*)(ws + WS_CTL) + CW_BAR, MISC + 8);
    const int lo = P.ph_lo, hi = P.ph_hi;
#ifndef PH_MASK
#define PH_MASK 0xFFFFFFFFu
#endif
#define IN(k) (((PH_MASK >> (k)) & 1u) && lo <= (k) && (k) < hi)
#define SEAM(k) do { if (IN(k) && IN((k) + 1)) xcd_barrier(bar); } while (0)
#define SEAM2(k, kn) do { if (IN(k) && IN(kn)) xcd_barrier(bar); } while (0)
    const int gw = vcu * 8 + wave, NGW = G * 8;
    const int gtid = vcu * 512 + tid, NGT = G * 512;

#define wpool ((bf16_t*)(ws + WS_WPOOL))
#define wup ((bf16_t*)(ws + WS_WUP))
#define wdown ((bf16_t*)(ws + WS_WDOWN))
#define wgate ((bf16_t*)(ws + WS_WGATE))
#define wproj ((bf16_t*)(ws + WS_WPROJ))
#define wdkvq ((bf16_t*)(ws + WS_WDKVQ))
#define wuq ((bf16_t*)(ws + WS_WUQ))
#define wukt ((bf16_t*)(ws + WS_WUKT))
#define wuvt ((bf16_t*)(ws + WS_WUVT))
#define wukb ((bf16_t*)(ws + WS_WUKB))
#define wo ((bf16_t*)(ws + WS_WO))
#define cs ((float*)(ws + WS_CS))
#define rstd0 ((float*)(ws + WS_RSTD0))
#define dbuf ((bf16_t*)(ws + WS_DBUF))
#define pb ((bf16_t*)(ws + WS_PB))
#define hbA ((bf16_t*)(ws + WS_HBA))
#define hbB ((bf16_t*)(ws + WS_HBB))
#define ssq ((float*)(ws + WS_SSQ))
#define abuf ((bf16_t*)(ws + WS_ABUF))
#define proj ((bf16_t*)(ws + WS_PROJ))
#define craw ((float*)(ws + WS_RAW))
#define ssqc ((float*)(ws + WS_RAW + (size_t)M * KVR * 4))
#define ssqq ((float*)(ws + WS_RAW + (size_t)M * KVR * 4 + (size_t)M * 16))
#define cb ((bf16_t*)(ws + WS_CB))
#define krbs ((bf16_t*)(ws + WS_KRBS))
#define cqb ((bf16_t*)(ws + WS_CQB))
#define qbuf ((bf16_t*)(ws + WS_QBUF))
#define qs ((bf16_t*)(ws + WS_QS))
#define kfull ((bf16_t*)(ws + WS_KFULL))
#define vt ((bf16_t*)(ws + WS_VT))
#define obuf ((bf16_t*)(ws + WS_OBUF))
    constexpr size_t SSQ_V = (size_t)M * 16;

    if (IN(0)) {
        LAS float* scr = (LAS float*)(lds + wave * 16384);
        int it = gw;
#define TI(W_, ks_, K_, N_, WT_, ro_) { const int n_items = ((K_) / 64) * ((N_) / 32); for (; it < n_items; it += NGW) transpose_item(W_, ks_, K_, N_, WT_, ro_, scr, it, lane); it -= n_items; }
        TI(P.in[I_POOLW] + 0 * 65536, nullptr, 256, 256, wpool, 0) TI(P.in[I_POOLW] + 1 * 65536, nullptr, 256, 256, wpool, 256)
        TI(P.in[I_POOLW] + 2 * 65536, nullptr, 256, 256, wpool, 512) TI(P.in[I_POOLW] + 3 * 65536, nullptr, 256, 256, wpool, 768)
        TI(P.in[I_WUP], P.in[I_NMLP], D, FF, wup, 0) TI(P.in[I_WUP] + (size_t)D * FF, P.in[I_NMLP] + D, D, FF, wup + (size_t)FF * D, 0)
        TI(P.in[I_WDOWN], nullptr, FF, D, wdown, 0) TI(P.in[I_WDOWN] + (size_t)D * FF, nullptr, FF, D, wdown + (size_t)FF * D, 0)
        TI(P.in[I_WGATE], P.in[I_NPLE], D, D, wgate, 0) TI(P.in[I_WGATE] + (size_t)D * D, P.in[I_NPLE] + D, D, D, wgate + (size_t)D * D, 0)
        TI(P.in[I_WPROJ], nullptr, PLE, D, wproj, 0) TI(P.in[I_WPROJ] + (size_t)PLE * D, nullptr, PLE, D, wproj + (size_t)PLE * D, 0)
        { const int n_items = (D / 64) * (320 / 32); for (; it < n_items; it += NGW) transpose_item<2>(P.in[I_WDKV], P.in[I_NKV], D, 320, wdkvq, 0, scr, it, lane); it -= n_items; }
        TI(P.in[I_WDQ], P.in[I_NMIX] + D, D, QR, wdkvq, 320)
        { const int n_items = (QR / 64) * (NH * QH / 32); for (; it < n_items; it += NGW) transpose_item<1>(P.in[I_WUQ], P.in[I_QN], QR, NH * QH, wuq, 0, scr, it, lane); it -= n_items; }
        TI(P.in[I_WUK], P.in[I_KVN], KVR, 1024, wukt, 0) TI(P.in[I_WUV], P.in[I_KVN], KVR, 1024, wuvt, 0) TI(P.in[I_WUV], nullptr, KVR, 1024, (bf16_t*)(ws + WS_WUVP), 0)
        TI(P.in[I_WO], nullptr, D, D, wo, 0)
#undef TI
        for (int i = gtid; i < 64 * D / 8; i += NGT) *(u32x4*)(wdkvq + (size_t)704 * D + (size_t)i * 8) = (u32x4){0u, 0u, 0u, 0u};
        for (int i = gtid; i < 256 * 1024 / 8; i += NGT) { const f32x4 a = *(const f32x4*)(P.in[I_WUK] + (size_t)i * 8), c = *(const f32x4*)(P.in[I_WUK] + (size_t)i * 8 + 4); *(bf16x8*)(wukb + (size_t)i * 8) = pack8v(a, c); }
        for (int i = gtid; i < NPOS * 32; i += NGT) { const int pos = i >> 5, f = i & 31; const double inv = exp2(-(double)f * (13.287712379549449 / 32.0)); const double ang = (double)pos * inv;
            double sn, cn; sincos(ang, &sn, &cn); cs[(size_t)pos * 64 + f] = (float)cn; cs[(size_t)pos * 64 + 32 + f] = (float)sn; }
        for (int i = gtid; i < 2 * M * PLE / 8; i += NGT) { const int li = i / (M * PLE / 8), r8 = i % (M * PLE / 8); const size_t e = (size_t)r8 * 8; const int row = (int)(e / PLE), c = (int)(e % PLE);
            const float* src = row < MP ? P.in[I_PP] + ((size_t)li * MP + row) * PLE + c : P.in[I_PS] + ((size_t)li * MS + (row - MP)) * PLE + c;
            *(bf16x8*)(pb + ((size_t)li * M + row) * PLE + c) = pack8v(*(const f32x4*)src, *(const f32x4*)(src + 4)); }
        for (int row0 = gw; row0 < M; row0 += 2 * NGW) {
            f32x4 v[2][4];
#pragma unroll
            for (int rr = 0; rr < 2; ++rr) { const int row = row0 + rr * NGW; if (row < M) { const float* xr = row < MP ? P.in[I_XP] + (size_t)row * D : P.in[I_XS] + (size_t)(row - MP) * D;
#pragma unroll
                for (int j = 0; j < 4; ++j) v[rr][j] = ((const f32x4*)xr)[lane + 64 * j]; } }
#pragma unroll
            for (int rr = 0; rr < 2; ++rr) { const int row = row0 + rr * NGW; if (row < M) {
                float s = 0.f;
#pragma unroll
                for (int j = 0; j < 4; ++j) s += (v[rr][j].x * v[rr][j].x + v[rr][j].y * v[rr][j].y) + (v[rr][j].z * v[rr][j].z + v[rr][j].w * v[rr][j].w);
                const float rstd = 1.0f / sqrtf(wave_sum(s) * (1.0f / D) + EPS);
                if (lane == 0) rstd0[row] = rstd;
                float* po = nullptr;
                if (row < MP) { const int b = row >> 13, t = row & (SEQ - 1); if (t >= SEQ - 15) po = out + O_PP + ((size_t)b * 15 + (t - (SEQ - 15))) * D; }
                else { const int rs_ = row - MP, b = rs_ >> 3, t = rs_ & 7; po = out + O_PS + ((size_t)b * 15 + 7 + t) * D; }
                if (po) {
#pragma unroll
                    for (int j = 0; j < 4; ++j) { const f32x4 gn = ((const f32x4*)P.in[I_NMIX])[lane + 64 * j]; ((f32x4*)po)[lane + 64 * j] = v[rr][j] * rstd * gn; } }
            } }
        }
        for (int i = gtid; i < DB * 7 * D / 4; i += NGT) { const int b = i / (7 * D / 4), r = (i / (D / 4)) % 7, c = i % (D / 4);
            ((f32x4*)(out + O_PS + ((size_t)b * 15 + r) * D))[c] = ((const f32x4*)(P.in[I_SPOOL] + ((size_t)b * 15 + 8 + r) * D))[c]; }
    }
    SEAM2(0, 2);
    if (IN(2)) {
#ifndef SUBM
#define SUBM 7
#endif
        { SgH<0> E{P.in[I_XS], P.in[I_POOLSC], nullptr, nullptr, nullptr, hbA, ssq + 0 * SSQ_V};
          for (int u = vcu; u < 256; u += G) {
              const int mt = u >> 4, gq = (u & 15) >> 2, w = 2 << gq, col = 256 * gq + 4 * lane, bs = mt * 8 + wave;
              const float* sp = P.in[I_SPOOL] + (size_t)bs * 15 * D; const float* xs0 = P.in[I_XS] + (size_t)(bs * DS) * D;
              const float rv = (lane < DS) ? rstd0[MP + bs * DS + lane] : 0.f;
              const f32x4 gn = *(const f32x4*)(P.in[I_NMIX] + col);
#pragma unroll
              for (int t = 0; t < DS; ++t) {
                  const f32x4 u0 = *(const f32x4*)(xs0 + (size_t)t * D + col) * __shfl(rv, t); f32x4 sum = u0, hist = {0.f, 0.f, 0.f, 0.f};
#pragma unroll
                  for (int i = 1; i < 16; ++i) if (i < w) { const int tt = t - i;
                      if (tt >= 0) sum += *(const f32x4*)(xs0 + (size_t)tt * D + col) * __shfl(rv, tt >= 0 ? tt : 0);
                      else hist += *(const f32x4*)(sp + (size_t)(15 + tt) * D + col); }
                  const f32x4 dd = (sum * gn + hist) / (float)w - u0 * gn;
                  u32x2 o; o.x = pk2(dd.x, dd.y); o.y = pk2(dd.z, dd.w);
                  *(u32x2*)(dbuf + (size_t)(MP + bs * DS + t) * D + col) = o;
              }
              asm volatile("s_waitcnt vmcnt(0)" ::: "memory"); __syncthreads();
              sk_gemm(lds, dbuf + (size_t)(MP + 64 * mt) * D + 256 * gq, D, wpool + (size_t)(64 * (u & 15)) * 256, 256, 64 * mt, 64 * (u & 15), u & 15, E, tid, wave, lane); } }
        { SgBf E{proj, D};
          for (int u = vcu; u < 256; u += G) sk_gemm(lds, pb + (size_t)(MP + 64 * (u >> 4)) * PLE, PLE, wproj + (size_t)(64 * (u & 15)) * PLE, PLE, 64 * (u >> 4), 64 * (u & 15), u & 15, E, tid, wave, lane); }
        { SgBf E{proj + (size_t)M * D, D};
          for (int u = vcu; u < 256; u += G) sk_gemm(lds, pb + (size_t)(M + MP + 64 * (u >> 4)) * PLE, PLE, wproj + (size_t)PLE * D + (size_t)(64 * (u & 15)) * PLE, PLE, 64 * (u >> 4), 64 * (u & 15), u & 15, E, tid, wave, lane); }
        if (SUBM & 1) { pg8::Gemm g{dbuf, wpool, MP, D, 256, D, 256}; pg8::StaticOrder S; S.init(MP, D, G, bx);
          {
            pg8::Unit uu;
            for (int i = 0; S.next(i, uu); ++i) {
#pragma unroll 1
                for (int cc = 0; cc < 2; ++cc) {
                    const int row0 = uu.pm * 256 + (2 * wave + cc) * 16, t0 = row0 & (SEQ - 1), col = 256 * uu.pn + 4 * lane;
                    const float rv = (lane < 31 && t0 - 15 + lane >= 0) ? rstd0[row0 - 15 + lane] : 0.f;
                    const int rvb = __builtin_bit_cast(int, rv);
                    const float* xr = P.in[I_XP] + (size_t)row0 * D; bf16_t* dr = dbuf + (size_t)row0 * D; const f32x4 gn = *(const f32x4*)(P.in[I_NMIX] + col);
                    if (uu.pn == 0) pool_chunk<2>(xr, rvb, gn, col, t0, dr); else if (uu.pn == 1) pool_chunk<4>(xr, rvb, gn, col, t0, dr);
                    else if (uu.pn == 2) pool_chunk<8>(xr, rvb, gn, col, t0, dr); else pool_chunk<16>(xr, rvb, gn, col, t0, dr);
                } }
            asm volatile("s_waitcnt vmcnt(0)" ::: "memory"); __syncthreads(); }
          EpiH<0> E{P.in[I_XP], P.in[I_XS], P.in[I_POOLSC], nullptr, nullptr, nullptr, hbA, ssq + 0 * SSQ_V};
          pg8::gemm_phase(lds, g, S, E); }
        if (SUBM & 2) { pg8::Gemm g{pb, wproj, MP, D, PLE, PLE, 0}; pg8::StaticOrder S; S.init(MP, D, G, bx);
          EpiBf E{proj, D};
          pg8::gemm_phase(lds, g, S, E); }
        if (SUBM & 4) { pg8::Gemm g{pb + (size_t)M * PLE, wproj + (size_t)PLE * D, MP, D, PLE, PLE, 0}; pg8::StaticOrder S; S.init(MP, D, G, bx);
          EpiBf E{proj + (size_t)M * D, D};
          pg8::gemm_phase(lds, g, S, E); }
    }
    SEAM(2);
    if (IN(3)) {
        { SgUp E{ssq + 0 * SSQ_V, abuf}; for (int u = vcu; u < 1024; u += G) sk_gemm(lds, hbA + (size_t)(MP + 64 * (u & 15)) * D, D, wup + (size_t)(64 * (u >> 4)) * D, D, 64 * (u & 15), 64 * (u >> 4), 0, E, tid, wave, lane); }
        pg8::Gemm g{hbA, wup, MP, FF, D, D, 0}; pg8::StaticOrder S; S.init(MP, FF, G, bx); EpiUp E{ssq + 0 * SSQ_V, abuf}; pg8::gemm_phase(lds, g, S, E); }
    SEAM(3);
    if (IN(4)) {
        { SgH<1> E{nullptr, nullptr, nullptr, nullptr, hbA, hbB, ssq + 1 * SSQ_V}; for (int u = vcu; u < 256; u += G) sk_gemm(lds, abuf + (size_t)(MP + 64 * (u >> 4)) * FF, FF, wdown + (size_t)(64 * (u & 15)) * FF, FF, 64 * (u >> 4), 64 * (u & 15), u & 15, E, tid, wave, lane); }
        pg8::Gemm g{abuf, wdown, MP, D, FF, FF, 0}; pg8::StaticOrder S; S.init(MP, D, G, bx);
        EpiH<1> E{nullptr, nullptr, nullptr, nullptr, nullptr, hbA, hbB, ssq + 1 * SSQ_V}; pg8::gemm_phase(lds, g, S, E); }
    SEAM(4);
    if (IN(5)) {
        { SgH<2> E{nullptr, nullptr, ssq + 1 * SSQ_V, proj, hbB, hbA, ssq + 2 * SSQ_V}; for (int u = vcu; u < 256; u += G) sk_gemm(lds, hbB + (size_t)(MP + 64 * (u >> 4)) * D, D, wgate + (size_t)(64 * (u & 15)) * D, D, 64 * (u >> 4), 64 * (u & 15), u & 15, E, tid, wave, lane); }
        pg8::Gemm g{hbB, wgate, MP, D, D, D, 0}; pg8::StaticOrder S; S.init(MP, D, G, bx);
        EpiH<2> E{nullptr, nullptr, nullptr, ssq + 1 * SSQ_V, proj, hbB, hbA, ssq + 2 * SSQ_V}; pg8::gemm_phase(lds, g, S, E); }
    SEAM(5);
    if (IN(6)) {
        pg8::Gemm g{hbA, wdkvq, M, NDKVQ, D, D, 0}; pg8::StaticOrder S; S.init(M, NDKVQ, G, bx); EpiDkvq E{ssq + 2 * SSQ_V, cs, craw, cb, cqb, ssqc, ssqq, out, kfull, krbs}; pg8::gemm_phase(lds, g, S, E); }
    SEAM2(6, 8);
    if (IN(8)) {
        if (SUBM & 1) { pg8::Gemm g{cqb, wuq, M, NH * QH, QR, QR, 0}; pg8::StaticOrder S; S.init(M, NH * QH, G, bx); EpiQ E{ssqq, cs, qbuf, qs}; pg8::gemm_phase(lds, g, S, E); }
        if (SUBM & 2) { pg8::Gemm g{cb, wukt, MP, 1024, KVR, KVR, 0}; pg8::StaticOrder S; S.init(MP, 1024, G, (bx + 128) % G); EpiKup E{kfull, ssqc}; pg8::gemm_phase(lds, g, S, E); }
        if (SUBM & 4) { pg8::Gemm g{wuvt, cb, 1024, MP, KVR, KVR, 0}; pg8::StaticOrder S; S.init(1024, MP, G, (bx + 128) % G); EpiVup E{vt, ssqc}; pg8::gemm_phase(lds, g, S, E); }
        { const f32x4 kvn = ((const f32x4*)P.in[I_KVN])[lane];
          for (int row0 = 2 * gw; row0 < M; row0 += 2 * NGW) {
              f32x4 c4[2], p4[2];
#pragma unroll
              for (int e = 0; e < 2; ++e) { c4[e] = ((const f32x4*)(craw + (size_t)(row0 + e) * KVR))[lane]; p4[e] = *(const f32x4*)(ssqc + (size_t)(row0 + e) * 4); }
#pragma unroll
              for (int e = 0; e < 2; ++e) { const int row = row0 + e; const bool isp = row < MP;
                  const float rc = 1.0f / sqrtf(((p4[e].x + p4[e].y) + (p4[e].z + p4[e].w)) * (1.0f / KVR) + EPS);
                  const f32x4 cn = c4[e] * rc * kvn;
                  float* lo_ = isp ? out + O_LP + (size_t)row * KVR : out + O_LS + (size_t)(row - MP) * KVR;
                  ((f32x4*)lo_)[lane] = cn;
                  if (!isp) { u32x2 o; o.x = pk2(cn.x, cn.y); o.y = pk2(cn.z, cn.w); ((u32x2*)(cb + (size_t)row * KVR))[lane] = o; } } } }
    }
    SEAM2(8, 10);
    if (IN(10)) {
        const bool sfirst = (bx >> 3) & 1;
        if (sfirst) for (int it = vcu; it < 2 * DB; it += G) sattn_item(P, it >> 1, it & 1, lds, tid, wave, lane);
        for (int u = vcu; u < 256; u += G) {
            const int bh = u >> 4, p = u & 15;
            attn_prompt_unit(qbuf, kfull, vt, obuf, bh >> 3, bh & 7, 31 - p, lds, tid, wave, lane);
            attn_prompt_unit(qbuf, kfull, vt, obuf, bh >> 3, bh & 7, p, lds, tid, wave, lane);
        }
        if (!sfirst) for (int it = vcu; it < 2 * DB; it += G) sattn_item(P, it >> 1, it & 1, lds, tid, wave, lane);
    }
    SEAM2(10, 12);
    if (IN(12)) {
        { SgH<1> E{nullptr, nullptr, nullptr, nullptr, hbA, hbB, ssq + 3 * SSQ_V}; const SgALoadComb AL{(const float*)(ws + WS_PART), (const float*)(ws + WS_ML)};
          for (int u = vcu; u < 256; u += G) sg_gemm_l<4, 1>(lds, AL, 0, wo, D, u, E, tid, wave, lane); }
        pg8::Gemm g{obuf, wo, MP, D, D, D, 0}; pg8::StaticOrder S; S.init(MP, D, G, bx);
        EpiH<1> E{nullptr, nullptr, nullptr, nullptr, nullptr, hbA, hbB, ssq + 3 * SSQ_V}; pg8::gemm_phase(lds, g, S, E); }
    SEAM(12);
    if (IN(13)) {
        { SgUp E{ssq + 3 * SSQ_V, abuf}; for (int u = vcu; u < 1024; u += G) sk_gemm(lds, hbB + (size_t)(MP + 64 * (u & 15)) * D, D, wup + (size_t)FF * D + (size_t)(64 * (u >> 4)) * D, D, 64 * (u & 15), 64 * (u >> 4), 0, E, tid, wave, lane); }
        pg8::Gemm g{hbB, wup + (size_t)FF * D, MP, FF, D, D, 0}; pg8::StaticOrder S; S.init(MP, FF, G, bx); EpiUp E{ssq + 3 * SSQ_V, abuf}; pg8::gemm_phase(lds, g, S, E); }
    SEAM(13);
    if (IN(14)) {
        { SgH<1> E{nullptr, nullptr, nullptr, nullptr, hbB, hbA, ssq + 4 * SSQ_V}; for (int u = vcu; u < 256; u += G) sk_gemm(lds, abuf + (size_t)(MP + 64 * (u >> 4)) * FF, FF, wdown + (size_t)FF * D + (size_t)(64 * (u & 15)) * FF, FF, 64 * (u >> 4), 64 * (u & 15), u & 15, E, tid, wave, lane); }
        pg8::Gemm g{abuf, wdown + (size_t)FF * D, MP, D, FF, FF, 0}; pg8::StaticOrder S; S.init(MP, D, G, bx);
        EpiH<1> E{nullptr, nullptr, nullptr, nullptr, nullptr, hbB, hbA, ssq + 4 * SSQ_V}; pg8::gemm_phase(lds, g, S, E); }
    SEAM(14);
    if (IN(15)) {
        { SgH<2> E{nullptr, nullptr, ssq + 4 * SSQ_V, proj + (size_t)M * D, hbA, hbB, ssq + 5 * SSQ_V}; for (int u = vcu; u < 256; u += G) sk_gemm(lds, hbA + (size_t)(MP + 64 * (u >> 4)) * D, D, wgate + (size_t)D * D + (size_t)(64 * (u & 15)) * D, D, 64 * (u >> 4), 64 * (u & 15), u & 15, E, tid, wave, lane); }
        pg8::Gemm g{hbA, wgate + (size_t)D * D, MP, D, D, D, 0}; pg8::StaticOrder S; S.init(MP, D, G, bx);
        EpiH<2> E{nullptr, nullptr, nullptr, ssq + 4 * SSQ_V, proj + (size_t)M * D, hbA, hbB, ssq + 5 * SSQ_V}; pg8::gemm_phase(lds, g, S, E); }
    SEAM(15);
    if (IN(16)) {
        f32x4 gn[4];
#pragma unroll
        for (int j = 0; j < 4; ++j) gn[j] = ((const f32x4*)P.in[I_NFIN])[lane + 64 * j];
        for (int row0 = 4 * gw; row0 < M; row0 += 4 * NGW) {
            u32x2 hv[4][4]; float sp[4];
#pragma unroll
            for (int e = 0; e < 4; ++e) { sp[e] = (lane < 16) ? ssq[5 * SSQ_V + (size_t)(row0 + e) * 16 + lane] : 0.f;
#pragma unroll
                for (int j = 0; j < 4; ++j) hv[e][j] = ((const u32x2*)(hbB + (size_t)(row0 + e) * D))[lane + 64 * j]; }
#pragma unroll
            for (int e = 0; e < 4; ++e) { const float rstd = 1.0f / sqrtf(wave_sum(sp[e]) * (1.0f / D) + EPS);
#pragma unroll
                for (int j = 0; j < 4; ++j) ((f32x4*)(out + O_Y + (size_t)(row0 + e) * D))[lane + 64 * j] = unpk4(hv[e][j]) * rstd * gn[j]; }
        }
    }
#undef IN
#undef SEAM
#undef SEAM2
#undef wpool
#undef wup
#undef wdown
#undef wgate
#undef wproj
#undef wdkvq
#undef wuq
#undef wukt
#undef wuvt
#undef wukb
#undef wo
#undef cs
#undef rstd0
#undef dbuf
#undef pb
#undef hbA
#undef hbB
#undef ssq
#undef abuf
#undef proj
#undef craw
#undef ssqc
#undef ssqq
#undef cb
#undef krbs
#undef cqb
#undef qbuf
#undef qs
#undef kfull
#undef vt
#undef obuf
}

extern "C" void kernel_launch(void* const* d_in, const int* in_sizes, int n_in, void* d_out, int out_size, void* d_ws, size_t ws_size, hipStream_t stream) {
    static int grid = 0;
    if (grid == 0) {
        if (n_in != 27 || (size_t)out_size != O_END || ws_size < WS_END) { fprintf(stderr, "kernel_launch: shape mismatch (n_in %d, out %d, ws %zu; need 27, %zu, %zu)\n", n_in, out_size, ws_size, (size_t)O_END, (size_t)WS_END); grid = -1; return; }
        int dev = 0, cus = 0, per_cu = 0;
        if (hipGetDevice(&dev) != hipSuccess || hipDeviceGetAttribute(&cus, hipDeviceAttributeMultiprocessorCount, dev) != hipSuccess) { grid = -1; return; }
        if (hipFuncSetAttribute((const void*)yoco_fwd, hipFuncAttributeMaxDynamicSharedMemorySize, LDS_BYTES) != hipSuccess) { fprintf(stderr, "kernel_launch: hipFuncSetAttribute failed\n"); grid = -1; return; }
        if (hipOccupancyMaxActiveBlocksPerMultiprocessor(&per_cu, (const void*)yoco_fwd, 512, LDS_BYTES) != hipSuccess || per_cu < 1) fprintf(stderr, "kernel_launch: occupancy query reports %d\n", per_cu);
        (void)hipGetLastError();
        grid = cus;
    }
    if (grid < 0) return;
    (void)hipMemsetAsync((char*)d_ws + WS_CTL, 0, CTL_BYTES, stream);
    Params p{};
    for (int i = 0; i < 27; ++i) p.in[i] = (const float*)d_in[i];
    p.out = (float*)d_out; p.ws = (unsigned char*)d_ws;
#if MK_N_LAUNCHES == 1
    p.ph_lo = 0; p.ph_hi = NPH;
    hipLaunchKernelGGL(yoco_fwd, dim3(grid), dim3(512), LDS_BYTES, stream, p);
#else
    for (int k = 0; k < NPH; ++k) { p.ph_lo = k; p.ph_hi = k + 1; hipLaunchKernelGGL(yoco_fwd, dim3(grid), dim3(512), LDS_BYTES, stream, p); }
#endif
    const hipError_t le = hipPeekAtLastError();
    if (le != hipSuccess) fprintf(stderr, "kernel_launch: launch failed: %s\n", hipGetErrorName(le));
}
```

```cpp
#include <hip/hip_runtime.h>
#include <cstdio>
#include <cstdint>

#ifndef MK_N_LAUNCHES
#define MK_N_LAUNCHES 1
#endif

#define GAS __attribute__((address_space(1)))
#define LAS __attribute__((address_space(3)))
typedef unsigned short bf16_t;
typedef short bf16x8 __attribute__((ext_vector_type(8)));
typedef float f32x4 __attribute__((ext_vector_type(4)));
typedef float f32x16 __attribute__((ext_vector_type(16)));
typedef unsigned u32x2 __attribute__((ext_vector_type(2)));
typedef unsigned u32x4 __attribute__((ext_vector_type(4)));

constexpr int D = 1024, FF = 4096, PLE = 256, SEQ = 8192, NBATCH = 2, DB = 128, DS = 8;
constexpr int MP = NBATCH * SEQ;
constexpr int MS = DB * DS;
constexpr int M = MP + MS;
constexpr int KVR = 256, ROPE = 64, QR = 384, NH = 8, NOPE = 128, VD = 128, QH = NOPE + ROPE;
constexpr int NDKVQ = 768;
constexpr int PAST = 8192, PAGE = 128, NPG = PAST / PAGE;
constexpr float EPS = 1e-6f;
constexpr float SM_SCALE = 0.07216878364870322f;
constexpr float LOG2E = 1.4426950408889634f;
constexpr float CEXP = SM_SCALE * LOG2E;
constexpr int NPOS = PAST + DS;

constexpr size_t O_Y = 0;
constexpr size_t O_PP = (size_t)M * D;
constexpr size_t O_PS = O_PP + (size_t)NBATCH * 15 * D;
constexpr size_t O_LP = O_PS + (size_t)DB * 15 * D;
constexpr size_t O_KP = O_LP + (size_t)MP * KVR;
constexpr size_t O_LS = O_KP + (size_t)MP * ROPE;
constexpr size_t O_KS = O_LS + (size_t)MS * KVR;
constexpr size_t O_END = O_KS + (size_t)MS * ROPE;

constexpr size_t al256(size_t x) { return (x + 255) / 256 * 256; }
constexpr size_t WS_CTL = 0, CTL_BYTES = 1u << 20;
constexpr size_t WS_WPOOL = CTL_BYTES;
constexpr size_t WS_WUP   = WS_WPOOL + al256((size_t)1024 * 256 * 2);
constexpr size_t WS_WDOWN = WS_WUP   + al256((size_t)2 * FF * D * 2);
constexpr size_t WS_WGATE = WS_WDOWN + al256((size_t)2 * FF * D * 2);
constexpr size_t WS_WPROJ = WS_WGATE + al256((size_t)2 * D * D * 2);
constexpr size_t WS_WDKVQ = WS_WPROJ + al256((size_t)2 * D * PLE * 2);
constexpr size_t WS_WUQ   = WS_WDKVQ + al256((size_t)NDKVQ * D * 2);
constexpr size_t WS_WUKT  = WS_WUQ   + al256((size_t)NH * QH * QR * 2);
constexpr size_t WS_WUVT  = WS_WUKT  + al256((size_t)1024 * 256 * 2);
constexpr size_t WS_WUVP  = WS_WUVT  + al256((size_t)1024 * 256 * 2);
constexpr size_t WS_WUKB  = WS_WUVP  + al256((size_t)1024 * 256 * 2);
constexpr size_t WS_WO    = WS_WUKB  + al256((size_t)1024 * 256 * 2);
constexpr size_t WS_CS    = WS_WO    + al256((size_t)D * D * 2);
constexpr size_t WS_RSTD0 = WS_CS    + al256((size_t)NPOS * 64 * 4);
constexpr size_t WS_DBUF  = WS_RSTD0 + al256((size_t)M * 4);
constexpr size_t WS_PB    = WS_DBUF  + al256((size_t)M * D * 2);
constexpr size_t WS_HBA   = WS_PB    + al256((size_t)2 * M * PLE * 2);
constexpr size_t WS_HBB   = WS_HBA   + al256((size_t)M * D * 2);
constexpr size_t WS_SSQ   = WS_HBB   + al256((size_t)M * D * 2);
constexpr size_t WS_ABUF  = WS_SSQ   + al256((size_t)6 * M * 16 * 4);
constexpr size_t WS_PROJ  = WS_ABUF  + al256((size_t)M * FF * 2);
constexpr size_t WS_RAW   = WS_PROJ  + al256((size_t)2 * M * D * 2);
constexpr size_t WS_CB    = WS_RAW   + al256((size_t)M * NDKVQ * 4);
constexpr size_t WS_KRBS  = WS_CB    + al256((size_t)M * KVR * 2);
constexpr size_t WS_CQB   = WS_KRBS  + al256((size_t)MS * ROPE * 2);
constexpr size_t WS_RSTDQ = WS_CQB   + al256((size_t)M * QR * 2);
constexpr size_t WS_QBUF  = WS_RSTDQ + al256((size_t)M * 4);
constexpr size_t WS_QS    = WS_QBUF  + al256((size_t)M * NH * QH * 2);
constexpr size_t WS_KFULL = WS_QS    + al256((size_t)MS * NH * 320 * 2);
constexpr size_t WS_VT    = WS_KFULL + al256((size_t)16 * SEQ * QH * 2);
constexpr size_t WS_OBUF  = WS_VT    + al256((size_t)16 * VD * SEQ * 2);
constexpr size_t WS_PART  = WS_OBUF  + al256((size_t)M * D * 2);
constexpr size_t WS_ML    = WS_PART  + al256((size_t)DB * 8 * 64 * 256 * 4);
constexpr size_t WS_END   = WS_ML    + al256((size_t)DB * 8 * 64 * 2 * 4);

constexpr int CW_BAR = 4096;

constexpr int RING_BYTES = 131072;
constexpr int LDS_BYTES = 147456;
constexpr int MISC_OFF = LDS_BYTES - 256;

typedef float f32x2 __attribute__((ext_vector_type(2)));
typedef __bf16 nbf16x2 __attribute__((ext_vector_type(2)));
__device__ __forceinline__ unsigned pk2(float lo, float hi) { const f32x2 v = {lo, hi}; return __builtin_bit_cast(unsigned, __builtin_convertvector(v, nbf16x2)); }
__device__ __forceinline__ unsigned f2bf(float f) { return pk2(f, 0.f) & 0xffffu; }
__device__ __forceinline__ float bf2f(unsigned short b) { return __builtin_bit_cast(float, ((unsigned)b) << 16); }
__device__ __forceinline__ f32x4 unpk4(u32x2 w) { f32x4 r; r.x = __builtin_bit_cast(float, w.x << 16); r.y = __builtin_bit_cast(float, w.x & 0xffff0000u); r.z = __builtin_bit_cast(float, w.y << 16); r.w = __builtin_bit_cast(float, w.y & 0xffff0000u); return r; }
__device__ __forceinline__ bf16x8 pack8(const float* v) { u32x4 w; w.x = pk2(v[0], v[1]); w.y = pk2(v[2], v[3]); w.z = pk2(v[4], v[5]); w.w = pk2(v[6], v[7]); return __builtin_bit_cast(bf16x8, w); }
__device__ __forceinline__ bf16x8 pack8v(f32x4 a, f32x4 b) { u32x4 w; w.x = pk2(a.x, a.y); w.y = pk2(a.z, a.w); w.z = pk2(b.x, b.y); w.w = pk2(b.z, b.w); return __builtin_bit_cast(bf16x8, w); }
__device__ __forceinline__ float wave_sum(float v) {
#pragma unroll
    for (int o = 1; o < 64; o <<= 1) v += __shfl_xor(v, o);
    return v;
}
__device__ __forceinline__ int crow(int r, int hi) { return (r & 3) + 8 * (r >> 2) + 4 * hi; }
#define LDS_WAIT() asm volatile("s_waitcnt lgkmcnt(0)" ::: "memory")
#define VM_WAIT() asm volatile("s_waitcnt vmcnt(0)" ::: "memory")

#define XB_TMO      128
#define XB_XCNT(j)  (256  + 64 * (j))
#define XB_XSUB(j)  (1280 + 64 * (j))
#define XB_XGEN(j)  (2304 + 64 * (j))
#define XB_TOP      3328
#define XB_TOPGEN   3392
#define XCD_BAR_WORDS 3456
#define XB_SPIN_CAP (1u << 18)
__device__ __forceinline__ unsigned xb_ld(unsigned* p)              { return __hip_atomic_load(p, __ATOMIC_RELAXED, __HIP_MEMORY_SCOPE_AGENT); }
__device__ __forceinline__ unsigned xb_add(unsigned* p, unsigned v) { return __hip_atomic_fetch_add(p, v, __ATOMIC_RELAXED, __HIP_MEMORY_SCOPE_AGENT); }
__device__ __forceinline__ unsigned xb_xcc_id() { return (unsigned)__builtin_amdgcn_s_getreg((3 << 11) | 20) & 0xFu; }
#define XB_SPIN(cond, bar) do { unsigned _sp = 0; while (cond) { __builtin_amdgcn_s_sleep(1); \
    if ((++_sp & 255u) == 0u) { if (xb_ld(&(bar)[XB_TMO])) break; if (_sp > XB_SPIN_CAP) { atomicAdd(&(bar)[XB_TMO], 1u); break; } } } } while (0)
struct XcdBarrier { unsigned* bar; unsigned x; volatile LAS unsigned* st; };
__device__ __forceinline__ XcdBarrier xcd_barrier_post(unsigned* bar, volatile LAS unsigned* st) {
    XcdBarrier b; b.bar = bar; b.x = xb_xcc_id(); b.st = st;
    if (threadIdx.x == 0) (void)xb_add(&bar[XB_XCNT(b.x)], 1u);
    return b;
}
__device__ __forceinline__ void xcd_barrier_complete(unsigned* bar, unsigned x, unsigned& nloc, unsigned& nx) {
    const unsigned G = gridDim.x * gridDim.y * gridDim.z;
    unsigned sum, cnt, mine, sp = 0u;
    for (;;) {
        sum = 0u; cnt = 0u; mine = 0u;
#pragma unroll
        for (unsigned j = 0; j < 16; ++j) { const unsigned c = xb_ld(&bar[XB_XCNT(j)]); sum += c; cnt += (c > 0u) ? 1u : 0u; mine = (j == x) ? c : mine; }
        if (sum == G) break;
        __builtin_amdgcn_s_sleep(1);
        if ((++sp & 255u) == 0u) { if (xb_ld(&bar[XB_TMO])) break; if (sp > XB_SPIN_CAP) { atomicAdd(&bar[XB_TMO], 1u); break; } }
    }
    nloc = mine > 0u ? mine : 1u; nx = cnt > 0u ? cnt : 1u;
}
__device__ __forceinline__ void xcd_barrier(const XcdBarrier& b) {
    asm volatile("s_waitcnt vmcnt(0)" ::: "memory");
    __syncthreads();
    if (threadIdx.x == 0) {
        unsigned* bar = b.bar;
        __builtin_amdgcn_s_waitcnt(0);
        unsigned nloc = b.st[0], nx = b.st[1];
        if (nloc == 0u) { xcd_barrier_complete(bar, b.x, nloc, nx); b.st[0] = nloc; b.st[1] = nx; }
        const unsigned old = xb_add(&bar[XB_XSUB(b.x)], 1u);
        const unsigned gen = old / nloc;
        if (old + 1u == (gen + 1u) * nloc) {
            __builtin_amdgcn_fence(__ATOMIC_RELEASE, "agent");
            asm volatile("s_waitcnt vmcnt(0)" ::: "memory");
            const unsigned og = xb_add(&bar[XB_TOP], 1u);
            const unsigned tg = og / nx;
            if (og + 1u == (tg + 1u) * nx) xb_add(&bar[XB_TOPGEN], 1u);
            else XB_SPIN(xb_ld(&bar[XB_TOPGEN]) == tg, bar);
            __builtin_amdgcn_fence(__ATOMIC_ACQUIRE, "agent");
            xb_add(&bar[XB_XGEN(b.x)], 1u);
            asm volatile("s_waitcnt vmcnt(0)" ::: "memory");
        } else {
            XB_SPIN(xb_ld(&bar[XB_XGEN(b.x)]) == gen, bar);
            __builtin_amdgcn_fence(__ATOMIC_ACQUIRE, "agent");
            asm volatile("s_waitcnt vmcnt(0)" ::: "memory");
        }
    }
    __syncthreads();
}

namespace pg8 {
constexpr int BM = 256, BK = 64, HALF = 128, HTB = HALF * BK * 2, STAGE_BYTES = 8 * HTB, NXCD = 8, WGM = 8;
__host__ __device__ __forceinline__ int lds_byte(int r, int c) { const int st = (r >> 4) * 2 + (c >> 5), rr = r & 15, cc = c & 31, ob = rr * 64 + cc * 2; return st * 1024 + (ob ^ (((ob >> 9) & 1) << 5)); }
__host__ __device__ __forceinline__ int perm32(int rho) { const int n = rho >> 4, i = rho & 15; return 8 * (i >> 2) + 4 * n + (i & 3); }
__host__ __device__ __forceinline__ void stage_rc(int b, int& R, int& C) { const int st = b / 1024, sb = b % 1024, swz = sb ^ (((sb >> 9) & 1) << 5); R = (st >> 1) * 16 + swz / 64; C = (st & 1) * 32 + (swz % 64) / 2; }
struct Unit { int pm, pn; };
struct Gemm { const bf16_t* A; const bf16_t* Bt; int M, N, K, lda, apn; };
struct StaticOrder {
    int nM, nN, nwg, G, c;
    __device__ __forceinline__ void init(int M, int N, int G_, int c_) { nM = M / BM; nN = N / BM; nwg = nM * nN; G = G_; c = c_; }
    __device__ __forceinline__ bool next(int i, Unit& u) const {
        const long L = (long)i * G + c; if (L >= nwg) return false;
        int wgid = (int)L; { const int q = nwg / NXCD, r = nwg % NXCD, xcd = wgid % NXCD, off = wgid / NXCD; wgid = (xcd < r ? xcd * (q + 1) : r * (q + 1) + (xcd - r) * q) + off; }
        const int nig = WGM * nN, gid = wgid / nig, fm = gid * WGM, gsz = (nM - fm) < WGM ? (nM - fm) : WGM;
        u.pm = fm + ((wgid % nig) % gsz); u.pn = (wgid % nig) / gsz; return true;
    }
};
template <class Epi>
__device__ __forceinline__ void gemm_phase(LAS unsigned char* lds, const Gemm g, const StaticOrder& S, const Epi& E) {
    const int tid = threadIdx.x, wid = __builtin_amdgcn_readfirstlane(tid >> 6), lane = tid & 63, wr = wid >> 2, wc = wid & 3, fr = lane & 15, fq = lane >> 4;
    const int K = g.K, nt = K / BK, lda = g.lda;
    unsigned voffA[2], voffB[2];
#pragma unroll
    for (int i = 0; i < 2; ++i) { int R, C; stage_rc(tid * 16 + i * 8192, R, C);
        const int Rb = Epi::PERM ? ((R & ~31) + perm32(R & 31)) : R;
        voffA[i] = (unsigned)(R * lda + C) * 2u; voffB[i] = (unsigned)(Rb * K + C) * 2u; }
    const size_t kstep = (size_t)(BK * 2);
    const size_t hstepA = (size_t)HALF * lda * 2, hstepB = (size_t)HALF * K * 2;
    const size_t tstepA = 2 * hstepA, tstepB = 2 * hstepB, pnA = (size_t)g.apn * 2;
    const unsigned ldsw = (unsigned)wid * 1024u;
    const int aoff = lds_byte(wr * 64 + fr, fq * 8), boff = lds_byte(wc * 32 + fr, fq * 8);
#define PG8_SA(b, h) (((b) * 2 + (h)) * HTB)
#define PG8_SB(b, h) ((4 + (b) * 2 + (h)) * HTB)
#define PG8_STAGE(bufoff, gbase, voff) do { _Pragma("unroll") for (int _i = 0; _i < 2; ++_i) \
        __builtin_amdgcn_global_load_lds((const unsigned*)((const char*)(gbase) + (voff)[_i]), (LAS unsigned*)(lds + (bufoff) + ldsw + _i * 8192), 16, 0, 0); } while (0)
#define PG8_LDA(dst, b, h) do { _Pragma("unroll") for (int m = 0; m < 4; ++m) _Pragma("unroll") for (int k = 0; k < 2; ++k) dst[m][k] = *(const LAS bf16x8*)(lds + PG8_SA(b, h) + aoff + m * 2048 + k * 1024); } while (0)
#define PG8_LDB(dst, b, h) do { _Pragma("unroll") for (int n = 0; n < 2; ++n) _Pragma("unroll") for (int k = 0; k < 2; ++k) dst[n][k] = *(const LAS bf16x8*)(lds + PG8_SB(b, h) + boff + n * 2048 + k * 1024); } while (0)
#define PG8_MMA(ai, bj, At, Bt) do { __builtin_amdgcn_s_setprio(1); _Pragma("unroll") for (int m = 0; m < 4; ++m) _Pragma("unroll") for (int n = 0; n < 2; ++n) _Pragma("unroll") for (int k = 0; k < 2; ++k) \
        acc[ai][bj][m][n] = __builtin_amdgcn_mfma_f32_16x16x32_bf16(Bt[n][k], At[m][k], acc[ai][bj][m][n], 0, 0, 0); __builtin_amdgcn_s_setprio(0); } while (0)
#define PG8_WAIT_V(n) asm volatile("s_waitcnt vmcnt(" #n ")" ::: "memory")
#define PG8_WAIT_L(n) asm volatile("s_waitcnt lgkmcnt(" #n ")" ::: "memory")
#define PG8_BAR __builtin_amdgcn_s_barrier()
#define PG8_SCHED __builtin_amdgcn_sched_barrier(0)
    Unit cur, nxt; int ui = 0;
    if (!S.next(0, cur)) return;
    f32x4 acc[2][2][4][2];
#pragma unroll
    for (int a = 0; a < 2; ++a)
#pragma unroll
        for (int b = 0; b < 2; ++b)
#pragma unroll
            for (int m = 0; m < 4; ++m)
#pragma unroll
                for (int n = 0; n < 2; ++n) acc[a][b][m][n] = (f32x4){0.f, 0.f, 0.f, 0.f};
    bf16x8 At[4][2], B0[2][2], B1[2][2];
    const char* cA = (const char*)g.A + (size_t)cur.pm * tstepA + (size_t)cur.pn * pnA; const char* cB = (const char*)g.Bt + (size_t)cur.pn * tstepB;
    PG8_STAGE(PG8_SB(0, 0), cB, voffB); PG8_STAGE(PG8_SB(0, 1), cB + hstepB, voffB); PG8_STAGE(PG8_SA(0, 0), cA, voffA); PG8_STAGE(PG8_SA(0, 1), cA + hstepA, voffA);
    if (wr == 1) PG8_BAR;
    PG8_WAIT_V(2); PG8_BAR;
    PG8_STAGE(PG8_SB(1, 0), cB + kstep, voffB); PG8_STAGE(PG8_SA(1, 0), cA + kstep, voffA); PG8_STAGE(PG8_SB(1, 1), cB + hstepB + kstep, voffB);
    PG8_WAIT_V(6); PG8_BAR;
    for (;;) {
        const bool has_next = S.next(ui + 1, nxt);
        const char* nA = has_next ? (const char*)g.A + (size_t)nxt.pm * tstepA + (size_t)nxt.pn * pnA : cA; const char* nB = has_next ? (const char*)g.Bt + (size_t)nxt.pn * tstepB : cB;
#pragma unroll 1
        for (int t = 0; t < nt; t += 2) {
            const bool last = (t == nt - 2);
            const char* a1 = cA + (size_t)(t + 1) * kstep;
            const char* a2 = last ? nA : cA + (size_t)(t + 2) * kstep; const char* b2 = last ? nB : cB + (size_t)(t + 2) * kstep;
            const char* a3 = a2 + kstep; const char* b3 = b2 + kstep;
            PG8_LDB(B0, 0, 0); PG8_LDB(B1, 0, 1); PG8_SCHED; PG8_LDA(At, 0, 0); PG8_STAGE(PG8_SA(1, 1), a1 + hstepA, voffA);
            PG8_WAIT_V(8); PG8_WAIT_L(0); PG8_BAR; PG8_MMA(0, 0, At, B0); PG8_MMA(0, 1, At, B1); PG8_BAR; PG8_SCHED;
            PG8_LDA(At, 0, 1); PG8_STAGE(PG8_SB(0, 0), b2, voffB); PG8_STAGE(PG8_SB(0, 1), b2 + hstepB, voffB); PG8_STAGE(PG8_SA(0, 0), a2, voffA);
            PG8_WAIT_V(8); PG8_WAIT_L(0); PG8_BAR; PG8_MMA(1, 0, At, B0); PG8_MMA(1, 1, At, B1); PG8_BAR; PG8_SCHED;
            PG8_LDB(B0, 1, 0); PG8_LDB(B1, 1, 1); PG8_SCHED; PG8_LDA(At, 1, 0); PG8_STAGE(PG8_SA(0, 1), a2 + hstepA, voffA);
            PG8_WAIT_V(8); PG8_WAIT_L(0); PG8_BAR; PG8_MMA(0, 0, At, B0); PG8_MMA(0, 1, At, B1); PG8_BAR; PG8_SCHED;
            PG8_LDA(At, 1, 1); PG8_STAGE(PG8_SB(1, 0), b3, voffB); PG8_STAGE(PG8_SB(1, 1), b3 + hstepB, voffB); PG8_STAGE(PG8_SA(1, 0), a3, voffA);
            PG8_WAIT_V(8); PG8_WAIT_L(0); PG8_BAR; PG8_MMA(1, 0, At, B0); PG8_MMA(1, 1, At, B1); PG8_BAR; PG8_SCHED;
        }
        if (wr == 0) PG8_BAR;
        E(acc, cur, wr, wc, fr, fq);
        if (!has_next) break;
#pragma unroll
        for (int a = 0; a < 2; ++a)
#pragma unroll
            for (int b = 0; b < 2; ++b)
#pragma unroll
                for (int m = 0; m < 4; ++m)
#pragma unroll
                    for (int n = 0; n < 2; ++n) acc[a][b][m][n] = (f32x4){0.f, 0.f, 0.f, 0.f};
        cur = nxt; cA = nA; cB = nB; ++ui;
        if (wr == 1) PG8_BAR;
    }
    PG8_WAIT_V(0);
    PG8_BAR;
#undef PG8_SA
#undef PG8_SB
#undef PG8_STAGE
#undef PG8_LDA
#undef PG8_LDB
#undef PG8_MMA
#undef PG8_WAIT_V
#undef PG8_WAIT_L
#undef PG8_BAR
#undef PG8_SCHED
}
}

struct Params { const float* in[27]; float* out; unsigned char* ws; int ph_lo, ph_hi; };
enum { I_XP = 0, I_XS, I_PP, I_PS, I_SPOOL, I_CLAT, I_CKR, I_PT, I_NMIX, I_NMLP, I_NPLE, I_POOLW, I_POOLSC, I_NKV, I_WDKV, I_KVN, I_WUK, I_WUV, I_WDQ, I_QN, I_WUQ, I_WO, I_WUP, I_WDOWN, I_WGATE, I_WPROJ, I_NFIN };

__device__ __forceinline__ void load_rstd(const float* ssq, const pg8::Unit& u, int wr, int fr, int fq, float (&rs)[2][4]) {
#pragma unroll
    for (int ai = 0; ai < 2; ++ai)
#pragma unroll
        for (int m = 0; m < 4; ++m) {
            const int row = u.pm * 256 + ai * 128 + wr * 64 + m * 16 + fr;
            const f32x4 a = ((const f32x4*)(ssq + (size_t)row * 16))[fq];
            float t = (a.x + a.y) + (a.z + a.w);
            t += __shfl_xor(t, 16); t += __shfl_xor(t, 32);
            rs[ai][m] = 1.0f / sqrtf(t * (1.0f / 1024.0f) + EPS);
        }
}
template <int NS> __device__ __forceinline__ void load_rstd_p(const float* ssqp, float inv_n, const pg8::Unit& u, int wr, int fr, int fq, float (&rs)[2][4]) {
#pragma unroll
    for (int ai = 0; ai < 2; ++ai)
#pragma unroll
        for (int m = 0; m < 4; ++m) {
            const int row = u.pm * 256 + ai * 128 + wr * 64 + m * 16 + fr;
            float t;
            if (NS == 4) t = ssqp[(size_t)row * 4 + fq]; else { const f32x2 a = ((const f32x2*)(ssqp + (size_t)row * 8))[fq]; t = a.x + a.y; }
            t += __shfl_xor(t, 16); t += __shfl_xor(t, 32);
            rs[ai][m] = 1.0f / sqrtf(t * inv_n + EPS);
        }
}
template <int MODE> struct EpiH {
    static constexpr bool PERM = true;
    const float* xp; const float* xs; const float* scale; const float* ssq_in; const bf16_t* proj;
    const bf16_t* hb_in; bf16_t* hb; float* ssq_out;
    __device__ __forceinline__ void operator()(const f32x4 (&acc)[2][2][4][2], const pg8::Unit& u, int wr, int wc, int fr_in, int fq_in) const {
        int fr = fr_in, fq = fq_in; asm volatile("" : "+v"(fr), "+v"(fq));
        float rs[2][4];
        if (MODE == 2) load_rstd(ssq_in, u, wr, fr, fq, rs);
        const int col0 = u.pn * 256 + wc * 32 + 8 * fq;
#pragma unroll
        for (int ai = 0; ai < 2; ++ai)
#pragma unroll
            for (int m = 0; m < 4; ++m) {
                const int row = u.pm * 256 + ai * 128 + wr * 64 + m * 16 + fr;
                float sq = 0.f;
#pragma unroll
                for (int bj = 0; bj < 2; ++bj) {
                    const int col = col0 + bj * 128;
                    f32x4 b0, b1;
                    if (MODE == 0) { const float* xr = (row < MP ? xp + (size_t)row * D : xs + (size_t)(row - MP) * D) + col; b0 = *(const f32x4*)xr; b1 = *(const f32x4*)(xr + 4); }
                    else { const u32x4 hv = *(const u32x4*)(hb_in + (size_t)row * D + col); b0 = unpk4((u32x2){hv.x, hv.y}); b1 = unpk4((u32x2){hv.z, hv.w}); }
                    const f32x4 a0 = acc[ai][bj][m][0], a1 = acc[ai][bj][m][1]; f32x4 o0, o1;
                    if (MODE == 0) { o0 = b0 + *(const f32x4*)(scale + col) * a0; o1 = b1 + *(const f32x4*)(scale + col + 4) * a1; }
                    else if (MODE == 1) { o0 = b0 + a0; o1 = b1 + a1; }
                    else { const u32x4 pv = *(const u32x4*)(proj + (size_t)row * D + col); const f32x4 p0 = unpk4((u32x2){pv.x, pv.y}), p1 = unpk4((u32x2){pv.z, pv.w}); const float r = rs[ai][m];
                        f32x4 g0, g1;
                        g0.x = 1.0f / (1.0f + __expf(-r * a0.x)); g0.y = 1.0f / (1.0f + __expf(-r * a0.y)); g0.z = 1.0f / (1.0f + __expf(-r * a0.z)); g0.w = 1.0f / (1.0f + __expf(-r * a0.w));
                        g1.x = 1.0f / (1.0f + __expf(-r * a1.x)); g1.y = 1.0f / (1.0f + __expf(-r * a1.y)); g1.z = 1.0f / (1.0f + __expf(-r * a1.z)); g1.w = 1.0f / (1.0f + __expf(-r * a1.w));
                        o0 = b0 + g0 * p0; o1 = b1 + g1 * p1; }
                    u32x4 w; w.x = pk2(o0.x, o0.y); w.y = pk2(o0.z, o0.w); w.z = pk2(o1.x, o1.y); w.w = pk2(o1.z, o1.w);
                    *(u32x4*)(hb + (size_t)row * D + col) = w;
                    sq += ((o0.x * o0.x + o0.y * o0.y) + (o0.z * o0.z + o0.w * o0.w)) + ((o1.x * o1.x + o1.y * o1.y) + (o1.z * o1.z + o1.w * o1.w));
                }
                sq += __shfl_xor(sq, 16); sq += __shfl_xor(sq, 32);
                if (fq == 0) ssq_out[(size_t)row * 16 + u.pn * 4 + wc] = sq;
                asm volatile("" ::: "memory");
            }
    }
};
struct EpiUp {
    static constexpr bool PERM = true;
    const float* ssq_in; bf16_t* abuf;
    __device__ __forceinline__ void operator()(const f32x4 (&acc)[2][2][4][2], const pg8::Unit& u, int wr, int wc, int fr_in, int fq_in) const {
        int fr = fr_in, fq = fq_in; asm volatile("" : "+v"(fr), "+v"(fq));
        float rs[2][4]; load_rstd(ssq_in, u, wr, fr, fq, rs);
        const int col0 = u.pn * 256 + wc * 32 + 8 * fq;
#pragma unroll
        for (int ai = 0; ai < 2; ++ai)
#pragma unroll
            for (int m = 0; m < 4; ++m) {
                const int row = u.pm * 256 + ai * 128 + wr * 64 + m * 16 + fr; const float r = rs[ai][m];
#pragma unroll
                for (int bj = 0; bj < 2; ++bj) {
                    f32x4 a = acc[ai][bj][m][0] * r, c = acc[ai][bj][m][1] * r;
                    a.x = fmaxf(a.x, 0.f); a.y = fmaxf(a.y, 0.f); a.z = fmaxf(a.z, 0.f); a.w = fmaxf(a.w, 0.f);
                    c.x = fmaxf(c.x, 0.f); c.y = fmaxf(c.y, 0.f); c.z = fmaxf(c.z, 0.f); c.w = fmaxf(c.w, 0.f);
                    u32x4 w; w.x = pk2(a.x * a.x, a.y * a.y); w.y = pk2(a.z * a.z, a.w * a.w); w.z = pk2(c.x * c.x, c.y * c.y); w.w = pk2(c.z * c.z, c.w * c.w);
                    *(u32x4*)(abuf + (size_t)row * FF + col0 + bj * 128) = w;
                }
            }
    }
};
template <int MODE> struct EpiF32 {
    static constexpr bool PERM = false;
    float* C; int ldc; const float* aux;
    __device__ __forceinline__ void operator()(const f32x4 (&acc)[2][2][4][2], const pg8::Unit& u, int wr, int wc, int fr_in, int fq_in) const {
        int fr = fr_in, fq = fq_in; asm volatile("" : "+v"(fr), "+v"(fq));
        float rs[2][4];
        if (MODE == 1) load_rstd(aux, u, wr, fr, fq, rs);
        const int col0 = u.pn * 256 + wc * 32 + 4 * fq;
#pragma unroll
        for (int ai = 0; ai < 2; ++ai)
#pragma unroll
            for (int m = 0; m < 4; ++m) {
                const int row = u.pm * 256 + ai * 128 + wr * 64 + m * 16 + fr;
                const float r = (MODE == 1) ? rs[ai][m] : (MODE == 2 ? aux[row] : 1.0f);
#pragma unroll
                for (int bj = 0; bj < 2; ++bj)
#pragma unroll
                    for (int n = 0; n < 2; ++n) *(f32x4*)(C + (size_t)row * ldc + col0 + bj * 128 + n * 16) = acc[ai][bj][m][n] * r;
            }
    }
};
struct EpiBf {
    static constexpr bool PERM = true;
    bf16_t* C; int ldc;
    __device__ __forceinline__ void operator()(const f32x4 (&acc)[2][2][4][2], const pg8::Unit& u, int wr, int wc, int fr_in, int fq_in) const {
        int fr = fr_in, fq = fq_in; asm volatile("" : "+v"(fr), "+v"(fq));
        const int col0 = u.pn * 256 + wc * 32 + 8 * fq;
#pragma unroll
        for (int ai = 0; ai < 2; ++ai)
#pragma unroll
            for (int m = 0; m < 4; ++m) {
                const int row = u.pm * 256 + ai * 128 + wr * 64 + m * 16 + fr;
#pragma unroll
                for (int bj = 0; bj < 2; ++bj) { const f32x4 a = acc[ai][bj][m][0], c = acc[ai][bj][m][1]; u32x4 w; w.x = pk2(a.x, a.y); w.y = pk2(a.z, a.w); w.z = pk2(c.x, c.y); w.w = pk2(c.z, c.w);
                    *(u32x4*)(C + (size_t)row * ldc + col0 + bj * 128) = w; }
            }
    }
};
__host__ __device__ __forceinline__ int kperm(int c) { if (c < KVR) return c; const int r = c - KVR, i = r & 31, sec = r >> 5; return KVR + 32 * (i >> 4) + 16 * sec + (i & 15); }
__host__ __device__ __forceinline__ int qperm(int c) { const int e = c % QH; if (e < NOPE) return c; const int r = e - NOPE, i = r & 31, sec = r >> 5; return c - e + NOPE + 32 * (i >> 4) + 16 * sec + (i & 15); }
struct EpiQ {
    static constexpr bool PERM = false;
    const float* ssqq_; const float* cs; bf16_t* qbuf; bf16_t* qs;
    __device__ __forceinline__ void operator()(const f32x4 (&acc)[2][2][4][2], const pg8::Unit& u, int wr, int wc, int fr_in, int fq_in) const {
        int fr = fr_in, fq = fq_in; asm volatile("" : "+v"(fr), "+v"(fq));
        const bool smp = u.pm >= MP / 256;
        float rq[2][4]; load_rstd_p<8>(ssqq_, 1.0f / QR, u, wr, fr, fq, rq);
#pragma unroll
        for (int ai = 0; ai < 2; ++ai)
#pragma unroll
            for (int m = 0; m < 4; ++m) {
                const int row = u.pm * 256 + ai * 128 + wr * 64 + m * 16 + fr; const float r = rq[ai][m]; const int pos = smp ? PAST + ((row - MP) & 7) : (row & (SEQ - 1));
                bf16_t* qrow = qbuf + (size_t)row * (NH * QH);
#pragma unroll
                for (int bj = 0; bj < 2; ++bj) {
                    const int Gi = u.pn * 8 + bj * 4 + wc, hh = Gi / 6, gi = Gi - hh * 6;
                    if (gi < 4) {
#pragma unroll
                        for (int n = 0; n < 2; ++n) { const f32x4 a = acc[ai][bj][m][n] * r; u32x2 w; w.x = pk2(a.x, a.y); w.y = pk2(a.z, a.w);
                            *(u32x2*)(qrow + Gi * 32 + n * 16 + 4 * fq) = w; }
                    } else {
                        const int i0 = 16 * (gi - 4) + 4 * fq;
                        const f32x4 x1 = acc[ai][bj][m][0] * r, x2 = acc[ai][bj][m][1] * r;
                        const f32x4 cn = *(const f32x4*)(cs + (size_t)pos * 64 + i0), sn = *(const f32x4*)(cs + (size_t)pos * 64 + 32 + i0);
                        const f32x4 o1 = x1 * cn - x2 * sn, o2 = x2 * cn + x1 * sn;
                        u32x2 w1, w2; w1.x = pk2(o1.x, o1.y); w1.y = pk2(o1.z, o1.w); w2.x = pk2(o2.x, o2.y); w2.y = pk2(o2.z, o2.w);
                        bf16_t* qd = smp ? qs + ((size_t)(row - MP) * NH + hh) * 320 + KVR : qrow + hh * QH + NOPE;
                        *(u32x2*)(qd + i0) = w1; *(u32x2*)(qd + 32 + i0) = w2;
                    }
                }
                asm volatile("" ::: "memory");
            }
    }
};
struct EpiDkvq {
    static constexpr bool PERM = false;
    const float* ssq_in; const float* cs; float* craw_; bf16_t* cb_; bf16_t* cqb_; float* ssqc_; float* ssqq_; float* out; bf16_t* kfull_; bf16_t* krbs_;
    __device__ __forceinline__ void operator()(const f32x4 (&acc)[2][2][4][2], const pg8::Unit& u, int wr, int wc, int fr_in, int fq_in) const {
        int fr = fr_in, fq = fq_in; asm volatile("" : "+v"(fr), "+v"(fq));
        float rs[2][4]; load_rstd(ssq_in, u, wr, fr, fq, rs);
        const bool smp = u.pm >= MP / 256;
#pragma unroll
        for (int ai = 0; ai < 2; ++ai)
#pragma unroll
            for (int m = 0; m < 4; ++m) {
                const int row = u.pm * 256 + ai * 128 + wr * 64 + m * 16 + fr; const float r = rs[ai][m];
                float sq = 0.f;
                if (u.pn == 0) {
#pragma unroll
                    for (int bj = 0; bj < 2; ++bj)
#pragma unroll
                        for (int n = 0; n < 2; ++n) { const int col = bj * 128 + wc * 32 + n * 16 + 4 * fq; const f32x4 v = acc[ai][bj][m][n] * r;
                            *(f32x4*)(craw_ + (size_t)row * KVR + col) = v; u32x2 w; w.x = pk2(v.x, v.y); w.y = pk2(v.z, v.w); *(u32x2*)(cb_ + (size_t)row * KVR + col) = w;
                            sq += (v.x * v.x + v.y * v.y) + (v.z * v.z + v.w * v.w); }
                    sq += __shfl_xor(sq, 16); sq += __shfl_xor(sq, 32);
                    if (fq == 0) ssqc_[(size_t)row * 4 + wc] = sq;
                } else {
#pragma unroll
                    for (int bj = 0; bj < 2; ++bj) {
                        const int g0 = (u.pn - 1) * 256 + bj * 128 + wc * 32;
                        if (g0 < ROPE) {
                            const int i0 = 16 * (g0 >> 5) + 4 * fq, pos = smp ? PAST + ((row - MP) & 7) : (row & (SEQ - 1));
                            const f32x4 x1 = acc[ai][bj][m][0] * r, x2 = acc[ai][bj][m][1] * r;
                            const f32x4 cn = *(const f32x4*)(cs + (size_t)pos * 64 + i0), sn = *(const f32x4*)(cs + (size_t)pos * 64 + 32 + i0);
                            const f32x4 o1 = x1 * cn - x2 * sn, o2 = x2 * cn + x1 * sn;
                            float* ko = smp ? out + O_KS + (size_t)(row - MP) * ROPE : out + O_KP + (size_t)row * ROPE;
                            *(f32x4*)(ko + i0) = o1; *(f32x4*)(ko + 32 + i0) = o2;
                            u32x2 w1, w2; w1.x = pk2(o1.x, o1.y); w1.y = pk2(o1.z, o1.w); w2.x = pk2(o2.x, o2.y); w2.y = pk2(o2.z, o2.w);
                            if (smp) { bf16_t* kd = krbs_ + (size_t)(row - MP) * ROPE; *(u32x2*)(kd + i0) = w1; *(u32x2*)(kd + 32 + i0) = w2; }
                            else { const int b = row >> 13, t = row & (SEQ - 1);
#pragma unroll
                                for (int h = 0; h < NH; ++h) { bf16_t* kd = kfull_ + ((size_t)(b * NH + h) * SEQ + t) * QH + NOPE; *(u32x2*)(kd + i0) = w1; *(u32x2*)(kd + 32 + i0) = w2; } }
                        } else if (g0 < ROPE + QR) {
#pragma unroll
                            for (int n = 0; n < 2; ++n) { const int qi = g0 - ROPE + n * 16 + 4 * fq; const f32x4 v = acc[ai][bj][m][n] * r;
                                u32x2 w; w.x = pk2(v.x, v.y); w.y = pk2(v.z, v.w); *(u32x2*)(cqb_ + (size_t)row * QR + qi) = w;
                                sq += (v.x * v.x + v.y * v.y) + (v.z * v.z + v.w * v.w); }
                        }
                    }
                    sq += __shfl_xor(sq, 16); sq += __shfl_xor(sq, 32);
                    if (fq == 0) ssqq_[(size_t)row * 8 + (u.pn - 1) * 4 + wc] = sq;
                }
                asm volatile("" ::: "memory");
            }
    }
};
struct EpiKup {
    static constexpr bool PERM = true;
    bf16_t* kfull; const float* ssqc_;
    __device__ __forceinline__ void operator()(const f32x4 (&acc)[2][2][4][2], const pg8::Unit& u, int wr, int wc, int fr_in, int fq_in) const {
        int fr = fr_in, fq = fq_in; asm volatile("" : "+v"(fr), "+v"(fq));
        const int col0 = u.pn * 256 + wc * 32 + 8 * fq;
        float rc[2][4]; load_rstd_p<4>(ssqc_, 1.0f / KVR, u, wr, fr, fq, rc);
#pragma unroll
        for (int ai = 0; ai < 2; ++ai)
#pragma unroll
            for (int m = 0; m < 4; ++m) {
                const int row = u.pm * 256 + ai * 128 + wr * 64 + m * 16 + fr; const int b = row >> 13, t = row & (SEQ - 1); const float r = rc[ai][m];
#pragma unroll
                for (int bj = 0; bj < 2; ++bj) { const int col = col0 + bj * 128; const int h = col >> 7, nn = col & 127; const f32x4 a = acc[ai][bj][m][0] * r, c = acc[ai][bj][m][1] * r;
                    u32x4 w; w.x = pk2(a.x, a.y); w.y = pk2(a.z, a.w); w.z = pk2(c.x, c.y); w.w = pk2(c.z, c.w);
                    *(u32x4*)(kfull + ((size_t)(b * NH + h) * SEQ + t) * QH + nn) = w; }
                asm volatile("" ::: "memory");
            }
    }
};
struct EpiVup {
    static constexpr bool PERM = true;
    bf16_t* vt; const float* ssqc_;
    __device__ __forceinline__ void operator()(const f32x4 (&acc)[2][2][4][2], const pg8::Unit& u, int wr, int wc, int fr_in, int fq_in) const {
        int fr = fr_in, fq = fq_in; asm volatile("" : "+v"(fr), "+v"(fq));
        const int col0 = u.pn * 256 + wc * 32 + 8 * fq;
        f32x4 rt[2][2];
#pragma unroll
        for (int bj = 0; bj < 2; ++bj)
#pragma unroll
            for (int k = 0; k < 8; ++k) { const f32x4 p4 = *(const f32x4*)(ssqc_ + (size_t)(col0 + bj * 128 + k) * 4); rt[bj][k >> 2][k & 3] = 1.0f / sqrtf(((p4.x + p4.y) + (p4.z + p4.w)) * (1.0f / KVR) + EPS); }
#pragma unroll
        for (int ai = 0; ai < 2; ++ai)
#pragma unroll
            for (int m = 0; m < 4; ++m) {
                const int row = u.pm * 256 + ai * 128 + wr * 64 + m * 16 + fr; const int h = row >> 7, v = row & 127;
#pragma unroll
                for (int bj = 0; bj < 2; ++bj) { const int col = col0 + bj * 128; const int b = col >> 13, t = col & (SEQ - 1); const f32x4 a = acc[ai][bj][m][0] * rt[bj][0], c = acc[ai][bj][m][1] * rt[bj][1];
                    u32x4 w; w.x = pk2(a.x, a.y); w.y = pk2(a.z, a.w); w.z = pk2(c.x, c.y); w.w = pk2(c.z, c.w);
                    *(u32x4*)(vt + ((size_t)(b * NH + h) * VD + v) * SEQ + t) = w; }
                asm volatile("" ::: "memory");
            }
    }
};

struct SgALoadBf { const bf16_t* A; int lda;
    __device__ __forceinline__ bf16x8 operator()(int row, int k) const { return *(const bf16x8*)(A + (size_t)row * lda + k); } };
struct SgALoadComb { const float* parto; const float* ml;
    __device__ __forceinline__ bf16x8 operator()(int row, int k) const {
        const int b = row >> 3, tok = row & 7, h = k >> 7, v = k & 127, q = tok * 8 + h;
        const float* m0p = ml + ((size_t)(b * 2 + 0) * 64 + q) * 2; const float* m1p = ml + ((size_t)(b * 2 + 1) * 64 + q) * 2;
        const float m0 = m0p[0], l0 = m0p[1], m1 = m1p[0], l1 = m1p[1], mx = fmaxf(m0, m1);
        float w0 = __builtin_amdgcn_exp2f(m0 - mx), w1 = __builtin_amdgcn_exp2f(m1 - mx); const float inv = 1.0f / (w0 * l0 + w1 * l1); w0 *= inv; w1 *= inv;
        const float* p0 = parto + ((size_t)(b * 2 + 0) * 64 + q) * 128 + v; const float* p1 = parto + ((size_t)(b * 2 + 1) * 64 + q) * 128 + v;
        return pack8v(*(const f32x4*)p0 * w0 + *(const f32x4*)p1 * w1, *(const f32x4*)(p0 + 4) * w0 + *(const f32x4*)(p1 + 4) * w1); } };
template <int NCT, int NCG, class Epi, class ALoad>
__device__ __forceinline__ void sg_gemm_l(LAS unsigned char* lds, const ALoad& AL, int apn256, const bf16_t* __restrict__ Bt, int K, int unit, const Epi& E, int tid, int wave, int lane) {
    constexpr int KS = 8 / NCG, W = NCG * NCT * 16, G4 = W / 4;
    static_assert(KS * 64 * W * 4 <= RING_BYTES, "sg_gemm reduction buffer");
    const int mt = unit >> 4, ntile = unit & 15, m0 = mt * 64, n0 = ntile * W;
    const int cg = wave % NCG, kp = wave / NCG, fr = lane & 15, fq = lane >> 4;
    const int Kw = K / KS;
    const int arow = m0 + fr, acol = (n0 >> 8) * apn256 + kp * Kw + 8 * fq;
    const bf16_t* bp = Bt + (size_t)(n0 + cg * NCT * 16 + fr) * K + kp * Kw + 8 * fq;
    f32x4 acc[4][NCT];
#pragma unroll
    for (int m = 0; m < 4; ++m)
#pragma unroll
        for (int n = 0; n < NCT; ++n) acc[m][n] = (f32x4){0.f, 0.f, 0.f, 0.f};
#pragma unroll 4
    for (int kk = 0; kk < Kw; kk += 32) {
        bf16x8 af[4], bfr[NCT];
#pragma unroll
        for (int m = 0; m < 4; ++m) af[m] = AL(arow + 16 * m, acol + kk);
#pragma unroll
        for (int n = 0; n < NCT; ++n) bfr[n] = *(const bf16x8*)(bp + (size_t)(16 * n) * K + kk);
#pragma unroll
        for (int m = 0; m < 4; ++m)
#pragma unroll
            for (int n = 0; n < NCT; ++n) acc[m][n] = __builtin_amdgcn_mfma_f32_16x16x32_bf16(bfr[n], af[m], acc[m][n], 0, 0, 0);
    }
    LAS float* red = (LAS float*)lds;
#pragma unroll
    for (int m = 0; m < 4; ++m)
#pragma unroll
        for (int n = 0; n < NCT; ++n) { const int row = 16 * m + fr, c4 = (cg * NCT * 16 + 16 * n) / 4 + fq;
            *(LAS f32x4*)(red + (size_t)(kp * 64 + row) * W + 4 * (c4 ^ (row & 3))) = acc[m][n]; }
    __syncthreads();
    for (int it = tid; it < 64 * G4; it += 512) {
        const int row = it / G4, c4 = it % G4;
        f32x4 v = *(const LAS f32x4*)(red + (size_t)row * W + 4 * (c4 ^ (row & 3)));
#pragma unroll
        for (int p = 1; p < KS; ++p) v += *(const LAS f32x4*)(red + (size_t)(p * 64 + row) * W + 4 * (c4 ^ (row & 3)));
        if constexpr (Epi::WHOLE_TILE) *(LAS f32x4*)(red + (size_t)row * W + 4 * (c4 ^ (row & 3))) = v;
        else E(MP + m0 + row, n0 + 4 * c4, v, ntile);
    }
    if constexpr (Epi::WHOLE_TILE) {
        __syncthreads();
        for (int it = tid; it < 64 * G4; it += 512) { const int row = it / G4, c4 = it % G4; E.tile(MP + m0 + row, n0, c4, red + (size_t)row * W, row & 3); }
    }
    __syncthreads();
}
template <int NCT, int NCG, class Epi>
__device__ __forceinline__ void sg_gemm(LAS unsigned char* lds, const bf16_t* __restrict__ A, int lda, int apn256, const bf16_t* __restrict__ Bt, int K, int unit, const Epi& E, int tid, int wave, int lane) {
    const SgALoadBf AL{A, lda}; sg_gemm_l<NCT, NCG>(lds, AL, apn256, Bt, K, unit, E, tid, wave, lane);
}
constexpr int SK_STG = 32768;
template <class Epi>
__device__ __forceinline__ void sk_gemm(LAS unsigned char* lds, const bf16_t* __restrict__ A, int lda, const bf16_t* __restrict__ Bt, int K, int m0, int n0, int ntile, const Epi& E, int tid, int wave, int lane) {
    const int nk = K >> 7, fr = lane & 15, fq = lane >> 4, mi = wave >> 1, nh = wave & 1;
    unsigned goA[2], goB[2];
#pragma unroll
    for (int e = 0; e < 2; ++e) { const int r = 4 * (wave + 8 * e) + (lane >> 4), c = (lane & 15) ^ (r & 15); goA[e] = (unsigned)(r * lda + c * 8) * 2u; goB[e] = (unsigned)(r * K + c * 8) * 2u; }
    const unsigned ldsw = (unsigned)wave * 1024u;
#define SK_STAGE(kc) do { const unsigned so_ = (unsigned)((kc) & 3) * SK_STG + ldsw; const size_t ko_ = (size_t)(kc) * 256; \
        _Pragma("unroll") for (int e = 0; e < 2; ++e) { \
            __builtin_amdgcn_global_load_lds((const unsigned*)((const char*)A + ko_ + goA[e]), (LAS unsigned*)(lds + so_ + e * 8192), 16, 0, 0); \
            __builtin_amdgcn_global_load_lds((const unsigned*)((const char*)Bt + ko_ + goB[e]), (LAS unsigned*)(lds + so_ + 16384 + e * 8192), 16, 0, 0); } } while (0)
    int co[4];
#pragma unroll
    for (int ks = 0; ks < 4; ++ks) co[ks] = ((4 * ks + fq) ^ fr) << 4;
    const int aro = (16 * mi + fr) * 256, bro = 16384 + (32 * nh + fr) * 256;
    f32x4 acc[2] = {(f32x4){0.f, 0.f, 0.f, 0.f}, (f32x4){0.f, 0.f, 0.f, 0.f}};
    asm volatile("s_waitcnt vmcnt(0)" ::: "memory");
    SK_STAGE(0); if (nk > 1) SK_STAGE(1); if (nk > 2) SK_STAGE(2);
#pragma unroll 1
    for (int kc = 0; kc < nk; ++kc) {
        if (kc + 2 < nk) asm volatile("s_waitcnt vmcnt(8)" ::: "memory"); else if (kc + 1 < nk) asm volatile("s_waitcnt vmcnt(4)" ::: "memory"); else asm volatile("s_waitcnt vmcnt(0)" ::: "memory");
        asm volatile("s_waitcnt lgkmcnt(0)" ::: "memory"); __builtin_amdgcn_s_barrier(); asm volatile("" ::: "memory");
        if (kc + 3 < nk) SK_STAGE(kc + 3);
        const LAS unsigned char* sp = lds + (kc & 3) * SK_STG;
        bf16x8 af[4], b0[4], b1[4];
#pragma unroll
        for (int ks = 0; ks < 4; ++ks) { af[ks] = *(const LAS bf16x8*)(sp + aro + co[ks]); b0[ks] = *(const LAS bf16x8*)(sp + bro + co[ks]); b1[ks] = *(const LAS bf16x8*)(sp + bro + 4096 + co[ks]); }
#pragma unroll
        for (int ks = 0; ks < 4; ++ks) { acc[0] = __builtin_amdgcn_mfma_f32_16x16x32_bf16(b0[ks], af[ks], acc[0], 0, 0, 0); acc[1] = __builtin_amdgcn_mfma_f32_16x16x32_bf16(b1[ks], af[ks], acc[1], 0, 0, 0); }
    }
#undef SK_STAGE
    asm volatile("s_waitcnt lgkmcnt(0)" ::: "memory"); __builtin_amdgcn_s_barrier(); asm volatile("" ::: "memory");
    LAS float* red = (LAS float*)lds;
    { const int row = 16 * mi + fr;
#pragma unroll
      for (int n = 0; n < 2; ++n) { const int c4 = 4 * (2 * nh + n) + fq; *(LAS f32x4*)(red + row * 64 + 4 * (c4 ^ (row & 3))) = acc[n]; } }
    __syncthreads();
#pragma unroll
    for (int it = tid; it < 1024; it += 512) { const int row = it >> 4, c4 = it & 15; const f32x4 v = *(const LAS f32x4*)(red + row * 64 + 4 * (c4 ^ (row & 3))); E(MP + m0 + row, n0 + 4 * c4, v, ntile); }
    __syncthreads();
}
__device__ __forceinline__ float row_rstd16(const float* ssq, int row) {
    const f32x4* s = (const f32x4*)(ssq + (size_t)row * 16); const f32x4 a = s[0], b = s[1], c = s[2], d = s[3];
    const float t = ((a.x + a.y) + (a.z + a.w)) + ((b.x + b.y) + (b.z + b.w)) + ((c.x + c.y) + (c.z + c.w)) + ((d.x + d.y) + (d.z + d.w));
    return 1.0f / sqrtf(t * (1.0f / 1024.0f) + EPS);
}
template <int MODE> struct SgH {
    static constexpr bool WHOLE_TILE = false;
    const float* xs; const float* scale; const float* ssq_in; const bf16_t* proj; const bf16_t* hb_in; bf16_t* hb; float* ssq_out;
    __device__ __forceinline__ void operator()(int row, int col, f32x4 a, int ntile) const {
        const f32x4 bs = (MODE == 0) ? *(const f32x4*)(xs + (size_t)(row - MP) * D + col) : unpk4(*(const u32x2*)(hb_in + (size_t)row * D + col));
        f32x4 o;
        if (MODE == 0) o = bs + *(const f32x4*)(scale + col) * a;
        else if (MODE == 1) o = bs + a;
        else { const float r = row_rstd16(ssq_in, row); const f32x4 pj = unpk4(*(const u32x2*)(proj + (size_t)row * D + col));
            f32x4 gt; gt.x = 1.0f / (1.0f + __expf(-r * a.x)); gt.y = 1.0f / (1.0f + __expf(-r * a.y)); gt.z = 1.0f / (1.0f + __expf(-r * a.z)); gt.w = 1.0f / (1.0f + __expf(-r * a.w));
            o = bs + gt * pj; }
        u32x2 w; w.x = pk2(o.x, o.y); w.y = pk2(o.z, o.w);
        *(u32x2*)(hb + (size_t)row * D + col) = w;
        float sq = (o.x * o.x + o.y * o.y) + (o.z * o.z + o.w * o.w);
        sq += __shfl_xor(sq, 1); sq += __shfl_xor(sq, 2); sq += __shfl_xor(sq, 4); sq += __shfl_xor(sq, 8);
        if ((col & 63) == 0) ssq_out[(size_t)row * 16 + ntile] = sq;
    }
};
struct SgUp {
    static constexpr bool WHOLE_TILE = false;
    const float* ssq_in; bf16_t* abuf;
    __device__ __forceinline__ void operator()(int row, int col, f32x4 a, int) const {
        const float r = row_rstd16(ssq_in, row); a = a * r;
        a.x = fmaxf(a.x, 0.f); a.y = fmaxf(a.y, 0.f); a.z = fmaxf(a.z, 0.f); a.w = fmaxf(a.w, 0.f);
        u32x2 w; w.x = pk2(a.x * a.x, a.y * a.y); w.y = pk2(a.z * a.z, a.w * a.w);
        *(u32x2*)(abuf + (size_t)row * FF + col) = w;
    }
};
template <int MODE> struct SgF32 {
    static constexpr bool WHOLE_TILE = false;
    float* C; int ldc; const float* aux;
    __device__ __forceinline__ void operator()(int row, int col, f32x4 a, int) const {
        const float r = (MODE == 1) ? row_rstd16(aux, row) : (MODE == 2 ? aux[row] : 1.0f);
        *(f32x4*)(C + (size_t)row * ldc + col) = a * r;
    }
};
struct SgBf {
    static constexpr bool WHOLE_TILE = false;
    bf16_t* C; int ldc;
    __device__ __forceinline__ void operator()(int row, int col, f32x4 a, int) const { u32x2 w; w.x = pk2(a.x, a.y); w.y = pk2(a.z, a.w); *(u32x2*)(C + (size_t)row * ldc + col) = w; }
};
struct SgQ {
    static constexpr bool WHOLE_TILE = true;
    const float* rstdq; const float* cs; bf16_t* qbuf; bf16_t* qs;
    __device__ __forceinline__ void operator()(int, int, f32x4, int) const {}
    __device__ __forceinline__ void tile(int row, int n0, int c4, const LAS float* trow, int sw) const {
        const int c = n0 + 4 * c4, hh = c / QH, e = c - hh * QH; const float r = rstdq[row];
        const f32x4 v = *(const LAS f32x4*)(trow + 4 * (c4 ^ sw)) * r;
        if (e < NOPE) { u32x2 w; w.x = pk2(v.x, v.y); w.y = pk2(v.z, v.w); *(u32x2*)(qbuf + (size_t)row * (NH * QH) + c) = w; }
        else { const int rp = e - NOPE, wi = rp & 31;
            if (wi < 16) { const int i0 = 16 * (rp >> 5) + wi, pos = PAST + ((row - MP) & 7);
                const f32x4 x2 = *(const LAS f32x4*)(trow + 4 * ((c4 + 4) ^ sw)) * r;
                const f32x4 cn = *(const f32x4*)(cs + (size_t)pos * 64 + i0), sn = *(const f32x4*)(cs + (size_t)pos * 64 + 32 + i0);
                const f32x4 o1 = v * cn - x2 * sn, o2 = x2 * cn + v * sn;
                bf16_t* qd = qs + ((size_t)(row - MP) * NH + hh) * 320 + KVR;
                u32x2 w1, w2; w1.x = pk2(o1.x, o1.y); w1.y = pk2(o1.z, o1.w); w2.x = pk2(o2.x, o2.y); w2.y = pk2(o2.z, o2.w);
                *(u32x2*)(qd + i0) = w1; *(u32x2*)(qd + 32 + i0) = w2; } }
    }
};

template <int PMODE = 0>
__device__ __forceinline__ void transpose_item(const float* W, const float* kscale, int K, int N, bf16_t* WT, int row_off, LAS float* scr, int item, int lane) {
    const int nblk = N / 32, kb = item / nblk, nb = item % nblk, k0 = 64 * kb, n0 = 32 * nb;
    { f32x4 v[8];
#pragma unroll
      for (int i = 0; i < 8; ++i) v[i] = *(const f32x4*)(W + (size_t)(k0 + (lane >> 3) + 8 * i) * N + n0 + (lane & 7) * 4);
#pragma unroll
      for (int i = 0; i < 8; ++i) { const int kk = (lane >> 3) + 8 * i; f32x4 x = v[i]; if (kscale) x = x * kscale[k0 + kk];
          LAS float* d = scr + kk * 33 + (lane & 7) * 4; d[0] = x.x; d[1] = x.y; d[2] = x.z; d[3] = x.w; } }
    LDS_WAIT(); asm volatile("" ::: "memory");
    const int c = lane & 7;
#pragma unroll
    for (int j = 0; j < 4; ++j) { const int n = (lane >> 3) + 8 * j; const LAS float* s = scr + (8 * c) * 33 + n;
        u32x4 o; o.x = pk2(s[0 * 33], s[1 * 33]); o.y = pk2(s[2 * 33], s[3 * 33]); o.z = pk2(s[4 * 33], s[5 * 33]); o.w = pk2(s[6 * 33], s[7 * 33]);
        *(u32x4*)(WT + (size_t)(row_off + (PMODE == 1 ? qperm(n0 + n) : (PMODE == 2 ? kperm(n0 + n) : n0 + n))) * K + k0 + 8 * c) = o; }
    LDS_WAIT(); asm volatile("" ::: "memory");
}

constexpr int AK_PITCH = 400, AK_BUF = 64 * AK_PITCH;
constexpr int AV_PITCH = 136, AV_BUF = 128 * AV_PITCH;
constexpr int AV_OFF = 2 * AK_BUF, AQ_OFF = AV_OFF + 2 * AV_BUF;
static_assert(AQ_OFF + 256 * 144 <= RING_BYTES, "attention LDS");
__device__ __forceinline__ void attn_prompt_unit(const bf16_t* __restrict__ qbuf, const bf16_t* __restrict__ Kf, const bf16_t* __restrict__ Vt, bf16_t* __restrict__ obuf,
                                                 int b, int h, int qb, LAS unsigned char* lds, int tid, int wave, int lane) {
    const int r32 = lane & 31, g = lane >> 5;
    const int t_lo = qb * 256 + wave * 32, trow = t_lo + r32;
    bf16x8 qf[8];
    { const bf16_t* qp = qbuf + (size_t)(b * SEQ + trow) * (NH * QH) + h * QH + 8 * g;
      __syncthreads();
#pragma unroll
      for (int ks = 8; ks < 12; ++ks) *(LAS bf16x8*)(lds + AQ_OFF + (wave * 32 + r32) * 144 + (2 * (ks - 8) + g) * 16) = *(const bf16x8*)(qp + 16 * ks);
#pragma unroll
      for (int ks = 0; ks < 8; ++ks) qf[ks] = *(const bf16x8*)(qp + 16 * ks);
#pragma unroll
      for (int ks = 0; ks < 8; ++ks) asm volatile("" : "+v"(qf[ks])); }
    f32x16 O[4];
#pragma unroll
    for (int i = 0; i < 4; ++i)
#pragma unroll
        for (int j = 0; j < 16; ++j) O[i][j] = 0.f;
    float mrun = -1e30f, lrun = 0.f;
    const bf16_t* Kb = Kf + (size_t)(b * NH + h) * SEQ * QH;
    const bf16_t* Vb = Vt + (size_t)(b * NH + h) * VD * SEQ;
    const int NT = (qb + 1) * 4;
    int kl_off[3], vl_off[2]; size_t vg_off[2];
#pragma unroll
    for (int e = 0; e < 3; ++e) kl_off[e] = (tid >> 3) * AK_PITCH + ((tid & 7) + 8 * e) * 16;
#pragma unroll
    for (int e = 0; e < 2; ++e) { const int c = tid + 512 * e; vl_off[e] = AV_OFF + (c >> 3) * AV_PITCH + (c & 7) * 16; vg_off[e] = (size_t)(c >> 3) * SEQ + (c & 7) * 8; }
    u32x4 kst[3], vst[2];
#define AT_LOAD(j) do { _Pragma("unroll") for (int e = 0; e < 3; ++e) kst[e] = *(const u32x4*)(Kb + (size_t)(64 * (j) + (tid >> 3)) * QH + ((tid & 7) + 8 * e) * 8); \
                        _Pragma("unroll") for (int e = 0; e < 2; ++e) vst[e] = *(const u32x4*)(Vb + vg_off[e] + 64 * (j)); } while (0)
#define AT_WRITE(buf) do { _Pragma("unroll") for (int e = 0; e < 3; ++e) *(LAS u32x4*)(lds + (buf) * AK_BUF + kl_off[e]) = kst[e]; \
                           _Pragma("unroll") for (int e = 0; e < 2; ++e) { *(LAS u32x2*)(lds + (buf) * AV_BUF + vl_off[e]) = (u32x2){vst[e].x, vst[e].y}; *(LAS u32x2*)(lds + (buf) * AV_BUF + vl_off[e] + 8) = (u32x2){vst[e].z, vst[e].w}; } } while (0)
    AT_LOAD(0); AT_WRITE(0);
    __syncthreads();
    for (int j = 0; j < NT; ++j) {
        const int buf = j & 1;
        if (j + 1 < NT) AT_LOAD(j + 1);
        if (64 * j <= t_lo + 31) {
            f32x16 S0, S1;
#pragma unroll
            for (int i = 0; i < 16; ++i) { S0[i] = 0.f; S1[i] = 0.f; }
            const LAS unsigned char* kl = lds + buf * AK_BUF + r32 * AK_PITCH + g * 16;
            const LAS unsigned char* ql = lds + AQ_OFF + (wave * 32 + r32) * 144 + g * 16;
            bf16x8 ka[3][2], qr_[3];
#define AT_KLD(ks) do { ka[(ks) % 3][0] = *(const LAS bf16x8*)(kl + (ks) * 32); ka[(ks) % 3][1] = *(const LAS bf16x8*)(kl + 32 * AK_PITCH + (ks) * 32); \
                        if ((ks) >= 8) qr_[(ks) % 3] = *(const LAS bf16x8*)(ql + ((ks) - 8) * 32); } while (0)
            AT_KLD(0); AT_KLD(1);
#pragma unroll
            for (int ks = 0; ks < 12; ++ks) {
                if (ks + 2 < 12) AT_KLD(ks + 2);
                __builtin_amdgcn_sched_barrier(0);
                const bf16x8 qb_ = (ks < 8) ? qf[ks < 8 ? ks : 0] : qr_[ks % 3];
                S0 = __builtin_amdgcn_mfma_f32_32x32x16_bf16(ka[ks % 3][0], qb_, S0, 0, 0, 0);
                S1 = __builtin_amdgcn_mfma_f32_32x32x16_bf16(ka[ks % 3][1], qb_, S1, 0, 0, 0);
                __builtin_amdgcn_sched_barrier(0);
            }
#undef AT_KLD
            if (64 * j + 63 > t_lo) {
                asm volatile("" ::: "memory");
#pragma unroll
                for (int i = 0; i < 16; ++i) { const int key = 64 * j + crow(i, g); if (key > trow) S0[i] = -1e30f; if (key + 32 > trow) S1[i] = -1e30f; }
            }
            float mx = S0[0];
#pragma unroll
            for (int i = 1; i < 16; ++i) mx = fmaxf(mx, S0[i]);
#pragma unroll
            for (int i = 0; i < 16; ++i) mx = fmaxf(mx, S1[i]);
            mx = fmaxf(mx, __shfl_xor(mx, 32)) * CEXP;
            if (__any(mx > mrun + 11.5f)) {
                const float mnew = fmaxf(mrun, mx), alpha = __builtin_amdgcn_exp2f(mrun - mnew);
                mrun = mnew; lrun *= alpha;
#pragma unroll
                for (int vt = 0; vt < 4; ++vt)
#pragma unroll
                    for (int i = 0; i < 16; ++i) O[vt][i] *= alpha;
            }
            float ps = 0.f;
#pragma unroll
            for (int i = 0; i < 16; ++i) { S0[i] = __builtin_amdgcn_exp2f(S0[i] * CEXP - mrun); S1[i] = __builtin_amdgcn_exp2f(S1[i] * CEXP - mrun); ps += S0[i] + S1[i]; }
            lrun += ps;
            bf16x8 pf[4];
            { float tmp[8];
#pragma unroll
              for (int s2 = 0; s2 < 4; ++s2) {
#pragma unroll
                for (int i = 0; i < 8; ++i) tmp[i] = (s2 < 2) ? S0[8 * (s2 & 1) + i] : S1[8 * (s2 & 1) + i];
                pf[s2] = pack8(tmp); } }
            const LAS unsigned char* vl = lds + AV_OFF + buf * AV_BUF + r32 * AV_PITCH + g * 8;
            u32x4 fa[4], fb[4];
#define AT_VLD(dst, vt) do { _Pragma("unroll") for (int s2 = 0; s2 < 4; ++s2) { const u32x2 lo_ = *(const LAS u32x2*)(vl + (vt) * 32 * AV_PITCH + s2 * 32), hi_ = *(const LAS u32x2*)(vl + (vt) * 32 * AV_PITCH + s2 * 32 + 16); dst[s2] = (u32x4){lo_.x, lo_.y, hi_.x, hi_.y}; } } while (0)
#define AT_VMM(src, vt) do { _Pragma("unroll") for (int s2 = 0; s2 < 4; ++s2) O[vt] = __builtin_amdgcn_mfma_f32_32x32x16_bf16(__builtin_bit_cast(bf16x8, src[s2]), pf[s2], O[vt], 0, 0, 0); } while (0)
            AT_VLD(fa, 0); AT_VLD(fb, 1); __builtin_amdgcn_sched_barrier(0);
            AT_VMM(fa, 0); __builtin_amdgcn_sched_barrier(0);
            AT_VLD(fa, 2); __builtin_amdgcn_sched_barrier(0);
            AT_VMM(fb, 1); __builtin_amdgcn_sched_barrier(0);
            AT_VLD(fb, 3); __builtin_amdgcn_sched_barrier(0);
            AT_VMM(fa, 2); __builtin_amdgcn_sched_barrier(0);
            AT_VMM(fb, 3);
#undef AT_VLD
#undef AT_VMM
        }
        if (j + 1 < NT) AT_WRITE(buf ^ 1);
        __syncthreads();
    }
#undef AT_LOAD
#undef AT_WRITE
    const float ltot = lrun + __shfl_xor(lrun, 32), inv = 1.0f / ltot;
    bf16_t* op = obuf + (size_t)(b * SEQ + trow) * D + h * VD + 4 * g;
#pragma unroll
    for (int vt = 0; vt < 4; ++vt)
#pragma unroll
        for (int jq = 0; jq < 4; ++jq) {
            u32x2 w; w.x = pk2(O[vt][4 * jq] * inv, O[vt][4 * jq + 1] * inv); w.y = pk2(O[vt][4 * jq + 2] * inv, O[vt][4 * jq + 3] * inv);
            *(u32x2*)(op + 32 * vt + 8 * jq) = w;
        }
}

typedef short s16x4 __attribute__((ext_vector_type(4)));
constexpr int SA_KR = 32768, SA_BUF = 32768 + 64 * 144, SA_QR = 2 * SA_BUF, SA_QI = SA_QR + 64 * 144, SA_QI_PITCH = 528, SA_OI = 69632;
static_assert(SA_OI >= 65536 + 1024 && SA_OI + 64 * SA_QI_PITCH <= MISC_OFF, "O image");
static_assert(SA_QI + 64 * SA_QI_PITCH <= MISC_OFF, "sample attention LDS");
__device__ __forceinline__ int sa_off(int row, int ch) { return 256 * row + 16 * (ch ^ (((row & 3) << 2) | ((row >> 2) & 3))); }
__device__ __forceinline__ void sattn_item(const Params& P, int b, int half, LAS unsigned char* lds, int tid, int wave, int lane) {
    unsigned char* ws = P.ws;
    const int r32 = lane & 31, g = lane >> 5;
    const bool is_cmp = wave < 4;
    const int qt = wave & 1, kb = (wave >> 1) & 1;
    const int ptv = ((const int*)P.in[I_PT])[b * NPG + half * 32 + (lane & 31)];
    const float* clat = P.in[I_CLAT]; const float* ckr = P.in[I_CKR];
#define SA_LOAD(S, h) do { const int pg_ = __builtin_amdgcn_readlane(ptv, (h) >> 2); const size_t prow_ = (size_t)pg_ * PAGE + (((h) & 3) << 5); \
        const char* lat_ = (const char*)(clat + prow_ * KVR); const char* kro_ = (const char*)(ckr + prow_ * ROPE); \
        _Pragma("unroll") for (int e = 0; e < 8; ++e) S[e] = *(const f32x4*)(lat_ + glb + e * 1024); \
        S[8] = *(const f32x4*)(kro_ + grb); S[9] = *(const f32x4*)(kro_ + grb + 1024); } while (0)
#define SA_PK4(v) ((u32x2){pk2((v).x, (v).y), pk2((v).z, (v).w)})
#define SA_WRITE(S, bufo, hh) do { \
        _Pragma("unroll") for (int e = 0; e < 8; ++e) *(LAS u32x2*)(lds + (bufo) + llb[e] + (hh) * 8192) = SA_PK4(S[e]); \
        _Pragma("unroll") for (int e = 0; e < 2; ++e) *(LAS u32x2*)(lds + (bufo) + lrb[e] + (hh) * 4608) = SA_PK4(S[8 + e]); asm volatile("" ::: "memory"); } while (0)
    __syncthreads();
    *(LAS u32x4*)(lds + SA_QR + (tid >> 3) * 144 + (tid & 7) * 16) = *(const u32x4*)((const bf16_t*)(ws + WS_QS) + ((size_t)b * 64 + (tid >> 3)) * 320 + KVR + (tid & 7) * 8);
    {
      const bf16_t* qn = (const bf16_t*)(ws + WS_QBUF) + (size_t)(MP + b * DS + (r32 & 7)) * (NH * QH) + wave * QH + 8 * g;
      bf16x8 an[8];
#pragma unroll
      for (int ks = 0; ks < 8; ++ks) { u32x4 z = {0u, 0u, 0u, 0u}; if (r32 < DS) z = *(const u32x4*)(qn + 16 * ks); an[ks] = __builtin_bit_cast(bf16x8, z); }
      const bf16_t* wk = (const bf16_t*)(ws + WS_WUKB) + (size_t)r32 * 1024 + wave * NOPE + 8 * g;
#pragma unroll 2
      for (int nt = 0; nt < 8; ++nt) {
          f32x16 acc;
#pragma unroll
          for (int i = 0; i < 16; ++i) acc[i] = 0.f;
#pragma unroll
          for (int ks = 0; ks < 8; ++ks) acc = __builtin_amdgcn_mfma_f32_32x32x16_bf16(an[ks], *(const bf16x8*)(wk + (size_t)(32 * nt) * 1024 + 16 * ks), acc, 0, 0, 0);
#pragma unroll
          for (int i = 0; i < 4; ++i) *(LAS bf16_t*)(lds + SA_QI + ((i + 4 * g) * 8 + wave) * SA_QI_PITCH + (32 * nt + r32) * 2) = (bf16_t)f2bf(acc[i]);
      } }
    __syncthreads();
#define SA_KLD(ks) do { const int o0_ = ((ks) < 16) ? (((ks) >> 3) * 16384 + krow + 32 * (((ks) & 7) ^ (x_ >> 1))) : (krope + 32 * ((ks) - 16)); \
        ka_[(ks) & 3] = *(const LAS bf16x8*)(kb_ + o0_); \
        qa_[(ks) & 3] = ((ks) < 16) ? *(const LAS bf16x8*)(qil + 32 * (ks)) : *(const LAS bf16x8*)(qrl + 32 * ((ks) - 16)); } while (0)
#define SA_VLD(dst, vt) do { const LAS unsigned char* vb_ = kb_ + ((vt) >> 2) * 16384 + 8192 * kb; \
        const int c0_ = 4 * ((vt) & 3) + 2 * vsub + (p_ >> 1); \
        const int blo_ = 256 * (4 * gg + q_) + 16 * (c0_ ^ ((q_ << 2) | gg)) + 8 * (p_ & 1); \
        const int bhi_ = 256 * (4 * gg + q_ + 8) + 16 * (c0_ ^ ((q_ << 2) | (gg + 2))) + 8 * (p_ & 1); \
        _Pragma("unroll") for (int s2 = 0; s2 < 2; ++s2) { \
            const s16x4 lo_ = __builtin_amdgcn_ds_read_tr16_b64_v4i16((LAS s16x4*)(vb_ + blo_ + 4096 * s2)); \
            const s16x4 hi_ = __builtin_amdgcn_ds_read_tr16_b64_v4i16((LAS s16x4*)(vb_ + bhi_ + 4096 * s2)); \
            dst[s2] = (bf16x8){lo_[0], lo_[1], lo_[2], lo_[3], hi_[0], hi_[1], hi_[2], hi_[3]}; } } while (0)
#define SA_VMM(src, vt) do { _Pragma("unroll") for (int s2 = 0; s2 < 2; ++s2) O[vt] = __builtin_amdgcn_mfma_f32_32x32x16_bf16(src[s2], pf[s2], O[vt], 0, 0, 0); } while (0)
#define SA_COMPUTE(j, bufo) do { \
        const LAS unsigned char* kb_ = lds + (bufo); \
        f32x16 S0; \
        _Pragma("unroll") for (int i = 0; i < 16; ++i) S0[i] = 0.f; \
        int r32v = r32; asm volatile("" : "+v"(r32v)); \
        const int x_ = ((r32v & 3) << 2) | ((r32v >> 2) & 3); \
        const int krow = 256 * (r32v + 32 * kb) + 16 * ((g ^ x_) & 1), krope = SA_KR + (r32v + 32 * kb) * 144 + g * 16; \
        const LAS unsigned char* qrl = lds + SA_QR + (32 * qt + r32v) * 144 + g * 16; const LAS unsigned char* qil = lds + SA_QI + (32 * qt + r32v) * SA_QI_PITCH + g * 16; \
        bf16x8 ka_[4], qa_[4]; \
        SA_KLD(0); SA_KLD(1); SA_KLD(2); \
        _Pragma("unroll") for (int ks = 0; ks < 20; ++ks) { \
            if (ks + 3 < 20) SA_KLD(ks + 3); \
            __builtin_amdgcn_sched_barrier(0); \
            S0 = __builtin_amdgcn_mfma_f32_32x32x16_bf16(ka_[ks & 3], qa_[ks & 3], S0, 0, 0, 0); \
            __builtin_amdgcn_sched_barrier(0); } \
        if ((j) == 64) { const int tok = (32 * qt + r32) >> 3; asm volatile("" ::: "memory"); \
            _Pragma("unroll") for (int i = 0; i < 16; ++i) { const int key = 32 * kb + crow(i, g); if (key > tok || key >= DS) S0[i] = -1e30f; } } \
        float mx = S0[0]; \
        _Pragma("unroll") for (int i = 1; i < 16; ++i) mx = fmaxf(mx, S0[i]); \
        mx = fmaxf(mx, __shfl_xor(mx, 32)) * CEXP; \
        if (__any(mx > mrun + 11.5f)) { const float mnew = fmaxf(mrun, mx), alpha = __builtin_amdgcn_exp2f(mrun - mnew); mrun = mnew; lrun *= alpha; \
            _Pragma("unroll") for (int vt = 0; vt < 8; ++vt) _Pragma("unroll") for (int i = 0; i < 16; ++i) O[vt][i] *= alpha; } \
        int lnv = lane; asm volatile("" : "+v"(lnv)); \
        const int li = lnv & 15, q_ = li >> 2, p_ = li & 3, vsub = (lnv >> 4) & 1, gg = lnv >> 5; \
        bf16x8 fa_[2], fb_[2]; \
        SA_VLD(fa_, 0); SA_VLD(fb_, 1);                        \
        float ps = 0.f; \
        _Pragma("unroll") for (int i = 0; i < 16; ++i) { S0[i] = __builtin_amdgcn_exp2f(S0[i] * CEXP - mrun); ps += S0[i]; } \
        lrun += ps; \
        bf16x8 pf[2]; \
        { float tmp[8]; \
          _Pragma("unroll") for (int s2 = 0; s2 < 2; ++s2) { \
            _Pragma("unroll") for (int i = 0; i < 8; ++i) tmp[i] = S0[8 * s2 + i]; \
            pf[s2] = pack8(tmp); } } \
        __builtin_amdgcn_sched_barrier(0); \
        SA_VMM(fa_, 0); __builtin_amdgcn_sched_barrier(0); SA_VLD(fa_, 2); __builtin_amdgcn_sched_barrier(0); \
        SA_VMM(fb_, 1); __builtin_amdgcn_sched_barrier(0); SA_VLD(fb_, 3); __builtin_amdgcn_sched_barrier(0); \
        SA_VMM(fa_, 2); __builtin_amdgcn_sched_barrier(0); SA_VLD(fa_, 4); __builtin_amdgcn_sched_barrier(0); \
        SA_VMM(fb_, 3); __builtin_amdgcn_sched_barrier(0); SA_VLD(fb_, 5); __builtin_amdgcn_sched_barrier(0); \
        SA_VMM(fa_, 4); __builtin_amdgcn_sched_barrier(0); SA_VLD(fa_, 6); __builtin_amdgcn_sched_barrier(0); \
        SA_VMM(fb_, 5); __builtin_amdgcn_sched_barrier(0); SA_VLD(fb_, 7); __builtin_amdgcn_sched_barrier(0); \
        SA_VMM(fa_, 6); __builtin_amdgcn_sched_barrier(0); \
        SA_VMM(fb_, 7); } while (0)
#define SA_LOADER(j, SX, SY, bufn) do { const int h0_ = 2 * (j) + 6 < 127 ? 2 * (j) + 6 : 127, h1_ = 2 * (j) + 7 < 127 ? 2 * (j) + 7 : 127; \
        __builtin_amdgcn_sched_barrier(0); SA_WRITE(SX, bufn, 0); SA_LOAD(SX, h0_); __builtin_amdgcn_sched_barrier(0); SA_WRITE(SY, bufn, 1); SA_LOAD(SY, h1_); __builtin_amdgcn_sched_barrier(0); } while (0)
#define SA_TAIL64(bufn) do { if (half == 1) { \
            const char* cbn = (const char*)((const bf16_t*)(ws + WS_CB) + (size_t)(MP + b * DS) * KVR); const char* krn = (const char*)((const bf16_t*)(ws + WS_KRBS) + (size_t)(b * DS) * ROPE); \
            const int w4_ = wave - 4; \
            _Pragma("unroll") for (int hh = 0; hh < 2; ++hh) { \
                _Pragma("unroll") for (int e = 0; e < 8; ++e) { const int key = 8 * w4_ + e + 32 * hh; u32x2 z = {0u, 0u}; if (key < DS) z = *(const u32x2*)(cbn + key * (KVR * 2) + 8 * lane); *(LAS u32x2*)(lds + (bufn) + llb[e] + hh * 8192) = z; } \
                _Pragma("unroll") for (int e = 0; e < 2; ++e) { const int key = 8 * w4_ + 4 * e + (lane >> 4) + 32 * hh; u32x2 z = {0u, 0u}; if (key < DS) z = *(const u32x2*)(krn + key * (ROPE * 2) + 8 * (lane & 15)); *(LAS u32x2*)(lds + (bufn) + lrb[e] + hh * 4608) = z; } } } } while (0)
#define SA_BAR() do { asm volatile("s_waitcnt lgkmcnt(0)" ::: "memory"); __builtin_amdgcn_s_barrier(); asm volatile("" ::: "memory"); } while (0)
    float* ml = (float*)(ws + WS_ML) + (size_t)(b * 2 + half) * 64 * 2;
    if (is_cmp) {
        SA_BAR();
        f32x16 O[8];
#pragma unroll
        for (int vt = 0; vt < 8; ++vt)
#pragma unroll
            for (int i = 0; i < 16; ++i) O[vt][i] = 0.f;
        float mrun = -1e30f, lrun = 0.f;
        int bo = 0;
        for (int j = 0; j < 64; ++j) {
            SA_COMPUTE(j, bo);
            bo = SA_BUF - bo;
            SA_BAR();
        }
        if (half == 1) { SA_COMPUTE(64, bo); SA_BAR(); }
        LAS float* xo = (LAS float*)(lds + qt * 32768); LAS float* xm = (LAS float*)(lds + 65536 + qt * 512);
        if (kb == 1) { xm[2 * lane] = mrun; xm[2 * lane + 1] = lrun;
#pragma unroll
            for (int vt = 0; vt < 8; ++vt)
#pragma unroll
                for (int i = 0; i < 16; ++i) xo[(vt * 16 + i) * 64 + lane] = O[vt][i]; }
        SA_BAR();
        if (kb == 0) {
            const float m1 = xm[2 * lane], l1 = xm[2 * lane + 1], mm = fmaxf(mrun, m1);
            const float a0 = __builtin_amdgcn_exp2f(mrun - mm), a1 = __builtin_amdgcn_exp2f(m1 - mm);
            const float ll = lrun * a0 + l1 * a1, lt = ll + __shfl_xor(ll, 32);
            const int q = 32 * qt + r32;
            if (g == 0) { ml[q * 2] = mm; ml[q * 2 + 1] = lt; }
#pragma unroll
            for (int vt = 0; vt < 8; ++vt) {
                float o[16];
#pragma unroll
                for (int i = 0; i < 16; ++i) o[i] = O[vt][i] * a0 + xo[(vt * 16 + i) * 64 + lane] * a1;
#pragma unroll
                for (int jq = 0; jq < 4; ++jq) { u32x2 w; w.x = pk2(o[4 * jq], o[4 * jq + 1]); w.y = pk2(o[4 * jq + 2], o[4 * jq + 3]);
                    *(LAS u32x2*)(lds + SA_OI + q * SA_QI_PITCH + (32 * vt + 8 * jq + 4 * g) * 2) = w; }
            }
        }
    } else {
        unsigned glb, grb, llb[8], lrb[2];
        { const int w4_ = wave - 4;
          glb = (unsigned)(8 * w4_ * 1024 + 16 * lane); grb = (unsigned)(8 * w4_ * 256 + 16 * lane);
#pragma unroll
          for (int e = 0; e < 8; ++e) { const int x_ = ((e & 3) << 2) | ((2 * w4_ + (e >> 2)) & 3);
              llb[e] = (unsigned)((lane >> 5) * 16384 + 256 * (8 * w4_ + e) + 16 * ((((lane & 31) >> 1)) ^ x_) + 8 * (lane & 1)); }
#pragma unroll
          for (int e = 0; e < 2; ++e) lrb[e] = (unsigned)(SA_KR + (8 * w4_ + 4 * e + (lane >> 4)) * 144 + 8 * (lane & 15)); }
        f32x4 s0[10], s1[10], s2[10], s3[10];
        SA_LOAD(s0, 0); SA_LOAD(s1, 1); SA_LOAD(s2, 2); SA_LOAD(s3, 3);
        SA_WRITE(s0, 0, 0); SA_LOAD(s0, 4); SA_WRITE(s1, 0, 1); SA_LOAD(s1, 5);
        SA_BAR();
        for (int j = 0; j < 62; j += 2) {
            SA_LOADER(j, s2, s3, SA_BUF);
            SA_BAR();
            SA_LOADER(j + 1, s0, s1, 0);
            SA_BAR();
        }
        SA_LOADER(62, s2, s3, SA_BUF);
        SA_BAR();
        SA_TAIL64(0);
        SA_BAR();
        if (half == 1) SA_BAR();
        SA_BAR();
    }
#undef SA_BAR
#undef SA_LOAD
#undef SA_WRITE
#undef SA_PK4
#undef SA_COMPUTE
#undef SA_KLD
#undef SA_VLD
#undef SA_VMM
#undef SA_LOADER
#undef SA_TAIL64

    float* parto = (float*)(ws + WS_PART) + (size_t)(b * 2 + half) * 64 * 128;
    __syncthreads();
    { bf16x8 ao[16];
#pragma unroll
      for (int ks = 0; ks < 16; ++ks) { u32x4 z = {0u, 0u, 0u, 0u}; if (r32 < DS) z = *(const LAS u32x4*)(lds + SA_OI + (r32 * 8 + wave) * SA_QI_PITCH + (16 * ks + 8 * g) * 2); ao[ks] = __builtin_bit_cast(bf16x8, z); }
      const bf16_t* wv = (const bf16_t*)(ws + WS_WUVP) + (size_t)(wave * VD + r32) * KVR + 8 * g;
#pragma unroll 2
      for (int nt = 0; nt < 4; ++nt) {
          f32x16 acc;
#pragma unroll
          for (int i = 0; i < 16; ++i) acc[i] = 0.f;
#pragma unroll
          for (int ks = 0; ks < 16; ++ks) acc = __builtin_amdgcn_mfma_f32_32x32x16_bf16(ao[ks], *(const bf16x8*)(wv + (size_t)(32 * nt) * KVR + 16 * ks), acc, 0, 0, 0);
#pragma unroll
          for (int i = 0; i < 4; ++i) parto[(size_t)((i + 4 * g) * 8 + wave) * 128 + 32 * nt + r32] = acc[i];
      } }
}

template <int W>
__device__ __forceinline__ void pool_chunk(const float* __restrict__ xr, int rvb, f32x4 gn, int col, int t0, bf16_t* __restrict__ drow) {
    f32x4 ring[W - 1]; f32x4 sum = {0.f, 0.f, 0.f, 0.f};
#pragma unroll
    for (int i = W - 1; i >= 1; --i) { f32x4 u = {0.f, 0.f, 0.f, 0.f};
        if (t0 - i >= 0) u = *(const f32x4*)(xr - (size_t)i * D + col) * __builtin_bit_cast(float, __builtin_amdgcn_readlane(rvb, 15 - i));
        ring[(W - 1 - i) % (W - 1)] = u; sum += u; }
#pragma unroll
    for (int r = 0; r < 16; ++r) {
        const f32x4 u = *(const f32x4*)(xr + (size_t)r * D + col) * __builtin_bit_cast(float, __builtin_amdgcn_readlane(rvb, 15 + r));
        sum += u;
        const int t = t0 + r; const float icnt = 1.0f / (float)((t + 1) < W ? (t + 1) : W);
        const f32x4 dd = (sum * icnt - u) * gn;
        u32x2 o; o.x = pk2(dd.x, dd.y); o.y = pk2(dd.z, dd.w);
        *(u32x2*)(drow + (size_t)r * D + col) = o;
        sum -= ring[r % (W - 1)]; ring[r % (W - 1)] = u;
    }
}
constexpr int NPH = 17;
__global__ void __launch_bounds__(512, 2) yoco_fwd(Params P) {
    extern __shared__ __attribute__((aligned(16))) unsigned char lds_raw[];
    LAS unsigned char* lds = (LAS unsigned char*)lds_raw;
    volatile LAS unsigned* MISC = (volatile LAS unsigned*)(lds + MISC_OFF);
    const int tid = threadIdx.x, lane = tid & 63, wave = __builtin_amdgcn_readfirstlane(tid >> 6);
    const int G = gridDim.x; const int bx = blockIdx.x; const int vcu = (G % 8 == 0) ? (bx % 8) * (G / 8) + bx / 8 : bx;
    unsigned char* ws = P.ws; float* out = P.out;
    for (int u = tid; u < 64; u += 512) MISC[u] = 0u;
    __syncthreads();
    XcdBarrier bar; bar.bar = (unsigned*)(ws + WS_CTL) + CW_BAR; bar.x = 0; bar.st = nullptr;
    if (MK_N_LAUNCHES == 1) bar = xcd_barrier_post((unsigned*)(ws + WS_CTL) + CW_BAR, MISC + 8);
    const int lo = P.ph_lo, hi = P.ph_hi;
#ifndef PH_MASK
#define PH_MASK 0xFFFFFFFFu
#endif
#define IN(k) (((PH_MASK >> (k)) & 1u) && lo <= (k) && (k) < hi)
#define SEAM(k) do { if (IN(k) && IN((k) + 1)) xcd_barrier(bar); } while (0)
#define SEAM2(k, kn) do { if (IN(k) && IN(kn)) xcd_barrier(bar); } while (0)
    const int gw = vcu * 8 + wave, NGW = G * 8;
    const int gtid = vcu * 512 + tid, NGT = G * 512;

#define wpool ((bf16_t*)(ws + WS_WPOOL))
#define wup ((bf16_t*)(ws + WS_WUP))
#define wdown ((bf16_t*)(ws + WS_WDOWN))
#define wgate ((bf16_t*)(ws + WS_WGATE))
#define wproj ((bf16_t*)(ws + WS_WPROJ))
#define wdkvq ((bf16_t*)(ws + WS_WDKVQ))
#define wuq ((bf16_t*)(ws + WS_WUQ))
#define wukt ((bf16_t*)(ws + WS_WUKT))
#define wuvt ((bf16_t*)(ws + WS_WUVT))
#define wukb ((bf16_t*)(ws + WS_WUKB))
#define wo ((bf16_t*)(ws + WS_WO))
#define cs ((float*)(ws + WS_CS))
#define rstd0 ((float*)(ws + WS_RSTD0))
#define dbuf ((bf16_t*)(ws + WS_DBUF))
#define pb ((bf16_t*)(ws + WS_PB))
#define hbA ((bf16_t*)(ws + WS_HBA))
#define hbB ((bf16_t*)(ws + WS_HBB))
#define ssq ((float*)(ws + WS_SSQ))
#define abuf ((bf16_t*)(ws + WS_ABUF))
#define proj ((bf16_t*)(ws + WS_PROJ))
#define craw ((float*)(ws + WS_RAW))
#define ssqc ((float*)(ws + WS_RAW + (size_t)M * KVR * 4))
#define ssqq ((float*)(ws + WS_RAW + (size_t)M * KVR * 4 + (size_t)M * 16))
#define cb ((bf16_t*)(ws + WS_CB))
#define krbs ((bf16_t*)(ws + WS_KRBS))
#define cqb ((bf16_t*)(ws + WS_CQB))
#define qbuf ((bf16_t*)(ws + WS_QBUF))
#define qs ((bf16_t*)(ws + WS_QS))
#define kfull ((bf16_t*)(ws + WS_KFULL))
#define vt ((bf16_t*)(ws + WS_VT))
#define obuf ((bf16_t*)(ws + WS_OBUF))
    constexpr size_t SSQ_V = (size_t)M * 16;

    if (IN(0)) {
        LAS float* scr = (LAS float*)(lds + wave * 16384);
        int it = gw;
#define TI(W_, ks_, K_, N_, WT_, ro_) { const int n_items = ((K_) / 64) * ((N_) / 32); for (; it < n_items; it += NGW) transpose_item(W_, ks_, K_, N_, WT_, ro_, scr, it, lane); it -= n_items; }
        TI(P.in[I_POOLW] + 0 * 65536, nullptr, 256, 256, wpool, 0) TI(P.in[I_POOLW] + 1 * 65536, nullptr, 256, 256, wpool, 256)
        TI(P.in[I_POOLW] + 2 * 65536, nullptr, 256, 256, wpool, 512) TI(P.in[I_POOLW] + 3 * 65536, nullptr, 256, 256, wpool, 768)
        TI(P.in[I_WUP], P.in[I_NMLP], D, FF, wup, 0) TI(P.in[I_WUP] + (size_t)D * FF, P.in[I_NMLP] + D, D, FF, wup + (size_t)FF * D, 0)
        TI(P.in[I_WDOWN], nullptr, FF, D, wdown, 0) TI(P.in[I_WDOWN] + (size_t)D * FF, nullptr, FF, D, wdown + (size_t)FF * D, 0)
        TI(P.in[I_WGATE], P.in[I_NPLE], D, D, wgate, 0) TI(P.in[I_WGATE] + (size_t)D * D, P.in[I_NPLE] + D, D, D, wgate + (size_t)D * D, 0)
        TI(P.in[I_WPROJ], nullptr, PLE, D, wproj, 0) TI(P.in[I_WPROJ] + (size_t)PLE * D, nullptr, PLE, D, wproj + (size_t)PLE * D, 0)
        { const int n_items = (D / 64) * (320 / 32); for (; it < n_items; it += NGW) transpose_item<2>(P.in[I_WDKV], P.in[I_NKV], D, 320, wdkvq, 0, scr, it, lane); it -= n_items; }
        TI(P.in[I_WDQ], P.in[I_NMIX] + D, D, QR, wdkvq, 320)
        { const int n_items = (QR / 64) * (NH * QH / 32); for (; it < n_items; it += NGW) transpose_item<1>(P.in[I_WUQ], P.in[I_QN], QR, NH * QH, wuq, 0, scr, it, lane); it -= n_items; }
        TI(P.in[I_WUK], P.in[I_KVN], KVR, 1024, wukt, 0) TI(P.in[I_WUV], P.in[I_KVN], KVR, 1024, wuvt, 0) TI(P.in[I_WUV], nullptr, KVR, 1024, (bf16_t*)(ws + WS_WUVP), 0)
        TI(P.in[I_WO], nullptr, D, D, wo, 0)
#undef TI
        for (int i = gtid; i < 64 * D / 8; i += NGT) *(u32x4*)(wdkvq + (size_t)704 * D + (size_t)i * 8) = (u32x4){0u, 0u, 0u, 0u};
        for (int i = gtid; i < 256 * 1024 / 8; i += NGT) { const f32x4 a = *(const f32x4*)(P.in[I_WUK] + (size_t)i * 8), c = *(const f32x4*)(P.in[I_WUK] + (size_t)i * 8 + 4); *(bf16x8*)(wukb + (size_t)i * 8) = pack8v(a, c); }
        for (int i = gtid; i < NPOS * 32; i += NGT) { const int pos = i >> 5, f = i & 31; const double inv = exp2(-(double)f * (13.287712379549449 / 32.0)); const double ang = (double)pos * inv;
            double sn, cn; sincos(ang, &sn, &cn); cs[(size_t)pos * 64 + f] = (float)cn; cs[(size_t)pos * 64 + 32 + f] = (float)sn; }
        for (int i = gtid; i < 2 * M * PLE / 8; i += NGT) { const int li = i / (M * PLE / 8), r8 = i % (M * PLE / 8); const size_t e = (size_t)r8 * 8; const int row = (int)(e / PLE), c = (int)(e % PLE);
            const float* src = row < MP ? P.in[I_PP] + ((size_t)li * MP + row) * PLE + c : P.in[I_PS] + ((size_t)li * MS + (row - MP)) * PLE + c;
            *(bf16x8*)(pb + ((size_t)li * M + row) * PLE + c) = pack8v(*(const f32x4*)src, *(const f32x4*)(src + 4)); }
        for (int row0 = gw; row0 < M; row0 += 2 * NGW) {
            f32x4 v[2][4];
#pragma unroll
            for (int rr = 0; rr < 2; ++rr) { const int row = row0 + rr * NGW; if (row < M) { const float* xr = row < MP ? P.in[I_XP] + (size_t)row * D : P.in[I_XS] + (size_t)(row - MP) * D;
#pragma unroll
                for (int j = 0; j < 4; ++j) v[rr][j] = ((const f32x4*)xr)[lane + 64 * j]; } }
#pragma unroll
            for (int rr = 0; rr < 2; ++rr) { const int row = row0 + rr * NGW; if (row < M) {
                float s = 0.f;
#pragma unroll
                for (int j = 0; j < 4; ++j) s += (v[rr][j].x * v[rr][j].x + v[rr][j].y * v[rr][j].y) + (v[rr][j].z * v[rr][j].z + v[rr][j].w * v[rr][j].w);
                const float rstd = 1.0f / sqrtf(wave_sum(s) * (1.0f / D) + EPS);
                if (lane == 0) rstd0[row] = rstd;
                float* po = nullptr;
                if (row < MP) { const int b = row >> 13, t = row & (SEQ - 1); if (t >= SEQ - 15) po = out + O_PP + ((size_t)b * 15 + (t - (SEQ - 15))) * D; }
                else { const int rs_ = row - MP, b = rs_ >> 3, t = rs_ & 7; po = out + O_PS + ((size_t)b * 15 + 7 + t) * D; }
                if (po) {
#pragma unroll
                    for (int j = 0; j < 4; ++j) { const f32x4 gn = ((const f32x4*)P.in[I_NMIX])[lane + 64 * j]; ((f32x4*)po)[lane + 64 * j] = v[rr][j] * rstd * gn; } }
            } }
        }
        for (int i = gtid; i < DB * 7 * D / 4; i += NGT) { const int b = i / (7 * D / 4), r = (i / (D / 4)) % 7, c = i % (D / 4);
            ((f32x4*)(out + O_PS + ((size_t)b * 15 + r) * D))[c] = ((const f32x4*)(P.in[I_SPOOL] + ((size_t)b * 15 + 8 + r) * D))[c]; }
    }
    SEAM2(0, 2);
    if (IN(2)) {
#ifndef SUBM
#define SUBM 7
#endif
        { SgH<0> E{P.in[I_XS], P.in[I_POOLSC], nullptr, nullptr, nullptr, hbA, ssq + 0 * SSQ_V};
          for (int u = vcu; u < 256; u += G) {
              const int mt = u >> 4, gq = (u & 15) >> 2, w = 2 << gq, col = 256 * gq + 4 * lane, bs = mt * 8 + wave;
              const float* sp = P.in[I_SPOOL] + (size_t)bs * 15 * D; const float* xs0 = P.in[I_XS] + (size_t)(bs * DS) * D;
              const float rv = (lane < DS) ? rstd0[MP + bs * DS + lane] : 0.f;
              const f32x4 gn = *(const f32x4*)(P.in[I_NMIX] + col);
#pragma unroll
              for (int t = 0; t < DS; ++t) {
                  const f32x4 u0 = *(const f32x4*)(xs0 + (size_t)t * D + col) * __shfl(rv, t); f32x4 sum = u0, hist = {0.f, 0.f, 0.f, 0.f};
#pragma unroll
                  for (int i = 1; i < 16; ++i) if (i < w) { const int tt = t - i;
                      if (tt >= 0) sum += *(const f32x4*)(xs0 + (size_t)tt * D + col) * __shfl(rv, tt >= 0 ? tt : 0);
                      else hist += *(const f32x4*)(sp + (size_t)(15 + tt) * D + col); }
                  const f32x4 dd = (sum * gn + hist) / (float)w - u0 * gn;
                  u32x2 o; o.x = pk2(dd.x, dd.y); o.y = pk2(dd.z, dd.w);
                  *(u32x2*)(dbuf + (size_t)(MP + bs * DS + t) * D + col) = o;
              }
              asm volatile("s_waitcnt vmcnt(0)" ::: "memory"); __syncthreads();
              sk_gemm(lds, dbuf + (size_t)(MP + 64 * mt) * D + 256 * gq, D, wpool + (size_t)(64 * (u & 15)) * 256, 256, 64 * mt, 64 * (u & 15), u & 15, E, tid, wave, lane); } }
        { SgBf E{proj, D};
          for (int u = vcu; u < 256; u += G) sk_gemm(lds, pb + (size_t)(MP + 64 * (u >> 4)) * PLE, PLE, wproj + (size_t)(64 * (u & 15)) * PLE, PLE, 64 * (u >> 4), 64 * (u & 15), u & 15, E, tid, wave, lane); }
        { SgBf E{proj + (size_t)M * D, D};
          for (int u = vcu; u < 256; u += G) sk_gemm(lds, pb + (size_t)(M + MP + 64 * (u >> 4)) * PLE, PLE, wproj + (size_t)PLE * D + (size_t)(64 * (u & 15)) * PLE, PLE, 64 * (u >> 4), 64 * (u & 15), u & 15, E, tid, wave, lane); }
        if (SUBM & 1) { pg8::Gemm g{dbuf, wpool, MP, D, 256, D, 256}; pg8::StaticOrder S; S.init(MP, D, G, bx);
          {
            pg8::Unit uu;
            for (int i = 0; S.next(i, uu); ++i) {
#pragma unroll 1
                for (int cc = 0; cc < 2; ++cc) {
                    const int row0 = uu.pm * 256 + (2 * wave + cc) * 16, t0 = row0 & (SEQ - 1), col = 256 * uu.pn + 4 * lane;
                    const float rv = (lane < 31 && t0 - 15 + lane >= 0) ? rstd0[row0 - 15 + lane] : 0.f;
                    const int rvb = __builtin_bit_cast(int, rv);
                    const float* xr = P.in[I_XP] + (size_t)row0 * D; bf16_t* dr = dbuf + (size_t)row0 * D; const f32x4 gn = *(const f32x4*)(P.in[I_NMIX] + col);
                    if (uu.pn == 0) pool_chunk<2>(xr, rvb, gn, col, t0, dr); else if (uu.pn == 1) pool_chunk<4>(xr, rvb, gn, col, t0, dr);
                    else if (uu.pn == 2) pool_chunk<8>(xr, rvb, gn, col, t0, dr); else pool_chunk<16>(xr, rvb, gn, col, t0, dr);
                } }
            asm volatile("s_waitcnt vmcnt(0)" ::: "memory"); __syncthreads(); }
          EpiH<0> E{P.in[I_XP], P.in[I_XS], P.in[I_POOLSC], nullptr, nullptr, nullptr, hbA, ssq + 0 * SSQ_V};
          pg8::gemm_phase(lds, g, S, E); }
        if (SUBM & 2) { pg8::Gemm g{pb, wproj, MP, D, PLE, PLE, 0}; pg8::StaticOrder S; S.init(MP, D, G, bx);
          EpiBf E{proj, D};
          pg8::gemm_phase(lds, g, S, E); }
        if (SUBM & 4) { pg8::Gemm g{pb + (size_t)M * PLE, wproj + (size_t)PLE * D, MP, D, PLE, PLE, 0}; pg8::StaticOrder S; S.init(MP, D, G, bx);
          EpiBf E{proj + (size_t)M * D, D};
          pg8::gemm_phase(lds, g, S, E); }
    }
    SEAM(2);
    if (IN(3)) {
        { SgUp E{ssq + 0 * SSQ_V, abuf}; for (int u = vcu; u < 1024; u += G) sk_gemm(lds, hbA + (size_t)(MP + 64 * (u & 15)) * D, D, wup + (size_t)(64 * (u >> 4)) * D, D, 64 * (u & 15), 64 * (u >> 4), 0, E, tid, wave, lane); }
        pg8::Gemm g{hbA, wup, MP, FF, D, D, 0}; pg8::StaticOrder S; S.init(MP, FF, G, bx); EpiUp E{ssq + 0 * SSQ_V, abuf}; pg8::gemm_phase(lds, g, S, E); }
    SEAM(3);
    if (IN(4)) {
        { SgH<1> E{nullptr, nullptr, nullptr, nullptr, hbA, hbB, ssq + 1 * SSQ_V}; for (int u = vcu; u < 256; u += G) sk_gemm(lds, abuf + (size_t)(MP + 64 * (u >> 4)) * FF, FF, wdown + (size_t)(64 * (u & 15)) * FF, FF, 64 * (u >> 4), 64 * (u & 15), u & 15, E, tid, wave, lane); }
        pg8::Gemm g{abuf, wdown, MP, D, FF, FF, 0}; pg8::StaticOrder S; S.init(MP, D, G, bx);
        EpiH<1> E{nullptr, nullptr, nullptr, nullptr, nullptr, hbA, hbB, ssq + 1 * SSQ_V}; pg8::gemm_phase(lds, g, S, E); }
    SEAM(4);
    if (IN(5)) {
        { SgH<2> E{nullptr, nullptr, ssq + 1 * SSQ_V, proj, hbB, hbA, ssq + 2 * SSQ_V}; for (int u = vcu; u < 256; u += G) sk_gemm(lds, hbB + (size_t)(MP + 64 * (u >> 4)) * D, D, wgate + (size_t)(64 * (u & 15)) * D, D, 64 * (u >> 4), 64 * (u & 15), u & 15, E, tid, wave, lane); }
        pg8::Gemm g{hbB, wgate, MP, D, D, D, 0}; pg8::StaticOrder S; S.init(MP, D, G, bx);
        EpiH<2> E{nullptr, nullptr, nullptr, ssq + 1 * SSQ_V, proj, hbB, hbA, ssq + 2 * SSQ_V}; pg8::gemm_phase(lds, g, S, E); }
    SEAM(5);
    if (IN(6)) {
        pg8::Gemm g{hbA, wdkvq, M, NDKVQ, D, D, 0}; pg8::StaticOrder S; S.init(M, NDKVQ, G, bx); EpiDkvq E{ssq + 2 * SSQ_V, cs, craw, cb, cqb, ssqc, ssqq, out, kfull, krbs}; pg8::gemm_phase(lds, g, S, E); }
    SEAM2(6, 8);
    if (IN(8)) {
        if (SUBM & 1) { pg8::Gemm g{cqb, wuq, M, NH * QH, QR, QR, 0}; pg8::StaticOrder S; S.init(M, NH * QH, G, bx); EpiQ E{ssqq, cs, qbuf, qs}; pg8::gemm_phase(lds, g, S, E); }
        if (SUBM & 2) { pg8::Gemm g{cb, wukt, MP, 1024, KVR, KVR, 0}; pg8::StaticOrder S; S.init(MP, 1024, G, (bx + 128) % G); EpiKup E{kfull, ssqc}; pg8::gemm_phase(lds, g, S, E); }
        if (SUBM & 4) { pg8::Gemm g{wuvt, cb, 1024, MP, KVR, KVR, 0}; pg8::StaticOrder S; S.init(1024, MP, G, (bx + 128) % G); EpiVup E{vt, ssqc}; pg8::gemm_phase(lds, g, S, E); }
        { const f32x4 kvn = ((const f32x4*)P.in[I_KVN])[lane];
          for (int row0 = 2 * gw; row0 < M; row0 += 2 * NGW) {
              f32x4 c4[2], p4[2];
#pragma unroll
              for (int e = 0; e < 2; ++e) { c4[e] = ((const f32x4*)(craw + (size_t)(row0 + e) * KVR))[lane]; p4[e] = *(const f32x4*)(ssqc + (size_t)(row0 + e) * 4); }
#pragma unroll
              for (int e = 0; e < 2; ++e) { const int row = row0 + e; const bool isp = row < MP;
                  const float rc = 1.0f / sqrtf(((p4[e].x + p4[e].y) + (p4[e].z + p4[e].w)) * (1.0f / KVR) + EPS);
                  const f32x4 cn = c4[e] * rc * kvn;
                  float* lo_ = isp ? out + O_LP + (size_t)row * KVR : out + O_LS + (size_t)(row - MP) * KVR;
                  ((f32x4*)lo_)[lane] = cn;
                  if (!isp) { u32x2 o; o.x = pk2(cn.x, cn.y); o.y = pk2(cn.z, cn.w); ((u32x2*)(cb + (size_t)row * KVR))[lane] = o; } } } }
    }
    SEAM2(8, 10);
    if (IN(10)) {
        const bool sfirst = (bx >> 3) & 1;
        if (sfirst) for (int it = vcu; it < 2 * DB; it += G) sattn_item(P, it >> 1, it & 1, lds, tid, wave, lane);
        for (int u = vcu; u < 256; u += G) {
            const int bh = u >> 4, p = u & 15;
            attn_prompt_unit(qbuf, kfull, vt, obuf, bh >> 3, bh & 7, 31 - p, lds, tid, wave, lane);
            attn_prompt_unit(qbuf, kfull, vt, obuf, bh >> 3, bh & 7, p, lds, tid, wave, lane);
        }
        if (!sfirst) for (int it = vcu; it < 2 * DB; it += G) sattn_item(P, it >> 1, it & 1, lds, tid, wave, lane);
    }
    SEAM2(10, 12);
    if (IN(12)) {
        { SgH<1> E{nullptr, nullptr, nullptr, nullptr, hbA, hbB, ssq + 3 * SSQ_V}; const SgALoadComb AL{(const float*)(ws + WS_PART), (const float*)(ws + WS_ML)};
          for (int u = vcu; u < 256; u += G) sg_gemm_l<4, 1>(lds, AL, 0, wo, D, u, E, tid, wave, lane); }
        pg8::Gemm g{obuf, wo, MP, D, D, D, 0}; pg8::StaticOrder S; S.init(MP, D, G, bx);
        EpiH<1> E{nullptr, nullptr, nullptr, nullptr, nullptr, hbA, hbB, ssq + 3 * SSQ_V}; pg8::gemm_phase(lds, g, S, E); }
    SEAM(12);
    if (IN(13)) {
        { SgUp E{ssq + 3 * SSQ_V, abuf}; for (int u = vcu; u < 1024; u += G) sk_gemm(lds, hbB + (size_t)(MP + 64 * (u & 15)) * D, D, wup + (size_t)FF * D + (size_t)(64 * (u >> 4)) * D, D, 64 * (u & 15), 64 * (u >> 4), 0, E, tid, wave, lane); }
        pg8::Gemm g{hbB, wup + (size_t)FF * D, MP, FF, D, D, 0}; pg8::StaticOrder S; S.init(MP, FF, G, bx); EpiUp E{ssq + 3 * SSQ_V, abuf}; pg8::gemm_phase(lds, g, S, E); }
    SEAM(13);
    if (IN(14)) {
        { SgH<1> E{nullptr, nullptr, nullptr, nullptr, hbB, hbA, ssq + 4 * SSQ_V}; for (int u = vcu; u < 256; u += G) sk_gemm(lds, abuf + (size_t)(MP + 64 * (u >> 4)) * FF, FF, wdown + (size_t)FF * D + (size_t)(64 * (u & 15)) * FF, FF, 64 * (u >> 4), 64 * (u & 15), u & 15, E, tid, wave, lane); }
        pg8::Gemm g{abuf, wdown + (size_t)FF * D, MP, D, FF, FF, 0}; pg8::StaticOrder S; S.init(MP, D, G, bx);
        EpiH<1> E{nullptr, nullptr, nullptr, nullptr, nullptr, hbB, hbA, ssq + 4 * SSQ_V}; pg8::gemm_phase(lds, g, S, E); }
    SEAM(14);
    if (IN(15)) {
        { SgH<2> E{nullptr, nullptr, ssq + 4 * SSQ_V, proj + (size_t)M * D, hbA, hbB, ssq + 5 * SSQ_V}; for (int u = vcu; u < 256; u += G) sk_gemm(lds, hbA + (size_t)(MP + 64 * (u >> 4)) * D, D, wgate + (size_t)D * D + (size_t)(64 * (u & 15)) * D, D, 64 * (u >> 4), 64 * (u & 15), u & 15, E, tid, wave, lane); }
        pg8::Gemm g{hbA, wgate + (size_t)D * D, MP, D, D, D, 0}; pg8::StaticOrder S; S.init(MP, D, G, bx);
        EpiH<2> E{nullptr, nullptr, nullptr, ssq + 4 * SSQ_V, proj + (size_t)M * D, hbA, hbB, ssq + 5 * SSQ_V}; pg8::gemm_phase(lds, g, S, E); }
    SEAM(15);
    if (IN(16)) {
        f32x4 gn[4];
#pragma unroll
        for (int j = 0; j < 4; ++j) gn[j] = ((const f32x4*)P.in[I_NFIN])[lane + 64 * j];
        for (int row0 = 4 * gw; row0 < M; row0 += 4 * NGW) {
            u32x2 hv[4][4]; float sp[4];
#pragma unroll
            for (int e = 0; e < 4; ++e) { sp[e] = (lane < 16) ? ssq[5 * SSQ_V + (size_t)(row0 + e) * 16 + lane] : 0.f;
#pragma unroll
                for (int j = 0; j < 4; ++j) hv[e][j] = ((const u32x2*)(hbB + (size_t)(row0 + e) * D))[lane + 64 * j]; }
#pragma unroll
            for (int e = 0; e < 4; ++e) { const float rstd = 1.0f / sqrtf(wave_sum(sp[e]) * (1.0f / D) + EPS);
#pragma unroll
                for (int j = 0; j < 4; ++j) ((f32x4*)(out + O_Y + (size_t)(row0 + e) * D))[lane + 64 * j] = unpk4(hv[e][j]) * rstd * gn[j]; }
        }
    }
#undef IN
#undef SEAM
#undef SEAM2
#undef wpool
#undef wup
#undef wdown
#undef wgate
#undef wproj
#undef wdkvq
#undef wuq
#undef wukt
#undef wuvt
#undef wukb
#undef wo
#undef cs
#undef rstd0
#undef dbuf
#undef pb
#undef hbA
#undef hbB
#undef ssq
#undef abuf
#undef proj
#undef craw
#undef ssqc
#undef ssqq
#undef cb
#undef krbs
#undef cqb
#undef qbuf
#undef qs
#undef kfull
#undef vt
#undef obuf
}

extern "C" void kernel_launch(void* const* d_in, const int* in_sizes, int n_in, void* d_out, int out_size, void* d_ws, size_t ws_size, hipStream_t stream) {
    static int grid = 0;
    if (grid == 0) {
        if (n_in != 27 || (size_t)out_size != O_END || ws_size < WS_END) { fprintf(stderr, "kernel_launch: shape mismatch (n_in %d, out %d, ws %zu; need 27, %zu, %zu)\n", n_in, out_size, ws_size, (size_t)O_END, (size_t)WS_END); grid = -1; return; }
        int dev = 0, cus = 0, per_cu = 0;
        if (hipGetDevice(&dev) != hipSuccess || hipDeviceGetAttribute(&cus, hipDeviceAttributeMultiprocessorCount, dev) != hipSuccess) { grid = -1; return; }
        if (hipFuncSetAttribute((const void*)yoco_fwd, hipFuncAttributeMaxDynamicSharedMemorySize, LDS_BYTES) != hipSuccess) { fprintf(stderr, "kernel_launch: hipFuncSetAttribute failed\n"); grid = -1; return; }
        if (hipOccupancyMaxActiveBlocksPerMultiprocessor(&per_cu, (const void*)yoco_fwd, 512, LDS_BYTES) != hipSuccess || per_cu < 1) fprintf(stderr, "kernel_launch: occupancy query reports %d\n", per_cu);
        (void)hipGetLastError();
        grid = cus;
    }
    if (grid < 0) return;
    (void)hipMemsetAsync((char*)d_ws + WS_CTL, 0, CTL_BYTES, stream);
    Params p{};
    for (int i = 0; i < 27; ++i) p.in[i] = (const float*)d_in[i];
    p.out = (float*)d_out; p.ws = (unsigned char*)d_ws;
#if MK_N_LAUNCHES == 1
    p.ph_lo = 0; p.ph_hi = NPH;
    hipLaunchKernelGGL(yoco_fwd, dim3(grid), dim3(512), LDS_BYTES, stream, p);
#else
    for (int k = 0; k < NPH; ++k) { p.ph_lo = k; p.ph_hi = k + 1; hipLaunchKernelGGL(yoco_fwd, dim3(grid), dim3(512), LDS_BYTES, stream, p); }
#endif
    const hipError_t le = hipPeekAtLastError();
    if (le != hipSuccess) fprintf(stderr, "kernel_launch: launch failed: %s\n", hipGetErrorName(le));
}
```

```cpp
#include <hip/hip_runtime.h>
#include <cstdio>
#include <cstdint>

#ifndef MK_N_LAUNCHES
#define MK_N_LAUNCHES 1
#endif

#define GAS __attribute__((address_space(1)))
#define LAS __attribute__((address_space(3)))
typedef unsigned short bf16_t;
typedef short bf16x8 __attribute__((ext_vector_type(8)));
typedef float f32x4 __attribute__((ext_vector_type(4)));
typedef float f32x16 __attribute__((ext_vector_type(16)));
typedef unsigned u32x2 __attribute__((ext_vector_type(2)));
typedef unsigned u32x4 __attribute__((ext_vector_type(4)));

constexpr int D = 1024, FF = 4096, PLE = 256, SEQ = 8192, NBATCH = 2, DB = 128, DS = 8;
constexpr int MP = NBATCH * SEQ;
constexpr int MS = DB * DS;
constexpr int M = MP + MS;
constexpr int KVR = 256, ROPE = 64, QR = 384, NH = 8, NOPE = 128, VD = 128, QH = NOPE + ROPE;
constexpr int NDKVQ = 768;
constexpr int PAST = 8192, PAGE = 128, NPG = PAST / PAGE;
constexpr float EPS = 1e-6f;
constexpr float SM_SCALE = 0.07216878364870322f;
constexpr float LOG2E = 1.4426950408889634f;
constexpr float CEXP = SM_SCALE * LOG2E;
constexpr int NPOS = PAST + DS;

constexpr size_t O_Y = 0;
constexpr size_t O_PP = (size_t)M * D;
constexpr size_t O_PS = O_PP + (size_t)NBATCH * 15 * D;
constexpr size_t O_LP = O_PS + (size_t)DB * 15 * D;
constexpr size_t O_KP = O_LP + (size_t)MP * KVR;
constexpr size_t O_LS = O_KP + (size_t)MP * ROPE;
constexpr size_t O_KS = O_LS + (size_t)MS * KVR;
constexpr size_t O_END = O_KS + (size_t)MS * ROPE;

constexpr size_t al256(size_t x) { return (x + 255) / 256 * 256; }
constexpr size_t WS_CTL = 0, CTL_BYTES = 1u << 20;
constexpr size_t WS_WPOOL = CTL_BYTES;
constexpr size_t WS_WUP   = WS_WPOOL + al256((size_t)1024 * 256 * 2);
constexpr size_t WS_WDOWN = WS_WUP   + al256((size_t)2 * FF * D * 2);
constexpr size_t WS_WGATE = WS_WDOWN + al256((size_t)2 * FF * D * 2);
constexpr size_t WS_WPROJ = WS_WGATE + al256((size_t)2 * D * D * 2);
constexpr size_t WS_WDKVQ = WS_WPROJ + al256((size_t)2 * D * PLE * 2);
constexpr size_t WS_WUQ   = WS_WDKVQ + al256((size_t)NDKVQ * D * 2);
constexpr size_t WS_WUKT  = WS_WUQ   + al256((size_t)NH * QH * QR * 2);
constexpr size_t WS_WUVT  = WS_WUKT  + al256((size_t)1024 * 256 * 2);
constexpr size_t WS_WUVP  = WS_WUVT  + al256((size_t)1024 * 256 * 2);
constexpr size_t WS_WUKB  = WS_WUVP  + al256((size_t)1024 * 256 * 2);
constexpr size_t WS_WO    = WS_WUKB  + al256((size_t)1024 * 256 * 2);
constexpr size_t WS_CS    = WS_WO    + al256((size_t)D * D * 2);
constexpr size_t WS_RSTD0 = WS_CS    + al256((size_t)NPOS * 64 * 4);
constexpr size_t WS_DBUF  = WS_RSTD0 + al256((size_t)M * 4);
constexpr size_t WS_PB    = WS_DBUF  + al256((size_t)M * D * 2);
constexpr size_t WS_HBA   = WS_PB    + al256((size_t)2 * M * PLE * 2);
constexpr size_t WS_HBB   = WS_HBA   + al256((size_t)M * D * 2);
constexpr size_t WS_SSQ   = WS_HBB   + al256((size_t)M * D * 2);
constexpr size_t WS_ABUF  = WS_SSQ   + al256((size_t)6 * M * 16 * 4);
constexpr size_t WS_PROJ  = WS_ABUF  + al256((size_t)M * FF * 2);
constexpr size_t WS_RAW   = WS_PROJ  + al256((size_t)2 * M * D * 2);
constexpr size_t WS_CB    = WS_RAW   + al256((size_t)M * NDKVQ * 4);
constexpr size_t WS_KRBS  = WS_CB    + al256((size_t)M * KVR * 2);
constexpr size_t WS_CQB   = WS_KRBS  + al256((size_t)MS * ROPE * 2);
constexpr size_t WS_RSTDQ = WS_CQB   + al256((size_t)M * QR * 2);
constexpr size_t WS_QBUF  = WS_RSTDQ + al256((size_t)M * 4);
constexpr size_t WS_QS    = WS_QBUF  + al256((size_t)M * NH * QH * 2);
constexpr size_t WS_KFULL = WS_QS    + al256((size_t)MS * NH * 320 * 2);
constexpr size_t WS_VT    = WS_KFULL + al256((size_t)16 * SEQ * QH * 2);
constexpr size_t WS_OBUF  = WS_VT    + al256((size_t)16 * VD * SEQ * 2);
constexpr size_t WS_PART  = WS_OBUF  + al256((size_t)M * D * 2);
constexpr size_t WS_ML    = WS_PART  + al256((size_t)DB * 8 * 64 * 256 * 4);
constexpr size_t WS_END   = WS_ML    + al256((size_t)DB * 8 * 64 * 2 * 4);

constexpr int CW_BAR = 4096;
constexpr int CW_SCNT = 16384;

constexpr int RING_BYTES = 131072;
constexpr int LDS_BYTES = 147456;
constexpr int MISC_OFF = LDS_BYTES - 256;

typedef float f32x2 __attribute__((ext_vector_type(2)));
typedef __bf16 nbf16x2 __attribute__((ext_vector_type(2)));
__device__ __forceinline__ unsigned pk2(float lo, float hi) { const f32x2 v = {lo, hi}; return __builtin_bit_cast(unsigned, __builtin_convertvector(v, nbf16x2)); }
__device__ __forceinline__ unsigned f2bf(float f) { return pk2(f, 0.f) & 0xffffu; }
__device__ __forceinline__ float bf2f(unsigned short b) { return __builtin_bit_cast(float, ((unsigned)b) << 16); }
__device__ __forceinline__ f32x4 unpk4(u32x2 w) { f32x4 r; r.x = __builtin_bit_cast(float, w.x << 16); r.y = __builtin_bit_cast(float, w.x & 0xffff0000u); r.z = __builtin_bit_cast(float, w.y << 16); r.w = __builtin_bit_cast(float, w.y & 0xffff0000u); return r; }
__device__ __forceinline__ bf16x8 pack8(const float* v) { u32x4 w; w.x = pk2(v[0], v[1]); w.y = pk2(v[2], v[3]); w.z = pk2(v[4], v[5]); w.w = pk2(v[6], v[7]); return __builtin_bit_cast(bf16x8, w); }
__device__ __forceinline__ bf16x8 pack8v(f32x4 a, f32x4 b) { u32x4 w; w.x = pk2(a.x, a.y); w.y = pk2(a.z, a.w); w.z = pk2(b.x, b.y); w.w = pk2(b.z, b.w); return __builtin_bit_cast(bf16x8, w); }
__device__ __forceinline__ float wave_sum(float v) {
#pragma unroll
    for (int o = 1; o < 64; o <<= 1) v += __shfl_xor(v, o);
    return v;
}
__device__ __forceinline__ int crow(int r, int hi) { return (r & 3) + 8 * (r >> 2) + 4 * hi; }
#define LDS_WAIT() asm volatile("s_waitcnt lgkmcnt(0)" ::: "memory")
#define VM_WAIT() asm volatile("s_waitcnt vmcnt(0)" ::: "memory")

#define XB_TMO      128
#define XB_XCNT(j)  (256  + 64 * (j))
#define XB_XSUB(j)  (1280 + 64 * (j))
#define XB_XGEN(j)  (2304 + 64 * (j))
#define XB_TOP      3328
#define XB_TOPGEN   3392
#define XCD_BAR_WORDS 3456
#define XB_SPIN_CAP (1u << 18)
__device__ __forceinline__ unsigned xb_ld(unsigned* p)              { return __hip_atomic_load(p, __ATOMIC_RELAXED, __HIP_MEMORY_SCOPE_AGENT); }
__device__ __forceinline__ unsigned xb_add(unsigned* p, unsigned v) { return __hip_atomic_fetch_add(p, v, __ATOMIC_RELAXED, __HIP_MEMORY_SCOPE_AGENT); }
__device__ __forceinline__ unsigned xb_xcc_id() { return (unsigned)__builtin_amdgcn_s_getreg((3 << 11) | 20) & 0xFu; }
#define XB_SPIN(cond, bar) do { unsigned _sp = 0; while (cond) { __builtin_amdgcn_s_sleep(1); \
    if ((++_sp & 255u) == 0u) { if (xb_ld(&(bar)[XB_TMO])) break; if (_sp > XB_SPIN_CAP) { atomicAdd(&(bar)[XB_TMO], 1u); break; } } } } while (0)
struct XcdBarrier { unsigned* bar; unsigned x; volatile LAS unsigned* st; };
__device__ __forceinline__ XcdBarrier xcd_barrier_post(unsigned* bar, volatile LAS unsigned* st) {
    XcdBarrier b; b.bar = bar; b.x = xb_xcc_id(); b.st = st;
    if (threadIdx.x == 0) (void)xb_add(&bar[XB_XCNT(b.x)], 1u);
    return b;
}
__device__ __forceinline__ void xcd_barrier_complete(unsigned* bar, unsigned x, unsigned& nloc, unsigned& nx) {
    const unsigned G = gridDim.x * gridDim.y * gridDim.z;
    unsigned sum, cnt, mine, sp = 0u;
    for (;;) {
        sum = 0u; cnt = 0u; mine = 0u;
#pragma unroll
        for (unsigned j = 0; j < 16; ++j) { const unsigned c = xb_ld(&bar[XB_XCNT(j)]); sum += c; cnt += (c > 0u) ? 1u : 0u; mine = (j == x) ? c : mine; }
        if (sum == G) break;
        __builtin_amdgcn_s_sleep(1);
        if ((++sp & 255u) == 0u) { if (xb_ld(&bar[XB_TMO])) break; if (sp > XB_SPIN_CAP) { atomicAdd(&bar[XB_TMO], 1u); break; } }
    }
    nloc = mine > 0u ? mine : 1u; nx = cnt > 0u ? cnt : 1u;
}
__device__ __forceinline__ void xcd_barrier(const XcdBarrier& b) {
    asm volatile("s_waitcnt vmcnt(0)" ::: "memory");
    __syncthreads();
    if (threadIdx.x == 0) {
        unsigned* bar = b.bar;
        __builtin_amdgcn_s_waitcnt(0);
        unsigned nloc = b.st[0], nx = b.st[1];
        if (nloc == 0u) { xcd_barrier_complete(bar, b.x, nloc, nx); b.st[0] = nloc; b.st[1] = nx; }
        const unsigned old = xb_add(&bar[XB_XSUB(b.x)], 1u);
        const unsigned gen = old / nloc;
        if (old + 1u == (gen + 1u) * nloc) {
            __builtin_amdgcn_fence(__ATOMIC_RELEASE, "agent");
            asm volatile("s_waitcnt vmcnt(0)" ::: "memory");
            const unsigned og = xb_add(&bar[XB_TOP], 1u);
            const unsigned tg = og / nx;
            if (og + 1u == (tg + 1u) * nx) xb_add(&bar[XB_TOPGEN], 1u);
            else XB_SPIN(xb_ld(&bar[XB_TOPGEN]) == tg, bar);
            __builtin_amdgcn_fence(__ATOMIC_ACQUIRE, "agent");
            xb_add(&bar[XB_XGEN(b.x)], 1u);
            asm volatile("s_waitcnt vmcnt(0)" ::: "memory");
        } else {
            XB_SPIN(xb_ld(&bar[XB_XGEN(b.x)]) == gen, bar);
            __builtin_amdgcn_fence(__ATOMIC_ACQUIRE, "agent");
            asm volatile("s_waitcnt vmcnt(0)" ::: "memory");
        }
    }
    __syncthreads();
}

namespace pg8 {
constexpr int BM = 256, BK = 64, HALF = 128, HTB = HALF * BK * 2, STAGE_BYTES = 8 * HTB, NXCD = 8, WGM = 8;
__host__ __device__ __forceinline__ int lds_byte(int r, int c) { const int st = (r >> 4) * 2 + (c >> 5), rr = r & 15, cc = c & 31, ob = rr * 64 + cc * 2; return st * 1024 + (ob ^ (((ob >> 9) & 1) << 5)); }
__host__ __device__ __forceinline__ int perm32(int rho) { const int n = rho >> 4, i = rho & 15; return 8 * (i >> 2) + 4 * n + (i & 3); }
__host__ __device__ __forceinline__ void stage_rc(int b, int& R, int& C) { const int st = b / 1024, sb = b % 1024, swz = sb ^ (((sb >> 9) & 1) << 5); R = (st >> 1) * 16 + swz / 64; C = (st & 1) * 32 + (swz % 64) / 2; }
struct Unit { int pm, pn; };
struct Gemm { const bf16_t* A; const bf16_t* Bt; int M, N, K, lda, apn; };
struct StaticOrder {
    int nM, nN, nwg, G, c;
    __device__ __forceinline__ void init(int M, int N, int G_, int c_) { nM = M / BM; nN = N / BM; nwg = nM * nN; G = G_; c = c_; }
    __device__ __forceinline__ bool next(int i, Unit& u) const {
        const long L = (long)i * G + c; if (L >= nwg) return false;
        int wgid = (int)L; { const int q = nwg / NXCD, r = nwg % NXCD, xcd = wgid % NXCD, off = wgid / NXCD; wgid = (xcd < r ? xcd * (q + 1) : r * (q + 1) + (xcd - r) * q) + off; }
        const int nig = WGM * nN, gid = wgid / nig, fm = gid * WGM, gsz = (nM - fm) < WGM ? (nM - fm) : WGM;
        u.pm = fm + ((wgid % nig) % gsz); u.pn = (wgid % nig) / gsz; return true;
    }
};
template <class Epi>
__device__ __forceinline__ void gemm_phase(LAS unsigned char* lds, const Gemm g, const StaticOrder& S, const Epi& E) {
    const int tid = threadIdx.x, wid = __builtin_amdgcn_readfirstlane(tid >> 6), lane = tid & 63, wr = wid >> 2, wc = wid & 3, fr = lane & 15, fq = lane >> 4;
    const int K = g.K, nt = K / BK, lda = g.lda;
    unsigned voffA[2], voffB[2];
#pragma unroll
    for (int i = 0; i < 2; ++i) { int R, C; stage_rc(tid * 16 + i * 8192, R, C);
        const int Rb = Epi::PERM ? ((R & ~31) + perm32(R & 31)) : R;
        voffA[i] = (unsigned)(R * lda + C) * 2u; voffB[i] = (unsigned)(Rb * K + C) * 2u; }
    const size_t kstep = (size_t)(BK * 2);
    const size_t hstepA = (size_t)HALF * lda * 2, hstepB = (size_t)HALF * K * 2;
    const size_t tstepA = 2 * hstepA, tstepB = 2 * hstepB, pnA = (size_t)g.apn * 2;
    const unsigned ldsw = (unsigned)wid * 1024u;
    const int aoff = lds_byte(wr * 64 + fr, fq * 8), boff = lds_byte(wc * 32 + fr, fq * 8);
#define PG8_SA(b, h) (((b) * 2 + (h)) * HTB)
#define PG8_SB(b, h) ((4 + (b) * 2 + (h)) * HTB)
#define PG8_STAGE(bufoff, gbase, voff) do { _Pragma("unroll") for (int _i = 0; _i < 2; ++_i) \
        __builtin_amdgcn_global_load_lds((const unsigned*)((const char*)(gbase) + (voff)[_i]), (LAS unsigned*)(lds + (bufoff) + ldsw + _i * 8192), 16, 0, 0); } while (0)
#define PG8_LDA(dst, b, h) do { _Pragma("unroll") for (int m = 0; m < 4; ++m) _Pragma("unroll") for (int k = 0; k < 2; ++k) dst[m][k] = *(const LAS bf16x8*)(lds + PG8_SA(b, h) + aoff + m * 2048 + k * 1024); } while (0)
#define PG8_LDB(dst, b, h) do { _Pragma("unroll") for (int n = 0; n < 2; ++n) _Pragma("unroll") for (int k = 0; k < 2; ++k) dst[n][k] = *(const LAS bf16x8*)(lds + PG8_SB(b, h) + boff + n * 2048 + k * 1024); } while (0)
#define PG8_MMA(ai, bj, At, Bt) do { __builtin_amdgcn_s_setprio(1); _Pragma("unroll") for (int m = 0; m < 4; ++m) _Pragma("unroll") for (int n = 0; n < 2; ++n) _Pragma("unroll") for (int k = 0; k < 2; ++k) \
        acc[ai][bj][m][n] = __builtin_amdgcn_mfma_f32_16x16x32_bf16(Bt[n][k], At[m][k], acc[ai][bj][m][n], 0, 0, 0); __builtin_amdgcn_s_setprio(0); } while (0)
#define PG8_WAIT_V(n) asm volatile("s_waitcnt vmcnt(" #n ")" ::: "memory")
#define PG8_WAIT_L(n) asm volatile("s_waitcnt lgkmcnt(" #n ")" ::: "memory")
#define PG8_BAR __builtin_amdgcn_s_barrier()
#define PG8_SCHED __builtin_amdgcn_sched_barrier(0)
    Unit cur, nxt; int ui = 0;
    if (!S.next(0, cur)) return;
    f32x4 acc[2][2][4][2];
#pragma unroll
    for (int a = 0; a < 2; ++a)
#pragma unroll
        for (int b = 0; b < 2; ++b)
#pragma unroll
            for (int m = 0; m < 4; ++m)
#pragma unroll
                for (int n = 0; n < 2; ++n) acc[a][b][m][n] = (f32x4){0.f, 0.f, 0.f, 0.f};
    bf16x8 At[4][2], B0[2][2], B1[2][2];
    const char* cA = (const char*)g.A + (size_t)cur.pm * tstepA + (size_t)cur.pn * pnA; const char* cB = (const char*)g.Bt + (size_t)cur.pn * tstepB;
    PG8_STAGE(PG8_SB(0, 0), cB, voffB); PG8_STAGE(PG8_SB(0, 1), cB + hstepB, voffB); PG8_STAGE(PG8_SA(0, 0), cA, voffA); PG8_STAGE(PG8_SA(0, 1), cA + hstepA, voffA);
    if (wr == 1) PG8_BAR;
    PG8_WAIT_V(2); PG8_BAR;
    PG8_STAGE(PG8_SB(1, 0), cB + kstep, voffB); PG8_STAGE(PG8_SA(1, 0), cA + kstep, voffA); PG8_STAGE(PG8_SB(1, 1), cB + hstepB + kstep, voffB);
    PG8_WAIT_V(6); PG8_BAR;
    for (;;) {
        const bool has_next = S.next(ui + 1, nxt);
        const char* nA = has_next ? (const char*)g.A + (size_t)nxt.pm * tstepA + (size_t)nxt.pn * pnA : cA; const char* nB = has_next ? (const char*)g.Bt + (size_t)nxt.pn * tstepB : cB;
#pragma unroll 1
        for (int t = 0; t < nt; t += 2) {
            const bool last = (t == nt - 2);
            const char* a1 = cA + (size_t)(t + 1) * kstep;
            const char* a2 = last ? nA : cA + (size_t)(t + 2) * kstep; const char* b2 = last ? nB : cB + (size_t)(t + 2) * kstep;
            const char* a3 = a2 + kstep; const char* b3 = b2 + kstep;
            PG8_LDB(B0, 0, 0); PG8_LDB(B1, 0, 1); PG8_SCHED; PG8_LDA(At, 0, 0); PG8_STAGE(PG8_SA(1, 1), a1 + hstepA, voffA);
            PG8_WAIT_V(8); PG8_WAIT_L(0); PG8_BAR; PG8_MMA(0, 0, At, B0); PG8_MMA(0, 1, At, B1); PG8_BAR; PG8_SCHED;
            PG8_LDA(At, 0, 1); PG8_STAGE(PG8_SB(0, 0), b2, voffB); PG8_STAGE(PG8_SB(0, 1), b2 + hstepB, voffB); PG8_STAGE(PG8_SA(0, 0), a2, voffA);
            PG8_WAIT_V(8); PG8_WAIT_L(0); PG8_BAR; PG8_MMA(1, 0, At, B0); PG8_MMA(1, 1, At, B1); PG8_BAR; PG8_SCHED;
            PG8_LDB(B0, 1, 0); PG8_LDB(B1, 1, 1); PG8_SCHED; PG8_LDA(At, 1, 0); PG8_STAGE(PG8_SA(0, 1), a2 + hstepA, voffA);
            PG8_WAIT_V(8); PG8_WAIT_L(0); PG8_BAR; PG8_MMA(0, 0, At, B0); PG8_MMA(0, 1, At, B1); PG8_BAR; PG8_SCHED;
            PG8_LDA(At, 1, 1); PG8_STAGE(PG8_SB(1, 0), b3, voffB); PG8_STAGE(PG8_SB(1, 1), b3 + hstepB, voffB); PG8_STAGE(PG8_SA(1, 0), a3, voffA);
            PG8_WAIT_V(8); PG8_WAIT_L(0); PG8_BAR; PG8_MMA(1, 0, At, B0); PG8_MMA(1, 1, At, B1); PG8_BAR; PG8_SCHED;
        }
        if (wr == 0) PG8_BAR;
        E(acc, cur, wr, wc, fr, fq);
        if (!has_next) break;
#pragma unroll
        for (int a = 0; a < 2; ++a)
#pragma unroll
            for (int b = 0; b < 2; ++b)
#pragma unroll
                for (int m = 0; m < 4; ++m)
#pragma unroll
                    for (int n = 0; n < 2; ++n) acc[a][b][m][n] = (f32x4){0.f, 0.f, 0.f, 0.f};
        cur = nxt; cA = nA; cB = nB; ++ui;
        if (wr == 1) PG8_BAR;
    }
    PG8_WAIT_V(0);
    PG8_BAR;
#undef PG8_SA
#undef PG8_SB
#undef PG8_STAGE
#undef PG8_LDA
#undef PG8_LDB
#undef PG8_MMA
#undef PG8_WAIT_V
#undef PG8_WAIT_L
#undef PG8_BAR
#undef PG8_SCHED
}
}

struct Params { const float* in[27]; float* out; unsigned char* ws; int ph_lo, ph_hi; };
enum { I_XP = 0, I_XS, I_PP, I_PS, I_SPOOL, I_CLAT, I_CKR, I_PT, I_NMIX, I_NMLP, I_NPLE, I_POOLW, I_POOLSC, I_NKV, I_WDKV, I_KVN, I_WUK, I_WUV, I_WDQ, I_QN, I_WUQ, I_WO, I_WUP, I_WDOWN, I_WGATE, I_WPROJ, I_NFIN };

__device__ __forceinline__ void load_rstd(const float* ssq, const pg8::Unit& u, int wr, int fr, int fq, float (&rs)[2][4]) {
#pragma unroll
    for (int ai = 0; ai < 2; ++ai)
#pragma unroll
        for (int m = 0; m < 4; ++m) {
            const int row = u.pm * 256 + ai * 128 + wr * 64 + m * 16 + fr;
            const f32x4 a = ((const f32x4*)(ssq + (size_t)row * 16))[fq];
            float t = (a.x + a.y) + (a.z + a.w);
            t += __shfl_xor(t, 16); t += __shfl_xor(t, 32);
            rs[ai][m] = 1.0f / sqrtf(t * (1.0f / 1024.0f) + EPS);
        }
}
template <int NS> __device__ __forceinline__ void load_rstd_p(const float* ssqp, float inv_n, const pg8::Unit& u, int wr, int fr, int fq, float (&rs)[2][4]) {
#pragma unroll
    for (int ai = 0; ai < 2; ++ai)
#pragma unroll
        for (int m = 0; m < 4; ++m) {
            const int row = u.pm * 256 + ai * 128 + wr * 64 + m * 16 + fr;
            float t;
            if (NS == 4) t = ssqp[(size_t)row * 4 + fq]; else { const f32x2 a = ((const f32x2*)(ssqp + (size_t)row * 8))[fq]; t = a.x + a.y; }
            t += __shfl_xor(t, 16); t += __shfl_xor(t, 32);
            rs[ai][m] = 1.0f / sqrtf(t * inv_n + EPS);
        }
}
template <int MODE> struct EpiH {
    static constexpr bool PERM = true;
    const float* xp; const float* xs; const float* scale; const float* ssq_in; const bf16_t* proj;
    const bf16_t* hb_in; bf16_t* hb; float* ssq_out;
    __device__ __forceinline__ void operator()(const f32x4 (&acc)[2][2][4][2], const pg8::Unit& u, int wr, int wc, int fr_in, int fq_in) const {
        int fr = fr_in, fq = fq_in; asm volatile("" : "+v"(fr), "+v"(fq));
        float rs[2][4];
        if (MODE == 2) load_rstd(ssq_in, u, wr, fr, fq, rs);
        const int col0 = u.pn * 256 + wc * 32 + 8 * fq;
#pragma unroll
        for (int ai = 0; ai < 2; ++ai)
#pragma unroll
            for (int m = 0; m < 4; ++m) {
                const int row = u.pm * 256 + ai * 128 + wr * 64 + m * 16 + fr;
                float sq = 0.f;
#pragma unroll
                for (int bj = 0; bj < 2; ++bj) {
                    const int col = col0 + bj * 128;
                    f32x4 b0, b1;
                    if (MODE == 0) { const float* xr = (row < MP ? xp + (size_t)row * D : xs + (size_t)(row - MP) * D) + col; b0 = *(const f32x4*)xr; b1 = *(const f32x4*)(xr + 4); }
                    else { const u32x4 hv = *(const u32x4*)(hb_in + (size_t)row * D + col); b0 = unpk4((u32x2){hv.x, hv.y}); b1 = unpk4((u32x2){hv.z, hv.w}); }
                    const f32x4 a0 = acc[ai][bj][m][0], a1 = acc[ai][bj][m][1]; f32x4 o0, o1;
                    if (MODE == 0) { o0 = b0 + *(const f32x4*)(scale + col) * a0; o1 = b1 + *(const f32x4*)(scale + col + 4) * a1; }
                    else if (MODE == 1) { o0 = b0 + a0; o1 = b1 + a1; }
                    else { const u32x4 pv = *(const u32x4*)(proj + (size_t)row * D + col); const f32x4 p0 = unpk4((u32x2){pv.x, pv.y}), p1 = unpk4((u32x2){pv.z, pv.w}); const float r = rs[ai][m];
                        f32x4 g0, g1;
                        g0.x = 1.0f / (1.0f + __expf(-r * a0.x)); g0.y = 1.0f / (1.0f + __expf(-r * a0.y)); g0.z = 1.0f / (1.0f + __expf(-r * a0.z)); g0.w = 1.0f / (1.0f + __expf(-r * a0.w));
                        g1.x = 1.0f / (1.0f + __expf(-r * a1.x)); g1.y = 1.0f / (1.0f + __expf(-r * a1.y)); g1.z = 1.0f / (1.0f + __expf(-r * a1.z)); g1.w = 1.0f / (1.0f + __expf(-r * a1.w));
                        o0 = b0 + g0 * p0; o1 = b1 + g1 * p1; }
                    u32x4 w; w.x = pk2(o0.x, o0.y); w.y = pk2(o0.z, o0.w); w.z = pk2(o1.x, o1.y); w.w = pk2(o1.z, o1.w);
                    *(u32x4*)(hb + (size_t)row * D + col) = w;
                    sq += ((o0.x * o0.x + o0.y * o0.y) + (o0.z * o0.z + o0.w * o0.w)) + ((o1.x * o1.x + o1.y * o1.y) + (o1.z * o1.z + o1.w * o1.w));
                }
                sq += __shfl_xor(sq, 16); sq += __shfl_xor(sq, 32);
                if (fq == 0) ssq_out[(size_t)row * 16 + u.pn * 4 + wc] = sq;
                asm volatile("" ::: "memory");
            }
    }
};
struct EpiUp {
    static constexpr bool PERM = true;
    const float* ssq_in; bf16_t* abuf;
    __device__ __forceinline__ void operator()(const f32x4 (&acc)[2][2][4][2], const pg8::Unit& u, int wr, int wc, int fr_in, int fq_in) const {
        int fr = fr_in, fq = fq_in; asm volatile("" : "+v"(fr), "+v"(fq));
        float rs[2][4]; load_rstd(ssq_in, u, wr, fr, fq, rs);
        const int col0 = u.pn * 256 + wc * 32 + 8 * fq;
#pragma unroll
        for (int ai = 0; ai < 2; ++ai)
#pragma unroll
            for (int m = 0; m < 4; ++m) {
                const int row = u.pm * 256 + ai * 128 + wr * 64 + m * 16 + fr; const float r = rs[ai][m];
#pragma unroll
                for (int bj = 0; bj < 2; ++bj) {
                    f32x4 a = acc[ai][bj][m][0] * r, c = acc[ai][bj][m][1] * r;
                    a.x = fmaxf(a.x, 0.f); a.y = fmaxf(a.y, 0.f); a.z = fmaxf(a.z, 0.f); a.w = fmaxf(a.w, 0.f);
                    c.x = fmaxf(c.x, 0.f); c.y = fmaxf(c.y, 0.f); c.z = fmaxf(c.z, 0.f); c.w = fmaxf(c.w, 0.f);
                    u32x4 w; w.x = pk2(a.x * a.x, a.y * a.y); w.y = pk2(a.z * a.z, a.w * a.w); w.z = pk2(c.x * c.x, c.y * c.y); w.w = pk2(c.z * c.z, c.w * c.w);
                    *(u32x4*)(abuf + (size_t)row * FF + col0 + bj * 128) = w;
                }
            }
    }
};
template <int MODE> struct EpiF32 {
    static constexpr bool PERM = false;
    float* C; int ldc; const float* aux;
    __device__ __forceinline__ void operator()(const f32x4 (&acc)[2][2][4][2], const pg8::Unit& u, int wr, int wc, int fr_in, int fq_in) const {
        int fr = fr_in, fq = fq_in; asm volatile("" : "+v"(fr), "+v"(fq));
        float rs[2][4];
        if (MODE == 1) load_rstd(aux, u, wr, fr, fq, rs);
        const int col0 = u.pn * 256 + wc * 32 + 4 * fq;
#pragma unroll
        for (int ai = 0; ai < 2; ++ai)
#pragma unroll
            for (int m = 0; m < 4; ++m) {
                const int row = u.pm * 256 + ai * 128 + wr * 64 + m * 16 + fr;
                const float r = (MODE == 1) ? rs[ai][m] : (MODE == 2 ? aux[row] : 1.0f);
#pragma unroll
                for (int bj = 0; bj < 2; ++bj)
#pragma unroll
                    for (int n = 0; n < 2; ++n) *(f32x4*)(C + (size_t)row * ldc + col0 + bj * 128 + n * 16) = acc[ai][bj][m][n] * r;
            }
    }
};
struct EpiBf {
    static constexpr bool PERM = true;
    bf16_t* C; int ldc;
    __device__ __forceinline__ void operator()(const f32x4 (&acc)[2][2][4][2], const pg8::Unit& u, int wr, int wc, int fr_in, int fq_in) const {
        int fr = fr_in, fq = fq_in; asm volatile("" : "+v"(fr), "+v"(fq));
        const int col0 = u.pn * 256 + wc * 32 + 8 * fq;
#pragma unroll
        for (int ai = 0; ai < 2; ++ai)
#pragma unroll
            for (int m = 0; m < 4; ++m) {
                const int row = u.pm * 256 + ai * 128 + wr * 64 + m * 16 + fr;
#pragma unroll
                for (int bj = 0; bj < 2; ++bj) { const f32x4 a = acc[ai][bj][m][0], c = acc[ai][bj][m][1]; u32x4 w; w.x = pk2(a.x, a.y); w.y = pk2(a.z, a.w); w.z = pk2(c.x, c.y); w.w = pk2(c.z, c.w);
                    *(u32x4*)(C + (size_t)row * ldc + col0 + bj * 128) = w; }
            }
    }
};
__host__ __device__ __forceinline__ int kperm(int c) { if (c < KVR) return c; const int r = c - KVR, i = r & 31, sec = r >> 5; return KVR + 32 * (i >> 4) + 16 * sec + (i & 15); }
__host__ __device__ __forceinline__ int qperm(int c) { const int e = c % QH; if (e < NOPE) return c; const int r = e - NOPE, i = r & 31, sec = r >> 5; return c - e + NOPE + 32 * (i >> 4) + 16 * sec + (i & 15); }
struct EpiQ {
    static constexpr bool PERM = false;
    const float* ssqq_; const float* cs; bf16_t* qbuf; bf16_t* qs;
    __device__ __forceinline__ void operator()(const f32x4 (&acc)[2][2][4][2], const pg8::Unit& u, int wr, int wc, int fr_in, int fq_in) const {
        int fr = fr_in, fq = fq_in; asm volatile("" : "+v"(fr), "+v"(fq));
        const bool smp = u.pm >= MP / 256;
        float rq[2][4]; load_rstd_p<8>(ssqq_, 1.0f / QR, u, wr, fr, fq, rq);
#pragma unroll
        for (int ai = 0; ai < 2; ++ai)
#pragma unroll
            for (int m = 0; m < 4; ++m) {
                const int row = u.pm * 256 + ai * 128 + wr * 64 + m * 16 + fr; const float r = rq[ai][m]; const int pos = smp ? PAST + ((row - MP) & 7) : (row & (SEQ - 1));
                bf16_t* qrow = qbuf + (size_t)row * (NH * QH);
#pragma unroll
                for (int bj = 0; bj < 2; ++bj) {
                    const int Gi = u.pn * 8 + bj * 4 + wc, hh = Gi / 6, gi = Gi - hh * 6;
                    if (gi < 4) {
#pragma unroll
                        for (int n = 0; n < 2; ++n) { const f32x4 a = acc[ai][bj][m][n] * r; u32x2 w; w.x = pk2(a.x, a.y); w.y = pk2(a.z, a.w);
                            *(u32x2*)(qrow + Gi * 32 + n * 16 + 4 * fq) = w; }
                    } else {
                        const int i0 = 16 * (gi - 4) + 4 * fq;
                        const f32x4 x1 = acc[ai][bj][m][0] * r, x2 = acc[ai][bj][m][1] * r;
                        const f32x4 cn = *(const f32x4*)(cs + (size_t)pos * 64 + i0), sn = *(const f32x4*)(cs + (size_t)pos * 64 + 32 + i0);
                        const f32x4 o1 = x1 * cn - x2 * sn, o2 = x2 * cn + x1 * sn;
                        u32x2 w1, w2; w1.x = pk2(o1.x, o1.y); w1.y = pk2(o1.z, o1.w); w2.x = pk2(o2.x, o2.y); w2.y = pk2(o2.z, o2.w);
                        bf16_t* qd = smp ? qs + ((size_t)(row - MP) * NH + hh) * 320 + KVR : qrow + hh * QH + NOPE;
                        *(u32x2*)(qd + i0) = w1; *(u32x2*)(qd + 32 + i0) = w2;
                    }
                }
                asm volatile("" ::: "memory");
            }
    }
};
struct EpiDkvq {
    static constexpr bool PERM = false;
    const float* ssq_in; const float* cs; float* craw_; bf16_t* cb_; bf16_t* cqb_; float* ssqc_; float* ssqq_; float* out; bf16_t* kfull_; bf16_t* krbs_;
    __device__ __forceinline__ void operator()(const f32x4 (&acc)[2][2][4][2], const pg8::Unit& u, int wr, int wc, int fr_in, int fq_in) const {
        int fr = fr_in, fq = fq_in; asm volatile("" : "+v"(fr), "+v"(fq));
        float rs[2][4]; load_rstd(ssq_in, u, wr, fr, fq, rs);
        const bool smp = u.pm >= MP / 256;
#pragma unroll
        for (int ai = 0; ai < 2; ++ai)
#pragma unroll
            for (int m = 0; m < 4; ++m) {
                const int row = u.pm * 256 + ai * 128 + wr * 64 + m * 16 + fr; const float r = rs[ai][m];
                float sq = 0.f;
                if (u.pn == 0) {
#pragma unroll
                    for (int bj = 0; bj < 2; ++bj)
#pragma unroll
                        for (int n = 0; n < 2; ++n) { const int col = bj * 128 + wc * 32 + n * 16 + 4 * fq; const f32x4 v = acc[ai][bj][m][n] * r;
                            *(f32x4*)(craw_ + (size_t)row * KVR + col) = v; u32x2 w; w.x = pk2(v.x, v.y); w.y = pk2(v.z, v.w); *(u32x2*)(cb_ + (size_t)row * KVR + col) = w;
                            sq += (v.x * v.x + v.y * v.y) + (v.z * v.z + v.w * v.w); }
                    sq += __shfl_xor(sq, 16); sq += __shfl_xor(sq, 32);
                    if (fq == 0) ssqc_[(size_t)row * 4 + wc] = sq;
                } else {
#pragma unroll
                    for (int bj = 0; bj < 2; ++bj) {
                        const int g0 = (u.pn - 1) * 256 + bj * 128 + wc * 32;
                        if (g0 < ROPE) {
                            const int i0 = 16 * (g0 >> 5) + 4 * fq, pos = smp ? PAST + ((row - MP) & 7) : (row & (SEQ - 1));
                            const f32x4 x1 = acc[ai][bj][m][0] * r, x2 = acc[ai][bj][m][1] * r;
                            const f32x4 cn = *(const f32x4*)(cs + (size_t)pos * 64 + i0), sn = *(const f32x4*)(cs + (size_t)pos * 64 + 32 + i0);
                            const f32x4 o1 = x1 * cn - x2 * sn, o2 = x2 * cn + x1 * sn;
                            float* ko = smp ? out + O_KS + (size_t)(row - MP) * ROPE : out + O_KP + (size_t)row * ROPE;
                            *(f32x4*)(ko + i0) = o1; *(f32x4*)(ko + 32 + i0) = o2;
                            u32x2 w1, w2; w1.x = pk2(o1.x, o1.y); w1.y = pk2(o1.z, o1.w); w2.x = pk2(o2.x, o2.y); w2.y = pk2(o2.z, o2.w);
                            if (smp) { bf16_t* kd = krbs_ + (size_t)(row - MP) * ROPE; *(u32x2*)(kd + i0) = w1; *(u32x2*)(kd + 32 + i0) = w2; }
                            else { const int b = row >> 13, t = row & (SEQ - 1);
#pragma unroll
                                for (int h = 0; h < NH; ++h) { bf16_t* kd = kfull_ + ((size_t)(b * NH + h) * SEQ + t) * QH + NOPE; *(u32x2*)(kd + i0) = w1; *(u32x2*)(kd + 32 + i0) = w2; } }
                        } else if (g0 < ROPE + QR) {
#pragma unroll
                            for (int n = 0; n < 2; ++n) { const int qi = g0 - ROPE + n * 16 + 4 * fq; const f32x4 v = acc[ai][bj][m][n] * r;
                                u32x2 w; w.x = pk2(v.x, v.y); w.y = pk2(v.z, v.w); *(u32x2*)(cqb_ + (size_t)row * QR + qi) = w;
                                sq += (v.x * v.x + v.y * v.y) + (v.z * v.z + v.w * v.w); }
                        }
                    }
                    sq += __shfl_xor(sq, 16); sq += __shfl_xor(sq, 32);
                    if (fq == 0) ssqq_[(size_t)row * 8 + (u.pn - 1) * 4 + wc] = sq;
                }
                asm volatile("" ::: "memory");
            }
    }
};
struct EpiKup {
    static constexpr bool PERM = true;
    bf16_t* kfull; const float* ssqc_;
    __device__ __forceinline__ void operator()(const f32x4 (&acc)[2][2][4][2], const pg8::Unit& u, int wr, int wc, int fr_in, int fq_in) const {
        int fr = fr_in, fq = fq_in; asm volatile("" : "+v"(fr), "+v"(fq));
        const int col0 = u.pn * 256 + wc * 32 + 8 * fq;
        float rc[2][4]; load_rstd_p<4>(ssqc_, 1.0f / KVR, u, wr, fr, fq, rc);
#pragma unroll
        for (int ai = 0; ai < 2; ++ai)
#pragma unroll
            for (int m = 0; m < 4; ++m) {
                const int row = u.pm * 256 + ai * 128 + wr * 64 + m * 16 + fr; const int b = row >> 13, t = row & (SEQ - 1); const float r = rc[ai][m];
#pragma unroll
                for (int bj = 0; bj < 2; ++bj) { const int col = col0 + bj * 128; const int h = col >> 7, nn = col & 127; const f32x4 a = acc[ai][bj][m][0] * r, c = acc[ai][bj][m][1] * r;
                    u32x4 w; w.x = pk2(a.x, a.y); w.y = pk2(a.z, a.w); w.z = pk2(c.x, c.y); w.w = pk2(c.z, c.w);
                    *(u32x4*)(kfull + ((size_t)(b * NH + h) * SEQ + t) * QH + nn) = w; }
                asm volatile("" ::: "memory");
            }
    }
};
struct EpiVup {
    static constexpr bool PERM = true;
    bf16_t* vt; const float* ssqc_;
    __device__ __forceinline__ void operator()(const f32x4 (&acc)[2][2][4][2], const pg8::Unit& u, int wr, int wc, int fr_in, int fq_in) const {
        int fr = fr_in, fq = fq_in; asm volatile("" : "+v"(fr), "+v"(fq));
        const int col0 = u.pn * 256 + wc * 32 + 8 * fq;
        f32x4 rt[2][2];
#pragma unroll
        for (int bj = 0; bj < 2; ++bj)
#pragma unroll
            for (int k = 0; k < 8; ++k) { const f32x4 p4 = *(const f32x4*)(ssqc_ + (size_t)(col0 + bj * 128 + k) * 4); rt[bj][k >> 2][k & 3] = 1.0f / sqrtf(((p4.x + p4.y) + (p4.z + p4.w)) * (1.0f / KVR) + EPS); }
#pragma unroll
        for (int ai = 0; ai < 2; ++ai)
#pragma unroll
            for (int m = 0; m < 4; ++m) {
                const int row = u.pm * 256 + ai * 128 + wr * 64 + m * 16 + fr; const int h = row >> 7, v = row & 127;
#pragma unroll
                for (int bj = 0; bj < 2; ++bj) { const int col = col0 + bj * 128; const int b = col >> 13, t = col & (SEQ - 1); const f32x4 a = acc[ai][bj][m][0] * rt[bj][0], c = acc[ai][bj][m][1] * rt[bj][1];
                    u32x4 w; w.x = pk2(a.x, a.y); w.y = pk2(a.z, a.w); w.z = pk2(c.x, c.y); w.w = pk2(c.z, c.w);
                    *(u32x4*)(vt + ((size_t)(b * NH + h) * VD + v) * SEQ + t) = w; }
                asm volatile("" ::: "memory");
            }
    }
};

struct SgALoadBf { const bf16_t* A; int lda;
    __device__ __forceinline__ bf16x8 operator()(int row, int k) const { return *(const bf16x8*)(A + (size_t)row * lda + k); } };
struct SgALoadComb { const float* parto; const float* ml;
    __device__ __forceinline__ bf16x8 operator()(int row, int k) const {
        const int b = row >> 3, tok = row & 7, h = k >> 7, v = k & 127, q = tok * 8 + h;
        const float* m0p = ml + ((size_t)(b * 2 + 0) * 64 + q) * 2; const float* m1p = ml + ((size_t)(b * 2 + 1) * 64 + q) * 2;
        const float m0 = m0p[0], l0 = m0p[1], m1 = m1p[0], l1 = m1p[1], mx = fmaxf(m0, m1);
        float w0 = __builtin_amdgcn_exp2f(m0 - mx), w1 = __builtin_amdgcn_exp2f(m1 - mx); const float inv = 1.0f / (w0 * l0 + w1 * l1); w0 *= inv; w1 *= inv;
        const float* p0 = parto + ((size_t)(b * 2 + 0) * 64 + q) * 128 + v; const float* p1 = parto + ((size_t)(b * 2 + 1) * 64 + q) * 128 + v;
        return pack8v(*(const f32x4*)p0 * w0 + *(const f32x4*)p1 * w1, *(const f32x4*)(p0 + 4) * w0 + *(const f32x4*)(p1 + 4) * w1); } };
template <int NCT, int NCG, class Epi, class ALoad>
__device__ __forceinline__ void sg_gemm_l(LAS unsigned char* lds, const ALoad& AL, int apn256, const bf16_t* __restrict__ Bt, int K, int unit, const Epi& E, int tid, int wave, int lane) {
    constexpr int KS = 8 / NCG, W = NCG * NCT * 16, G4 = W / 4;
    static_assert(KS * 64 * W * 4 <= RING_BYTES, "sg_gemm reduction buffer");
    const int mt = unit >> 4, ntile = unit & 15, m0 = mt * 64, n0 = ntile * W;
    const int cg = wave % NCG, kp = wave / NCG, fr = lane & 15, fq = lane >> 4;
    const int Kw = K / KS;
    const int arow = m0 + fr, acol = (n0 >> 8) * apn256 + kp * Kw + 8 * fq;
    const bf16_t* bp = Bt + (size_t)(n0 + cg * NCT * 16 + fr) * K + kp * Kw + 8 * fq;
    f32x4 acc[4][NCT];
#pragma unroll
    for (int m = 0; m < 4; ++m)
#pragma unroll
        for (int n = 0; n < NCT; ++n) acc[m][n] = (f32x4){0.f, 0.f, 0.f, 0.f};
#pragma unroll 4
    for (int kk = 0; kk < Kw; kk += 32) {
        bf16x8 af[4], bfr[NCT];
#pragma unroll
        for (int m = 0; m < 4; ++m) af[m] = AL(arow + 16 * m, acol + kk);
#pragma unroll
        for (int n = 0; n < NCT; ++n) bfr[n] = *(const bf16x8*)(bp + (size_t)(16 * n) * K + kk);
#pragma unroll
        for (int m = 0; m < 4; ++m)
#pragma unroll
            for (int n = 0; n < NCT; ++n) acc[m][n] = __builtin_amdgcn_mfma_f32_16x16x32_bf16(bfr[n], af[m], acc[m][n], 0, 0, 0);
    }
    LAS float* red = (LAS float*)lds;
#pragma unroll
    for (int m = 0; m < 4; ++m)
#pragma unroll
        for (int n = 0; n < NCT; ++n) { const int row = 16 * m + fr, c4 = (cg * NCT * 16 + 16 * n) / 4 + fq;
            *(LAS f32x4*)(red + (size_t)(kp * 64 + row) * W + 4 * (c4 ^ (row & 3))) = acc[m][n]; }
    __syncthreads();
    for (int it = tid; it < 64 * G4; it += 512) {
        const int row = it / G4, c4 = it % G4;
        f32x4 v = *(const LAS f32x4*)(red + (size_t)row * W + 4 * (c4 ^ (row & 3)));
#pragma unroll
        for (int p = 1; p < KS; ++p) v += *(const LAS f32x4*)(red + (size_t)(p * 64 + row) * W + 4 * (c4 ^ (row & 3)));
        if constexpr (Epi::WHOLE_TILE) *(LAS f32x4*)(red + (size_t)row * W + 4 * (c4 ^ (row & 3))) = v;
        else E(MP + m0 + row, n0 + 4 * c4, v, ntile);
    }
    if constexpr (Epi::WHOLE_TILE) {
        __syncthreads();
        for (int it = tid; it < 64 * G4; it += 512) { const int row = it / G4, c4 = it % G4; E.tile(MP + m0 + row, n0, c4, red + (size_t)row * W, row & 3); }
    }
    __syncthreads();
}
template <int NCT, int NCG, class Epi>
__device__ __forceinline__ void sg_gemm(LAS unsigned char* lds, const bf16_t* __restrict__ A, int lda, int apn256, const bf16_t* __restrict__ Bt, int K, int unit, const Epi& E, int tid, int wave, int lane) {
    const SgALoadBf AL{A, lda}; sg_gemm_l<NCT, NCG>(lds, AL, apn256, Bt, K, unit, E, tid, wave, lane);
}
constexpr int SK_STG = 32768;
template <class Epi>
__device__ __forceinline__ void sk_gemm(LAS unsigned char* lds, const bf16_t* __restrict__ A, int lda, const bf16_t* __restrict__ Bt, int K, int m0, int n0, int ntile, const Epi& E, int tid, int wave, int lane) {
    const int nk = K >> 7, fr = lane & 15, fq = lane >> 4, mi = wave >> 1, nh = wave & 1;
    unsigned goA[2], goB[2];
#pragma unroll
    for (int e = 0; e < 2; ++e) { const int r = 4 * (wave + 8 * e) + (lane >> 4), c = (lane & 15) ^ (r & 15); goA[e] = (unsigned)(r * lda + c * 8) * 2u; goB[e] = (unsigned)(r * K + c * 8) * 2u; }
    const unsigned ldsw = (unsigned)wave * 1024u;
#define SK_STAGE(kc) do { const unsigned so_ = (unsigned)((kc) & 3) * SK_STG + ldsw; const size_t ko_ = (size_t)(kc) * 256; \
        _Pragma("unroll") for (int e = 0; e < 2; ++e) { \
            __builtin_amdgcn_global_load_lds((const unsigned*)((const char*)A + ko_ + goA[e]), (LAS unsigned*)(lds + so_ + e * 8192), 16, 0, 0); \
            __builtin_amdgcn_global_load_lds((const unsigned*)((const char*)Bt + ko_ + goB[e]), (LAS unsigned*)(lds + so_ + 16384 + e * 8192), 16, 0, 0); } } while (0)
    int co[4];
#pragma unroll
    for (int ks = 0; ks < 4; ++ks) co[ks] = ((4 * ks + fq) ^ fr) << 4;
    const int aro = (16 * mi + fr) * 256, bro = 16384 + (32 * nh + fr) * 256;
    f32x4 acc[2] = {(f32x4){0.f, 0.f, 0.f, 0.f}, (f32x4){0.f, 0.f, 0.f, 0.f}};
    asm volatile("s_waitcnt vmcnt(0)" ::: "memory");
    SK_STAGE(0); if (nk > 1) SK_STAGE(1); if (nk > 2) SK_STAGE(2);
#pragma unroll 1
    for (int kc = 0; kc < nk; ++kc) {
        if (kc + 2 < nk) asm volatile("s_waitcnt vmcnt(8)" ::: "memory"); else if (kc + 1 < nk) asm volatile("s_waitcnt vmcnt(4)" ::: "memory"); else asm volatile("s_waitcnt vmcnt(0)" ::: "memory");
        asm volatile("s_waitcnt lgkmcnt(0)" ::: "memory"); __builtin_amdgcn_s_barrier(); asm volatile("" ::: "memory");
        if (kc + 3 < nk) SK_STAGE(kc + 3);
        const LAS unsigned char* sp = lds + (kc & 3) * SK_STG;
        bf16x8 af[4], b0[4], b1[4];
#pragma unroll
        for (int ks = 0; ks < 4; ++ks) { af[ks] = *(const LAS bf16x8*)(sp + aro + co[ks]); b0[ks] = *(const LAS bf16x8*)(sp + bro + co[ks]); b1[ks] = *(const LAS bf16x8*)(sp + bro + 4096 + co[ks]); }
#pragma unroll
        for (int ks = 0; ks < 4; ++ks) { acc[0] = __builtin_amdgcn_mfma_f32_16x16x32_bf16(b0[ks], af[ks], acc[0], 0, 0, 0); acc[1] = __builtin_amdgcn_mfma_f32_16x16x32_bf16(b1[ks], af[ks], acc[1], 0, 0, 0); }
    }
#undef SK_STAGE
    asm volatile("s_waitcnt lgkmcnt(0)" ::: "memory"); __builtin_amdgcn_s_barrier(); asm volatile("" ::: "memory");
    LAS float* red = (LAS float*)lds;
    { const int row = 16 * mi + fr;
#pragma unroll
      for (int n = 0; n < 2; ++n) { const int c4 = 4 * (2 * nh + n) + fq; *(LAS f32x4*)(red + row * 64 + 4 * (c4 ^ (row & 3))) = acc[n]; } }
    __syncthreads();
#pragma unroll
    for (int it = tid; it < 1024; it += 512) { const int row = it >> 4, c4 = it & 15; const f32x4 v = *(const LAS f32x4*)(red + row * 64 + 4 * (c4 ^ (row & 3))); E(MP + m0 + row, n0 + 4 * c4, v, ntile); }
    __syncthreads();
}
__device__ __forceinline__ float row_rstd16(const float* ssq, int row) {
    const f32x4* s = (const f32x4*)(ssq + (size_t)row * 16); const f32x4 a = s[0], b = s[1], c = s[2], d = s[3];
    const float t = ((a.x + a.y) + (a.z + a.w)) + ((b.x + b.y) + (b.z + b.w)) + ((c.x + c.y) + (c.z + c.w)) + ((d.x + d.y) + (d.z + d.w));
    return 1.0f / sqrtf(t * (1.0f / 1024.0f) + EPS);
}
template <int MODE> struct SgH {
    static constexpr bool WHOLE_TILE = false;
    const float* xs; const float* scale; const float* ssq_in; const bf16_t* proj; const bf16_t* hb_in; bf16_t* hb; float* ssq_out;
    __device__ __forceinline__ void operator()(int row, int col, f32x4 a, int ntile) const {
        const f32x4 bs = (MODE == 0) ? *(const f32x4*)(xs + (size_t)(row - MP) * D + col) : unpk4(*(const u32x2*)(hb_in + (size_t)row * D + col));
        f32x4 o;
        if (MODE == 0) o = bs + *(const f32x4*)(scale + col) * a;
        else if (MODE == 1) o = bs + a;
        else { const float r = row_rstd16(ssq_in, row); const f32x4 pj = unpk4(*(const u32x2*)(proj + (size_t)row * D + col));
            f32x4 gt; gt.x = 1.0f / (1.0f + __expf(-r * a.x)); gt.y = 1.0f / (1.0f + __expf(-r * a.y)); gt.z = 1.0f / (1.0f + __expf(-r * a.z)); gt.w = 1.0f / (1.0f + __expf(-r * a.w));
            o = bs + gt * pj; }
        u32x2 w; w.x = pk2(o.x, o.y); w.y = pk2(o.z, o.w);
        *(u32x2*)(hb + (size_t)row * D + col) = w;
        float sq = (o.x * o.x + o.y * o.y) + (o.z * o.z + o.w * o.w);
        sq += __shfl_xor(sq, 1); sq += __shfl_xor(sq, 2); sq += __shfl_xor(sq, 4); sq += __shfl_xor(sq, 8);
        if ((col & 63) == 0) ssq_out[(size_t)row * 16 + ntile] = sq;
    }
};
struct SgUp {
    static constexpr bool WHOLE_TILE = false;
    const float* ssq_in; bf16_t* abuf;
    __device__ __forceinline__ void operator()(int row, int col, f32x4 a, int) const {
        const float r = row_rstd16(ssq_in, row); a = a * r;
        a.x = fmaxf(a.x, 0.f); a.y = fmaxf(a.y, 0.f); a.z = fmaxf(a.z, 0.f); a.w = fmaxf(a.w, 0.f);
        u32x2 w; w.x = pk2(a.x * a.x, a.y * a.y); w.y = pk2(a.z * a.z, a.w * a.w);
        *(u32x2*)(abuf + (size_t)row * FF + col) = w;
    }
};
template <int MODE> struct SgF32 {
    static constexpr bool WHOLE_TILE = false;
    float* C; int ldc; const float* aux;
    __device__ __forceinline__ void operator()(int row, int col, f32x4 a, int) const {
        const float r = (MODE == 1) ? row_rstd16(aux, row) : (MODE == 2 ? aux[row] : 1.0f);
        *(f32x4*)(C + (size_t)row * ldc + col) = a * r;
    }
};
struct SgBf {
    static constexpr bool WHOLE_TILE = false;
    bf16_t* C; int ldc;
    __device__ __forceinline__ void operator()(int row, int col, f32x4 a, int) const { u32x2 w; w.x = pk2(a.x, a.y); w.y = pk2(a.z, a.w); *(u32x2*)(C + (size_t)row * ldc + col) = w; }
};
struct SgQ {
    static constexpr bool WHOLE_TILE = true;
    const float* rstdq; const float* cs; bf16_t* qbuf; bf16_t* qs;
    __device__ __forceinline__ void operator()(int, int, f32x4, int) const {}
    __device__ __forceinline__ void tile(int row, int n0, int c4, const LAS float* trow, int sw) const {
        const int c = n0 + 4 * c4, hh = c / QH, e = c - hh * QH; const float r = rstdq[row];
        const f32x4 v = *(const LAS f32x4*)(trow + 4 * (c4 ^ sw)) * r;
        if (e < NOPE) { u32x2 w; w.x = pk2(v.x, v.y); w.y = pk2(v.z, v.w); *(u32x2*)(qbuf + (size_t)row * (NH * QH) + c) = w; }
        else { const int rp = e - NOPE, wi = rp & 31;
            if (wi < 16) { const int i0 = 16 * (rp >> 5) + wi, pos = PAST + ((row - MP) & 7);
                const f32x4 x2 = *(const LAS f32x4*)(trow + 4 * ((c4 + 4) ^ sw)) * r;
                const f32x4 cn = *(const f32x4*)(cs + (size_t)pos * 64 + i0), sn = *(const f32x4*)(cs + (size_t)pos * 64 + 32 + i0);
                const f32x4 o1 = v * cn - x2 * sn, o2 = x2 * cn + v * sn;
                bf16_t* qd = qs + ((size_t)(row - MP) * NH + hh) * 320 + KVR;
                u32x2 w1, w2; w1.x = pk2(o1.x, o1.y); w1.y = pk2(o1.z, o1.w); w2.x = pk2(o2.x, o2.y); w2.y = pk2(o2.z, o2.w);
                *(u32x2*)(qd + i0) = w1; *(u32x2*)(qd + 32 + i0) = w2; } }
    }
};

template <int PMODE = 0>
__device__ __forceinline__ void transpose_item(const float* W, const float* kscale, int K, int N, bf16_t* WT, int row_off, LAS float* scr, int item, int lane) {
    const int nblk = N / 32, kb = item / nblk, nb = item % nblk, k0 = 64 * kb, n0 = 32 * nb;
    { f32x4 v[8];
#pragma unroll
      for (int i = 0; i < 8; ++i) v[i] = *(const f32x4*)(W + (size_t)(k0 + (lane >> 3) + 8 * i) * N + n0 + (lane & 7) * 4);
#pragma unroll
      for (int i = 0; i < 8; ++i) { const int kk = (lane >> 3) + 8 * i; f32x4 x = v[i]; if (kscale) x = x * kscale[k0 + kk];
          LAS float* d = scr + kk * 33 + (lane & 7) * 4; d[0] = x.x; d[1] = x.y; d[2] = x.z; d[3] = x.w; } }
    LDS_WAIT(); asm volatile("" ::: "memory");
    const int c = lane & 7;
#pragma unroll
    for (int j = 0; j < 4; ++j) { const int n = (lane >> 3) + 8 * j; const LAS float* s = scr + (8 * c) * 33 + n;
        u32x4 o; o.x = pk2(s[0 * 33], s[1 * 33]); o.y = pk2(s[2 * 33], s[3 * 33]); o.z = pk2(s[4 * 33], s[5 * 33]); o.w = pk2(s[6 * 33], s[7 * 33]);
        *(u32x4*)(WT + (size_t)(row_off + (PMODE == 1 ? qperm(n0 + n) : (PMODE == 2 ? kperm(n0 + n) : n0 + n))) * K + k0 + 8 * c) = o; }
    LDS_WAIT(); asm volatile("" ::: "memory");
}

constexpr int AK_PITCH = 400, AK_BUF = 64 * AK_PITCH;
constexpr int AV_PITCH = 136, AV_BUF = 128 * AV_PITCH;
constexpr int AV_OFF = 2 * AK_BUF, AQ_OFF = AV_OFF + 2 * AV_BUF;
static_assert(AQ_OFF + 256 * 144 <= RING_BYTES, "attention LDS");
__device__ __forceinline__ void attn_prompt_unit(const bf16_t* __restrict__ qbuf, const bf16_t* __restrict__ Kf, const bf16_t* __restrict__ Vt, bf16_t* __restrict__ obuf,
                                                 int b, int h, int qb, LAS unsigned char* lds, int tid, int wave, int lane) {
    const int r32 = lane & 31, g = lane >> 5;
    const int t_lo = qb * 256 + wave * 32, trow = t_lo + r32;
    bf16x8 qf[8];
    { const bf16_t* qp = qbuf + (size_t)(b * SEQ + trow) * (NH * QH) + h * QH + 8 * g;
      __syncthreads();
#pragma unroll
      for (int ks = 8; ks < 12; ++ks) *(LAS bf16x8*)(lds + AQ_OFF + (wave * 32 + r32) * 144 + (2 * (ks - 8) + g) * 16) = *(const bf16x8*)(qp + 16 * ks);
#pragma unroll
      for (int ks = 0; ks < 8; ++ks) qf[ks] = *(const bf16x8*)(qp + 16 * ks);
#pragma unroll
      for (int ks = 0; ks < 8; ++ks) asm volatile("" : "+v"(qf[ks])); }
    f32x16 O[4];
#pragma unroll
    for (int i = 0; i < 4; ++i)
#pragma unroll
        for (int j = 0; j < 16; ++j) O[i][j] = 0.f;
    float mrun = -1e30f, lrun = 0.f;
    const bf16_t* Kb = Kf + (size_t)(b * NH + h) * SEQ * QH;
    const bf16_t* Vb = Vt + (size_t)(b * NH + h) * VD * SEQ;
    const int NT = (qb + 1) * 4;
    int kl_off[3], vl_off[2]; size_t vg_off[2];
#pragma unroll
    for (int e = 0; e < 3; ++e) kl_off[e] = (tid >> 3) * AK_PITCH + ((tid & 7) + 8 * e) * 16;
#pragma unroll
    for (int e = 0; e < 2; ++e) { const int c = tid + 512 * e; vl_off[e] = AV_OFF + (c >> 3) * AV_PITCH + (c & 7) * 16; vg_off[e] = (size_t)(c >> 3) * SEQ + (c & 7) * 8; }
    u32x4 kst[3], vst[2];
#define AT_LOAD(j) do { _Pragma("unroll") for (int e = 0; e < 3; ++e) kst[e] = *(const u32x4*)(Kb + (size_t)(64 * (j) + (tid >> 3)) * QH + ((tid & 7) + 8 * e) * 8); \
                        _Pragma("unroll") for (int e = 0; e < 2; ++e) vst[e] = *(const u32x4*)(Vb + vg_off[e] + 64 * (j)); } while (0)
#define AT_WRITE(buf) do { _Pragma("unroll") for (int e = 0; e < 3; ++e) *(LAS u32x4*)(lds + (buf) * AK_BUF + kl_off[e]) = kst[e]; \
                           _Pragma("unroll") for (int e = 0; e < 2; ++e) { *(LAS u32x2*)(lds + (buf) * AV_BUF + vl_off[e]) = (u32x2){vst[e].x, vst[e].y}; *(LAS u32x2*)(lds + (buf) * AV_BUF + vl_off[e] + 8) = (u32x2){vst[e].z, vst[e].w}; } } while (0)
    AT_LOAD(0); AT_WRITE(0);
    __syncthreads();
    for (int j = 0; j < NT; ++j) {
        const int buf = j & 1;
        if (j + 1 < NT) AT_LOAD(j + 1);
        if (64 * j <= t_lo + 31) {
            f32x16 S0, S1;
#pragma unroll
            for (int i = 0; i < 16; ++i) { S0[i] = 0.f; S1[i] = 0.f; }
            const LAS unsigned char* kl = lds + buf * AK_BUF + r32 * AK_PITCH + g * 16;
            const LAS unsigned char* ql = lds + AQ_OFF + (wave * 32 + r32) * 144 + g * 16;
            bf16x8 ka[3][2], qr_[3];
#define AT_KLD(ks) do { ka[(ks) % 3][0] = *(const LAS bf16x8*)(kl + (ks) * 32); ka[(ks) % 3][1] = *(const LAS bf16x8*)(kl + 32 * AK_PITCH + (ks) * 32); \
                        if ((ks) >= 8) qr_[(ks) % 3] = *(const LAS bf16x8*)(ql + ((ks) - 8) * 32); } while (0)
            AT_KLD(0); AT_KLD(1);
#pragma unroll
            for (int ks = 0; ks < 12; ++ks) {
                if (ks + 2 < 12) AT_KLD(ks + 2);
                __builtin_amdgcn_sched_barrier(0);
                const bf16x8 qb_ = (ks < 8) ? qf[ks < 8 ? ks : 0] : qr_[ks % 3];
                S0 = __builtin_amdgcn_mfma_f32_32x32x16_bf16(ka[ks % 3][0], qb_, S0, 0, 0, 0);
                S1 = __builtin_amdgcn_mfma_f32_32x32x16_bf16(ka[ks % 3][1], qb_, S1, 0, 0, 0);
                __builtin_amdgcn_sched_barrier(0);
            }
#undef AT_KLD
            if (64 * j + 63 > t_lo) {
                asm volatile("" ::: "memory");
#pragma unroll
                for (int i = 0; i < 16; ++i) { const int key = 64 * j + crow(i, g); if (key > trow) S0[i] = -1e30f; if (key + 32 > trow) S1[i] = -1e30f; }
            }
            float mx = S0[0];
#pragma unroll
            for (int i = 1; i < 16; ++i) mx = fmaxf(mx, S0[i]);
#pragma unroll
            for (int i = 0; i < 16; ++i) mx = fmaxf(mx, S1[i]);
            mx = fmaxf(mx, __shfl_xor(mx, 32)) * CEXP;
            if (__any(mx > mrun + 11.5f)) {
                const float mnew = fmaxf(mrun, mx), alpha = __builtin_amdgcn_exp2f(mrun - mnew);
                mrun = mnew; lrun *= alpha;
#pragma unroll
                for (int vt = 0; vt < 4; ++vt)
#pragma unroll
                    for (int i = 0; i < 16; ++i) O[vt][i] *= alpha;
            }
            float ps = 0.f;
#pragma unroll
            for (int i = 0; i < 16; ++i) { S0[i] = __builtin_amdgcn_exp2f(S0[i] * CEXP - mrun); S1[i] = __builtin_amdgcn_exp2f(S1[i] * CEXP - mrun); ps += S0[i] + S1[i]; }
            lrun += ps;
            bf16x8 pf[4];
            { float tmp[8];
#pragma unroll
              for (int s2 = 0; s2 < 4; ++s2) {
#pragma unroll
                for (int i = 0; i < 8; ++i) tmp[i] = (s2 < 2) ? S0[8 * (s2 & 1) + i] : S1[8 * (s2 & 1) + i];
                pf[s2] = pack8(tmp); } }
            const LAS unsigned char* vl = lds + AV_OFF + buf * AV_BUF + r32 * AV_PITCH + g * 8;
            u32x4 fa[4], fb[4];
#define AT_VLD(dst, vt) do { _Pragma("unroll") for (int s2 = 0; s2 < 4; ++s2) { const u32x2 lo_ = *(const LAS u32x2*)(vl + (vt) * 32 * AV_PITCH + s2 * 32), hi_ = *(const LAS u32x2*)(vl + (vt) * 32 * AV_PITCH + s2 * 32 + 16); dst[s2] = (u32x4){lo_.x, lo_.y, hi_.x, hi_.y}; } } while (0)
#define AT_VMM(src, vt) do { _Pragma("unroll") for (int s2 = 0; s2 < 4; ++s2) O[vt] = __builtin_amdgcn_mfma_f32_32x32x16_bf16(__builtin_bit_cast(bf16x8, src[s2]), pf[s2], O[vt], 0, 0, 0); } while (0)
            AT_VLD(fa, 0); AT_VLD(fb, 1); __builtin_amdgcn_sched_barrier(0);
            AT_VMM(fa, 0); __builtin_amdgcn_sched_barrier(0);
            AT_VLD(fa, 2); __builtin_amdgcn_sched_barrier(0);
            AT_VMM(fb, 1); __builtin_amdgcn_sched_barrier(0);
            AT_VLD(fb, 3); __builtin_amdgcn_sched_barrier(0);
            AT_VMM(fa, 2); __builtin_amdgcn_sched_barrier(0);
            AT_VMM(fb, 3);
#undef AT_VLD
#undef AT_VMM
        }
        if (j + 1 < NT) AT_WRITE(buf ^ 1);
        __syncthreads();
    }
#undef AT_LOAD
#undef AT_WRITE
    const float ltot = lrun + __shfl_xor(lrun, 32), inv = 1.0f / ltot;
    bf16_t* op = obuf + (size_t)(b * SEQ + trow) * D + h * VD + 4 * g;
#pragma unroll
    for (int vt = 0; vt < 4; ++vt)
#pragma unroll
        for (int jq = 0; jq < 4; ++jq) {
            u32x2 w; w.x = pk2(O[vt][4 * jq] * inv, O[vt][4 * jq + 1] * inv); w.y = pk2(O[vt][4 * jq + 2] * inv, O[vt][4 * jq + 3] * inv);
            *(u32x2*)(op + 32 * vt + 8 * jq) = w;
        }
}

typedef short s16x4 __attribute__((ext_vector_type(4)));
constexpr int SA_KR = 32768, SA_BUF = 32768 + 64 * 144, SA_QR = 2 * SA_BUF, SA_QI = SA_QR + 64 * 144, SA_QI_PITCH = 528, SA_OI = 69632;
static_assert(SA_OI >= 65536 + 1024 && SA_OI + 64 * SA_QI_PITCH <= MISC_OFF, "O image");
static_assert(SA_QI + 64 * SA_QI_PITCH <= MISC_OFF, "sample attention LDS");
__device__ __forceinline__ int sa_off(int row, int ch) { return 256 * row + 16 * (ch ^ (((row & 3) << 2) | ((row >> 2) & 3))); }
__device__ __forceinline__ void sattn_item(const Params& P, int b, int half, LAS unsigned char* lds, int tid, int wave, int lane) {
    unsigned char* ws = P.ws;
    const int r32 = lane & 31, g = lane >> 5;
    const bool is_cmp = wave < 4;
    const int qt = wave & 1, kb = (wave >> 1) & 1;
    const int ptv = ((const int*)P.in[I_PT])[b * NPG + half * 32 + (lane & 31)];
    const float* clat = P.in[I_CLAT]; const float* ckr = P.in[I_CKR];
#define SA_LOAD(S, h) do { const int pg_ = __builtin_amdgcn_readlane(ptv, (h) >> 2); const size_t prow_ = (size_t)pg_ * PAGE + (((h) & 3) << 5); \
        const char* lat_ = (const char*)(clat + prow_ * KVR); const char* kro_ = (const char*)(ckr + prow_ * ROPE); \
        _Pragma("unroll") for (int e = 0; e < 8; ++e) S[e] = *(const f32x4*)(lat_ + glb + e * 1024); \
        S[8] = *(const f32x4*)(kro_ + grb); S[9] = *(const f32x4*)(kro_ + grb + 1024); } while (0)
#define SA_PK4(v) ((u32x2){pk2((v).x, (v).y), pk2((v).z, (v).w)})
#define SA_WRITE(S, bufo, hh) do { \
        _Pragma("unroll") for (int e = 0; e < 8; ++e) *(LAS u32x2*)(lds + (bufo) + llb[e] + (hh) * 8192) = SA_PK4(S[e]); \
        _Pragma("unroll") for (int e = 0; e < 2; ++e) *(LAS u32x2*)(lds + (bufo) + lrb[e] + (hh) * 4608) = SA_PK4(S[8 + e]); asm volatile("" ::: "memory"); } while (0)
    __syncthreads();
    *(LAS u32x4*)(lds + SA_QR + (tid >> 3) * 144 + (tid & 7) * 16) = *(const u32x4*)((const bf16_t*)(ws + WS_QS) + ((size_t)b * 64 + (tid >> 3)) * 320 + KVR + (tid & 7) * 8);
    {
      const bf16_t* qn = (const bf16_t*)(ws + WS_QBUF) + (size_t)(MP + b * DS + (r32 & 7)) * (NH * QH) + wave * QH + 8 * g;
      bf16x8 an[8];
#pragma unroll
      for (int ks = 0; ks < 8; ++ks) { u32x4 z = {0u, 0u, 0u, 0u}; if (r32 < DS) z = *(const u32x4*)(qn + 16 * ks); an[ks] = __builtin_bit_cast(bf16x8, z); }
      const bf16_t* wk = (const bf16_t*)(ws + WS_WUKB) + (size_t)wave * (64 * 512) + lane * 8;
#pragma unroll 2
      for (int nt = 0; nt < 8; ++nt) {
          f32x16 acc;
#pragma unroll
          for (int i = 0; i < 16; ++i) acc[i] = 0.f;
#pragma unroll
          for (int ks = 0; ks < 8; ++ks) acc = __builtin_amdgcn_mfma_f32_32x32x16_bf16(an[ks], *(const bf16x8*)(wk + (nt * 8 + ks) * 512), acc, 0, 0, 0);
#pragma unroll
          for (int i = 0; i < 4; ++i) *(LAS bf16_t*)(lds + SA_QI + ((i + 4 * g) * 8 + wave) * SA_QI_PITCH + (32 * nt + r32) * 2) = (bf16_t)f2bf(acc[i]);
      } }
    __syncthreads();
#define SA_KLD(ks) do { const int o0_ = ((ks) < 16) ? (((ks) >> 3) * 16384 + krow + 32 * (((ks) & 7) ^ (x_ >> 1))) : (krope + 32 * ((ks) - 16)); \
        ka_[(ks) & 3] = *(const LAS bf16x8*)(kb_ + o0_); \
        qa_[(ks) & 3] = ((ks) < 16) ? *(const LAS bf16x8*)(qil + 32 * (ks)) : *(const LAS bf16x8*)(qrl + 32 * ((ks) - 16)); } while (0)
#define SA_VLD(dst, vt) do { const LAS unsigned char* vb_ = kb_ + ((vt) >> 2) * 16384 + 8192 * kb; \
        const int c0_ = 4 * ((vt) & 3) + 2 * vsub + (p_ >> 1); \
        const int blo_ = 256 * (4 * gg + q_) + 16 * (c0_ ^ ((q_ << 2) | gg)) + 8 * (p_ & 1); \
        const int bhi_ = 256 * (4 * gg + q_ + 8) + 16 * (c0_ ^ ((q_ << 2) | (gg + 2))) + 8 * (p_ & 1); \
        _Pragma("unroll") for (int s2 = 0; s2 < 2; ++s2) { \
            const s16x4 lo_ = __builtin_amdgcn_ds_read_tr16_b64_v4i16((LAS s16x4*)(vb_ + blo_ + 4096 * s2)); \
            const s16x4 hi_ = __builtin_amdgcn_ds_read_tr16_b64_v4i16((LAS s16x4*)(vb_ + bhi_ + 4096 * s2)); \
            dst[s2] = (bf16x8){lo_[0], lo_[1], lo_[2], lo_[3], hi_[0], hi_[1], hi_[2], hi_[3]}; } } while (0)
#define SA_VMM(src, vt) do { _Pragma("unroll") for (int s2 = 0; s2 < 2; ++s2) O[vt] = __builtin_amdgcn_mfma_f32_32x32x16_bf16(src[s2], pf[s2], O[vt], 0, 0, 0); } while (0)
#define SA_COMPUTE(j, bufo) do { \
        const LAS unsigned char* kb_ = lds + (bufo); \
        f32x16 S0; \
        _Pragma("unroll") for (int i = 0; i < 16; ++i) S0[i] = 0.f; \
        int r32v = r32; asm volatile("" : "+v"(r32v)); \
        const int x_ = ((r32v & 3) << 2) | ((r32v >> 2) & 3); \
        const int krow = 256 * (r32v + 32 * kb) + 16 * ((g ^ x_) & 1), krope = SA_KR + (r32v + 32 * kb) * 144 + g * 16; \
        const LAS unsigned char* qrl = lds + SA_QR + (32 * qt + r32v) * 144 + g * 16; const LAS unsigned char* qil = lds + SA_QI + (32 * qt + r32v) * SA_QI_PITCH + g * 16; \
        bf16x8 ka_[4], qa_[4]; \
        SA_KLD(0); SA_KLD(1); SA_KLD(2); \
        _Pragma("unroll") for (int ks = 0; ks < 20; ++ks) { \
            if (ks + 3 < 20) SA_KLD(ks + 3); \
            __builtin_amdgcn_sched_barrier(0); \
            S0 = __builtin_amdgcn_mfma_f32_32x32x16_bf16(ka_[ks & 3], qa_[ks & 3], S0, 0, 0, 0); \
            __builtin_amdgcn_sched_barrier(0); } \
        if ((j) == 64) { const int tok = (32 * qt + r32) >> 3; asm volatile("" ::: "memory"); \
            _Pragma("unroll") for (int i = 0; i < 16; ++i) { const int key = 32 * kb + crow(i, g); if (key > tok || key >= DS) S0[i] = -1e30f; } } \
        float mx = S0[0]; \
        _Pragma("unroll") for (int i = 1; i < 16; ++i) mx = fmaxf(mx, S0[i]); \
        mx = fmaxf(mx, __shfl_xor(mx, 32)) * CEXP; \
        if (__any(mx > mrun + 11.5f)) { const float mnew = fmaxf(mrun, mx), alpha = __builtin_amdgcn_exp2f(mrun - mnew); mrun = mnew; lrun *= alpha; \
            _Pragma("unroll") for (int vt = 0; vt < 8; ++vt) _Pragma("unroll") for (int i = 0; i < 16; ++i) O[vt][i] *= alpha; } \
        int lnv = lane; asm volatile("" : "+v"(lnv)); \
        const int li = lnv & 15, q_ = li >> 2, p_ = li & 3, vsub = (lnv >> 4) & 1, gg = lnv >> 5; \
        bf16x8 fa_[2], fb_[2]; \
        SA_VLD(fa_, 0); SA_VLD(fb_, 1);                        \
        float ps = 0.f; \
        _Pragma("unroll") for (int i = 0; i < 16; ++i) { S0[i] = __builtin_amdgcn_exp2f(S0[i] * CEXP - mrun); ps += S0[i]; } \
        lrun += ps; \
        bf16x8 pf[2]; \
        { float tmp[8]; \
          _Pragma("unroll") for (int s2 = 0; s2 < 2; ++s2) { \
            _Pragma("unroll") for (int i = 0; i < 8; ++i) tmp[i] = S0[8 * s2 + i]; \
            pf[s2] = pack8(tmp); } } \
        __builtin_amdgcn_sched_barrier(0); \
        SA_VMM(fa_, 0); __builtin_amdgcn_sched_barrier(0); SA_VLD(fa_, 2); __builtin_amdgcn_sched_barrier(0); \
        SA_VMM(fb_, 1); __builtin_amdgcn_sched_barrier(0); SA_VLD(fb_, 3); __builtin_amdgcn_sched_barrier(0); \
        SA_VMM(fa_, 2); __builtin_amdgcn_sched_barrier(0); SA_VLD(fa_, 4); __builtin_amdgcn_sched_barrier(0); \
        SA_VMM(fb_, 3); __builtin_amdgcn_sched_barrier(0); SA_VLD(fb_, 5); __builtin_amdgcn_sched_barrier(0); \
        SA_VMM(fa_, 4); __builtin_amdgcn_sched_barrier(0); SA_VLD(fa_, 6); __builtin_amdgcn_sched_barrier(0); \
        SA_VMM(fb_, 5); __builtin_amdgcn_sched_barrier(0); SA_VLD(fb_, 7); __builtin_amdgcn_sched_barrier(0); \
        SA_VMM(fa_, 6); __builtin_amdgcn_sched_barrier(0); \
        SA_VMM(fb_, 7); } while (0)
#define SA_LOADER(j, SX, SY, bufn) do { const int h0_ = 2 * (j) + 6 < 127 ? 2 * (j) + 6 : 127, h1_ = 2 * (j) + 7 < 127 ? 2 * (j) + 7 : 127; \
        __builtin_amdgcn_sched_barrier(0); SA_WRITE(SX, bufn, 0); SA_LOAD(SX, h0_); __builtin_amdgcn_sched_barrier(0); SA_WRITE(SY, bufn, 1); SA_LOAD(SY, h1_); __builtin_amdgcn_sched_barrier(0); } while (0)
#define SA_TAIL64(bufn) do { if (half == 1) { \
            const char* cbn = (const char*)((const bf16_t*)(ws + WS_CB) + (size_t)(MP + b * DS) * KVR); const char* krn = (const char*)((const bf16_t*)(ws + WS_KRBS) + (size_t)(b * DS) * ROPE); \
            const int w4_ = wave - 4; \
            _Pragma("unroll") for (int hh = 0; hh < 2; ++hh) { \
                _Pragma("unroll") for (int e = 0; e < 8; ++e) { const int key = 8 * w4_ + e + 32 * hh; u32x2 z = {0u, 0u}; if (key < DS) z = *(const u32x2*)(cbn + key * (KVR * 2) + 8 * lane); *(LAS u32x2*)(lds + (bufn) + llb[e] + hh * 8192) = z; } \
                _Pragma("unroll") for (int e = 0; e < 2; ++e) { const int key = 8 * w4_ + 4 * e + (lane >> 4) + 32 * hh; u32x2 z = {0u, 0u}; if (key < DS) z = *(const u32x2*)(krn + key * (ROPE * 2) + 8 * (lane & 15)); *(LAS u32x2*)(lds + (bufn) + lrb[e] + hh * 4608) = z; } } } } while (0)
#define SA_BAR() do { asm volatile("s_waitcnt lgkmcnt(0)" ::: "memory"); __builtin_amdgcn_s_barrier(); asm volatile("" ::: "memory"); } while (0)
    float* ml = (float*)(ws + WS_ML) + (size_t)(b * 2 + half) * 64 * 2;
    if (is_cmp) {
        SA_BAR();
        f32x16 O[8];
#pragma unroll
        for (int vt = 0; vt < 8; ++vt)
#pragma unroll
            for (int i = 0; i < 16; ++i) O[vt][i] = 0.f;
        float mrun = -1e30f, lrun = 0.f;
        int bo = 0;
        for (int j = 0; j < 64; ++j) {
            SA_COMPUTE(j, bo);
            bo = SA_BUF - bo;
            SA_BAR();
        }
        if (half == 1) { SA_COMPUTE(64, bo); SA_BAR(); }
        LAS float* xo = (LAS float*)(lds + qt * 32768); LAS float* xm = (LAS float*)(lds + 65536 + qt * 512);
        if (kb == 1) { xm[2 * lane] = mrun; xm[2 * lane + 1] = lrun;
#pragma unroll
            for (int vt = 0; vt < 8; ++vt)
#pragma unroll
                for (int i = 0; i < 16; ++i) xo[(vt * 16 + i) * 64 + lane] = O[vt][i]; }
        SA_BAR();
        if (kb == 0) {
            const float m1 = xm[2 * lane], l1 = xm[2 * lane + 1], mm = fmaxf(mrun, m1);
            const float a0 = __builtin_amdgcn_exp2f(mrun - mm), a1 = __builtin_amdgcn_exp2f(m1 - mm);
            const float ll = lrun * a0 + l1 * a1, lt = ll + __shfl_xor(ll, 32);
            const int q = 32 * qt + r32;
            if (g == 0) { ml[q * 2] = mm; ml[q * 2 + 1] = lt; }
#pragma unroll
            for (int vt = 0; vt < 8; ++vt) {
                float o[16];
#pragma unroll
                for (int i = 0; i < 16; ++i) o[i] = O[vt][i] * a0 + xo[(vt * 16 + i) * 64 + lane] * a1;
#pragma unroll
                for (int jq = 0; jq < 4; ++jq) { u32x2 w; w.x = pk2(o[4 * jq], o[4 * jq + 1]); w.y = pk2(o[4 * jq + 2], o[4 * jq + 3]);
                    *(LAS u32x2*)(lds + SA_OI + q * SA_QI_PITCH + (32 * vt + 8 * jq + 4 * g) * 2) = w; }
            }
        }
    } else {
        unsigned glb, grb, llb[8], lrb[2];
        { const int w4_ = wave - 4;
          glb = (unsigned)(8 * w4_ * 1024 + 16 * lane); grb = (unsigned)(8 * w4_ * 256 + 16 * lane);
#pragma unroll
          for (int e = 0; e < 8; ++e) { const int x_ = ((e & 3) << 2) | ((2 * w4_ + (e >> 2)) & 3);
              llb[e] = (unsigned)((lane >> 5) * 16384 + 256 * (8 * w4_ + e) + 16 * ((((lane & 31) >> 1)) ^ x_) + 8 * (lane & 1)); }
#pragma unroll
          for (int e = 0; e < 2; ++e) lrb[e] = (unsigned)(SA_KR + (8 * w4_ + 4 * e + (lane >> 4)) * 144 + 8 * (lane & 15)); }
        f32x4 s0[10], s1[10], s2[10], s3[10];
        SA_LOAD(s0, 0); SA_LOAD(s1, 1); SA_LOAD(s2, 2); SA_LOAD(s3, 3);
        SA_WRITE(s0, 0, 0); SA_LOAD(s0, 4); SA_WRITE(s1, 0, 1); SA_LOAD(s1, 5);
        SA_BAR();
        for (int j = 0; j < 62; j += 2) {
            SA_LOADER(j, s2, s3, SA_BUF);
            SA_BAR();
            SA_LOADER(j + 1, s0, s1, 0);
            SA_BAR();
        }
        SA_LOADER(62, s2, s3, SA_BUF);
        SA_BAR();
        SA_TAIL64(0);
        SA_BAR();
        if (half == 1) SA_BAR();
        SA_BAR();
    }
#undef SA_BAR
#undef SA_LOAD
#undef SA_WRITE
#undef SA_PK4
#undef SA_COMPUTE
#undef SA_KLD
#undef SA_VLD
#undef SA_VMM
#undef SA_LOADER
#undef SA_TAIL64

    float* parto = (float*)(ws + WS_PART) + (size_t)(b * 2 + half) * 64 * 128;
    __syncthreads();
    { bf16x8 ao[16];
#pragma unroll
      for (int ks = 0; ks < 16; ++ks) { u32x4 z = {0u, 0u, 0u, 0u}; if (r32 < DS) z = *(const LAS u32x4*)(lds + SA_OI + (r32 * 8 + wave) * SA_QI_PITCH + (16 * ks + 8 * g) * 2); ao[ks] = __builtin_bit_cast(bf16x8, z); }
      const bf16_t* wv = (const bf16_t*)(ws + WS_WUVP) + (size_t)wave * (64 * 512) + lane * 8;
#pragma unroll 2
      for (int nt = 0; nt < 4; ++nt) {
          f32x16 acc;
#pragma unroll
          for (int i = 0; i < 16; ++i) acc[i] = 0.f;
#pragma unroll
          for (int ks = 0; ks < 16; ++ks) acc = __builtin_amdgcn_mfma_f32_32x32x16_bf16(ao[ks], *(const bf16x8*)(wv + (nt * 16 + ks) * 512), acc, 0, 0, 0);
#pragma unroll
          for (int i = 0; i < 4; ++i) parto[(size_t)((i + 4 * g) * 8 + wave) * 128 + 32 * nt + r32] = acc[i];
      } }
    volatile LAS unsigned* flag = (volatile LAS unsigned*)(lds + MISC_OFF) + 16;
    asm volatile("s_waitcnt vmcnt(0)" ::: "memory");
    __syncthreads();
    if (tid == 0) {
        __builtin_amdgcn_fence(__ATOMIC_RELEASE, "agent");
        asm volatile("s_waitcnt vmcnt(0)" ::: "memory");
        const unsigned old = __hip_atomic_fetch_add((unsigned*)(ws + WS_CTL) + CW_SCNT + 64 * b, 1u, __ATOMIC_RELAXED, __HIP_MEMORY_SCOPE_AGENT);
        if (old == 1u) { __builtin_amdgcn_fence(__ATOMIC_ACQUIRE, "agent"); asm volatile("s_waitcnt vmcnt(0)" ::: "memory"); }
        flag[0] = old;
    }
    __syncthreads();
    if (flag[0] == 1u) {
        const int q = tid >> 3, v0 = (tid & 7) * 16, tok = q >> 3, h = q & 7;
        const float* mlb = (const float*)(ws + WS_ML) + ((size_t)(b * 2) * 64 + q) * 2; const float* pab = (const float*)(ws + WS_PART) + ((size_t)(b * 2) * 64 + q) * 128 + v0;
        const float m0 = mlb[0], l0 = mlb[1], m1 = mlb[128], l1 = mlb[129], mx = fmaxf(m0, m1);
        float w0 = __builtin_amdgcn_exp2f(m0 - mx), w1 = __builtin_amdgcn_exp2f(m1 - mx); const float inv = 1.0f / (w0 * l0 + w1 * l1); w0 *= inv; w1 *= inv;
        f32x4 a[4];
#pragma unroll
        for (int c = 0; c < 4; ++c) a[c] = *(const f32x4*)(pab + 4 * c) * w0 + *(const f32x4*)(pab + 64 * 128 + 4 * c) * w1;
        bf16_t* od = (bf16_t*)(ws + WS_OBUF) + (size_t)(MP + b * DS + tok) * D + h * VD + v0;
        *(bf16x8*)od = pack8v(a[0], a[1]); *(bf16x8*)(od + 8) = pack8v(a[2], a[3]);
    }
}

template <int W>
__device__ __forceinline__ void pool_chunk(const float* __restrict__ xr, int rvb, f32x4 gn, int col, int t0, bf16_t* __restrict__ drow) {
    f32x4 ring[W - 1]; f32x4 sum = {0.f, 0.f, 0.f, 0.f};
#pragma unroll
    for (int i = W - 1; i >= 1; --i) { f32x4 u = {0.f, 0.f, 0.f, 0.f};
        if (t0 - i >= 0) u = *(const f32x4*)(xr - (size_t)i * D + col) * __builtin_bit_cast(float, __builtin_amdgcn_readlane(rvb, 15 - i));
        ring[(W - 1 - i) % (W - 1)] = u; sum += u; }
#pragma unroll
    for (int r = 0; r < 16; ++r) {
        const f32x4 u = *(const f32x4*)(xr + (size_t)r * D + col) * __builtin_bit_cast(float, __builtin_amdgcn_readlane(rvb, 15 + r));
        sum += u;
        const int t = t0 + r; const float icnt = 1.0f / (float)((t + 1) < W ? (t + 1) : W);
        const f32x4 dd = (sum * icnt - u) * gn;
        u32x2 o; o.x = pk2(dd.x, dd.y); o.y = pk2(dd.z, dd.w);
        *(u32x2*)(drow + (size_t)r * D + col) = o;
        sum -= ring[r % (W - 1)]; ring[r % (W - 1)] = u;
    }
}
constexpr int NPH = 17;
__global__ void __launch_bounds__(512, 2) yoco_fwd(Params P) {
    extern __shared__ __attribute__((aligned(16))) unsigned char lds_raw[];
    LAS unsigned char* lds = (LAS unsigned char*)lds_raw;
    volatile LAS unsigned* MISC = (volatile LAS unsigned*)(lds + MISC_OFF);
    const int tid = threadIdx.x, lane = tid & 63, wave = __builtin_amdgcn_readfirstlane(tid >> 6);
    const int G = gridDim.x; const int bx = blockIdx.x; const int vcu = (G % 8 == 0) ? (bx % 8) * (G / 8) + bx / 8 : bx;
    unsigned char* ws = P.ws; float* out = P.out;
    for (int u = tid; u < 64; u += 512) MISC[u] = 0u;
    __syncthreads();
    XcdBarrier bar; bar.bar = (unsigned*)(ws + WS_CTL) + CW_BAR; bar.x = 0; bar.st = nullptr;
    if (MK_N_LAUNCHES == 1) bar = xcd_barrier_post((unsigned*)(ws + WS_CTL) + CW_BAR, MISC + 8);
    const int lo = P.ph_lo, hi = P.ph_hi;
#ifndef PH_MASK
#define PH_MASK 0xFFFFFFFFu
#endif
#define IN(k) (((PH_MASK >> (k)) & 1u) && lo <= (k) && (k) < hi)
#define SEAM(k) do { if (IN(k) && IN((k) + 1)) xcd_barrier(bar); } while (0)
#define SEAM2(k, kn) do { if (IN(k) && IN(kn)) xcd_barrier(bar); } while (0)
    const int gw = vcu * 8 + wave, NGW = G * 8;
    const int gtid = vcu * 512 + tid, NGT = G * 512;

#define wpool ((bf16_t*)(ws + WS_WPOOL))
#define wup ((bf16_t*)(ws + WS_WUP))
#define wdown ((bf16_t*)(ws + WS_WDOWN))
#define wgate ((bf16_t*)(ws + WS_WGATE))
#define wproj ((bf16_t*)(ws + WS_WPROJ))
#define wdkvq ((bf16_t*)(ws + WS_WDKVQ))
#define wuq ((bf16_t*)(ws + WS_WUQ))
#define wukt ((bf16_t*)(ws + WS_WUKT))
#define wuvt ((bf16_t*)(ws + WS_WUVT))
#define wukb ((bf16_t*)(ws + WS_WUKB))
#define wo ((bf16_t*)(ws + WS_WO))
#define cs ((float*)(ws + WS_CS))
#define rstd0 ((float*)(ws + WS_RSTD0))
#define dbuf ((bf16_t*)(ws + WS_DBUF))
#define pb ((bf16_t*)(ws + WS_PB))
#define hbA ((bf16_t*)(ws + WS_HBA))
#define hbB ((bf16_t*)(ws + WS_HBB))
#define ssq ((float*)(ws + WS_SSQ))
#define abuf ((bf16_t*)(ws + WS_ABUF))
#define proj ((bf16_t*)(ws + WS_PROJ))
#define craw ((float*)(ws + WS_RAW))
#define ssqc ((float*)(ws + WS_RAW + (size_t)M * KVR * 4))
#define ssqq ((float*)(ws + WS_RAW + (size_t)M * KVR * 4 + (size_t)M * 16))
#define cb ((bf16_t*)(ws + WS_CB))
#define krbs ((bf16_t*)(ws + WS_KRBS))
#define cqb ((bf16_t*)(ws + WS_CQB))
#define qbuf ((bf16_t*)(ws + WS_QBUF))
#define qs ((bf16_t*)(ws + WS_QS))
#define kfull ((bf16_t*)(ws + WS_KFULL))
#define vt ((bf16_t*)(ws + WS_VT))
#define obuf ((bf16_t*)(ws + WS_OBUF))
    constexpr size_t SSQ_V = (size_t)M * 16;

    if (IN(0)) {
        LAS float* scr = (LAS float*)(lds + wave * 16384);
        int it = gw;
#define TI(W_, ks_, K_, N_, WT_, ro_) { const int n_items = ((K_) / 64) * ((N_) / 32); for (; it < n_items; it += NGW) transpose_item(W_, ks_, K_, N_, WT_, ro_, scr, it, lane); it -= n_items; }
        TI(P.in[I_POOLW] + 0 * 65536, nullptr, 256, 256, wpool, 0) TI(P.in[I_POOLW] + 1 * 65536, nullptr, 256, 256, wpool, 256)
        TI(P.in[I_POOLW] + 2 * 65536, nullptr, 256, 256, wpool, 512) TI(P.in[I_POOLW] + 3 * 65536, nullptr, 256, 256, wpool, 768)
        TI(P.in[I_WUP], P.in[I_NMLP], D, FF, wup, 0) TI(P.in[I_WUP] + (size_t)D * FF, P.in[I_NMLP] + D, D, FF, wup + (size_t)FF * D, 0)
        TI(P.in[I_WDOWN], nullptr, FF, D, wdown, 0) TI(P.in[I_WDOWN] + (size_t)D * FF, nullptr, FF, D, wdown + (size_t)FF * D, 0)
        TI(P.in[I_WGATE], P.in[I_NPLE], D, D, wgate, 0) TI(P.in[I_WGATE] + (size_t)D * D, P.in[I_NPLE] + D, D, D, wgate + (size_t)D * D, 0)
        TI(P.in[I_WPROJ], nullptr, PLE, D, wproj, 0) TI(P.in[I_WPROJ] + (size_t)PLE * D, nullptr, PLE, D, wproj + (size_t)PLE * D, 0)
        { const int n_items = (D / 64) * (320 / 32); for (; it < n_items; it += NGW) transpose_item<2>(P.in[I_WDKV], P.in[I_NKV], D, 320, wdkvq, 0, scr, it, lane); it -= n_items; }
        TI(P.in[I_WDQ], P.in[I_NMIX] + D, D, QR, wdkvq, 320)
        { const int n_items = (QR / 64) * (NH * QH / 32); for (; it < n_items; it += NGW) transpose_item<1>(P.in[I_WUQ], P.in[I_QN], QR, NH * QH, wuq, 0, scr, it, lane); it -= n_items; }
        TI(P.in[I_WUK], P.in[I_KVN], KVR, 1024, wukt, 0) TI(P.in[I_WUV], P.in[I_KVN], KVR, 1024, wuvt, 0)
        TI(P.in[I_WO], nullptr, D, D, wo, 0)
#undef TI
        for (int i = gtid; i < 64 * D / 8; i += NGT) *(u32x4*)(wdkvq + (size_t)704 * D + (size_t)i * 8) = (u32x4){0u, 0u, 0u, 0u};
        for (int i = gtid; i < 256 * 1024 / 8; i += NGT) { const int ln = i & 63, ks = (i >> 6) & 7, nt = (i >> 9) & 7, h = i >> 12;
            const float* sp = P.in[I_WUK] + (size_t)(32 * nt + (ln & 31)) * 1024 + h * NOPE + 16 * ks + 8 * (ln >> 5);
            *(bf16x8*)(wukb + (size_t)i * 8) = pack8v(*(const f32x4*)sp, *(const f32x4*)(sp + 4)); }
        for (int i = gtid; i < 256 * 1024 / 8; i += NGT) { const int ln = i & 63, ks = (i >> 6) & 15, nt = (i >> 10) & 3, h = i >> 12;
            const float* sp = P.in[I_WUV] + (size_t)(16 * ks + 8 * (ln >> 5)) * 1024 + h * VD + 32 * nt + (ln & 31);
            float t[8];
#pragma unroll
            for (int e = 0; e < 8; ++e) t[e] = sp[(size_t)e * 1024];
            *(bf16x8*)((bf16_t*)(ws + WS_WUVP) + (size_t)i * 8) = pack8(t); }
        for (int i = gtid; i < NPOS * 32; i += NGT) { const int pos = i >> 5, f = i & 31; const double inv = exp2(-(double)f * (13.287712379549449 / 32.0)); const double ang = (double)pos * inv;
            double sn, cn; sincos(ang, &sn, &cn); cs[(size_t)pos * 64 + f] = (float)cn; cs[(size_t)pos * 64 + 32 + f] = (float)sn; }
        for (int i = gtid; i < 2 * M * PLE / 8; i += NGT) { const int li = i / (M * PLE / 8), r8 = i % (M * PLE / 8); const size_t e = (size_t)r8 * 8; const int row = (int)(e / PLE), c = (int)(e % PLE);
            const float* src = row < MP ? P.in[I_PP] + ((size_t)li * MP + row) * PLE + c : P.in[I_PS] + ((size_t)li * MS + (row - MP)) * PLE + c;
            *(bf16x8*)(pb + ((size_t)li * M + row) * PLE + c) = pack8v(*(const f32x4*)src, *(const f32x4*)(src + 4)); }
        for (int row0 = gw; row0 < M; row0 += 2 * NGW) {
            f32x4 v[2][4];
#pragma unroll
            for (int rr = 0; rr < 2; ++rr) { const int row = row0 + rr * NGW; if (row < M) { const float* xr = row < MP ? P.in[I_XP] + (size_t)row * D : P.in[I_XS] + (size_t)(row - MP) * D;
#pragma unroll
                for (int j = 0; j < 4; ++j) v[rr][j] = ((const f32x4*)xr)[lane + 64 * j]; } }
#pragma unroll
            for (int rr = 0; rr < 2; ++rr) { const int row = row0 + rr * NGW; if (row < M) {
                float s = 0.f;
#pragma unroll
                for (int j = 0; j < 4; ++j) s += (v[rr][j].x * v[rr][j].x + v[rr][j].y * v[rr][j].y) + (v[rr][j].z * v[rr][j].z + v[rr][j].w * v[rr][j].w);
                const float rstd = 1.0f / sqrtf(wave_sum(s) * (1.0f / D) + EPS);
                if (lane == 0) rstd0[row] = rstd;
                float* po = nullptr;
                if (row < MP) { const int b = row >> 13, t = row & (SEQ - 1); if (t >= SEQ - 15) po = out + O_PP + ((size_t)b * 15 + (t - (SEQ - 15))) * D; }
                else { const int rs_ = row - MP, b = rs_ >> 3, t = rs_ & 7; po = out + O_PS + ((size_t)b * 15 + 7 + t) * D; }
                if (po) {
#pragma unroll
                    for (int j = 0; j < 4; ++j) { const f32x4 gn = ((const f32x4*)P.in[I_NMIX])[lane + 64 * j]; ((f32x4*)po)[lane + 64 * j] = v[rr][j] * rstd * gn; } }
            } }
        }
        for (int i = gtid; i < DB * 7 * D / 4; i += NGT) { const int b = i / (7 * D / 4), r = (i / (D / 4)) % 7, c = i % (D / 4);
            ((f32x4*)(out + O_PS + ((size_t)b * 15 + r) * D))[c] = ((const f32x4*)(P.in[I_SPOOL] + ((size_t)b * 15 + 8 + r) * D))[c]; }
    }
    SEAM2(0, 2);
    if (IN(2)) {
#ifndef SUBM
#define SUBM 7
#endif
        { SgH<0> E{P.in[I_XS], P.in[I_POOLSC], nullptr, nullptr, nullptr, hbA, ssq + 0 * SSQ_V};
          for (int u = vcu; u < 256; u += G) {
              const int mt = u >> 4, gq = (u & 15) >> 2, w = 2 << gq, col = 256 * gq + 4 * lane, bs = mt * 8 + wave;
              const float* sp = P.in[I_SPOOL] + (size_t)bs * 15 * D; const float* xs0 = P.in[I_XS] + (size_t)(bs * DS) * D;
              const float rv = (lane < DS) ? rstd0[MP + bs * DS + lane] : 0.f;
              const f32x4 gn = *(const f32x4*)(P.in[I_NMIX] + col);
#pragma unroll
              for (int t = 0; t < DS; ++t) {
                  const f32x4 u0 = *(const f32x4*)(xs0 + (size_t)t * D + col) * __shfl(rv, t); f32x4 sum = u0, hist = {0.f, 0.f, 0.f, 0.f};
#pragma unroll
                  for (int i = 1; i < 16; ++i) if (i < w) { const int tt = t - i;
                      if (tt >= 0) sum += *(const f32x4*)(xs0 + (size_t)tt * D + col) * __shfl(rv, tt >= 0 ? tt : 0);
                      else hist += *(const f32x4*)(sp + (size_t)(15 + tt) * D + col); }
                  const f32x4 dd = (sum * gn + hist) / (float)w - u0 * gn;
                  u32x2 o; o.x = pk2(dd.x, dd.y); o.y = pk2(dd.z, dd.w);
                  *(u32x2*)(dbuf + (size_t)(MP + bs * DS + t) * D + col) = o;
              }
              asm volatile("s_waitcnt vmcnt(0)" ::: "memory"); __syncthreads();
              sk_gemm(lds, dbuf + (size_t)(MP + 64 * mt) * D + 256 * gq, D, wpool + (size_t)(64 * (u & 15)) * 256, 256, 64 * mt, 64 * (u & 15), u & 15, E, tid, wave, lane); } }
        { SgBf E{proj, D};
          for (int u = vcu; u < 256; u += G) sk_gemm(lds, pb + (size_t)(MP + 64 * (u >> 4)) * PLE, PLE, wproj + (size_t)(64 * (u & 15)) * PLE, PLE, 64 * (u >> 4), 64 * (u & 15), u & 15, E, tid, wave, lane); }
        { SgBf E{proj + (size_t)M * D, D};
          for (int u = vcu; u < 256; u += G) sk_gemm(lds, pb + (size_t)(M + MP + 64 * (u >> 4)) * PLE, PLE, wproj + (size_t)PLE * D + (size_t)(64 * (u & 15)) * PLE, PLE, 64 * (u >> 4), 64 * (u & 15), u & 15, E, tid, wave, lane); }
        if (SUBM & 1) { pg8::Gemm g{dbuf, wpool, MP, D, 256, D, 256}; pg8::StaticOrder S; S.init(MP, D, G, bx);
          {
            pg8::Unit uu;
            for (int i = 0; S.next(i, uu); ++i) {
#pragma unroll 1
                for (int cc = 0; cc < 2; ++cc) {
                    const int row0 = uu.pm * 256 + (2 * wave + cc) * 16, t0 = row0 & (SEQ - 1), col = 256 * uu.pn + 4 * lane;
                    const float rv = (lane < 31 && t0 - 15 + lane >= 0) ? rstd0[row0 - 15 + lane] : 0.f;
                    const int rvb = __builtin_bit_cast(int, rv);
                    const float* xr = P.in[I_XP] + (size_t)row0 * D; bf16_t* dr = dbuf + (size_t)row0 * D; const f32x4 gn = *(const f32x4*)(P.in[I_NMIX] + col);
                    if (uu.pn == 0) pool_chunk<2>(xr, rvb, gn, col, t0, dr); else if (uu.pn == 1) pool_chunk<4>(xr, rvb, gn, col, t0, dr);
                    else if (uu.pn == 2) pool_chunk<8>(xr, rvb, gn, col, t0, dr); else pool_chunk<16>(xr, rvb, gn, col, t0, dr);
                } }
            asm volatile("s_waitcnt vmcnt(0)" ::: "memory"); __syncthreads(); }
          EpiH<0> E{P.in[I_XP], P.in[I_XS], P.in[I_POOLSC], nullptr, nullptr, nullptr, hbA, ssq + 0 * SSQ_V};
          pg8::gemm_phase(lds, g, S, E); }
        if (SUBM & 2) { pg8::Gemm g{pb, wproj, MP, D, PLE, PLE, 0}; pg8::StaticOrder S; S.init(MP, D, G, bx);
          EpiBf E{proj, D};
          pg8::gemm_phase(lds, g, S, E); }
        if (SUBM & 4) { pg8::Gemm g{pb + (size_t)M * PLE, wproj + (size_t)PLE * D, MP, D, PLE, PLE, 0}; pg8::StaticOrder S; S.init(MP, D, G, bx);
          EpiBf E{proj + (size_t)M * D, D};
          pg8::gemm_phase(lds, g, S, E); }
    }
    SEAM(2);
    if (IN(3)) {
        { SgUp E{ssq + 0 * SSQ_V, abuf}; for (int u = vcu; u < 1024; u += G) sk_gemm(lds, hbA + (size_t)(MP + 64 * (u & 15)) * D, D, wup + (size_t)(64 * (u >> 4)) * D, D, 64 * (u & 15), 64 * (u >> 4), 0, E, tid, wave, lane); }
        pg8::Gemm g{hbA, wup, MP, FF, D, D, 0}; pg8::StaticOrder S; S.init(MP, FF, G, bx); EpiUp E{ssq + 0 * SSQ_V, abuf}; pg8::gemm_phase(lds, g, S, E); }
    SEAM(3);
    if (IN(4)) {
        { SgH<1> E{nullptr, nullptr, nullptr, nullptr, hbA, hbB, ssq + 1 * SSQ_V}; for (int u = vcu; u < 256; u += G) sk_gemm(lds, abuf + (size_t)(MP + 64 * (u >> 4)) * FF, FF, wdown + (size_t)(64 * (u & 15)) * FF, FF, 64 * (u >> 4), 64 * (u & 15), u & 15, E, tid, wave, lane); }
        pg8::Gemm g{abuf, wdown, MP, D, FF, FF, 0}; pg8::StaticOrder S; S.init(MP, D, G, bx);
        EpiH<1> E{nullptr, nullptr, nullptr, nullptr, nullptr, hbA, hbB, ssq + 1 * SSQ_V}; pg8::gemm_phase(lds, g, S, E); }
    SEAM(4);
    if (IN(5)) {
        { SgH<2> E{nullptr, nullptr, ssq + 1 * SSQ_V, proj, hbB, hbA, ssq + 2 * SSQ_V}; for (int u = vcu; u < 256; u += G) sk_gemm(lds, hbB + (size_t)(MP + 64 * (u >> 4)) * D, D, wgate + (size_t)(64 * (u & 15)) * D, D, 64 * (u >> 4), 64 * (u & 15), u & 15, E, tid, wave, lane); }
        pg8::Gemm g{hbB, wgate, MP, D, D, D, 0}; pg8::StaticOrder S; S.init(MP, D, G, bx);
        EpiH<2> E{nullptr, nullptr, nullptr, ssq + 1 * SSQ_V, proj, hbB, hbA, ssq + 2 * SSQ_V}; pg8::gemm_phase(lds, g, S, E); }
    SEAM(5);
    if (IN(6)) {
        pg8::Gemm g{hbA, wdkvq, M, NDKVQ, D, D, 0}; pg8::StaticOrder S; S.init(M, NDKVQ, G, bx); EpiDkvq E{ssq + 2 * SSQ_V, cs, craw, cb, cqb, ssqc, ssqq, out, kfull, krbs}; pg8::gemm_phase(lds, g, S, E); }
    SEAM2(6, 8);
    if (IN(8)) {
        if (SUBM & 1) { pg8::Gemm g{cqb, wuq, M, NH * QH, QR, QR, 0}; pg8::StaticOrder S; S.init(M, NH * QH, G, bx); EpiQ E{ssqq, cs, qbuf, qs}; pg8::gemm_phase(lds, g, S, E); }
        if (SUBM & 2) { pg8::Gemm g{cb, wukt, MP, 1024, KVR, KVR, 0}; pg8::StaticOrder S; S.init(MP, 1024, G, (bx + 128) % G); EpiKup E{kfull, ssqc}; pg8::gemm_phase(lds, g, S, E); }
        if (SUBM & 4) { pg8::Gemm g{wuvt, cb, 1024, MP, KVR, KVR, 0}; pg8::StaticOrder S; S.init(1024, MP, G, (bx + 128) % G); EpiVup E{vt, ssqc}; pg8::gemm_phase(lds, g, S, E); }
        { const f32x4 kvn = ((const f32x4*)P.in[I_KVN])[lane];
          for (int row0 = 2 * gw; row0 < M; row0 += 2 * NGW) {
              f32x4 c4[2], p4[2];
#pragma unroll
              for (int e = 0; e < 2; ++e) { c4[e] = ((const f32x4*)(craw + (size_t)(row0 + e) * KVR))[lane]; p4[e] = *(const f32x4*)(ssqc + (size_t)(row0 + e) * 4); }
#pragma unroll
              for (int e = 0; e < 2; ++e) { const int row = row0 + e; const bool isp = row < MP;
                  const float rc = 1.0f / sqrtf(((p4[e].x + p4[e].y) + (p4[e].z + p4[e].w)) * (1.0f / KVR) + EPS);
                  const f32x4 cn = c4[e] * rc * kvn;
                  float* lo_ = isp ? out + O_LP + (size_t)row * KVR : out + O_LS + (size_t)(row - MP) * KVR;
                  ((f32x4*)lo_)[lane] = cn;
                  if (!isp) { u32x2 o; o.x = pk2(cn.x, cn.y); o.y = pk2(cn.z, cn.w); ((u32x2*)(cb + (size_t)row * KVR))[lane] = o; } } } }
    }
    SEAM2(8, 10);
    if (IN(10)) {
        const bool sfirst = (bx >> 3) & 1;
        if (sfirst) for (int it = vcu; it < 2 * DB; it += G) sattn_item(P, it >> 1, it & 1, lds, tid, wave, lane);
        for (int u = vcu; u < 256; u += G) {
            const int bh = u >> 4, p = u & 15;
            attn_prompt_unit(qbuf, kfull, vt, obuf, bh >> 3, bh & 7, 31 - p, lds, tid, wave, lane);
            attn_prompt_unit(qbuf, kfull, vt, obuf, bh >> 3, bh & 7, p, lds, tid, wave, lane);
        }
        if (!sfirst) for (int it = vcu; it < 2 * DB; it += G) sattn_item(P, it >> 1, it & 1, lds, tid, wave, lane);
    }
    SEAM2(10, 12);
    if (IN(12)) {
        { SgH<1> E{nullptr, nullptr, nullptr, nullptr, hbA, hbB, ssq + 3 * SSQ_V};
          for (int u = vcu; u < 256; u += G) sk_gemm(lds, obuf + (size_t)(MP + 64 * (u >> 4)) * D, D, wo + (size_t)(64 * (u & 15)) * D, D, 64 * (u >> 4), 64 * (u & 15), u & 15, E, tid, wave, lane); }
        pg8::Gemm g{obuf, wo, MP, D, D, D, 0}; pg8::StaticOrder S; S.init(MP, D, G, bx);
        EpiH<1> E{nullptr, nullptr, nullptr, nullptr, nullptr, hbA, hbB, ssq + 3 * SSQ_V}; pg8::gemm_phase(lds, g, S, E); }
    SEAM(12);
    if (IN(13)) {
        { SgUp E{ssq + 3 * SSQ_V, abuf}; for (int u = vcu; u < 1024; u += G) sk_gemm(lds, hbB + (size_t)(MP + 64 * (u & 15)) * D, D, wup + (size_t)FF * D + (size_t)(64 * (u >> 4)) * D, D, 64 * (u & 15), 64 * (u >> 4), 0, E, tid, wave, lane); }
        pg8::Gemm g{hbB, wup + (size_t)FF * D, MP, FF, D, D, 0}; pg8::StaticOrder S; S.init(MP, FF, G, bx); EpiUp E{ssq + 3 * SSQ_V, abuf}; pg8::gemm_phase(lds, g, S, E); }
    SEAM(13);
    if (IN(14)) {
        { SgH<1> E{nullptr, nullptr, nullptr, nullptr, hbB, hbA, ssq + 4 * SSQ_V}; for (int u = vcu; u < 256; u += G) sk_gemm(lds, abuf + (size_t)(MP + 64 * (u >> 4)) * FF, FF, wdown + (size_t)FF * D + (size_t)(64 * (u & 15)) * FF, FF, 64 * (u >> 4), 64 * (u & 15), u & 15, E, tid, wave, lane); }
        pg8::Gemm g{abuf, wdown + (size_t)FF * D, MP, D, FF, FF, 0}; pg8::StaticOrder S; S.init(MP, D, G, bx);
        EpiH<1> E{nullptr, nullptr, nullptr, nullptr, nullptr, hbB, hbA, ssq + 4 * SSQ_V}; pg8::gemm_phase(lds, g, S, E); }
    SEAM(14);
    if (IN(15)) {
        { SgH<2> E{nullptr, nullptr, ssq + 4 * SSQ_V, proj + (size_t)M * D, hbA, hbB, ssq + 5 * SSQ_V}; for (int u = vcu; u < 256; u += G) sk_gemm(lds, hbA + (size_t)(MP + 64 * (u >> 4)) * D, D, wgate + (size_t)D * D + (size_t)(64 * (u & 15)) * D, D, 64 * (u >> 4), 64 * (u & 15), u & 15, E, tid, wave, lane); }
        pg8::Gemm g{hbA, wgate + (size_t)D * D, MP, D, D, D, 0}; pg8::StaticOrder S; S.init(MP, D, G, bx);
        EpiH<2> E{nullptr, nullptr, nullptr, ssq + 4 * SSQ_V, proj + (size_t)M * D, hbA, hbB, ssq + 5 * SSQ_V}; pg8::gemm_phase(lds, g, S, E); }
    SEAM(15);
    if (IN(16)) {
        f32x4 gn[4];
#pragma unroll
        for (int j = 0; j < 4; ++j) gn[j] = ((const f32x4*)P.in[I_NFIN])[lane + 64 * j];
        for (int row0 = 4 * gw; row0 < M; row0 += 4 * NGW) {
            u32x2 hv[4][4]; float sp[4];
#pragma unroll
            for (int e = 0; e < 4; ++e) { sp[e] = (lane < 16) ? ssq[5 * SSQ_V + (size_t)(row0 + e) * 16 + lane] : 0.f;
#pragma unroll
                for (int j = 0; j < 4; ++j) hv[e][j] = ((const u32x2*)(hbB + (size_t)(row0 + e) * D))[lane + 64 * j]; }
#pragma unroll
            for (int e = 0; e < 4; ++e) { const float rstd = 1.0f / sqrtf(wave_sum(sp[e]) * (1.0f / D) + EPS);
#pragma unroll
                for (int j = 0; j < 4; ++j) ((f32x4*)(out + O_Y + (size_t)(row0 + e) * D))[lane + 64 * j] = unpk4(hv[e][j]) * rstd * gn[j]; }
        }
    }
#undef IN
#undef SEAM
#undef SEAM2
#undef wpool
#undef wup
#undef wdown
#undef wgate
#undef wproj
#undef wdkvq
#undef wuq
#undef wukt
#undef wuvt
#undef wukb
#undef wo
#undef cs
#undef rstd0
#undef dbuf
#undef pb
#undef hbA
#undef hbB
#undef ssq
#undef abuf
#undef proj
#undef craw
#undef ssqc
#undef ssqq
#undef cb
#undef krbs
#undef cqb
#undef qbuf
#undef qs
#undef kfull
#undef vt
#undef obuf
}

extern "C" void kernel_launch(void* const* d_in, const int* in_sizes, int n_in, void* d_out, int out_size, void* d_ws, size_t ws_size, hipStream_t stream) {
    static int grid = 0;
    if (grid == 0) {
        if (n_in != 27 || (size_t)out_size != O_END || ws_size < WS_END) { fprintf(stderr, "kernel_launch: shape mismatch (n_in %d, out %d, ws %zu; need 27, %zu, %zu)\n", n_in, out_size, ws_size, (size_t)O_END, (size_t)WS_END); grid = -1; return; }
        int dev = 0, cus = 0, per_cu = 0;
        if (hipGetDevice(&dev) != hipSuccess || hipDeviceGetAttribute(&cus, hipDeviceAttributeMultiprocessorCount, dev) != hipSuccess) { grid = -1; return; }
        if (hipFuncSetAttribute((const void*)yoco_fwd, hipFuncAttributeMaxDynamicSharedMemorySize, LDS_BYTES) != hipSuccess) { fprintf(stderr, "kernel_launch: hipFuncSetAttribute failed\n"); grid = -1; return; }
        if (hipOccupancyMaxActiveBlocksPerMultiprocessor(&per_cu, (const void*)yoco_fwd, 512, LDS_BYTES) != hipSuccess || per_cu < 1) fprintf(stderr, "kernel_launch: occupancy query reports %d\n", per_cu);
        (void)hipGetLastError();
        grid = cus;
    }
    if (grid < 0) return;
    (void)hipMemsetAsync((char*)d_ws + WS_CTL, 0, CTL_BYTES, stream);
    Params p{};
    for (int i = 0; i < 27; ++i) p.in[i] = (const float*)d_in[i];
    p.out = (float*)d_out; p.ws = (unsigned char*)d_ws;
#if MK_N_LAUNCHES == 1
    p.ph_lo = 0; p.ph_hi = NPH;
    hipLaunchKernelGGL(yoco_fwd, dim3(grid), dim3(512), LDS_BYTES, stream, p);
#else
    for (int k = 0; k < NPH; ++k) { p.ph_lo = k; p.ph_hi = k + 1; hipLaunchKernelGGL(yoco_fwd, dim3(grid), dim3(512), LDS_BYTES, stream, p); }
#endif
    const hipError_t le = hipPeekAtLastError();
    if (le != hipSuccess) fprintf(stderr, "kernel_launch: launch failed: %s\n", hipGetErrorName(le));
}
```

```cpp
#include <hip/hip_runtime.h>
#include <cstdio>
#include <cstdint>

#ifndef MK_N_LAUNCHES
#define MK_N_LAUNCHES 1
#endif

#define GAS __attribute__((address_space(1)))
#define LAS __attribute__((address_space(3)))
typedef unsigned short bf16_t;
typedef short bf16x8 __attribute__((ext_vector_type(8)));
typedef float f32x4 __attribute__((ext_vector_type(4)));
typedef float f32x16 __attribute__((ext_vector_type(16)));
typedef unsigned u32x2 __attribute__((ext_vector_type(2)));
typedef unsigned u32x4 __attribute__((ext_vector_type(4)));

constexpr int D = 1024, FF = 4096, PLE = 256, SEQ = 8192, NBATCH = 2, DB = 128, DS = 8;
constexpr int MP = NBATCH * SEQ;
constexpr int MS = DB * DS;
constexpr int M = MP + MS;
constexpr int KVR = 256, ROPE = 64, QR = 384, NH = 8, NOPE = 128, VD = 128, QH = NOPE + ROPE;
constexpr int NDKVQ = 768;
constexpr int PAST = 8192, PAGE = 128, NPG = PAST / PAGE;
constexpr float EPS = 1e-6f;
constexpr float SM_SCALE = 0.07216878364870322f;
constexpr float LOG2E = 1.4426950408889634f;
constexpr float CEXP = SM_SCALE * LOG2E;
constexpr int NPOS = PAST + DS;

constexpr size_t O_Y = 0;
constexpr size_t O_PP = (size_t)M * D;
constexpr size_t O_PS = O_PP + (size_t)NBATCH * 15 * D;
constexpr size_t O_LP = O_PS + (size_t)DB * 15 * D;
constexpr size_t O_KP = O_LP + (size_t)MP * KVR;
constexpr size_t O_LS = O_KP + (size_t)MP * ROPE;
constexpr size_t O_KS = O_LS + (size_t)MS * KVR;
constexpr size_t O_END = O_KS + (size_t)MS * ROPE;

constexpr size_t al256(size_t x) { return (x + 255) / 256 * 256; }
constexpr size_t WS_CTL = 0, CTL_BYTES = 1u << 20;
constexpr size_t WS_WPOOL = CTL_BYTES;
constexpr size_t WS_WUP   = WS_WPOOL + al256((size_t)1024 * 256 * 2);
constexpr size_t WS_WDOWN = WS_WUP   + al256((size_t)2 * FF * D * 2);
constexpr size_t WS_WGATE = WS_WDOWN + al256((size_t)2 * FF * D * 2);
constexpr size_t WS_WPROJ = WS_WGATE + al256((size_t)2 * D * D * 2);
constexpr size_t WS_WDKVQ = WS_WPROJ + al256((size_t)2 * D * PLE * 2);
constexpr size_t WS_WUQ   = WS_WDKVQ + al256((size_t)NDKVQ * D * 2);
constexpr size_t WS_WUKT  = WS_WUQ   + al256((size_t)NH * QH * QR * 2);
constexpr size_t WS_WUVT  = WS_WUKT  + al256((size_t)1024 * 256 * 2);
constexpr size_t WS_WUVP  = WS_WUVT  + al256((size_t)1024 * 256 * 2);
constexpr size_t WS_WUKB  = WS_WUVP  + al256((size_t)1024 * 256 * 2);
constexpr size_t WS_WO    = WS_WUKB  + al256((size_t)1024 * 256 * 2);
constexpr size_t WS_CS    = WS_WO    + al256((size_t)D * D * 2);
constexpr size_t WS_RSTD0 = WS_CS    + al256((size_t)NPOS * 64 * 4);
constexpr size_t WS_DBUF  = WS_RSTD0 + al256((size_t)M * 4);
constexpr size_t WS_PB    = WS_DBUF  + al256((size_t)M * D * 2);
constexpr size_t WS_HBA   = WS_PB    + al256((size_t)2 * M * PLE * 2);
constexpr size_t WS_HBB   = WS_HBA   + al256((size_t)M * D * 2);
constexpr size_t WS_SSQ   = WS_HBB   + al256((size_t)M * D * 2);
constexpr size_t WS_ABUF  = WS_SSQ   + al256((size_t)6 * M * 16 * 4);
constexpr size_t WS_PROJ  = WS_ABUF  + al256((size_t)M * FF * 2);
constexpr size_t WS_RAW   = WS_PROJ  + al256((size_t)2 * M * D * 2);
constexpr size_t WS_CB    = WS_RAW   + al256((size_t)M * NDKVQ * 4);
constexpr size_t WS_KRBS  = WS_CB    + al256((size_t)M * KVR * 2);
constexpr size_t WS_CQB   = WS_KRBS  + al256((size_t)MS * ROPE * 2);
constexpr size_t WS_RSTDQ = WS_CQB   + al256((size_t)M * QR * 2);
constexpr size_t WS_QBUF  = WS_RSTDQ + al256((size_t)M * 4);
constexpr size_t WS_QS    = WS_QBUF  + al256((size_t)M * NH * QH * 2);
constexpr size_t WS_KFULL = WS_QS    + al256((size_t)MS * NH * 320 * 2);
constexpr size_t WS_VT    = WS_KFULL + al256((size_t)16 * SEQ * QH * 2);
constexpr size_t WS_OBUF  = WS_VT    + al256((size_t)16 * VD * SEQ * 2);
constexpr size_t WS_PART  = WS_OBUF  + al256((size_t)M * D * 2);
constexpr size_t WS_ML    = WS_PART  + al256((size_t)DB * 8 * 64 * 256 * 4);
constexpr size_t WS_END   = WS_ML    + al256((size_t)DB * 8 * 64 * 2 * 4);

constexpr int CW_BAR = 4096;
constexpr int CW_SCNT = 16384;

constexpr int RING_BYTES = 131072;
constexpr int LDS_BYTES = 147456;
constexpr int MISC_OFF = LDS_BYTES - 256;

typedef float f32x2 __attribute__((ext_vector_type(2)));
typedef __bf16 nbf16x2 __attribute__((ext_vector_type(2)));
__device__ __forceinline__ unsigned pk2(float lo, float hi) { const f32x2 v = {lo, hi}; return __builtin_bit_cast(unsigned, __builtin_convertvector(v, nbf16x2)); }
__device__ __forceinline__ unsigned f2bf(float f) { return pk2(f, 0.f) & 0xffffu; }
__device__ __forceinline__ float bf2f(unsigned short b) { return __builtin_bit_cast(float, ((unsigned)b) << 16); }
__device__ __forceinline__ f32x4 unpk4(u32x2 w) { f32x4 r; r.x = __builtin_bit_cast(float, w.x << 16); r.y = __builtin_bit_cast(float, w.x & 0xffff0000u); r.z = __builtin_bit_cast(float, w.y << 16); r.w = __builtin_bit_cast(float, w.y & 0xffff0000u); return r; }
__device__ __forceinline__ bf16x8 pack8(const float* v) { u32x4 w; w.x = pk2(v[0], v[1]); w.y = pk2(v[2], v[3]); w.z = pk2(v[4], v[5]); w.w = pk2(v[6], v[7]); return __builtin_bit_cast(bf16x8, w); }
__device__ __forceinline__ bf16x8 pack8v(f32x4 a, f32x4 b) { u32x4 w; w.x = pk2(a.x, a.y); w.y = pk2(a.z, a.w); w.z = pk2(b.x, b.y); w.w = pk2(b.z, b.w); return __builtin_bit_cast(bf16x8, w); }
__device__ __forceinline__ float wave_sum(float v) {
#pragma unroll
    for (int o = 1; o < 64; o <<= 1) v += __shfl_xor(v, o);
    return v;
}
__device__ __forceinline__ int crow(int r, int hi) { return (r & 3) + 8 * (r >> 2) + 4 * hi; }
#define LDS_WAIT() asm volatile("s_waitcnt lgkmcnt(0)" ::: "memory")
#define VM_WAIT() asm volatile("s_waitcnt vmcnt(0)" ::: "memory")

#define XB_TMO      128
#define XB_XCNT(j)  (256  + 64 * (j))
#define XB_XSUB(j)  (1280 + 64 * (j))
#define XB_XGEN(j)  (2304 + 64 * (j))
#define XB_TOP      3328
#define XB_TOPGEN   3392
#define XCD_BAR_WORDS 3456
#define XB_SPIN_CAP (1u << 18)
__device__ __forceinline__ unsigned xb_ld(unsigned* p)              { return __hip_atomic_load(p, __ATOMIC_RELAXED, __HIP_MEMORY_SCOPE_AGENT); }
__device__ __forceinline__ unsigned xb_add(unsigned* p, unsigned v) { return __hip_atomic_fetch_add(p, v, __ATOMIC_RELAXED, __HIP_MEMORY_SCOPE_AGENT); }
__device__ __forceinline__ unsigned xb_xcc_id() { return (unsigned)__builtin_amdgcn_s_getreg((3 << 11) | 20) & 0xFu; }
#define XB_SPIN(cond, bar) do { unsigned _sp = 0; while (cond) { __builtin_amdgcn_s_sleep(1); \
    if ((++_sp & 255u) == 0u) { if (xb_ld(&(bar)[XB_TMO])) break; if (_sp > XB_SPIN_CAP) { atomicAdd(&(bar)[XB_TMO], 1u); break; } } } } while (0)
struct XcdBarrier { unsigned* bar; unsigned x; volatile LAS unsigned* st; };
__device__ __forceinline__ XcdBarrier xcd_barrier_post(unsigned* bar, volatile LAS unsigned* st) {
    XcdBarrier b; b.bar = bar; b.x = xb_xcc_id(); b.st = st;
    if (threadIdx.x == 0) (void)xb_add(&bar[XB_XCNT(b.x)], 1u);
    return b;
}
__device__ __forceinline__ void xcd_barrier_complete(unsigned* bar, unsigned x, unsigned& nloc, unsigned& nx) {
    const unsigned G = gridDim.x * gridDim.y * gridDim.z;
    unsigned sum, cnt, mine, sp = 0u;
    for (;;) {
        sum = 0u; cnt = 0u; mine = 0u;
#pragma unroll
        for (unsigned j = 0; j < 16; ++j) { const unsigned c = xb_ld(&bar[XB_XCNT(j)]); sum += c; cnt += (c > 0u) ? 1u : 0u; mine = (j == x) ? c : mine; }
        if (sum == G) break;
        __builtin_amdgcn_s_sleep(1);
        if ((++sp & 255u) == 0u) { if (xb_ld(&bar[XB_TMO])) break; if (sp > XB_SPIN_CAP) { atomicAdd(&bar[XB_TMO], 1u); break; } }
    }
    nloc = mine > 0u ? mine : 1u; nx = cnt > 0u ? cnt : 1u;
}
__device__ __forceinline__ void xcd_barrier(const XcdBarrier& b) {
    asm volatile("s_waitcnt vmcnt(0)" ::: "memory");
    __syncthreads();
    if (threadIdx.x == 0) {
        unsigned* bar = b.bar;
        __builtin_amdgcn_s_waitcnt(0);
        unsigned nloc = b.st[0], nx = b.st[1];
        if (nloc == 0u) { xcd_barrier_complete(bar, b.x, nloc, nx); b.st[0] = nloc; b.st[1] = nx; }
        const unsigned old = xb_add(&bar[XB_XSUB(b.x)], 1u);
        const unsigned gen = old / nloc;
        if (old + 1u == (gen + 1u) * nloc) {
            __builtin_amdgcn_fence(__ATOMIC_RELEASE, "agent");
            asm volatile("s_waitcnt vmcnt(0)" ::: "memory");
            const unsigned og = xb_add(&bar[XB_TOP], 1u);
            const unsigned tg = og / nx;
            if (og + 1u == (tg + 1u) * nx) xb_add(&bar[XB_TOPGEN], 1u);
            else XB_SPIN(xb_ld(&bar[XB_TOPGEN]) == tg, bar);
            __builtin_amdgcn_fence(__ATOMIC_ACQUIRE, "agent");
            xb_add(&bar[XB_XGEN(b.x)], 1u);
            asm volatile("s_waitcnt vmcnt(0)" ::: "memory");
        } else {
            XB_SPIN(xb_ld(&bar[XB_XGEN(b.x)]) == gen, bar);
            __builtin_amdgcn_fence(__ATOMIC_ACQUIRE, "agent");
            asm volatile("s_waitcnt vmcnt(0)" ::: "memory");
        }
    }
    __syncthreads();
}

namespace pg8 {
constexpr int BM = 256, BK = 64, HALF = 128, HTB = HALF * BK * 2, STAGE_BYTES = 8 * HTB, NXCD = 8, WGM = 8;
__host__ __device__ __forceinline__ int lds_byte(int r, int c) { const int st = (r >> 4) * 2 + (c >> 5), rr = r & 15, cc = c & 31, ob = rr * 64 + cc * 2; return st * 1024 + (ob ^ (((ob >> 9) & 1) << 5)); }
__host__ __device__ __forceinline__ int perm32(int rho) { const int n = rho >> 4, i = rho & 15; return 8 * (i >> 2) + 4 * n + (i & 3); }
__host__ __device__ __forceinline__ void stage_rc(int b, int& R, int& C) { const int st = b / 1024, sb = b % 1024, swz = sb ^ (((sb >> 9) & 1) << 5); R = (st >> 1) * 16 + swz / 64; C = (st & 1) * 32 + (swz % 64) / 2; }
struct Unit { int pm, pn; };
struct Gemm { const bf16_t* A; const bf16_t* Bt; int M, N, K, lda, apn; };
struct StaticOrder {
    int nM, nN, nwg, G, c;
    __device__ __forceinline__ void init(int M, int N, int G_, int c_) { nM = M / BM; nN = N / BM; nwg = nM * nN; G = G_; c = c_; }
    __device__ __forceinline__ bool next(int i, Unit& u) const {
        const long L = (long)i * G + c; if (L >= nwg) return false;
        int wgid = (int)L; { const int q = nwg / NXCD, r = nwg % NXCD, xcd = wgid % NXCD, off = wgid / NXCD; wgid = (xcd < r ? xcd * (q + 1) : r * (q + 1) + (xcd - r) * q) + off; }
        const int nig = WGM * nN, gid = wgid / nig, fm = gid * WGM, gsz = (nM - fm) < WGM ? (nM - fm) : WGM;
        u.pm = fm + ((wgid % nig) % gsz); u.pn = (wgid % nig) / gsz; return true;
    }
};
template <class Epi>
__device__ __forceinline__ void gemm_phase(LAS unsigned char* lds, const Gemm g, const StaticOrder& S, const Epi& E) {
    const int tid = threadIdx.x, wid = __builtin_amdgcn_readfirstlane(tid >> 6), lane = tid & 63, wr = wid >> 2, wc = wid & 3, fr = lane & 15, fq = lane >> 4;
    const int K = g.K, nt = K / BK, lda = g.lda;
    unsigned voffA[2], voffB[2];
#pragma unroll
    for (int i = 0; i < 2; ++i) { int R, C; stage_rc(tid * 16 + i * 8192, R, C);
        const int Rb = Epi::PERM ? ((R & ~31) + perm32(R & 31)) : R;
        voffA[i] = (unsigned)(R * lda + C) * 2u; voffB[i] = (unsigned)(Rb * K + C) * 2u; }
    const size_t kstep = (size_t)(BK * 2);
    const size_t hstepA = (size_t)HALF * lda * 2, hstepB = (size_t)HALF * K * 2;
    const size_t tstepA = 2 * hstepA, tstepB = 2 * hstepB, pnA = (size_t)g.apn * 2;
    const unsigned ldsw = (unsigned)wid * 1024u;
    const int aoff = lds_byte(wr * 64 + fr, fq * 8), boff = lds_byte(wc * 32 + fr, fq * 8);
#define PG8_SA(b, h) (((b) * 2 + (h)) * HTB)
#define PG8_SB(b, h) ((4 + (b) * 2 + (h)) * HTB)
#define PG8_STAGE(bufoff, gbase, voff) do { _Pragma("unroll") for (int _i = 0; _i < 2; ++_i) \
        __builtin_amdgcn_global_load_lds((const unsigned*)((const char*)(gbase) + (voff)[_i]), (LAS unsigned*)(lds + (bufoff) + ldsw + _i * 8192), 16, 0, 0); } while (0)
#define PG8_LDA(dst, b, h) do { _Pragma("unroll") for (int m = 0; m < 4; ++m) _Pragma("unroll") for (int k = 0; k < 2; ++k) dst[m][k] = *(const LAS bf16x8*)(lds + PG8_SA(b, h) + aoff + m * 2048 + k * 1024); } while (0)
#define PG8_LDB(dst, b, h) do { _Pragma("unroll") for (int n = 0; n < 2; ++n) _Pragma("unroll") for (int k = 0; k < 2; ++k) dst[n][k] = *(const LAS bf16x8*)(lds + PG8_SB(b, h) + boff + n * 2048 + k * 1024); } while (0)
#define PG8_MMA(ai, bj, At, Bt) do { __builtin_amdgcn_s_setprio(1); _Pragma("unroll") for (int m = 0; m < 4; ++m) _Pragma("unroll") for (int n = 0; n < 2; ++n) _Pragma("unroll") for (int k = 0; k < 2; ++k) \
        acc[ai][bj][m][n] = __builtin_amdgcn_mfma_f32_16x16x32_bf16(Bt[n][k], At[m][k], acc[ai][bj][m][n], 0, 0, 0); __builtin_amdgcn_s_setprio(0); } while (0)
#define PG8_WAIT_V(n) asm volatile("s_waitcnt vmcnt(" #n ")" ::: "memory")
#define PG8_WAIT_L(n) asm volatile("s_waitcnt lgkmcnt(" #n ")" ::: "memory")
#define PG8_BAR __builtin_amdgcn_s_barrier()
#define PG8_SCHED __builtin_amdgcn_sched_barrier(0)
    Unit cur, nxt; int ui = 0;
    if (!S.next(0, cur)) return;
    f32x4 acc[2][2][4][2];
#pragma unroll
    for (int a = 0; a < 2; ++a)
#pragma unroll
        for (int b = 0; b < 2; ++b)
#pragma unroll
            for (int m = 0; m < 4; ++m)
#pragma unroll
                for (int n = 0; n < 2; ++n) acc[a][b][m][n] = (f32x4){0.f, 0.f, 0.f, 0.f};
    bf16x8 At[4][2], B0[2][2], B1[2][2];
    const char* cA = (const char*)g.A + (size_t)cur.pm * tstepA + (size_t)cur.pn * pnA; const char* cB = (const char*)g.Bt + (size_t)cur.pn * tstepB;
    PG8_STAGE(PG8_SB(0, 0), cB, voffB); PG8_STAGE(PG8_SB(0, 1), cB + hstepB, voffB); PG8_STAGE(PG8_SA(0, 0), cA, voffA); PG8_STAGE(PG8_SA(0, 1), cA + hstepA, voffA);
    if (wr == 1) PG8_BAR;
    PG8_WAIT_V(2); PG8_BAR;
    PG8_STAGE(PG8_SB(1, 0), cB + kstep, voffB); PG8_STAGE(PG8_SA(1, 0), cA + kstep, voffA); PG8_STAGE(PG8_SB(1, 1), cB + hstepB + kstep, voffB);
    PG8_WAIT_V(6); PG8_BAR;
    for (;;) {
        const bool has_next = S.next(ui + 1, nxt);
        const char* nA = has_next ? (const char*)g.A + (size_t)nxt.pm * tstepA + (size_t)nxt.pn * pnA : cA; const char* nB = has_next ? (const char*)g.Bt + (size_t)nxt.pn * tstepB : cB;
#pragma unroll 1
        for (int t = 0; t < nt; t += 2) {
            const bool last = (t == nt - 2);
            const char* a1 = cA + (size_t)(t + 1) * kstep;
            const char* a2 = last ? nA : cA + (size_t)(t + 2) * kstep; const char* b2 = last ? nB : cB + (size_t)(t + 2) * kstep;
            const char* a3 = a2 + kstep; const char* b3 = b2 + kstep;
            PG8_LDB(B0, 0, 0); PG8_LDB(B1, 0, 1); PG8_SCHED; PG8_LDA(At, 0, 0); PG8_STAGE(PG8_SA(1, 1), a1 + hstepA, voffA);
            PG8_WAIT_V(8); PG8_WAIT_L(0); PG8_BAR; PG8_MMA(0, 0, At, B0); PG8_MMA(0, 1, At, B1); PG8_BAR; PG8_SCHED;
            PG8_LDA(At, 0, 1); PG8_STAGE(PG8_SB(0, 0), b2, voffB); PG8_STAGE(PG8_SB(0, 1), b2 + hstepB, voffB); PG8_STAGE(PG8_SA(0, 0), a2, voffA);
            PG8_WAIT_V(8); PG8_WAIT_L(0); PG8_BAR; PG8_MMA(1, 0, At, B0); PG8_MMA(1, 1, At, B1); PG8_BAR; PG8_SCHED;
            PG8_LDB(B0, 1, 0); PG8_LDB(B1, 1, 1); PG8_SCHED; PG8_LDA(At, 1, 0); PG8_STAGE(PG8_SA(0, 1), a2 + hstepA, voffA);
            PG8_WAIT_V(8); PG8_WAIT_L(0); PG8_BAR; PG8_MMA(0, 0, At, B0); PG8_MMA(0, 1, At, B1); PG8_BAR; PG8_SCHED;
            PG8_LDA(At, 1, 1); PG8_STAGE(PG8_SB(1, 0), b3, voffB); PG8_STAGE(PG8_SB(1, 1), b3 + hstepB, voffB); PG8_STAGE(PG8_SA(1, 0), a3, voffA);
            PG8_WAIT_V(8); PG8_WAIT_L(0); PG8_BAR; PG8_MMA(1, 0, At, B0); PG8_MMA(1, 1, At, B1); PG8_BAR; PG8_SCHED;
        }
        if (wr == 0) PG8_BAR;
        E(acc, cur, wr, wc, fr, fq);
        if (!has_next) break;
#pragma unroll
        for (int a = 0; a < 2; ++a)
#pragma unroll
            for (int b = 0; b < 2; ++b)
#pragma unroll
                for (int m = 0; m < 4; ++m)
#pragma unroll
                    for (int n = 0; n < 2; ++n) acc[a][b][m][n] = (f32x4){0.f, 0.f, 0.f, 0.f};
        cur = nxt; cA = nA; cB = nB; ++ui;
        if (wr == 1) PG8_BAR;
    }
    PG8_WAIT_V(0);
    PG8_BAR;
#undef PG8_SA
#undef PG8_SB
#undef PG8_STAGE
#undef PG8_LDA
#undef PG8_LDB
#undef PG8_MMA
#undef PG8_WAIT_V
#undef PG8_WAIT_L
#undef PG8_BAR
#undef PG8_SCHED
}
}

struct Params { const float* in[27]; float* out; unsigned char* ws; int ph_lo, ph_hi; };
enum { I_XP = 0, I_XS, I_PP, I_PS, I_SPOOL, I_CLAT, I_CKR, I_PT, I_NMIX, I_NMLP, I_NPLE, I_POOLW, I_POOLSC, I_NKV, I_WDKV, I_KVN, I_WUK, I_WUV, I_WDQ, I_QN, I_WUQ, I_WO, I_WUP, I_WDOWN, I_WGATE, I_WPROJ, I_NFIN };

__device__ __forceinline__ void load_rstd(const float* ssq, const pg8::Unit& u, int wr, int fr, int fq, float (&rs)[2][4]) {
#pragma unroll
    for (int ai = 0; ai < 2; ++ai)
#pragma unroll
        for (int m = 0; m < 4; ++m) {
            const int row = u.pm * 256 + ai * 128 + wr * 64 + m * 16 + fr;
            const f32x4 a = ((const f32x4*)(ssq + (size_t)row * 16))[fq];
            float t = (a.x + a.y) + (a.z + a.w);
            t += __shfl_xor(t, 16); t += __shfl_xor(t, 32);
            rs[ai][m] = 1.0f / sqrtf(t * (1.0f / 1024.0f) + EPS);
        }
}
template <int NS> __device__ __forceinline__ void load_rstd_p(const float* ssqp, float inv_n, const pg8::Unit& u, int wr, int fr, int fq, float (&rs)[2][4]) {
#pragma unroll
    for (int ai = 0; ai < 2; ++ai)
#pragma unroll
        for (int m = 0; m < 4; ++m) {
            const int row = u.pm * 256 + ai * 128 + wr * 64 + m * 16 + fr;
            float t;
            if (NS == 4) t = ssqp[(size_t)row * 4 + fq]; else { const f32x2 a = ((const f32x2*)(ssqp + (size_t)row * 8))[fq]; t = a.x + a.y; }
            t += __shfl_xor(t, 16); t += __shfl_xor(t, 32);
            rs[ai][m] = 1.0f / sqrtf(t * inv_n + EPS);
        }
}
template <int MODE> struct EpiH {
    static constexpr bool PERM = true;
    const float* xp; const float* xs; const float* scale; const float* ssq_in; const bf16_t* proj;
    const bf16_t* hb_in; bf16_t* hb; float* ssq_out;
    __device__ __forceinline__ void operator()(const f32x4 (&acc)[2][2][4][2], const pg8::Unit& u, int wr, int wc, int fr_in, int fq_in) const {
        int fr = fr_in, fq = fq_in; asm volatile("" : "+v"(fr), "+v"(fq));
        float rs[2][4];
        if (MODE == 2) load_rstd(ssq_in, u, wr, fr, fq, rs);
        const int col0 = u.pn * 256 + wc * 32 + 8 * fq;
#pragma unroll
        for (int ai = 0; ai < 2; ++ai)
#pragma unroll
            for (int m = 0; m < 4; ++m) {
                const int row = u.pm * 256 + ai * 128 + wr * 64 + m * 16 + fr;
                float sq = 0.f;
#pragma unroll
                for (int bj = 0; bj < 2; ++bj) {
                    const int col = col0 + bj * 128;
                    f32x4 b0, b1;
                    if (MODE == 0) { const float* xr = (row < MP ? xp + (size_t)row * D : xs + (size_t)(row - MP) * D) + col; b0 = *(const f32x4*)xr; b1 = *(const f32x4*)(xr + 4); }
                    else { const u32x4 hv = *(const u32x4*)(hb_in + (size_t)row * D + col); b0 = unpk4((u32x2){hv.x, hv.y}); b1 = unpk4((u32x2){hv.z, hv.w}); }
                    const f32x4 a0 = acc[ai][bj][m][0], a1 = acc[ai][bj][m][1]; f32x4 o0, o1;
                    if (MODE == 0) { o0 = b0 + *(const f32x4*)(scale + col) * a0; o1 = b1 + *(const f32x4*)(scale + col + 4) * a1; }
                    else if (MODE == 1) { o0 = b0 + a0; o1 = b1 + a1; }
                    else { const u32x4 pv = *(const u32x4*)(proj + (size_t)row * D + col); const f32x4 p0 = unpk4((u32x2){pv.x, pv.y}), p1 = unpk4((u32x2){pv.z, pv.w}); const float r = rs[ai][m];
                        f32x4 g0, g1;
                        g0.x = 1.0f / (1.0f + __expf(-r * a0.x)); g0.y = 1.0f / (1.0f + __expf(-r * a0.y)); g0.z = 1.0f / (1.0f + __expf(-r * a0.z)); g0.w = 1.0f / (1.0f + __expf(-r * a0.w));
                        g1.x = 1.0f / (1.0f + __expf(-r * a1.x)); g1.y = 1.0f / (1.0f + __expf(-r * a1.y)); g1.z = 1.0f / (1.0f + __expf(-r * a1.z)); g1.w = 1.0f / (1.0f + __expf(-r * a1.w));
                        o0 = b0 + g0 * p0; o1 = b1 + g1 * p1; }
                    u32x4 w; w.x = pk2(o0.x, o0.y); w.y = pk2(o0.z, o0.w); w.z = pk2(o1.x, o1.y); w.w = pk2(o1.z, o1.w);
                    *(u32x4*)(hb + (size_t)row * D + col) = w;
                    sq += ((o0.x * o0.x + o0.y * o0.y) + (o0.z * o0.z + o0.w * o0.w)) + ((o1.x * o1.x + o1.y * o1.y) + (o1.z * o1.z + o1.w * o1.w));
                }
                sq += __shfl_xor(sq, 16); sq += __shfl_xor(sq, 32);
                if (fq == 0) ssq_out[(size_t)row * 16 + u.pn * 4 + wc] = sq;
                asm volatile("" ::: "memory");
            }
    }
};
struct EpiUp {
    static constexpr bool PERM = true;
    const float* ssq_in; bf16_t* abuf;
    __device__ __forceinline__ void operator()(const f32x4 (&acc)[2][2][4][2], const pg8::Unit& u, int wr, int wc, int fr_in, int fq_in) const {
        int fr = fr_in, fq = fq_in; asm volatile("" : "+v"(fr), "+v"(fq));
        float rs[2][4]; load_rstd(ssq_in, u, wr, fr, fq, rs);
        const int col0 = u.pn * 256 + wc * 32 + 8 * fq;
#pragma unroll
        for (int ai = 0; ai < 2; ++ai)
#pragma unroll
            for (int m = 0; m < 4; ++m) {
                const int row = u.pm * 256 + ai * 128 + wr * 64 + m * 16 + fr; const float r = rs[ai][m];
#pragma unroll
                for (int bj = 0; bj < 2; ++bj) {
                    f32x4 a = acc[ai][bj][m][0] * r, c = acc[ai][bj][m][1] * r;
                    a.x = fmaxf(a.x, 0.f); a.y = fmaxf(a.y, 0.f); a.z = fmaxf(a.z, 0.f); a.w = fmaxf(a.w, 0.f);
                    c.x = fmaxf(c.x, 0.f); c.y = fmaxf(c.y, 0.f); c.z = fmaxf(c.z, 0.f); c.w = fmaxf(c.w, 0.f);
                    u32x4 w; w.x = pk2(a.x * a.x, a.y * a.y); w.y = pk2(a.z * a.z, a.w * a.w); w.z = pk2(c.x * c.x, c.y * c.y); w.w = pk2(c.z * c.z, c.w * c.w);
                    *(u32x4*)(abuf + (size_t)row * FF + col0 + bj * 128) = w;
                }
            }
    }
};
template <int MODE> struct EpiF32 {
    static constexpr bool PERM = false;
    float* C; int ldc; const float* aux;
    __device__ __forceinline__ void operator()(const f32x4 (&acc)[2][2][4][2], const pg8::Unit& u, int wr, int wc, int fr_in, int fq_in) const {
        int fr = fr_in, fq = fq_in; asm volatile("" : "+v"(fr), "+v"(fq));
        float rs[2][4];
        if (MODE == 1) load_rstd(aux, u, wr, fr, fq, rs);
        const int col0 = u.pn * 256 + wc * 32 + 4 * fq;
#pragma unroll
        for (int ai = 0; ai < 2; ++ai)
#pragma unroll
            for (int m = 0; m < 4; ++m) {
                const int row = u.pm * 256 + ai * 128 + wr * 64 + m * 16 + fr;
                const float r = (MODE == 1) ? rs[ai][m] : (MODE == 2 ? aux[row] : 1.0f);
#pragma unroll
                for (int bj = 0; bj < 2; ++bj)
#pragma unroll
                    for (int n = 0; n < 2; ++n) *(f32x4*)(C + (size_t)row * ldc + col0 + bj * 128 + n * 16) = acc[ai][bj][m][n] * r;
            }
    }
};
struct EpiBf {
    static constexpr bool PERM = true;
    bf16_t* C; int ldc;
    __device__ __forceinline__ void operator()(const f32x4 (&acc)[2][2][4][2], const pg8::Unit& u, int wr, int wc, int fr_in, int fq_in) const {
        int fr = fr_in, fq = fq_in; asm volatile("" : "+v"(fr), "+v"(fq));
        const int col0 = u.pn * 256 + wc * 32 + 8 * fq;
#pragma unroll
        for (int ai = 0; ai < 2; ++ai)
#pragma unroll
            for (int m = 0; m < 4; ++m) {
                const int row = u.pm * 256 + ai * 128 + wr * 64 + m * 16 + fr;
#pragma unroll
                for (int bj = 0; bj < 2; ++bj) { const f32x4 a = acc[ai][bj][m][0], c = acc[ai][bj][m][1]; u32x4 w; w.x = pk2(a.x, a.y); w.y = pk2(a.z, a.w); w.z = pk2(c.x, c.y); w.w = pk2(c.z, c.w);
                    *(u32x4*)(C + (size_t)row * ldc + col0 + bj * 128) = w; }
            }
    }
};
__host__ __device__ __forceinline__ int kperm(int c) { if (c < KVR) return c; const int r = c - KVR, i = r & 31, sec = r >> 5; return KVR + 32 * (i >> 4) + 16 * sec + (i & 15); }
__host__ __device__ __forceinline__ int qperm(int c) { const int e = c % QH; if (e < NOPE) return c; const int r = e - NOPE, i = r & 31, sec = r >> 5; return c - e + NOPE + 32 * (i >> 4) + 16 * sec + (i & 15); }
struct EpiQ {
    static constexpr bool PERM = false;
    const float* ssqq_; const float* cs; bf16_t* qbuf; bf16_t* qs;
    __device__ __forceinline__ void operator()(const f32x4 (&acc)[2][2][4][2], const pg8::Unit& u, int wr, int wc, int fr_in, int fq_in) const {
        int fr = fr_in, fq = fq_in; asm volatile("" : "+v"(fr), "+v"(fq));
        const bool smp = u.pm >= MP / 256;
        float rq[2][4]; load_rstd_p<8>(ssqq_, 1.0f / QR, u, wr, fr, fq, rq);
#pragma unroll
        for (int ai = 0; ai < 2; ++ai)
#pragma unroll
            for (int m = 0; m < 4; ++m) {
                const int row = u.pm * 256 + ai * 128 + wr * 64 + m * 16 + fr; const float r = rq[ai][m]; const int pos = smp ? PAST + ((row - MP) & 7) : (row & (SEQ - 1));
                bf16_t* qrow = qbuf + (size_t)row * (NH * QH);
#pragma unroll
                for (int bj = 0; bj < 2; ++bj) {
                    const int Gi = u.pn * 8 + bj * 4 + wc, hh = Gi / 6, gi = Gi - hh * 6;
                    if (gi < 4) {
#pragma unroll
                        for (int n = 0; n < 2; ++n) { const f32x4 a = acc[ai][bj][m][n] * r; u32x2 w; w.x = pk2(a.x, a.y); w.y = pk2(a.z, a.w);
                            *(u32x2*)(qrow + Gi * 32 + n * 16 + 4 * fq) = w; }
                    } else {
                        const int i0 = 16 * (gi - 4) + 4 * fq;
                        const f32x4 x1 = acc[ai][bj][m][0] * r, x2 = acc[ai][bj][m][1] * r;
                        const f32x4 cn = *(const f32x4*)(cs + (size_t)pos * 64 + i0), sn = *(const f32x4*)(cs + (size_t)pos * 64 + 32 + i0);
                        const f32x4 o1 = x1 * cn - x2 * sn, o2 = x2 * cn + x1 * sn;
                        u32x2 w1, w2; w1.x = pk2(o1.x, o1.y); w1.y = pk2(o1.z, o1.w); w2.x = pk2(o2.x, o2.y); w2.y = pk2(o2.z, o2.w);
                        bf16_t* qd = smp ? qs + ((size_t)(row - MP) * NH + hh) * 320 + KVR : qrow + hh * QH + NOPE;
                        *(u32x2*)(qd + i0) = w1; *(u32x2*)(qd + 32 + i0) = w2;
                    }
                }
                asm volatile("" ::: "memory");
            }
    }
};
struct EpiDkvq {
    static constexpr bool PERM = false;
    const float* ssq_in; const float* cs; float* craw_; bf16_t* cb_; bf16_t* cqb_; float* ssqc_; float* ssqq_; float* out; bf16_t* kfull_; bf16_t* krbs_;
    __device__ __forceinline__ void operator()(const f32x4 (&acc)[2][2][4][2], const pg8::Unit& u, int wr, int wc, int fr_in, int fq_in) const {
        int fr = fr_in, fq = fq_in; asm volatile("" : "+v"(fr), "+v"(fq));
        float rs[2][4]; load_rstd(ssq_in, u, wr, fr, fq, rs);
        const bool smp = u.pm >= MP / 256;
#pragma unroll
        for (int ai = 0; ai < 2; ++ai)
#pragma unroll
            for (int m = 0; m < 4; ++m) {
                const int row = u.pm * 256 + ai * 128 + wr * 64 + m * 16 + fr; const float r = rs[ai][m];
                float sq = 0.f;
                if (u.pn == 0) {
#pragma unroll
                    for (int bj = 0; bj < 2; ++bj)
#pragma unroll
                        for (int n = 0; n < 2; ++n) { const int col = bj * 128 + wc * 32 + n * 16 + 4 * fq; const f32x4 v = acc[ai][bj][m][n] * r;
                            *(f32x4*)(craw_ + (size_t)row * KVR + col) = v; u32x2 w; w.x = pk2(v.x, v.y); w.y = pk2(v.z, v.w); *(u32x2*)(cb_ + (size_t)row * KVR + col) = w;
                            sq += (v.x * v.x + v.y * v.y) + (v.z * v.z + v.w * v.w); }
                    sq += __shfl_xor(sq, 16); sq += __shfl_xor(sq, 32);
                    if (fq == 0) ssqc_[(size_t)row * 4 + wc] = sq;
                } else {
#pragma unroll
                    for (int bj = 0; bj < 2; ++bj) {
                        const int g0 = (u.pn - 1) * 256 + bj * 128 + wc * 32;
                        if (g0 < ROPE) {
                            const int i0 = 16 * (g0 >> 5) + 4 * fq, pos = smp ? PAST + ((row - MP) & 7) : (row & (SEQ - 1));
                            const f32x4 x1 = acc[ai][bj][m][0] * r, x2 = acc[ai][bj][m][1] * r;
                            const f32x4 cn = *(const f32x4*)(cs + (size_t)pos * 64 + i0), sn = *(const f32x4*)(cs + (size_t)pos * 64 + 32 + i0);
                            const f32x4 o1 = x1 * cn - x2 * sn, o2 = x2 * cn + x1 * sn;
                            float* ko = smp ? out + O_KS + (size_t)(row - MP) * ROPE : out + O_KP + (size_t)row * ROPE;
                            *(f32x4*)(ko + i0) = o1; *(f32x4*)(ko + 32 + i0) = o2;
                            u32x2 w1, w2; w1.x = pk2(o1.x, o1.y); w1.y = pk2(o1.z, o1.w); w2.x = pk2(o2.x, o2.y); w2.y = pk2(o2.z, o2.w);
                            if (smp) { bf16_t* kd = krbs_ + (size_t)(row - MP) * ROPE; *(u32x2*)(kd + i0) = w1; *(u32x2*)(kd + 32 + i0) = w2; }
                            else { const int b = row >> 13, t = row & (SEQ - 1);
#pragma unroll
                                for (int h = 0; h < NH; ++h) { bf16_t* kd = kfull_ + ((size_t)(b * NH + h) * SEQ + t) * QH + NOPE; *(u32x2*)(kd + i0) = w1; *(u32x2*)(kd + 32 + i0) = w2; } }
                        } else if (g0 < ROPE + QR) {
#pragma unroll
                            for (int n = 0; n < 2; ++n) { const int qi = g0 - ROPE + n * 16 + 4 * fq; const f32x4 v = acc[ai][bj][m][n] * r;
                                u32x2 w; w.x = pk2(v.x, v.y); w.y = pk2(v.z, v.w); *(u32x2*)(cqb_ + (size_t)row * QR + qi) = w;
                                sq += (v.x * v.x + v.y * v.y) + (v.z * v.z + v.w * v.w); }
                        }
                    }
                    sq += __shfl_xor(sq, 16); sq += __shfl_xor(sq, 32);
                    if (fq == 0) ssqq_[(size_t)row * 8 + (u.pn - 1) * 4 + wc] = sq;
                }
                asm volatile("" ::: "memory");
            }
    }
};
struct EpiKup {
    static constexpr bool PERM = true;
    bf16_t* kfull; const float* ssqc_;
    __device__ __forceinline__ void operator()(const f32x4 (&acc)[2][2][4][2], const pg8::Unit& u, int wr, int wc, int fr_in, int fq_in) const {
        int fr = fr_in, fq = fq_in; asm volatile("" : "+v"(fr), "+v"(fq));
        const int col0 = u.pn * 256 + wc * 32 + 8 * fq;
        float rc[2][4]; load_rstd_p<4>(ssqc_, 1.0f / KVR, u, wr, fr, fq, rc);
#pragma unroll
        for (int ai = 0; ai < 2; ++ai)
#pragma unroll
            for (int m = 0; m < 4; ++m) {
                const int row = u.pm * 256 + ai * 128 + wr * 64 + m * 16 + fr; const int b = row >> 13, t = row & (SEQ - 1); const float r = rc[ai][m];
#pragma unroll
                for (int bj = 0; bj < 2; ++bj) { const int col = col0 + bj * 128; const int h = col >> 7, nn = col & 127; const f32x4 a = acc[ai][bj][m][0] * r, c = acc[ai][bj][m][1] * r;
                    u32x4 w; w.x = pk2(a.x, a.y); w.y = pk2(a.z, a.w); w.z = pk2(c.x, c.y); w.w = pk2(c.z, c.w);
                    *(u32x4*)(kfull + ((size_t)(b * NH + h) * SEQ + t) * QH + nn) = w; }
                asm volatile("" ::: "memory");
            }
    }
};
struct EpiVup {
    static constexpr bool PERM = true;
    bf16_t* vt; const float* ssqc_;
    __device__ __forceinline__ void operator()(const f32x4 (&acc)[2][2][4][2], const pg8::Unit& u, int wr, int wc, int fr_in, int fq_in) const {
        int fr = fr_in, fq = fq_in; asm volatile("" : "+v"(fr), "+v"(fq));
        const int col0 = u.pn * 256 + wc * 32 + 8 * fq;
        f32x4 rt[2][2];
#pragma unroll
        for (int bj = 0; bj < 2; ++bj)
#pragma unroll
            for (int k = 0; k < 8; ++k) { const f32x4 p4 = *(const f32x4*)(ssqc_ + (size_t)(col0 + bj * 128 + k) * 4); rt[bj][k >> 2][k & 3] = 1.0f / sqrtf(((p4.x + p4.y) + (p4.z + p4.w)) * (1.0f / KVR) + EPS); }
#pragma unroll
        for (int ai = 0; ai < 2; ++ai)
#pragma unroll
            for (int m = 0; m < 4; ++m) {
                const int row = u.pm * 256 + ai * 128 + wr * 64 + m * 16 + fr; const int h = row >> 7, v = row & 127;
#pragma unroll
                for (int bj = 0; bj < 2; ++bj) { const int col = col0 + bj * 128; const int b = col >> 13, t = col & (SEQ - 1); const f32x4 a = acc[ai][bj][m][0] * rt[bj][0], c = acc[ai][bj][m][1] * rt[bj][1];
                    u32x4 w; w.x = pk2(a.x, a.y); w.y = pk2(a.z, a.w); w.z = pk2(c.x, c.y); w.w = pk2(c.z, c.w);
                    *(u32x4*)(vt + ((size_t)(b * NH + h) * VD + v) * SEQ + t) = w; }
                asm volatile("" ::: "memory");
            }
    }
};

struct SgALoadBf { const bf16_t* A; int lda;
    __device__ __forceinline__ bf16x8 operator()(int row, int k) const { return *(const bf16x8*)(A + (size_t)row * lda + k); } };
struct SgALoadComb { const float* parto; const float* ml;
    __device__ __forceinline__ bf16x8 operator()(int row, int k) const {
        const int b = row >> 3, tok = row & 7, h = k >> 7, v = k & 127, q = tok * 8 + h;
        const float* m0p = ml + ((size_t)(b * 2 + 0) * 64 + q) * 2; const float* m1p = ml + ((size_t)(b * 2 + 1) * 64 + q) * 2;
        const float m0 = m0p[0], l0 = m0p[1], m1 = m1p[0], l1 = m1p[1], mx = fmaxf(m0, m1);
        float w0 = __builtin_amdgcn_exp2f(m0 - mx), w1 = __builtin_amdgcn_exp2f(m1 - mx); const float inv = 1.0f / (w0 * l0 + w1 * l1); w0 *= inv; w1 *= inv;
        const float* p0 = parto + ((size_t)(b * 2 + 0) * 64 + q) * 128 + v; const float* p1 = parto + ((size_t)(b * 2 + 1) * 64 + q) * 128 + v;
        return pack8v(*(const f32x4*)p0 * w0 + *(const f32x4*)p1 * w1, *(const f32x4*)(p0 + 4) * w0 + *(const f32x4*)(p1 + 4) * w1); } };
template <int NCT, int NCG, class Epi, class ALoad>
__device__ __forceinline__ void sg_gemm_l(LAS unsigned char* lds, const ALoad& AL, int apn256, const bf16_t* __restrict__ Bt, int K, int unit, const Epi& E, int tid, int wave, int lane) {
    constexpr int KS = 8 / NCG, W = NCG * NCT * 16, G4 = W / 4;
    static_assert(KS * 64 * W * 4 <= RING_BYTES, "sg_gemm reduction buffer");
    const int mt = unit >> 4, ntile = unit & 15, m0 = mt * 64, n0 = ntile * W;
    const int cg = wave % NCG, kp = wave / NCG, fr = lane & 15, fq = lane >> 4;
    const int Kw = K / KS;
    const int arow = m0 + fr, acol = (n0 >> 8) * apn256 + kp * Kw + 8 * fq;
    const bf16_t* bp = Bt + (size_t)(n0 + cg * NCT * 16 + fr) * K + kp * Kw + 8 * fq;
    f32x4 acc[4][NCT];
#pragma unroll
    for (int m = 0; m < 4; ++m)
#pragma unroll
        for (int n = 0; n < NCT; ++n) acc[m][n] = (f32x4){0.f, 0.f, 0.f, 0.f};
#pragma unroll 4
    for (int kk = 0; kk < Kw; kk += 32) {
        bf16x8 af[4], bfr[NCT];
#pragma unroll
        for (int m = 0; m < 4; ++m) af[m] = AL(arow + 16 * m, acol + kk);
#pragma unroll
        for (int n = 0; n < NCT; ++n) bfr[n] = *(const bf16x8*)(bp + (size_t)(16 * n) * K + kk);
#pragma unroll
        for (int m = 0; m < 4; ++m)
#pragma unroll
            for (int n = 0; n < NCT; ++n) acc[m][n] = __builtin_amdgcn_mfma_f32_16x16x32_bf16(bfr[n], af[m], acc[m][n], 0, 0, 0);
    }
    LAS float* red = (LAS float*)lds;
#pragma unroll
    for (int m = 0; m < 4; ++m)
#pragma unroll
        for (int n = 0; n < NCT; ++n) { const int row = 16 * m + fr, c4 = (cg * NCT * 16 + 16 * n) / 4 + fq;
            *(LAS f32x4*)(red + (size_t)(kp * 64 + row) * W + 4 * (c4 ^ (row & 3))) = acc[m][n]; }
    __syncthreads();
    for (int it = tid; it < 64 * G4; it += 512) {
        const int row = it / G4, c4 = it % G4;
        f32x4 v = *(const LAS f32x4*)(red + (size_t)row * W + 4 * (c4 ^ (row & 3)));
#pragma unroll
        for (int p = 1; p < KS; ++p) v += *(const LAS f32x4*)(red + (size_t)(p * 64 + row) * W + 4 * (c4 ^ (row & 3)));
        if constexpr (Epi::WHOLE_TILE) *(LAS f32x4*)(red + (size_t)row * W + 4 * (c4 ^ (row & 3))) = v;
        else E(MP + m0 + row, n0 + 4 * c4, v, ntile);
    }
    if constexpr (Epi::WHOLE_TILE) {
        __syncthreads();
        for (int it = tid; it < 64 * G4; it += 512) { const int row = it / G4, c4 = it % G4; E.tile(MP + m0 + row, n0, c4, red + (size_t)row * W, row & 3); }
    }
    __syncthreads();
}
template <int NCT, int NCG, class Epi>
__device__ __forceinline__ void sg_gemm(LAS unsigned char* lds, const bf16_t* __restrict__ A, int lda, int apn256, const bf16_t* __restrict__ Bt, int K, int unit, const Epi& E, int tid, int wave, int lane) {
    const SgALoadBf AL{A, lda}; sg_gemm_l<NCT, NCG>(lds, AL, apn256, Bt, K, unit, E, tid, wave, lane);
}
constexpr int SK_STG = 32768;
template <class Epi>
__device__ __forceinline__ void sk_gemm(LAS unsigned char* lds, const bf16_t* __restrict__ A, int lda, const bf16_t* __restrict__ Bt, int K, int m0, int n0, int ntile, const Epi& E, int tid, int wave, int lane) {
    const int nk = K >> 7, fr = lane & 15, fq = lane >> 4, mi = wave >> 1, nh = wave & 1;
    unsigned goA[2], goB[2];
#pragma unroll
    for (int e = 0; e < 2; ++e) { const int r = 4 * (wave + 8 * e) + (lane >> 4), c = (lane & 15) ^ (r & 15); goA[e] = (unsigned)(r * lda + c * 8) * 2u; goB[e] = (unsigned)(r * K + c * 8) * 2u; }
    const unsigned ldsw = (unsigned)wave * 1024u;
#define SK_STAGE(kc) do { const unsigned so_ = (unsigned)((kc) & 3) * SK_STG + ldsw; const size_t ko_ = (size_t)(kc) * 256; \
        _Pragma("unroll") for (int e = 0; e < 2; ++e) { \
            __builtin_amdgcn_global_load_lds((const unsigned*)((const char*)A + ko_ + goA[e]), (LAS unsigned*)(lds + so_ + e * 8192), 16, 0, 0); \
            __builtin_amdgcn_global_load_lds((const unsigned*)((const char*)Bt + ko_ + goB[e]), (LAS unsigned*)(lds + so_ + 16384 + e * 8192), 16, 0, 0); } } while (0)
    int co[4];
#pragma unroll
    for (int ks = 0; ks < 4; ++ks) co[ks] = ((4 * ks + fq) ^ fr) << 4;
    const int aro = (16 * mi + fr) * 256, bro = 16384 + (32 * nh + fr) * 256;
    f32x4 acc[2] = {(f32x4){0.f, 0.f, 0.f, 0.f}, (f32x4){0.f, 0.f, 0.f, 0.f}};
    asm volatile("s_waitcnt vmcnt(0)" ::: "memory");
    SK_STAGE(0); if (nk > 1) SK_STAGE(1); if (nk > 2) SK_STAGE(2);
#pragma unroll 1
    for (int kc = 0; kc < nk; ++kc) {
        if (kc + 2 < nk) asm volatile("s_waitcnt vmcnt(8)" ::: "memory"); else if (kc + 1 < nk) asm volatile("s_waitcnt vmcnt(4)" ::: "memory"); else asm volatile("s_waitcnt vmcnt(0)" ::: "memory");
        asm volatile("s_waitcnt lgkmcnt(0)" ::: "memory"); __builtin_amdgcn_s_barrier(); asm volatile("" ::: "memory");
        if (kc + 3 < nk) SK_STAGE(kc + 3);
        const LAS unsigned char* sp = lds + (kc & 3) * SK_STG;
        bf16x8 af[4], b0[4], b1[4];
#pragma unroll
        for (int ks = 0; ks < 4; ++ks) { af[ks] = *(const LAS bf16x8*)(sp + aro + co[ks]); b0[ks] = *(const LAS bf16x8*)(sp + bro + co[ks]); b1[ks] = *(const LAS bf16x8*)(sp + bro + 4096 + co[ks]); }
#pragma unroll
        for (int ks = 0; ks < 4; ++ks) { acc[0] = __builtin_amdgcn_mfma_f32_16x16x32_bf16(b0[ks], af[ks], acc[0], 0, 0, 0); acc[1] = __builtin_amdgcn_mfma_f32_16x16x32_bf16(b1[ks], af[ks], acc[1], 0, 0, 0); }
    }
#undef SK_STAGE
    asm volatile("s_waitcnt lgkmcnt(0)" ::: "memory"); __builtin_amdgcn_s_barrier(); asm volatile("" ::: "memory");
    LAS float* red = (LAS float*)lds;
    { const int row = 16 * mi + fr;
#pragma unroll
      for (int n = 0; n < 2; ++n) { const int c4 = 4 * (2 * nh + n) + fq; *(LAS f32x4*)(red + row * 64 + 4 * (c4 ^ (row & 3))) = acc[n]; } }
    __syncthreads();
#pragma unroll
    for (int it = tid; it < 1024; it += 512) { const int row = it >> 4, c4 = it & 15; const f32x4 v = *(const LAS f32x4*)(red + row * 64 + 4 * (c4 ^ (row & 3))); E(MP + m0 + row, n0 + 4 * c4, v, ntile); }
    __syncthreads();
}
constexpr int SKW_STG = 40960;
template <class Epi>
__device__ __forceinline__ void sk_gemm_w(LAS unsigned char* lds, const bf16_t* __restrict__ A, int lda, const bf16_t* __restrict__ Bt, int K, int m0, int n0, const Epi& E, int tid, int wave, int lane) {
    const int nk = K >> 6, fr = lane & 15, fq = lane >> 4;
    unsigned goA, goB[4];
    { const int r = 8 * wave + (lane >> 3), c = (lane & 7) ^ (r & 7); goA = (unsigned)(r * lda + c * 8) * 2u;
#pragma unroll
      for (int e = 0; e < 4; ++e) goB[e] = (unsigned)((r + 64 * e) * K + c * 8) * 2u; }
    const unsigned ldsw = (unsigned)wave * 1024u;
#define SKW_STAGE(kc) do { const unsigned so_ = (unsigned)((kc) % 3) * SKW_STG + ldsw; const size_t ko_ = (size_t)(kc) * 128; \
        __builtin_amdgcn_global_load_lds((const unsigned*)((const char*)A + ko_ + goA), (LAS unsigned*)(lds + so_), 16, 0, 0); \
        _Pragma("unroll") for (int e = 0; e < 4; ++e) __builtin_amdgcn_global_load_lds((const unsigned*)((const char*)Bt + ko_ + goB[e]), (LAS unsigned*)(lds + so_ + 8192 + e * 8192), 16, 0, 0); } while (0)
    const int co0 = (fq ^ (fr & 7)) << 4, co1 = ((4 + fq) ^ (fr & 7)) << 4;
    const int aro = fr * 128, bro = 8192 + (32 * wave + fr) * 128;
    f32x4 acc[4][2];
#pragma unroll
    for (int m = 0; m < 4; ++m)
#pragma unroll
        for (int n = 0; n < 2; ++n) acc[m][n] = (f32x4){0.f, 0.f, 0.f, 0.f};
    asm volatile("s_waitcnt vmcnt(0)" ::: "memory");
    SKW_STAGE(0); if (nk > 1) SKW_STAGE(1);
#pragma unroll 1
    for (int kc = 0; kc < nk; ++kc) {
        if (kc + 1 < nk) asm volatile("s_waitcnt vmcnt(5)" ::: "memory"); else asm volatile("s_waitcnt vmcnt(0)" ::: "memory");
        asm volatile("s_waitcnt lgkmcnt(0)" ::: "memory"); __builtin_amdgcn_s_barrier(); asm volatile("" ::: "memory");
        if (kc + 2 < nk) SKW_STAGE(kc + 2);
        const LAS unsigned char* sp = lds + (kc % 3) * SKW_STG;
        bf16x8 af[4][2], bf_[2][2];
#pragma unroll
        for (int m = 0; m < 4; ++m) { af[m][0] = *(const LAS bf16x8*)(sp + aro + m * 2048 + co0); af[m][1] = *(const LAS bf16x8*)(sp + aro + m * 2048 + co1); }
#pragma unroll
        for (int n = 0; n < 2; ++n) { bf_[n][0] = *(const LAS bf16x8*)(sp + bro + n * 2048 + co0); bf_[n][1] = *(const LAS bf16x8*)(sp + bro + n * 2048 + co1); }
#pragma unroll
        for (int m = 0; m < 4; ++m)
#pragma unroll
            for (int n = 0; n < 2; ++n) { acc[m][n] = __builtin_amdgcn_mfma_f32_16x16x32_bf16(bf_[n][0], af[m][0], acc[m][n], 0, 0, 0); acc[m][n] = __builtin_amdgcn_mfma_f32_16x16x32_bf16(bf_[n][1], af[m][1], acc[m][n], 0, 0, 0); }
    }
#undef SKW_STAGE
    asm volatile("s_waitcnt lgkmcnt(0)" ::: "memory"); __builtin_amdgcn_s_barrier(); asm volatile("" ::: "memory");
    LAS float* red = (LAS float*)lds;
#pragma unroll
    for (int m = 0; m < 4; ++m)
#pragma unroll
        for (int n = 0; n < 2; ++n) { const int row = 16 * m + fr, c4 = 8 * wave + 4 * n + fq; *(LAS f32x4*)(red + row * 256 + 4 * (c4 ^ (row & 15))) = acc[m][n]; }
    __syncthreads();
#pragma unroll
    for (int i = 0; i < 8; ++i) { const int it = tid + 512 * i, row = it >> 6, c4 = it & 63; const f32x4 v = *(const LAS f32x4*)(red + row * 256 + 4 * (c4 ^ (row & 15))); E(MP + m0 + row, n0 + 4 * c4, v, 0); }
    __syncthreads();
}
__device__ __forceinline__ float row_rstd16(const float* ssq, int row) {
    const f32x4* s = (const f32x4*)(ssq + (size_t)row * 16); const f32x4 a = s[0], b = s[1], c = s[2], d = s[3];
    const float t = ((a.x + a.y) + (a.z + a.w)) + ((b.x + b.y) + (b.z + b.w)) + ((c.x + c.y) + (c.z + c.w)) + ((d.x + d.y) + (d.z + d.w));
    return 1.0f / sqrtf(t * (1.0f / 1024.0f) + EPS);
}
template <int MODE> struct SgH {
    static constexpr bool WHOLE_TILE = false;
    const float* xs; const float* scale; const float* ssq_in; const bf16_t* proj; const bf16_t* hb_in; bf16_t* hb; float* ssq_out;
    __device__ __forceinline__ void operator()(int row, int col, f32x4 a, int ntile) const {
        const f32x4 bs = (MODE == 0) ? *(const f32x4*)(xs + (size_t)(row - MP) * D + col) : unpk4(*(const u32x2*)(hb_in + (size_t)row * D + col));
        f32x4 o;
        if (MODE == 0) o = bs + *(const f32x4*)(scale + col) * a;
        else if (MODE == 1) o = bs + a;
        else { const float r = row_rstd16(ssq_in, row); const f32x4 pj = unpk4(*(const u32x2*)(proj + (size_t)row * D + col));
            f32x4 gt; gt.x = 1.0f / (1.0f + __expf(-r * a.x)); gt.y = 1.0f / (1.0f + __expf(-r * a.y)); gt.z = 1.0f / (1.0f + __expf(-r * a.z)); gt.w = 1.0f / (1.0f + __expf(-r * a.w));
            o = bs + gt * pj; }
        u32x2 w; w.x = pk2(o.x, o.y); w.y = pk2(o.z, o.w);
        *(u32x2*)(hb + (size_t)row * D + col) = w;
        float sq = (o.x * o.x + o.y * o.y) + (o.z * o.z + o.w * o.w);
        sq += __shfl_xor(sq, 1); sq += __shfl_xor(sq, 2); sq += __shfl_xor(sq, 4); sq += __shfl_xor(sq, 8);
        if ((col & 63) == 0) ssq_out[(size_t)row * 16 + ntile] = sq;
    }
};
struct SgUp {
    static constexpr bool WHOLE_TILE = false;
    const float* ssq_in; bf16_t* abuf;
    __device__ __forceinline__ void operator()(int row, int col, f32x4 a, int) const {
        const float r = row_rstd16(ssq_in, row); a = a * r;
        a.x = fmaxf(a.x, 0.f); a.y = fmaxf(a.y, 0.f); a.z = fmaxf(a.z, 0.f); a.w = fmaxf(a.w, 0.f);
        u32x2 w; w.x = pk2(a.x * a.x, a.y * a.y); w.y = pk2(a.z * a.z, a.w * a.w);
        *(u32x2*)(abuf + (size_t)row * FF + col) = w;
    }
};
template <int MODE> struct SgF32 {
    static constexpr bool WHOLE_TILE = false;
    float* C; int ldc; const float* aux;
    __device__ __forceinline__ void operator()(int row, int col, f32x4 a, int) const {
        const float r = (MODE == 1) ? row_rstd16(aux, row) : (MODE == 2 ? aux[row] : 1.0f);
        *(f32x4*)(C + (size_t)row * ldc + col) = a * r;
    }
};
struct SgBf {
    static constexpr bool WHOLE_TILE = false;
    bf16_t* C; int ldc;
    __device__ __forceinline__ void operator()(int row, int col, f32x4 a, int) const { u32x2 w; w.x = pk2(a.x, a.y); w.y = pk2(a.z, a.w); *(u32x2*)(C + (size_t)row * ldc + col) = w; }
};
struct SgQ {
    static constexpr bool WHOLE_TILE = true;
    const float* rstdq; const float* cs; bf16_t* qbuf; bf16_t* qs;
    __device__ __forceinline__ void operator()(int, int, f32x4, int) const {}
    __device__ __forceinline__ void tile(int row, int n0, int c4, const LAS float* trow, int sw) const {
        const int c = n0 + 4 * c4, hh = c / QH, e = c - hh * QH; const float r = rstdq[row];
        const f32x4 v = *(const LAS f32x4*)(trow + 4 * (c4 ^ sw)) * r;
        if (e < NOPE) { u32x2 w; w.x = pk2(v.x, v.y); w.y = pk2(v.z, v.w); *(u32x2*)(qbuf + (size_t)row * (NH * QH) + c) = w; }
        else { const int rp = e - NOPE, wi = rp & 31;
            if (wi < 16) { const int i0 = 16 * (rp >> 5) + wi, pos = PAST + ((row - MP) & 7);
                const f32x4 x2 = *(const LAS f32x4*)(trow + 4 * ((c4 + 4) ^ sw)) * r;
                const f32x4 cn = *(const f32x4*)(cs + (size_t)pos * 64 + i0), sn = *(const f32x4*)(cs + (size_t)pos * 64 + 32 + i0);
                const f32x4 o1 = v * cn - x2 * sn, o2 = x2 * cn + v * sn;
                bf16_t* qd = qs + ((size_t)(row - MP) * NH + hh) * 320 + KVR;
                u32x2 w1, w2; w1.x = pk2(o1.x, o1.y); w1.y = pk2(o1.z, o1.w); w2.x = pk2(o2.x, o2.y); w2.y = pk2(o2.z, o2.w);
                *(u32x2*)(qd + i0) = w1; *(u32x2*)(qd + 32 + i0) = w2; } }
    }
};

template <int PMODE = 0>
__device__ __forceinline__ void transpose_item(const float* W, const float* kscale, int K, int N, bf16_t* WT, int row_off, LAS float* scr, int item, int lane) {
    const int nblk = N / 32, kb = item / nblk, nb = item % nblk, k0 = 64 * kb, n0 = 32 * nb;
    { f32x4 v[8];
#pragma unroll
      for (int i = 0; i < 8; ++i) v[i] = *(const f32x4*)(W + (size_t)(k0 + (lane >> 3) + 8 * i) * N + n0 + (lane & 7) * 4);
#pragma unroll
      for (int i = 0; i < 8; ++i) { const int kk = (lane >> 3) + 8 * i; f32x4 x = v[i]; if (kscale) x = x * kscale[k0 + kk];
          LAS float* d = scr + kk * 33 + (lane & 7) * 4; d[0] = x.x; d[1] = x.y; d[2] = x.z; d[3] = x.w; } }
    LDS_WAIT(); asm volatile("" ::: "memory");
    const int c = lane & 7;
#pragma unroll
    for (int j = 0; j < 4; ++j) { const int n = (lane >> 3) + 8 * j; const LAS float* s = scr + (8 * c) * 33 + n;
        u32x4 o; o.x = pk2(s[0 * 33], s[1 * 33]); o.y = pk2(s[2 * 33], s[3 * 33]); o.z = pk2(s[4 * 33], s[5 * 33]); o.w = pk2(s[6 * 33], s[7 * 33]);
        *(u32x4*)(WT + (size_t)(row_off + (PMODE == 1 ? qperm(n0 + n) : (PMODE == 2 ? kperm(n0 + n) : n0 + n))) * K + k0 + 8 * c) = o; }
    LDS_WAIT(); asm volatile("" ::: "memory");
}

constexpr int AK_PITCH = 400, AK_BUF = 64 * AK_PITCH;
constexpr int AV_PITCH = 136, AV_BUF = 128 * AV_PITCH;
constexpr int AV_OFF = 2 * AK_BUF, AQ_OFF = AV_OFF + 2 * AV_BUF;
static_assert(AQ_OFF + 256 * 144 <= RING_BYTES, "attention LDS");
__device__ __forceinline__ void attn_prompt_unit(const bf16_t* __restrict__ qbuf, const bf16_t* __restrict__ Kf, const bf16_t* __restrict__ Vt, bf16_t* __restrict__ obuf,
                                                 int b, int h, int qb, LAS unsigned char* lds, int tid, int wave, int lane) {
    const int r32 = lane & 31, g = lane >> 5;
    const int t_lo = qb * 256 + wave * 32, trow = t_lo + r32;
    bf16x8 qf[8];
    { const bf16_t* qp = qbuf + (size_t)(b * SEQ + trow) * (NH * QH) + h * QH + 8 * g;
      __syncthreads();
#pragma unroll
      for (int ks = 8; ks < 12; ++ks) *(LAS bf16x8*)(lds + AQ_OFF + (wave * 32 + r32) * 144 + (2 * (ks - 8) + g) * 16) = *(const bf16x8*)(qp + 16 * ks);
#pragma unroll
      for (int ks = 0; ks < 8; ++ks) qf[ks] = *(const bf16x8*)(qp + 16 * ks);
#pragma unroll
      for (int ks = 0; ks < 8; ++ks) asm volatile("" : "+v"(qf[ks])); }
    f32x16 O[4];
#pragma unroll
    for (int i = 0; i < 4; ++i)
#pragma unroll
        for (int j = 0; j < 16; ++j) O[i][j] = 0.f;
    float mrun = -1e30f, lrun = 0.f;
    const bf16_t* Kb = Kf + (size_t)(b * NH + h) * SEQ * QH;
    const bf16_t* Vb = Vt + (size_t)(b * NH + h) * VD * SEQ;
    const int NT = (qb + 1) * 4;
    int kl_off[3], vl_off[2]; size_t vg_off[2];
#pragma unroll
    for (int e = 0; e < 3; ++e) kl_off[e] = (tid >> 3) * AK_PITCH + ((tid & 7) + 8 * e) * 16;
#pragma unroll
    for (int e = 0; e < 2; ++e) { const int c = tid + 512 * e; vl_off[e] = AV_OFF + (c >> 3) * AV_PITCH + (c & 7) * 16; vg_off[e] = (size_t)(c >> 3) * SEQ + (c & 7) * 8; }
    u32x4 kst[3], vst[2];
#define AT_LOAD(j) do { _Pragma("unroll") for (int e = 0; e < 3; ++e) kst[e] = *(const u32x4*)(Kb + (size_t)(64 * (j) + (tid >> 3)) * QH + ((tid & 7) + 8 * e) * 8); \
                        _Pragma("unroll") for (int e = 0; e < 2; ++e) vst[e] = *(const u32x4*)(Vb + vg_off[e] + 64 * (j)); } while (0)
#define AT_WRITE(buf) do { _Pragma("unroll") for (int e = 0; e < 3; ++e) *(LAS u32x4*)(lds + (buf) * AK_BUF + kl_off[e]) = kst[e]; \
                           _Pragma("unroll") for (int e = 0; e < 2; ++e) { *(LAS u32x2*)(lds + (buf) * AV_BUF + vl_off[e]) = (u32x2){vst[e].x, vst[e].y}; *(LAS u32x2*)(lds + (buf) * AV_BUF + vl_off[e] + 8) = (u32x2){vst[e].z, vst[e].w}; } } while (0)
    AT_LOAD(0); AT_WRITE(0);
    __syncthreads();
    for (int j = 0; j < NT; ++j) {
        const int buf = j & 1;
        if (j + 1 < NT) AT_LOAD(j + 1);
        if (64 * j <= t_lo + 31) {
            f32x16 S0, S1;
#pragma unroll
            for (int i = 0; i < 16; ++i) { S0[i] = 0.f; S1[i] = 0.f; }
            const LAS unsigned char* kl = lds + buf * AK_BUF + r32 * AK_PITCH + g * 16;
            const LAS unsigned char* ql = lds + AQ_OFF + (wave * 32 + r32) * 144 + g * 16;
            bf16x8 ka[3][2], qr_[3];
#define AT_KLD(ks) do { ka[(ks) % 3][0] = *(const LAS bf16x8*)(kl + (ks) * 32); ka[(ks) % 3][1] = *(const LAS bf16x8*)(kl + 32 * AK_PITCH + (ks) * 32); \
                        if ((ks) >= 8) qr_[(ks) % 3] = *(const LAS bf16x8*)(ql + ((ks) - 8) * 32); } while (0)
            AT_KLD(0); AT_KLD(1);
#pragma unroll
            for (int ks = 0; ks < 12; ++ks) {
                if (ks + 2 < 12) AT_KLD(ks + 2);
                __builtin_amdgcn_sched_barrier(0);
                const bf16x8 qb_ = (ks < 8) ? qf[ks < 8 ? ks : 0] : qr_[ks % 3];
                S0 = __builtin_amdgcn_mfma_f32_32x32x16_bf16(ka[ks % 3][0], qb_, S0, 0, 0, 0);
                S1 = __builtin_amdgcn_mfma_f32_32x32x16_bf16(ka[ks % 3][1], qb_, S1, 0, 0, 0);
                __builtin_amdgcn_sched_barrier(0);
            }
#undef AT_KLD
            if (64 * j + 63 > t_lo) {
                asm volatile("" ::: "memory");
#pragma unroll
                for (int i = 0; i < 16; ++i) { const int key = 64 * j + crow(i, g); if (key > trow) S0[i] = -1e30f; if (key + 32 > trow) S1[i] = -1e30f; }
            }
            float mx = S0[0];
#pragma unroll
            for (int i = 1; i < 16; ++i) mx = fmaxf(mx, S0[i]);
#pragma unroll
            for (int i = 0; i < 16; ++i) mx = fmaxf(mx, S1[i]);
            mx = fmaxf(mx, __shfl_xor(mx, 32)) * CEXP;
            if (__any(mx > mrun + 11.5f)) {
                const float mnew = fmaxf(mrun, mx), alpha = __builtin_amdgcn_exp2f(mrun - mnew);
                mrun = mnew; lrun *= alpha;
#pragma unroll
                for (int vt = 0; vt < 4; ++vt)
#pragma unroll
                    for (int i = 0; i < 16; ++i) O[vt][i] *= alpha;
            }
            float ps = 0.f;
#pragma unroll
            for (int i = 0; i < 16; ++i) { S0[i] = __builtin_amdgcn_exp2f(S0[i] * CEXP - mrun); S1[i] = __builtin_amdgcn_exp2f(S1[i] * CEXP - mrun); ps += S0[i] + S1[i]; }
            lrun += ps;
            bf16x8 pf[4];
            { float tmp[8];
#pragma unroll
              for (int s2 = 0; s2 < 4; ++s2) {
#pragma unroll
                for (int i = 0; i < 8; ++i) tmp[i] = (s2 < 2) ? S0[8 * (s2 & 1) + i] : S1[8 * (s2 & 1) + i];
                pf[s2] = pack8(tmp); } }
            const LAS unsigned char* vl = lds + AV_OFF + buf * AV_BUF + r32 * AV_PITCH + g * 8;
            u32x4 fa[4], fb[4];
#define AT_VLD(dst, vt) do { _Pragma("unroll") for (int s2 = 0; s2 < 4; ++s2) { const u32x2 lo_ = *(const LAS u32x2*)(vl + (vt) * 32 * AV_PITCH + s2 * 32), hi_ = *(const LAS u32x2*)(vl + (vt) * 32 * AV_PITCH + s2 * 32 + 16); dst[s2] = (u32x4){lo_.x, lo_.y, hi_.x, hi_.y}; } } while (0)
#define AT_VMM(src, vt) do { _Pragma("unroll") for (int s2 = 0; s2 < 4; ++s2) O[vt] = __builtin_amdgcn_mfma_f32_32x32x16_bf16(__builtin_bit_cast(bf16x8, src[s2]), pf[s2], O[vt], 0, 0, 0); } while (0)
            AT_VLD(fa, 0); AT_VLD(fb, 1); __builtin_amdgcn_sched_barrier(0);
            AT_VMM(fa, 0); __builtin_amdgcn_sched_barrier(0);
            AT_VLD(fa, 2); __builtin_amdgcn_sched_barrier(0);
            AT_VMM(fb, 1); __builtin_amdgcn_sched_barrier(0);
            AT_VLD(fb, 3); __builtin_amdgcn_sched_barrier(0);
            AT_VMM(fa, 2); __builtin_amdgcn_sched_barrier(0);
            AT_VMM(fb, 3);
#undef AT_VLD
#undef AT_VMM
        }
        if (j + 1 < NT) AT_WRITE(buf ^ 1);
        __syncthreads();
    }
#undef AT_LOAD
#undef AT_WRITE
    const float ltot = lrun + __shfl_xor(lrun, 32), inv = 1.0f / ltot;
    bf16_t* op = obuf + (size_t)(b * SEQ + trow) * D + h * VD + 4 * g;
#pragma unroll
    for (int vt = 0; vt < 4; ++vt)
#pragma unroll
        for (int jq = 0; jq < 4; ++jq) {
            u32x2 w; w.x = pk2(O[vt][4 * jq] * inv, O[vt][4 * jq + 1] * inv); w.y = pk2(O[vt][4 * jq + 2] * inv, O[vt][4 * jq + 3] * inv);
            *(u32x2*)(op + 32 * vt + 8 * jq) = w;
        }
}

typedef short s16x4 __attribute__((ext_vector_type(4)));
constexpr int SA_KR = 32768, SA_BUF = 32768 + 64 * 144, SA_QR = 2 * SA_BUF, SA_QI = SA_QR + 64 * 144, SA_QI_PITCH = 528, SA_OI = 69632;
static_assert(SA_OI >= 65536 + 1024 && SA_OI + 64 * SA_QI_PITCH <= MISC_OFF, "O image");
static_assert(SA_QI + 64 * SA_QI_PITCH <= MISC_OFF, "sample attention LDS");
__device__ __forceinline__ int sa_off(int row, int ch) { return 256 * row + 16 * (ch ^ (((row & 3) << 2) | ((row >> 2) & 3))); }
__device__ __forceinline__ void sattn_item(const Params& P, int b, int half, LAS unsigned char* lds, int tid, int wave, int lane) {
    unsigned char* ws = P.ws;
    const int r32 = lane & 31, g = lane >> 5;
    const bool is_cmp = wave < 4;
    const int qt = wave & 1, kb = (wave >> 1) & 1;
    const int ptv = ((const int*)P.in[I_PT])[b * NPG + half * 32 + (lane & 31)];
    const float* clat = P.in[I_CLAT]; const float* ckr = P.in[I_CKR];
#define SA_LOAD(S, h) do { const int pg_ = __builtin_amdgcn_readlane(ptv, (h) >> 2); const size_t prow_ = (size_t)pg_ * PAGE + (((h) & 3) << 5); \
        const char* lat_ = (const char*)(clat + prow_ * KVR); const char* kro_ = (const char*)(ckr + prow_ * ROPE); \
        _Pragma("unroll") for (int e = 0; e < 8; ++e) S[e] = *(const f32x4*)(lat_ + glb + e * 1024); \
        S[8] = *(const f32x4*)(kro_ + grb); S[9] = *(const f32x4*)(kro_ + grb + 1024); } while (0)
#define SA_PK4(v) ((u32x2){pk2((v).x, (v).y), pk2((v).z, (v).w)})
#define SA_WRITE(S, bufo, hh) do { \
        _Pragma("unroll") for (int e = 0; e < 8; ++e) *(LAS u32x2*)(lds + (bufo) + llb[e] + (hh) * 8192) = SA_PK4(S[e]); \
        _Pragma("unroll") for (int e = 0; e < 2; ++e) *(LAS u32x2*)(lds + (bufo) + lrb[e] + (hh) * 4608) = SA_PK4(S[8 + e]); asm volatile("" ::: "memory"); } while (0)
    __syncthreads();
    *(LAS u32x4*)(lds + SA_QR + (tid >> 3) * 144 + (tid & 7) * 16) = *(const u32x4*)((const bf16_t*)(ws + WS_QS) + ((size_t)b * 64 + (tid >> 3)) * 320 + KVR + (tid & 7) * 8);
    {
      const bf16_t* qn = (const bf16_t*)(ws + WS_QBUF) + (size_t)(MP + b * DS + (r32 & 7)) * (NH * QH) + wave * QH + 8 * g;
      bf16x8 an[8];
#pragma unroll
      for (int ks = 0; ks < 8; ++ks) { u32x4 z = {0u, 0u, 0u, 0u}; if (r32 < DS) z = *(const u32x4*)(qn + 16 * ks); an[ks] = __builtin_bit_cast(bf16x8, z); }
      const bf16_t* wk = (const bf16_t*)(ws + WS_WUKB) + (size_t)wave * (64 * 512) + lane * 8;
#pragma unroll 2
      for (int nt = 0; nt < 8; ++nt) {
          f32x16 acc;
#pragma unroll
          for (int i = 0; i < 16; ++i) acc[i] = 0.f;
#pragma unroll
          for (int ks = 0; ks < 8; ++ks) acc = __builtin_amdgcn_mfma_f32_32x32x16_bf16(an[ks], *(const bf16x8*)(wk + (nt * 8 + ks) * 512), acc, 0, 0, 0);
#pragma unroll
          for (int i = 0; i < 4; ++i) *(LAS bf16_t*)(lds + SA_QI + ((i + 4 * g) * 8 + wave) * SA_QI_PITCH + (32 * nt + r32) * 2) = (bf16_t)f2bf(acc[i]);
      } }
    __syncthreads();
#define SA_KLD(ks) do { const int o0_ = ((ks) < 16) ? (((ks) >> 3) * 16384 + krow + 32 * (((ks) & 7) ^ (x_ >> 1))) : (krope + 32 * ((ks) - 16)); \
        ka_[(ks) & 3] = *(const LAS bf16x8*)(kb_ + o0_); \
        qa_[(ks) & 3] = ((ks) < 16) ? *(const LAS bf16x8*)(qil + 32 * (ks)) : *(const LAS bf16x8*)(qrl + 32 * ((ks) - 16)); } while (0)
#define SA_VLD(dst, vt) do { const LAS unsigned char* vb_ = kb_ + ((vt) >> 2) * 16384 + 8192 * kb; \
        const int c0_ = 4 * ((vt) & 3) + 2 * vsub + (p_ >> 1); \
        const int blo_ = 256 * (4 * gg + q_) + 16 * (c0_ ^ ((q_ << 2) | gg)) + 8 * (p_ & 1); \
        const int bhi_ = 256 * (4 * gg + q_ + 8) + 16 * (c0_ ^ ((q_ << 2) | (gg + 2))) + 8 * (p_ & 1); \
        _Pragma("unroll") for (int s2 = 0; s2 < 2; ++s2) { \
            const s16x4 lo_ = __builtin_amdgcn_ds_read_tr16_b64_v4i16((LAS s16x4*)(vb_ + blo_ + 4096 * s2)); \
            const s16x4 hi_ = __builtin_amdgcn_ds_read_tr16_b64_v4i16((LAS s16x4*)(vb_ + bhi_ + 4096 * s2)); \
            dst[s2] = (bf16x8){lo_[0], lo_[1], lo_[2], lo_[3], hi_[0], hi_[1], hi_[2], hi_[3]}; } } while (0)
#define SA_VMM(src, vt) do { _Pragma("unroll") for (int s2 = 0; s2 < 2; ++s2) O[vt] = __builtin_amdgcn_mfma_f32_32x32x16_bf16(src[s2], pf[s2], O[vt], 0, 0, 0); } while (0)
#define SA_COMPUTE(j, bufo) do { \
        const LAS unsigned char* kb_ = lds + (bufo); \
        f32x16 S0; \
        _Pragma("unroll") for (int i = 0; i < 16; ++i) S0[i] = 0.f; \
        int r32v = r32; asm volatile("" : "+v"(r32v)); \
        const int x_ = ((r32v & 3) << 2) | ((r32v >> 2) & 3); \
        const int krow = 256 * (r32v + 32 * kb) + 16 * ((g ^ x_) & 1), krope = SA_KR + (r32v + 32 * kb) * 144 + g * 16; \
        const LAS unsigned char* qrl = lds + SA_QR + (32 * qt + r32v) * 144 + g * 16; const LAS unsigned char* qil = lds + SA_QI + (32 * qt + r32v) * SA_QI_PITCH + g * 16; \
        bf16x8 ka_[4], qa_[4]; \
        SA_KLD(0); SA_KLD(1); SA_KLD(2); \
        _Pragma("unroll") for (int ks = 0; ks < 20; ++ks) { \
            if (ks + 3 < 20) SA_KLD(ks + 3); \
            __builtin_amdgcn_sched_barrier(0); \
            S0 = __builtin_amdgcn_mfma_f32_32x32x16_bf16(ka_[ks & 3], qa_[ks & 3], S0, 0, 0, 0); \
            __builtin_amdgcn_sched_barrier(0); } \
        if ((j) == 64) { const int tok = (32 * qt + r32) >> 3; asm volatile("" ::: "memory"); \
            _Pragma("unroll") for (int i = 0; i < 16; ++i) { const int key = 32 * kb + crow(i, g); if (key > tok || key >= DS) S0[i] = -1e30f; } } \
        float mx = S0[0]; \
        _Pragma("unroll") for (int i = 1; i < 16; ++i) mx = fmaxf(mx, S0[i]); \
        mx = fmaxf(mx, __shfl_xor(mx, 32)) * CEXP; \
        if (__any(mx > mrun + 11.5f)) { const float mnew = fmaxf(mrun, mx), alpha = __builtin_amdgcn_exp2f(mrun - mnew); mrun = mnew; lrun *= alpha; \
            _Pragma("unroll") for (int vt = 0; vt < 8; ++vt) _Pragma("unroll") for (int i = 0; i < 16; ++i) O[vt][i] *= alpha; } \
        int lnv = lane; asm volatile("" : "+v"(lnv)); \
        const int li = lnv & 15, q_ = li >> 2, p_ = li & 3, vsub = (lnv >> 4) & 1, gg = lnv >> 5; \
        bf16x8 fa_[2], fb_[2]; \
        SA_VLD(fa_, 0); SA_VLD(fb_, 1);                        \
        float ps = 0.f; \
        _Pragma("unroll") for (int i = 0; i < 16; ++i) { S0[i] = __builtin_amdgcn_exp2f(S0[i] * CEXP - mrun); ps += S0[i]; } \
        lrun += ps; \
        bf16x8 pf[2]; \
        { float tmp[8]; \
          _Pragma("unroll") for (int s2 = 0; s2 < 2; ++s2) { \
            _Pragma("unroll") for (int i = 0; i < 8; ++i) tmp[i] = S0[8 * s2 + i]; \
            pf[s2] = pack8(tmp); } } \
        __builtin_amdgcn_sched_barrier(0); \
        SA_VMM(fa_, 0); __builtin_amdgcn_sched_barrier(0); SA_VLD(fa_, 2); __builtin_amdgcn_sched_barrier(0); \
        SA_VMM(fb_, 1); __builtin_amdgcn_sched_barrier(0); SA_VLD(fb_, 3); __builtin_amdgcn_sched_barrier(0); \
        SA_VMM(fa_, 2); __builtin_amdgcn_sched_barrier(0); SA_VLD(fa_, 4); __builtin_amdgcn_sched_barrier(0); \
        SA_VMM(fb_, 3); __builtin_amdgcn_sched_barrier(0); SA_VLD(fb_, 5); __builtin_amdgcn_sched_barrier(0); \
        SA_VMM(fa_, 4); __builtin_amdgcn_sched_barrier(0); SA_VLD(fa_, 6); __builtin_amdgcn_sched_barrier(0); \
        SA_VMM(fb_, 5); __builtin_amdgcn_sched_barrier(0); SA_VLD(fb_, 7); __builtin_amdgcn_sched_barrier(0); \
        SA_VMM(fa_, 6); __builtin_amdgcn_sched_barrier(0); \
        SA_VMM(fb_, 7); } while (0)
#define SA_LOADER(j, SX, SY, bufn) do { const int h0_ = 2 * (j) + 6 < 127 ? 2 * (j) + 6 : 127, h1_ = 2 * (j) + 7 < 127 ? 2 * (j) + 7 : 127; \
        __builtin_amdgcn_sched_barrier(0); SA_WRITE(SX, bufn, 0); SA_LOAD(SX, h0_); __builtin_amdgcn_sched_barrier(0); SA_WRITE(SY, bufn, 1); SA_LOAD(SY, h1_); __builtin_amdgcn_sched_barrier(0); } while (0)
#define SA_TAIL64(bufn) do { if (half == 1) { \
            const char* cbn = (const char*)((const bf16_t*)(ws + WS_CB) + (size_t)(MP + b * DS) * KVR); const char* krn = (const char*)((const bf16_t*)(ws + WS_KRBS) + (size_t)(b * DS) * ROPE); \
            const int w4_ = wave - 4; \
            _Pragma("unroll") for (int hh = 0; hh < 2; ++hh) { \
                _Pragma("unroll") for (int e = 0; e < 8; ++e) { const int key = 8 * w4_ + e + 32 * hh; u32x2 z = {0u, 0u}; if (key < DS) z = *(const u32x2*)(cbn + key * (KVR * 2) + 8 * lane); *(LAS u32x2*)(lds + (bufn) + llb[e] + hh * 8192) = z; } \
                _Pragma("unroll") for (int e = 0; e < 2; ++e) { const int key = 8 * w4_ + 4 * e + (lane >> 4) + 32 * hh; u32x2 z = {0u, 0u}; if (key < DS) z = *(const u32x2*)(krn + key * (ROPE * 2) + 8 * (lane & 15)); *(LAS u32x2*)(lds + (bufn) + lrb[e] + hh * 4608) = z; } } } } while (0)
#define SA_BAR() do { asm volatile("s_waitcnt lgkmcnt(0)" ::: "memory"); __builtin_amdgcn_s_barrier(); asm volatile("" ::: "memory"); } while (0)
    float* ml = (float*)(ws + WS_ML) + (size_t)(b * 2 + half) * 64 * 2;
    if (is_cmp) {
        SA_BAR();
        f32x16 O[8];
#pragma unroll
        for (int vt = 0; vt < 8; ++vt)
#pragma unroll
            for (int i = 0; i < 16; ++i) O[vt][i] = 0.f;
        float mrun = -1e30f, lrun = 0.f;
        int bo = 0;
        for (int j = 0; j < 64; ++j) {
            SA_COMPUTE(j, bo);
            bo = SA_BUF - bo;
            SA_BAR();
        }
        if (half == 1) { SA_COMPUTE(64, bo); SA_BAR(); }
        LAS float* xo = (LAS float*)(lds + qt * 32768); LAS float* xm = (LAS float*)(lds + 65536 + qt * 512);
        if (kb == 1) { xm[2 * lane] = mrun; xm[2 * lane + 1] = lrun;
#pragma unroll
            for (int vt = 0; vt < 8; ++vt)
#pragma unroll
                for (int i = 0; i < 16; ++i) xo[(vt * 16 + i) * 64 + lane] = O[vt][i]; }
        SA_BAR();
        if (kb == 0) {
            const float m1 = xm[2 * lane], l1 = xm[2 * lane + 1], mm = fmaxf(mrun, m1);
            const float a0 = __builtin_amdgcn_exp2f(mrun - mm), a1 = __builtin_amdgcn_exp2f(m1 - mm);
            const float ll = lrun * a0 + l1 * a1, lt = ll + __shfl_xor(ll, 32);
            const int q = 32 * qt + r32;
            if (g == 0) { ml[q * 2] = mm; ml[q * 2 + 1] = lt; }
#pragma unroll
            for (int vt = 0; vt < 8; ++vt) {
                float o[16];
#pragma unroll
                for (int i = 0; i < 16; ++i) o[i] = O[vt][i] * a0 + xo[(vt * 16 + i) * 64 + lane] * a1;
#pragma unroll
                for (int jq = 0; jq < 4; ++jq) { u32x2 w; w.x = pk2(o[4 * jq], o[4 * jq + 1]); w.y = pk2(o[4 * jq + 2], o[4 * jq + 3]);
                    *(LAS u32x2*)(lds + SA_OI + q * SA_QI_PITCH + (32 * vt + 8 * jq + 4 * g) * 2) = w; }
            }
        }
    } else {
        unsigned glb, grb, llb[8], lrb[2];
        { const int w4_ = wave - 4;
          glb = (unsigned)(8 * w4_ * 1024 + 16 * lane); grb = (unsigned)(8 * w4_ * 256 + 16 * lane);
#pragma unroll
          for (int e = 0; e < 8; ++e) { const int x_ = ((e & 3) << 2) | ((2 * w4_ + (e >> 2)) & 3);
              llb[e] = (unsigned)((lane >> 5) * 16384 + 256 * (8 * w4_ + e) + 16 * ((((lane & 31) >> 1)) ^ x_) + 8 * (lane & 1)); }
#pragma unroll
          for (int e = 0; e < 2; ++e) lrb[e] = (unsigned)(SA_KR + (8 * w4_ + 4 * e + (lane >> 4)) * 144 + 8 * (lane & 15)); }
        f32x4 s0[10], s1[10], s2[10], s3[10];
        SA_LOAD(s0, 0); SA_LOAD(s1, 1); SA_LOAD(s2, 2); SA_LOAD(s3, 3);
        SA_WRITE(s0, 0, 0); SA_LOAD(s0, 4); SA_WRITE(s1, 0, 1); SA_LOAD(s1, 5);
        SA_BAR();
        for (int j = 0; j < 62; j += 2) {
            SA_LOADER(j, s2, s3, SA_BUF);
            SA_BAR();
            SA_LOADER(j + 1, s0, s1, 0);
            SA_BAR();
        }
        SA_LOADER(62, s2, s3, SA_BUF);
        SA_BAR();
        SA_TAIL64(0);
        SA_BAR();
        if (half == 1) SA_BAR();
        SA_BAR();
    }
#undef SA_BAR
#undef SA_LOAD
#undef SA_WRITE
#undef SA_PK4
#undef SA_COMPUTE
#undef SA_KLD
#undef SA_VLD
#undef SA_VMM
#undef SA_LOADER
#undef SA_TAIL64

    float* parto = (float*)(ws + WS_PART) + (size_t)(b * 2 + half) * 64 * 128;
    __syncthreads();
    { bf16x8 ao[16];
#pragma unroll
      for (int ks = 0; ks < 16; ++ks) { u32x4 z = {0u, 0u, 0u, 0u}; if (r32 < DS) z = *(const LAS u32x4*)(lds + SA_OI + (r32 * 8 + wave) * SA_QI_PITCH + (16 * ks + 8 * g) * 2); ao[ks] = __builtin_bit_cast(bf16x8, z); }
      const bf16_t* wv = (const bf16_t*)(ws + WS_WUVP) + (size_t)wave * (64 * 512) + lane * 8;
#pragma unroll 2
      for (int nt = 0; nt < 4; ++nt) {
          f32x16 acc;
#pragma unroll
          for (int i = 0; i < 16; ++i) acc[i] = 0.f;
#pragma unroll
          for (int ks = 0; ks < 16; ++ks) acc = __builtin_amdgcn_mfma_f32_32x32x16_bf16(ao[ks], *(const bf16x8*)(wv + (nt * 16 + ks) * 512), acc, 0, 0, 0);
#pragma unroll
          for (int i = 0; i < 4; ++i) parto[(size_t)((i + 4 * g) * 8 + wave) * 128 + 32 * nt + r32] = acc[i];
      } }
    volatile LAS unsigned* flag = (volatile LAS unsigned*)(lds + MISC_OFF) + 16;
    asm volatile("s_waitcnt vmcnt(0)" ::: "memory");
    __syncthreads();
    if (tid == 0) {
        __builtin_amdgcn_fence(__ATOMIC_RELEASE, "agent");
        asm volatile("s_waitcnt vmcnt(0)" ::: "memory");
        const unsigned old = __hip_atomic_fetch_add((unsigned*)(ws + WS_CTL) + CW_SCNT + 64 * b, 1u, __ATOMIC_RELAXED, __HIP_MEMORY_SCOPE_AGENT);
        if (old == 1u) { __builtin_amdgcn_fence(__ATOMIC_ACQUIRE, "agent"); asm volatile("s_waitcnt vmcnt(0)" ::: "memory"); }
        flag[0] = old;
    }
    __syncthreads();
    if (flag[0] == 1u) {
        const int q = tid >> 3, v0 = (tid & 7) * 16, tok = q >> 3, h = q & 7;
        const float* mlb = (const float*)(ws + WS_ML) + ((size_t)(b * 2) * 64 + q) * 2; const float* pab = (const float*)(ws + WS_PART) + ((size_t)(b * 2) * 64 + q) * 128 + v0;
        const float m0 = mlb[0], l0 = mlb[1], m1 = mlb[128], l1 = mlb[129], mx = fmaxf(m0, m1);
        float w0 = __builtin_amdgcn_exp2f(m0 - mx), w1 = __builtin_amdgcn_exp2f(m1 - mx); const float inv = 1.0f / (w0 * l0 + w1 * l1); w0 *= inv; w1 *= inv;
        f32x4 a[4];
#pragma unroll
        for (int c = 0; c < 4; ++c) a[c] = *(const f32x4*)(pab + 4 * c) * w0 + *(const f32x4*)(pab + 64 * 128 + 4 * c) * w1;
        bf16_t* od = (bf16_t*)(ws + WS_OBUF) + (size_t)(MP + b * DS + tok) * D + h * VD + v0;
        *(bf16x8*)od = pack8v(a[0], a[1]); *(bf16x8*)(od + 8) = pack8v(a[2], a[3]);
    }
}

template <int W>
__device__ __forceinline__ void pool_chunk(const float* __restrict__ xr, int rvb, f32x4 gn, int col, int t0, bf16_t* __restrict__ drow) {
    f32x4 ring[W - 1]; f32x4 sum = {0.f, 0.f, 0.f, 0.f};
#pragma unroll
    for (int i = W - 1; i >= 1; --i) { f32x4 u = {0.f, 0.f, 0.f, 0.f};
        if (t0 - i >= 0) u = *(const f32x4*)(xr - (size_t)i * D + col) * __builtin_bit_cast(float, __builtin_amdgcn_readlane(rvb, 15 - i));
        ring[(W - 1 - i) % (W - 1)] = u; sum += u; }
#pragma unroll
    for (int r = 0; r < 16; ++r) {
        const f32x4 u = *(const f32x4*)(xr + (size_t)r * D + col) * __builtin_bit_cast(float, __builtin_amdgcn_readlane(rvb, 15 + r));
        sum += u;
        const int t = t0 + r; const float icnt = 1.0f / (float)((t + 1) < W ? (t + 1) : W);
        const f32x4 dd = (sum * icnt - u) * gn;
        u32x2 o; o.x = pk2(dd.x, dd.y); o.y = pk2(dd.z, dd.w);
        *(u32x2*)(drow + (size_t)r * D + col) = o;
        sum -= ring[r % (W - 1)]; ring[r % (W - 1)] = u;
    }
}
constexpr int NPH = 17;
__global__ void __launch_bounds__(512, 2) yoco_fwd(Params P) {
    extern __shared__ __attribute__((aligned(16))) unsigned char lds_raw[];
    LAS unsigned char* lds = (LAS unsigned char*)lds_raw;
    volatile LAS unsigned* MISC = (volatile LAS unsigned*)(lds + MISC_OFF);
    const int tid = threadIdx.x, lane = tid & 63, wave = __builtin_amdgcn_readfirstlane(tid >> 6);
    const int G = gridDim.x; const int bx = blockIdx.x; const int vcu = (G % 8 == 0) ? (bx % 8) * (G / 8) + bx / 8 : bx;
    unsigned char* ws = P.ws; float* out = P.out;
    for (int u = tid; u < 64; u += 512) MISC[u] = 0u;
    __syncthreads();
    XcdBarrier bar; bar.bar = (unsigned*)(ws + WS_CTL) + CW_BAR; bar.x = 0; bar.st = nullptr;
    if (MK_N_LAUNCHES == 1) bar = xcd_barrier_post((unsigned*)(ws + WS_CTL) + CW_BAR, MISC + 8);
    const int lo = P.ph_lo, hi = P.ph_hi;
#ifndef PH_MASK
#define PH_MASK 0xFFFFFFFFu
#endif
#define IN(k) (((PH_MASK >> (k)) & 1u) && lo <= (k) && (k) < hi)
#define SEAM(k) do { if (IN(k) && IN((k) + 1)) xcd_barrier(bar); } while (0)
#define SEAM2(k, kn) do { if (IN(k) && IN(kn)) xcd_barrier(bar); } while (0)
    const int gw = vcu * 8 + wave, NGW = G * 8;
    const int gtid = vcu * 512 + tid, NGT = G * 512;

#define wpool ((bf16_t*)(ws + WS_WPOOL))
#define wup ((bf16_t*)(ws + WS_WUP))
#define wdown ((bf16_t*)(ws + WS_WDOWN))
#define wgate ((bf16_t*)(ws + WS_WGATE))
#define wproj ((bf16_t*)(ws + WS_WPROJ))
#define wdkvq ((bf16_t*)(ws + WS_WDKVQ))
#define wuq ((bf16_t*)(ws + WS_WUQ))
#define wukt ((bf16_t*)(ws + WS_WUKT))
#define wuvt ((bf16_t*)(ws + WS_WUVT))
#define wukb ((bf16_t*)(ws + WS_WUKB))
#define wo ((bf16_t*)(ws + WS_WO))
#define cs ((float*)(ws + WS_CS))
#define rstd0 ((float*)(ws + WS_RSTD0))
#define dbuf ((bf16_t*)(ws + WS_DBUF))
#define pb ((bf16_t*)(ws + WS_PB))
#define hbA ((bf16_t*)(ws + WS_HBA))
#define hbB ((bf16_t*)(ws + WS_HBB))
#define ssq ((float*)(ws + WS_SSQ))
#define abuf ((bf16_t*)(ws + WS_ABUF))
#define proj ((bf16_t*)(ws + WS_PROJ))
#define craw ((float*)(ws + WS_RAW))
#define ssqc ((float*)(ws + WS_RAW + (size_t)M * KVR * 4))
#define ssqq ((float*)(ws + WS_RAW + (size_t)M * KVR * 4 + (size_t)M * 16))
#define cb ((bf16_t*)(ws + WS_CB))
#define krbs ((bf16_t*)(ws + WS_KRBS))
#define cqb ((bf16_t*)(ws + WS_CQB))
#define qbuf ((bf16_t*)(ws + WS_QBUF))
#define qs ((bf16_t*)(ws + WS_QS))
#define kfull ((bf16_t*)(ws + WS_KFULL))
#define vt ((bf16_t*)(ws + WS_VT))
#define obuf ((bf16_t*)(ws + WS_OBUF))
    constexpr size_t SSQ_V = (size_t)M * 16;

    if (IN(0)) {
        LAS float* scr = (LAS float*)(lds + wave * 16384);
        int it = gw;
#define TI(W_, ks_, K_, N_, WT_, ro_) { const int n_items = ((K_) / 64) * ((N_) / 32); for (; it < n_items; it += NGW) transpose_item(W_, ks_, K_, N_, WT_, ro_, scr, it, lane); it -= n_items; }
        TI(P.in[I_POOLW] + 0 * 65536, nullptr, 256, 256, wpool, 0) TI(P.in[I_POOLW] + 1 * 65536, nullptr, 256, 256, wpool, 256)
        TI(P.in[I_POOLW] + 2 * 65536, nullptr, 256, 256, wpool, 512) TI(P.in[I_POOLW] + 3 * 65536, nullptr, 256, 256, wpool, 768)
        TI(P.in[I_WUP], P.in[I_NMLP], D, FF, wup, 0) TI(P.in[I_WUP] + (size_t)D * FF, P.in[I_NMLP] + D, D, FF, wup + (size_t)FF * D, 0)
        TI(P.in[I_WDOWN], nullptr, FF, D, wdown, 0) TI(P.in[I_WDOWN] + (size_t)D * FF, nullptr, FF, D, wdown + (size_t)FF * D, 0)
        TI(P.in[I_WGATE], P.in[I_NPLE], D, D, wgate, 0) TI(P.in[I_WGATE] + (size_t)D * D, P.in[I_NPLE] + D, D, D, wgate + (size_t)D * D, 0)
        TI(P.in[I_WPROJ], nullptr, PLE, D, wproj, 0) TI(P.in[I_WPROJ] + (size_t)PLE * D, nullptr, PLE, D, wproj + (size_t)PLE * D, 0)
        { const int n_items = (D / 64) * (320 / 32); for (; it < n_items; it += NGW) transpose_item<2>(P.in[I_WDKV], P.in[I_NKV], D, 320, wdkvq, 0, scr, it, lane); it -= n_items; }
        TI(P.in[I_WDQ], P.in[I_NMIX] + D, D, QR, wdkvq, 320)
        { const int n_items = (QR / 64) * (NH * QH / 32); for (; it < n_items; it += NGW) transpose_item<1>(P.in[I_WUQ], P.in[I_QN], QR, NH * QH, wuq, 0, scr, it, lane); it -= n_items; }
        TI(P.in[I_WUK], P.in[I_KVN], KVR, 1024, wukt, 0) TI(P.in[I_WUV], P.in[I_KVN], KVR, 1024, wuvt, 0)
        TI(P.in[I_WO], nullptr, D, D, wo, 0)
#undef TI
        for (int i = gtid; i < 64 * D / 8; i += NGT) *(u32x4*)(wdkvq + (size_t)704 * D + (size_t)i * 8) = (u32x4){0u, 0u, 0u, 0u};
        for (int i = gtid; i < 256 * 1024 / 8; i += NGT) { const int ln = i & 63, ks = (i >> 6) & 7, nt = (i >> 9) & 7, h = i >> 12;
            const float* sp = P.in[I_WUK] + (size_t)(32 * nt + (ln & 31)) * 1024 + h * NOPE + 16 * ks + 8 * (ln >> 5);
            *(bf16x8*)(wukb + (size_t)i * 8) = pack8v(*(const f32x4*)sp, *(const f32x4*)(sp + 4)); }
        for (int i = gtid; i < 256 * 1024 / 8; i += NGT) { const int ln = i & 63, ks = (i >> 6) & 15, nt = (i >> 10) & 3, h = i >> 12;
            const float* sp = P.in[I_WUV] + (size_t)(16 * ks + 8 * (ln >> 5)) * 1024 + h * VD + 32 * nt + (ln & 31);
            float t[8];
#pragma unroll
            for (int e = 0; e < 8; ++e) t[e] = sp[(size_t)e * 1024];
            *(bf16x8*)((bf16_t*)(ws + WS_WUVP) + (size_t)i * 8) = pack8(t); }
        for (int i = gtid; i < NPOS * 32; i += NGT) { const int pos = i >> 5, f = i & 31; const double inv = exp2(-(double)f * (13.287712379549449 / 32.0)); const double ang = (double)pos * inv;
            double sn, cn; sincos(ang, &sn, &cn); cs[(size_t)pos * 64 + f] = (float)cn; cs[(size_t)pos * 64 + 32 + f] = (float)sn; }
        for (int i = gtid; i < 2 * M * PLE / 8; i += NGT) { const int li = i / (M * PLE / 8), r8 = i % (M * PLE / 8); const size_t e = (size_t)r8 * 8; const int row = (int)(e / PLE), c = (int)(e % PLE);
            const float* src = row < MP ? P.in[I_PP] + ((size_t)li * MP + row) * PLE + c : P.in[I_PS] + ((size_t)li * MS + (row - MP)) * PLE + c;
            *(bf16x8*)(pb + ((size_t)li * M + row) * PLE + c) = pack8v(*(const f32x4*)src, *(const f32x4*)(src + 4)); }
        for (int row0 = gw; row0 < M; row0 += 2 * NGW) {
            f32x4 v[2][4];
#pragma unroll
            for (int rr = 0; rr < 2; ++rr) { const int row = row0 + rr * NGW; if (row < M) { const float* xr = row < MP ? P.in[I_XP] + (size_t)row * D : P.in[I_XS] + (size_t)(row - MP) * D;
#pragma unroll
                for (int j = 0; j < 4; ++j) v[rr][j] = ((const f32x4*)xr)[lane + 64 * j]; } }
#pragma unroll
            for (int rr = 0; rr < 2; ++rr) { const int row = row0 + rr * NGW; if (row < M) {
                float s = 0.f;
#pragma unroll
                for (int j = 0; j < 4; ++j) s += (v[rr][j].x * v[rr][j].x + v[rr][j].y * v[rr][j].y) + (v[rr][j].z * v[rr][j].z + v[rr][j].w * v[rr][j].w);
                const float rstd = 1.0f / sqrtf(wave_sum(s) * (1.0f / D) + EPS);
                if (lane == 0) rstd0[row] = rstd;
                float* po = nullptr;
                if (row < MP) { const int b = row >> 13, t = row & (SEQ - 1); if (t >= SEQ - 15) po = out + O_PP + ((size_t)b * 15 + (t - (SEQ - 15))) * D; }
                else { const int rs_ = row - MP, b = rs_ >> 3, t = rs_ & 7; po = out + O_PS + ((size_t)b * 15 + 7 + t) * D; }
                if (po) {
#pragma unroll
                    for (int j = 0; j < 4; ++j) { const f32x4 gn = ((const f32x4*)P.in[I_NMIX])[lane + 64 * j]; ((f32x4*)po)[lane + 64 * j] = v[rr][j] * rstd * gn; } }
            } }
        }
        for (int i = gtid; i < DB * 7 * D / 4; i += NGT) { const int b = i / (7 * D / 4), r = (i / (D / 4)) % 7, c = i % (D / 4);
            ((f32x4*)(out + O_PS + ((size_t)b * 15 + r) * D))[c] = ((const f32x4*)(P.in[I_SPOOL] + ((size_t)b * 15 + 8 + r) * D))[c]; }
    }
    SEAM2(0, 2);
    if (IN(2)) {
#ifndef SUBM
#define SUBM 7
#endif
        { SgH<0> E{P.in[I_XS], P.in[I_POOLSC], nullptr, nullptr, nullptr, hbA, ssq + 0 * SSQ_V};
          for (int u = vcu; u < 256; u += G) {
              const int mt = u >> 4, gq = (u & 15) >> 2, w = 2 << gq, col = 256 * gq + 4 * lane, bs = mt * 8 + wave;
              const float* sp = P.in[I_SPOOL] + (size_t)bs * 15 * D; const float* xs0 = P.in[I_XS] + (size_t)(bs * DS) * D;
              const float rv = (lane < DS) ? rstd0[MP + bs * DS + lane] : 0.f;
              const f32x4 gn = *(const f32x4*)(P.in[I_NMIX] + col);
#pragma unroll
              for (int t = 0; t < DS; ++t) {
                  const f32x4 u0 = *(const f32x4*)(xs0 + (size_t)t * D + col) * __shfl(rv, t); f32x4 sum = u0, hist = {0.f, 0.f, 0.f, 0.f};
#pragma unroll
                  for (int i = 1; i < 16; ++i) if (i < w) { const int tt = t - i;
                      if (tt >= 0) sum += *(const f32x4*)(xs0 + (size_t)tt * D + col) * __shfl(rv, tt >= 0 ? tt : 0);
                      else hist += *(const f32x4*)(sp + (size_t)(15 + tt) * D + col); }
                  const f32x4 dd = (sum * gn + hist) / (float)w - u0 * gn;
                  u32x2 o; o.x = pk2(dd.x, dd.y); o.y = pk2(dd.z, dd.w);
                  *(u32x2*)(dbuf + (size_t)(MP + bs * DS + t) * D + col) = o;
              }
              asm volatile("s_waitcnt vmcnt(0)" ::: "memory"); __syncthreads();
              sk_gemm(lds, dbuf + (size_t)(MP + 64 * mt) * D + 256 * gq, D, wpool + (size_t)(64 * (u & 15)) * 256, 256, 64 * mt, 64 * (u & 15), u & 15, E, tid, wave, lane); } }
        { SgBf E{proj, D};
          for (int u = vcu; u < 256; u += G) sk_gemm(lds, pb + (size_t)(MP + 64 * (u >> 4)) * PLE, PLE, wproj + (size_t)(64 * (u & 15)) * PLE, PLE, 64 * (u >> 4), 64 * (u & 15), u & 15, E, tid, wave, lane); }
        { SgBf E{proj + (size_t)M * D, D};
          for (int u = vcu; u < 256; u += G) sk_gemm(lds, pb + (size_t)(M + MP + 64 * (u >> 4)) * PLE, PLE, wproj + (size_t)PLE * D + (size_t)(64 * (u & 15)) * PLE, PLE, 64 * (u >> 4), 64 * (u & 15), u & 15, E, tid, wave, lane); }
        if (SUBM & 1) { pg8::Gemm g{dbuf, wpool, MP, D, 256, D, 256}; pg8::StaticOrder S; S.init(MP, D, G, bx);
          {
            pg8::Unit uu;
            for (int i = 0; S.next(i, uu); ++i) {
#pragma unroll 1
                for (int cc = 0; cc < 2; ++cc) {
                    const int row0 = uu.pm * 256 + (2 * wave + cc) * 16, t0 = row0 & (SEQ - 1), col = 256 * uu.pn + 4 * lane;
                    const float rv = (lane < 31 && t0 - 15 + lane >= 0) ? rstd0[row0 - 15 + lane] : 0.f;
                    const int rvb = __builtin_bit_cast(int, rv);
                    const float* xr = P.in[I_XP] + (size_t)row0 * D; bf16_t* dr = dbuf + (size_t)row0 * D; const f32x4 gn = *(const f32x4*)(P.in[I_NMIX] + col);
                    if (uu.pn == 0) pool_chunk<2>(xr, rvb, gn, col, t0, dr); else if (uu.pn == 1) pool_chunk<4>(xr, rvb, gn, col, t0, dr);
                    else if (uu.pn == 2) pool_chunk<8>(xr, rvb, gn, col, t0, dr); else pool_chunk<16>(xr, rvb, gn, col, t0, dr);
                } }
            asm volatile("s_waitcnt vmcnt(0)" ::: "memory"); __syncthreads(); }
          EpiH<0> E{P.in[I_XP], P.in[I_XS], P.in[I_POOLSC], nullptr, nullptr, nullptr, hbA, ssq + 0 * SSQ_V};
          pg8::gemm_phase(lds, g, S, E); }
        if (SUBM & 2) { pg8::Gemm g{pb, wproj, MP, D, PLE, PLE, 0}; pg8::StaticOrder S; S.init(MP, D, G, bx);
          EpiBf E{proj, D};
          pg8::gemm_phase(lds, g, S, E); }
        if (SUBM & 4) { pg8::Gemm g{pb + (size_t)M * PLE, wproj + (size_t)PLE * D, MP, D, PLE, PLE, 0}; pg8::StaticOrder S; S.init(MP, D, G, bx);
          EpiBf E{proj + (size_t)M * D, D};
          pg8::gemm_phase(lds, g, S, E); }
    }
    SEAM(2);
    if (IN(3)) {
        { SgUp E{ssq + 0 * SSQ_V, abuf}; for (int u = vcu; u < 256; u += G) sk_gemm_w(lds, hbA + (size_t)(MP + 64 * (u & 15)) * D, D, wup + (size_t)(256 * (u >> 4)) * D, D, 64 * (u & 15), 256 * (u >> 4), E, tid, wave, lane); }
        pg8::Gemm g{hbA, wup, MP, FF, D, D, 0}; pg8::StaticOrder S; S.init(MP, FF, G, bx); EpiUp E{ssq + 0 * SSQ_V, abuf}; pg8::gemm_phase(lds, g, S, E); }
    SEAM(3);
    if (IN(4)) {
        { SgH<1> E{nullptr, nullptr, nullptr, nullptr, hbA, hbB, ssq + 1 * SSQ_V}; for (int u = vcu; u < 256; u += G) sk_gemm(lds, abuf + (size_t)(MP + 64 * (u >> 4)) * FF, FF, wdown + (size_t)(64 * (u & 15)) * FF, FF, 64 * (u >> 4), 64 * (u & 15), u & 15, E, tid, wave, lane); }
        pg8::Gemm g{abuf, wdown, MP, D, FF, FF, 0}; pg8::StaticOrder S; S.init(MP, D, G, bx);
        EpiH<1> E{nullptr, nullptr, nullptr, nullptr, nullptr, hbA, hbB, ssq + 1 * SSQ_V}; pg8::gemm_phase(lds, g, S, E); }
    SEAM(4);
    if (IN(5)) {
        { SgH<2> E{nullptr, nullptr, ssq + 1 * SSQ_V, proj, hbB, hbA, ssq + 2 * SSQ_V}; for (int u = vcu; u < 256; u += G) sk_gemm(lds, hbB + (size_t)(MP + 64 * (u >> 4)) * D, D, wgate + (size_t)(64 * (u & 15)) * D, D, 64 * (u >> 4), 64 * (u & 15), u & 15, E, tid, wave, lane); }
        pg8::Gemm g{hbB, wgate, MP, D, D, D, 0}; pg8::StaticOrder S; S.init(MP, D, G, bx);
        EpiH<2> E{nullptr, nullptr, nullptr, ssq + 1 * SSQ_V, proj, hbB, hbA, ssq + 2 * SSQ_V}; pg8::gemm_phase(lds, g, S, E); }
    SEAM(5);
    if (IN(6)) {
        pg8::Gemm g{hbA, wdkvq, M, NDKVQ, D, D, 0}; pg8::StaticOrder S; S.init(M, NDKVQ, G, bx); EpiDkvq E{ssq + 2 * SSQ_V, cs, craw, cb, cqb, ssqc, ssqq, out, kfull, krbs}; pg8::gemm_phase(lds, g, S, E); }
    SEAM2(6, 8);
    if (IN(8)) {
        if (SUBM & 1) { pg8::Gemm g{cqb, wuq, M, NH * QH, QR, QR, 0}; pg8::StaticOrder S; S.init(M, NH * QH, G, bx); EpiQ E{ssqq, cs, qbuf, qs}; pg8::gemm_phase(lds, g, S, E); }
        if (SUBM & 2) { pg8::Gemm g{cb, wukt, MP, 1024, KVR, KVR, 0}; pg8::StaticOrder S; S.init(MP, 1024, G, (bx + 128) % G); EpiKup E{kfull, ssqc}; pg8::gemm_phase(lds, g, S, E); }
        if (SUBM & 4) { pg8::Gemm g{wuvt, cb, 1024, MP, KVR, KVR, 0}; pg8::StaticOrder S; S.init(1024, MP, G, (bx + 128) % G); EpiVup E{vt, ssqc}; pg8::gemm_phase(lds, g, S, E); }
        { const f32x4 kvn = ((const f32x4*)P.in[I_KVN])[lane];
          for (int row0 = 2 * gw; row0 < M; row0 += 2 * NGW) {
              f32x4 c4[2], p4[2];
#pragma unroll
              for (int e = 0; e < 2; ++e) { c4[e] = ((const f32x4*)(craw + (size_t)(row0 + e) * KVR))[lane]; p4[e] = *(const f32x4*)(ssqc + (size_t)(row0 + e) * 4); }
#pragma unroll
              for (int e = 0; e < 2; ++e) { const int row = row0 + e; const bool isp = row < MP;
                  const float rc = 1.0f / sqrtf(((p4[e].x + p4[e].y) + (p4[e].z + p4[e].w)) * (1.0f / KVR) + EPS);
                  const f32x4 cn = c4[e] * rc * kvn;
                  float* lo_ = isp ? out + O_LP + (size_t)row * KVR : out + O_LS + (size_t)(row - MP) * KVR;
                  ((f32x4*)lo_)[lane] = cn;
                  if (!isp) { u32x2 o; o.x = pk2(cn.x, cn.y); o.y = pk2(cn.z, cn.w); ((u32x2*)(cb + (size_t)row * KVR))[lane] = o; } } } }
    }
    SEAM2(8, 10);
    if (IN(10)) {
        const bool sfirst = (bx >> 3) & 1;
        if (sfirst) for (int it = vcu; it < 2 * DB; it += G) sattn_item(P, it >> 1, it & 1, lds, tid, wave, lane);
        for (int u = vcu; u < 256; u += G) {
            const int bh = u >> 4, p = u & 15;
            attn_prompt_unit(qbuf, kfull, vt, obuf, bh >> 3, bh & 7, 31 - p, lds, tid, wave, lane);
            attn_prompt_unit(qbuf, kfull, vt, obuf, bh >> 3, bh & 7, p, lds, tid, wave, lane);
        }
        if (!sfirst) for (int it = vcu; it < 2 * DB; it += G) sattn_item(P, it >> 1, it & 1, lds, tid, wave, lane);
    }
    SEAM2(10, 12);
    if (IN(12)) {
        { SgH<1> E{nullptr, nullptr, nullptr, nullptr, hbA, hbB, ssq + 3 * SSQ_V};
          for (int u = vcu; u < 256; u += G) sk_gemm(lds, obuf + (size_t)(MP + 64 * (u >> 4)) * D, D, wo + (size_t)(64 * (u & 15)) * D, D, 64 * (u >> 4), 64 * (u & 15), u & 15, E, tid, wave, lane); }
        pg8::Gemm g{obuf, wo, MP, D, D, D, 0}; pg8::StaticOrder S; S.init(MP, D, G, bx);
        EpiH<1> E{nullptr, nullptr, nullptr, nullptr, nullptr, hbA, hbB, ssq + 3 * SSQ_V}; pg8::gemm_phase(lds, g, S, E); }
    SEAM(12);
    if (IN(13)) {
        { SgUp E{ssq + 3 * SSQ_V, abuf}; for (int u = vcu; u < 256; u += G) sk_gemm_w(lds, hbB + (size_t)(MP + 64 * (u & 15)) * D, D, wup + (size_t)FF * D + (size_t)(256 * (u >> 4)) * D, D, 64 * (u & 15), 256 * (u >> 4), E, tid, wave, lane); }
        pg8::Gemm g{hbB, wup + (size_t)FF * D, MP, FF, D, D, 0}; pg8::StaticOrder S; S.init(MP, FF, G, bx); EpiUp E{ssq + 3 * SSQ_V, abuf}; pg8::gemm_phase(lds, g, S, E); }
    SEAM(13);
    if (IN(14)) {
        { SgH<1> E{nullptr, nullptr, nullptr, nullptr, hbB, hbA, ssq + 4 * SSQ_V}; for (int u = vcu; u < 256; u += G) sk_gemm(lds, abuf + (size_t)(MP + 64 * (u >> 4)) * FF, FF, wdown + (size_t)FF * D + (size_t)(64 * (u & 15)) * FF, FF, 64 * (u >> 4), 64 * (u & 15), u & 15, E, tid, wave, lane); }
        pg8::Gemm g{abuf, wdown + (size_t)FF * D, MP, D, FF, FF, 0}; pg8::StaticOrder S; S.init(MP, D, G, bx);
        EpiH<1> E{nullptr, nullptr, nullptr, nullptr, nullptr, hbB, hbA, ssq + 4 * SSQ_V}; pg8::gemm_phase(lds, g, S, E); }
    SEAM(14);
    if (IN(15)) {
        { SgH<2> E{nullptr, nullptr, ssq + 4 * SSQ_V, proj + (size_t)M * D, hbA, hbB, ssq + 5 * SSQ_V}; for (int u = vcu; u < 256; u += G) sk_gemm(lds, hbA + (size_t)(MP + 64 * (u >> 4)) * D, D, wgate + (size_t)D * D + (size_t)(64 * (u & 15)) * D, D, 64 * (u >> 4), 64 * (u & 15), u & 15, E, tid, wave, lane); }
        pg8::Gemm g{hbA, wgate + (size_t)D * D, MP, D, D, D, 0}; pg8::StaticOrder S; S.init(MP, D, G, bx);
        EpiH<2> E{nullptr, nullptr, nullptr, ssq + 4 * SSQ_V, proj + (size_t)M * D, hbA, hbB, ssq + 5 * SSQ_V}; pg8::gemm_phase(lds, g, S, E); }
    SEAM(15);
    if (IN(16)) {
        f32x4 gn[4];
#pragma unroll
        for (int j = 0; j < 4; ++j) gn[j] = ((const f32x4*)P.in[I_NFIN])[lane + 64 * j];
        for (int row0 = 4 * gw; row0 < M; row0 += 4 * NGW) {
            u32x2 hv[4][4]; float sp[4];
#pragma unroll
            for (int e = 0; e < 4; ++e) { sp[e] = (lane < 16) ? ssq[5 * SSQ_V + (size_t)(row0 + e) * 16 + lane] : 0.f;
#pragma unroll
                for (int j = 0; j < 4; ++j) hv[e][j] = ((const u32x2*)(hbB + (size_t)(row0 + e) * D))[lane + 64 * j]; }
#pragma unroll
            for (int e = 0; e < 4; ++e) { const float rstd = 1.0f / sqrtf(wave_sum(sp[e]) * (1.0f / D) + EPS);
#pragma unroll
                for (int j = 0; j < 4; ++j) ((f32x4*)(out + O_Y + (size_t)(row0 + e) * D))[lane + 64 * j] = unpk4(hv[e][j]) * rstd * gn[j]; }
        }
    }
#undef IN
#undef SEAM
#undef SEAM2
#undef wpool
#undef wup
#undef wdown
#undef wgate
#undef wproj
#undef wdkvq
#undef wuq
#undef wukt
#undef wuvt
#undef wukb
#undef wo
#undef cs
#undef rstd0
#undef dbuf
#undef pb
#undef hbA
#undef hbB
#undef ssq
#undef abuf
#undef proj
#undef craw
#undef ssqc
#undef ssqq
#undef cb
#undef krbs
#undef cqb
#undef qbuf
#undef qs
#undef kfull
#undef vt
#undef obuf
}

extern "C" void kernel_launch(void* const* d_in, const int* in_sizes, int n_in, void* d_out, int out_size, void* d_ws, size_t ws_size, hipStream_t stream) {
    static int grid = 0;
    if (grid == 0) {
        if (n_in != 27 || (size_t)out_size != O_END || ws_size < WS_END) { fprintf(stderr, "kernel_launch: shape mismatch (n_in %d, out %d, ws %zu; need 27, %zu, %zu)\n", n_in, out_size, ws_size, (size_t)O_END, (size_t)WS_END); grid = -1; return; }
        int dev = 0, cus = 0, per_cu = 0;
        if (hipGetDevice(&dev) != hipSuccess || hipDeviceGetAttribute(&cus, hipDeviceAttributeMultiprocessorCount, dev) != hipSuccess) { grid = -1; return; }
        if (hipFuncSetAttribute((const void*)yoco_fwd, hipFuncAttributeMaxDynamicSharedMemorySize, LDS_BYTES) != hipSuccess) { fprintf(stderr, "kernel_launch: hipFuncSetAttribute failed\n"); grid = -1; return; }
        if (hipOccupancyMaxActiveBlocksPerMultiprocessor(&per_cu, (const void*)yoco_fwd, 512, LDS_BYTES) != hipSuccess || per_cu < 1) fprintf(stderr, "kernel_launch: occupancy query reports %d\n", per_cu);
        (void)hipGetLastError();
        grid = cus;
    }
    if (grid < 0) return;
    (void)hipMemsetAsync((char*)d_ws + WS_CTL, 0, CTL_BYTES, stream);
    Params p{};
    for (int i = 0; i < 27; ++i) p.in[i] = (const float*)d_in[i];
    p.out = (float*)d_out; p.ws = (unsigned char*)d_ws;
#if MK_N_LAUNCHES == 1
    p.ph_lo = 0; p.ph_hi = NPH;
    hipLaunchKernelGGL(yoco_fwd, dim3(grid), dim3(512), LDS_BYTES, stream, p);
#else
    for (int k = 0; k < NPH; ++k) { p.ph_lo = k; p.ph_hi = k + 1; hipLaunchKernelGGL(yoco_fwd, dim3(grid), dim3(512), LDS_BYTES, stream, p); }
#endif
    const hipError_t le = hipPeekAtLastError();
    if (le != hipSuccess) fprintf(stderr, "kernel_launch: launch failed: %s\n", hipGetErrorName(le));
}
```

```cpp
#include <hip/hip_runtime.h>
#include <cstdio>
#include <cstdint>

#ifndef MK_N_LAUNCHES
#define MK_N_LAUNCHES 1
#endif

#define GAS __attribute__((address_space(1)))
#define LAS __attribute__((address_space(3)))
typedef unsigned short bf16_t;
typedef short bf16x8 __attribute__((ext_vector_type(8)));
typedef float f32x4 __attribute__((ext_vector_type(4)));
typedef float f32x16 __attribute__((ext_vector_type(16)));
typedef unsigned u32x2 __attribute__((ext_vector_type(2)));
typedef unsigned u32x4 __attribute__((ext_vector_type(4)));

constexpr int D = 1024, FF = 4096, PLE = 256, SEQ = 8192, NBATCH = 2, DB = 128, DS = 8;
constexpr int MP = NBATCH * SEQ;
constexpr int MS = DB * DS;
constexpr int M = MP + MS;
constexpr int KVR = 256, ROPE = 64, QR = 384, NH = 8, NOPE = 128, VD = 128, QH = NOPE + ROPE;
constexpr int NDKVQ = 768;
constexpr int PAST = 8192, PAGE = 128, NPG = PAST / PAGE;
constexpr float EPS = 1e-6f;
constexpr float SM_SCALE = 0.07216878364870322f;
constexpr float LOG2E = 1.4426950408889634f;
constexpr float CEXP = SM_SCALE * LOG2E;
constexpr int NPOS = PAST + DS;

constexpr size_t O_Y = 0;
constexpr size_t O_PP = (size_t)M * D;
constexpr size_t O_PS = O_PP + (size_t)NBATCH * 15 * D;
constexpr size_t O_LP = O_PS + (size_t)DB * 15 * D;
constexpr size_t O_KP = O_LP + (size_t)MP * KVR;
constexpr size_t O_LS = O_KP + (size_t)MP * ROPE;
constexpr size_t O_KS = O_LS + (size_t)MS * KVR;
constexpr size_t O_END = O_KS + (size_t)MS * ROPE;

constexpr size_t al256(size_t x) { return (x + 255) / 256 * 256; }
constexpr size_t WS_CTL = 0, CTL_BYTES = 1u << 20;
constexpr size_t WS_WPOOL = CTL_BYTES;
constexpr size_t WS_WUP   = WS_WPOOL + al256((size_t)1024 * 256 * 2);
constexpr size_t WS_WDOWN = WS_WUP   + al256((size_t)2 * FF * D * 2);
constexpr size_t WS_WGATE = WS_WDOWN + al256((size_t)2 * FF * D * 2);
constexpr size_t WS_WPROJ = WS_WGATE + al256((size_t)2 * D * D * 2);
constexpr size_t WS_WDKVQ = WS_WPROJ + al256((size_t)2 * D * PLE * 2);
constexpr size_t WS_WUQ   = WS_WDKVQ + al256((size_t)NDKVQ * D * 2);
constexpr size_t WS_WUKT  = WS_WUQ   + al256((size_t)NH * QH * QR * 2);
constexpr size_t WS_WUVT  = WS_WUKT  + al256((size_t)1024 * 256 * 2);
constexpr size_t WS_WUVP  = WS_WUVT  + al256((size_t)1024 * 256 * 2);
constexpr size_t WS_WUKB  = WS_WUVP  + al256((size_t)1024 * 256 * 2);
constexpr size_t WS_WO    = WS_WUKB  + al256((size_t)1024 * 256 * 2);
constexpr size_t WS_CS    = WS_WO    + al256((size_t)D * D * 2);
constexpr size_t WS_RSTD0 = WS_CS    + al256((size_t)NPOS * 64 * 4);
constexpr size_t WS_DBUF  = WS_RSTD0 + al256((size_t)M * 4);
constexpr size_t WS_PB    = WS_DBUF  + al256((size_t)M * D * 2);
constexpr size_t WS_HBA   = WS_PB    + al256((size_t)2 * M * PLE * 2);
constexpr size_t WS_HBB   = WS_HBA   + al256((size_t)M * D * 2);
constexpr size_t WS_SSQ   = WS_HBB   + al256((size_t)M * D * 2);
constexpr size_t WS_ABUF  = WS_SSQ   + al256((size_t)6 * M * 16 * 4);
constexpr size_t WS_PROJ  = WS_ABUF  + al256((size_t)M * FF * 2);
constexpr size_t WS_RAW   = WS_PROJ  + al256((size_t)2 * M * D * 2);
constexpr size_t WS_CB    = WS_RAW   + al256((size_t)M * NDKVQ * 4);
constexpr size_t WS_KRBS  = WS_CB    + al256((size_t)M * KVR * 2);
constexpr size_t WS_CQB   = WS_KRBS  + al256((size_t)MS * ROPE * 2);
constexpr size_t WS_RSTDQ = WS_CQB   + al256((size_t)M * QR * 2);
constexpr size_t WS_QBUF  = WS_RSTDQ + al256((size_t)M * 4);
constexpr size_t WS_QS    = WS_QBUF  + al256((size_t)M * NH * QH * 2);
constexpr size_t WS_KFULL = WS_QS    + al256((size_t)MS * NH * 320 * 2);
constexpr size_t WS_VT    = WS_KFULL + al256((size_t)16 * SEQ * QH * 2);
constexpr size_t WS_OBUF  = WS_VT    + al256((size_t)16 * VD * SEQ * 2);
constexpr size_t WS_PART  = WS_OBUF  + al256((size_t)M * D * 2);
constexpr size_t WS_ML    = WS_PART  + al256((size_t)DB * 8 * 64 * 256 * 4);
constexpr size_t WS_END   = WS_ML    + al256((size_t)DB * 8 * 64 * 2 * 4);

constexpr int CW_BAR = 4096;
constexpr int CW_SCNT = 16384;

constexpr int RING_BYTES = 131072;
constexpr int LDS_BYTES = 147456;
constexpr int MISC_OFF = LDS_BYTES - 256;

typedef float f32x2 __attribute__((ext_vector_type(2)));
typedef __bf16 nbf16x2 __attribute__((ext_vector_type(2)));
__device__ __forceinline__ unsigned pk2(float lo, float hi) { const f32x2 v = {lo, hi}; return __builtin_bit_cast(unsigned, __builtin_convertvector(v, nbf16x2)); }
__device__ __forceinline__ unsigned f2bf(float f) { return pk2(f, 0.f) & 0xffffu; }
__device__ __forceinline__ float bf2f(unsigned short b) { return __builtin_bit_cast(float, ((unsigned)b) << 16); }
__device__ __forceinline__ f32x4 unpk4(u32x2 w) { f32x4 r; r.x = __builtin_bit_cast(float, w.x << 16); r.y = __builtin_bit_cast(float, w.x & 0xffff0000u); r.z = __builtin_bit_cast(float, w.y << 16); r.w = __builtin_bit_cast(float, w.y & 0xffff0000u); return r; }
__device__ __forceinline__ bf16x8 pack8(const float* v) { u32x4 w; w.x = pk2(v[0], v[1]); w.y = pk2(v[2], v[3]); w.z = pk2(v[4], v[5]); w.w = pk2(v[6], v[7]); return __builtin_bit_cast(bf16x8, w); }
__device__ __forceinline__ bf16x8 pack8v(f32x4 a, f32x4 b) { u32x4 w; w.x = pk2(a.x, a.y); w.y = pk2(a.z, a.w); w.z = pk2(b.x, b.y); w.w = pk2(b.z, b.w); return __builtin_bit_cast(bf16x8, w); }
__device__ __forceinline__ float wave_sum(float v) {
#pragma unroll
    for (int o = 1; o < 64; o <<= 1) v += __shfl_xor(v, o);
    return v;
}
__device__ __forceinline__ int crow(int r, int hi) { return (r & 3) + 8 * (r >> 2) + 4 * hi; }
#define LDS_WAIT() asm volatile("s_waitcnt lgkmcnt(0)" ::: "memory")
#define VM_WAIT() asm volatile("s_waitcnt vmcnt(0)" ::: "memory")

#define XB_TMO      128
#define XB_XCNT(j)  (256  + 64 * (j))
#define XB_XSUB(j)  (1280 + 64 * (j))
#define XB_XGEN(j)  (2304 + 64 * (j))
#define XB_TOP      3328
#define XB_TOPGEN   3392
#define XCD_BAR_WORDS 3456
#define XB_SPIN_CAP (1u << 18)
__device__ __forceinline__ unsigned xb_ld(unsigned* p)              { return __hip_atomic_load(p, __ATOMIC_RELAXED, __HIP_MEMORY_SCOPE_AGENT); }
__device__ __forceinline__ unsigned xb_add(unsigned* p, unsigned v) { return __hip_atomic_fetch_add(p, v, __ATOMIC_RELAXED, __HIP_MEMORY_SCOPE_AGENT); }
__device__ __forceinline__ unsigned xb_xcc_id() { return (unsigned)__builtin_amdgcn_s_getreg((3 << 11) | 20) & 0xFu; }
#define XB_SPIN(cond, bar) do { unsigned _sp = 0; while (cond) { __builtin_amdgcn_s_sleep(1); \
    if ((++_sp & 255u) == 0u) { if (xb_ld(&(bar)[XB_TMO])) break; if (_sp > XB_SPIN_CAP) { atomicAdd(&(bar)[XB_TMO], 1u); break; } } } } while (0)
struct XcdBarrier { unsigned* bar; unsigned x; volatile LAS unsigned* st; };
__device__ __forceinline__ XcdBarrier xcd_barrier_post(unsigned* bar, volatile LAS unsigned* st) {
    XcdBarrier b; b.bar = bar; b.x = xb_xcc_id(); b.st = st;
    if (threadIdx.x == 0) (void)xb_add(&bar[XB_XCNT(b.x)], 1u);
    return b;
}
__device__ __forceinline__ void xcd_barrier_complete(unsigned* bar, unsigned x, unsigned& nloc, unsigned& nx) {
    const unsigned G = gridDim.x * gridDim.y * gridDim.z;
    unsigned sum, cnt, mine, sp = 0u;
    for (;;) {
        sum = 0u; cnt = 0u; mine = 0u;
#pragma unroll
        for (unsigned j = 0; j < 16; ++j) { const unsigned c = xb_ld(&bar[XB_XCNT(j)]); sum += c; cnt += (c > 0u) ? 1u : 0u; mine = (j == x) ? c : mine; }
        if (sum == G) break;
        __builtin_amdgcn_s_sleep(1);
        if ((++sp & 255u) == 0u) { if (xb_ld(&bar[XB_TMO])) break; if (sp > XB_SPIN_CAP) { atomicAdd(&bar[XB_TMO], 1u); break; } }
    }
    nloc = mine > 0u ? mine : 1u; nx = cnt > 0u ? cnt : 1u;
}
__device__ __forceinline__ void xcd_barrier(const XcdBarrier& b) {
    asm volatile("s_waitcnt vmcnt(0)" ::: "memory");
    __syncthreads();
    if (threadIdx.x == 0) {
        unsigned* bar = b.bar;
        __builtin_amdgcn_s_waitcnt(0);
        unsigned nloc = b.st[0], nx = b.st[1];
        if (nloc == 0u) { xcd_barrier_complete(bar, b.x, nloc, nx); b.st[0] = nloc; b.st[1] = nx; }
        const unsigned old = xb_add(&bar[XB_XSUB(b.x)], 1u);
        const unsigned gen = old / nloc;
        if (old + 1u == (gen + 1u) * nloc) {
            __builtin_amdgcn_fence(__ATOMIC_RELEASE, "agent");
            asm volatile("s_waitcnt vmcnt(0)" ::: "memory");
            const unsigned og = xb_add(&bar[XB_TOP], 1u);
            const unsigned tg = og / nx;
            if (og + 1u == (tg + 1u) * nx) xb_add(&bar[XB_TOPGEN], 1u);
            else XB_SPIN(xb_ld(&bar[XB_TOPGEN]) == tg, bar);
            __builtin_amdgcn_fence(__ATOMIC_ACQUIRE, "agent");
            xb_add(&bar[XB_XGEN(b.x)], 1u);
            asm volatile("s_waitcnt vmcnt(0)" ::: "memory");
        } else {
            XB_SPIN(xb_ld(&bar[XB_XGEN(b.x)]) == gen, bar);
            __builtin_amdgcn_fence(__ATOMIC_ACQUIRE, "agent");
            asm volatile("s_waitcnt vmcnt(0)" ::: "memory");
        }
    }
    __syncthreads();
}

namespace pg8 {
constexpr int BM = 256, BK = 64, HALF = 128, HTB = HALF * BK * 2, STAGE_BYTES = 8 * HTB, NXCD = 8, WGM = 8;
__host__ __device__ __forceinline__ int lds_byte(int r, int c) { const int st = (r >> 4) * 2 + (c >> 5), rr = r & 15, cc = c & 31, ob = rr * 64 + cc * 2; return st * 1024 + (ob ^ (((ob >> 9) & 1) << 5)); }
__host__ __device__ __forceinline__ int perm32(int rho) { const int n = rho >> 4, i = rho & 15; return 8 * (i >> 2) + 4 * n + (i & 3); }
__host__ __device__ __forceinline__ void stage_rc(int b, int& R, int& C) { const int st = b / 1024, sb = b % 1024, swz = sb ^ (((sb >> 9) & 1) << 5); R = (st >> 1) * 16 + swz / 64; C = (st & 1) * 32 + (swz % 64) / 2; }
struct Unit { int pm, pn; };
struct Gemm { const bf16_t* A; const bf16_t* Bt; int M, N, K, lda, apn; };
struct StaticOrder {
    int nM, nN, nwg, G, c;
    __device__ __forceinline__ void init(int M, int N, int G_, int c_) { nM = M / BM; nN = N / BM; nwg = nM * nN; G = G_; c = c_; }
    __device__ __forceinline__ bool next(int i, Unit& u) const {
        const long L = (long)i * G + c; if (L >= nwg) return false;
        int wgid = (int)L; { const int q = nwg / NXCD, r = nwg % NXCD, xcd = wgid % NXCD, off = wgid / NXCD; wgid = (xcd < r ? xcd * (q + 1) : r * (q + 1) + (xcd - r) * q) + off; }
        const int nig = WGM * nN, gid = wgid / nig, fm = gid * WGM, gsz = (nM - fm) < WGM ? (nM - fm) : WGM;
        u.pm = fm + ((wgid % nig) % gsz); u.pn = (wgid % nig) / gsz; return true;
    }
};
template <class Epi>
__device__ __forceinline__ void gemm_phase(LAS unsigned char* lds, const Gemm g, const StaticOrder& S, const Epi& E) {
    const int tid = threadIdx.x, wid = __builtin_amdgcn_readfirstlane(tid >> 6), lane = tid & 63, wr = wid >> 2, wc = wid & 3, fr = lane & 15, fq = lane >> 4;
    const int K = g.K, nt = K / BK, lda = g.lda;
    unsigned voffA[2], voffB[2];
#pragma unroll
    for (int i = 0; i < 2; ++i) { int R, C; stage_rc(tid * 16 + i * 8192, R, C);
        const int Rb = Epi::PERM ? ((R & ~31) + perm32(R & 31)) : R;
        voffA[i] = (unsigned)(R * lda + C) * 2u; voffB[i] = (unsigned)(Rb * K + C) * 2u; }
    const size_t kstep = (size_t)(BK * 2);
    const size_t hstepA = (size_t)HALF * lda * 2, hstepB = (size_t)HALF * K * 2;
    const size_t tstepA = 2 * hstepA, tstepB = 2 * hstepB, pnA = (size_t)g.apn * 2;
    const unsigned ldsw = (unsigned)wid * 1024u;
    const int aoff = lds_byte(wr * 64 + fr, fq * 8), boff = lds_byte(wc * 32 + fr, fq * 8);
#define PG8_SA(b, h) (((b) * 2 + (h)) * HTB)
#define PG8_SB(b, h) ((4 + (b) * 2 + (h)) * HTB)
#define PG8_STAGE(bufoff, gbase, voff) do { _Pragma("unroll") for (int _i = 0; _i < 2; ++_i) \
        __builtin_amdgcn_global_load_lds((const unsigned*)((const char*)(gbase) + (voff)[_i]), (LAS unsigned*)(lds + (bufoff) + ldsw + _i * 8192), 16, 0, 0); } while (0)
#define PG8_LDA(dst, b, h) do { _Pragma("unroll") for (int m = 0; m < 4; ++m) _Pragma("unroll") for (int k = 0; k < 2; ++k) dst[m][k] = *(const LAS bf16x8*)(lds + PG8_SA(b, h) + aoff + m * 2048 + k * 1024); } while (0)
#define PG8_LDB(dst, b, h) do { _Pragma("unroll") for (int n = 0; n < 2; ++n) _Pragma("unroll") for (int k = 0; k < 2; ++k) dst[n][k] = *(const LAS bf16x8*)(lds + PG8_SB(b, h) + boff + n * 2048 + k * 1024); } while (0)
#define PG8_MMA(ai, bj, At, Bt) do { __builtin_amdgcn_s_setprio(1); _Pragma("unroll") for (int m = 0; m < 4; ++m) _Pragma("unroll") for (int n = 0; n < 2; ++n) _Pragma("unroll") for (int k = 0; k < 2; ++k) \
        acc[ai][bj][m][n] = __builtin_amdgcn_mfma_f32_16x16x32_bf16(Bt[n][k], At[m][k], acc[ai][bj][m][n], 0, 0, 0); __builtin_amdgcn_s_setprio(0); } while (0)
#define PG8_WAIT_V(n) asm volatile("s_waitcnt vmcnt(" #n ")" ::: "memory")
#define PG8_WAIT_L(n) asm volatile("s_waitcnt lgkmcnt(" #n ")" ::: "memory")
#define PG8_BAR __builtin_amdgcn_s_barrier()
#define PG8_SCHED __builtin_amdgcn_sched_barrier(0)
    Unit cur, nxt; int ui = 0;
    if (!S.next(0, cur)) return;
    f32x4 acc[2][2][4][2];
#pragma unroll
    for (int a = 0; a < 2; ++a)
#pragma unroll
        for (int b = 0; b < 2; ++b)
#pragma unroll
            for (int m = 0; m < 4; ++m)
#pragma unroll
                for (int n = 0; n < 2; ++n) acc[a][b][m][n] = (f32x4){0.f, 0.f, 0.f, 0.f};
    bf16x8 At[4][2], B0[2][2], B1[2][2];
    const char* cA = (const char*)g.A + (size_t)cur.pm * tstepA + (size_t)cur.pn * pnA; const char* cB = (const char*)g.Bt + (size_t)cur.pn * tstepB;
    PG8_STAGE(PG8_SB(0, 0), cB, voffB); PG8_STAGE(PG8_SB(0, 1), cB + hstepB, voffB); PG8_STAGE(PG8_SA(0, 0), cA, voffA); PG8_STAGE(PG8_SA(0, 1), cA + hstepA, voffA);
    if (wr == 1) PG8_BAR;
    PG8_WAIT_V(2); PG8_BAR;
    PG8_STAGE(PG8_SB(1, 0), cB + kstep, voffB); PG8_STAGE(PG8_SA(1, 0), cA + kstep, voffA); PG8_STAGE(PG8_SB(1, 1), cB + hstepB + kstep, voffB);
    PG8_WAIT_V(6); PG8_BAR;
    for (;;) {
        const bool has_next = S.next(ui + 1, nxt);
        const char* nA = has_next ? (const char*)g.A + (size_t)nxt.pm * tstepA + (size_t)nxt.pn * pnA : cA; const char* nB = has_next ? (const char*)g.Bt + (size_t)nxt.pn * tstepB : cB;
#pragma unroll 1
        for (int t = 0; t < nt; t += 2) {
            const bool last = (t == nt - 2);
            const char* a1 = cA + (size_t)(t + 1) * kstep;
            const char* a2 = last ? nA : cA + (size_t)(t + 2) * kstep; const char* b2 = last ? nB : cB + (size_t)(t + 2) * kstep;
            const char* a3 = a2 + kstep; const char* b3 = b2 + kstep;
            PG8_LDB(B0, 0, 0); PG8_LDB(B1, 0, 1); PG8_SCHED; PG8_LDA(At, 0, 0); PG8_STAGE(PG8_SA(1, 1), a1 + hstepA, voffA);
            PG8_WAIT_V(8); PG8_WAIT_L(0); PG8_BAR; PG8_MMA(0, 0, At, B0); PG8_MMA(0, 1, At, B1); PG8_BAR; PG8_SCHED;
            PG8_LDA(At, 0, 1); PG8_STAGE(PG8_SB(0, 0), b2, voffB); PG8_STAGE(PG8_SB(0, 1), b2 + hstepB, voffB); PG8_STAGE(PG8_SA(0, 0), a2, voffA);
            PG8_WAIT_V(8); PG8_WAIT_L(0); PG8_BAR; PG8_MMA(1, 0, At, B0); PG8_MMA(1, 1, At, B1); PG8_BAR; PG8_SCHED;
            PG8_LDB(B0, 1, 0); PG8_LDB(B1, 1, 1); PG8_SCHED; PG8_LDA(At, 1, 0); PG8_STAGE(PG8_SA(0, 1), a2 + hstepA, voffA);
            PG8_WAIT_V(8); PG8_WAIT_L(0); PG8_BAR; PG8_MMA(0, 0, At, B0); PG8_MMA(0, 1, At, B1); PG8_BAR; PG8_SCHED;
            PG8_LDA(At, 1, 1); PG8_STAGE(PG8_SB(1, 0), b3, voffB); PG8_STAGE(PG8_SB(1, 1), b3 + hstepB, voffB); PG8_STAGE(PG8_SA(1, 0), a3, voffA);
            PG8_WAIT_V(8); PG8_WAIT_L(0); PG8_BAR; PG8_MMA(1, 0, At, B0); PG8_MMA(1, 1, At, B1); PG8_BAR; PG8_SCHED;
        }
        if (wr == 0) PG8_BAR;
        E(acc, cur, wr, wc, fr, fq);
        if (!has_next) break;
#pragma unroll
        for (int a = 0; a < 2; ++a)
#pragma unroll
            for (int b = 0; b < 2; ++b)
#pragma unroll
                for (int m = 0; m < 4; ++m)
#pragma unroll
                    for (int n = 0; n < 2; ++n) acc[a][b][m][n] = (f32x4){0.f, 0.f, 0.f, 0.f};
        cur = nxt; cA = nA; cB = nB; ++ui;
        if (wr == 1) PG8_BAR;
    }
    PG8_WAIT_V(0);
    PG8_BAR;
#undef PG8_SA
#undef PG8_SB
#undef PG8_STAGE
#undef PG8_LDA
#undef PG8_LDB
#undef PG8_MMA
#undef PG8_WAIT_V
#undef PG8_WAIT_L
#undef PG8_BAR
#undef PG8_SCHED
}
}

struct Params { const float* in[27]; float* out; unsigned char* ws; int ph_lo, ph_hi; };
enum { I_XP = 0, I_XS, I_PP, I_PS, I_SPOOL, I_CLAT, I_CKR, I_PT, I_NMIX, I_NMLP, I_NPLE, I_POOLW, I_POOLSC, I_NKV, I_WDKV, I_KVN, I_WUK, I_WUV, I_WDQ, I_QN, I_WUQ, I_WO, I_WUP, I_WDOWN, I_WGATE, I_WPROJ, I_NFIN };

__device__ __forceinline__ void load_rstd(const float* ssq, const pg8::Unit& u, int wr, int fr, int fq, float (&rs)[2][4]) {
#pragma unroll
    for (int ai = 0; ai < 2; ++ai)
#pragma unroll
        for (int m = 0; m < 4; ++m) {
            const int row = u.pm * 256 + ai * 128 + wr * 64 + m * 16 + fr;
            const f32x4 a = ((const f32x4*)(ssq + (size_t)row * 16))[fq];
            float t = (a.x + a.y) + (a.z + a.w);
            t += __shfl_xor(t, 16); t += __shfl_xor(t, 32);
            rs[ai][m] = 1.0f / sqrtf(t * (1.0f / 1024.0f) + EPS);
        }
}
template <int NS> __device__ __forceinline__ void load_rstd_p(const float* ssqp, float inv_n, const pg8::Unit& u, int wr, int fr, int fq, float (&rs)[2][4]) {
#pragma unroll
    for (int ai = 0; ai < 2; ++ai)
#pragma unroll
        for (int m = 0; m < 4; ++m) {
            const int row = u.pm * 256 + ai * 128 + wr * 64 + m * 16 + fr;
            float t;
            if (NS == 4) t = ssqp[(size_t)row * 4 + fq]; else { const f32x2 a = ((const f32x2*)(ssqp + (size_t)row * 8))[fq]; t = a.x + a.y; }
            t += __shfl_xor(t, 16); t += __shfl_xor(t, 32);
            rs[ai][m] = 1.0f / sqrtf(t * inv_n + EPS);
        }
}
template <int MODE> struct EpiH {
    static constexpr bool PERM = true;
    const float* xp; const float* xs; const float* scale; const float* ssq_in; const bf16_t* proj;
    const bf16_t* hb_in; bf16_t* hb; float* ssq_out;
    __device__ __forceinline__ void operator()(const f32x4 (&acc)[2][2][4][2], const pg8::Unit& u, int wr, int wc, int fr_in, int fq_in) const {
        int fr = fr_in, fq = fq_in; asm volatile("" : "+v"(fr), "+v"(fq));
        float rs[2][4];
        if (MODE == 2) load_rstd(ssq_in, u, wr, fr, fq, rs);
        const int col0 = u.pn * 256 + wc * 32 + 8 * fq;
#pragma unroll
        for (int ai = 0; ai < 2; ++ai)
#pragma unroll
            for (int m = 0; m < 4; ++m) {
                const int row = u.pm * 256 + ai * 128 + wr * 64 + m * 16 + fr;
                float sq = 0.f;
#pragma unroll
                for (int bj = 0; bj < 2; ++bj) {
                    const int col = col0 + bj * 128;
                    f32x4 b0, b1;
                    if (MODE == 0) { const float* xr = (row < MP ? xp + (size_t)row * D : xs + (size_t)(row - MP) * D) + col; b0 = *(const f32x4*)xr; b1 = *(const f32x4*)(xr + 4); }
                    else { const u32x4 hv = *(const u32x4*)(hb_in + (size_t)row * D + col); b0 = unpk4((u32x2){hv.x, hv.y}); b1 = unpk4((u32x2){hv.z, hv.w}); }
                    const f32x4 a0 = acc[ai][bj][m][0], a1 = acc[ai][bj][m][1]; f32x4 o0, o1;
                    if (MODE == 0) { o0 = b0 + *(const f32x4*)(scale + col) * a0; o1 = b1 + *(const f32x4*)(scale + col + 4) * a1; }
                    else if (MODE == 1) { o0 = b0 + a0; o1 = b1 + a1; }
                    else { const u32x4 pv = *(const u32x4*)(proj + (size_t)row * D + col); const f32x4 p0 = unpk4((u32x2){pv.x, pv.y}), p1 = unpk4((u32x2){pv.z, pv.w}); const float r = rs[ai][m];
                        f32x4 g0, g1;
                        g0.x = 1.0f / (1.0f + __expf(-r * a0.x)); g0.y = 1.0f / (1.0f + __expf(-r * a0.y)); g0.z = 1.0f / (1.0f + __expf(-r * a0.z)); g0.w = 1.0f / (1.0f + __expf(-r * a0.w));
                        g1.x = 1.0f / (1.0f + __expf(-r * a1.x)); g1.y = 1.0f / (1.0f + __expf(-r * a1.y)); g1.z = 1.0f / (1.0f + __expf(-r * a1.z)); g1.w = 1.0f / (1.0f + __expf(-r * a1.w));
                        o0 = b0 + g0 * p0; o1 = b1 + g1 * p1; }
                    u32x4 w; w.x = pk2(o0.x, o0.y); w.y = pk2(o0.z, o0.w); w.z = pk2(o1.x, o1.y); w.w = pk2(o1.z, o1.w);
                    *(u32x4*)(hb + (size_t)row * D + col) = w;
                    sq += ((o0.x * o0.x + o0.y * o0.y) + (o0.z * o0.z + o0.w * o0.w)) + ((o1.x * o1.x + o1.y * o1.y) + (o1.z * o1.z + o1.w * o1.w));
                }
                sq += __shfl_xor(sq, 16); sq += __shfl_xor(sq, 32);
                if (fq == 0) ssq_out[(size_t)row * 16 + u.pn * 4 + wc] = sq;
                asm volatile("" ::: "memory");
            }
    }
};
struct EpiUp {
    static constexpr bool PERM = true;
    const float* ssq_in; bf16_t* abuf;
    __device__ __forceinline__ void operator()(const f32x4 (&acc)[2][2][4][2], const pg8::Unit& u, int wr, int wc, int fr_in, int fq_in) const {
        int fr = fr_in, fq = fq_in; asm volatile("" : "+v"(fr), "+v"(fq));
        float rs[2][4]; load_rstd(ssq_in, u, wr, fr, fq, rs);
        const int col0 = u.pn * 256 + wc * 32 + 8 * fq;
#pragma unroll
        for (int ai = 0; ai < 2; ++ai)
#pragma unroll
            for (int m = 0; m < 4; ++m) {
                const int row = u.pm * 256 + ai * 128 + wr * 64 + m * 16 + fr; const float r = rs[ai][m];
#pragma unroll
                for (int bj = 0; bj < 2; ++bj) {
                    f32x4 a = acc[ai][bj][m][0] * r, c = acc[ai][bj][m][1] * r;
                    a.x = fmaxf(a.x, 0.f); a.y = fmaxf(a.y, 0.f); a.z = fmaxf(a.z, 0.f); a.w = fmaxf(a.w, 0.f);
                    c.x = fmaxf(c.x, 0.f); c.y = fmaxf(c.y, 0.f); c.z = fmaxf(c.z, 0.f); c.w = fmaxf(c.w, 0.f);
                    u32x4 w; w.x = pk2(a.x * a.x, a.y * a.y); w.y = pk2(a.z * a.z, a.w * a.w); w.z = pk2(c.x * c.x, c.y * c.y); w.w = pk2(c.z * c.z, c.w * c.w);
                    *(u32x4*)(abuf + (size_t)row * FF + col0 + bj * 128) = w;
                }
            }
    }
};
template <int MODE> struct EpiF32 {
    static constexpr bool PERM = false;
    float* C; int ldc; const float* aux;
    __device__ __forceinline__ void operator()(const f32x4 (&acc)[2][2][4][2], const pg8::Unit& u, int wr, int wc, int fr_in, int fq_in) const {
        int fr = fr_in, fq = fq_in; asm volatile("" : "+v"(fr), "+v"(fq));
        float rs[2][4];
        if (MODE == 1) load_rstd(aux, u, wr, fr, fq, rs);
        const int col0 = u.pn * 256 + wc * 32 + 4 * fq;
#pragma unroll
        for (int ai = 0; ai < 2; ++ai)
#pragma unroll
            for (int m = 0; m < 4; ++m) {
                const int row = u.pm * 256 + ai * 128 + wr * 64 + m * 16 + fr;
                const float r = (MODE == 1) ? rs[ai][m] : (MODE == 2 ? aux[row] : 1.0f);
#pragma unroll
                for (int bj = 0; bj < 2; ++bj)
#pragma unroll
                    for (int n = 0; n < 2; ++n) *(f32x4*)(C + (size_t)row * ldc + col0 + bj * 128 + n * 16) = acc[ai][bj][m][n] * r;
            }
    }
};
struct EpiBf {
    static constexpr bool PERM = true;
    bf16_t* C; int ldc;
    __device__ __forceinline__ void operator()(const f32x4 (&acc)[2][2][4][2], const pg8::Unit& u, int wr, int wc, int fr_in, int fq_in) const {
        int fr = fr_in, fq = fq_in; asm volatile("" : "+v"(fr), "+v"(fq));
        const int col0 = u.pn * 256 + wc * 32 + 8 * fq;
#pragma unroll
        for (int ai = 0; ai < 2; ++ai)
#pragma unroll
            for (int m = 0; m < 4; ++m) {
                const int row = u.pm * 256 + ai * 128 + wr * 64 + m * 16 + fr;
#pragma unroll
                for (int bj = 0; bj < 2; ++bj) { const f32x4 a = acc[ai][bj][m][0], c = acc[ai][bj][m][1]; u32x4 w; w.x = pk2(a.x, a.y); w.y = pk2(a.z, a.w); w.z = pk2(c.x, c.y); w.w = pk2(c.z, c.w);
                    *(u32x4*)(C + (size_t)row * ldc + col0 + bj * 128) = w; }
            }
    }
};
__host__ __device__ __forceinline__ int kperm(int c) { if (c < KVR) return c; const int r = c - KVR, i = r & 31, sec = r >> 5; return KVR + 32 * (i >> 4) + 16 * sec + (i & 15); }
__host__ __device__ __forceinline__ int qperm(int c) { const int e = c % QH; if (e < NOPE) return c; const int r = e - NOPE, i = r & 31, sec = r >> 5; return c - e + NOPE + 32 * (i >> 4) + 16 * sec + (i & 15); }
struct EpiQ {
    static constexpr bool PERM = false;
    const float* ssqq_; const float* cs; bf16_t* qbuf; bf16_t* qs;
    __device__ __forceinline__ void operator()(const f32x4 (&acc)[2][2][4][2], const pg8::Unit& u, int wr, int wc, int fr_in, int fq_in) const {
        int fr = fr_in, fq = fq_in; asm volatile("" : "+v"(fr), "+v"(fq));
        const bool smp = u.pm >= MP / 256;
        float rq[2][4]; load_rstd_p<8>(ssqq_, 1.0f / QR, u, wr, fr, fq, rq);
#pragma unroll
        for (int ai = 0; ai < 2; ++ai)
#pragma unroll
            for (int m = 0; m < 4; ++m) {
                const int row = u.pm * 256 + ai * 128 + wr * 64 + m * 16 + fr; const float r = rq[ai][m]; const int pos = smp ? PAST + ((row - MP) & 7) : (row & (SEQ - 1));
                bf16_t* qrow = qbuf + (size_t)row * (NH * QH);
#pragma unroll
                for (int bj = 0; bj < 2; ++bj) {
                    const int Gi = u.pn * 8 + bj * 4 + wc, hh = Gi / 6, gi = Gi - hh * 6;
                    if (gi < 4) {
#pragma unroll
                        for (int n = 0; n < 2; ++n) { const f32x4 a = acc[ai][bj][m][n] * r; u32x2 w; w.x = pk2(a.x, a.y); w.y = pk2(a.z, a.w);
                            *(u32x2*)(qrow + Gi * 32 + n * 16 + 4 * fq) = w; }
                    } else {
                        const int i0 = 16 * (gi - 4) + 4 * fq;
                        const f32x4 x1 = acc[ai][bj][m][0] * r, x2 = acc[ai][bj][m][1] * r;
                        const f32x4 cn = *(const f32x4*)(cs + (size_t)pos * 64 + i0), sn = *(const f32x4*)(cs + (size_t)pos * 64 + 32 + i0);
                        const f32x4 o1 = x1 * cn - x2 * sn, o2 = x2 * cn + x1 * sn;
                        u32x2 w1, w2; w1.x = pk2(o1.x, o1.y); w1.y = pk2(o1.z, o1.w); w2.x = pk2(o2.x, o2.y); w2.y = pk2(o2.z, o2.w);
                        bf16_t* qd = smp ? qs + ((size_t)(row - MP) * NH + hh) * 320 + KVR : qrow + hh * QH + NOPE;
                        *(u32x2*)(qd + i0) = w1; *(u32x2*)(qd + 32 + i0) = w2;
                    }
                }
                asm volatile("" ::: "memory");
            }
    }
};
struct EpiDkvq {
    static constexpr bool PERM = false;
    const float* ssq_in; const float* cs; float* craw_; bf16_t* cb_; bf16_t* cqb_; float* ssqc_; float* ssqq_; float* out; bf16_t* kfull_; bf16_t* krbs_;
    __device__ __forceinline__ void operator()(const f32x4 (&acc)[2][2][4][2], const pg8::Unit& u, int wr, int wc, int fr_in, int fq_in) const {
        int fr = fr_in, fq = fq_in; asm volatile("" : "+v"(fr), "+v"(fq));
        float rs[2][4]; load_rstd(ssq_in, u, wr, fr, fq, rs);
        const bool smp = u.pm >= MP / 256;
#pragma unroll
        for (int ai = 0; ai < 2; ++ai)
#pragma unroll
            for (int m = 0; m < 4; ++m) {
                const int row = u.pm * 256 + ai * 128 + wr * 64 + m * 16 + fr; const float r = rs[ai][m];
                float sq = 0.f;
                if (u.pn == 0) {
#pragma unroll
                    for (int bj = 0; bj < 2; ++bj)
#pragma unroll
                        for (int n = 0; n < 2; ++n) { const int col = bj * 128 + wc * 32 + n * 16 + 4 * fq; const f32x4 v = acc[ai][bj][m][n] * r;
                            *(f32x4*)(craw_ + (size_t)row * KVR + col) = v; u32x2 w; w.x = pk2(v.x, v.y); w.y = pk2(v.z, v.w); *(u32x2*)(cb_ + (size_t)row * KVR + col) = w;
                            sq += (v.x * v.x + v.y * v.y) + (v.z * v.z + v.w * v.w); }
                    sq += __shfl_xor(sq, 16); sq += __shfl_xor(sq, 32);
                    if (fq == 0) ssqc_[(size_t)row * 4 + wc] = sq;
                } else {
#pragma unroll
                    for (int bj = 0; bj < 2; ++bj) {
                        const int g0 = (u.pn - 1) * 256 + bj * 128 + wc * 32;
                        if (g0 < ROPE) {
                            const int i0 = 16 * (g0 >> 5) + 4 * fq, pos = smp ? PAST + ((row - MP) & 7) : (row & (SEQ - 1));
                            const f32x4 x1 = acc[ai][bj][m][0] * r, x2 = acc[ai][bj][m][1] * r;
                            const f32x4 cn = *(const f32x4*)(cs + (size_t)pos * 64 + i0), sn = *(const f32x4*)(cs + (size_t)pos * 64 + 32 + i0);
                            const f32x4 o1 = x1 * cn - x2 * sn, o2 = x2 * cn + x1 * sn;
                            float* ko = smp ? out + O_KS + (size_t)(row - MP) * ROPE : out + O_KP + (size_t)row * ROPE;
                            *(f32x4*)(ko + i0) = o1; *(f32x4*)(ko + 32 + i0) = o2;
                            u32x2 w1, w2; w1.x = pk2(o1.x, o1.y); w1.y = pk2(o1.z, o1.w); w2.x = pk2(o2.x, o2.y); w2.y = pk2(o2.z, o2.w);
                            if (smp) { bf16_t* kd = krbs_ + (size_t)(row - MP) * ROPE; *(u32x2*)(kd + i0) = w1; *(u32x2*)(kd + 32 + i0) = w2; }
                            else { const int b = row >> 13, t = row & (SEQ - 1);
#pragma unroll
                                for (int h = 0; h < NH; ++h) { bf16_t* kd = kfull_ + ((size_t)(b * NH + h) * SEQ + t) * QH + NOPE; *(u32x2*)(kd + i0) = w1; *(u32x2*)(kd + 32 + i0) = w2; } }
                        } else if (g0 < ROPE + QR) {
#pragma unroll
                            for (int n = 0; n < 2; ++n) { const int qi = g0 - ROPE + n * 16 + 4 * fq; const f32x4 v = acc[ai][bj][m][n] * r;
                                u32x2 w; w.x = pk2(v.x, v.y); w.y = pk2(v.z, v.w); *(u32x2*)(cqb_ + (size_t)row * QR + qi) = w;
                                sq += (v.x * v.x + v.y * v.y) + (v.z * v.z + v.w * v.w); }
                        }
                    }
                    sq += __shfl_xor(sq, 16); sq += __shfl_xor(sq, 32);
                    if (fq == 0) ssqq_[(size_t)row * 8 + (u.pn - 1) * 4 + wc] = sq;
                }
                asm volatile("" ::: "memory");
            }
    }
};
struct EpiKup {
    static constexpr bool PERM = true;
    bf16_t* kfull; const float* ssqc_;
    __device__ __forceinline__ void operator()(const f32x4 (&acc)[2][2][4][2], const pg8::Unit& u, int wr, int wc, int fr_in, int fq_in) const {
        int fr = fr_in, fq = fq_in; asm volatile("" : "+v"(fr), "+v"(fq));
        const int col0 = u.pn * 256 + wc * 32 + 8 * fq;
        float rc[2][4]; load_rstd_p<4>(ssqc_, 1.0f / KVR, u, wr, fr, fq, rc);
#pragma unroll
        for (int ai = 0; ai < 2; ++ai)
#pragma unroll
            for (int m = 0; m < 4; ++m) {
                const int row = u.pm * 256 + ai * 128 + wr * 64 + m * 16 + fr; const int b = row >> 13, t = row & (SEQ - 1); const float r = rc[ai][m];
#pragma unroll
                for (int bj = 0; bj < 2; ++bj) { const int col = col0 + bj * 128; const int h = col >> 7, nn = col & 127; const f32x4 a = acc[ai][bj][m][0] * r, c = acc[ai][bj][m][1] * r;
                    u32x4 w; w.x = pk2(a.x, a.y); w.y = pk2(a.z, a.w); w.z = pk2(c.x, c.y); w.w = pk2(c.z, c.w);
                    *(u32x4*)(kfull + ((size_t)(b * NH + h) * SEQ + t) * QH + nn) = w; }
                asm volatile("" ::: "memory");
            }
    }
};
struct EpiVup {
    static constexpr bool PERM = true;
    bf16_t* vt; const float* ssqc_;
    __device__ __forceinline__ void operator()(const f32x4 (&acc)[2][2][4][2], const pg8::Unit& u, int wr, int wc, int fr_in, int fq_in) const {
        int fr = fr_in, fq = fq_in; asm volatile("" : "+v"(fr), "+v"(fq));
        const int col0 = u.pn * 256 + wc * 32 + 8 * fq;
        f32x4 rt[2][2];
#pragma unroll
        for (int bj = 0; bj < 2; ++bj)
#pragma unroll
            for (int k = 0; k < 8; ++k) { const f32x4 p4 = *(const f32x4*)(ssqc_ + (size_t)(col0 + bj * 128 + k) * 4); rt[bj][k >> 2][k & 3] = 1.0f / sqrtf(((p4.x + p4.y) + (p4.z + p4.w)) * (1.0f / KVR) + EPS); }
#pragma unroll
        for (int ai = 0; ai < 2; ++ai)
#pragma unroll
            for (int m = 0; m < 4; ++m) {
                const int row = u.pm * 256 + ai * 128 + wr * 64 + m * 16 + fr; const int h = row >> 7, v = row & 127;
#pragma unroll
                for (int bj = 0; bj < 2; ++bj) { const int col = col0 + bj * 128; const int b = col >> 13, t = col & (SEQ - 1); const f32x4 a = acc[ai][bj][m][0] * rt[bj][0], c = acc[ai][bj][m][1] * rt[bj][1];
                    u32x4 w; w.x = pk2(a.x, a.y); w.y = pk2(a.z, a.w); w.z = pk2(c.x, c.y); w.w = pk2(c.z, c.w);
                    *(u32x4*)(vt + ((size_t)(b * NH + h) * VD + v) * SEQ + t) = w; }
                asm volatile("" ::: "memory");
            }
    }
};

struct SgALoadBf { const bf16_t* A; int lda;
    __device__ __forceinline__ bf16x8 operator()(int row, int k) const { return *(const bf16x8*)(A + (size_t)row * lda + k); } };
struct SgALoadComb { const float* parto; const float* ml;
    __device__ __forceinline__ bf16x8 operator()(int row, int k) const {
        const int b = row >> 3, tok = row & 7, h = k >> 7, v = k & 127, q = tok * 8 + h;
        const float* m0p = ml + ((size_t)(b * 2 + 0) * 64 + q) * 2; const float* m1p = ml + ((size_t)(b * 2 + 1) * 64 + q) * 2;
        const float m0 = m0p[0], l0 = m0p[1], m1 = m1p[0], l1 = m1p[1], mx = fmaxf(m0, m1);
        float w0 = __builtin_amdgcn_exp2f(m0 - mx), w1 = __builtin_amdgcn_exp2f(m1 - mx); const float inv = 1.0f / (w0 * l0 + w1 * l1); w0 *= inv; w1 *= inv;
        const float* p0 = parto + ((size_t)(b * 2 + 0) * 64 + q) * 128 + v; const float* p1 = parto + ((size_t)(b * 2 + 1) * 64 + q) * 128 + v;
        return pack8v(*(const f32x4*)p0 * w0 + *(const f32x4*)p1 * w1, *(const f32x4*)(p0 + 4) * w0 + *(const f32x4*)(p1 + 4) * w1); } };
template <int NCT, int NCG, class Epi, class ALoad>
__device__ __forceinline__ void sg_gemm_l(LAS unsigned char* lds, const ALoad& AL, int apn256, const bf16_t* __restrict__ Bt, int K, int unit, const Epi& E, int tid, int wave, int lane) {
    constexpr int KS = 8 / NCG, W = NCG * NCT * 16, G4 = W / 4;
    static_assert(KS * 64 * W * 4 <= RING_BYTES, "sg_gemm reduction buffer");
    const int mt = unit >> 4, ntile = unit & 15, m0 = mt * 64, n0 = ntile * W;
    const int cg = wave % NCG, kp = wave / NCG, fr = lane & 15, fq = lane >> 4;
    const int Kw = K / KS;
    const int arow = m0 + fr, acol = (n0 >> 8) * apn256 + kp * Kw + 8 * fq;
    const bf16_t* bp = Bt + (size_t)(n0 + cg * NCT * 16 + fr) * K + kp * Kw + 8 * fq;
    f32x4 acc[4][NCT];
#pragma unroll
    for (int m = 0; m < 4; ++m)
#pragma unroll
        for (int n = 0; n < NCT; ++n) acc[m][n] = (f32x4){0.f, 0.f, 0.f, 0.f};
#pragma unroll 4
    for (int kk = 0; kk < Kw; kk += 32) {
        bf16x8 af[4], bfr[NCT];
#pragma unroll
        for (int m = 0; m < 4; ++m) af[m] = AL(arow + 16 * m, acol + kk);
#pragma unroll
        for (int n = 0; n < NCT; ++n) bfr[n] = *(const bf16x8*)(bp + (size_t)(16 * n) * K + kk);
#pragma unroll
        for (int m = 0; m < 4; ++m)
#pragma unroll
            for (int n = 0; n < NCT; ++n) acc[m][n] = __builtin_amdgcn_mfma_f32_16x16x32_bf16(bfr[n], af[m], acc[m][n], 0, 0, 0);
    }
    LAS float* red = (LAS float*)lds;
#pragma unroll
    for (int m = 0; m < 4; ++m)
#pragma unroll
        for (int n = 0; n < NCT; ++n) { const int row = 16 * m + fr, c4 = (cg * NCT * 16 + 16 * n) / 4 + fq;
            *(LAS f32x4*)(red + (size_t)(kp * 64 + row) * W + 4 * (c4 ^ (row & 3))) = acc[m][n]; }
    __syncthreads();
    for (int it = tid; it < 64 * G4; it += 512) {
        const int row = it / G4, c4 = it % G4;
        f32x4 v = *(const LAS f32x4*)(red + (size_t)row * W + 4 * (c4 ^ (row & 3)));
#pragma unroll
        for (int p = 1; p < KS; ++p) v += *(const LAS f32x4*)(red + (size_t)(p * 64 + row) * W + 4 * (c4 ^ (row & 3)));
        if constexpr (Epi::WHOLE_TILE) *(LAS f32x4*)(red + (size_t)row * W + 4 * (c4 ^ (row & 3))) = v;
        else E(MP + m0 + row, n0 + 4 * c4, v, ntile);
    }
    if constexpr (Epi::WHOLE_TILE) {
        __syncthreads();
        for (int it = tid; it < 64 * G4; it += 512) { const int row = it / G4, c4 = it % G4; E.tile(MP + m0 + row, n0, c4, red + (size_t)row * W, row & 3); }
    }
    __syncthreads();
}
template <int NCT, int NCG, class Epi>
__device__ __forceinline__ void sg_gemm(LAS unsigned char* lds, const bf16_t* __restrict__ A, int lda, int apn256, const bf16_t* __restrict__ Bt, int K, int unit, const Epi& E, int tid, int wave, int lane) {
    const SgALoadBf AL{A, lda}; sg_gemm_l<NCT, NCG>(lds, AL, apn256, Bt, K, unit, E, tid, wave, lane);
}
constexpr int SK_STG = 32768;
template <class Epi>
__device__ __forceinline__ void sk_gemm(LAS unsigned char* lds, const bf16_t* __restrict__ A, int lda, const bf16_t* __restrict__ Bt, int K, int m0, int n0, int ntile, const Epi& E, int tid, int wave, int lane) {
    const int nk = K >> 7, fr = lane & 15, fq = lane >> 4, mi = wave >> 1, nh = wave & 1;
    unsigned goA[2], goB[2];
#pragma unroll
    for (int e = 0; e < 2; ++e) { const int r = 4 * (wave + 8 * e) + (lane >> 4), c = (lane & 15) ^ (r & 15); goA[e] = (unsigned)(r * lda + c * 8) * 2u; goB[e] = (unsigned)(r * K + c * 8) * 2u; }
    const unsigned ldsw = (unsigned)wave * 1024u;
#define SK_STAGE(kc) do { const unsigned so_ = (unsigned)((kc) & 3) * SK_STG + ldsw; const size_t ko_ = (size_t)(kc) * 256; \
        _Pragma("unroll") for (int e = 0; e < 2; ++e) { \
            __builtin_amdgcn_global_load_lds((const unsigned*)((const char*)A + ko_ + goA[e]), (LAS unsigned*)(lds + so_ + e * 8192), 16, 0, 0); \
            __builtin_amdgcn_global_load_lds((const unsigned*)((const char*)Bt + ko_ + goB[e]), (LAS unsigned*)(lds + so_ + 16384 + e * 8192), 16, 0, 0); } } while (0)
    int co[4];
#pragma unroll
    for (int ks = 0; ks < 4; ++ks) co[ks] = ((4 * ks + fq) ^ fr) << 4;
    const int aro = (16 * mi + fr) * 256, bro = 16384 + (32 * nh + fr) * 256;
    f32x4 acc[2] = {(f32x4){0.f, 0.f, 0.f, 0.f}, (f32x4){0.f, 0.f, 0.f, 0.f}};
    asm volatile("s_waitcnt vmcnt(0)" ::: "memory");
    SK_STAGE(0); if (nk > 1) SK_STAGE(1); if (nk > 2) SK_STAGE(2);
#pragma unroll 1
    for (int kc = 0; kc < nk; ++kc) {
        if (kc + 2 < nk) asm volatile("s_waitcnt vmcnt(8)" ::: "memory"); else if (kc + 1 < nk) asm volatile("s_waitcnt vmcnt(4)" ::: "memory"); else asm volatile("s_waitcnt vmcnt(0)" ::: "memory");
        asm volatile("s_waitcnt lgkmcnt(0)" ::: "memory"); __builtin_amdgcn_s_barrier(); asm volatile("" ::: "memory");
        if (kc + 3 < nk) SK_STAGE(kc + 3);
        const LAS unsigned char* sp = lds + (kc & 3) * SK_STG;
        bf16x8 af[4], b0[4], b1[4];
#pragma unroll
        for (int ks = 0; ks < 4; ++ks) { af[ks] = *(const LAS bf16x8*)(sp + aro + co[ks]); b0[ks] = *(const LAS bf16x8*)(sp + bro + co[ks]); b1[ks] = *(const LAS bf16x8*)(sp + bro + 4096 + co[ks]); }
#pragma unroll
        for (int ks = 0; ks < 4; ++ks) { acc[0] = __builtin_amdgcn_mfma_f32_16x16x32_bf16(b0[ks], af[ks], acc[0], 0, 0, 0); acc[1] = __builtin_amdgcn_mfma_f32_16x16x32_bf16(b1[ks], af[ks], acc[1], 0, 0, 0); }
    }
#undef SK_STAGE
    asm volatile("s_waitcnt lgkmcnt(0)" ::: "memory"); __builtin_amdgcn_s_barrier(); asm volatile("" ::: "memory");
    LAS float* red = (LAS float*)lds;
    { const int row = 16 * mi + fr;
#pragma unroll
      for (int n = 0; n < 2; ++n) { const int c4 = 4 * (2 * nh + n) + fq; *(LAS f32x4*)(red + row * 64 + 4 * (c4 ^ (row & 3))) = acc[n]; } }
    __syncthreads();
#pragma unroll
    for (int it = tid; it < 1024; it += 512) { const int row = it >> 4, c4 = it & 15; const f32x4 v = *(const LAS f32x4*)(red + row * 64 + 4 * (c4 ^ (row & 3))); E(MP + m0 + row, n0 + 4 * c4, v, ntile); }
    __syncthreads();
}
constexpr int SKW_STG = 40960;
template <class Epi>
__device__ __forceinline__ void sk_gemm_w(LAS unsigned char* lds, const bf16_t* __restrict__ A, int lda, const bf16_t* __restrict__ Bt, int K, int m0, int n0, const Epi& E, int tid, int wave, int lane) {
    const int nk = K >> 6, fr = lane & 15, fq = lane >> 4;
    unsigned goA, goB[4];
    { const int r = 8 * wave + (lane >> 3), c = (lane & 7) ^ (r & 7); goA = (unsigned)(r * lda + c * 8) * 2u;
#pragma unroll
      for (int e = 0; e < 4; ++e) goB[e] = (unsigned)((r + 64 * e) * K + c * 8) * 2u; }
    const unsigned ldsw = (unsigned)wave * 1024u;
#define SKW_STAGE(kc) do { const unsigned so_ = (unsigned)((kc) % 3) * SKW_STG + ldsw; const size_t ko_ = (size_t)(kc) * 128; \
        __builtin_amdgcn_global_load_lds((const unsigned*)((const char*)A + ko_ + goA), (LAS unsigned*)(lds + so_), 16, 0, 0); \
        _Pragma("unroll") for (int e = 0; e < 4; ++e) __builtin_amdgcn_global_load_lds((const unsigned*)((const char*)Bt + ko_ + goB[e]), (LAS unsigned*)(lds + so_ + 8192 + e * 8192), 16, 0, 0); } while (0)
    const int co0 = (fq ^ (fr & 7)) << 4, co1 = ((4 + fq) ^ (fr & 7)) << 4;
    const int aro = fr * 128, bro = 8192 + (32 * wave + fr) * 128;
    f32x4 acc[4][2];
#pragma unroll
    for (int m = 0; m < 4; ++m)
#pragma unroll
        for (int n = 0; n < 2; ++n) acc[m][n] = (f32x4){0.f, 0.f, 0.f, 0.f};
    asm volatile("s_waitcnt vmcnt(0)" ::: "memory");
    SKW_STAGE(0); if (nk > 1) SKW_STAGE(1);
#pragma unroll 1
    for (int kc = 0; kc < nk; ++kc) {
        if (kc + 1 < nk) asm volatile("s_waitcnt vmcnt(5)" ::: "memory"); else asm volatile("s_waitcnt vmcnt(0)" ::: "memory");
        asm volatile("s_waitcnt lgkmcnt(0)" ::: "memory"); __builtin_amdgcn_s_barrier(); asm volatile("" ::: "memory");
        if (kc + 2 < nk) SKW_STAGE(kc + 2);
        const LAS unsigned char* sp = lds + (kc % 3) * SKW_STG;
        bf16x8 af[4][2], bf_[2][2];
#pragma unroll
        for (int m = 0; m < 4; ++m) { af[m][0] = *(const LAS bf16x8*)(sp + aro + m * 2048 + co0); af[m][1] = *(const LAS bf16x8*)(sp + aro + m * 2048 + co1); }
#pragma unroll
        for (int n = 0; n < 2; ++n) { bf_[n][0] = *(const LAS bf16x8*)(sp + bro + n * 2048 + co0); bf_[n][1] = *(const LAS bf16x8*)(sp + bro + n * 2048 + co1); }
#pragma unroll
        for (int m = 0; m < 4; ++m)
#pragma unroll
            for (int n = 0; n < 2; ++n) { acc[m][n] = __builtin_amdgcn_mfma_f32_16x16x32_bf16(bf_[n][0], af[m][0], acc[m][n], 0, 0, 0); acc[m][n] = __builtin_amdgcn_mfma_f32_16x16x32_bf16(bf_[n][1], af[m][1], acc[m][n], 0, 0, 0); }
    }
#undef SKW_STAGE
    asm volatile("s_waitcnt lgkmcnt(0)" ::: "memory"); __builtin_amdgcn_s_barrier(); asm volatile("" ::: "memory");
    LAS float* red = (LAS float*)lds;
#pragma unroll
    for (int m = 0; m < 4; ++m)
#pragma unroll
        for (int n = 0; n < 2; ++n) { const int row = 16 * m + fr, c4 = 8 * wave + 4 * n + fq; *(LAS f32x4*)(red + row * 256 + 4 * (c4 ^ (row & 15))) = acc[m][n]; }
    __syncthreads();
#pragma unroll
    for (int i = 0; i < 8; ++i) { const int it = tid + 512 * i, row = it >> 6, c4 = it & 63; const f32x4 v = *(const LAS f32x4*)(red + row * 256 + 4 * (c4 ^ (row & 15))); E(MP + m0 + row, n0 + 4 * c4, v, 0); }
    __syncthreads();
}
__device__ __forceinline__ float row_rstd16(const float* ssq, int row) {
    const f32x4* s = (const f32x4*)(ssq + (size_t)row * 16); const f32x4 a = s[0], b = s[1], c = s[2], d = s[3];
    const float t = ((a.x + a.y) + (a.z + a.w)) + ((b.x + b.y) + (b.z + b.w)) + ((c.x + c.y) + (c.z + c.w)) + ((d.x + d.y) + (d.z + d.w));
    return 1.0f / sqrtf(t * (1.0f / 1024.0f) + EPS);
}
template <int MODE> struct SgH {
    static constexpr bool WHOLE_TILE = false;
    const float* xs; const float* scale; const float* ssq_in; const bf16_t* proj; const bf16_t* hb_in; bf16_t* hb; float* ssq_out;
    __device__ __forceinline__ void operator()(int row, int col, f32x4 a, int ntile) const {
        const f32x4 bs = (MODE == 0) ? *(const f32x4*)(xs + (size_t)(row - MP) * D + col) : unpk4(*(const u32x2*)(hb_in + (size_t)row * D + col));
        f32x4 o;
        if (MODE == 0) o = bs + *(const f32x4*)(scale + col) * a;
        else if (MODE == 1) o = bs + a;
        else { const float r = row_rstd16(ssq_in, row); const f32x4 pj = unpk4(*(const u32x2*)(proj + (size_t)row * D + col));
            f32x4 gt; gt.x = 1.0f / (1.0f + __expf(-r * a.x)); gt.y = 1.0f / (1.0f + __expf(-r * a.y)); gt.z = 1.0f / (1.0f + __expf(-r * a.z)); gt.w = 1.0f / (1.0f + __expf(-r * a.w));
            o = bs + gt * pj; }
        u32x2 w; w.x = pk2(o.x, o.y); w.y = pk2(o.z, o.w);
        *(u32x2*)(hb + (size_t)row * D + col) = w;
        float sq = (o.x * o.x + o.y * o.y) + (o.z * o.z + o.w * o.w);
        sq += __shfl_xor(sq, 1); sq += __shfl_xor(sq, 2); sq += __shfl_xor(sq, 4); sq += __shfl_xor(sq, 8);
        if ((col & 63) == 0) ssq_out[(size_t)row * 16 + ntile] = sq;
    }
};
struct SgUp {
    static constexpr bool WHOLE_TILE = false;
    const float* ssq_in; bf16_t* abuf;
    __device__ __forceinline__ void operator()(int row, int col, f32x4 a, int) const {
        const float r = row_rstd16(ssq_in, row); a = a * r;
        a.x = fmaxf(a.x, 0.f); a.y = fmaxf(a.y, 0.f); a.z = fmaxf(a.z, 0.f); a.w = fmaxf(a.w, 0.f);
        u32x2 w; w.x = pk2(a.x * a.x, a.y * a.y); w.y = pk2(a.z * a.z, a.w * a.w);
        *(u32x2*)(abuf + (size_t)row * FF + col) = w;
    }
};
template <int MODE> struct SgF32 {
    static constexpr bool WHOLE_TILE = false;
    float* C; int ldc; const float* aux;
    __device__ __forceinline__ void operator()(int row, int col, f32x4 a, int) const {
        const float r = (MODE == 1) ? row_rstd16(aux, row) : (MODE == 2 ? aux[row] : 1.0f);
        *(f32x4*)(C + (size_t)row * ldc + col) = a * r;
    }
};
struct SgBf {
    static constexpr bool WHOLE_TILE = false;
    bf16_t* C; int ldc;
    __device__ __forceinline__ void operator()(int row, int col, f32x4 a, int) const { u32x2 w; w.x = pk2(a.x, a.y); w.y = pk2(a.z, a.w); *(u32x2*)(C + (size_t)row * ldc + col) = w; }
};
struct SgQ {
    static constexpr bool WHOLE_TILE = true;
    const float* rstdq; const float* cs; bf16_t* qbuf; bf16_t* qs;
    __device__ __forceinline__ void operator()(int, int, f32x4, int) const {}
    __device__ __forceinline__ void tile(int row, int n0, int c4, const LAS float* trow, int sw) const {
        const int c = n0 + 4 * c4, hh = c / QH, e = c - hh * QH; const float r = rstdq[row];
        const f32x4 v = *(const LAS f32x4*)(trow + 4 * (c4 ^ sw)) * r;
        if (e < NOPE) { u32x2 w; w.x = pk2(v.x, v.y); w.y = pk2(v.z, v.w); *(u32x2*)(qbuf + (size_t)row * (NH * QH) + c) = w; }
        else { const int rp = e - NOPE, wi = rp & 31;
            if (wi < 16) { const int i0 = 16 * (rp >> 5) + wi, pos = PAST + ((row - MP) & 7);
                const f32x4 x2 = *(const LAS f32x4*)(trow + 4 * ((c4 + 4) ^ sw)) * r;
                const f32x4 cn = *(const f32x4*)(cs + (size_t)pos * 64 + i0), sn = *(const f32x4*)(cs + (size_t)pos * 64 + 32 + i0);
                const f32x4 o1 = v * cn - x2 * sn, o2 = x2 * cn + v * sn;
                bf16_t* qd = qs + ((size_t)(row - MP) * NH + hh) * 320 + KVR;
                u32x2 w1, w2; w1.x = pk2(o1.x, o1.y); w1.y = pk2(o1.z, o1.w); w2.x = pk2(o2.x, o2.y); w2.y = pk2(o2.z, o2.w);
                *(u32x2*)(qd + i0) = w1; *(u32x2*)(qd + 32 + i0) = w2; } }
    }
};

template <int PMODE = 0>
__device__ __forceinline__ void transpose_item(const float* W, const float* kscale, int K, int N, bf16_t* WT, int row_off, LAS float* scr, int item, int lane) {
    const int nblk = N / 32, kb = item / nblk, nb = item % nblk, k0 = 64 * kb, n0 = 32 * nb;
    { f32x4 v[8];
#pragma unroll
      for (int i = 0; i < 8; ++i) v[i] = *(const f32x4*)(W + (size_t)(k0 + (lane >> 3) + 8 * i) * N + n0 + (lane & 7) * 4);
#pragma unroll
      for (int i = 0; i < 8; ++i) { const int kk = (lane >> 3) + 8 * i; f32x4 x = v[i]; if (kscale) x = x * kscale[k0 + kk];
          LAS float* d = scr + kk * 33 + (lane & 7) * 4; d[0] = x.x; d[1] = x.y; d[2] = x.z; d[3] = x.w; } }
    LDS_WAIT(); asm volatile("" ::: "memory");
    const int c = lane & 7;
#pragma unroll
    for (int j = 0; j < 4; ++j) { const int n = (lane >> 3) + 8 * j; const LAS float* s = scr + (8 * c) * 33 + n;
        u32x4 o; o.x = pk2(s[0 * 33], s[1 * 33]); o.y = pk2(s[2 * 33], s[3 * 33]); o.z = pk2(s[4 * 33], s[5 * 33]); o.w = pk2(s[6 * 33], s[7 * 33]);
        *(u32x4*)(WT + (size_t)(row_off + (PMODE == 1 ? qperm(n0 + n) : (PMODE == 2 ? kperm(n0 + n) : n0 + n))) * K + k0 + 8 * c) = o; }
    LDS_WAIT(); asm volatile("" ::: "memory");
}

constexpr int AK_PITCH = 400, AK_BUF = 64 * AK_PITCH;
constexpr int AV_PITCH = 136, AV_BUF = 128 * AV_PITCH;
constexpr int AV_OFF = 2 * AK_BUF, AQ_OFF = AV_OFF + 2 * AV_BUF;
static_assert(AQ_OFF + 256 * 144 <= RING_BYTES, "attention LDS");
__device__ __forceinline__ void attn_prompt_unit(const bf16_t* __restrict__ qbuf, const bf16_t* __restrict__ Kf, const bf16_t* __restrict__ Vt, bf16_t* __restrict__ obuf,
                                                 int b, int h, int qb, LAS unsigned char* lds, int tid, int wave, int lane) {
    const int r32 = lane & 31, g = lane >> 5;
    const int t_lo = qb * 256 + wave * 32, trow = t_lo + r32;
    bf16x8 qf[8];
    { const bf16_t* qp = qbuf + (size_t)(b * SEQ + trow) * (NH * QH) + h * QH + 8 * g;
      __syncthreads();
#pragma unroll
      for (int ks = 8; ks < 12; ++ks) *(LAS bf16x8*)(lds + AQ_OFF + (wave * 32 + r32) * 144 + (2 * (ks - 8) + g) * 16) = *(const bf16x8*)(qp + 16 * ks);
#pragma unroll
      for (int ks = 0; ks < 8; ++ks) qf[ks] = *(const bf16x8*)(qp + 16 * ks);
#pragma unroll
      for (int ks = 0; ks < 8; ++ks) asm volatile("" : "+v"(qf[ks])); }
    f32x16 O[4];
#pragma unroll
    for (int i = 0; i < 4; ++i)
#pragma unroll
        for (int j = 0; j < 16; ++j) O[i][j] = 0.f;
    float mrun = -1e30f, lrun = 0.f;
    const bf16_t* Kb = Kf + (size_t)(b * NH + h) * SEQ * QH;
    const bf16_t* Vb = Vt + (size_t)(b * NH + h) * VD * SEQ;
    const int NT = (qb + 1) * 4;
    int kl_off[3], vl_off[2]; size_t vg_off[2];
#pragma unroll
    for (int e = 0; e < 3; ++e) kl_off[e] = (tid >> 3) * AK_PITCH + ((tid & 7) + 8 * e) * 16;
#pragma unroll
    for (int e = 0; e < 2; ++e) { const int c = tid + 512 * e; vl_off[e] = AV_OFF + (c >> 3) * AV_PITCH + (c & 7) * 16; vg_off[e] = (size_t)(c >> 3) * SEQ + (c & 7) * 8; }
    u32x4 kst[3], vst[2];
#define AT_LOAD(j) do { _Pragma("unroll") for (int e = 0; e < 3; ++e) kst[e] = *(const u32x4*)(Kb + (size_t)(64 * (j) + (tid >> 3)) * QH + ((tid & 7) + 8 * e) * 8); \
                        _Pragma("unroll") for (int e = 0; e < 2; ++e) vst[e] = *(const u32x4*)(Vb + vg_off[e] + 64 * (j)); } while (0)
#define AT_WRITE(buf) do { _Pragma("unroll") for (int e = 0; e < 3; ++e) *(LAS u32x4*)(lds + (buf) * AK_BUF + kl_off[e]) = kst[e]; \
                           _Pragma("unroll") for (int e = 0; e < 2; ++e) { *(LAS u32x2*)(lds + (buf) * AV_BUF + vl_off[e]) = (u32x2){vst[e].x, vst[e].y}; *(LAS u32x2*)(lds + (buf) * AV_BUF + vl_off[e] + 8) = (u32x2){vst[e].z, vst[e].w}; } } while (0)
    AT_LOAD(0); AT_WRITE(0);
    __syncthreads();
    for (int j = 0; j < NT; ++j) {
        const int buf = j & 1;
        if (j + 1 < NT) AT_LOAD(j + 1);
        if (64 * j <= t_lo + 31) {
            f32x16 S0, S1;
#pragma unroll
            for (int i = 0; i < 16; ++i) { S0[i] = 0.f; S1[i] = 0.f; }
            const LAS unsigned char* kl = lds + buf * AK_BUF + r32 * AK_PITCH + g * 16;
            const LAS unsigned char* ql = lds + AQ_OFF + (wave * 32 + r32) * 144 + g * 16;
            bf16x8 ka[3][2], qr_[3];
#define AT_KLD(ks) do { ka[(ks) % 3][0] = *(const LAS bf16x8*)(kl + (ks) * 32); ka[(ks) % 3][1] = *(const LAS bf16x8*)(kl + 32 * AK_PITCH + (ks) * 32); \
                        if ((ks) >= 8) qr_[(ks) % 3] = *(const LAS bf16x8*)(ql + ((ks) - 8) * 32); } while (0)
            AT_KLD(0); AT_KLD(1);
#pragma unroll
            for (int ks = 0; ks < 12; ++ks) {
                if (ks + 2 < 12) AT_KLD(ks + 2);
                __builtin_amdgcn_sched_barrier(0);
                const bf16x8 qb_ = (ks < 8) ? qf[ks < 8 ? ks : 0] : qr_[ks % 3];
                S0 = __builtin_amdgcn_mfma_f32_32x32x16_bf16(ka[ks % 3][0], qb_, S0, 0, 0, 0);
                S1 = __builtin_amdgcn_mfma_f32_32x32x16_bf16(ka[ks % 3][1], qb_, S1, 0, 0, 0);
                __builtin_amdgcn_sched_barrier(0);
            }
#undef AT_KLD
            if (64 * j + 63 > t_lo) {
                asm volatile("" ::: "memory");
#pragma unroll
                for (int i = 0; i < 16; ++i) { const int key = 64 * j + crow(i, g); if (key > trow) S0[i] = -1e30f; if (key + 32 > trow) S1[i] = -1e30f; }
            }
            float mx = S0[0];
#pragma unroll
            for (int i = 1; i < 16; ++i) mx = fmaxf(mx, S0[i]);
#pragma unroll
            for (int i = 0; i < 16; ++i) mx = fmaxf(mx, S1[i]);
            mx = fmaxf(mx, __shfl_xor(mx, 32)) * CEXP;
            if (__any(mx > mrun + 11.5f)) {
                const float mnew = fmaxf(mrun, mx), alpha = __builtin_amdgcn_exp2f(mrun - mnew);
                mrun = mnew; lrun *= alpha;
#pragma unroll
                for (int vt = 0; vt < 4; ++vt)
#pragma unroll
                    for (int i = 0; i < 16; ++i) O[vt][i] *= alpha;
            }
            float ps = 0.f;
#pragma unroll
            for (int i = 0; i < 16; ++i) { S0[i] = __builtin_amdgcn_exp2f(S0[i] * CEXP - mrun); S1[i] = __builtin_amdgcn_exp2f(S1[i] * CEXP - mrun); ps += S0[i] + S1[i]; }
            lrun += ps;
            bf16x8 pf[4];
            { float tmp[8];
#pragma unroll
              for (int s2 = 0; s2 < 4; ++s2) {
#pragma unroll
                for (int i = 0; i < 8; ++i) tmp[i] = (s2 < 2) ? S0[8 * (s2 & 1) + i] : S1[8 * (s2 & 1) + i];
                pf[s2] = pack8(tmp); } }
            const LAS unsigned char* vl = lds + AV_OFF + buf * AV_BUF + r32 * AV_PITCH + g * 8;
            u32x4 fa[4], fb[4];
#define AT_VLD(dst, vt) do { _Pragma("unroll") for (int s2 = 0; s2 < 4; ++s2) { const u32x2 lo_ = *(const LAS u32x2*)(vl + (vt) * 32 * AV_PITCH + s2 * 32), hi_ = *(const LAS u32x2*)(vl + (vt) * 32 * AV_PITCH + s2 * 32 + 16); dst[s2] = (u32x4){lo_.x, lo_.y, hi_.x, hi_.y}; } } while (0)
#define AT_VMM(src, vt) do { _Pragma("unroll") for (int s2 = 0; s2 < 4; ++s2) O[vt] = __builtin_amdgcn_mfma_f32_32x32x16_bf16(__builtin_bit_cast(bf16x8, src[s2]), pf[s2], O[vt], 0, 0, 0); } while (0)
            AT_VLD(fa, 0); AT_VLD(fb, 1); __builtin_amdgcn_sched_barrier(0);
            AT_VMM(fa, 0); __builtin_amdgcn_sched_barrier(0);
            AT_VLD(fa, 2); __builtin_amdgcn_sched_barrier(0);
            AT_VMM(fb, 1); __builtin_amdgcn_sched_barrier(0);
            AT_VLD(fb, 3); __builtin_amdgcn_sched_barrier(0);
            AT_VMM(fa, 2); __builtin_amdgcn_sched_barrier(0);
            AT_VMM(fb, 3);
#undef AT_VLD
#undef AT_VMM
        }
        if (j + 1 < NT) AT_WRITE(buf ^ 1);
        __syncthreads();
    }
#undef AT_LOAD
#undef AT_WRITE
    const float ltot = lrun + __shfl_xor(lrun, 32), inv = 1.0f / ltot;
    bf16_t* op = obuf + (size_t)(b * SEQ + trow) * D + h * VD + 4 * g;
#pragma unroll
    for (int vt = 0; vt < 4; ++vt)
#pragma unroll
        for (int jq = 0; jq < 4; ++jq) {
            u32x2 w; w.x = pk2(O[vt][4 * jq] * inv, O[vt][4 * jq + 1] * inv); w.y = pk2(O[vt][4 * jq + 2] * inv, O[vt][4 * jq + 3] * inv);
            *(u32x2*)(op + 32 * vt + 8 * jq) = w;
        }
}

typedef short s16x4 __attribute__((ext_vector_type(4)));
constexpr int SA_KR = 32768, SA_BUF = 32768 + 64 * 144, SA_QR = 2 * SA_BUF, SA_QI = SA_QR + 64 * 144, SA_QI_PITCH = 528, SA_OI = 69632;
static_assert(SA_OI >= 65536 + 1024 && SA_OI + 64 * SA_QI_PITCH <= MISC_OFF, "O image");
static_assert(SA_QI + 64 * SA_QI_PITCH <= MISC_OFF, "sample attention LDS");
__device__ __forceinline__ int sa_off(int row, int ch) { return 256 * row + 16 * (ch ^ (((row & 3) << 2) | ((row >> 2) & 3))); }
__device__ __forceinline__ void sattn_item(const Params& P, int b, int half, LAS unsigned char* lds, int tid, int wave, int lane) {
    unsigned char* ws = P.ws;
    const int r32 = lane & 31, g = lane >> 5;
    const bool is_cmp = wave < 4;
    const int qt = wave & 1, kb = (wave >> 1) & 1;
    const int ptv = ((const int*)P.in[I_PT])[b * NPG + half * 32 + (lane & 31)];
    const float* clat = P.in[I_CLAT]; const float* ckr = P.in[I_CKR];
#define SA_LOAD(S, h) do { const int pg_ = __builtin_amdgcn_readlane(ptv, (h) >> 2); const size_t prow_ = (size_t)pg_ * PAGE + (((h) & 3) << 5); \
        const char* lat_ = (const char*)(clat + prow_ * KVR); const char* kro_ = (const char*)(ckr + prow_ * ROPE); \
        _Pragma("unroll") for (int e = 0; e < 8; ++e) S[e] = *(const f32x4*)(lat_ + glb + e * 1024); \
        S[8] = *(const f32x4*)(kro_ + grb); S[9] = *(const f32x4*)(kro_ + grb + 1024); } while (0)
#define SA_PK4(v) ((u32x2){pk2((v).x, (v).y), pk2((v).z, (v).w)})
#define SA_WRITE(S, bufo, hh) do { \
        _Pragma("unroll") for (int e = 0; e < 8; ++e) *(LAS u32x2*)(lds + (bufo) + llb[e] + (hh) * 8192) = SA_PK4(S[e]); \
        _Pragma("unroll") for (int e = 0; e < 2; ++e) *(LAS u32x2*)(lds + (bufo) + lrb[e] + (hh) * 4608) = SA_PK4(S[8 + e]); asm volatile("" ::: "memory"); } while (0)
    __syncthreads();
    *(LAS u32x4*)(lds + SA_QR + (tid >> 3) * 144 + (tid & 7) * 16) = *(const u32x4*)((const bf16_t*)(ws + WS_QS) + ((size_t)b * 64 + (tid >> 3)) * 320 + KVR + (tid & 7) * 8);
    {
      const bf16_t* qn = (const bf16_t*)(ws + WS_QBUF) + (size_t)(MP + b * DS + (r32 & 7)) * (NH * QH) + wave * QH + 8 * g;
      bf16x8 an[8];
#pragma unroll
      for (int ks = 0; ks < 8; ++ks) { u32x4 z = {0u, 0u, 0u, 0u}; if (r32 < DS) z = *(const u32x4*)(qn + 16 * ks); an[ks] = __builtin_bit_cast(bf16x8, z); }
      const bf16_t* wk = (const bf16_t*)(ws + WS_WUKB) + (size_t)wave * (64 * 512) + lane * 8;
#pragma unroll 2
      for (int nt = 0; nt < 8; ++nt) {
          f32x16 acc;
#pragma unroll
          for (int i = 0; i < 16; ++i) acc[i] = 0.f;
#pragma unroll
          for (int ks = 0; ks < 8; ++ks) acc = __builtin_amdgcn_mfma_f32_32x32x16_bf16(an[ks], *(const bf16x8*)(wk + (nt * 8 + ks) * 512), acc, 0, 0, 0);
#pragma unroll
          for (int i = 0; i < 4; ++i) *(LAS bf16_t*)(lds + SA_QI + ((i + 4 * g) * 8 + wave) * SA_QI_PITCH + (32 * nt + r32) * 2) = (bf16_t)f2bf(acc[i]);
      } }
    __syncthreads();
#define SA_KLD(ks) do { const int o0_ = ((ks) < 16) ? (((ks) >> 3) * 16384 + krow + 32 * (((ks) & 7) ^ (x_ >> 1))) : (krope + 32 * ((ks) - 16)); \
        ka_[(ks) & 3] = *(const LAS bf16x8*)(kb_ + o0_); \
        qa_[(ks) & 3] = ((ks) < 16) ? *(const LAS bf16x8*)(qil + 32 * (ks)) : *(const LAS bf16x8*)(qrl + 32 * ((ks) - 16)); } while (0)
#define SA_VLD(dst, vt) do { const LAS unsigned char* vb_ = kb_ + ((vt) >> 2) * 16384 + 8192 * kb; \
        const int c0_ = 4 * ((vt) & 3) + 2 * vsub + (p_ >> 1); \
        const int blo_ = 256 * (4 * gg + q_) + 16 * (c0_ ^ ((q_ << 2) | gg)) + 8 * (p_ & 1); \
        const int bhi_ = 256 * (4 * gg + q_ + 8) + 16 * (c0_ ^ ((q_ << 2) | (gg + 2))) + 8 * (p_ & 1); \
        _Pragma("unroll") for (int s2 = 0; s2 < 2; ++s2) { \
            const s16x4 lo_ = __builtin_amdgcn_ds_read_tr16_b64_v4i16((LAS s16x4*)(vb_ + blo_ + 4096 * s2)); \
            const s16x4 hi_ = __builtin_amdgcn_ds_read_tr16_b64_v4i16((LAS s16x4*)(vb_ + bhi_ + 4096 * s2)); \
            dst[s2] = (bf16x8){lo_[0], lo_[1], lo_[2], lo_[3], hi_[0], hi_[1], hi_[2], hi_[3]}; } } while (0)
#define SA_VMM(src, vt) do { _Pragma("unroll") for (int s2 = 0; s2 < 2; ++s2) O[vt] = __builtin_amdgcn_mfma_f32_32x32x16_bf16(src[s2], pf[s2], O[vt], 0, 0, 0); } while (0)
#define SA_COMPUTE(j, bufo) do { \
        const LAS unsigned char* kb_ = lds + (bufo); \
        f32x16 S0; \
        _Pragma("unroll") for (int i = 0; i < 16; ++i) S0[i] = 0.f; \
        int r32v = r32; asm volatile("" : "+v"(r32v)); \
        const int x_ = ((r32v & 3) << 2) | ((r32v >> 2) & 3); \
        const int krow = 256 * (r32v + 32 * kb) + 16 * ((g ^ x_) & 1), krope = SA_KR + (r32v + 32 * kb) * 144 + g * 16; \
        const LAS unsigned char* qrl = lds + SA_QR + (32 * qt + r32v) * 144 + g * 16; const LAS unsigned char* qil = lds + SA_QI + (32 * qt + r32v) * SA_QI_PITCH + g * 16; \
        bf16x8 ka_[4], qa_[4]; \
        SA_KLD(0); SA_KLD(1); SA_KLD(2); \
        _Pragma("unroll") for (int ks = 0; ks < 20; ++ks) { \
            if (ks + 3 < 20) SA_KLD(ks + 3); \
            __builtin_amdgcn_sched_barrier(0); \
            S0 = __builtin_amdgcn_mfma_f32_32x32x16_bf16(ka_[ks & 3], qa_[ks & 3], S0, 0, 0, 0); \
            __builtin_amdgcn_sched_barrier(0); } \
        if ((j) == 64) { const int tok = (32 * qt + r32) >> 3; asm volatile("" ::: "memory"); \
            _Pragma("unroll") for (int i = 0; i < 16; ++i) { const int key = 32 * kb + crow(i, g); if (key > tok || key >= DS) S0[i] = -1e30f; } } \
        float mx = S0[0]; \
        _Pragma("unroll") for (int i = 1; i < 16; ++i) mx = fmaxf(mx, S0[i]); \
        mx = fmaxf(mx, __shfl_xor(mx, 32)) * CEXP; \
        if (__any(mx > mrun + 11.5f)) { const float mnew = fmaxf(mrun, mx), alpha = __builtin_amdgcn_exp2f(mrun - mnew); mrun = mnew; lrun *= alpha; \
            _Pragma("unroll") for (int vt = 0; vt < 8; ++vt) _Pragma("unroll") for (int i = 0; i < 16; ++i) O[vt][i] *= alpha; } \
        int lnv = lane; asm volatile("" : "+v"(lnv)); \
        const int li = lnv & 15, q_ = li >> 2, p_ = li & 3, vsub = (lnv >> 4) & 1, gg = lnv >> 5; \
        bf16x8 fa_[2], fb_[2]; \
        SA_VLD(fa_, 0); SA_VLD(fb_, 1);                        \
        float ps = 0.f; \
        _Pragma("unroll") for (int i = 0; i < 16; ++i) { S0[i] = __builtin_amdgcn_exp2f(S0[i] * CEXP - mrun); ps += S0[i]; } \
        lrun += ps; \
        bf16x8 pf[2]; \
        { float tmp[8]; \
          _Pragma("unroll") for (int s2 = 0; s2 < 2; ++s2) { \
            _Pragma("unroll") for (int i = 0; i < 8; ++i) tmp[i] = S0[8 * s2 + i]; \
            pf[s2] = pack8(tmp); } } \
        __builtin_amdgcn_sched_barrier(0); \
        SA_VMM(fa_, 0); __builtin_amdgcn_sched_barrier(0); SA_VLD(fa_, 2); __builtin_amdgcn_sched_barrier(0); \
        SA_VMM(fb_, 1); __builtin_amdgcn_sched_barrier(0); SA_VLD(fb_, 3); __builtin_amdgcn_sched_barrier(0); \
        SA_VMM(fa_, 2); __builtin_amdgcn_sched_barrier(0); SA_VLD(fa_, 4); __builtin_amdgcn_sched_barrier(0); \
        SA_VMM(fb_, 3); __builtin_amdgcn_sched_barrier(0); SA_VLD(fb_, 5); __builtin_amdgcn_sched_barrier(0); \
        SA_VMM(fa_, 4); __builtin_amdgcn_sched_barrier(0); SA_VLD(fa_, 6); __builtin_amdgcn_sched_barrier(0); \
        SA_VMM(fb_, 5); __builtin_amdgcn_sched_barrier(0); SA_VLD(fb_, 7); __builtin_amdgcn_sched_barrier(0); \
        SA_VMM(fa_, 6); __builtin_amdgcn_sched_barrier(0); \
        SA_VMM(fb_, 7); } while (0)
#define SA_LOADER(j, SX, SY, bufn) do { const int h0_ = 2 * (j) + 6 < 127 ? 2 * (j) + 6 : 127, h1_ = 2 * (j) + 7 < 127 ? 2 * (j) + 7 : 127; \
        __builtin_amdgcn_sched_barrier(0); SA_WRITE(SX, bufn, 0); SA_LOAD(SX, h0_); __builtin_amdgcn_sched_barrier(0); SA_WRITE(SY, bufn, 1); SA_LOAD(SY, h1_); __builtin_amdgcn_sched_barrier(0); } while (0)
#define SA_TAIL64(bufn) do { if (half == 1) { \
            const char* cbn = (const char*)((const bf16_t*)(ws + WS_CB) + (size_t)(MP + b * DS) * KVR); const char* krn = (const char*)((const bf16_t*)(ws + WS_KRBS) + (size_t)(b * DS) * ROPE); \
            const int w4_ = wave - 4; \
            _Pragma("unroll") for (int hh = 0; hh < 2; ++hh) { \
                _Pragma("unroll") for (int e = 0; e < 8; ++e) { const int key = 8 * w4_ + e + 32 * hh; u32x2 z = {0u, 0u}; if (key < DS) z = *(const u32x2*)(cbn + key * (KVR * 2) + 8 * lane); *(LAS u32x2*)(lds + (bufn) + llb[e] + hh * 8192) = z; } \
                _Pragma("unroll") for (int e = 0; e < 2; ++e) { const int key = 8 * w4_ + 4 * e + (lane >> 4) + 32 * hh; u32x2 z = {0u, 0u}; if (key < DS) z = *(const u32x2*)(krn + key * (ROPE * 2) + 8 * (lane & 15)); *(LAS u32x2*)(lds + (bufn) + lrb[e] + hh * 4608) = z; } } } } while (0)
#define SA_BAR() do { asm volatile("s_waitcnt lgkmcnt(0)" ::: "memory"); __builtin_amdgcn_s_barrier(); asm volatile("" ::: "memory"); } while (0)
    float* ml = (float*)(ws + WS_ML) + (size_t)(b * 2 + half) * 64 * 2;
    if (is_cmp) {
        SA_BAR();
        f32x16 O[8];
#pragma unroll
        for (int vt = 0; vt < 8; ++vt)
#pragma unroll
            for (int i = 0; i < 16; ++i) O[vt][i] = 0.f;
        float mrun = -1e30f, lrun = 0.f;
        int bo = 0;
        for (int j = 0; j < 64; ++j) {
            SA_COMPUTE(j, bo);
            bo = SA_BUF - bo;
            SA_BAR();
        }
        if (half == 1) { SA_COMPUTE(64, bo); SA_BAR(); }
        LAS float* xo = (LAS float*)(lds + qt * 32768); LAS float* xm = (LAS float*)(lds + 65536 + qt * 512);
        if (kb == 1) { xm[2 * lane] = mrun; xm[2 * lane + 1] = lrun;
#pragma unroll
            for (int vt = 0; vt < 8; ++vt)
#pragma unroll
                for (int i = 0; i < 16; ++i) xo[(vt * 16 + i) * 64 + lane] = O[vt][i]; }
        SA_BAR();
        if (kb == 0) {
            const float m1 = xm[2 * lane], l1 = xm[2 * lane + 1], mm = fmaxf(mrun, m1);
            const float a0 = __builtin_amdgcn_exp2f(mrun - mm), a1 = __builtin_amdgcn_exp2f(m1 - mm);
            const float ll = lrun * a0 + l1 * a1, lt = ll + __shfl_xor(ll, 32);
            const int q = 32 * qt + r32;
            if (g == 0) { ml[q * 2] = mm; ml[q * 2 + 1] = lt; }
#pragma unroll
            for (int vt = 0; vt < 8; ++vt) {
                float o[16];
#pragma unroll
                for (int i = 0; i < 16; ++i) o[i] = O[vt][i] * a0 + xo[(vt * 16 + i) * 64 + lane] * a1;
#pragma unroll
                for (int jq = 0; jq < 4; ++jq) { u32x2 w; w.x = pk2(o[4 * jq], o[4 * jq + 1]); w.y = pk2(o[4 * jq + 2], o[4 * jq + 3]);
                    *(LAS u32x2*)(lds + SA_OI + q * SA_QI_PITCH + (32 * vt + 8 * jq + 4 * g) * 2) = w; }
            }
        }
    } else {
        unsigned glb, grb, llb[8], lrb[2];
        { const int w4_ = wave - 4;
          glb = (unsigned)(8 * w4_ * 1024 + 16 * lane); grb = (unsigned)(8 * w4_ * 256 + 16 * lane);
#pragma unroll
          for (int e = 0; e < 8; ++e) { const int x_ = ((e & 3) << 2) | ((2 * w4_ + (e >> 2)) & 3);
              llb[e] = (unsigned)((lane >> 5) * 16384 + 256 * (8 * w4_ + e) + 16 * ((((lane & 31) >> 1)) ^ x_) + 8 * (lane & 1)); }
#pragma unroll
          for (int e = 0; e < 2; ++e) lrb[e] = (unsigned)(SA_KR + (8 * w4_ + 4 * e + (lane >> 4)) * 144 + 8 * (lane & 15)); }
        f32x4 s0[10], s1[10], s2[10], s3[10];
        SA_LOAD(s0, 0); SA_LOAD(s1, 1); SA_LOAD(s2, 2); SA_LOAD(s3, 3);
        SA_WRITE(s0, 0, 0); SA_LOAD(s0, 4); SA_WRITE(s1, 0, 1); SA_LOAD(s1, 5);
        SA_BAR();
        for (int j = 0; j < 62; j += 2) {
            SA_LOADER(j, s2, s3, SA_BUF);
            SA_BAR();
            SA_LOADER(j + 1, s0, s1, 0);
            SA_BAR();
        }
        SA_LOADER(62, s2, s3, SA_BUF);
        SA_BAR();
        SA_TAIL64(0);
        SA_BAR();
        if (half == 1) SA_BAR();
        SA_BAR();
    }
#undef SA_BAR
#undef SA_LOAD
#undef SA_WRITE
#undef SA_PK4
#undef SA_COMPUTE
#undef SA_KLD
#undef SA_VLD
#undef SA_VMM
#undef SA_LOADER
#undef SA_TAIL64

    float* parto = (float*)(ws + WS_PART) + (size_t)(b * 2 + half) * 64 * 128;
    __syncthreads();
    { bf16x8 ao[16];
#pragma unroll
      for (int ks = 0; ks < 16; ++ks) { u32x4 z = {0u, 0u, 0u, 0u}; if (r32 < DS) z = *(const LAS u32x4*)(lds + SA_OI + (r32 * 8 + wave) * SA_QI_PITCH + (16 * ks + 8 * g) * 2); ao[ks] = __builtin_bit_cast(bf16x8, z); }
      const bf16_t* wv = (const bf16_t*)(ws + WS_WUVP) + (size_t)wave * (64 * 512) + lane * 8;
#pragma unroll 2
      for (int nt = 0; nt < 4; ++nt) {
          f32x16 acc;
#pragma unroll
          for (int i = 0; i < 16; ++i) acc[i] = 0.f;
#pragma unroll
          for (int ks = 0; ks < 16; ++ks) acc = __builtin_amdgcn_mfma_f32_32x32x16_bf16(ao[ks], *(const bf16x8*)(wv + (nt * 16 + ks) * 512), acc, 0, 0, 0);
#pragma unroll
          for (int i = 0; i < 4; ++i) parto[(size_t)((i + 4 * g) * 8 + wave) * 128 + 32 * nt + r32] = acc[i];
      } }
    volatile LAS unsigned* flag = (volatile LAS unsigned*)(lds + MISC_OFF) + 16;
    asm volatile("s_waitcnt vmcnt(0)" ::: "memory");
    __syncthreads();
    if (tid == 0) {
        __builtin_amdgcn_fence(__ATOMIC_RELEASE, "agent");
        asm volatile("s_waitcnt vmcnt(0)" ::: "memory");
        const unsigned old = __hip_atomic_fetch_add((unsigned*)(ws + WS_CTL) + CW_SCNT + 64 * b, 1u, __ATOMIC_RELAXED, __HIP_MEMORY_SCOPE_AGENT);
        if (old == 1u) { __builtin_amdgcn_fence(__ATOMIC_ACQUIRE, "agent"); asm volatile("s_waitcnt vmcnt(0)" ::: "memory"); }
        flag[0] = old;
    }
    __syncthreads();
    if (flag[0] == 1u) {
        const int q = tid >> 3, v0 = (tid & 7) * 16, tok = q >> 3, h = q & 7;
        const float* mlb = (const float*)(ws + WS_ML) + ((size_t)(b * 2) * 64 + q) * 2; const float* pab = (const float*)(ws + WS_PART) + ((size_t)(b * 2) * 64 + q) * 128 + v0;
        const float m0 = mlb[0], l0 = mlb[1], m1 = mlb[128], l1 = mlb[129], mx = fmaxf(m0, m1);
        float w0 = __builtin_amdgcn_exp2f(m0 - mx), w1 = __builtin_amdgcn_exp2f(m1 - mx); const float inv = 1.0f / (w0 * l0 + w1 * l1); w0 *= inv; w1 *= inv;
        f32x4 a[4];
#pragma unroll
        for (int c = 0; c < 4; ++c) a[c] = *(const f32x4*)(pab + 4 * c) * w0 + *(const f32x4*)(pab + 64 * 128 + 4 * c) * w1;
        bf16_t* od = (bf16_t*)(ws + WS_OBUF) + (size_t)(MP + b * DS + tok) * D + h * VD + v0;
        *(bf16x8*)od = pack8v(a[0], a[1]); *(bf16x8*)(od + 8) = pack8v(a[2], a[3]);
    }
}

template <int W>
__device__ __forceinline__ void pool_chunk(const float* __restrict__ xr, int rvb, f32x4 gn, int col, int t0, bf16_t* __restrict__ drow) {
    f32x4 ring[W - 1]; f32x4 sum = {0.f, 0.f, 0.f, 0.f};
#pragma unroll
    for (int i = W - 1; i >= 1; --i) { f32x4 u = {0.f, 0.f, 0.f, 0.f};
        if (t0 - i >= 0) u = *(const f32x4*)(xr - (size_t)i * D + col) * __builtin_bit_cast(float, __builtin_amdgcn_readlane(rvb, 15 - i));
        ring[(W - 1 - i) % (W - 1)] = u; sum += u; }
#pragma unroll
    for (int r = 0; r < 16; ++r) {
        const f32x4 u = *(const f32x4*)(xr + (size_t)r * D + col) * __builtin_bit_cast(float, __builtin_amdgcn_readlane(rvb, 15 + r));
        sum += u;
        const int t = t0 + r; const float icnt = 1.0f / (float)((t + 1) < W ? (t + 1) : W);
        const f32x4 dd = (sum * icnt - u) * gn;
        u32x2 o; o.x = pk2(dd.x, dd.y); o.y = pk2(dd.z, dd.w);
        *(u32x2*)(drow + (size_t)r * D + col) = o;
        sum -= ring[r % (W - 1)]; ring[r % (W - 1)] = u;
    }
}
constexpr int NPH = 17;
__global__ void __launch_bounds__(512, 2) yoco_fwd(Params P) {
    extern __shared__ __attribute__((aligned(16))) unsigned char lds_raw[];
    LAS unsigned char* lds = (LAS unsigned char*)lds_raw;
    volatile LAS unsigned* MISC = (volatile LAS unsigned*)(lds + MISC_OFF);
    const int tid = threadIdx.x, lane = tid & 63, wave = __builtin_amdgcn_readfirstlane(tid >> 6);
    const int G = gridDim.x; const int bx = blockIdx.x; const int vcu = (G % 8 == 0) ? (bx % 8) * (G / 8) + bx / 8 : bx;
    unsigned char* ws = P.ws; float* out = P.out;
    for (int u = tid; u < 64; u += 512) MISC[u] = 0u;
    __syncthreads();
    XcdBarrier bar; bar.bar = (unsigned*)(ws + WS_CTL) + CW_BAR; bar.x = 0; bar.st = nullptr;
    if (MK_N_LAUNCHES == 1) bar = xcd_barrier_post((unsigned*)(ws + WS_CTL) + CW_BAR, MISC + 8);
    const int lo = P.ph_lo, hi = P.ph_hi;
#ifndef PH_MASK
#define PH_MASK 0xFFFFFFFFu
#endif
#define IN(k) (((PH_MASK >> (k)) & 1u) && lo <= (k) && (k) < hi)
#define SEAM(k) do { if (IN(k) && IN((k) + 1)) xcd_barrier(bar); } while (0)
#define SEAM2(k, kn) do { if (IN(k) && IN(kn)) xcd_barrier(bar); } while (0)
    const int gw = vcu * 8 + wave, NGW = G * 8;
    const int gtid = vcu * 512 + tid, NGT = G * 512;

#define wpool ((bf16_t*)(ws + WS_WPOOL))
#define wup ((bf16_t*)(ws + WS_WUP))
#define wdown ((bf16_t*)(ws + WS_WDOWN))
#define wgate ((bf16_t*)(ws + WS_WGATE))
#define wproj ((bf16_t*)(ws + WS_WPROJ))
#define wdkvq ((bf16_t*)(ws + WS_WDKVQ))
#define wuq ((bf16_t*)(ws + WS_WUQ))
#define wukt ((bf16_t*)(ws + WS_WUKT))
#define wuvt ((bf16_t*)(ws + WS_WUVT))
#define wukb ((bf16_t*)(ws + WS_WUKB))
#define wo ((bf16_t*)(ws + WS_WO))
#define cs ((float*)(ws + WS_CS))
#define rstd0 ((float*)(ws + WS_RSTD0))
#define dbuf ((bf16_t*)(ws + WS_DBUF))
#define pb ((bf16_t*)(ws + WS_PB))
#define hbA ((bf16_t*)(ws + WS_HBA))
#define hbB ((bf16_t*)(ws + WS_HBB))
#define ssq ((float*)(ws + WS_SSQ))
#define abuf ((bf16_t*)(ws + WS_ABUF))
#define proj ((bf16_t*)(ws + WS_PROJ))
#define craw ((float*)(ws + WS_RAW))
#define ssqc ((float*)(ws + WS_RAW + (size_t)M * KVR * 4))
#define ssqq ((float*)(ws + WS_RAW + (size_t)M * KVR * 4 + (size_t)M * 16))
#define cb ((bf16_t*)(ws + WS_CB))
#define krbs ((bf16_t*)(ws + WS_KRBS))
#define cqb ((bf16_t*)(ws + WS_CQB))
#define qbuf ((bf16_t*)(ws + WS_QBUF))
#define qs ((bf16_t*)(ws + WS_QS))
#define kfull ((bf16_t*)(ws + WS_KFULL))
#define vt ((bf16_t*)(ws + WS_VT))
#define obuf ((bf16_t*)(ws + WS_OBUF))
    constexpr size_t SSQ_V = (size_t)M * 16;

    constexpr int NU6 = (M / 256) * (NDKVQ / 256);
    const bool defer_l1 = (MK_N_LAUNCHES == 1) && G >= NU6 + 32;
    if (IN(0)) {
        LAS float* scr = (LAS float*)(lds + wave * 16384);
        int it = gw;
#define TI(W_, ks_, K_, N_, WT_, ro_) { const int n_items = ((K_) / 64) * ((N_) / 32); for (; it < n_items; it += NGW) transpose_item(W_, ks_, K_, N_, WT_, ro_, scr, it, lane); it -= n_items; }
        TI(P.in[I_POOLW] + 0 * 65536, nullptr, 256, 256, wpool, 0) TI(P.in[I_POOLW] + 1 * 65536, nullptr, 256, 256, wpool, 256)
        TI(P.in[I_POOLW] + 2 * 65536, nullptr, 256, 256, wpool, 512) TI(P.in[I_POOLW] + 3 * 65536, nullptr, 256, 256, wpool, 768)
        TI(P.in[I_WUP], P.in[I_NMLP], D, FF, wup, 0) if (!defer_l1) TI(P.in[I_WUP] + (size_t)D * FF, P.in[I_NMLP] + D, D, FF, wup + (size_t)FF * D, 0)
        TI(P.in[I_WDOWN], nullptr, FF, D, wdown, 0) if (!defer_l1) TI(P.in[I_WDOWN] + (size_t)D * FF, nullptr, FF, D, wdown + (size_t)FF * D, 0)
        TI(P.in[I_WGATE], P.in[I_NPLE], D, D, wgate, 0) if (!defer_l1) TI(P.in[I_WGATE] + (size_t)D * D, P.in[I_NPLE] + D, D, D, wgate + (size_t)D * D, 0)
        TI(P.in[I_WPROJ], nullptr, PLE, D, wproj, 0) TI(P.in[I_WPROJ] + (size_t)PLE * D, nullptr, PLE, D, wproj + (size_t)PLE * D, 0)
        { const int n_items = (D / 64) * (320 / 32); for (; it < n_items; it += NGW) transpose_item<2>(P.in[I_WDKV], P.in[I_NKV], D, 320, wdkvq, 0, scr, it, lane); it -= n_items; }
        TI(P.in[I_WDQ], P.in[I_NMIX] + D, D, QR, wdkvq, 320)
        { const int n_items = (QR / 64) * (NH * QH / 32); for (; it < n_items; it += NGW) transpose_item<1>(P.in[I_WUQ], P.in[I_QN], QR, NH * QH, wuq, 0, scr, it, lane); it -= n_items; }
        TI(P.in[I_WUK], P.in[I_KVN], KVR, 1024, wukt, 0) TI(P.in[I_WUV], P.in[I_KVN], KVR, 1024, wuvt, 0)
        if (!defer_l1) TI(P.in[I_WO], nullptr, D, D, wo, 0)
#undef TI
        for (int i = gtid; i < 64 * D / 8; i += NGT) *(u32x4*)(wdkvq + (size_t)704 * D + (size_t)i * 8) = (u32x4){0u, 0u, 0u, 0u};
        for (int i = gtid; i < 256 * 1024 / 8; i += NGT) { const int ln = i & 63, ks = (i >> 6) & 7, nt = (i >> 9) & 7, h = i >> 12;
            const float* sp = P.in[I_WUK] + (size_t)(32 * nt + (ln & 31)) * 1024 + h * NOPE + 16 * ks + 8 * (ln >> 5);
            *(bf16x8*)(wukb + (size_t)i * 8) = pack8v(*(const f32x4*)sp, *(const f32x4*)(sp + 4)); }
        for (int i = gtid; i < 256 * 1024 / 8; i += NGT) { const int ln = i & 63, ks = (i >> 6) & 15, nt = (i >> 10) & 3, h = i >> 12;
            const float* sp = P.in[I_WUV] + (size_t)(16 * ks + 8 * (ln >> 5)) * 1024 + h * VD + 32 * nt + (ln & 31);
            float t[8];
#pragma unroll
            for (int e = 0; e < 8; ++e) t[e] = sp[(size_t)e * 1024];
            *(bf16x8*)((bf16_t*)(ws + WS_WUVP) + (size_t)i * 8) = pack8(t); }
        for (int i = gtid; i < NPOS * 32; i += NGT) { const int pos = i >> 5, f = i & 31; const double inv = exp2(-(double)f * (13.287712379549449 / 32.0)); const double ang = (double)pos * inv;
            double sn, cn; sincos(ang, &sn, &cn); cs[(size_t)pos * 64 + f] = (float)cn; cs[(size_t)pos * 64 + 32 + f] = (float)sn; }
        for (int i = gtid; i < 2 * M * PLE / 8; i += NGT) { const int li = i / (M * PLE / 8), r8 = i % (M * PLE / 8); const size_t e = (size_t)r8 * 8; const int row = (int)(e / PLE), c = (int)(e % PLE);
            const float* src = row < MP ? P.in[I_PP] + ((size_t)li * MP + row) * PLE + c : P.in[I_PS] + ((size_t)li * MS + (row - MP)) * PLE + c;
            *(bf16x8*)(pb + ((size_t)li * M + row) * PLE + c) = pack8v(*(const f32x4*)src, *(const f32x4*)(src + 4)); }
        for (int row0 = gw; row0 < M; row0 += 2 * NGW) {
            f32x4 v[2][4];
#pragma unroll
            for (int rr = 0; rr < 2; ++rr) { const int row = row0 + rr * NGW; if (row < M) { const float* xr = row < MP ? P.in[I_XP] + (size_t)row * D : P.in[I_XS] + (size_t)(row - MP) * D;
#pragma unroll
                for (int j = 0; j < 4; ++j) v[rr][j] = ((const f32x4*)xr)[lane + 64 * j]; } }
#pragma unroll
            for (int rr = 0; rr < 2; ++rr) { const int row = row0 + rr * NGW; if (row < M) {
                float s = 0.f;
#pragma unroll
                for (int j = 0; j < 4; ++j) s += (v[rr][j].x * v[rr][j].x + v[rr][j].y * v[rr][j].y) + (v[rr][j].z * v[rr][j].z + v[rr][j].w * v[rr][j].w);
                const float rstd = 1.0f / sqrtf(wave_sum(s) * (1.0f / D) + EPS);
                if (lane == 0) rstd0[row] = rstd;
                float* po = nullptr;
                if (row < MP) { const int b = row >> 13, t = row & (SEQ - 1); if (t >= SEQ - 15) po = out + O_PP + ((size_t)b * 15 + (t - (SEQ - 15))) * D; }
                else { const int rs_ = row - MP, b = rs_ >> 3, t = rs_ & 7; po = out + O_PS + ((size_t)b * 15 + 7 + t) * D; }
                if (po) {
#pragma unroll
                    for (int j = 0; j < 4; ++j) { const f32x4 gn = ((const f32x4*)P.in[I_NMIX])[lane + 64 * j]; ((f32x4*)po)[lane + 64 * j] = v[rr][j] * rstd * gn; } }
            } }
        }
        for (int i = gtid; i < DB * 7 * D / 4; i += NGT) { const int b = i / (7 * D / 4), r = (i / (D / 4)) % 7, c = i % (D / 4);
            ((f32x4*)(out + O_PS + ((size_t)b * 15 + r) * D))[c] = ((const f32x4*)(P.in[I_SPOOL] + ((size_t)b * 15 + 8 + r) * D))[c]; }
    }
    SEAM2(0, 2);
    if (IN(2)) {
#ifndef SUBM
#define SUBM 7
#endif
        { SgH<0> E{P.in[I_XS], P.in[I_POOLSC], nullptr, nullptr, nullptr, hbA, ssq + 0 * SSQ_V};
          for (int u = vcu; u < 256; u += G) {
              const int mt = u >> 4, gq = (u & 15) >> 2, w = 2 << gq, col = 256 * gq + 4 * lane, bs = mt * 8 + wave;
              const float* sp = P.in[I_SPOOL] + (size_t)bs * 15 * D; const float* xs0 = P.in[I_XS] + (size_t)(bs * DS) * D;
              const float rv = (lane < DS) ? rstd0[MP + bs * DS + lane] : 0.f;
              const f32x4 gn = *(const f32x4*)(P.in[I_NMIX] + col);
#pragma unroll
              for (int t = 0; t < DS; ++t) {
                  const f32x4 u0 = *(const f32x4*)(xs0 + (size_t)t * D + col) * __shfl(rv, t); f32x4 sum = u0, hist = {0.f, 0.f, 0.f, 0.f};
#pragma unroll
                  for (int i = 1; i < 16; ++i) if (i < w) { const int tt = t - i;
                      if (tt >= 0) sum += *(const f32x4*)(xs0 + (size_t)tt * D + col) * __shfl(rv, tt >= 0 ? tt : 0);
                      else hist += *(const f32x4*)(sp + (size_t)(15 + tt) * D + col); }
                  const f32x4 dd = (sum * gn + hist) / (float)w - u0 * gn;
                  u32x2 o; o.x = pk2(dd.x, dd.y); o.y = pk2(dd.z, dd.w);
                  *(u32x2*)(dbuf + (size_t)(MP + bs * DS + t) * D + col) = o;
              }
              asm volatile("s_waitcnt vmcnt(0)" ::: "memory"); __syncthreads();
              sk_gemm(lds, dbuf + (size_t)(MP + 64 * mt) * D + 256 * gq, D, wpool + (size_t)(64 * (u & 15)) * 256, 256, 64 * mt, 64 * (u & 15), u & 15, E, tid, wave, lane); } }
        { SgBf E{proj, D};
          for (int u = vcu; u < 256; u += G) sk_gemm(lds, pb + (size_t)(MP + 64 * (u >> 4)) * PLE, PLE, wproj + (size_t)(64 * (u & 15)) * PLE, PLE, 64 * (u >> 4), 64 * (u & 15), u & 15, E, tid, wave, lane); }
        { SgBf E{proj + (size_t)M * D, D};
          for (int u = vcu; u < 256; u += G) sk_gemm(lds, pb + (size_t)(M + MP + 64 * (u >> 4)) * PLE, PLE, wproj + (size_t)PLE * D + (size_t)(64 * (u & 15)) * PLE, PLE, 64 * (u >> 4), 64 * (u & 15), u & 15, E, tid, wave, lane); }
        if (SUBM & 1) { pg8::Gemm g{dbuf, wpool, MP, D, 256, D, 256}; pg8::StaticOrder S; S.init(MP, D, G, bx);
          {
            pg8::Unit uu;
            for (int i = 0; S.next(i, uu); ++i) {
#pragma unroll 1
                for (int cc = 0; cc < 2; ++cc) {
                    const int row0 = uu.pm * 256 + (2 * wave + cc) * 16, t0 = row0 & (SEQ - 1), col = 256 * uu.pn + 4 * lane;
                    const float rv = (lane < 31 && t0 - 15 + lane >= 0) ? rstd0[row0 - 15 + lane] : 0.f;
                    const int rvb = __builtin_bit_cast(int, rv);
                    const float* xr = P.in[I_XP] + (size_t)row0 * D; bf16_t* dr = dbuf + (size_t)row0 * D; const f32x4 gn = *(const f32x4*)(P.in[I_NMIX] + col);
                    if (uu.pn == 0) pool_chunk<2>(xr, rvb, gn, col, t0, dr); else if (uu.pn == 1) pool_chunk<4>(xr, rvb, gn, col, t0, dr);
                    else if (uu.pn == 2) pool_chunk<8>(xr, rvb, gn, col, t0, dr); else pool_chunk<16>(xr, rvb, gn, col, t0, dr);
                } }
            asm volatile("s_waitcnt vmcnt(0)" ::: "memory"); __syncthreads(); }
          EpiH<0> E{P.in[I_XP], P.in[I_XS], P.in[I_POOLSC], nullptr, nullptr, nullptr, hbA, ssq + 0 * SSQ_V};
          pg8::gemm_phase(lds, g, S, E); }
        if (SUBM & 2) { pg8::Gemm g{pb, wproj, MP, D, PLE, PLE, 0}; pg8::StaticOrder S; S.init(MP, D, G, bx);
          EpiBf E{proj, D};
          pg8::gemm_phase(lds, g, S, E); }
        if (SUBM & 4) { pg8::Gemm g{pb + (size_t)M * PLE, wproj + (size_t)PLE * D, MP, D, PLE, PLE, 0}; pg8::StaticOrder S; S.init(MP, D, G, bx);
          EpiBf E{proj + (size_t)M * D, D};
          pg8::gemm_phase(lds, g, S, E); }
    }
    SEAM(2);
    if (IN(3)) {
        { SgUp E{ssq + 0 * SSQ_V, abuf}; for (int u = vcu; u < 256; u += G) sk_gemm_w(lds, hbA + (size_t)(MP + 64 * (u & 15)) * D, D, wup + (size_t)(256 * (u >> 4)) * D, D, 64 * (u & 15), 256 * (u >> 4), E, tid, wave, lane); }
        pg8::Gemm g{hbA, wup, MP, FF, D, D, 0}; pg8::StaticOrder S; S.init(MP, FF, G, bx); EpiUp E{ssq + 0 * SSQ_V, abuf}; pg8::gemm_phase(lds, g, S, E); }
    SEAM(3);
    if (IN(4)) {
        { SgH<1> E{nullptr, nullptr, nullptr, nullptr, hbA, hbB, ssq + 1 * SSQ_V}; for (int u = vcu; u < 256; u += G) sk_gemm(lds, abuf + (size_t)(MP + 64 * (u >> 4)) * FF, FF, wdown + (size_t)(64 * (u & 15)) * FF, FF, 64 * (u >> 4), 64 * (u & 15), u & 15, E, tid, wave, lane); }
        pg8::Gemm g{abuf, wdown, MP, D, FF, FF, 0}; pg8::StaticOrder S; S.init(MP, D, G, bx);
        EpiH<1> E{nullptr, nullptr, nullptr, nullptr, nullptr, hbA, hbB, ssq + 1 * SSQ_V}; pg8::gemm_phase(lds, g, S, E); }
    SEAM(4);
    if (IN(5)) {
        { SgH<2> E{nullptr, nullptr, ssq + 1 * SSQ_V, proj, hbB, hbA, ssq + 2 * SSQ_V}; for (int u = vcu; u < 256; u += G) sk_gemm(lds, hbB + (size_t)(MP + 64 * (u >> 4)) * D, D, wgate + (size_t)(64 * (u & 15)) * D, D, 64 * (u >> 4), 64 * (u & 15), u & 15, E, tid, wave, lane); }
        pg8::Gemm g{hbB, wgate, MP, D, D, D, 0}; pg8::StaticOrder S; S.init(MP, D, G, bx);
        EpiH<2> E{nullptr, nullptr, nullptr, ssq + 1 * SSQ_V, proj, hbB, hbA, ssq + 2 * SSQ_V}; pg8::gemm_phase(lds, g, S, E); }
    SEAM(5);
    if (IN(6)) {
        if (defer_l1 && bx >= NU6) {
            LAS float* scr = (LAS float*)(lds + wave * 16384);
            const int nst = (G - NU6) * 8; int it = (bx - NU6) * 8 + wave;
#define TI(W_, ks_, K_, N_, WT_, ro_) { const int n_items = ((K_) / 64) * ((N_) / 32); for (; it < n_items; it += nst) transpose_item(W_, ks_, K_, N_, WT_, ro_, scr, it, lane); it -= n_items; }
            TI(P.in[I_WUP] + (size_t)D * FF, P.in[I_NMLP] + D, D, FF, wup + (size_t)FF * D, 0) TI(P.in[I_WDOWN] + (size_t)D * FF, nullptr, FF, D, wdown + (size_t)FF * D, 0)
            TI(P.in[I_WGATE] + (size_t)D * D, P.in[I_NPLE] + D, D, D, wgate + (size_t)D * D, 0) TI(P.in[I_WO], nullptr, D, D, wo, 0)
#undef TI
        }
        pg8::Gemm g{hbA, wdkvq, M, NDKVQ, D, D, 0}; pg8::StaticOrder S; S.init(M, NDKVQ, G, bx); EpiDkvq E{ssq + 2 * SSQ_V, cs, craw, cb, cqb, ssqc, ssqq, out, kfull, krbs}; pg8::gemm_phase(lds, g, S, E); }
    SEAM2(6, 8);
    if (IN(8)) {
        if (SUBM & 1) { pg8::Gemm g{cqb, wuq, M, NH * QH, QR, QR, 0}; pg8::StaticOrder S; S.init(M, NH * QH, G, bx); EpiQ E{ssqq, cs, qbuf, qs}; pg8::gemm_phase(lds, g, S, E); }
        if (SUBM & 2) { pg8::Gemm g{cb, wukt, MP, 1024, KVR, KVR, 0}; pg8::StaticOrder S; S.init(MP, 1024, G, (bx + 128) % G); EpiKup E{kfull, ssqc}; pg8::gemm_phase(lds, g, S, E); }
        if (SUBM & 4) { pg8::Gemm g{wuvt, cb, 1024, MP, KVR, KVR, 0}; pg8::StaticOrder S; S.init(1024, MP, G, (bx + 128) % G); EpiVup E{vt, ssqc}; pg8::gemm_phase(lds, g, S, E); }
        { const f32x4 kvn = ((const f32x4*)P.in[I_KVN])[lane];
          for (int row0 = 2 * gw; row0 < M; row0 += 2 * NGW) {
              f32x4 c4[2], p4[2];
#pragma unroll
              for (int e = 0; e < 2; ++e) { c4[e] = ((const f32x4*)(craw + (size_t)(row0 + e) * KVR))[lane]; p4[e] = *(const f32x4*)(ssqc + (size_t)(row0 + e) * 4); }
#pragma unroll
              for (int e = 0; e < 2; ++e) { const int row = row0 + e; const bool isp = row < MP;
                  const float rc = 1.0f / sqrtf(((p4[e].x + p4[e].y) + (p4[e].z + p4[e].w)) * (1.0f / KVR) + EPS);
                  const f32x4 cn = c4[e] * rc * kvn;
                  float* lo_ = isp ? out + O_LP + (size_t)row * KVR : out + O_LS + (size_t)(row - MP) * KVR;
                  ((f32x4*)lo_)[lane] = cn;
                  if (!isp) { u32x2 o; o.x = pk2(cn.x, cn.y); o.y = pk2(cn.z, cn.w); ((u32x2*)(cb + (size_t)row * KVR))[lane] = o; } } } }
    }
    SEAM2(8, 10);
    if (IN(10)) {
        const bool sfirst = (bx >> 3) & 1;
        if (sfirst) for (int it = vcu; it < 2 * DB; it += G) sattn_item(P, it >> 1, it & 1, lds, tid, wave, lane);
        for (int u = vcu; u < 256; u += G) {
            const int bh = u >> 4, p = u & 15;
            attn_prompt_unit(qbuf, kfull, vt, obuf, bh >> 3, bh & 7, 31 - p, lds, tid, wave, lane);
            attn_prompt_unit(qbuf, kfull, vt, obuf, bh >> 3, bh & 7, p, lds, tid, wave, lane);
        }
        if (!sfirst) for (int it = vcu; it < 2 * DB; it += G) sattn_item(P, it >> 1, it & 1, lds, tid, wave, lane);
    }
    SEAM2(10, 12);
    if (IN(12)) {
        { SgH<1> E{nullptr, nullptr, nullptr, nullptr, hbA, hbB, ssq + 3 * SSQ_V};
          for (int u = vcu; u < 256; u += G) sk_gemm(lds, obuf + (size_t)(MP + 64 * (u >> 4)) * D, D, wo + (size_t)(64 * (u & 15)) * D, D, 64 * (u >> 4), 64 * (u & 15), u & 15, E, tid, wave, lane); }
        pg8::Gemm g{obuf, wo, MP, D, D, D, 0}; pg8::StaticOrder S; S.init(MP, D, G, bx);
        EpiH<1> E{nullptr, nullptr, nullptr, nullptr, nullptr, hbA, hbB, ssq + 3 * SSQ_V}; pg8::gemm_phase(lds, g, S, E); }
    SEAM(12);
    if (IN(13)) {
        { SgUp E{ssq + 3 * SSQ_V, abuf}; for (int u = vcu; u < 256; u += G) sk_gemm_w(lds, hbB + (size_t)(MP + 64 * (u & 15)) * D, D, wup + (size_t)FF * D + (size_t)(256 * (u >> 4)) * D, D, 64 * (u & 15), 256 * (u >> 4), E, tid, wave, lane); }
        pg8::Gemm g{hbB, wup + (size_t)FF * D, MP, FF, D, D, 0}; pg8::StaticOrder S; S.init(MP, FF, G, bx); EpiUp E{ssq + 3 * SSQ_V, abuf}; pg8::gemm_phase(lds, g, S, E); }
    SEAM(13);
    if (IN(14)) {
        { SgH<1> E{nullptr, nullptr, nullptr, nullptr, hbB, hbA, ssq + 4 * SSQ_V}; for (int u = vcu; u < 256; u += G) sk_gemm(lds, abuf + (size_t)(MP + 64 * (u >> 4)) * FF, FF, wdown + (size_t)FF * D + (size_t)(64 * (u & 15)) * FF, FF, 64 * (u >> 4), 64 * (u & 15), u & 15, E, tid, wave, lane); }
        pg8::Gemm g{abuf, wdown + (size_t)FF * D, MP, D, FF, FF, 0}; pg8::StaticOrder S; S.init(MP, D, G, bx);
        EpiH<1> E{nullptr, nullptr, nullptr, nullptr, nullptr, hbB, hbA, ssq + 4 * SSQ_V}; pg8::gemm_phase(lds, g, S, E); }
    SEAM(14);
    if (IN(15)) {
        { SgH<2> E{nullptr, nullptr, ssq + 4 * SSQ_V, proj + (size_t)M * D, hbA, hbB, ssq + 5 * SSQ_V}; for (int u = vcu; u < 256; u += G) sk_gemm(lds, hbA + (size_t)(MP + 64 * (u >> 4)) * D, D, wgate + (size_t)D * D + (size_t)(64 * (u & 15)) * D, D, 64 * (u >> 4), 64 * (u & 15), u & 15, E, tid, wave, lane); }
        pg8::Gemm g{hbA, wgate + (size_t)D * D, MP, D, D, D, 0}; pg8::StaticOrder S; S.init(MP, D, G, bx);
        EpiH<2> E{nullptr, nullptr, nullptr, ssq + 4 * SSQ_V, proj + (size_t)M * D, hbA, hbB, ssq + 5 * SSQ_V}; pg8::gemm_phase(lds, g, S, E); }
    SEAM(15);
    if (IN(16)) {
        f32x4 gn[4];
#pragma unroll
        for (int j = 0; j < 4; ++j) gn[j] = ((const f32x4*)P.in[I_NFIN])[lane + 64 * j];
        for (int row0 = 4 * gw; row0 < M; row0 += 4 * NGW) {
            u32x2 hv[4][4]; float sp[4];
#pragma unroll
            for (int e = 0; e < 4; ++e) { sp[e] = (lane < 16) ? ssq[5 * SSQ_V + (size_t)(row0 + e) * 16 + lane] : 0.f;
#pragma unroll
                for (int j = 0; j < 4; ++j) hv[e][j] = ((const u32x2*)(hbB + (size_t)(row0 + e) * D))[lane + 64 * j]; }
#pragma unroll
            for (int e = 0; e < 4; ++e) { const float rstd = 1.0f / sqrtf(wave_sum(sp[e]) * (1.0f / D) + EPS);
#pragma unroll
                for (int j = 0; j < 4; ++j) ((f32x4*)(out + O_Y + (size_t)(row0 + e) * D))[lane + 64 * j] = unpk4(hv[e][j]) * rstd * gn[j]; }
        }
    }
#undef IN
#undef SEAM
#undef SEAM2
#undef wpool
#undef wup
#undef wdown
#undef wgate
#undef wproj
#undef wdkvq
#undef wuq
#undef wukt
#undef wuvt
#undef wukb
#undef wo
#undef cs
#undef rstd0
#undef dbuf
#undef pb
#undef hbA
#undef hbB
#undef ssq
#undef abuf
#undef proj
#undef craw
#undef ssqc
#undef ssqq
#undef cb
#undef krbs
#undef cqb
#undef qbuf
#undef qs
#undef kfull
#undef vt
#undef obuf
}

extern "C" void kernel_launch(void* const* d_in, const int* in_sizes, int n_in, void* d_out, int out_size, void* d_ws, size_t ws_size, hipStream_t stream) {
    static int grid = 0;
    if (grid == 0) {
        if (n_in != 27 || (size_t)out_size != O_END || ws_size < WS_END) { fprintf(stderr, "kernel_launch: shape mismatch (n_in %d, out %d, ws %zu; need 27, %zu, %zu)\n", n_in, out_size, ws_size, (size_t)O_END, (size_t)WS_END); grid = -1; return; }
        int dev = 0, cus = 0, per_cu = 0;
        if (hipGetDevice(&dev) != hipSuccess || hipDeviceGetAttribute(&cus, hipDeviceAttributeMultiprocessorCount, dev) != hipSuccess) { grid = -1; return; }
        if (hipFuncSetAttribute((const void*)yoco_fwd, hipFuncAttributeMaxDynamicSharedMemorySize, LDS_BYTES) != hipSuccess) { fprintf(stderr, "kernel_launch: hipFuncSetAttribute failed\n"); grid = -1; return; }
        if (hipOccupancyMaxActiveBlocksPerMultiprocessor(&per_cu, (const void*)yoco_fwd, 512, LDS_BYTES) != hipSuccess || per_cu < 1) fprintf(stderr, "kernel_launch: occupancy query reports %d\n", per_cu);
        (void)hipGetLastError();
        grid = cus;
    }
    if (grid < 0) return;
    (void)hipMemsetAsync((char*)d_ws + WS_CTL, 0, CTL_BYTES, stream);
    Params p{};
    for (int i = 0; i < 27; ++i) p.in[i] = (const float*)d_in[i];
    p.out = (float*)d_out; p.ws = (unsigned char*)d_ws;
#if MK_N_LAUNCHES == 1
    p.ph_lo = 0; p.ph_hi = NPH;
    hipLaunchKernelGGL(yoco_fwd, dim3(grid), dim3(512), LDS_BYTES, stream, p);
#else
    for (int k = 0; k < NPH; ++k) { p.ph_lo = k; p.ph_hi = k + 1; hipLaunchKernelGGL(yoco_fwd, dim3(grid), dim3(512), LDS_BYTES, stream, p); }
#endif
    const hipError_t le = hipPeekAtLastError();
    if (le != hipSuccess) fprintf(stderr, "kernel_launch: launch failed: %s\n", hipGetErrorName(le));
}
```

```cpp
#include <hip/hip_runtime.h>
#include <cstdio>
#include <cstdint>

#ifndef MK_N_LAUNCHES
#define MK_N_LAUNCHES 1
#endif

#define GAS __attribute__((address_space(1)))
#define LAS __attribute__((address_space(3)))
typedef unsigned short bf16_t;
typedef short bf16x8 __attribute__((ext_vector_type(8)));
typedef float f32x4 __attribute__((ext_vector_type(4)));
typedef float f32x16 __attribute__((ext_vector_type(16)));
typedef unsigned u32x2 __attribute__((ext_vector_type(2)));
typedef unsigned u32x4 __attribute__((ext_vector_type(4)));

constexpr int D = 1024, FF = 4096, PLE = 256, SEQ = 8192, NBATCH = 2, DB = 128, DS = 8;
constexpr int MP = NBATCH * SEQ;
constexpr int MS = DB * DS;
constexpr int M = MP + MS;
constexpr int KVR = 256, ROPE = 64, QR = 384, NH = 8, NOPE = 128, VD = 128, QH = NOPE + ROPE;
constexpr int NDKVQ = 768;
constexpr int PAST = 8192, PAGE = 128, NPG = PAST / PAGE;
constexpr float EPS = 1e-6f;
constexpr float SM_SCALE = 0.07216878364870322f;
constexpr float LOG2E = 1.4426950408889634f;
constexpr float CEXP = SM_SCALE * LOG2E;
constexpr int NPOS = PAST + DS;

constexpr size_t O_Y = 0;
constexpr size_t O_PP = (size_t)M * D;
constexpr size_t O_PS = O_PP + (size_t)NBATCH * 15 * D;
constexpr size_t O_LP = O_PS + (size_t)DB * 15 * D;
constexpr size_t O_KP = O_LP + (size_t)MP * KVR;
constexpr size_t O_LS = O_KP + (size_t)MP * ROPE;
constexpr size_t O_KS = O_LS + (size_t)MS * KVR;
constexpr size_t O_END = O_KS + (size_t)MS * ROPE;

constexpr size_t al256(size_t x) { return (x + 255) / 256 * 256; }
constexpr size_t WS_CTL = 0, CTL_BYTES = 1u << 20;
constexpr size_t WS_WPOOL = CTL_BYTES;
constexpr size_t WS_WUP   = WS_WPOOL + al256((size_t)1024 * 256 * 2);
constexpr size_t WS_WDOWN = WS_WUP   + al256((size_t)2 * FF * D * 2);
constexpr size_t WS_WGATE = WS_WDOWN + al256((size_t)2 * FF * D * 2);
constexpr size_t WS_WPROJ = WS_WGATE + al256((size_t)2 * D * D * 2);
constexpr size_t WS_WDKVQ = WS_WPROJ + al256((size_t)2 * D * PLE * 2);
constexpr size_t WS_WUQ   = WS_WDKVQ + al256((size_t)NDKVQ * D * 2);
constexpr size_t WS_WUKT  = WS_WUQ   + al256((size_t)NH * QH * QR * 2);
constexpr size_t WS_WUVT  = WS_WUKT  + al256((size_t)1024 * 256 * 2);
constexpr size_t WS_WUVP  = WS_WUVT  + al256((size_t)1024 * 256 * 2);
constexpr size_t WS_WUKB  = WS_WUVP  + al256((size_t)1024 * 256 * 2);
constexpr size_t WS_WO    = WS_WUKB  + al256((size_t)1024 * 256 * 2);
constexpr size_t WS_CS    = WS_WO    + al256((size_t)D * D * 2);
constexpr size_t WS_RSTD0 = WS_CS    + al256((size_t)NPOS * 64 * 4);
constexpr size_t WS_DBUF  = WS_RSTD0 + al256((size_t)M * 4);
constexpr size_t WS_PB    = WS_DBUF  + al256((size_t)M * D * 2);
constexpr size_t WS_HBA   = WS_PB    + al256((size_t)2 * M * PLE * 2);
constexpr size_t WS_HBB   = WS_HBA   + al256((size_t)M * D * 2);
constexpr size_t WS_SSQ   = WS_HBB   + al256((size_t)M * D * 2);
constexpr size_t WS_ABUF  = WS_SSQ   + al256((size_t)6 * M * 16 * 4);
constexpr size_t WS_PROJ  = WS_ABUF  + al256((size_t)M * FF * 2);
constexpr size_t WS_RAW   = WS_PROJ  + al256((size_t)2 * M * D * 2);
constexpr size_t WS_CB    = WS_RAW   + al256((size_t)M * NDKVQ * 4);
constexpr size_t WS_KRBS  = WS_CB    + al256((size_t)M * KVR * 2);
constexpr size_t WS_CQB   = WS_KRBS  + al256((size_t)MS * ROPE * 2);
constexpr size_t WS_RSTDQ = WS_CQB   + al256((size_t)M * QR * 2);
constexpr size_t WS_QBUF  = WS_RSTDQ + al256((size_t)M * 4);
constexpr size_t WS_QS    = WS_QBUF  + al256((size_t)M * NH * QH * 2);
constexpr size_t WS_KFULL = WS_QS    + al256((size_t)MS * NH * 320 * 2);
constexpr size_t WS_VT    = WS_KFULL + al256((size_t)16 * SEQ * QH * 2);
constexpr size_t WS_OBUF  = WS_VT    + al256((size_t)16 * VD * SEQ * 2);
constexpr size_t WS_PART  = WS_OBUF  + al256((size_t)M * D * 2);
constexpr size_t WS_ML    = WS_PART  + al256((size_t)DB * 8 * 64 * 256 * 4);
constexpr size_t WS_END   = WS_ML    + al256((size_t)DB * 8 * 64 * 2 * 4);

constexpr int CW_BAR = 4096;
constexpr int CW_SCNT = 16384;

constexpr int RING_BYTES = 131072;
constexpr int LDS_BYTES = 147456;
constexpr int MISC_OFF = LDS_BYTES - 256;

typedef float f32x2 __attribute__((ext_vector_type(2)));
typedef __bf16 nbf16x2 __attribute__((ext_vector_type(2)));
__device__ __forceinline__ unsigned pk2(float lo, float hi) { const f32x2 v = {lo, hi}; return __builtin_bit_cast(unsigned, __builtin_convertvector(v, nbf16x2)); }
__device__ __forceinline__ unsigned f2bf(float f) { return pk2(f, 0.f) & 0xffffu; }
__device__ __forceinline__ float bf2f(unsigned short b) { return __builtin_bit_cast(float, ((unsigned)b) << 16); }
__device__ __forceinline__ f32x4 unpk4(u32x2 w) { f32x4 r; r.x = __builtin_bit_cast(float, w.x << 16); r.y = __builtin_bit_cast(float, w.x & 0xffff0000u); r.z = __builtin_bit_cast(float, w.y << 16); r.w = __builtin_bit_cast(float, w.y & 0xffff0000u); return r; }
__device__ __forceinline__ bf16x8 pack8(const float* v) { u32x4 w; w.x = pk2(v[0], v[1]); w.y = pk2(v[2], v[3]); w.z = pk2(v[4], v[5]); w.w = pk2(v[6], v[7]); return __builtin_bit_cast(bf16x8, w); }
__device__ __forceinline__ bf16x8 pack8v(f32x4 a, f32x4 b) { u32x4 w; w.x = pk2(a.x, a.y); w.y = pk2(a.z, a.w); w.z = pk2(b.x, b.y); w.w = pk2(b.z, b.w); return __builtin_bit_cast(bf16x8, w); }
__device__ __forceinline__ float wave_sum(float v) {
#pragma unroll
    for (int o = 1; o < 64; o <<= 1) v += __shfl_xor(v, o);
    return v;
}
__device__ __forceinline__ int crow(int r, int hi) { return (r & 3) + 8 * (r >> 2) + 4 * hi; }
#define LDS_WAIT() asm volatile("s_waitcnt lgkmcnt(0)" ::: "memory")
#define VM_WAIT() asm volatile("s_waitcnt vmcnt(0)" ::: "memory")

#define XB_TMO      128
#define XB_XCNT(j)  (256  + 64 * (j))
#define XB_XSUB(j)  (1280 + 64 * (j))
#define XB_XGEN(j)  (2304 + 64 * (j))
#define XB_TOP      3328
#define XB_TOPGEN   3392
#define XCD_BAR_WORDS 3456
#define XB_SPIN_CAP (1u << 18)
__device__ __forceinline__ unsigned xb_ld(unsigned* p)              { return __hip_atomic_load(p, __ATOMIC_RELAXED, __HIP_MEMORY_SCOPE_AGENT); }
__device__ __forceinline__ unsigned xb_add(unsigned* p, unsigned v) { return __hip_atomic_fetch_add(p, v, __ATOMIC_RELAXED, __HIP_MEMORY_SCOPE_AGENT); }
__device__ __forceinline__ unsigned xb_xcc_id() { return (unsigned)__builtin_amdgcn_s_getreg((3 << 11) | 20) & 0xFu; }
#define XB_SPIN(cond, bar) do { unsigned _sp = 0; while (cond) { __builtin_amdgcn_s_sleep(1); \
    if ((++_sp & 255u) == 0u) { if (xb_ld(&(bar)[XB_TMO])) break; if (_sp > XB_SPIN_CAP) { atomicAdd(&(bar)[XB_TMO], 1u); break; } } } } while (0)
struct XcdBarrier { unsigned* bar; unsigned x; volatile LAS unsigned* st; };
__device__ __forceinline__ XcdBarrier xcd_barrier_post(unsigned* bar, volatile LAS unsigned* st) {
    XcdBarrier b; b.bar = bar; b.x = xb_xcc_id(); b.st = st;
    if (threadIdx.x == 0) (void)xb_add(&bar[XB_XCNT(b.x)], 1u);
    return b;
}
__device__ __forceinline__ void xcd_barrier_complete(unsigned* bar, unsigned x, unsigned& nloc, unsigned& nx) {
    const unsigned G = gridDim.x * gridDim.y * gridDim.z;
    unsigned sum, cnt, mine, sp = 0u;
    for (;;) {
        sum = 0u; cnt = 0u; mine = 0u;
#pragma unroll
        for (unsigned j = 0; j < 16; ++j) { const unsigned c = xb_ld(&bar[XB_XCNT(j)]); sum += c; cnt += (c > 0u) ? 1u : 0u; mine = (j == x) ? c : mine; }
        if (sum == G) break;
        __builtin_amdgcn_s_sleep(1);
        if ((++sp & 255u) == 0u) { if (xb_ld(&bar[XB_TMO])) break; if (sp > XB_SPIN_CAP) { atomicAdd(&bar[XB_TMO], 1u); break; } }
    }
    nloc = mine > 0u ? mine : 1u; nx = cnt > 0u ? cnt : 1u;
}
__device__ __forceinline__ void xcd_barrier(const XcdBarrier& b) {
    asm volatile("s_waitcnt vmcnt(0)" ::: "memory");
    __syncthreads();
    if (threadIdx.x == 0) {
        unsigned* bar = b.bar;
        __builtin_amdgcn_s_waitcnt(0);
        unsigned nloc = b.st[0], nx = b.st[1];
        if (nloc == 0u) { xcd_barrier_complete(bar, b.x, nloc, nx); b.st[0] = nloc; b.st[1] = nx; }
        const unsigned old = xb_add(&bar[XB_XSUB(b.x)], 1u);
        const unsigned gen = old / nloc;
        if (old + 1u == (gen + 1u) * nloc) {
            __builtin_amdgcn_fence(__ATOMIC_RELEASE, "agent");
            asm volatile("s_waitcnt vmcnt(0)" ::: "memory");
            const unsigned og = xb_add(&bar[XB_TOP], 1u);
            const unsigned tg = og / nx;
            if (og + 1u == (tg + 1u) * nx) xb_add(&bar[XB_TOPGEN], 1u);
            else XB_SPIN(xb_ld(&bar[XB_TOPGEN]) == tg, bar);
            __builtin_amdgcn_fence(__ATOMIC_ACQUIRE, "agent");
            xb_add(&bar[XB_XGEN(b.x)], 1u);
            asm volatile("s_waitcnt vmcnt(0)" ::: "memory");
        } else {
            XB_SPIN(xb_ld(&bar[XB_XGEN(b.x)]) == gen, bar);
            __builtin_amdgcn_fence(__ATOMIC_ACQUIRE, "agent");
            asm volatile("s_waitcnt vmcnt(0)" ::: "memory");
        }
    }
    __syncthreads();
}

namespace pg8 {
constexpr int BM = 256, BK = 64, HALF = 128, HTB = HALF * BK * 2, STAGE_BYTES = 8 * HTB, NXCD = 8, WGM = 8;
__host__ __device__ __forceinline__ int lds_byte(int r, int c) { const int st = (r >> 4) * 2 + (c >> 5), rr = r & 15, cc = c & 31, ob = rr * 64 + cc * 2; return st * 1024 + (ob ^ (((ob >> 9) & 1) << 5)); }
__host__ __device__ __forceinline__ int perm32(int rho) { const int n = rho >> 4, i = rho & 15; return 8 * (i >> 2) + 4 * n + (i & 3); }
__host__ __device__ __forceinline__ void stage_rc(int b, int& R, int& C) { const int st = b / 1024, sb = b % 1024, swz = sb ^ (((sb >> 9) & 1) << 5); R = (st >> 1) * 16 + swz / 64; C = (st & 1) * 32 + (swz % 64) / 2; }
struct Unit { int pm, pn; };
struct Gemm { const bf16_t* A; const bf16_t* Bt; int M, N, K, lda, apn; };
struct StaticOrder {
    int nM, nN, nwg, G, c;
    __device__ __forceinline__ void init(int M, int N, int G_, int c_) { nM = M / BM; nN = N / BM; nwg = nM * nN; G = G_; c = c_; }
    __device__ __forceinline__ bool next(int i, Unit& u) const {
        const long L = (long)i * G + c; if (L >= nwg) return false;
        int wgid = (int)L; { const int q = nwg / NXCD, r = nwg % NXCD, xcd = wgid % NXCD, off = wgid / NXCD; wgid = (xcd < r ? xcd * (q + 1) : r * (q + 1) + (xcd - r) * q) + off; }
        const int nig = WGM * nN, gid = wgid / nig, fm = gid * WGM, gsz = (nM - fm) < WGM ? (nM - fm) : WGM;
        u.pm = fm + ((wgid % nig) % gsz); u.pn = (wgid % nig) / gsz; return true;
    }
};
template <class Epi>
__device__ __forceinline__ void gemm_phase(LAS unsigned char* lds, const Gemm g, const StaticOrder& S, const Epi& E) {
    const int tid = threadIdx.x, wid = __builtin_amdgcn_readfirstlane(tid >> 6), lane = tid & 63, wr = wid >> 2, wc = wid & 3, fr = lane & 15, fq = lane >> 4;
    const int K = g.K, nt = K / BK, lda = g.lda;
    unsigned voffA[2], voffB[2];
#pragma unroll
    for (int i = 0; i < 2; ++i) { int R, C; stage_rc(tid * 16 + i * 8192, R, C);
        const int Rb = Epi::PERM ? ((R & ~31) + perm32(R & 31)) : R;
        voffA[i] = (unsigned)(R * lda + C) * 2u; voffB[i] = (unsigned)(Rb * K + C) * 2u; }
    const size_t kstep = (size_t)(BK * 2);
    const size_t hstepA = (size_t)HALF * lda * 2, hstepB = (size_t)HALF * K * 2;
    const size_t tstepA = 2 * hstepA, tstepB = 2 * hstepB, pnA = (size_t)g.apn * 2;
    const unsigned ldsw = (unsigned)wid * 1024u;
    const int aoff = lds_byte(wr * 64 + fr, fq * 8), boff = lds_byte(wc * 32 + fr, fq * 8);
#define PG8_SA(b, h) (((b) * 2 + (h)) * HTB)
#define PG8_SB(b, h) ((4 + (b) * 2 + (h)) * HTB)
#define PG8_STAGE(bufoff, gbase, voff) do { _Pragma("unroll") for (int _i = 0; _i < 2; ++_i) \
        __builtin_amdgcn_global_load_lds((const unsigned*)((const char*)(gbase) + (voff)[_i]), (LAS unsigned*)(lds + (bufoff) + ldsw + _i * 8192), 16, 0, 0); } while (0)
#define PG8_LDA(dst, b, h) do { _Pragma("unroll") for (int m = 0; m < 4; ++m) _Pragma("unroll") for (int k = 0; k < 2; ++k) dst[m][k] = *(const LAS bf16x8*)(lds + PG8_SA(b, h) + aoff + m * 2048 + k * 1024); } while (0)
#define PG8_LDB(dst, b, h) do { _Pragma("unroll") for (int n = 0; n < 2; ++n) _Pragma("unroll") for (int k = 0; k < 2; ++k) dst[n][k] = *(const LAS bf16x8*)(lds + PG8_SB(b, h) + boff + n * 2048 + k * 1024); } while (0)
#define PG8_MMA(ai, bj, At, Bt) do { __builtin_amdgcn_s_setprio(1); _Pragma("unroll") for (int m = 0; m < 4; ++m) _Pragma("unroll") for (int n = 0; n < 2; ++n) _Pragma("unroll") for (int k = 0; k < 2; ++k) \
        acc[ai][bj][m][n] = __builtin_amdgcn_mfma_f32_16x16x32_bf16(Bt[n][k], At[m][k], acc[ai][bj][m][n], 0, 0, 0); __builtin_amdgcn_s_setprio(0); } while (0)
#define PG8_WAIT_V(n) asm volatile("s_waitcnt vmcnt(" #n ")" ::: "memory")
#define PG8_WAIT_L(n) asm volatile("s_waitcnt lgkmcnt(" #n ")" ::: "memory")
#define PG8_BAR __builtin_amdgcn_s_barrier()
#define PG8_SCHED __builtin_amdgcn_sched_barrier(0)
    Unit cur, nxt; int ui = 0;
    if (!S.next(0, cur)) return;
    f32x4 acc[2][2][4][2];
#pragma unroll
    for (int a = 0; a < 2; ++a)
#pragma unroll
        for (int b = 0; b < 2; ++b)
#pragma unroll
            for (int m = 0; m < 4; ++m)
#pragma unroll
                for (int n = 0; n < 2; ++n) acc[a][b][m][n] = (f32x4){0.f, 0.f, 0.f, 0.f};
    bf16x8 At[4][2], B0[2][2], B1[2][2];
    const char* cA = (const char*)g.A + (size_t)cur.pm * tstepA + (size_t)cur.pn * pnA; const char* cB = (const char*)g.Bt + (size_t)cur.pn * tstepB;
    PG8_STAGE(PG8_SB(0, 0), cB, voffB); PG8_STAGE(PG8_SB(0, 1), cB + hstepB, voffB); PG8_STAGE(PG8_SA(0, 0), cA, voffA); PG8_STAGE(PG8_SA(0, 1), cA + hstepA, voffA);
    if (wr == 1) PG8_BAR;
    PG8_WAIT_V(2); PG8_BAR;
    PG8_STAGE(PG8_SB(1, 0), cB + kstep, voffB); PG8_STAGE(PG8_SA(1, 0), cA + kstep, voffA); PG8_STAGE(PG8_SB(1, 1), cB + hstepB + kstep, voffB);
    PG8_WAIT_V(6); PG8_BAR;
    for (;;) {
        const bool has_next = S.next(ui + 1, nxt);
        const char* nA = has_next ? (const char*)g.A + (size_t)nxt.pm * tstepA + (size_t)nxt.pn * pnA : cA; const char* nB = has_next ? (const char*)g.Bt + (size_t)nxt.pn * tstepB : cB;
#pragma unroll 1
        for (int t = 0; t < nt; t += 2) {
            const bool last = (t == nt - 2);
            const char* a1 = cA + (size_t)(t + 1) * kstep;
            const char* a2 = last ? nA : cA + (size_t)(t + 2) * kstep; const char* b2 = last ? nB : cB + (size_t)(t + 2) * kstep;
            const char* a3 = a2 + kstep; const char* b3 = b2 + kstep;
            PG8_LDB(B0, 0, 0); PG8_LDB(B1, 0, 1); PG8_SCHED; PG8_LDA(At, 0, 0); PG8_STAGE(PG8_SA(1, 1), a1 + hstepA, voffA);
            PG8_WAIT_V(8); PG8_WAIT_L(0); PG8_BAR; PG8_MMA(0, 0, At, B0); PG8_MMA(0, 1, At, B1); PG8_BAR; PG8_SCHED;
            PG8_LDA(At, 0, 1); PG8_STAGE(PG8_SB(0, 0), b2, voffB); PG8_STAGE(PG8_SB(0, 1), b2 + hstepB, voffB); PG8_STAGE(PG8_SA(0, 0), a2, voffA);
            PG8_WAIT_V(8); PG8_WAIT_L(0); PG8_BAR; PG8_MMA(1, 0, At, B0); PG8_MMA(1, 1, At, B1); PG8_BAR; PG8_SCHED;
            PG8_LDB(B0, 1, 0); PG8_LDB(B1, 1, 1); PG8_SCHED; PG8_LDA(At, 1, 0); PG8_STAGE(PG8_SA(0, 1), a2 + hstepA, voffA);
            PG8_WAIT_V(8); PG8_WAIT_L(0); PG8_BAR; PG8_MMA(0, 0, At, B0); PG8_MMA(0, 1, At, B1); PG8_BAR; PG8_SCHED;
            PG8_LDA(At, 1, 1); PG8_STAGE(PG8_SB(1, 0), b3, voffB); PG8_STAGE(PG8_SB(1, 1), b3 + hstepB, voffB); PG8_STAGE(PG8_SA(1, 0), a3, voffA);
            PG8_WAIT_V(8); PG8_WAIT_L(0); PG8_BAR; PG8_MMA(1, 0, At, B0); PG8_MMA(1, 1, At, B1); PG8_BAR; PG8_SCHED;
        }
        if (wr == 0) PG8_BAR;
        E(acc, cur, wr, wc, fr, fq);
        if (!has_next) break;
#pragma unroll
        for (int a = 0; a < 2; ++a)
#pragma unroll
            for (int b = 0; b < 2; ++b)
#pragma unroll
                for (int m = 0; m < 4; ++m)
#pragma unroll
                    for (int n = 0; n < 2; ++n) acc[a][b][m][n] = (f32x4){0.f, 0.f, 0.f, 0.f};
        cur = nxt; cA = nA; cB = nB; ++ui;
        if (wr == 1) PG8_BAR;
    }
    PG8_WAIT_V(0);
    PG8_BAR;
#undef PG8_SA
#undef PG8_SB
#undef PG8_STAGE
#undef PG8_LDA
#undef PG8_LDB
#undef PG8_MMA
#undef PG8_WAIT_V
#undef PG8_WAIT_L
#undef PG8_BAR
#undef PG8_SCHED
}
}

struct Params { const float* in[27]; float* out; unsigned char* ws; int ph_lo, ph_hi; };
enum { I_XP = 0, I_XS, I_PP, I_PS, I_SPOOL, I_CLAT, I_CKR, I_PT, I_NMIX, I_NMLP, I_NPLE, I_POOLW, I_POOLSC, I_NKV, I_WDKV, I_KVN, I_WUK, I_WUV, I_WDQ, I_QN, I_WUQ, I_WO, I_WUP, I_WDOWN, I_WGATE, I_WPROJ, I_NFIN };

__device__ __forceinline__ void load_rstd(const float* ssq, const pg8::Unit& u, int wr, int fr, int fq, float (&rs)[2][4]) {
#pragma unroll
    for (int ai = 0; ai < 2; ++ai)
#pragma unroll
        for (int m = 0; m < 4; ++m) {
            const int row = u.pm * 256 + ai * 128 + wr * 64 + m * 16 + fr;
            const f32x4 a = ((const f32x4*)(ssq + (size_t)row * 16))[fq];
            float t = (a.x + a.y) + (a.z + a.w);
            t += __shfl_xor(t, 16); t += __shfl_xor(t, 32);
            rs[ai][m] = 1.0f / sqrtf(t * (1.0f / 1024.0f) + EPS);
        }
}
template <int NS> __device__ __forceinline__ void load_rstd_p(const float* ssqp, float inv_n, const pg8::Unit& u, int wr, int fr, int fq, float (&rs)[2][4]) {
#pragma unroll
    for (int ai = 0; ai < 2; ++ai)
#pragma unroll
        for (int m = 0; m < 4; ++m) {
            const int row = u.pm * 256 + ai * 128 + wr * 64 + m * 16 + fr;
            float t;
            if (NS == 4) t = ssqp[(size_t)row * 4 + fq]; else { const f32x2 a = ((const f32x2*)(ssqp + (size_t)row * 8))[fq]; t = a.x + a.y; }
            t += __shfl_xor(t, 16); t += __shfl_xor(t, 32);
            rs[ai][m] = 1.0f / sqrtf(t * inv_n + EPS);
        }
}
template <int MODE> struct EpiH {
    static constexpr bool PERM = true;
    const float* xp; const float* xs; const float* scale; const float* ssq_in; const bf16_t* proj;
    const bf16_t* hb_in; bf16_t* hb; float* ssq_out;
    __device__ __forceinline__ void operator()(const f32x4 (&acc)[2][2][4][2], const pg8::Unit& u, int wr, int wc, int fr_in, int fq_in) const {
        int fr = fr_in, fq = fq_in; asm volatile("" : "+v"(fr), "+v"(fq));
        float rs[2][4];
        if (MODE == 2) load_rstd(ssq_in, u, wr, fr, fq, rs);
        const int col0 = u.pn * 256 + wc * 32 + 8 * fq;
#pragma unroll
        for (int ai = 0; ai < 2; ++ai)
#pragma unroll
            for (int m = 0; m < 4; ++m) {
                const int row = u.pm * 256 + ai * 128 + wr * 64 + m * 16 + fr;
                float sq = 0.f;
#pragma unroll
                for (int bj = 0; bj < 2; ++bj) {
                    const int col = col0 + bj * 128;
                    f32x4 b0, b1;
                    if (MODE == 0) { const float* xr = (row < MP ? xp + (size_t)row * D : xs + (size_t)(row - MP) * D) + col; b0 = *(const f32x4*)xr; b1 = *(const f32x4*)(xr + 4); }
                    else { const u32x4 hv = *(const u32x4*)(hb_in + (size_t)row * D + col); b0 = unpk4((u32x2){hv.x, hv.y}); b1 = unpk4((u32x2){hv.z, hv.w}); }
                    const f32x4 a0 = acc[ai][bj][m][0], a1 = acc[ai][bj][m][1]; f32x4 o0, o1;
                    if (MODE == 0) { o0 = b0 + *(const f32x4*)(scale + col) * a0; o1 = b1 + *(const f32x4*)(scale + col + 4) * a1; }
                    else if (MODE == 1) { o0 = b0 + a0; o1 = b1 + a1; }
                    else { const u32x4 pv = *(const u32x4*)(proj + (size_t)row * D + col); const f32x4 p0 = unpk4((u32x2){pv.x, pv.y}), p1 = unpk4((u32x2){pv.z, pv.w}); const float r = rs[ai][m];
                        f32x4 g0, g1;
                        g0.x = 1.0f / (1.0f + __expf(-r * a0.x)); g0.y = 1.0f / (1.0f + __expf(-r * a0.y)); g0.z = 1.0f / (1.0f + __expf(-r * a0.z)); g0.w = 1.0f / (1.0f + __expf(-r * a0.w));
                        g1.x = 1.0f / (1.0f + __expf(-r * a1.x)); g1.y = 1.0f / (1.0f + __expf(-r * a1.y)); g1.z = 1.0f / (1.0f + __expf(-r * a1.z)); g1.w = 1.0f / (1.0f + __expf(-r * a1.w));
                        o0 = b0 + g0 * p0; o1 = b1 + g1 * p1; }
                    u32x4 w; w.x = pk2(o0.x, o0.y); w.y = pk2(o0.z, o0.w); w.z = pk2(o1.x, o1.y); w.w = pk2(o1.z, o1.w);
                    *(u32x4*)(hb + (size_t)row * D + col) = w;
                    sq += ((o0.x * o0.x + o0.y * o0.y) + (o0.z * o0.z + o0.w * o0.w)) + ((o1.x * o1.x + o1.y * o1.y) + (o1.z * o1.z + o1.w * o1.w));
                }
                sq += __shfl_xor(sq, 16); sq += __shfl_xor(sq, 32);
                if (fq == 0) ssq_out[(size_t)row * 16 + u.pn * 4 + wc] = sq;
                asm volatile("" ::: "memory");
            }
    }
};
struct EpiUp {
    static constexpr bool PERM = true;
    const float* ssq_in; bf16_t* abuf;
    __device__ __forceinline__ void operator()(const f32x4 (&acc)[2][2][4][2], const pg8::Unit& u, int wr, int wc, int fr_in, int fq_in) const {
        int fr = fr_in, fq = fq_in; asm volatile("" : "+v"(fr), "+v"(fq));
        float rs[2][4]; load_rstd(ssq_in, u, wr, fr, fq, rs);
        const int col0 = u.pn * 256 + wc * 32 + 8 * fq;
#pragma unroll
        for (int ai = 0; ai < 2; ++ai)
#pragma unroll
            for (int m = 0; m < 4; ++m) {
                const int row = u.pm * 256 + ai * 128 + wr * 64 + m * 16 + fr; const float r = rs[ai][m];
#pragma unroll
                for (int bj = 0; bj < 2; ++bj) {
                    f32x4 a = acc[ai][bj][m][0] * r, c = acc[ai][bj][m][1] * r;
                    a.x = fmaxf(a.x, 0.f); a.y = fmaxf(a.y, 0.f); a.z = fmaxf(a.z, 0.f); a.w = fmaxf(a.w, 0.f);
                    c.x = fmaxf(c.x, 0.f); c.y = fmaxf(c.y, 0.f); c.z = fmaxf(c.z, 0.f); c.w = fmaxf(c.w, 0.f);
                    u32x4 w; w.x = pk2(a.x * a.x, a.y * a.y); w.y = pk2(a.z * a.z, a.w * a.w); w.z = pk2(c.x * c.x, c.y * c.y); w.w = pk2(c.z * c.z, c.w * c.w);
                    *(u32x4*)(abuf + (size_t)row * FF + col0 + bj * 128) = w;
                }
            }
    }
};
template <int MODE> struct EpiF32 {
    static constexpr bool PERM = false;
    float* C; int ldc; const float* aux;
    __device__ __forceinline__ void operator()(const f32x4 (&acc)[2][2][4][2], const pg8::Unit& u, int wr, int wc, int fr_in, int fq_in) const {
        int fr = fr_in, fq = fq_in; asm volatile("" : "+v"(fr), "+v"(fq));
        float rs[2][4];
        if (MODE == 1) load_rstd(aux, u, wr, fr, fq, rs);
        const int col0 = u.pn * 256 + wc * 32 + 4 * fq;
#pragma unroll
        for (int ai = 0; ai < 2; ++ai)
#pragma unroll
            for (int m = 0; m < 4; ++m) {
                const int row = u.pm * 256 + ai * 128 + wr * 64 + m * 16 + fr;
                const float r = (MODE == 1) ? rs[ai][m] : (MODE == 2 ? aux[row] : 1.0f);
#pragma unroll
                for (int bj = 0; bj < 2; ++bj)
#pragma unroll
                    for (int n = 0; n < 2; ++n) *(f32x4*)(C + (size_t)row * ldc + col0 + bj * 128 + n * 16) = acc[ai][bj][m][n] * r;
            }
    }
};
struct EpiBf {
    static constexpr bool PERM = true;
    bf16_t* C; int ldc;
    __device__ __forceinline__ void operator()(const f32x4 (&acc)[2][2][4][2], const pg8::Unit& u, int wr, int wc, int fr_in, int fq_in) const {
        int fr = fr_in, fq = fq_in; asm volatile("" : "+v"(fr), "+v"(fq));
        const int col0 = u.pn * 256 + wc * 32 + 8 * fq;
#pragma unroll
        for (int ai = 0; ai < 2; ++ai)
#pragma unroll
            for (int m = 0; m < 4; ++m) {
                const int row = u.pm * 256 + ai * 128 + wr * 64 + m * 16 + fr;
#pragma unroll
                for (int bj = 0; bj < 2; ++bj) { const f32x4 a = acc[ai][bj][m][0], c = acc[ai][bj][m][1]; u32x4 w; w.x = pk2(a.x, a.y); w.y = pk2(a.z, a.w); w.z = pk2(c.x, c.y); w.w = pk2(c.z, c.w);
                    *(u32x4*)(C + (size_t)row * ldc + col0 + bj * 128) = w; }
            }
    }
};
__host__ __device__ __forceinline__ int kperm(int c) { if (c < KVR) return c; const int r = c - KVR, i = r & 31, sec = r >> 5; return KVR + 32 * (i >> 4) + 16 * sec + (i & 15); }
__host__ __device__ __forceinline__ int qperm(int c) { const int e = c % QH; if (e < NOPE) return c; const int r = e - NOPE, i = r & 31, sec = r >> 5; return c - e + NOPE + 32 * (i >> 4) + 16 * sec + (i & 15); }
struct EpiQ {
    static constexpr bool PERM = false;
    const float* ssqq_; const float* cs; bf16_t* qbuf; bf16_t* qs;
    __device__ __forceinline__ void operator()(const f32x4 (&acc)[2][2][4][2], const pg8::Unit& u, int wr, int wc, int fr_in, int fq_in) const {
        int fr = fr_in, fq = fq_in; asm volatile("" : "+v"(fr), "+v"(fq));
        const bool smp = u.pm >= MP / 256;
        float rq[2][4]; load_rstd_p<8>(ssqq_, 1.0f / QR, u, wr, fr, fq, rq);
#pragma unroll
        for (int ai = 0; ai < 2; ++ai)
#pragma unroll
            for (int m = 0; m < 4; ++m) {
                const int row = u.pm * 256 + ai * 128 + wr * 64 + m * 16 + fr; const float r = rq[ai][m]; const int pos = smp ? PAST + ((row - MP) & 7) : (row & (SEQ - 1));
                bf16_t* qrow = qbuf + (size_t)row * (NH * QH);
#pragma unroll
                for (int bj = 0; bj < 2; ++bj) {
                    const int Gi = u.pn * 8 + bj * 4 + wc, hh = Gi / 6, gi = Gi - hh * 6;
                    if (gi < 4) {
#pragma unroll
                        for (int n = 0; n < 2; ++n) { const f32x4 a = acc[ai][bj][m][n] * r; u32x2 w; w.x = pk2(a.x, a.y); w.y = pk2(a.z, a.w);
                            *(u32x2*)(qrow + Gi * 32 + n * 16 + 4 * fq) = w; }
                    } else {
                        const int i0 = 16 * (gi - 4) + 4 * fq;
                        const f32x4 x1 = acc[ai][bj][m][0] * r, x2 = acc[ai][bj][m][1] * r;
                        const f32x4 cn = *(const f32x4*)(cs + (size_t)pos * 64 + i0), sn = *(const f32x4*)(cs + (size_t)pos * 64 + 32 + i0);
                        const f32x4 o1 = x1 * cn - x2 * sn, o2 = x2 * cn + x1 * sn;
                        u32x2 w1, w2; w1.x = pk2(o1.x, o1.y); w1.y = pk2(o1.z, o1.w); w2.x = pk2(o2.x, o2.y); w2.y = pk2(o2.z, o2.w);
                        bf16_t* qd = smp ? qs + ((size_t)(row - MP) * NH + hh) * 320 + KVR : qrow + hh * QH + NOPE;
                        *(u32x2*)(qd + i0) = w1; *(u32x2*)(qd + 32 + i0) = w2;
                    }
                }
                asm volatile("" ::: "memory");
            }
    }
};
struct EpiDkvq {
    static constexpr bool PERM = false;
    const float* ssq_in; const float* cs; float* craw_; bf16_t* cb_; bf16_t* cqb_; float* ssqc_; float* ssqq_; float* out; bf16_t* kfull_; bf16_t* krbs_;
    __device__ __forceinline__ void operator()(const f32x4 (&acc)[2][2][4][2], const pg8::Unit& u, int wr, int wc, int fr_in, int fq_in) const {
        int fr = fr_in, fq = fq_in; asm volatile("" : "+v"(fr), "+v"(fq));
        float rs[2][4]; load_rstd(ssq_in, u, wr, fr, fq, rs);
        const bool smp = u.pm >= MP / 256;
#pragma unroll
        for (int ai = 0; ai < 2; ++ai)
#pragma unroll
            for (int m = 0; m < 4; ++m) {
                const int row = u.pm * 256 + ai * 128 + wr * 64 + m * 16 + fr; const float r = rs[ai][m];
                float sq = 0.f;
                if (u.pn == 0) {
#pragma unroll
                    for (int bj = 0; bj < 2; ++bj)
#pragma unroll
                        for (int n = 0; n < 2; ++n) { const int col = bj * 128 + wc * 32 + n * 16 + 4 * fq; const f32x4 v = acc[ai][bj][m][n] * r;
                            *(f32x4*)(craw_ + (size_t)row * KVR + col) = v; u32x2 w; w.x = pk2(v.x, v.y); w.y = pk2(v.z, v.w); *(u32x2*)(cb_ + (size_t)row * KVR + col) = w;
                            sq += (v.x * v.x + v.y * v.y) + (v.z * v.z + v.w * v.w); }
                    sq += __shfl_xor(sq, 16); sq += __shfl_xor(sq, 32);
                    if (fq == 0) ssqc_[(size_t)row * 4 + wc] = sq;
                } else {
#pragma unroll
                    for (int bj = 0; bj < 2; ++bj) {
                        const int g0 = (u.pn - 1) * 256 + bj * 128 + wc * 32;
                        if (g0 < ROPE) {
                            const int i0 = 16 * (g0 >> 5) + 4 * fq, pos = smp ? PAST + ((row - MP) & 7) : (row & (SEQ - 1));
                            const f32x4 x1 = acc[ai][bj][m][0] * r, x2 = acc[ai][bj][m][1] * r;
                            const f32x4 cn = *(const f32x4*)(cs + (size_t)pos * 64 + i0), sn = *(const f32x4*)(cs + (size_t)pos * 64 + 32 + i0);
                            const f32x4 o1 = x1 * cn - x2 * sn, o2 = x2 * cn + x1 * sn;
                            float* ko = smp ? out + O_KS + (size_t)(row - MP) * ROPE : out + O_KP + (size_t)row * ROPE;
                            *(f32x4*)(ko + i0) = o1; *(f32x4*)(ko + 32 + i0) = o2;
                            u32x2 w1, w2; w1.x = pk2(o1.x, o1.y); w1.y = pk2(o1.z, o1.w); w2.x = pk2(o2.x, o2.y); w2.y = pk2(o2.z, o2.w);
                            if (smp) { bf16_t* kd = krbs_ + (size_t)(row - MP) * ROPE; *(u32x2*)(kd + i0) = w1; *(u32x2*)(kd + 32 + i0) = w2; }
                            else { const int b = row >> 13, t = row & (SEQ - 1);
#pragma unroll
                                for (int h = 0; h < NH; ++h) { bf16_t* kd = kfull_ + ((size_t)(b * NH + h) * SEQ + t) * QH + NOPE; *(u32x2*)(kd + i0) = w1; *(u32x2*)(kd + 32 + i0) = w2; } }
                        } else if (g0 < ROPE + QR) {
#pragma unroll
                            for (int n = 0; n < 2; ++n) { const int qi = g0 - ROPE + n * 16 + 4 * fq; const f32x4 v = acc[ai][bj][m][n] * r;
                                u32x2 w; w.x = pk2(v.x, v.y); w.y = pk2(v.z, v.w); *(u32x2*)(cqb_ + (size_t)row * QR + qi) = w;
                                sq += (v.x * v.x + v.y * v.y) + (v.z * v.z + v.w * v.w); }
                        }
                    }
                    sq += __shfl_xor(sq, 16); sq += __shfl_xor(sq, 32);
                    if (fq == 0) ssqq_[(size_t)row * 8 + (u.pn - 1) * 4 + wc] = sq;
                }
                asm volatile("" ::: "memory");
            }
    }
};
struct EpiKup {
    static constexpr bool PERM = true;
    bf16_t* kfull; const float* ssqc_;
    __device__ __forceinline__ void operator()(const f32x4 (&acc)[2][2][4][2], const pg8::Unit& u, int wr, int wc, int fr_in, int fq_in) const {
        int fr = fr_in, fq = fq_in; asm volatile("" : "+v"(fr), "+v"(fq));
        const int col0 = u.pn * 256 + wc * 32 + 8 * fq;
        float rc[2][4]; load_rstd_p<4>(ssqc_, 1.0f / KVR, u, wr, fr, fq, rc);
#pragma unroll
        for (int ai = 0; ai < 2; ++ai)
#pragma unroll
            for (int m = 0; m < 4; ++m) {
                const int row = u.pm * 256 + ai * 128 + wr * 64 + m * 16 + fr; const int b = row >> 13, t = row & (SEQ - 1); const float r = rc[ai][m];
#pragma unroll
                for (int bj = 0; bj < 2; ++bj) { const int col = col0 + bj * 128; const int h = col >> 7, nn = col & 127; const f32x4 a = acc[ai][bj][m][0] * r, c = acc[ai][bj][m][1] * r;
                    u32x4 w; w.x = pk2(a.x, a.y); w.y = pk2(a.z, a.w); w.z = pk2(c.x, c.y); w.w = pk2(c.z, c.w);
                    *(u32x4*)(kfull + ((size_t)(b * NH + h) * SEQ + t) * QH + nn) = w; }
                asm volatile("" ::: "memory");
            }
    }
};
struct EpiVup {
    static constexpr bool PERM = true;
    bf16_t* vt; const float* ssqc_;
    __device__ __forceinline__ void operator()(const f32x4 (&acc)[2][2][4][2], const pg8::Unit& u, int wr, int wc, int fr_in, int fq_in) const {
        int fr = fr_in, fq = fq_in; asm volatile("" : "+v"(fr), "+v"(fq));
        const int col0 = u.pn * 256 + wc * 32 + 8 * fq;
        f32x4 rt[2][2];
#pragma unroll
        for (int bj = 0; bj < 2; ++bj)
#pragma unroll
            for (int k = 0; k < 8; ++k) { const f32x4 p4 = *(const f32x4*)(ssqc_ + (size_t)(col0 + bj * 128 + k) * 4); rt[bj][k >> 2][k & 3] = 1.0f / sqrtf(((p4.x + p4.y) + (p4.z + p4.w)) * (1.0f / KVR) + EPS); }
#pragma unroll
        for (int ai = 0; ai < 2; ++ai)
#pragma unroll
            for (int m = 0; m < 4; ++m) {
                const int row = u.pm * 256 + ai * 128 + wr * 64 + m * 16 + fr; const int h = row >> 7, v = row & 127;
#pragma unroll
                for (int bj = 0; bj < 2; ++bj) { const int col = col0 + bj * 128; const int b = col >> 13, t = col & (SEQ - 1); const f32x4 a = acc[ai][bj][m][0] * rt[bj][0], c = acc[ai][bj][m][1] * rt[bj][1];
                    u32x4 w; w.x = pk2(a.x, a.y); w.y = pk2(a.z, a.w); w.z = pk2(c.x, c.y); w.w = pk2(c.z, c.w);
                    *(u32x4*)(vt + ((size_t)(b * NH + h) * VD + v) * SEQ + t) = w; }
                asm volatile("" ::: "memory");
            }
    }
};

struct SgALoadBf { const bf16_t* A; int lda;
    __device__ __forceinline__ bf16x8 operator()(int row, int k) const { return *(const bf16x8*)(A + (size_t)row * lda + k); } };
struct SgALoadComb { const float* parto; const float* ml;
    __device__ __forceinline__ bf16x8 operator()(int row, int k) const {
        const int b = row >> 3, tok = row & 7, h = k >> 7, v = k & 127, q = tok * 8 + h;
        const float* m0p = ml + ((size_t)(b * 2 + 0) * 64 + q) * 2; const float* m1p = ml + ((size_t)(b * 2 + 1) * 64 + q) * 2;
        const float m0 = m0p[0], l0 = m0p[1], m1 = m1p[0], l1 = m1p[1], mx = fmaxf(m0, m1);
        float w0 = __builtin_amdgcn_exp2f(m0 - mx), w1 = __builtin_amdgcn_exp2f(m1 - mx); const float inv = 1.0f / (w0 * l0 + w1 * l1); w0 *= inv; w1 *= inv;
        const float* p0 = parto + ((size_t)(b * 2 + 0) * 64 + q) * 128 + v; const float* p1 = parto + ((size_t)(b * 2 + 1) * 64 + q) * 128 + v;
        return pack8v(*(const f32x4*)p0 * w0 + *(const f32x4*)p1 * w1, *(const f32x4*)(p0 + 4) * w0 + *(const f32x4*)(p1 + 4) * w1); } };
template <int NCT, int NCG, class Epi, class ALoad>
__device__ __forceinline__ void sg_gemm_l(LAS unsigned char* lds, const ALoad& AL, int apn256, const bf16_t* __restrict__ Bt, int K, int unit, const Epi& E, int tid, int wave, int lane) {
    constexpr int KS = 8 / NCG, W = NCG * NCT * 16, G4 = W / 4;
    static_assert(KS * 64 * W * 4 <= RING_BYTES, "sg_gemm reduction buffer");
    const int mt = unit >> 4, ntile = unit & 15, m0 = mt * 64, n0 = ntile * W;
    const int cg = wave % NCG, kp = wave / NCG, fr = lane & 15, fq = lane >> 4;
    const int Kw = K / KS;
    const int arow = m0 + fr, acol = (n0 >> 8) * apn256 + kp * Kw + 8 * fq;
    const bf16_t* bp = Bt + (size_t)(n0 + cg * NCT * 16 + fr) * K + kp * Kw + 8 * fq;
    f32x4 acc[4][NCT];
#pragma unroll
    for (int m = 0; m < 4; ++m)
#pragma unroll
        for (int n = 0; n < NCT; ++n) acc[m][n] = (f32x4){0.f, 0.f, 0.f, 0.f};
#pragma unroll 4
    for (int kk = 0; kk < Kw; kk += 32) {
        bf16x8 af[4], bfr[NCT];
#pragma unroll
        for (int m = 0; m < 4; ++m) af[m] = AL(arow + 16 * m, acol + kk);
#pragma unroll
        for (int n = 0; n < NCT; ++n) bfr[n] = *(const bf16x8*)(bp + (size_t)(16 * n) * K + kk);
#pragma unroll
        for (int m = 0; m < 4; ++m)
#pragma unroll
            for (int n = 0; n < NCT; ++n) acc[m][n] = __builtin_amdgcn_mfma_f32_16x16x32_bf16(bfr[n], af[m], acc[m][n], 0, 0, 0);
    }
    LAS float* red = (LAS float*)lds;
#pragma unroll
    for (int m = 0; m < 4; ++m)
#pragma unroll
        for (int n = 0; n < NCT; ++n) { const int row = 16 * m + fr, c4 = (cg * NCT * 16 + 16 * n) / 4 + fq;
            *(LAS f32x4*)(red + (size_t)(kp * 64 + row) * W + 4 * (c4 ^ (row & 3))) = acc[m][n]; }
    __syncthreads();
    for (int it = tid; it < 64 * G4; it += 512) {
        const int row = it / G4, c4 = it % G4;
        f32x4 v = *(const LAS f32x4*)(red + (size_t)row * W + 4 * (c4 ^ (row & 3)));
#pragma unroll
        for (int p = 1; p < KS; ++p) v += *(const LAS f32x4*)(red + (size_t)(p * 64 + row) * W + 4 * (c4 ^ (row & 3)));
        if constexpr (Epi::WHOLE_TILE) *(LAS f32x4*)(red + (size_t)row * W + 4 * (c4 ^ (row & 3))) = v;
        else E(MP + m0 + row, n0 + 4 * c4, v, ntile);
    }
    if constexpr (Epi::WHOLE_TILE) {
        __syncthreads();
        for (int it = tid; it < 64 * G4; it += 512) { const int row = it / G4, c4 = it % G4; E.tile(MP + m0 + row, n0, c4, red + (size_t)row * W, row & 3); }
    }
    __syncthreads();
}
template <int NCT, int NCG, class Epi>
__device__ __forceinline__ void sg_gemm(LAS unsigned char* lds, const bf16_t* __restrict__ A, int lda, int apn256, const bf16_t* __restrict__ Bt, int K, int unit, const Epi& E, int tid, int wave, int lane) {
    const SgALoadBf AL{A, lda}; sg_gemm_l<NCT, NCG>(lds, AL, apn256, Bt, K, unit, E, tid, wave, lane);
}
constexpr int SK_STG = 32768;
template <class Epi>
__device__ __forceinline__ void sk_gemm(LAS unsigned char* lds, const bf16_t* __restrict__ A, int lda, const bf16_t* __restrict__ Bt, int K, int m0, int n0, int ntile, const Epi& E, int tid, int wave, int lane) {
    const int nk = K >> 7, fr = lane & 15, fq = lane >> 4, mi = wave >> 1, nh = wave & 1;
    unsigned goA[2], goB[2];
#pragma unroll
    for (int e = 0; e < 2; ++e) { const int r = 4 * (wave + 8 * e) + (lane >> 4), c = (lane & 15) ^ (r & 15); goA[e] = (unsigned)(r * lda + c * 8) * 2u; goB[e] = (unsigned)(r * K + c * 8) * 2u; }
    const unsigned ldsw = (unsigned)wave * 1024u;
#define SK_STAGE(kc) do { const unsigned so_ = (unsigned)((kc) & 3) * SK_STG + ldsw; const size_t ko_ = (size_t)(kc) * 256; \
        _Pragma("unroll") for (int e = 0; e < 2; ++e) { \
            __builtin_amdgcn_global_load_lds((const unsigned*)((const char*)A + ko_ + goA[e]), (LAS unsigned*)(lds + so_ + e * 8192), 16, 0, 0); \
            __builtin_amdgcn_global_load_lds((const unsigned*)((const char*)Bt + ko_ + goB[e]), (LAS unsigned*)(lds + so_ + 16384 + e * 8192), 16, 0, 0); } } while (0)
    int co[4];
#pragma unroll
    for (int ks = 0; ks < 4; ++ks) co[ks] = ((4 * ks + fq) ^ fr) << 4;
    const int aro = (16 * mi + fr) * 256, bro = 16384 + (32 * nh + fr) * 256;
    f32x4 acc[2] = {(f32x4){0.f, 0.f, 0.f, 0.f}, (f32x4){0.f, 0.f, 0.f, 0.f}};
    asm volatile("s_waitcnt vmcnt(0)" ::: "memory");
    SK_STAGE(0); if (nk > 1) SK_STAGE(1); if (nk > 2) SK_STAGE(2);
#pragma unroll 1
    for (int kc = 0; kc < nk; ++kc) {
        if (kc + 2 < nk) asm volatile("s_waitcnt vmcnt(8)" ::: "memory"); else if (kc + 1 < nk) asm volatile("s_waitcnt vmcnt(4)" ::: "memory"); else asm volatile("s_waitcnt vmcnt(0)" ::: "memory");
        asm volatile("s_waitcnt lgkmcnt(0)" ::: "memory"); __builtin_amdgcn_s_barrier(); asm volatile("" ::: "memory");
        if (kc + 3 < nk) SK_STAGE(kc + 3);
        const LAS unsigned char* sp = lds + (kc & 3) * SK_STG;
        bf16x8 af[4], b0[4], b1[4];
#pragma unroll
        for (int ks = 0; ks < 4; ++ks) { af[ks] = *(const LAS bf16x8*)(sp + aro + co[ks]); b0[ks] = *(const LAS bf16x8*)(sp + bro + co[ks]); b1[ks] = *(const LAS bf16x8*)(sp + bro + 4096 + co[ks]); }
#pragma unroll
        for (int ks = 0; ks < 4; ++ks) { acc[0] = __builtin_amdgcn_mfma_f32_16x16x32_bf16(b0[ks], af[ks], acc[0], 0, 0, 0); acc[1] = __builtin_amdgcn_mfma_f32_16x16x32_bf16(b1[ks], af[ks], acc[1], 0, 0, 0); }
    }
#undef SK_STAGE
    asm volatile("s_waitcnt lgkmcnt(0)" ::: "memory"); __builtin_amdgcn_s_barrier(); asm volatile("" ::: "memory");
    LAS float* red = (LAS float*)lds;
    { const int row = 16 * mi + fr;
#pragma unroll
      for (int n = 0; n < 2; ++n) { const int c4 = 4 * (2 * nh + n) + fq; *(LAS f32x4*)(red + row * 64 + 4 * (c4 ^ (row & 3))) = acc[n]; } }
    __syncthreads();
#pragma unroll
    for (int it = tid; it < 1024; it += 512) { const int row = it >> 4, c4 = it & 15; const f32x4 v = *(const LAS f32x4*)(red + row * 64 + 4 * (c4 ^ (row & 3))); E(MP + m0 + row, n0 + 4 * c4, v, ntile); }
    __syncthreads();
}
constexpr int SKW_STG = 40960;
template <class Epi>
__device__ __forceinline__ void sk_gemm_w(LAS unsigned char* lds, const bf16_t* __restrict__ A, int lda, const bf16_t* __restrict__ Bt, int K, int m0, int n0, const Epi& E, int tid, int wave, int lane) {
    const int nk = K >> 6, fr = lane & 15, fq = lane >> 4;
    unsigned goA, goB[4];
    { const int r = 8 * wave + (lane >> 3), c = (lane & 7) ^ (r & 7); goA = (unsigned)(r * lda + c * 8) * 2u;
#pragma unroll
      for (int e = 0; e < 4; ++e) goB[e] = (unsigned)((r + 64 * e) * K + c * 8) * 2u; }
    const unsigned ldsw = (unsigned)wave * 1024u;
#define SKW_STAGE(kc) do { const unsigned so_ = (unsigned)((kc) % 3) * SKW_STG + ldsw; const size_t ko_ = (size_t)(kc) * 128; \
        __builtin_amdgcn_global_load_lds((const unsigned*)((const char*)A + ko_ + goA), (LAS unsigned*)(lds + so_), 16, 0, 0); \
        _Pragma("unroll") for (int e = 0; e < 4; ++e) __builtin_amdgcn_global_load_lds((const unsigned*)((const char*)Bt + ko_ + goB[e]), (LAS unsigned*)(lds + so_ + 8192 + e * 8192), 16, 0, 0); } while (0)
    const int co0 = (fq ^ (fr & 7)) << 4, co1 = ((4 + fq) ^ (fr & 7)) << 4;
    const int aro = fr * 128, bro = 8192 + (32 * wave + fr) * 128;
    f32x4 acc[4][2];
#pragma unroll
    for (int m = 0; m < 4; ++m)
#pragma unroll
        for (int n = 0; n < 2; ++n) acc[m][n] = (f32x4){0.f, 0.f, 0.f, 0.f};
    asm volatile("s_waitcnt vmcnt(0)" ::: "memory");
    SKW_STAGE(0); if (nk > 1) SKW_STAGE(1);
#pragma unroll 1
    for (int kc = 0; kc < nk; ++kc) {
        if (kc + 1 < nk) asm volatile("s_waitcnt vmcnt(5)" ::: "memory"); else asm volatile("s_waitcnt vmcnt(0)" ::: "memory");
        asm volatile("s_waitcnt lgkmcnt(0)" ::: "memory"); __builtin_amdgcn_s_barrier(); asm volatile("" ::: "memory");
        if (kc + 2 < nk) SKW_STAGE(kc + 2);
        const LAS unsigned char* sp = lds + (kc % 3) * SKW_STG;
        bf16x8 af[4][2], bf_[2][2];
#pragma unroll
        for (int m = 0; m < 4; ++m) { af[m][0] = *(const LAS bf16x8*)(sp + aro + m * 2048 + co0); af[m][1] = *(const LAS bf16x8*)(sp + aro + m * 2048 + co1); }
#pragma unroll
        for (int n = 0; n < 2; ++n) { bf_[n][0] = *(const LAS bf16x8*)(sp + bro + n * 2048 + co0); bf_[n][1] = *(const LAS bf16x8*)(sp + bro + n * 2048 + co1); }
#pragma unroll
        for (int m = 0; m < 4; ++m)
#pragma unroll
            for (int n = 0; n < 2; ++n) { acc[m][n] = __builtin_amdgcn_mfma_f32_16x16x32_bf16(bf_[n][0], af[m][0], acc[m][n], 0, 0, 0); acc[m][n] = __builtin_amdgcn_mfma_f32_16x16x32_bf16(bf_[n][1], af[m][1], acc[m][n], 0, 0, 0); }
    }
#undef SKW_STAGE
    asm volatile("s_waitcnt lgkmcnt(0)" ::: "memory"); __builtin_amdgcn_s_barrier(); asm volatile("" ::: "memory");
    LAS float* red = (LAS float*)lds;
#pragma unroll
    for (int m = 0; m < 4; ++m)
#pragma unroll
        for (int n = 0; n < 2; ++n) { const int row = 16 * m + fr, c4 = 8 * wave + 4 * n + fq; *(LAS f32x4*)(red + row * 256 + 4 * (c4 ^ (row & 15))) = acc[m][n]; }
    __syncthreads();
#pragma unroll
    for (int i = 0; i < 8; ++i) { const int it = tid + 512 * i, row = it >> 6, c4 = it & 63; const f32x4 v = *(const LAS f32x4*)(red + row * 256 + 4 * (c4 ^ (row & 15))); E(MP + m0 + row, n0 + 4 * c4, v, 0); }
    __syncthreads();
}
__device__ __forceinline__ float row_rstd16(const float* ssq, int row) {
    const f32x4* s = (const f32x4*)(ssq + (size_t)row * 16); const f32x4 a = s[0], b = s[1], c = s[2], d = s[3];
    const float t = ((a.x + a.y) + (a.z + a.w)) + ((b.x + b.y) + (b.z + b.w)) + ((c.x + c.y) + (c.z + c.w)) + ((d.x + d.y) + (d.z + d.w));
    return 1.0f / sqrtf(t * (1.0f / 1024.0f) + EPS);
}
template <int MODE> struct SgH {
    static constexpr bool WHOLE_TILE = false;
    const float* xs; const float* scale; const float* ssq_in; const bf16_t* proj; const bf16_t* hb_in; bf16_t* hb; float* ssq_out;
    __device__ __forceinline__ void operator()(int row, int col, f32x4 a, int ntile) const {
        const f32x4 bs = (MODE == 0) ? *(const f32x4*)(xs + (size_t)(row - MP) * D + col) : unpk4(*(const u32x2*)(hb_in + (size_t)row * D + col));
        f32x4 o;
        if (MODE == 0) o = bs + *(const f32x4*)(scale + col) * a;
        else if (MODE == 1) o = bs + a;
        else { const float r = row_rstd16(ssq_in, row); const f32x4 pj = unpk4(*(const u32x2*)(proj + (size_t)row * D + col));
            f32x4 gt; gt.x = 1.0f / (1.0f + __expf(-r * a.x)); gt.y = 1.0f / (1.0f + __expf(-r * a.y)); gt.z = 1.0f / (1.0f + __expf(-r * a.z)); gt.w = 1.0f / (1.0f + __expf(-r * a.w));
            o = bs + gt * pj; }
        u32x2 w; w.x = pk2(o.x, o.y); w.y = pk2(o.z, o.w);
        *(u32x2*)(hb + (size_t)row * D + col) = w;
        float sq = (o.x * o.x + o.y * o.y) + (o.z * o.z + o.w * o.w);
        sq += __shfl_xor(sq, 1); sq += __shfl_xor(sq, 2); sq += __shfl_xor(sq, 4); sq += __shfl_xor(sq, 8);
        if ((col & 63) == 0) ssq_out[(size_t)row * 16 + ntile] = sq;
    }
};
struct SgUp {
    static constexpr bool WHOLE_TILE = false;
    const float* ssq_in; bf16_t* abuf;
    __device__ __forceinline__ void operator()(int row, int col, f32x4 a, int) const {
        const float r = row_rstd16(ssq_in, row); a = a * r;
        a.x = fmaxf(a.x, 0.f); a.y = fmaxf(a.y, 0.f); a.z = fmaxf(a.z, 0.f); a.w = fmaxf(a.w, 0.f);
        u32x2 w; w.x = pk2(a.x * a.x, a.y * a.y); w.y = pk2(a.z * a.z, a.w * a.w);
        *(u32x2*)(abuf + (size_t)row * FF + col) = w;
    }
};
template <int MODE> struct SgF32 {
    static constexpr bool WHOLE_TILE = false;
    float* C; int ldc; const float* aux;
    __device__ __forceinline__ void operator()(int row, int col, f32x4 a, int) const {
        const float r = (MODE == 1) ? row_rstd16(aux, row) : (MODE == 2 ? aux[row] : 1.0f);
        *(f32x4*)(C + (size_t)row * ldc + col) = a * r;
    }
};
struct SgBf {
    static constexpr bool WHOLE_TILE = false;
    bf16_t* C; int ldc;
    __device__ __forceinline__ void operator()(int row, int col, f32x4 a, int) const { u32x2 w; w.x = pk2(a.x, a.y); w.y = pk2(a.z, a.w); *(u32x2*)(C + (size_t)row * ldc + col) = w; }
};
struct SgQ {
    static constexpr bool WHOLE_TILE = true;
    const float* rstdq; const float* cs; bf16_t* qbuf; bf16_t* qs;
    __device__ __forceinline__ void operator()(int, int, f32x4, int) const {}
    __device__ __forceinline__ void tile(int row, int n0, int c4, const LAS float* trow, int sw) const {
        const int c = n0 + 4 * c4, hh = c / QH, e = c - hh * QH; const float r = rstdq[row];
        const f32x4 v = *(const LAS f32x4*)(trow + 4 * (c4 ^ sw)) * r;
        if (e < NOPE) { u32x2 w; w.x = pk2(v.x, v.y); w.y = pk2(v.z, v.w); *(u32x2*)(qbuf + (size_t)row * (NH * QH) + c) = w; }
        else { const int rp = e - NOPE, wi = rp & 31;
            if (wi < 16) { const int i0 = 16 * (rp >> 5) + wi, pos = PAST + ((row - MP) & 7);
                const f32x4 x2 = *(const LAS f32x4*)(trow + 4 * ((c4 + 4) ^ sw)) * r;
                const f32x4 cn = *(const f32x4*)(cs + (size_t)pos * 64 + i0), sn = *(const f32x4*)(cs + (size_t)pos * 64 + 32 + i0);
                const f32x4 o1 = v * cn - x2 * sn, o2 = x2 * cn + v * sn;
                bf16_t* qd = qs + ((size_t)(row - MP) * NH + hh) * 320 + KVR;
                u32x2 w1, w2; w1.x = pk2(o1.x, o1.y); w1.y = pk2(o1.z, o1.w); w2.x = pk2(o2.x, o2.y); w2.y = pk2(o2.z, o2.w);
                *(u32x2*)(qd + i0) = w1; *(u32x2*)(qd + 32 + i0) = w2; } }
    }
};

template <int PMODE = 0>
__device__ __forceinline__ void transpose_item(const float* W, const float* kscale, int K, int N, bf16_t* WT, int row_off, LAS float* scr, int item, int lane) {
    const int nblk = N / 32, kb = item / nblk, nb = item % nblk, k0 = 64 * kb, n0 = 32 * nb;
    { f32x4 v[8];
#pragma unroll
      for (int i = 0; i < 8; ++i) v[i] = *(const f32x4*)(W + (size_t)(k0 + (lane >> 3) + 8 * i) * N + n0 + (lane & 7) * 4);
#pragma unroll
      for (int i = 0; i < 8; ++i) { const int kk = (lane >> 3) + 8 * i; f32x4 x = v[i]; if (kscale) x = x * kscale[k0 + kk];
          LAS float* d = scr + kk * 33 + (lane & 7) * 4; d[0] = x.x; d[1] = x.y; d[2] = x.z; d[3] = x.w; } }
    LDS_WAIT(); asm volatile("" ::: "memory");
    const int c = lane & 7;
#pragma unroll
    for (int j = 0; j < 4; ++j) { const int n = (lane >> 3) + 8 * j; const LAS float* s = scr + (8 * c) * 33 + n;
        u32x4 o; o.x = pk2(s[0 * 33], s[1 * 33]); o.y = pk2(s[2 * 33], s[3 * 33]); o.z = pk2(s[4 * 33], s[5 * 33]); o.w = pk2(s[6 * 33], s[7 * 33]);
        *(u32x4*)(WT + (size_t)(row_off + (PMODE == 1 ? qperm(n0 + n) : (PMODE == 2 ? kperm(n0 + n) : n0 + n))) * K + k0 + 8 * c) = o; }
    LDS_WAIT(); asm volatile("" ::: "memory");
}

constexpr int AK_PITCH = 400, AK_BUF = 64 * AK_PITCH;
constexpr int AV_PITCH = 136, AV_BUF = 128 * AV_PITCH;
constexpr int AV_OFF = 2 * AK_BUF, AQ_OFF = AV_OFF + 2 * AV_BUF;
static_assert(AQ_OFF + 256 * 144 <= RING_BYTES, "attention LDS");
__device__ __forceinline__ void attn_prompt_unit(const bf16_t* __restrict__ qbuf, const bf16_t* __restrict__ Kf, const bf16_t* __restrict__ Vt, bf16_t* __restrict__ obuf,
                                                 int b, int h, int qb, LAS unsigned char* lds, int tid, int wave, int lane) {
    const int r32 = lane & 31, g = lane >> 5;
    const int t_lo = qb * 256 + wave * 32, trow = t_lo + r32;
    bf16x8 qf[8];
    { const bf16_t* qp = qbuf + (size_t)(b * SEQ + trow) * (NH * QH) + h * QH + 8 * g;
      __syncthreads();
#pragma unroll
      for (int ks = 8; ks < 12; ++ks) *(LAS bf16x8*)(lds + AQ_OFF + (wave * 32 + r32) * 144 + (2 * (ks - 8) + g) * 16) = *(const bf16x8*)(qp + 16 * ks);
#pragma unroll
      for (int ks = 0; ks < 8; ++ks) qf[ks] = *(const bf16x8*)(qp + 16 * ks);
#pragma unroll
      for (int ks = 0; ks < 8; ++ks) asm volatile("" : "+v"(qf[ks])); }
    f32x16 O[4];
#pragma unroll
    for (int i = 0; i < 4; ++i)
#pragma unroll
        for (int j = 0; j < 16; ++j) O[i][j] = 0.f;
    float mrun = -1e30f, lrun = 0.f;
    const bf16_t* Kb = Kf + (size_t)(b * NH + h) * SEQ * QH;
    const bf16_t* Vb = Vt + (size_t)(b * NH + h) * VD * SEQ;
    const int NT = (qb + 1) * 4;
    int kl_off[3], vl_off[2]; size_t vg_off[2];
#pragma unroll
    for (int e = 0; e < 3; ++e) kl_off[e] = (tid >> 3) * AK_PITCH + ((tid & 7) + 8 * e) * 16;
#pragma unroll
    for (int e = 0; e < 2; ++e) { const int c = tid + 512 * e; vl_off[e] = AV_OFF + (c >> 3) * AV_PITCH + (c & 7) * 16; vg_off[e] = (size_t)(c >> 3) * SEQ + (c & 7) * 8; }
    u32x4 kst[3], vst[2];
#define AT_LOAD(j) do { _Pragma("unroll") for (int e = 0; e < 3; ++e) kst[e] = *(const u32x4*)(Kb + (size_t)(64 * (j) + (tid >> 3)) * QH + ((tid & 7) + 8 * e) * 8); \
                        _Pragma("unroll") for (int e = 0; e < 2; ++e) vst[e] = *(const u32x4*)(Vb + vg_off[e] + 64 * (j)); } while (0)
#define AT_WRITE(buf) do { _Pragma("unroll") for (int e = 0; e < 3; ++e) *(LAS u32x4*)(lds + (buf) * AK_BUF + kl_off[e]) = kst[e]; \
                           _Pragma("unroll") for (int e = 0; e < 2; ++e) { *(LAS u32x2*)(lds + (buf) * AV_BUF + vl_off[e]) = (u32x2){vst[e].x, vst[e].y}; *(LAS u32x2*)(lds + (buf) * AV_BUF + vl_off[e] + 8) = (u32x2){vst[e].z, vst[e].w}; } } while (0)
    AT_LOAD(0); AT_WRITE(0);
    __syncthreads();
    for (int j = 0; j < NT; ++j) {
        const int buf = j & 1;
        if (j + 1 < NT) AT_LOAD(j + 1);
        if (64 * j <= t_lo + 31) {
            f32x16 S0, S1;
#pragma unroll
            for (int i = 0; i < 16; ++i) { S0[i] = 0.f; S1[i] = 0.f; }
            const LAS unsigned char* kl = lds + buf * AK_BUF + r32 * AK_PITCH + g * 16;
            const LAS unsigned char* ql = lds + AQ_OFF + (wave * 32 + r32) * 144 + g * 16;
            bf16x8 ka[3][2], qr_[3];
#define AT_KLD(ks) do { ka[(ks) % 3][0] = *(const LAS bf16x8*)(kl + (ks) * 32); ka[(ks) % 3][1] = *(const LAS bf16x8*)(kl + 32 * AK_PITCH + (ks) * 32); \
                        if ((ks) >= 8) qr_[(ks) % 3] = *(const LAS bf16x8*)(ql + ((ks) - 8) * 32); } while (0)
            AT_KLD(0); AT_KLD(1);
#pragma unroll
            for (int ks = 0; ks < 12; ++ks) {
                if (ks + 2 < 12) AT_KLD(ks + 2);
                __builtin_amdgcn_sched_barrier(0);
                const bf16x8 qb_ = (ks < 8) ? qf[ks < 8 ? ks : 0] : qr_[ks % 3];
                S0 = __builtin_amdgcn_mfma_f32_32x32x16_bf16(ka[ks % 3][0], qb_, S0, 0, 0, 0);
                S1 = __builtin_amdgcn_mfma_f32_32x32x16_bf16(ka[ks % 3][1], qb_, S1, 0, 0, 0);
                __builtin_amdgcn_sched_barrier(0);
            }
#undef AT_KLD
            if (64 * j + 63 > t_lo) {
                asm volatile("" ::: "memory");
#pragma unroll
                for (int i = 0; i < 16; ++i) { const int key = 64 * j + crow(i, g); if (key > trow) S0[i] = -1e30f; if (key + 32 > trow) S1[i] = -1e30f; }
            }
            float mx = S0[0];
#pragma unroll
            for (int i = 1; i < 16; ++i) mx = fmaxf(mx, S0[i]);
#pragma unroll
            for (int i = 0; i < 16; ++i) mx = fmaxf(mx, S1[i]);
            mx = fmaxf(mx, __shfl_xor(mx, 32)) * CEXP;
            if (__any(mx > mrun + 11.5f)) {
                const float mnew = fmaxf(mrun, mx), alpha = __builtin_amdgcn_exp2f(mrun - mnew);
                mrun = mnew; lrun *= alpha;
#pragma unroll
                for (int vt = 0; vt < 4; ++vt)
#pragma unroll
                    for (int i = 0; i < 16; ++i) O[vt][i] *= alpha;
            }
            float ps = 0.f;
#pragma unroll
            for (int i = 0; i < 16; ++i) { S0[i] = __builtin_amdgcn_exp2f(S0[i] * CEXP - mrun); S1[i] = __builtin_amdgcn_exp2f(S1[i] * CEXP - mrun); ps += S0[i] + S1[i]; }
            lrun += ps;
            bf16x8 pf[4];
            { float tmp[8];
#pragma unroll
              for (int s2 = 0; s2 < 4; ++s2) {
#pragma unroll
                for (int i = 0; i < 8; ++i) tmp[i] = (s2 < 2) ? S0[8 * (s2 & 1) + i] : S1[8 * (s2 & 1) + i];
                pf[s2] = pack8(tmp); } }
            const LAS unsigned char* vl = lds + AV_OFF + buf * AV_BUF + r32 * AV_PITCH + g * 8;
            u32x4 fa[4], fb[4];
#define AT_VLD(dst, vt) do { _Pragma("unroll") for (int s2 = 0; s2 < 4; ++s2) { const u32x2 lo_ = *(const LAS u32x2*)(vl + (vt) * 32 * AV_PITCH + s2 * 32), hi_ = *(const LAS u32x2*)(vl + (vt) * 32 * AV_PITCH + s2 * 32 + 16); dst[s2] = (u32x4){lo_.x, lo_.y, hi_.x, hi_.y}; } } while (0)
#define AT_VMM(src, vt) do { _Pragma("unroll") for (int s2 = 0; s2 < 4; ++s2) O[vt] = __builtin_amdgcn_mfma_f32_32x32x16_bf16(__builtin_bit_cast(bf16x8, src[s2]), pf[s2], O[vt], 0, 0, 0); } while (0)
            AT_VLD(fa, 0); AT_VLD(fb, 1); __builtin_amdgcn_sched_barrier(0);
            AT_VMM(fa, 0); __builtin_amdgcn_sched_barrier(0);
            AT_VLD(fa, 2); __builtin_amdgcn_sched_barrier(0);
            AT_VMM(fb, 1); __builtin_amdgcn_sched_barrier(0);
            AT_VLD(fb, 3); __builtin_amdgcn_sched_barrier(0);
            AT_VMM(fa, 2); __builtin_amdgcn_sched_barrier(0);
            AT_VMM(fb, 3);
#undef AT_VLD
#undef AT_VMM
        }
        if (j + 1 < NT) AT_WRITE(buf ^ 1);
        __syncthreads();
    }
#undef AT_LOAD
#undef AT_WRITE
    const float ltot = lrun + __shfl_xor(lrun, 32), inv = 1.0f / ltot;
    bf16_t* op = obuf + (size_t)(b * SEQ + trow) * D + h * VD + 4 * g;
#pragma unroll
    for (int vt = 0; vt < 4; ++vt)
#pragma unroll
        for (int jq = 0; jq < 4; ++jq) {
            u32x2 w; w.x = pk2(O[vt][4 * jq] * inv, O[vt][4 * jq + 1] * inv); w.y = pk2(O[vt][4 * jq + 2] * inv, O[vt][4 * jq + 3] * inv);
            *(u32x2*)(op + 32 * vt + 8 * jq) = w;
        }
}

typedef short s16x4 __attribute__((ext_vector_type(4)));
constexpr int SA_KR = 32768, SA_BUF = 32768 + 64 * 144, SA_QR = 2 * SA_BUF, SA_QI = SA_QR + 64 * 144, SA_QI_PITCH = 528, SA_OI = 69632;
static_assert(SA_OI >= 65536 + 1024 && SA_OI + 64 * SA_QI_PITCH <= MISC_OFF, "O image");
static_assert(SA_QI + 64 * SA_QI_PITCH <= MISC_OFF, "sample attention LDS");
__device__ __forceinline__ int sa_off(int row, int ch) { return 256 * row + 16 * (ch ^ (((row & 3) << 2) | ((row >> 2) & 3))); }
__device__ __forceinline__ void sattn_item(const Params& P, int b, int half, LAS unsigned char* lds, int tid, int wave, int lane) {
    unsigned char* ws = P.ws;
    const int r32 = lane & 31, g = lane >> 5;
    const bool is_cmp = wave < 4;
    const int qt = wave & 1, kb = (wave >> 1) & 1;
    const int ptv = ((const int*)P.in[I_PT])[b * NPG + half * 32 + (lane & 31)];
    const float* clat = P.in[I_CLAT]; const float* ckr = P.in[I_CKR];
#define SA_LOAD(S, h) do { const int pg_ = __builtin_amdgcn_readlane(ptv, (h) >> 2); const size_t prow_ = (size_t)pg_ * PAGE + (((h) & 3) << 5); \
        const char* lat_ = (const char*)(clat + prow_ * KVR); const char* kro_ = (const char*)(ckr + prow_ * ROPE); \
        _Pragma("unroll") for (int e = 0; e < 8; ++e) S[e] = *(const f32x4*)(lat_ + glb + e * 1024); \
        S[8] = *(const f32x4*)(kro_ + grb); S[9] = *(const f32x4*)(kro_ + grb + 1024); } while (0)
#define SA_PK4(v) ((u32x2){pk2((v).x, (v).y), pk2((v).z, (v).w)})
#define SA_WRITE(S, bufo, hh) do { \
        _Pragma("unroll") for (int e = 0; e < 8; ++e) *(LAS u32x2*)(lds + (bufo) + llb[e] + (hh) * 8192) = SA_PK4(S[e]); \
        _Pragma("unroll") for (int e = 0; e < 2; ++e) *(LAS u32x2*)(lds + (bufo) + lrb[e] + (hh) * 4608) = SA_PK4(S[8 + e]); asm volatile("" ::: "memory"); } while (0)
    __syncthreads();
    *(LAS u32x4*)(lds + SA_QR + (tid >> 3) * 144 + (tid & 7) * 16) = *(const u32x4*)((const bf16_t*)(ws + WS_QS) + ((size_t)b * 64 + (tid >> 3)) * 320 + KVR + (tid & 7) * 8);
    {
      const bf16_t* qn = (const bf16_t*)(ws + WS_QBUF) + (size_t)(MP + b * DS + (r32 & 7)) * (NH * QH) + wave * QH + 8 * g;
      bf16x8 an[8];
#pragma unroll
      for (int ks = 0; ks < 8; ++ks) { u32x4 z = {0u, 0u, 0u, 0u}; if (r32 < DS) z = *(const u32x4*)(qn + 16 * ks); an[ks] = __builtin_bit_cast(bf16x8, z); }
      const bf16_t* wk = (const bf16_t*)(ws + WS_WUKB) + (size_t)wave * (64 * 512) + lane * 8;
#pragma unroll 2
      for (int nt = 0; nt < 8; ++nt) {
          f32x16 acc;
#pragma unroll
          for (int i = 0; i < 16; ++i) acc[i] = 0.f;
#pragma unroll
          for (int ks = 0; ks < 8; ++ks) acc = __builtin_amdgcn_mfma_f32_32x32x16_bf16(an[ks], *(const bf16x8*)(wk + (nt * 8 + ks) * 512), acc, 0, 0, 0);
#pragma unroll
          for (int i = 0; i < 4; ++i) *(LAS bf16_t*)(lds + SA_QI + ((i + 4 * g) * 8 + wave) * SA_QI_PITCH + (32 * nt + r32) * 2) = (bf16_t)f2bf(acc[i]);
      } }
    __syncthreads();
#define SA_KLD(ks) do { const int o0_ = ((ks) < 16) ? (((ks) >> 3) * 16384 + krow + 32 * (((ks) & 7) ^ (x_ >> 1))) : (krope + 32 * ((ks) - 16)); \
        ka_[(ks) & 3] = *(const LAS bf16x8*)(kb_ + o0_); \
        qa_[(ks) & 3] = ((ks) < 16) ? *(const LAS bf16x8*)(qil + 32 * (ks)) : *(const LAS bf16x8*)(qrl + 32 * ((ks) - 16)); } while (0)
#define SA_VLD(dst, vt) do { const LAS unsigned char* vb_ = kb_ + ((vt) >> 2) * 16384 + 8192 * kb; \
        const int c0_ = 4 * ((vt) & 3) + 2 * vsub + (p_ >> 1); \
        const int blo_ = 256 * (4 * gg + q_) + 16 * (c0_ ^ ((q_ << 2) | gg)) + 8 * (p_ & 1); \
        const int bhi_ = 256 * (4 * gg + q_ + 8) + 16 * (c0_ ^ ((q_ << 2) | (gg + 2))) + 8 * (p_ & 1); \
        _Pragma("unroll") for (int s2 = 0; s2 < 2; ++s2) { \
            const s16x4 lo_ = __builtin_amdgcn_ds_read_tr16_b64_v4i16((LAS s16x4*)(vb_ + blo_ + 4096 * s2)); \
            const s16x4 hi_ = __builtin_amdgcn_ds_read_tr16_b64_v4i16((LAS s16x4*)(vb_ + bhi_ + 4096 * s2)); \
            dst[s2] = (bf16x8){lo_[0], lo_[1], lo_[2], lo_[3], hi_[0], hi_[1], hi_[2], hi_[3]}; } } while (0)
#define SA_VMM(src, vt) do { _Pragma("unroll") for (int s2 = 0; s2 < 2; ++s2) O[vt] = __builtin_amdgcn_mfma_f32_32x32x16_bf16(src[s2], pf[s2], O[vt], 0, 0, 0); } while (0)
#define SA_COMPUTE(j, bufo) do { \
        const LAS unsigned char* kb_ = lds + (bufo); \
        f32x16 S0; \
        _Pragma("unroll") for (int i = 0; i < 16; ++i) S0[i] = 0.f; \
        int r32v = r32; asm volatile("" : "+v"(r32v)); \
        const int x_ = ((r32v & 3) << 2) | ((r32v >> 2) & 3); \
        const int krow = 256 * (r32v + 32 * kb) + 16 * ((g ^ x_) & 1), krope = SA_KR + (r32v + 32 * kb) * 144 + g * 16; \
        const LAS unsigned char* qrl = lds + SA_QR + (32 * qt + r32v) * 144 + g * 16; const LAS unsigned char* qil = lds + SA_QI + (32 * qt + r32v) * SA_QI_PITCH + g * 16; \
        bf16x8 ka_[4], qa_[4]; \
        SA_KLD(0); SA_KLD(1); SA_KLD(2); \
        _Pragma("unroll") for (int ks = 0; ks < 20; ++ks) { \
            if (ks + 3 < 20) SA_KLD(ks + 3); \
            __builtin_amdgcn_sched_barrier(0); \
            S0 = __builtin_amdgcn_mfma_f32_32x32x16_bf16(ka_[ks & 3], qa_[ks & 3], S0, 0, 0, 0); \
            __builtin_amdgcn_sched_barrier(0); } \
        if ((j) == 64) { const int tok = (32 * qt + r32) >> 3; asm volatile("" ::: "memory"); \
            _Pragma("unroll") for (int i = 0; i < 16; ++i) { const int key = 32 * kb + crow(i, g); if (key > tok || key >= DS) S0[i] = -1e30f; } } \
        float mx = S0[0]; \
        _Pragma("unroll") for (int i = 1; i < 16; ++i) mx = fmaxf(mx, S0[i]); \
        mx = fmaxf(mx, __shfl_xor(mx, 32)) * CEXP; \
        if (__any(mx > mrun + 11.5f)) { const float mnew = fmaxf(mrun, mx), alpha = __builtin_amdgcn_exp2f(mrun - mnew); mrun = mnew; lrun *= alpha; \
            _Pragma("unroll") for (int vt = 0; vt < 8; ++vt) _Pragma("unroll") for (int i = 0; i < 16; ++i) O[vt][i] *= alpha; } \
        int lnv = lane; asm volatile("" : "+v"(lnv)); \
        const int li = lnv & 15, q_ = li >> 2, p_ = li & 3, vsub = (lnv >> 4) & 1, gg = lnv >> 5; \
        bf16x8 fa_[2], fb_[2]; \
        SA_VLD(fa_, 0); SA_VLD(fb_, 1);                        \
        float ps = 0.f; \
        _Pragma("unroll") for (int i = 0; i < 16; ++i) { S0[i] = __builtin_amdgcn_exp2f(S0[i] * CEXP - mrun); ps += S0[i]; } \
        lrun += ps; \
        bf16x8 pf[2]; \
        { float tmp[8]; \
          _Pragma("unroll") for (int s2 = 0; s2 < 2; ++s2) { \
            _Pragma("unroll") for (int i = 0; i < 8; ++i) tmp[i] = S0[8 * s2 + i]; \
            pf[s2] = pack8(tmp); } } \
        __builtin_amdgcn_sched_barrier(0); \
        SA_VMM(fa_, 0); __builtin_amdgcn_sched_barrier(0); SA_VLD(fa_, 2); __builtin_amdgcn_sched_barrier(0); \
        SA_VMM(fb_, 1); __builtin_amdgcn_sched_barrier(0); SA_VLD(fb_, 3); __builtin_amdgcn_sched_barrier(0); \
        SA_VMM(fa_, 2); __builtin_amdgcn_sched_barrier(0); SA_VLD(fa_, 4); __builtin_amdgcn_sched_barrier(0); \
        SA_VMM(fb_, 3); __builtin_amdgcn_sched_barrier(0); SA_VLD(fb_, 5); __builtin_amdgcn_sched_barrier(0); \
        SA_VMM(fa_, 4); __builtin_amdgcn_sched_barrier(0); SA_VLD(fa_, 6); __builtin_amdgcn_sched_barrier(0); \
        SA_VMM(fb_, 5); __builtin_amdgcn_sched_barrier(0); SA_VLD(fb_, 7); __builtin_amdgcn_sched_barrier(0); \
        SA_VMM(fa_, 6); __builtin_amdgcn_sched_barrier(0); \
        SA_VMM(fb_, 7); } while (0)
#define SA_LOADER(j, SX, SY, bufn) do { const int h0_ = 2 * (j) + 6 < 127 ? 2 * (j) + 6 : 127, h1_ = 2 * (j) + 7 < 127 ? 2 * (j) + 7 : 127; \
        __builtin_amdgcn_sched_barrier(0); SA_WRITE(SX, bufn, 0); SA_LOAD(SX, h0_); __builtin_amdgcn_sched_barrier(0); SA_WRITE(SY, bufn, 1); SA_LOAD(SY, h1_); __builtin_amdgcn_sched_barrier(0); } while (0)
#define SA_TAIL64(bufn) do { if (half == 1) { \
            const char* cbn = (const char*)((const bf16_t*)(ws + WS_CB) + (size_t)(MP + b * DS) * KVR); const char* krn = (const char*)((const bf16_t*)(ws + WS_KRBS) + (size_t)(b * DS) * ROPE); \
            const int w4_ = wave - 4; \
            _Pragma("unroll") for (int hh = 0; hh < 2; ++hh) { \
                _Pragma("unroll") for (int e = 0; e < 8; ++e) { const int key = 8 * w4_ + e + 32 * hh; u32x2 z = {0u, 0u}; if (key < DS) z = *(const u32x2*)(cbn + key * (KVR * 2) + 8 * lane); *(LAS u32x2*)(lds + (bufn) + llb[e] + hh * 8192) = z; } \
                _Pragma("unroll") for (int e = 0; e < 2; ++e) { const int key = 8 * w4_ + 4 * e + (lane >> 4) + 32 * hh; u32x2 z = {0u, 0u}; if (key < DS) z = *(const u32x2*)(krn + key * (ROPE * 2) + 8 * (lane & 15)); *(LAS u32x2*)(lds + (bufn) + lrb[e] + hh * 4608) = z; } } } } while (0)
#define SA_BAR() do { asm volatile("s_waitcnt lgkmcnt(0)" ::: "memory"); __builtin_amdgcn_s_barrier(); asm volatile("" ::: "memory"); } while (0)
    float* ml = (float*)(ws + WS_ML) + (size_t)(b * 2 + half) * 64 * 2;
    if (is_cmp) {
        SA_BAR();
        f32x16 O[8];
#pragma unroll
        for (int vt = 0; vt < 8; ++vt)
#pragma unroll
            for (int i = 0; i < 16; ++i) O[vt][i] = 0.f;
        float mrun = -1e30f, lrun = 0.f;
        int bo = 0;
        for (int j = 0; j < 64; ++j) {
            SA_COMPUTE(j, bo);
            bo = SA_BUF - bo;
            SA_BAR();
        }
        if (half == 1) { SA_COMPUTE(64, bo); SA_BAR(); }
        LAS float* xo = (LAS float*)(lds + qt * 32768); LAS float* xm = (LAS float*)(lds + 65536 + qt * 512);
        if (kb == 1) { xm[2 * lane] = mrun; xm[2 * lane + 1] = lrun;
#pragma unroll
            for (int vt = 0; vt < 8; ++vt)
#pragma unroll
                for (int i = 0; i < 16; ++i) xo[(vt * 16 + i) * 64 + lane] = O[vt][i]; }
        SA_BAR();
        if (kb == 0) {
            const float m1 = xm[2 * lane], l1 = xm[2 * lane + 1], mm = fmaxf(mrun, m1);
            const float a0 = __builtin_amdgcn_exp2f(mrun - mm), a1 = __builtin_amdgcn_exp2f(m1 - mm);
            const float ll = lrun * a0 + l1 * a1, lt = ll + __shfl_xor(ll, 32);
            const int q = 32 * qt + r32;
            if (g == 0) { ml[q * 2] = mm; ml[q * 2 + 1] = lt; }
#pragma unroll
            for (int vt = 0; vt < 8; ++vt) {
                float o[16];
#pragma unroll
                for (int i = 0; i < 16; ++i) o[i] = O[vt][i] * a0 + xo[(vt * 16 + i) * 64 + lane] * a1;
#pragma unroll
                for (int jq = 0; jq < 4; ++jq) { u32x2 w; w.x = pk2(o[4 * jq], o[4 * jq + 1]); w.y = pk2(o[4 * jq + 2], o[4 * jq + 3]);
                    *(LAS u32x2*)(lds + SA_OI + q * SA_QI_PITCH + (32 * vt + 8 * jq + 4 * g) * 2) = w; }
            }
        }
    } else {
        unsigned glb, grb, llb[8], lrb[2];
        { const int w4_ = wave - 4;
          glb = (unsigned)(8 * w4_ * 1024 + 16 * lane); grb = (unsigned)(8 * w4_ * 256 + 16 * lane);
#pragma unroll
          for (int e = 0; e < 8; ++e) { const int x_ = ((e & 3) << 2) | ((2 * w4_ + (e >> 2)) & 3);
              llb[e] = (unsigned)((lane >> 5) * 16384 + 256 * (8 * w4_ + e) + 16 * ((((lane & 31) >> 1)) ^ x_) + 8 * (lane & 1)); }
#pragma unroll
          for (int e = 0; e < 2; ++e) lrb[e] = (unsigned)(SA_KR + (8 * w4_ + 4 * e + (lane >> 4)) * 144 + 8 * (lane & 15)); }
        f32x4 s0[10], s1[10], s2[10], s3[10];
        SA_LOAD(s0, 0); SA_LOAD(s1, 1); SA_LOAD(s2, 2); SA_LOAD(s3, 3);
        SA_WRITE(s0, 0, 0); SA_LOAD(s0, 4); SA_WRITE(s1, 0, 1); SA_LOAD(s1, 5);
        SA_BAR();
        for (int j = 0; j < 62; j += 2) {
            SA_LOADER(j, s2, s3, SA_BUF);
            SA_BAR();
            SA_LOADER(j + 1, s0, s1, 0);
            SA_BAR();
        }
        SA_LOADER(62, s2, s3, SA_BUF);
        SA_BAR();
        SA_TAIL64(0);
        SA_BAR();
        if (half == 1) SA_BAR();
        SA_BAR();
    }
#undef SA_BAR
#undef SA_LOAD
#undef SA_WRITE
#undef SA_PK4
#undef SA_COMPUTE
#undef SA_KLD
#undef SA_VLD
#undef SA_VMM
#undef SA_LOADER
#undef SA_TAIL64

    float* parto = (float*)(ws + WS_PART) + (size_t)(b * 2 + half) * 64 * 128;
    __syncthreads();
    { bf16x8 ao[16];
#pragma unroll
      for (int ks = 0; ks < 16; ++ks) { u32x4 z = {0u, 0u, 0u, 0u}; if (r32 < DS) z = *(const LAS u32x4*)(lds + SA_OI + (r32 * 8 + wave) * SA_QI_PITCH + (16 * ks + 8 * g) * 2); ao[ks] = __builtin_bit_cast(bf16x8, z); }
      const bf16_t* wv = (const bf16_t*)(ws + WS_WUVP) + (size_t)wave * (64 * 512) + lane * 8;
#pragma unroll 2
      for (int nt = 0; nt < 4; ++nt) {
          f32x16 acc;
#pragma unroll
          for (int i = 0; i < 16; ++i) acc[i] = 0.f;
#pragma unroll
          for (int ks = 0; ks < 16; ++ks) acc = __builtin_amdgcn_mfma_f32_32x32x16_bf16(ao[ks], *(const bf16x8*)(wv + (nt * 16 + ks) * 512), acc, 0, 0, 0);
#pragma unroll
          for (int i = 0; i < 4; ++i) parto[(size_t)((i + 4 * g) * 8 + wave) * 128 + 32 * nt + r32] = acc[i];
      } }
    volatile LAS unsigned* flag = (volatile LAS unsigned*)(lds + MISC_OFF) + 16;
    asm volatile("s_waitcnt vmcnt(0)" ::: "memory");
    __syncthreads();
    if (tid == 0) {
        __builtin_amdgcn_fence(__ATOMIC_RELEASE, "agent");
        asm volatile("s_waitcnt vmcnt(0)" ::: "memory");
        const unsigned old = __hip_atomic_fetch_add((unsigned*)(ws + WS_CTL) + CW_SCNT + 64 * b, 1u, __ATOMIC_RELAXED, __HIP_MEMORY_SCOPE_AGENT);
        if (old == 1u) { __builtin_amdgcn_fence(__ATOMIC_ACQUIRE, "agent"); asm volatile("s_waitcnt vmcnt(0)" ::: "memory"); }
        flag[0] = old;
    }
    __syncthreads();
    if (flag[0] == 1u) {
        const int q = tid >> 3, v0 = (tid & 7) * 16, tok = q >> 3, h = q & 7;
        const float* mlb = (const float*)(ws + WS_ML) + ((size_t)(b * 2) * 64 + q) * 2; const float* pab = (const float*)(ws + WS_PART) + ((size_t)(b * 2) * 64 + q) * 128 + v0;
        const float m0 = mlb[0], l0 = mlb[1], m1 = mlb[128], l1 = mlb[129], mx = fmaxf(m0, m1);
        float w0 = __builtin_amdgcn_exp2f(m0 - mx), w1 = __builtin_amdgcn_exp2f(m1 - mx); const float inv = 1.0f / (w0 * l0 + w1 * l1); w0 *= inv; w1 *= inv;
        f32x4 a[4];
#pragma unroll
        for (int c = 0; c < 4; ++c) a[c] = *(const f32x4*)(pab + 4 * c) * w0 + *(const f32x4*)(pab + 64 * 128 + 4 * c) * w1;
        bf16_t* od = (bf16_t*)(ws + WS_OBUF) + (size_t)(MP + b * DS + tok) * D + h * VD + v0;
        *(bf16x8*)od = pack8v(a[0], a[1]); *(bf16x8*)(od + 8) = pack8v(a[2], a[3]);
    }
}

template <int W>
__device__ __forceinline__ void pool_chunk(const float* __restrict__ xr, int rvb, f32x4 gn, int col, int t0, bf16_t* __restrict__ drow) {
    f32x4 ring[W - 1]; f32x4 sum = {0.f, 0.f, 0.f, 0.f};
#pragma unroll
    for (int i = W - 1; i >= 1; --i) { f32x4 u = {0.f, 0.f, 0.f, 0.f};
        if (t0 - i >= 0) u = *(const f32x4*)(xr - (size_t)i * D + col) * __builtin_bit_cast(float, __builtin_amdgcn_readlane(rvb, 15 - i));
        ring[(W - 1 - i) % (W - 1)] = u; sum += u; }
#pragma unroll
    for (int r = 0; r < 16; ++r) {
        const f32x4 u = *(const f32x4*)(xr + (size_t)r * D + col) * __builtin_bit_cast(float, __builtin_amdgcn_readlane(rvb, 15 + r));
        sum += u;
        const int t = t0 + r; const float icnt = 1.0f / (float)((t + 1) < W ? (t + 1) : W);
        const f32x4 dd = (sum * icnt - u) * gn;
        u32x2 o; o.x = pk2(dd.x, dd.y); o.y = pk2(dd.z, dd.w);
        *(u32x2*)(drow + (size_t)r * D + col) = o;
        sum -= ring[r % (W - 1)]; ring[r % (W - 1)] = u;
    }
}
constexpr int NPH = 17;
__global__ void __launch_bounds__(512, 2) yoco_fwd(Params P) {
    extern __shared__ __attribute__((aligned(16))) unsigned char lds_raw[];
    LAS unsigned char* lds = (LAS unsigned char*)lds_raw;
    volatile LAS unsigned* MISC = (volatile LAS unsigned*)(lds + MISC_OFF);
    const int tid = threadIdx.x, lane = tid & 63, wave = __builtin_amdgcn_readfirstlane(tid >> 6);
    const int G = gridDim.x; const int bx = blockIdx.x; const int vcu = (G % 8 == 0) ? (bx % 8) * (G / 8) + bx / 8 : bx;
    unsigned char* ws = P.ws; float* out = P.out;
    for (int u = tid; u < 64; u += 512) MISC[u] = 0u;
    __syncthreads();
    XcdBarrier bar; bar.bar = (unsigned*)(ws + WS_CTL) + CW_BAR; bar.x = 0; bar.st = nullptr;
    if (MK_N_LAUNCHES == 1) bar = xcd_barrier_post((unsigned*)(ws + WS_CTL) + CW_BAR, MISC + 8);
    const int lo = P.ph_lo, hi = P.ph_hi;
#ifndef PH_MASK
#define PH_MASK 0xFFFFFFFFu
#endif
#define IN(k) (((PH_MASK >> (k)) & 1u) && lo <= (k) && (k) < hi)
#define SEAM(k) do { if (IN(k) && IN((k) + 1)) xcd_barrier(bar); } while (0)
#define SEAM2(k, kn) do { if (IN(k) && IN(kn)) xcd_barrier(bar); } while (0)
    const int gw = vcu * 8 + wave, NGW = G * 8;
    const int gtid = vcu * 512 + tid, NGT = G * 512;

#define wpool ((bf16_t*)(ws + WS_WPOOL))
#define wup ((bf16_t*)(ws + WS_WUP))
#define wdown ((bf16_t*)(ws + WS_WDOWN))
#define wgate ((bf16_t*)(ws + WS_WGATE))
#define wproj ((bf16_t*)(ws + WS_WPROJ))
#define wdkvq ((bf16_t*)(ws + WS_WDKVQ))
#define wuq ((bf16_t*)(ws + WS_WUQ))
#define wukt ((bf16_t*)(ws + WS_WUKT))
#define wuvt ((bf16_t*)(ws + WS_WUVT))
#define wukb ((bf16_t*)(ws + WS_WUKB))
#define wo ((bf16_t*)(ws + WS_WO))
#define cs ((float*)(ws + WS_CS))
#define rstd0 ((float*)(ws + WS_RSTD0))
#define dbuf ((bf16_t*)(ws + WS_DBUF))
#define pb ((bf16_t*)(ws + WS_PB))
#define hbA ((bf16_t*)(ws + WS_HBA))
#define hbB ((bf16_t*)(ws + WS_HBB))
#define ssq ((float*)(ws + WS_SSQ))
#define abuf ((bf16_t*)(ws + WS_ABUF))
#define proj ((bf16_t*)(ws + WS_PROJ))
#define craw ((float*)(ws + WS_RAW))
#define ssqc ((float*)(ws + WS_RAW + (size_t)M * KVR * 4))
#define ssqq ((float*)(ws + WS_RAW + (size_t)M * KVR * 4 + (size_t)M * 16))
#define cb ((bf16_t*)(ws + WS_CB))
#define krbs ((bf16_t*)(ws + WS_KRBS))
#define cqb ((bf16_t*)(ws + WS_CQB))
#define qbuf ((bf16_t*)(ws + WS_QBUF))
#define qs ((bf16_t*)(ws + WS_QS))
#define kfull ((bf16_t*)(ws + WS_KFULL))
#define vt ((bf16_t*)(ws + WS_VT))
#define obuf ((bf16_t*)(ws + WS_OBUF))
    constexpr size_t SSQ_V = (size_t)M * 16;

    constexpr int NU6 = (M / 256) * (NDKVQ / 256);
    const bool defer_l1 = (MK_N_LAUNCHES == 1) && G >= NU6 + 32;
    if (IN(0)) {
        LAS float* scr = (LAS float*)(lds + wave * 16384);
        int it = gw;
#define TI(W_, ks_, K_, N_, WT_, ro_) { const int n_items = ((K_) / 64) * ((N_) / 32); for (; it < n_items; it += NGW) transpose_item(W_, ks_, K_, N_, WT_, ro_, scr, it, lane); it -= n_items; }
        TI(P.in[I_POOLW] + 0 * 65536, nullptr, 256, 256, wpool, 0) TI(P.in[I_POOLW] + 1 * 65536, nullptr, 256, 256, wpool, 256)
        TI(P.in[I_POOLW] + 2 * 65536, nullptr, 256, 256, wpool, 512) TI(P.in[I_POOLW] + 3 * 65536, nullptr, 256, 256, wpool, 768)
        TI(P.in[I_WUP], P.in[I_NMLP], D, FF, wup, 0) if (!defer_l1) TI(P.in[I_WUP] + (size_t)D * FF, P.in[I_NMLP] + D, D, FF, wup + (size_t)FF * D, 0)
        TI(P.in[I_WDOWN], nullptr, FF, D, wdown, 0) if (!defer_l1) TI(P.in[I_WDOWN] + (size_t)D * FF, nullptr, FF, D, wdown + (size_t)FF * D, 0)
        TI(P.in[I_WGATE], P.in[I_NPLE], D, D, wgate, 0) if (!defer_l1) TI(P.in[I_WGATE] + (size_t)D * D, P.in[I_NPLE] + D, D, D, wgate + (size_t)D * D, 0)
        TI(P.in[I_WPROJ], nullptr, PLE, D, wproj, 0) TI(P.in[I_WPROJ] + (size_t)PLE * D, nullptr, PLE, D, wproj + (size_t)PLE * D, 0)
        { const int n_items = (D / 64) * (320 / 32); for (; it < n_items; it += NGW) transpose_item<2>(P.in[I_WDKV], P.in[I_NKV], D, 320, wdkvq, 0, scr, it, lane); it -= n_items; }
        TI(P.in[I_WDQ], P.in[I_NMIX] + D, D, QR, wdkvq, 320)
        { const int n_items = (QR / 64) * (NH * QH / 32); for (; it < n_items; it += NGW) transpose_item<1>(P.in[I_WUQ], P.in[I_QN], QR, NH * QH, wuq, 0, scr, it, lane); it -= n_items; }
        TI(P.in[I_WUK], P.in[I_KVN], KVR, 1024, wukt, 0) TI(P.in[I_WUV], P.in[I_KVN], KVR, 1024, wuvt, 0)
        if (!defer_l1) TI(P.in[I_WO], nullptr, D, D, wo, 0)
#undef TI
        for (int i = gtid; i < 64 * D / 8; i += NGT) *(u32x4*)(wdkvq + (size_t)704 * D + (size_t)i * 8) = (u32x4){0u, 0u, 0u, 0u};
        for (int i = gtid; i < 256 * 1024 / 8; i += NGT) { const int ln = i & 63, ks = (i >> 6) & 7, nt = (i >> 9) & 7, h = i >> 12;
            const float* sp = P.in[I_WUK] + (size_t)(32 * nt + (ln & 31)) * 1024 + h * NOPE + 16 * ks + 8 * (ln >> 5);
            *(bf16x8*)(wukb + (size_t)i * 8) = pack8v(*(const f32x4*)sp, *(const f32x4*)(sp + 4)); }
        for (int i = gtid; i < 256 * 1024 / 8; i += NGT) { const int ln = i & 63, ks = (i >> 6) & 15, nt = (i >> 10) & 3, h = i >> 12;
            const float* sp = P.in[I_WUV] + (size_t)(16 * ks + 8 * (ln >> 5)) * 1024 + h * VD + 32 * nt + (ln & 31);
            float t[8];
#pragma unroll
            for (int e = 0; e < 8; ++e) t[e] = sp[(size_t)e * 1024];
            *(bf16x8*)((bf16_t*)(ws + WS_WUVP) + (size_t)i * 8) = pack8(t); }
        for (int i = gtid; i < NPOS * 32; i += NGT) { const int pos = i >> 5, f = i & 31; const double inv = exp2(-(double)f * (13.287712379549449 / 32.0)); const double ang = (double)pos * inv;
            double sn, cn; sincos(ang, &sn, &cn); cs[(size_t)pos * 64 + f] = (float)cn; cs[(size_t)pos * 64 + 32 + f] = (float)sn; }
        for (int i = gtid; i < 2 * M * PLE / 8; i += NGT) { const int li = i / (M * PLE / 8), r8 = i % (M * PLE / 8); const size_t e = (size_t)r8 * 8; const int row = (int)(e / PLE), c = (int)(e % PLE);
            const float* src = row < MP ? P.in[I_PP] + ((size_t)li * MP + row) * PLE + c : P.in[I_PS] + ((size_t)li * MS + (row - MP)) * PLE + c;
            *(bf16x8*)(pb + ((size_t)li * M + row) * PLE + c) = pack8v(*(const f32x4*)src, *(const f32x4*)(src + 4)); }
        for (int row0 = gw; row0 < M; row0 += 2 * NGW) {
            f32x4 v[2][4];
#pragma unroll
            for (int rr = 0; rr < 2; ++rr) { const int row = row0 + rr * NGW; if (row < M) { const float* xr = row < MP ? P.in[I_XP] + (size_t)row * D : P.in[I_XS] + (size_t)(row - MP) * D;
#pragma unroll
                for (int j = 0; j < 4; ++j) v[rr][j] = ((const f32x4*)xr)[lane + 64 * j]; } }
#pragma unroll
            for (int rr = 0; rr < 2; ++rr) { const int row = row0 + rr * NGW; if (row < M) {
                float s = 0.f;
#pragma unroll
                for (int j = 0; j < 4; ++j) s += (v[rr][j].x * v[rr][j].x + v[rr][j].y * v[rr][j].y) + (v[rr][j].z * v[rr][j].z + v[rr][j].w * v[rr][j].w);
                const float rstd = 1.0f / sqrtf(wave_sum(s) * (1.0f / D) + EPS);
                if (lane == 0) rstd0[row] = rstd;
                float* po = nullptr;
                if (row < MP) { const int b = row >> 13, t = row & (SEQ - 1); if (t >= SEQ - 15) po = out + O_PP + ((size_t)b * 15 + (t - (SEQ - 15))) * D; }
                else { const int rs_ = row - MP, b = rs_ >> 3, t = rs_ & 7; po = out + O_PS + ((size_t)b * 15 + 7 + t) * D; }
                if (po) {
#pragma unroll
                    for (int j = 0; j < 4; ++j) { const f32x4 gn = ((const f32x4*)P.in[I_NMIX])[lane + 64 * j]; ((f32x4*)po)[lane + 64 * j] = v[rr][j] * rstd * gn; } }
            } }
        }
        for (int i = gtid; i < DB * 7 * D / 4; i += NGT) { const int b = i / (7 * D / 4), r = (i / (D / 4)) % 7, c = i % (D / 4);
            ((f32x4*)(out + O_PS + ((size_t)b * 15 + r) * D))[c] = ((const f32x4*)(P.in[I_SPOOL] + ((size_t)b * 15 + 8 + r) * D))[c]; }
    }
    SEAM2(0, 2);
    if (IN(2)) {
#ifndef SUBM
#define SUBM 7
#endif
        { SgH<0> E{P.in[I_XS], P.in[I_POOLSC], nullptr, nullptr, nullptr, hbA, ssq + 0 * SSQ_V};
          for (int u = vcu; u < 256; u += G) {
              const int mt = u >> 4, gq = (u & 15) >> 2, w = 2 << gq, col = 256 * gq + 4 * lane, bs = mt * 8 + wave;
              const float* sp = P.in[I_SPOOL] + (size_t)bs * 15 * D; const float* xs0 = P.in[I_XS] + (size_t)(bs * DS) * D;
              const float rv = (lane < DS) ? rstd0[MP + bs * DS + lane] : 0.f;
              const f32x4 gn = *(const f32x4*)(P.in[I_NMIX] + col);
#pragma unroll
              for (int t = 0; t < DS; ++t) {
                  const f32x4 u0 = *(const f32x4*)(xs0 + (size_t)t * D + col) * __shfl(rv, t); f32x4 sum = u0, hist = {0.f, 0.f, 0.f, 0.f};
#pragma unroll
                  for (int i = 1; i < 16; ++i) if (i < w) { const int tt = t - i;
                      if (tt >= 0) sum += *(const f32x4*)(xs0 + (size_t)tt * D + col) * __shfl(rv, tt >= 0 ? tt : 0);
                      else hist += *(const f32x4*)(sp + (size_t)(15 + tt) * D + col); }
                  const f32x4 dd = (sum * gn + hist) / (float)w - u0 * gn;
                  u32x2 o; o.x = pk2(dd.x, dd.y); o.y = pk2(dd.z, dd.w);
                  *(u32x2*)(dbuf + (size_t)(MP + bs * DS + t) * D + col) = o;
              }
              asm volatile("s_waitcnt vmcnt(0)" ::: "memory"); __syncthreads();
              sk_gemm(lds, dbuf + (size_t)(MP + 64 * mt) * D + 256 * gq, D, wpool + (size_t)(64 * (u & 15)) * 256, 256, 64 * mt, 64 * (u & 15), u & 15, E, tid, wave, lane); } }
        { SgBf E{proj, D};
          for (int u = vcu; u < 256; u += G) sk_gemm(lds, pb + (size_t)(MP + 64 * (u >> 4)) * PLE, PLE, wproj + (size_t)(64 * (u & 15)) * PLE, PLE, 64 * (u >> 4), 64 * (u & 15), u & 15, E, tid, wave, lane); }
        { SgBf E{proj + (size_t)M * D, D};
          for (int u = vcu; u < 256; u += G) sk_gemm(lds, pb + (size_t)(M + MP + 64 * (u >> 4)) * PLE, PLE, wproj + (size_t)PLE * D + (size_t)(64 * (u & 15)) * PLE, PLE, 64 * (u >> 4), 64 * (u & 15), u & 15, E, tid, wave, lane); }
        if (SUBM & 1) { pg8::Gemm g{dbuf, wpool, MP, D, 256, D, 256}; pg8::StaticOrder S; S.init(MP, D, G, bx);
          {
            pg8::Unit uu;
            for (int i = 0; S.next(i, uu); ++i) {
#pragma unroll 1
                for (int cc = 0; cc < 2; ++cc) {
                    const int row0 = uu.pm * 256 + (2 * wave + cc) * 16, t0 = row0 & (SEQ - 1), col = 256 * uu.pn + 4 * lane;
                    const float rv = (lane < 31 && t0 - 15 + lane >= 0) ? rstd0[row0 - 15 + lane] : 0.f;
                    const int rvb = __builtin_bit_cast(int, rv);
                    const float* xr = P.in[I_XP] + (size_t)row0 * D; bf16_t* dr = dbuf + (size_t)row0 * D; const f32x4 gn = *(const f32x4*)(P.in[I_NMIX] + col);
                    if (uu.pn == 0) pool_chunk<2>(xr, rvb, gn, col, t0, dr); else if (uu.pn == 1) pool_chunk<4>(xr, rvb, gn, col, t0, dr);
                    else if (uu.pn == 2) pool_chunk<8>(xr, rvb, gn, col, t0, dr); else pool_chunk<16>(xr, rvb, gn, col, t0, dr);
                } }
            asm volatile("s_waitcnt vmcnt(0)" ::: "memory"); __syncthreads(); }
          EpiH<0> E{P.in[I_XP], P.in[I_XS], P.in[I_POOLSC], nullptr, nullptr, nullptr, hbA, ssq + 0 * SSQ_V};
          pg8::gemm_phase(lds, g, S, E); }
        if (SUBM & 2) { pg8::Gemm g{pb, wproj, MP, D, PLE, PLE, 0}; pg8::StaticOrder S; S.init(MP, D, G, bx);
          EpiBf E{proj, D};
          pg8::gemm_phase(lds, g, S, E); }
        if (SUBM & 4) { pg8::Gemm g{pb + (size_t)M * PLE, wproj + (size_t)PLE * D, MP, D, PLE, PLE, 0}; pg8::StaticOrder S; S.init(MP, D, G, bx);
          EpiBf E{proj + (size_t)M * D, D};
          pg8::gemm_phase(lds, g, S, E); }
    }
    SEAM(2);
    if (IN(3)) {
        { SgUp E{ssq + 0 * SSQ_V, abuf}; for (int u = vcu; u < 256; u += G) sk_gemm_w(lds, hbA + (size_t)(MP + 64 * (u & 15)) * D, D, wup + (size_t)(256 * (u >> 4)) * D, D, 64 * (u & 15), 256 * (u >> 4), E, tid, wave, lane); }
        pg8::Gemm g{hbA, wup, MP, FF, D, D, 0}; pg8::StaticOrder S; S.init(MP, FF, G, bx); EpiUp E{ssq + 0 * SSQ_V, abuf}; pg8::gemm_phase(lds, g, S, E); }
    SEAM(3);
    if (IN(4)) {
        { SgH<1> E{nullptr, nullptr, nullptr, nullptr, hbA, hbB, ssq + 1 * SSQ_V}; for (int u = vcu; u < 256; u += G) sk_gemm(lds, abuf + (size_t)(MP + 64 * (u >> 4)) * FF, FF, wdown + (size_t)(64 * (u & 15)) * FF, FF, 64 * (u >> 4), 64 * (u & 15), u & 15, E, tid, wave, lane); }
        pg8::Gemm g{abuf, wdown, MP, D, FF, FF, 0}; pg8::StaticOrder S; S.init(MP, D, G, bx);
        EpiH<1> E{nullptr, nullptr, nullptr, nullptr, nullptr, hbA, hbB, ssq + 1 * SSQ_V}; pg8::gemm_phase(lds, g, S, E); }
    SEAM(4);
    if (IN(5)) {
        { SgH<2> E{nullptr, nullptr, ssq + 1 * SSQ_V, proj, hbB, hbA, ssq + 2 * SSQ_V}; for (int u = vcu; u < 256; u += G) sk_gemm(lds, hbB + (size_t)(MP + 64 * (u >> 4)) * D, D, wgate + (size_t)(64 * (u & 15)) * D, D, 64 * (u >> 4), 64 * (u & 15), u & 15, E, tid, wave, lane); }
        pg8::Gemm g{hbB, wgate, MP, D, D, D, 0}; pg8::StaticOrder S; S.init(MP, D, G, bx);
        EpiH<2> E{nullptr, nullptr, nullptr, ssq + 1 * SSQ_V, proj, hbB, hbA, ssq + 2 * SSQ_V}; pg8::gemm_phase(lds, g, S, E); }
    SEAM(5);
    if (IN(6)) {
        if (defer_l1 && bx >= NU6) {
            LAS float* scr = (LAS float*)(lds + wave * 16384);
            const int nst = (G - NU6) * 8; int it = (bx - NU6) * 8 + wave;
#define TI(W_, ks_, K_, N_, WT_, ro_) { const int n_items = ((K_) / 64) * ((N_) / 32); for (; it < n_items; it += nst) transpose_item(W_, ks_, K_, N_, WT_, ro_, scr, it, lane); it -= n_items; }
            TI(P.in[I_WUP] + (size_t)D * FF, P.in[I_NMLP] + D, D, FF, wup + (size_t)FF * D, 0) TI(P.in[I_WDOWN] + (size_t)D * FF, nullptr, FF, D, wdown + (size_t)FF * D, 0)
            TI(P.in[I_WGATE] + (size_t)D * D, P.in[I_NPLE] + D, D, D, wgate + (size_t)D * D, 0) TI(P.in[I_WO], nullptr, D, D, wo, 0)
#undef TI
        }
        pg8::Gemm g{hbA, wdkvq, M, NDKVQ, D, D, 0}; pg8::StaticOrder S; S.init(M, NDKVQ, G, bx); EpiDkvq E{ssq + 2 * SSQ_V, cs, craw, cb, cqb, ssqc, ssqq, out, kfull, krbs}; pg8::gemm_phase(lds, g, S, E); }
    SEAM2(6, 8);
    if (IN(8)) {
        if (SUBM & 1) { pg8::Gemm g{cqb, wuq, M, NH * QH, QR, QR, 0}; pg8::StaticOrder S; S.init(M, NH * QH, G, bx); EpiQ E{ssqq, cs, qbuf, qs}; pg8::gemm_phase(lds, g, S, E); }
        if (SUBM & 2) { pg8::Gemm g{cb, wukt, MP, 1024, KVR, KVR, 0}; pg8::StaticOrder S; S.init(MP, 1024, G, (bx + 128) % G); EpiKup E{kfull, ssqc}; pg8::gemm_phase(lds, g, S, E); }
        if (SUBM & 4) { pg8::Gemm g{wuvt, cb, 1024, MP, KVR, KVR, 0}; pg8::StaticOrder S; S.init(1024, MP, G, (bx + 128) % G); EpiVup E{vt, ssqc}; pg8::gemm_phase(lds, g, S, E); }
        { const f32x4 kvn = ((const f32x4*)P.in[I_KVN])[lane];
          for (int row0 = 2 * gw; row0 < M; row0 += 2 * NGW) {
              f32x4 c4[2], p4[2];
#pragma unroll
              for (int e = 0; e < 2; ++e) { c4[e] = ((const f32x4*)(craw + (size_t)(row0 + e) * KVR))[lane]; p4[e] = *(const f32x4*)(ssqc + (size_t)(row0 + e) * 4); }
#pragma unroll
              for (int e = 0; e < 2; ++e) { const int row = row0 + e; const bool isp = row < MP;
                  const float rc = 1.0f / sqrtf(((p4[e].x + p4[e].y) + (p4[e].z + p4[e].w)) * (1.0f / KVR) + EPS);
                  const f32x4 cn = c4[e] * rc * kvn;
                  float* lo_ = isp ? out + O_LP + (size_t)row * KVR : out + O_LS + (size_t)(row - MP) * KVR;
                  ((f32x4*)lo_)[lane] = cn;
                  if (!isp) { u32x2 o; o.x = pk2(cn.x, cn.y); o.y = pk2(cn.z, cn.w); ((u32x2*)(cb + (size_t)row * KVR))[lane] = o; } } } }
    }
    SEAM2(8, 10);
    if (IN(10)) {
        const int sq_ = (bx >> 3) & 3;
        if (sq_ == 0) for (int it = vcu; it < 2 * DB; it += G) sattn_item(P, it >> 1, it & 1, lds, tid, wave, lane);
        for (int u = vcu; u < 256; u += G) { const int bh = u >> 4, p = u & 15; attn_prompt_unit(qbuf, kfull, vt, obuf, bh >> 3, bh & 7, sq_ == 1 ? p : 31 - p, lds, tid, wave, lane); }
        if (sq_ == 1 || sq_ == 2) for (int it = vcu; it < 2 * DB; it += G) sattn_item(P, it >> 1, it & 1, lds, tid, wave, lane);
        for (int u = vcu; u < 256; u += G) { const int bh = u >> 4, p = u & 15; attn_prompt_unit(qbuf, kfull, vt, obuf, bh >> 3, bh & 7, sq_ == 1 ? 31 - p : p, lds, tid, wave, lane); }
        if (sq_ == 3) for (int it = vcu; it < 2 * DB; it += G) sattn_item(P, it >> 1, it & 1, lds, tid, wave, lane);
    }
    SEAM2(10, 12);
    if (IN(12)) {
        { SgH<1> E{nullptr, nullptr, nullptr, nullptr, hbA, hbB, ssq + 3 * SSQ_V};
          for (int u = vcu; u < 256; u += G) sk_gemm(lds, obuf + (size_t)(MP + 64 * (u >> 4)) * D, D, wo + (size_t)(64 * (u & 15)) * D, D, 64 * (u >> 4), 64 * (u & 15), u & 15, E, tid, wave, lane); }
        pg8::Gemm g{obuf, wo, MP, D, D, D, 0}; pg8::StaticOrder S; S.init(MP, D, G, bx);
        EpiH<1> E{nullptr, nullptr, nullptr, nullptr, nullptr, hbA, hbB, ssq + 3 * SSQ_V}; pg8::gemm_phase(lds, g, S, E); }
    SEAM(12);
    if (IN(13)) {
        { SgUp E{ssq + 3 * SSQ_V, abuf}; for (int u = vcu; u < 256; u += G) sk_gemm_w(lds, hbB + (size_t)(MP + 64 * (u & 15)) * D, D, wup + (size_t)FF * D + (size_t)(256 * (u >> 4)) * D, D, 64 * (u & 15), 256 * (u >> 4), E, tid, wave, lane); }
        pg8::Gemm g{hbB, wup + (size_t)FF * D, MP, FF, D, D, 0}; pg8::StaticOrder S; S.init(MP, FF, G, bx); EpiUp E{ssq + 3 * SSQ_V, abuf}; pg8::gemm_phase(lds, g, S, E); }
    SEAM(13);
    if (IN(14)) {
        { SgH<1> E{nullptr, nullptr, nullptr, nullptr, hbB, hbA, ssq + 4 * SSQ_V}; for (int u = vcu; u < 256; u += G) sk_gemm(lds, abuf + (size_t)(MP + 64 * (u >> 4)) * FF, FF, wdown + (size_t)FF * D + (size_t)(64 * (u & 15)) * FF, FF, 64 * (u >> 4), 64 * (u & 15), u & 15, E, tid, wave, lane); }
        pg8::Gemm g{abuf, wdown + (size_t)FF * D, MP, D, FF, FF, 0}; pg8::StaticOrder S; S.init(MP, D, G, bx);
        EpiH<1> E{nullptr, nullptr, nullptr, nullptr, nullptr, hbB, hbA, ssq + 4 * SSQ_V}; pg8::gemm_phase(lds, g, S, E); }
    SEAM(14);
    if (IN(15)) {
        { SgH<2> E{nullptr, nullptr, ssq + 4 * SSQ_V, proj + (size_t)M * D, hbA, hbB, ssq + 5 * SSQ_V}; for (int u = vcu; u < 256; u += G) sk_gemm(lds, hbA + (size_t)(MP + 64 * (u >> 4)) * D, D, wgate + (size_t)D * D + (size_t)(64 * (u & 15)) * D, D, 64 * (u >> 4), 64 * (u & 15), u & 15, E, tid, wave, lane); }
        pg8::Gemm g{hbA, wgate + (size_t)D * D, MP, D, D, D, 0}; pg8::StaticOrder S; S.init(MP, D, G, bx);
        EpiH<2> E{nullptr, nullptr, nullptr, ssq + 4 * SSQ_V, proj + (size_t)M * D, hbA, hbB, ssq + 5 * SSQ_V}; pg8::gemm_phase(lds, g, S, E); }
    SEAM(15);
    if (IN(16)) {
        f32x4 gn[4];
#pragma unroll
        for (int j = 0; j < 4; ++j) gn[j] = ((const f32x4*)P.in[I_NFIN])[lane + 64 * j];
        for (int row0 = 4 * gw; row0 < M; row0 += 4 * NGW) {
            u32x2 hv[4][4]; float sp[4];
#pragma unroll
            for (int e = 0; e < 4; ++e) { sp[e] = (lane < 16) ? ssq[5 * SSQ_V + (size_t)(row0 + e) * 16 + lane] : 0.f;
#pragma unroll
                for (int j = 0; j < 4; ++j) hv[e][j] = ((const u32x2*)(hbB + (size_t)(row0 + e) * D))[lane + 64 * j]; }
#pragma unroll
            for (int e = 0; e < 4; ++e) { const float rstd = 1.0f / sqrtf(wave_sum(sp[e]) * (1.0f / D) + EPS);
#pragma unroll
                for (int j = 0; j < 4; ++j) ((f32x4*)(out + O_Y + (size_t)(row0 + e) * D))[lane + 64 * j] = unpk4(hv[e][j]) * rstd * gn[j]; }
        }
    }
#undef IN
#undef SEAM
#undef SEAM2
#undef wpool
#undef wup
#undef wdown
#undef wgate
#undef wproj
#undef wdkvq
#undef wuq
#undef wukt
#undef wuvt
#undef wukb
#undef wo
#undef cs
#undef rstd0
#undef dbuf
#undef pb
#undef hbA
#undef hbB
#undef ssq
#undef abuf
#undef proj
#undef craw
#undef ssqc
#undef ssqq
#undef cb
#undef krbs
#undef cqb
#undef qbuf
#undef qs
#undef kfull
#undef vt
#undef obuf
}

extern "C" void kernel_launch(void* const* d_in, const int* in_sizes, int n_in, void* d_out, int out_size, void* d_ws, size_t ws_size, hipStream_t stream) {
    static int grid = 0;
    if (grid == 0) {
        if (n_in != 27 || (size_t)out_size != O_END || ws_size < WS_END) { fprintf(stderr, "kernel_launch: shape mismatch (n_in %d, out %d, ws %zu; need 27, %zu, %zu)\n", n_in, out_size, ws_size, (size_t)O_END, (size_t)WS_END); grid = -1; return; }
        int dev = 0, cus = 0, per_cu = 0;
        if (hipGetDevice(&dev) != hipSuccess || hipDeviceGetAttribute(&cus, hipDeviceAttributeMultiprocessorCount, dev) != hipSuccess) { grid = -1; return; }
        if (hipFuncSetAttribute((const void*)yoco_fwd, hipFuncAttributeMaxDynamicSharedMemorySize, LDS_BYTES) != hipSuccess) { fprintf(stderr, "kernel_launch: hipFuncSetAttribute failed\n"); grid = -1; return; }
        if (hipOccupancyMaxActiveBlocksPerMultiprocessor(&per_cu, (const void*)yoco_fwd, 512, LDS_BYTES) != hipSuccess || per_cu < 1) fprintf(stderr, "kernel_launch: occupancy query reports %d\n", per_cu);
        (void)hipGetLastError();
        grid = cus;
    }
    if (grid < 0) return;
    (void)hipMemsetAsync((char*)d_ws + WS_CTL, 0, CTL_BYTES, stream);
    Params p{};
    for (int i = 0; i < 27; ++i) p.in[i] = (const float*)d_in[i];
    p.out = (float*)d_out; p.ws = (unsigned char*)d_ws;
#if MK_N_LAUNCHES == 1
    p.ph_lo = 0; p.ph_hi = NPH;
    hipLaunchKernelGGL(yoco_fwd, dim3(grid), dim3(512), LDS_BYTES, stream, p);
#else
    for (int k = 0; k < NPH; ++k) { p.ph_lo = k; p.ph_hi = k + 1; hipLaunchKernelGGL(yoco_fwd, dim3(grid), dim3(512), LDS_BYTES, stream, p); }
#endif
    const hipError_t le = hipPeekAtLastError();
    if (le != hipSuccess) fprintf(stderr, "kernel_launch: launch failed: %s\n", hipGetErrorName(le));
}
```

```cpp
#include <hip/hip_runtime.h>
#include <cstdio>
#include <cstdint>

#ifndef MK_N_LAUNCHES
#define MK_N_LAUNCHES 1
#endif

#define GAS __attribute__((address_space(1)))
#define LAS __attribute__((address_space(3)))
typedef unsigned short bf16_t;
typedef short bf16x8 __attribute__((ext_vector_type(8)));
typedef float f32x4 __attribute__((ext_vector_type(4)));
typedef float f32x16 __attribute__((ext_vector_type(16)));
typedef unsigned u32x2 __attribute__((ext_vector_type(2)));
typedef unsigned u32x4 __attribute__((ext_vector_type(4)));

constexpr int D = 1024, FF = 4096, PLE = 256, SEQ = 8192, NBATCH = 2, DB = 128, DS = 8;
constexpr int MP = NBATCH * SEQ;
constexpr int MS = DB * DS;
constexpr int M = MP + MS;
constexpr int KVR = 256, ROPE = 64, QR = 384, NH = 8, NOPE = 128, VD = 128, QH = NOPE + ROPE;
constexpr int NDKVQ = 768;
constexpr int PAST = 8192, PAGE = 128, NPG = PAST / PAGE;
constexpr float EPS = 1e-6f;
constexpr float SM_SCALE = 0.07216878364870322f;
constexpr float LOG2E = 1.4426950408889634f;
constexpr float CEXP = SM_SCALE * LOG2E;
constexpr int NPOS = PAST + DS;

constexpr size_t O_Y = 0;
constexpr size_t O_PP = (size_t)M * D;
constexpr size_t O_PS = O_PP + (size_t)NBATCH * 15 * D;
constexpr size_t O_LP = O_PS + (size_t)DB * 15 * D;
constexpr size_t O_KP = O_LP + (size_t)MP * KVR;
constexpr size_t O_LS = O_KP + (size_t)MP * ROPE;
constexpr size_t O_KS = O_LS + (size_t)MS * KVR;
constexpr size_t O_END = O_KS + (size_t)MS * ROPE;

constexpr size_t al256(size_t x) { return (x + 255) / 256 * 256; }
constexpr size_t WS_CTL = 0, CTL_BYTES = 1u << 20;
constexpr size_t WS_WPOOL = CTL_BYTES;
constexpr size_t WS_WUP   = WS_WPOOL + al256((size_t)1024 * 256 * 2);
constexpr size_t WS_WDOWN = WS_WUP   + al256((size_t)2 * FF * D * 2);
constexpr size_t WS_WGATE = WS_WDOWN + al256((size_t)2 * FF * D * 2);
constexpr size_t WS_WPROJ = WS_WGATE + al256((size_t)2 * D * D * 2);
constexpr size_t WS_WDKVQ = WS_WPROJ + al256((size_t)2 * D * PLE * 2);
constexpr size_t WS_WUQ   = WS_WDKVQ + al256((size_t)NDKVQ * D * 2);
constexpr size_t WS_WUKT  = WS_WUQ   + al256((size_t)NH * QH * QR * 2);
constexpr size_t WS_WUVT  = WS_WUKT  + al256((size_t)1024 * 256 * 2);
constexpr size_t WS_WUVP  = WS_WUVT  + al256((size_t)1024 * 256 * 2);
constexpr size_t WS_WUKB  = WS_WUVP  + al256((size_t)1024 * 256 * 2);
constexpr size_t WS_WO    = WS_WUKB  + al256((size_t)1024 * 256 * 2);
constexpr size_t WS_CS    = WS_WO    + al256((size_t)D * D * 2);
constexpr size_t WS_RSTD0 = WS_CS    + al256((size_t)NPOS * 64 * 4);
constexpr size_t WS_DBUF  = WS_RSTD0 + al256((size_t)M * 4);
constexpr size_t WS_PB    = WS_DBUF  + al256((size_t)M * D * 2);
constexpr size_t WS_HBA   = WS_PB    + al256((size_t)2 * M * PLE * 2);
constexpr size_t WS_HBB   = WS_HBA   + al256((size_t)M * D * 2);
constexpr size_t WS_SSQ   = WS_HBB   + al256((size_t)M * D * 2);
constexpr size_t WS_ABUF  = WS_SSQ   + al256((size_t)6 * M * 16 * 4);
constexpr size_t WS_PROJ  = WS_ABUF  + al256((size_t)M * FF * 2);
constexpr size_t WS_RAW   = WS_PROJ  + al256((size_t)2 * M * D * 2);
constexpr size_t WS_CB    = WS_RAW   + al256((size_t)M * NDKVQ * 4);
constexpr size_t WS_KRBS  = WS_CB    + al256((size_t)M * KVR * 2);
constexpr size_t WS_CQB   = WS_KRBS  + al256((size_t)M * ROPE * 2);
constexpr size_t WS_RSTDQ = WS_CQB   + al256((size_t)M * QR * 2);
constexpr size_t WS_QBUF  = WS_RSTDQ + al256((size_t)M * 4);
constexpr size_t WS_QS    = WS_QBUF  + al256((size_t)M * NH * QH * 2);
constexpr size_t WS_KFULL = WS_QS    + al256((size_t)MS * NH * 320 * 2);
constexpr size_t WS_VT    = WS_KFULL + al256((size_t)16 * SEQ * QH * 2);
constexpr size_t WS_OBUF  = WS_VT    + al256((size_t)16 * VD * SEQ * 2);
constexpr size_t WS_PART  = WS_OBUF  + al256((size_t)M * D * 2);
constexpr size_t WS_ML    = WS_PART  + al256((size_t)DB * 8 * 64 * 256 * 4);
constexpr size_t WS_END   = WS_ML    + al256((size_t)DB * 8 * 64 * 2 * 4);

constexpr int CW_BAR = 4096;
constexpr int CW_SCNT = 16384;

constexpr int RING_BYTES = 131072;
constexpr int LDS_BYTES = 147456;
constexpr int MISC_OFF = LDS_BYTES - 256;

typedef float f32x2 __attribute__((ext_vector_type(2)));
typedef __bf16 nbf16x2 __attribute__((ext_vector_type(2)));
__device__ __forceinline__ unsigned pk2(float lo, float hi) { const f32x2 v = {lo, hi}; return __builtin_bit_cast(unsigned, __builtin_convertvector(v, nbf16x2)); }
__device__ __forceinline__ unsigned f2bf(float f) { return pk2(f, 0.f) & 0xffffu; }
__device__ __forceinline__ float bf2f(unsigned short b) { return __builtin_bit_cast(float, ((unsigned)b) << 16); }
__device__ __forceinline__ f32x4 unpk4(u32x2 w) { f32x4 r; r.x = __builtin_bit_cast(float, w.x << 16); r.y = __builtin_bit_cast(float, w.x & 0xffff0000u); r.z = __builtin_bit_cast(float, w.y << 16); r.w = __builtin_bit_cast(float, w.y & 0xffff0000u); return r; }
__device__ __forceinline__ bf16x8 pack8(const float* v) { u32x4 w; w.x = pk2(v[0], v[1]); w.y = pk2(v[2], v[3]); w.z = pk2(v[4], v[5]); w.w = pk2(v[6], v[7]); return __builtin_bit_cast(bf16x8, w); }
__device__ __forceinline__ bf16x8 pack8v(f32x4 a, f32x4 b) { u32x4 w; w.x = pk2(a.x, a.y); w.y = pk2(a.z, a.w); w.z = pk2(b.x, b.y); w.w = pk2(b.z, b.w); return __builtin_bit_cast(bf16x8, w); }
__device__ __forceinline__ float wave_sum(float v) {
#pragma unroll
    for (int o = 1; o < 64; o <<= 1) v += __shfl_xor(v, o);
    return v;
}
__device__ __forceinline__ int crow(int r, int hi) { return (r & 3) + 8 * (r >> 2) + 4 * hi; }
#define LDS_WAIT() asm volatile("s_waitcnt lgkmcnt(0)" ::: "memory")
#define VM_WAIT() asm volatile("s_waitcnt vmcnt(0)" ::: "memory")

#define XB_TMO      128
#define XB_XCNT(j)  (256  + 64 * (j))
#define XB_XSUB(j)  (1280 + 64 * (j))
#define XB_XGEN(j)  (2304 + 64 * (j))
#define XB_TOP      3328
#define XB_TOPGEN   3392
#define XCD_BAR_WORDS 3456
#define XB_SPIN_CAP (1u << 18)
__device__ __forceinline__ unsigned xb_ld(unsigned* p)              { return __hip_atomic_load(p, __ATOMIC_RELAXED, __HIP_MEMORY_SCOPE_AGENT); }
__device__ __forceinline__ unsigned xb_add(unsigned* p, unsigned v) { return __hip_atomic_fetch_add(p, v, __ATOMIC_RELAXED, __HIP_MEMORY_SCOPE_AGENT); }
__device__ __forceinline__ unsigned xb_xcc_id() { return (unsigned)__builtin_amdgcn_s_getreg((3 << 11) | 20) & 0xFu; }
#define XB_SPIN(cond, bar) do { unsigned _sp = 0; while (cond) { __builtin_amdgcn_s_sleep(1); \
    if ((++_sp & 255u) == 0u) { if (xb_ld(&(bar)[XB_TMO])) break; if (_sp > XB_SPIN_CAP) { atomicAdd(&(bar)[XB_TMO], 1u); break; } } } } while (0)
struct XcdBarrier { unsigned* bar; unsigned x; volatile LAS unsigned* st; };
__device__ __forceinline__ XcdBarrier xcd_barrier_post(unsigned* bar, volatile LAS unsigned* st) {
    XcdBarrier b; b.bar = bar; b.x = xb_xcc_id(); b.st = st;
    if (threadIdx.x == 0) (void)xb_add(&bar[XB_XCNT(b.x)], 1u);
    return b;
}
__device__ __forceinline__ void xcd_barrier_complete(unsigned* bar, unsigned x, unsigned& nloc, unsigned& nx) {
    const unsigned G = gridDim.x * gridDim.y * gridDim.z;
    unsigned sum, cnt, mine, sp = 0u;
    for (;;) {
        sum = 0u; cnt = 0u; mine = 0u;
#pragma unroll
        for (unsigned j = 0; j < 16; ++j) { const unsigned c = xb_ld(&bar[XB_XCNT(j)]); sum += c; cnt += (c > 0u) ? 1u : 0u; mine = (j == x) ? c : mine; }
        if (sum == G) break;
        __builtin_amdgcn_s_sleep(1);
        if ((++sp & 255u) == 0u) { if (xb_ld(&bar[XB_TMO])) break; if (sp > XB_SPIN_CAP) { atomicAdd(&bar[XB_TMO], 1u); break; } }
    }
    nloc = mine > 0u ? mine : 1u; nx = cnt > 0u ? cnt : 1u;
}
__device__ __forceinline__ void xcd_barrier(const XcdBarrier& b) {
    asm volatile("s_waitcnt vmcnt(0)" ::: "memory");
    __syncthreads();
    if (threadIdx.x == 0) {
        unsigned* bar = b.bar;
        __builtin_amdgcn_s_waitcnt(0);
        unsigned nloc = b.st[0], nx = b.st[1];
        if (nloc == 0u) { xcd_barrier_complete(bar, b.x, nloc, nx); b.st[0] = nloc; b.st[1] = nx; }
        const unsigned old = xb_add(&bar[XB_XSUB(b.x)], 1u);
        const unsigned gen = old / nloc;
        if (old + 1u == (gen + 1u) * nloc) {
            __builtin_amdgcn_fence(__ATOMIC_RELEASE, "agent");
            asm volatile("s_waitcnt vmcnt(0)" ::: "memory");
            const unsigned og = xb_add(&bar[XB_TOP], 1u);
            const unsigned tg = og / nx;
            if (og + 1u == (tg + 1u) * nx) xb_add(&bar[XB_TOPGEN], 1u);
            else XB_SPIN(xb_ld(&bar[XB_TOPGEN]) == tg, bar);
            __builtin_amdgcn_fence(__ATOMIC_ACQUIRE, "agent");
            xb_add(&bar[XB_XGEN(b.x)], 1u);
            asm volatile("s_waitcnt vmcnt(0)" ::: "memory");
        } else {
            XB_SPIN(xb_ld(&bar[XB_XGEN(b.x)]) == gen, bar);
            __builtin_amdgcn_fence(__ATOMIC_ACQUIRE, "agent");
            asm volatile("s_waitcnt vmcnt(0)" ::: "memory");
        }
    }
    __syncthreads();
}

namespace pg8 {
constexpr int BM = 256, BK = 64, HALF = 128, HTB = HALF * BK * 2, STAGE_BYTES = 8 * HTB, NXCD = 8, WGM = 8;
__host__ __device__ __forceinline__ int lds_byte(int r, int c) { const int st = (r >> 4) * 2 + (c >> 5), rr = r & 15, cc = c & 31, ob = rr * 64 + cc * 2; return st * 1024 + (ob ^ (((ob >> 9) & 1) << 5)); }
__host__ __device__ __forceinline__ int perm32(int rho) { const int n = rho >> 4, i = rho & 15; return 8 * (i >> 2) + 4 * n + (i & 3); }
__host__ __device__ __forceinline__ void stage_rc(int b, int& R, int& C) { const int st = b / 1024, sb = b % 1024, swz = sb ^ (((sb >> 9) & 1) << 5); R = (st >> 1) * 16 + swz / 64; C = (st & 1) * 32 + (swz % 64) / 2; }
struct Unit { int pm, pn; };
struct Gemm { const bf16_t* A; const bf16_t* Bt; int M, N, K, lda, apn; };
struct StaticOrder {
    int nM, nN, nwg, G, c;
    __device__ __forceinline__ void init(int M, int N, int G_, int c_) { nM = M / BM; nN = N / BM; nwg = nM * nN; G = G_; c = c_; }
    __device__ __forceinline__ bool next(int i, Unit& u) const {
        const long L = (long)i * G + c; if (L >= nwg) return false;
        int wgid = (int)L; { const int q = nwg / NXCD, r = nwg % NXCD, xcd = wgid % NXCD, off = wgid / NXCD; wgid = (xcd < r ? xcd * (q + 1) : r * (q + 1) + (xcd - r) * q) + off; }
        const int nig = WGM * nN, gid = wgid / nig, fm = gid * WGM, gsz = (nM - fm) < WGM ? (nM - fm) : WGM;
        u.pm = fm + ((wgid % nig) % gsz); u.pn = (wgid % nig) / gsz; return true;
    }
};
template <class Epi>
__device__ __forceinline__ void gemm_phase(LAS unsigned char* lds, const Gemm g, const StaticOrder& S, const Epi& E) {
    const int tid = threadIdx.x, wid = __builtin_amdgcn_readfirstlane(tid >> 6), lane = tid & 63, wr = wid >> 2, wc = wid & 3, fr = lane & 15, fq = lane >> 4;
    const int K = g.K, nt = K / BK, lda = g.lda;
    unsigned voffA[2], voffB[2];
#pragma unroll
    for (int i = 0; i < 2; ++i) { int R, C; stage_rc(tid * 16 + i * 8192, R, C);
        const int Rb = Epi::PERM ? ((R & ~31) + perm32(R & 31)) : R;
        voffA[i] = (unsigned)(R * lda + C) * 2u; voffB[i] = (unsigned)(Rb * K + C) * 2u; }
    const size_t kstep = (size_t)(BK * 2);
    const size_t hstepA = (size_t)HALF * lda * 2, hstepB = (size_t)HALF * K * 2;
    const size_t tstepA = 2 * hstepA, tstepB = 2 * hstepB, pnA = (size_t)g.apn * 2;
    const unsigned ldsw = (unsigned)wid * 1024u;
    const int aoff = lds_byte(wr * 64 + fr, fq * 8), boff = lds_byte(wc * 32 + fr, fq * 8);
#define PG8_SA(b, h) (((b) * 2 + (h)) * HTB)
#define PG8_SB(b, h) ((4 + (b) * 2 + (h)) * HTB)
#define PG8_STAGE(bufoff, gbase, voff) do { _Pragma("unroll") for (int _i = 0; _i < 2; ++_i) \
        __builtin_amdgcn_global_load_lds((const unsigned*)((const char*)(gbase) + (voff)[_i]), (LAS unsigned*)(lds + (bufoff) + ldsw + _i * 8192), 16, 0, 0); } while (0)
#define PG8_LDA(dst, b, h) do { _Pragma("unroll") for (int m = 0; m < 4; ++m) _Pragma("unroll") for (int k = 0; k < 2; ++k) dst[m][k] = *(const LAS bf16x8*)(lds + PG8_SA(b, h) + aoff + m * 2048 + k * 1024); } while (0)
#define PG8_LDB(dst, b, h) do { _Pragma("unroll") for (int n = 0; n < 2; ++n) _Pragma("unroll") for (int k = 0; k < 2; ++k) dst[n][k] = *(const LAS bf16x8*)(lds + PG8_SB(b, h) + boff + n * 2048 + k * 1024); } while (0)
#define PG8_MMA(ai, bj, At, Bt) do { __builtin_amdgcn_s_setprio(1); _Pragma("unroll") for (int m = 0; m < 4; ++m) _Pragma("unroll") for (int n = 0; n < 2; ++n) _Pragma("unroll") for (int k = 0; k < 2; ++k) \
        acc[ai][bj][m][n] = __builtin_amdgcn_mfma_f32_16x16x32_bf16(Bt[n][k], At[m][k], acc[ai][bj][m][n], 0, 0, 0); __builtin_amdgcn_s_setprio(0); } while (0)
#define PG8_WAIT_V(n) asm volatile("s_waitcnt vmcnt(" #n ")" ::: "memory")
#define PG8_WAIT_L(n) asm volatile("s_waitcnt lgkmcnt(" #n ")" ::: "memory")
#define PG8_BAR __builtin_amdgcn_s_barrier()
#define PG8_SCHED __builtin_amdgcn_sched_barrier(0)
    Unit cur, nxt; int ui = 0;
    if (!S.next(0, cur)) return;
    f32x4 acc[2][2][4][2];
#pragma unroll
    for (int a = 0; a < 2; ++a)
#pragma unroll
        for (int b = 0; b < 2; ++b)
#pragma unroll
            for (int m = 0; m < 4; ++m)
#pragma unroll
                for (int n = 0; n < 2; ++n) acc[a][b][m][n] = (f32x4){0.f, 0.f, 0.f, 0.f};
    bf16x8 At[4][2], B0[2][2], B1[2][2];
    const char* cA = (const char*)g.A + (size_t)cur.pm * tstepA + (size_t)cur.pn * pnA; const char* cB = (const char*)g.Bt + (size_t)cur.pn * tstepB;
    PG8_STAGE(PG8_SB(0, 0), cB, voffB); PG8_STAGE(PG8_SB(0, 1), cB + hstepB, voffB); PG8_STAGE(PG8_SA(0, 0), cA, voffA); PG8_STAGE(PG8_SA(0, 1), cA + hstepA, voffA);
    if (wr == 1) PG8_BAR;
    PG8_WAIT_V(2); PG8_BAR;
    PG8_STAGE(PG8_SB(1, 0), cB + kstep, voffB); PG8_STAGE(PG8_SA(1, 0), cA + kstep, voffA); PG8_STAGE(PG8_SB(1, 1), cB + hstepB + kstep, voffB);
    PG8_WAIT_V(6); PG8_BAR;
    for (;;) {
        const bool has_next = S.next(ui + 1, nxt);
        const char* nA = has_next ? (const char*)g.A + (size_t)nxt.pm * tstepA + (size_t)nxt.pn * pnA : cA; const char* nB = has_next ? (const char*)g.Bt + (size_t)nxt.pn * tstepB : cB;
#pragma unroll 1
        for (int t = 0; t < nt; t += 2) {
            const bool last = (t == nt - 2);
            const char* a1 = cA + (size_t)(t + 1) * kstep;
            const char* a2 = last ? nA : cA + (size_t)(t + 2) * kstep; const char* b2 = last ? nB : cB + (size_t)(t + 2) * kstep;
            const char* a3 = a2 + kstep; const char* b3 = b2 + kstep;
            PG8_LDB(B0, 0, 0); PG8_LDB(B1, 0, 1); PG8_SCHED; PG8_LDA(At, 0, 0); PG8_STAGE(PG8_SA(1, 1), a1 + hstepA, voffA);
            PG8_WAIT_V(8); PG8_WAIT_L(0); PG8_BAR; PG8_MMA(0, 0, At, B0); PG8_MMA(0, 1, At, B1); PG8_BAR; PG8_SCHED;
            PG8_LDA(At, 0, 1); PG8_STAGE(PG8_SB(0, 0), b2, voffB); PG8_STAGE(PG8_SB(0, 1), b2 + hstepB, voffB); PG8_STAGE(PG8_SA(0, 0), a2, voffA);
            PG8_WAIT_V(8); PG8_WAIT_L(0); PG8_BAR; PG8_MMA(1, 0, At, B0); PG8_MMA(1, 1, At, B1); PG8_BAR; PG8_SCHED;
            PG8_LDB(B0, 1, 0); PG8_LDB(B1, 1, 1); PG8_SCHED; PG8_LDA(At, 1, 0); PG8_STAGE(PG8_SA(0, 1), a2 + hstepA, voffA);
            PG8_WAIT_V(8); PG8_WAIT_L(0); PG8_BAR; PG8_MMA(0, 0, At, B0); PG8_MMA(0, 1, At, B1); PG8_BAR; PG8_SCHED;
            PG8_LDA(At, 1, 1); PG8_STAGE(PG8_SB(1, 0), b3, voffB); PG8_STAGE(PG8_SB(1, 1), b3 + hstepB, voffB); PG8_STAGE(PG8_SA(1, 0), a3, voffA);
            PG8_WAIT_V(8); PG8_WAIT_L(0); PG8_BAR; PG8_MMA(1, 0, At, B0); PG8_MMA(1, 1, At, B1); PG8_BAR; PG8_SCHED;
        }
        if (wr == 0) PG8_BAR;
        E(acc, cur, wr, wc, fr, fq);
        if (!has_next) break;
#pragma unroll
        for (int a = 0; a < 2; ++a)
#pragma unroll
            for (int b = 0; b < 2; ++b)
#pragma unroll
                for (int m = 0; m < 4; ++m)
#pragma unroll
                    for (int n = 0; n < 2; ++n) acc[a][b][m][n] = (f32x4){0.f, 0.f, 0.f, 0.f};
        cur = nxt; cA = nA; cB = nB; ++ui;
        if (wr == 1) PG8_BAR;
    }
    PG8_WAIT_V(0);
    PG8_BAR;
#undef PG8_SA
#undef PG8_SB
#undef PG8_STAGE
#undef PG8_LDA
#undef PG8_LDB
#undef PG8_MMA
#undef PG8_WAIT_V
#undef PG8_WAIT_L
#undef PG8_BAR
#undef PG8_SCHED
}
}

struct Params { const float* in[27]; float* out; unsigned char* ws; int ph_lo, ph_hi; };
enum { I_XP = 0, I_XS, I_PP, I_PS, I_SPOOL, I_CLAT, I_CKR, I_PT, I_NMIX, I_NMLP, I_NPLE, I_POOLW, I_POOLSC, I_NKV, I_WDKV, I_KVN, I_WUK, I_WUV, I_WDQ, I_QN, I_WUQ, I_WO, I_WUP, I_WDOWN, I_WGATE, I_WPROJ, I_NFIN };

__device__ __forceinline__ void load_rstd(const float* ssq, const pg8::Unit& u, int wr, int fr, int fq, float (&rs)[2][4]) {
#pragma unroll
    for (int ai = 0; ai < 2; ++ai)
#pragma unroll
        for (int m = 0; m < 4; ++m) {
            const int row = u.pm * 256 + ai * 128 + wr * 64 + m * 16 + fr;
            const f32x4 a = ((const f32x4*)(ssq + (size_t)row * 16))[fq];
            float t = (a.x + a.y) + (a.z + a.w);
            t += __shfl_xor(t, 16); t += __shfl_xor(t, 32);
            rs[ai][m] = 1.0f / sqrtf(t * (1.0f / 1024.0f) + EPS);
        }
}
template <int NS> __device__ __forceinline__ void load_rstd_p(const float* ssqp, float inv_n, const pg8::Unit& u, int wr, int fr, int fq, float (&rs)[2][4]) {
#pragma unroll
    for (int ai = 0; ai < 2; ++ai)
#pragma unroll
        for (int m = 0; m < 4; ++m) {
            const int row = u.pm * 256 + ai * 128 + wr * 64 + m * 16 + fr;
            float t;
            if (NS == 4) t = ssqp[(size_t)row * 4 + fq]; else { const f32x2 a = ((const f32x2*)(ssqp + (size_t)row * 8))[fq]; t = a.x + a.y; }
            t += __shfl_xor(t, 16); t += __shfl_xor(t, 32);
            rs[ai][m] = 1.0f / sqrtf(t * inv_n + EPS);
        }
}
template <int MODE> struct EpiH {
    static constexpr bool PERM = true;
    const float* xp; const float* xs; const float* scale; const float* ssq_in; const bf16_t* proj;
    const bf16_t* hb_in; bf16_t* hb; float* ssq_out;
    __device__ __forceinline__ void operator()(const f32x4 (&acc)[2][2][4][2], const pg8::Unit& u, int wr, int wc, int fr_in, int fq_in) const {
        int fr = fr_in, fq = fq_in; asm volatile("" : "+v"(fr), "+v"(fq));
        float rs[2][4];
        if (MODE == 2) load_rstd(ssq_in, u, wr, fr, fq, rs);
        const int col0 = u.pn * 256 + wc * 32 + 8 * fq;
#pragma unroll
        for (int ai = 0; ai < 2; ++ai)
#pragma unroll
            for (int m = 0; m < 4; ++m) {
                const int row = u.pm * 256 + ai * 128 + wr * 64 + m * 16 + fr;
                float sq = 0.f;
#pragma unroll
                for (int bj = 0; bj < 2; ++bj) {
                    const int col = col0 + bj * 128;
                    f32x4 b0, b1;
                    if (MODE == 0) { const float* xr = (row < MP ? xp + (size_t)row * D : xs + (size_t)(row - MP) * D) + col; b0 = *(const f32x4*)xr; b1 = *(const f32x4*)(xr + 4); }
                    else { const u32x4 hv = *(const u32x4*)(hb_in + (size_t)row * D + col); b0 = unpk4((u32x2){hv.x, hv.y}); b1 = unpk4((u32x2){hv.z, hv.w}); }
                    const f32x4 a0 = acc[ai][bj][m][0], a1 = acc[ai][bj][m][1]; f32x4 o0, o1;
                    if (MODE == 0) { o0 = b0 + *(const f32x4*)(scale + col) * a0; o1 = b1 + *(const f32x4*)(scale + col + 4) * a1; }
                    else if (MODE == 1) { o0 = b0 + a0; o1 = b1 + a1; }
                    else { const u32x4 pv = *(const u32x4*)(proj + (size_t)row * D + col); const f32x4 p0 = unpk4((u32x2){pv.x, pv.y}), p1 = unpk4((u32x2){pv.z, pv.w}); const float r = rs[ai][m];
                        f32x4 g0, g1;
                        g0.x = 1.0f / (1.0f + __expf(-r * a0.x)); g0.y = 1.0f / (1.0f + __expf(-r * a0.y)); g0.z = 1.0f / (1.0f + __expf(-r * a0.z)); g0.w = 1.0f / (1.0f + __expf(-r * a0.w));
                        g1.x = 1.0f / (1.0f + __expf(-r * a1.x)); g1.y = 1.0f / (1.0f + __expf(-r * a1.y)); g1.z = 1.0f / (1.0f + __expf(-r * a1.z)); g1.w = 1.0f / (1.0f + __expf(-r * a1.w));
                        o0 = b0 + g0 * p0; o1 = b1 + g1 * p1; }
                    u32x4 w; w.x = pk2(o0.x, o0.y); w.y = pk2(o0.z, o0.w); w.z = pk2(o1.x, o1.y); w.w = pk2(o1.z, o1.w);
                    *(u32x4*)(hb + (size_t)row * D + col) = w;
                    sq += ((o0.x * o0.x + o0.y * o0.y) + (o0.z * o0.z + o0.w * o0.w)) + ((o1.x * o1.x + o1.y * o1.y) + (o1.z * o1.z + o1.w * o1.w));
                }
                sq += __shfl_xor(sq, 16); sq += __shfl_xor(sq, 32);
                if (fq == 0) ssq_out[(size_t)row * 16 + u.pn * 4 + wc] = sq;
                asm volatile("" ::: "memory");
            }
    }
};
struct EpiUp {
    static constexpr bool PERM = true;
    const float* ssq_in; bf16_t* abuf;
    __device__ __forceinline__ void operator()(const f32x4 (&acc)[2][2][4][2], const pg8::Unit& u, int wr, int wc, int fr_in, int fq_in) const {
        int fr = fr_in, fq = fq_in; asm volatile("" : "+v"(fr), "+v"(fq));
        float rs[2][4]; load_rstd(ssq_in, u, wr, fr, fq, rs);
        const int col0 = u.pn * 256 + wc * 32 + 8 * fq;
#pragma unroll
        for (int ai = 0; ai < 2; ++ai)
#pragma unroll
            for (int m = 0; m < 4; ++m) {
                const int row = u.pm * 256 + ai * 128 + wr * 64 + m * 16 + fr; const float r = rs[ai][m];
#pragma unroll
                for (int bj = 0; bj < 2; ++bj) {
                    f32x4 a = acc[ai][bj][m][0] * r, c = acc[ai][bj][m][1] * r;
                    a.x = fmaxf(a.x, 0.f); a.y = fmaxf(a.y, 0.f); a.z = fmaxf(a.z, 0.f); a.w = fmaxf(a.w, 0.f);
                    c.x = fmaxf(c.x, 0.f); c.y = fmaxf(c.y, 0.f); c.z = fmaxf(c.z, 0.f); c.w = fmaxf(c.w, 0.f);
                    u32x4 w; w.x = pk2(a.x * a.x, a.y * a.y); w.y = pk2(a.z * a.z, a.w * a.w); w.z = pk2(c.x * c.x, c.y * c.y); w.w = pk2(c.z * c.z, c.w * c.w);
                    *(u32x4*)(abuf + (size_t)row * FF + col0 + bj * 128) = w;
                }
            }
    }
};
template <int MODE> struct EpiF32 {
    static constexpr bool PERM = false;
    float* C; int ldc; const float* aux;
    __device__ __forceinline__ void operator()(const f32x4 (&acc)[2][2][4][2], const pg8::Unit& u, int wr, int wc, int fr_in, int fq_in) const {
        int fr = fr_in, fq = fq_in; asm volatile("" : "+v"(fr), "+v"(fq));
        float rs[2][4];
        if (MODE == 1) load_rstd(aux, u, wr, fr, fq, rs);
        const int col0 = u.pn * 256 + wc * 32 + 4 * fq;
#pragma unroll
        for (int ai = 0; ai < 2; ++ai)
#pragma unroll
            for (int m = 0; m < 4; ++m) {
                const int row = u.pm * 256 + ai * 128 + wr * 64 + m * 16 + fr;
                const float r = (MODE == 1) ? rs[ai][m] : (MODE == 2 ? aux[row] : 1.0f);
#pragma unroll
                for (int bj = 0; bj < 2; ++bj)
#pragma unroll
                    for (int n = 0; n < 2; ++n) *(f32x4*)(C + (size_t)row * ldc + col0 + bj * 128 + n * 16) = acc[ai][bj][m][n] * r;
            }
    }
};
struct EpiBf {
    static constexpr bool PERM = true;
    bf16_t* C; int ldc;
    __device__ __forceinline__ void operator()(const f32x4 (&acc)[2][2][4][2], const pg8::Unit& u, int wr, int wc, int fr_in, int fq_in) const {
        int fr = fr_in, fq = fq_in; asm volatile("" : "+v"(fr), "+v"(fq));
        const int col0 = u.pn * 256 + wc * 32 + 8 * fq;
#pragma unroll
        for (int ai = 0; ai < 2; ++ai)
#pragma unroll
            for (int m = 0; m < 4; ++m) {
                const int row = u.pm * 256 + ai * 128 + wr * 64 + m * 16 + fr;
#pragma unroll
                for (int bj = 0; bj < 2; ++bj) { const f32x4 a = acc[ai][bj][m][0], c = acc[ai][bj][m][1]; u32x4 w; w.x = pk2(a.x, a.y); w.y = pk2(a.z, a.w); w.z = pk2(c.x, c.y); w.w = pk2(c.z, c.w);
                    *(u32x4*)(C + (size_t)row * ldc + col0 + bj * 128) = w; }
            }
    }
};
__host__ __device__ __forceinline__ int kperm(int c) { if (c < KVR) return c; const int r = c - KVR, i = r & 31, sec = r >> 5; return KVR + 32 * (i >> 4) + 16 * sec + (i & 15); }
__host__ __device__ __forceinline__ int qperm(int c) { const int e = c % QH; if (e < NOPE) return c; const int r = e - NOPE, i = r & 31, sec = r >> 5; return c - e + NOPE + 32 * (i >> 4) + 16 * sec + (i & 15); }
struct EpiQ {
    static constexpr bool PERM = false;
    const float* ssqq_; const float* cs; bf16_t* qbuf; bf16_t* qs;
    __device__ __forceinline__ void operator()(const f32x4 (&acc)[2][2][4][2], const pg8::Unit& u, int wr, int wc, int fr_in, int fq_in) const {
        int fr = fr_in, fq = fq_in; asm volatile("" : "+v"(fr), "+v"(fq));
        const bool smp = u.pm >= MP / 256;
        float rq[2][4]; load_rstd_p<8>(ssqq_, 1.0f / QR, u, wr, fr, fq, rq);
#pragma unroll
        for (int ai = 0; ai < 2; ++ai)
#pragma unroll
            for (int m = 0; m < 4; ++m) {
                const int row = u.pm * 256 + ai * 128 + wr * 64 + m * 16 + fr; const float r = rq[ai][m]; const int pos = smp ? PAST + ((row - MP) & 7) : (row & (SEQ - 1));
                bf16_t* qrow = qbuf + (size_t)row * (NH * QH);
#pragma unroll
                for (int bj = 0; bj < 2; ++bj) {
                    const int Gi = u.pn * 8 + bj * 4 + wc, hh = Gi / 6, gi = Gi - hh * 6;
                    if (gi < 4) {
#pragma unroll
                        for (int n = 0; n < 2; ++n) { const f32x4 a = acc[ai][bj][m][n] * r; u32x2 w; w.x = pk2(a.x, a.y); w.y = pk2(a.z, a.w);
                            *(u32x2*)(qrow + Gi * 32 + n * 16 + 4 * fq) = w; }
                    } else {
                        const int i0 = 16 * (gi - 4) + 4 * fq;
                        const f32x4 x1 = acc[ai][bj][m][0] * r, x2 = acc[ai][bj][m][1] * r;
                        const f32x4 cn = *(const f32x4*)(cs + (size_t)pos * 64 + i0), sn = *(const f32x4*)(cs + (size_t)pos * 64 + 32 + i0);
                        const f32x4 o1 = x1 * cn - x2 * sn, o2 = x2 * cn + x1 * sn;
                        u32x2 w1, w2; w1.x = pk2(o1.x, o1.y); w1.y = pk2(o1.z, o1.w); w2.x = pk2(o2.x, o2.y); w2.y = pk2(o2.z, o2.w);
                        bf16_t* qd = smp ? qs + ((size_t)(row - MP) * NH + hh) * 320 + KVR : qrow + hh * QH + NOPE;
                        *(u32x2*)(qd + i0) = w1; *(u32x2*)(qd + 32 + i0) = w2;
                    }
                }
                asm volatile("" ::: "memory");
            }
    }
};
struct EpiDkvq {
    static constexpr bool PERM = false;
    const float* ssq_in; const float* cs; float* craw_; bf16_t* cb_; bf16_t* cqb_; float* ssqc_; float* ssqq_; float* out; bf16_t* kfull_; bf16_t* krbs_;
    __device__ __forceinline__ void operator()(const f32x4 (&acc)[2][2][4][2], const pg8::Unit& u, int wr, int wc, int fr_in, int fq_in) const {
        int fr = fr_in, fq = fq_in; asm volatile("" : "+v"(fr), "+v"(fq));
        float rs[2][4]; load_rstd(ssq_in, u, wr, fr, fq, rs);
        const bool smp = u.pm >= MP / 256;
#pragma unroll
        for (int ai = 0; ai < 2; ++ai)
#pragma unroll
            for (int m = 0; m < 4; ++m) {
                const int row = u.pm * 256 + ai * 128 + wr * 64 + m * 16 + fr; const float r = rs[ai][m];
                float sq = 0.f;
                if (u.pn == 0) {
#pragma unroll
                    for (int bj = 0; bj < 2; ++bj)
#pragma unroll
                        for (int n = 0; n < 2; ++n) { const int col = bj * 128 + wc * 32 + n * 16 + 4 * fq; const f32x4 v = acc[ai][bj][m][n] * r;
                            u32x2 w; w.x = pk2(v.x, v.y); w.y = pk2(v.z, v.w); *(u32x2*)(cb_ + (size_t)row * KVR + col) = w;
                            sq += (v.x * v.x + v.y * v.y) + (v.z * v.z + v.w * v.w); }
                    sq += __shfl_xor(sq, 16); sq += __shfl_xor(sq, 32);
                    if (fq == 0) ssqc_[(size_t)row * 4 + wc] = sq;
                } else {
#pragma unroll
                    for (int bj = 0; bj < 2; ++bj) {
                        const int g0 = (u.pn - 1) * 256 + bj * 128 + wc * 32;
                        if (g0 < ROPE) {
                            const int i0 = 16 * (g0 >> 5) + 4 * fq, pos = smp ? PAST + ((row - MP) & 7) : (row & (SEQ - 1));
                            const f32x4 x1 = acc[ai][bj][m][0] * r, x2 = acc[ai][bj][m][1] * r;
                            const f32x4 cn = *(const f32x4*)(cs + (size_t)pos * 64 + i0), sn = *(const f32x4*)(cs + (size_t)pos * 64 + 32 + i0);
                            const f32x4 o1 = x1 * cn - x2 * sn, o2 = x2 * cn + x1 * sn;
                            float* ko = smp ? out + O_KS + (size_t)(row - MP) * ROPE : out + O_KP + (size_t)row * ROPE;
                            *(f32x4*)(ko + i0) = o1; *(f32x4*)(ko + 32 + i0) = o2;
                            u32x2 w1, w2; w1.x = pk2(o1.x, o1.y); w1.y = pk2(o1.z, o1.w); w2.x = pk2(o2.x, o2.y); w2.y = pk2(o2.z, o2.w);
                            { bf16_t* kd = krbs_ + (size_t)row * ROPE; *(u32x2*)(kd + i0) = w1; *(u32x2*)(kd + 32 + i0) = w2; }
                        } else if (g0 < ROPE + QR) {
#pragma unroll
                            for (int n = 0; n < 2; ++n) { const int qi = g0 - ROPE + n * 16 + 4 * fq; const f32x4 v = acc[ai][bj][m][n] * r;
                                u32x2 w; w.x = pk2(v.x, v.y); w.y = pk2(v.z, v.w); *(u32x2*)(cqb_ + (size_t)row * QR + qi) = w;
                                sq += (v.x * v.x + v.y * v.y) + (v.z * v.z + v.w * v.w); }
                        }
                    }
                    sq += __shfl_xor(sq, 16); sq += __shfl_xor(sq, 32);
                    if (fq == 0) ssqq_[(size_t)row * 8 + (u.pn - 1) * 4 + wc] = sq;
                }
                asm volatile("" ::: "memory");
            }
    }
};
struct EpiKup {
    static constexpr bool PERM = true;
    bf16_t* kfull; const float* ssqc_;
    __device__ __forceinline__ void operator()(const f32x4 (&acc)[2][2][4][2], const pg8::Unit& u, int wr, int wc, int fr_in, int fq_in) const {
        int fr = fr_in, fq = fq_in; asm volatile("" : "+v"(fr), "+v"(fq));
        const int col0 = u.pn * 256 + wc * 32 + 8 * fq;
        float rc[2][4]; load_rstd_p<4>(ssqc_, 1.0f / KVR, u, wr, fr, fq, rc);
#pragma unroll
        for (int ai = 0; ai < 2; ++ai)
#pragma unroll
            for (int m = 0; m < 4; ++m) {
                const int row = u.pm * 256 + ai * 128 + wr * 64 + m * 16 + fr; const int b = row >> 13, t = row & (SEQ - 1); const float r = rc[ai][m];
#pragma unroll
                for (int bj = 0; bj < 2; ++bj) { const int col = col0 + bj * 128; const int h = col >> 7, nn = col & 127; const f32x4 a = acc[ai][bj][m][0] * r, c = acc[ai][bj][m][1] * r;
                    u32x4 w; w.x = pk2(a.x, a.y); w.y = pk2(a.z, a.w); w.z = pk2(c.x, c.y); w.w = pk2(c.z, c.w);
                    *(u32x4*)(kfull + ((size_t)(b * NH + h) * SEQ + t) * QH + nn) = w; }
                asm volatile("" ::: "memory");
            }
    }
};
struct EpiVup {
    static constexpr bool PERM = true;
    bf16_t* vt; const float* ssqc_;
    __device__ __forceinline__ void operator()(const f32x4 (&acc)[2][2][4][2], const pg8::Unit& u, int wr, int wc, int fr_in, int fq_in) const {
        int fr = fr_in, fq = fq_in; asm volatile("" : "+v"(fr), "+v"(fq));
        const int col0 = u.pn * 256 + wc * 32 + 8 * fq;
        f32x4 rt[2][2];
#pragma unroll
        for (int bj = 0; bj < 2; ++bj)
#pragma unroll
            for (int k = 0; k < 8; ++k) { const f32x4 p4 = *(const f32x4*)(ssqc_ + (size_t)(col0 + bj * 128 + k) * 4); rt[bj][k >> 2][k & 3] = 1.0f / sqrtf(((p4.x + p4.y) + (p4.z + p4.w)) * (1.0f / KVR) + EPS); }
#pragma unroll
        for (int ai = 0; ai < 2; ++ai)
#pragma unroll
            for (int m = 0; m < 4; ++m) {
                const int row = u.pm * 256 + ai * 128 + wr * 64 + m * 16 + fr; const int h = row >> 7, v = row & 127;
#pragma unroll
                for (int bj = 0; bj < 2; ++bj) { const int col = col0 + bj * 128; const int b = col >> 13, t = col & (SEQ - 1); const f32x4 a = acc[ai][bj][m][0] * rt[bj][0], c = acc[ai][bj][m][1] * rt[bj][1];
                    u32x4 w; w.x = pk2(a.x, a.y); w.y = pk2(a.z, a.w); w.z = pk2(c.x, c.y); w.w = pk2(c.z, c.w);
                    *(u32x4*)(vt + ((size_t)(b * NH + h) * VD + v) * SEQ + t) = w; }
                asm volatile("" ::: "memory");
            }
    }
};

struct SgALoadBf { const bf16_t* A; int lda;
    __device__ __forceinline__ bf16x8 operator()(int row, int k) const { return *(const bf16x8*)(A + (size_t)row * lda + k); } };
struct SgALoadComb { const float* parto; const float* ml;
    __device__ __forceinline__ bf16x8 operator()(int row, int k) const {
        const int b = row >> 3, tok = row & 7, h = k >> 7, v = k & 127, q = tok * 8 + h;
        const float* m0p = ml + ((size_t)(b * 2 + 0) * 64 + q) * 2; const float* m1p = ml + ((size_t)(b * 2 + 1) * 64 + q) * 2;
        const float m0 = m0p[0], l0 = m0p[1], m1 = m1p[0], l1 = m1p[1], mx = fmaxf(m0, m1);
        float w0 = __builtin_amdgcn_exp2f(m0 - mx), w1 = __builtin_amdgcn_exp2f(m1 - mx); const float inv = 1.0f / (w0 * l0 + w1 * l1); w0 *= inv; w1 *= inv;
        const float* p0 = parto + ((size_t)(b * 2 + 0) * 64 + q) * 128 + v; const float* p1 = parto + ((size_t)(b * 2 + 1) * 64 + q) * 128 + v;
        return pack8v(*(const f32x4*)p0 * w0 + *(const f32x4*)p1 * w1, *(const f32x4*)(p0 + 4) * w0 + *(const f32x4*)(p1 + 4) * w1); } };
template <int NCT, int NCG, class Epi, class ALoad>
__device__ __forceinline__ void sg_gemm_l(LAS unsigned char* lds, const ALoad& AL, int apn256, const bf16_t* __restrict__ Bt, int K, int unit, const Epi& E, int tid, int wave, int lane) {
    constexpr int KS = 8 / NCG, W = NCG * NCT * 16, G4 = W / 4;
    static_assert(KS * 64 * W * 4 <= RING_BYTES, "sg_gemm reduction buffer");
    const int mt = unit >> 4, ntile = unit & 15, m0 = mt * 64, n0 = ntile * W;
    const int cg = wave % NCG, kp = wave / NCG, fr = lane & 15, fq = lane >> 4;
    const int Kw = K / KS;
    const int arow = m0 + fr, acol = (n0 >> 8) * apn256 + kp * Kw + 8 * fq;
    const bf16_t* bp = Bt + (size_t)(n0 + cg * NCT * 16 + fr) * K + kp * Kw + 8 * fq;
    f32x4 acc[4][NCT];
#pragma unroll
    for (int m = 0; m < 4; ++m)
#pragma unroll
        for (int n = 0; n < NCT; ++n) acc[m][n] = (f32x4){0.f, 0.f, 0.f, 0.f};
#pragma unroll 4
    for (int kk = 0; kk < Kw; kk += 32) {
        bf16x8 af[4], bfr[NCT];
#pragma unroll
        for (int m = 0; m < 4; ++m) af[m] = AL(arow + 16 * m, acol + kk);
#pragma unroll
        for (int n = 0; n < NCT; ++n) bfr[n] = *(const bf16x8*)(bp + (size_t)(16 * n) * K + kk);
#pragma unroll
        for (int m = 0; m < 4; ++m)
#pragma unroll
            for (int n = 0; n < NCT; ++n) acc[m][n] = __builtin_amdgcn_mfma_f32_16x16x32_bf16(bfr[n], af[m], acc[m][n], 0, 0, 0);
    }
    LAS float* red = (LAS float*)lds;
#pragma unroll
    for (int m = 0; m < 4; ++m)
#pragma unroll
        for (int n = 0; n < NCT; ++n) { const int row = 16 * m + fr, c4 = (cg * NCT * 16 + 16 * n) / 4 + fq;
            *(LAS f32x4*)(red + (size_t)(kp * 64 + row) * W + 4 * (c4 ^ (row & 3))) = acc[m][n]; }
    __syncthreads();
    for (int it = tid; it < 64 * G4; it += 512) {
        const int row = it / G4, c4 = it % G4;
        f32x4 v = *(const LAS f32x4*)(red + (size_t)row * W + 4 * (c4 ^ (row & 3)));
#pragma unroll
        for (int p = 1; p < KS; ++p) v += *(const LAS f32x4*)(red + (size_t)(p * 64 + row) * W + 4 * (c4 ^ (row & 3)));
        if constexpr (Epi::WHOLE_TILE) *(LAS f32x4*)(red + (size_t)row * W + 4 * (c4 ^ (row & 3))) = v;
        else E(MP + m0 + row, n0 + 4 * c4, v, ntile);
    }
    if constexpr (Epi::WHOLE_TILE) {
        __syncthreads();
        for (int it = tid; it < 64 * G4; it += 512) { const int row = it / G4, c4 = it % G4; E.tile(MP + m0 + row, n0, c4, red + (size_t)row * W, row & 3); }
    }
    __syncthreads();
}
template <int NCT, int NCG, class Epi>
__device__ __forceinline__ void sg_gemm(LAS unsigned char* lds, const bf16_t* __restrict__ A, int lda, int apn256, const bf16_t* __restrict__ Bt, int K, int unit, const Epi& E, int tid, int wave, int lane) {
    const SgALoadBf AL{A, lda}; sg_gemm_l<NCT, NCG>(lds, AL, apn256, Bt, K, unit, E, tid, wave, lane);
}
constexpr int SK_STG = 32768;
template <class Epi>
__device__ __forceinline__ void sk_gemm(LAS unsigned char* lds, const bf16_t* __restrict__ A, int lda, const bf16_t* __restrict__ Bt, int K, int m0, int n0, int ntile, const Epi& E, int tid, int wave, int lane) {
    const int nk = K >> 7, fr = lane & 15, fq = lane >> 4, mi = wave >> 1, nh = wave & 1;
    unsigned goA[2], goB[2];
#pragma unroll
    for (int e = 0; e < 2; ++e) { const int r = 4 * (wave + 8 * e) + (lane >> 4), c = (lane & 15) ^ (r & 15); goA[e] = (unsigned)(r * lda + c * 8) * 2u; goB[e] = (unsigned)(r * K + c * 8) * 2u; }
    const unsigned ldsw = (unsigned)wave * 1024u;
#define SK_STAGE(kc) do { const unsigned so_ = (unsigned)((kc) & 3) * SK_STG + ldsw; const size_t ko_ = (size_t)(kc) * 256; \
        _Pragma("unroll") for (int e = 0; e < 2; ++e) { \
            __builtin_amdgcn_global_load_lds((const unsigned*)((const char*)A + ko_ + goA[e]), (LAS unsigned*)(lds + so_ + e * 8192), 16, 0, 0); \
            __builtin_amdgcn_global_load_lds((const unsigned*)((const char*)Bt + ko_ + goB[e]), (LAS unsigned*)(lds + so_ + 16384 + e * 8192), 16, 0, 0); } } while (0)
    int co[4];
#pragma unroll
    for (int ks = 0; ks < 4; ++ks) co[ks] = ((4 * ks + fq) ^ fr) << 4;
    const int aro = (16 * mi + fr) * 256, bro = 16384 + (32 * nh + fr) * 256;
    f32x4 acc[2] = {(f32x4){0.f, 0.f, 0.f, 0.f}, (f32x4){0.f, 0.f, 0.f, 0.f}};
    asm volatile("s_waitcnt vmcnt(0)" ::: "memory");
    SK_STAGE(0); if (nk > 1) SK_STAGE(1); if (nk > 2) SK_STAGE(2);
#pragma unroll 1
    for (int kc = 0; kc < nk; ++kc) {
        if (kc + 2 < nk) asm volatile("s_waitcnt vmcnt(8)" ::: "memory"); else if (kc + 1 < nk) asm volatile("s_waitcnt vmcnt(4)" ::: "memory"); else asm volatile("s_waitcnt vmcnt(0)" ::: "memory");
        asm volatile("s_waitcnt lgkmcnt(0)" ::: "memory"); __builtin_amdgcn_s_barrier(); asm volatile("" ::: "memory");
        if (kc + 3 < nk) SK_STAGE(kc + 3);
        const LAS unsigned char* sp = lds + (kc & 3) * SK_STG;
        bf16x8 af[4], b0[4], b1[4];
#pragma unroll
        for (int ks = 0; ks < 4; ++ks) { af[ks] = *(const LAS bf16x8*)(sp + aro + co[ks]); b0[ks] = *(const LAS bf16x8*)(sp + bro + co[ks]); b1[ks] = *(const LAS bf16x8*)(sp + bro + 4096 + co[ks]); }
#pragma unroll
        for (int ks = 0; ks < 4; ++ks) { acc[0] = __builtin_amdgcn_mfma_f32_16x16x32_bf16(b0[ks], af[ks], acc[0], 0, 0, 0); acc[1] = __builtin_amdgcn_mfma_f32_16x16x32_bf16(b1[ks], af[ks], acc[1], 0, 0, 0); }
    }
#undef SK_STAGE
    asm volatile("s_waitcnt lgkmcnt(0)" ::: "memory"); __builtin_amdgcn_s_barrier(); asm volatile("" ::: "memory");
    LAS float* red = (LAS float*)lds;
    { const int row = 16 * mi + fr;
#pragma unroll
      for (int n = 0; n < 2; ++n) { const int c4 = 4 * (2 * nh + n) + fq; *(LAS f32x4*)(red + row * 64 + 4 * (c4 ^ (row & 3))) = acc[n]; } }
    __syncthreads();
#pragma unroll
    for (int it = tid; it < 1024; it += 512) { const int row = it >> 4, c4 = it & 15; const f32x4 v = *(const LAS f32x4*)(red + row * 64 + 4 * (c4 ^ (row & 3))); E(MP + m0 + row, n0 + 4 * c4, v, ntile); }
    __syncthreads();
}
constexpr int SKW_STG = 40960;
template <class Epi>
__device__ __forceinline__ void sk_gemm_w(LAS unsigned char* lds, const bf16_t* __restrict__ A, int lda, const bf16_t* __restrict__ Bt, int K, int m0, int n0, const Epi& E, int tid, int wave, int lane) {
    const int nk = K >> 6, fr = lane & 15, fq = lane >> 4;
    unsigned goA, goB[4];
    { const int r = 8 * wave + (lane >> 3), c = (lane & 7) ^ (r & 7); goA = (unsigned)(r * lda + c * 8) * 2u;
#pragma unroll
      for (int e = 0; e < 4; ++e) goB[e] = (unsigned)((r + 64 * e) * K + c * 8) * 2u; }
    const unsigned ldsw = (unsigned)wave * 1024u;
#define SKW_STAGE(kc) do { const unsigned so_ = (unsigned)((kc) % 3) * SKW_STG + ldsw; const size_t ko_ = (size_t)(kc) * 128; \
        __builtin_amdgcn_global_load_lds((const unsigned*)((const char*)A + ko_ + goA), (LAS unsigned*)(lds + so_), 16, 0, 0); \
        _Pragma("unroll") for (int e = 0; e < 4; ++e) __builtin_amdgcn_global_load_lds((const unsigned*)((const char*)Bt + ko_ + goB[e]), (LAS unsigned*)(lds + so_ + 8192 + e * 8192), 16, 0, 0); } while (0)
    const int co0 = (fq ^ (fr & 7)) << 4, co1 = ((4 + fq) ^ (fr & 7)) << 4;
    const int aro = fr * 128, bro = 8192 + (32 * wave + fr) * 128;
    f32x4 acc[4][2];
#pragma unroll
    for (int m = 0; m < 4; ++m)
#pragma unroll
        for (int n = 0; n < 2; ++n) acc[m][n] = (f32x4){0.f, 0.f, 0.f, 0.f};
    asm volatile("s_waitcnt vmcnt(0)" ::: "memory");
    SKW_STAGE(0); if (nk > 1) SKW_STAGE(1);
#pragma unroll 1
    for (int kc = 0; kc < nk; ++kc) {
        if (kc + 1 < nk) asm volatile("s_waitcnt vmcnt(5)" ::: "memory"); else asm volatile("s_waitcnt vmcnt(0)" ::: "memory");
        asm volatile("s_waitcnt lgkmcnt(0)" ::: "memory"); __builtin_amdgcn_s_barrier(); asm volatile("" ::: "memory");
        if (kc + 2 < nk) SKW_STAGE(kc + 2);
        const LAS unsigned char* sp = lds + (kc % 3) * SKW_STG;
        bf16x8 af[4][2], bf_[2][2];
#pragma unroll
        for (int m = 0; m < 4; ++m) { af[m][0] = *(const LAS bf16x8*)(sp + aro + m * 2048 + co0); af[m][1] = *(const LAS bf16x8*)(sp + aro + m * 2048 + co1); }
#pragma unroll
        for (int n = 0; n < 2; ++n) { bf_[n][0] = *(const LAS bf16x8*)(sp + bro + n * 2048 + co0); bf_[n][1] = *(const LAS bf16x8*)(sp + bro + n * 2048 + co1); }
#pragma unroll
        for (int m = 0; m < 4; ++m)
#pragma unroll
            for (int n = 0; n < 2; ++n) { acc[m][n] = __builtin_amdgcn_mfma_f32_16x16x32_bf16(bf_[n][0], af[m][0], acc[m][n], 0, 0, 0); acc[m][n] = __builtin_amdgcn_mfma_f32_16x16x32_bf16(bf_[n][1], af[m][1], acc[m][n], 0, 0, 0); }
    }
#undef SKW_STAGE
    asm volatile("s_waitcnt lgkmcnt(0)" ::: "memory"); __builtin_amdgcn_s_barrier(); asm volatile("" ::: "memory");
    LAS float* red = (LAS float*)lds;
#pragma unroll
    for (int m = 0; m < 4; ++m)
#pragma unroll
        for (int n = 0; n < 2; ++n) { const int row = 16 * m + fr, c4 = 8 * wave + 4 * n + fq; *(LAS f32x4*)(red + row * 256 + 4 * (c4 ^ (row & 15))) = acc[m][n]; }
    __syncthreads();
#pragma unroll
    for (int i = 0; i < 8; ++i) { const int it = tid + 512 * i, row = it >> 6, c4 = it & 63; const f32x4 v = *(const LAS f32x4*)(red + row * 256 + 4 * (c4 ^ (row & 15))); E(MP + m0 + row, n0 + 4 * c4, v, 0); }
    __syncthreads();
}
__device__ __forceinline__ float row_rstd16(const float* ssq, int row) {
    const f32x4* s = (const f32x4*)(ssq + (size_t)row * 16); const f32x4 a = s[0], b = s[1], c = s[2], d = s[3];
    const float t = ((a.x + a.y) + (a.z + a.w)) + ((b.x + b.y) + (b.z + b.w)) + ((c.x + c.y) + (c.z + c.w)) + ((d.x + d.y) + (d.z + d.w));
    return 1.0f / sqrtf(t * (1.0f / 1024.0f) + EPS);
}
template <int MODE> struct SgH {
    static constexpr bool WHOLE_TILE = false;
    const float* xs; const float* scale; const float* ssq_in; const bf16_t* proj; const bf16_t* hb_in; bf16_t* hb; float* ssq_out;
    __device__ __forceinline__ void operator()(int row, int col, f32x4 a, int ntile) const {
        const f32x4 bs = (MODE == 0) ? *(const f32x4*)(xs + (size_t)(row - MP) * D + col) : unpk4(*(const u32x2*)(hb_in + (size_t)row * D + col));
        f32x4 o;
        if (MODE == 0) o = bs + *(const f32x4*)(scale + col) * a;
        else if (MODE == 1) o = bs + a;
        else { const float r = row_rstd16(ssq_in, row); const f32x4 pj = unpk4(*(const u32x2*)(proj + (size_t)row * D + col));
            f32x4 gt; gt.x = 1.0f / (1.0f + __expf(-r * a.x)); gt.y = 1.0f / (1.0f + __expf(-r * a.y)); gt.z = 1.0f / (1.0f + __expf(-r * a.z)); gt.w = 1.0f / (1.0f + __expf(-r * a.w));
            o = bs + gt * pj; }
        u32x2 w; w.x = pk2(o.x, o.y); w.y = pk2(o.z, o.w);
        *(u32x2*)(hb + (size_t)row * D + col) = w;
        float sq = (o.x * o.x + o.y * o.y) + (o.z * o.z + o.w * o.w);
        sq += __shfl_xor(sq, 1); sq += __shfl_xor(sq, 2); sq += __shfl_xor(sq, 4); sq += __shfl_xor(sq, 8);
        if ((col & 63) == 0) ssq_out[(size_t)row * 16 + ntile] = sq;
    }
};
struct SgUp {
    static constexpr bool WHOLE_TILE = false;
    const float* ssq_in; bf16_t* abuf;
    __device__ __forceinline__ void operator()(int row, int col, f32x4 a, int) const {
        const float r = row_rstd16(ssq_in, row); a = a * r;
        a.x = fmaxf(a.x, 0.f); a.y = fmaxf(a.y, 0.f); a.z = fmaxf(a.z, 0.f); a.w = fmaxf(a.w, 0.f);
        u32x2 w; w.x = pk2(a.x * a.x, a.y * a.y); w.y = pk2(a.z * a.z, a.w * a.w);
        *(u32x2*)(abuf + (size_t)row * FF + col) = w;
    }
};
template <int MODE> struct SgF32 {
    static constexpr bool WHOLE_TILE = false;
    float* C; int ldc; const float* aux;
    __device__ __forceinline__ void operator()(int row, int col, f32x4 a, int) const {
        const float r = (MODE == 1) ? row_rstd16(aux, row) : (MODE == 2 ? aux[row] : 1.0f);
        *(f32x4*)(C + (size_t)row * ldc + col) = a * r;
    }
};
struct SgBf {
    static constexpr bool WHOLE_TILE = false;
    bf16_t* C; int ldc;
    __device__ __forceinline__ void operator()(int row, int col, f32x4 a, int) const { u32x2 w; w.x = pk2(a.x, a.y); w.y = pk2(a.z, a.w); *(u32x2*)(C + (size_t)row * ldc + col) = w; }
};
struct SgQ {
    static constexpr bool WHOLE_TILE = true;
    const float* rstdq; const float* cs; bf16_t* qbuf; bf16_t* qs;
    __device__ __forceinline__ void operator()(int, int, f32x4, int) const {}
    __device__ __forceinline__ void tile(int row, int n0, int c4, const LAS float* trow, int sw) const {
        const int c = n0 + 4 * c4, hh = c / QH, e = c - hh * QH; const float r = rstdq[row];
        const f32x4 v = *(const LAS f32x4*)(trow + 4 * (c4 ^ sw)) * r;
        if (e < NOPE) { u32x2 w; w.x = pk2(v.x, v.y); w.y = pk2(v.z, v.w); *(u32x2*)(qbuf + (size_t)row * (NH * QH) + c) = w; }
        else { const int rp = e - NOPE, wi = rp & 31;
            if (wi < 16) { const int i0 = 16 * (rp >> 5) + wi, pos = PAST + ((row - MP) & 7);
                const f32x4 x2 = *(const LAS f32x4*)(trow + 4 * ((c4 + 4) ^ sw)) * r;
                const f32x4 cn = *(const f32x4*)(cs + (size_t)pos * 64 + i0), sn = *(const f32x4*)(cs + (size_t)pos * 64 + 32 + i0);
                const f32x4 o1 = v * cn - x2 * sn, o2 = x2 * cn + v * sn;
                bf16_t* qd = qs + ((size_t)(row - MP) * NH + hh) * 320 + KVR;
                u32x2 w1, w2; w1.x = pk2(o1.x, o1.y); w1.y = pk2(o1.z, o1.w); w2.x = pk2(o2.x, o2.y); w2.y = pk2(o2.z, o2.w);
                *(u32x2*)(qd + i0) = w1; *(u32x2*)(qd + 32 + i0) = w2; } }
    }
};

template <int PMODE = 0>
__device__ __forceinline__ void transpose_item(const float* W, const float* kscale, int K, int N, bf16_t* WT, int row_off, LAS float* scr, int item, int lane) {
    const int nblk = N / 32, kb = item / nblk, nb = item % nblk, k0 = 64 * kb, n0 = 32 * nb;
    { f32x4 v[8];
#pragma unroll
      for (int i = 0; i < 8; ++i) v[i] = *(const f32x4*)(W + (size_t)(k0 + (lane >> 3) + 8 * i) * N + n0 + (lane & 7) * 4);
#pragma unroll
      for (int i = 0; i < 8; ++i) { const int kk = (lane >> 3) + 8 * i; f32x4 x = v[i]; if (kscale) x = x * kscale[k0 + kk];
          LAS float* d = scr + kk * 33 + (lane & 7) * 4; d[0] = x.x; d[1] = x.y; d[2] = x.z; d[3] = x.w; } }
    LDS_WAIT(); asm volatile("" ::: "memory");
    const int c = lane & 7;
#pragma unroll
    for (int j = 0; j < 4; ++j) { const int n = (lane >> 3) + 8 * j; const LAS float* s = scr + (8 * c) * 33 + n;
        u32x4 o; o.x = pk2(s[0 * 33], s[1 * 33]); o.y = pk2(s[2 * 33], s[3 * 33]); o.z = pk2(s[4 * 33], s[5 * 33]); o.w = pk2(s[6 * 33], s[7 * 33]);
        *(u32x4*)(WT + (size_t)(row_off + (PMODE == 1 ? qperm(n0 + n) : (PMODE == 2 ? kperm(n0 + n) : n0 + n))) * K + k0 + 8 * c) = o; }
    LDS_WAIT(); asm volatile("" ::: "memory");
}

constexpr int AK_PITCH = 400, AK_BUF = 64 * AK_PITCH;
constexpr int AV_PITCH = 136, AV_BUF = 128 * AV_PITCH;
constexpr int AV_OFF = 2 * AK_BUF, AQ_OFF = AV_OFF + 2 * AV_BUF;
static_assert(AQ_OFF + 256 * 144 <= RING_BYTES, "attention LDS");
__device__ __forceinline__ void attn_prompt_unit(const bf16_t* __restrict__ qbuf, const bf16_t* __restrict__ Kf, const bf16_t* __restrict__ Krb, const bf16_t* __restrict__ Vt, bf16_t* __restrict__ obuf,
                                                 int b, int h, int qb, LAS unsigned char* lds, int tid, int wave, int lane) {
    const int r32 = lane & 31, g = lane >> 5;
    const int t_lo = qb * 256 + wave * 32, trow = t_lo + r32;
    bf16x8 qf[8];
    { const bf16_t* qp = qbuf + (size_t)(b * SEQ + trow) * (NH * QH) + h * QH + 8 * g;
      __syncthreads();
#pragma unroll
      for (int ks = 8; ks < 12; ++ks) *(LAS bf16x8*)(lds + AQ_OFF + (wave * 32 + r32) * 144 + (2 * (ks - 8) + g) * 16) = *(const bf16x8*)(qp + 16 * ks);
#pragma unroll
      for (int ks = 0; ks < 8; ++ks) qf[ks] = *(const bf16x8*)(qp + 16 * ks);
#pragma unroll
      for (int ks = 0; ks < 8; ++ks) asm volatile("" : "+v"(qf[ks])); }
    f32x16 O[4];
#pragma unroll
    for (int i = 0; i < 4; ++i)
#pragma unroll
        for (int j = 0; j < 16; ++j) O[i][j] = 0.f;
    float mrun = -1e30f, lrun = 0.f;
    const bf16_t* Kb = Kf + (size_t)(b * NH + h) * SEQ * QH; const bf16_t* Kr = Krb + (size_t)b * SEQ * ROPE;
    const bf16_t* Vb = Vt + (size_t)(b * NH + h) * VD * SEQ;
    const int NT = (qb + 1) * 4;
    int kl_off[3], vl_off[2]; size_t vg_off[2];
#pragma unroll
    for (int e = 0; e < 3; ++e) kl_off[e] = (tid >> 3) * AK_PITCH + ((tid & 7) + 8 * e) * 16;
#pragma unroll
    for (int e = 0; e < 2; ++e) { const int c = tid + 512 * e; vl_off[e] = AV_OFF + (c >> 3) * AV_PITCH + (c & 7) * 16; vg_off[e] = (size_t)(c >> 3) * SEQ + (c & 7) * 8; }
    u32x4 kst[3], vst[2];
#define AT_LOAD(j) do { _Pragma("unroll") for (int e = 0; e < 2; ++e) kst[e] = *(const u32x4*)(Kb + (size_t)(64 * (j) + (tid >> 3)) * QH + ((tid & 7) + 8 * e) * 8); \
                        kst[2] = *(const u32x4*)(Kr + (size_t)(64 * (j) + (tid >> 3)) * ROPE + (tid & 7) * 8); \
                        _Pragma("unroll") for (int e = 0; e < 2; ++e) vst[e] = *(const u32x4*)(Vb + vg_off[e] + 64 * (j)); } while (0)
#define AT_WRITE(buf) do { _Pragma("unroll") for (int e = 0; e < 3; ++e) *(LAS u32x4*)(lds + (buf) * AK_BUF + kl_off[e]) = kst[e]; \
                           _Pragma("unroll") for (int e = 0; e < 2; ++e) { *(LAS u32x2*)(lds + (buf) * AV_BUF + vl_off[e]) = (u32x2){vst[e].x, vst[e].y}; *(LAS u32x2*)(lds + (buf) * AV_BUF + vl_off[e] + 8) = (u32x2){vst[e].z, vst[e].w}; } } while (0)
    AT_LOAD(0); AT_WRITE(0);
    __syncthreads();
    for (int j = 0; j < NT; ++j) {
        const int buf = j & 1;
        if (j + 1 < NT) AT_LOAD(j + 1);
        if (64 * j <= t_lo + 31) {
            f32x16 S0, S1;
#pragma unroll
            for (int i = 0; i < 16; ++i) { S0[i] = 0.f; S1[i] = 0.f; }
            const LAS unsigned char* kl = lds + buf * AK_BUF + r32 * AK_PITCH + g * 16;
            const LAS unsigned char* ql = lds + AQ_OFF + (wave * 32 + r32) * 144 + g * 16;
            bf16x8 ka[3][2], qr_[3];
#define AT_KLD(ks) do { ka[(ks) % 3][0] = *(const LAS bf16x8*)(kl + (ks) * 32); ka[(ks) % 3][1] = *(const LAS bf16x8*)(kl + 32 * AK_PITCH + (ks) * 32); \
                        if ((ks) >= 8) qr_[(ks) % 3] = *(const LAS bf16x8*)(ql + ((ks) - 8) * 32); } while (0)
            AT_KLD(0); AT_KLD(1);
#pragma unroll
            for (int ks = 0; ks < 12; ++ks) {
                if (ks + 2 < 12) AT_KLD(ks + 2);
                __builtin_amdgcn_sched_barrier(0);
                const bf16x8 qb_ = (ks < 8) ? qf[ks < 8 ? ks : 0] : qr_[ks % 3];
                S0 = __builtin_amdgcn_mfma_f32_32x32x16_bf16(ka[ks % 3][0], qb_, S0, 0, 0, 0);
                S1 = __builtin_amdgcn_mfma_f32_32x32x16_bf16(ka[ks % 3][1], qb_, S1, 0, 0, 0);
                __builtin_amdgcn_sched_barrier(0);
            }
#undef AT_KLD
            if (64 * j + 63 > t_lo) {
                asm volatile("" ::: "memory");
#pragma unroll
                for (int i = 0; i < 16; ++i) { const int key = 64 * j + crow(i, g); if (key > trow) S0[i] = -1e30f; if (key + 32 > trow) S1[i] = -1e30f; }
            }
            float mx = S0[0];
#pragma unroll
            for (int i = 1; i < 16; ++i) mx = fmaxf(mx, S0[i]);
#pragma unroll
            for (int i = 0; i < 16; ++i) mx = fmaxf(mx, S1[i]);
            mx = fmaxf(mx, __shfl_xor(mx, 32)) * CEXP;
            if (__any(mx > mrun + 11.5f)) {
                const float mnew = fmaxf(mrun, mx), alpha = __builtin_amdgcn_exp2f(mrun - mnew);
                mrun = mnew; lrun *= alpha;
#pragma unroll
                for (int vt = 0; vt < 4; ++vt)
#pragma unroll
                    for (int i = 0; i < 16; ++i) O[vt][i] *= alpha;
            }
            float ps = 0.f;
#pragma unroll
            for (int i = 0; i < 16; ++i) { S0[i] = __builtin_amdgcn_exp2f(S0[i] * CEXP - mrun); S1[i] = __builtin_amdgcn_exp2f(S1[i] * CEXP - mrun); ps += S0[i] + S1[i]; }
            lrun += ps;
            bf16x8 pf[4];
            { float tmp[8];
#pragma unroll
              for (int s2 = 0; s2 < 4; ++s2) {
#pragma unroll
                for (int i = 0; i < 8; ++i) tmp[i] = (s2 < 2) ? S0[8 * (s2 & 1) + i] : S1[8 * (s2 & 1) + i];
                pf[s2] = pack8(tmp); } }
            const LAS unsigned char* vl = lds + AV_OFF + buf * AV_BUF + r32 * AV_PITCH + g * 8;
            u32x4 fa[4], fb[4];
#define AT_VLD(dst, vt) do { _Pragma("unroll") for (int s2 = 0; s2 < 4; ++s2) { const u32x2 lo_ = *(const LAS u32x2*)(vl + (vt) * 32 * AV_PITCH + s2 * 32), hi_ = *(const LAS u32x2*)(vl + (vt) * 32 * AV_PITCH + s2 * 32 + 16); dst[s2] = (u32x4){lo_.x, lo_.y, hi_.x, hi_.y}; } } while (0)
#define AT_VMM(src, vt) do { _Pragma("unroll") for (int s2 = 0; s2 < 4; ++s2) O[vt] = __builtin_amdgcn_mfma_f32_32x32x16_bf16(__builtin_bit_cast(bf16x8, src[s2]), pf[s2], O[vt], 0, 0, 0); } while (0)
            AT_VLD(fa, 0); AT_VLD(fb, 1); __builtin_amdgcn_sched_barrier(0);
            AT_VMM(fa, 0); __builtin_amdgcn_sched_barrier(0);
            AT_VLD(fa, 2); __builtin_amdgcn_sched_barrier(0);
            AT_VMM(fb, 1); __builtin_amdgcn_sched_barrier(0);
            AT_VLD(fb, 3); __builtin_amdgcn_sched_barrier(0);
            AT_VMM(fa, 2); __builtin_amdgcn_sched_barrier(0);
            AT_VMM(fb, 3);
#undef AT_VLD
#undef AT_VMM
        }
        if (j + 1 < NT) AT_WRITE(buf ^ 1);
        __syncthreads();
    }
#undef AT_LOAD
#undef AT_WRITE
    const float ltot = lrun + __shfl_xor(lrun, 32), inv = 1.0f / ltot;
    bf16_t* op = obuf + (size_t)(b * SEQ + trow) * D + h * VD + 4 * g;
#pragma unroll
    for (int vt = 0; vt < 4; ++vt)
#pragma unroll
        for (int jq = 0; jq < 4; ++jq) {
            u32x2 w; w.x = pk2(O[vt][4 * jq] * inv, O[vt][4 * jq + 1] * inv); w.y = pk2(O[vt][4 * jq + 2] * inv, O[vt][4 * jq + 3] * inv);
            *(u32x2*)(op + 32 * vt + 8 * jq) = w;
        }
}

typedef short s16x4 __attribute__((ext_vector_type(4)));
constexpr int SA_KR = 32768, SA_BUF = 32768 + 64 * 144, SA_QR = 2 * SA_BUF, SA_QI = SA_QR + 64 * 144, SA_QI_PITCH = 528, SA_OI = 69632;
static_assert(SA_OI >= 65536 + 1024 && SA_OI + 64 * SA_QI_PITCH <= MISC_OFF, "O image");
static_assert(SA_QI + 64 * SA_QI_PITCH <= MISC_OFF, "sample attention LDS");
__device__ __forceinline__ int sa_off(int row, int ch) { return 256 * row + 16 * (ch ^ (((row & 3) << 2) | ((row >> 2) & 3))); }
__device__ __forceinline__ void sattn_item(const Params& P, int b, int half, LAS unsigned char* lds, int tid, int wave, int lane) {
    unsigned char* ws = P.ws;
    const int r32 = lane & 31, g = lane >> 5;
    const bool is_cmp = wave < 4;
    const int qt = wave & 1, kb = (wave >> 1) & 1;
    const int ptv = ((const int*)P.in[I_PT])[b * NPG + half * 32 + (lane & 31)];
    const float* clat = P.in[I_CLAT]; const float* ckr = P.in[I_CKR];
#define SA_LOAD(S, h) do { const int pg_ = __builtin_amdgcn_readlane(ptv, (h) >> 2); const size_t prow_ = (size_t)pg_ * PAGE + (((h) & 3) << 5); \
        const char* lat_ = (const char*)(clat + prow_ * KVR); const char* kro_ = (const char*)(ckr + prow_ * ROPE); \
        _Pragma("unroll") for (int e = 0; e < 8; ++e) S[e] = *(const f32x4*)(lat_ + glb + e * 1024); \
        S[8] = *(const f32x4*)(kro_ + grb); S[9] = *(const f32x4*)(kro_ + grb + 1024); } while (0)
#define SA_PK4(v) ((u32x2){pk2((v).x, (v).y), pk2((v).z, (v).w)})
#define SA_WRITE(S, bufo, hh) do { \
        _Pragma("unroll") for (int e = 0; e < 8; ++e) *(LAS u32x2*)(lds + (bufo) + llb[e] + (hh) * 8192) = SA_PK4(S[e]); \
        _Pragma("unroll") for (int e = 0; e < 2; ++e) *(LAS u32x2*)(lds + (bufo) + lrb[e] + (hh) * 4608) = SA_PK4(S[8 + e]); asm volatile("" ::: "memory"); } while (0)
    __syncthreads();
    *(LAS u32x4*)(lds + SA_QR + (tid >> 3) * 144 + (tid & 7) * 16) = *(const u32x4*)((const bf16_t*)(ws + WS_QS) + ((size_t)b * 64 + (tid >> 3)) * 320 + KVR + (tid & 7) * 8);
    {
      const bf16_t* qn = (const bf16_t*)(ws + WS_QBUF) + (size_t)(MP + b * DS + (r32 & 7)) * (NH * QH) + wave * QH + 8 * g;
      bf16x8 an[8];
#pragma unroll
      for (int ks = 0; ks < 8; ++ks) { u32x4 z = {0u, 0u, 0u, 0u}; if (r32 < DS) z = *(const u32x4*)(qn + 16 * ks); an[ks] = __builtin_bit_cast(bf16x8, z); }
      const bf16_t* wk = (const bf16_t*)(ws + WS_WUKB) + (size_t)wave * (64 * 512) + lane * 8;
#pragma unroll 2
      for (int nt = 0; nt < 8; ++nt) {
          f32x16 acc;
#pragma unroll
          for (int i = 0; i < 16; ++i) acc[i] = 0.f;
#pragma unroll
          for (int ks = 0; ks < 8; ++ks) acc = __builtin_amdgcn_mfma_f32_32x32x16_bf16(an[ks], *(const bf16x8*)(wk + (nt * 8 + ks) * 512), acc, 0, 0, 0);
#pragma unroll
          for (int i = 0; i < 4; ++i) *(LAS bf16_t*)(lds + SA_QI + ((i + 4 * g) * 8 + wave) * SA_QI_PITCH + (32 * nt + r32) * 2) = (bf16_t)f2bf(acc[i]);
      } }
    __syncthreads();
#define SA_KLD(ks) do { const int o0_ = ((ks) < 16) ? (((ks) >> 3) * 16384 + krow + 32 * (((ks) & 7) ^ (x_ >> 1))) : (krope + 32 * ((ks) - 16)); \
        ka_[(ks) & 3] = *(const LAS bf16x8*)(kb_ + o0_); \
        qa_[(ks) & 3] = ((ks) < 16) ? *(const LAS bf16x8*)(qil + 32 * (ks)) : *(const LAS bf16x8*)(qrl + 32 * ((ks) - 16)); } while (0)
#define SA_VLD(dst, vt) do { const LAS unsigned char* vb_ = kb_ + ((vt) >> 2) * 16384 + 8192 * kb; \
        const int c0_ = 4 * ((vt) & 3) + 2 * vsub + (p_ >> 1); \
        const int blo_ = 256 * (4 * gg + q_) + 16 * (c0_ ^ ((q_ << 2) | gg)) + 8 * (p_ & 1); \
        const int bhi_ = 256 * (4 * gg + q_ + 8) + 16 * (c0_ ^ ((q_ << 2) | (gg + 2))) + 8 * (p_ & 1); \
        _Pragma("unroll") for (int s2 = 0; s2 < 2; ++s2) { \
            const s16x4 lo_ = __builtin_amdgcn_ds_read_tr16_b64_v4i16((LAS s16x4*)(vb_ + blo_ + 4096 * s2)); \
            const s16x4 hi_ = __builtin_amdgcn_ds_read_tr16_b64_v4i16((LAS s16x4*)(vb_ + bhi_ + 4096 * s2)); \
            dst[s2] = (bf16x8){lo_[0], lo_[1], lo_[2], lo_[3], hi_[0], hi_[1], hi_[2], hi_[3]}; } } while (0)
#define SA_VMM(src, vt) do { _Pragma("unroll") for (int s2 = 0; s2 < 2; ++s2) O[vt] = __builtin_amdgcn_mfma_f32_32x32x16_bf16(src[s2], pf[s2], O[vt], 0, 0, 0); } while (0)
#define SA_COMPUTE(j, bufo) do { \
        const LAS unsigned char* kb_ = lds + (bufo); \
        f32x16 S0; \
        _Pragma("unroll") for (int i = 0; i < 16; ++i) S0[i] = 0.f; \
        int r32v = r32; asm volatile("" : "+v"(r32v)); \
        const int x_ = ((r32v & 3) << 2) | ((r32v >> 2) & 3); \
        const int krow = 256 * (r32v + 32 * kb) + 16 * ((g ^ x_) & 1), krope = SA_KR + (r32v + 32 * kb) * 144 + g * 16; \
        const LAS unsigned char* qrl = lds + SA_QR + (32 * qt + r32v) * 144 + g * 16; const LAS unsigned char* qil = lds + SA_QI + (32 * qt + r32v) * SA_QI_PITCH + g * 16; \
        bf16x8 ka_[4], qa_[4]; \
        SA_KLD(0); SA_KLD(1); SA_KLD(2); \
        _Pragma("unroll") for (int ks = 0; ks < 20; ++ks) { \
            if (ks + 3 < 20) SA_KLD(ks + 3); \
            __builtin_amdgcn_sched_barrier(0); \
            S0 = __builtin_amdgcn_mfma_f32_32x32x16_bf16(ka_[ks & 3], qa_[ks & 3], S0, 0, 0, 0); \
            __builtin_amdgcn_sched_barrier(0); } \
        if ((j) == 64) { const int tok = (32 * qt + r32) >> 3; asm volatile("" ::: "memory"); \
            _Pragma("unroll") for (int i = 0; i < 16; ++i) { const int key = 32 * kb + crow(i, g); if (key > tok || key >= DS) S0[i] = -1e30f; } } \
        float mx = S0[0]; \
        _Pragma("unroll") for (int i = 1; i < 16; ++i) mx = fmaxf(mx, S0[i]); \
        mx = fmaxf(mx, __shfl_xor(mx, 32)) * CEXP; \
        if (__any(mx > mrun + 11.5f)) { const float mnew = fmaxf(mrun, mx), alpha = __builtin_amdgcn_exp2f(mrun - mnew); mrun = mnew; lrun *= alpha; \
            _Pragma("unroll") for (int vt = 0; vt < 8; ++vt) _Pragma("unroll") for (int i = 0; i < 16; ++i) O[vt][i] *= alpha; } \
        int lnv = lane; asm volatile("" : "+v"(lnv)); \
        const int li = lnv & 15, q_ = li >> 2, p_ = li & 3, vsub = (lnv >> 4) & 1, gg = lnv >> 5; \
        bf16x8 fa_[2], fb_[2]; \
        SA_VLD(fa_, 0); SA_VLD(fb_, 1);                        \
        float ps = 0.f; \
        _Pragma("unroll") for (int i = 0; i < 16; ++i) { S0[i] = __builtin_amdgcn_exp2f(S0[i] * CEXP - mrun); ps += S0[i]; } \
        lrun += ps; \
        bf16x8 pf[2]; \
        { float tmp[8]; \
          _Pragma("unroll") for (int s2 = 0; s2 < 2; ++s2) { \
            _Pragma("unroll") for (int i = 0; i < 8; ++i) tmp[i] = S0[8 * s2 + i]; \
            pf[s2] = pack8(tmp); } } \
        __builtin_amdgcn_sched_barrier(0); \
        SA_VMM(fa_, 0); __builtin_amdgcn_sched_barrier(0); SA_VLD(fa_, 2); __builtin_amdgcn_sched_barrier(0); \
        SA_VMM(fb_, 1); __builtin_amdgcn_sched_barrier(0); SA_VLD(fb_, 3); __builtin_amdgcn_sched_barrier(0); \
        SA_VMM(fa_, 2); __builtin_amdgcn_sched_barrier(0); SA_VLD(fa_, 4); __builtin_amdgcn_sched_barrier(0); \
        SA_VMM(fb_, 3); __builtin_amdgcn_sched_barrier(0); SA_VLD(fb_, 5); __builtin_amdgcn_sched_barrier(0); \
        SA_VMM(fa_, 4); __builtin_amdgcn_sched_barrier(0); SA_VLD(fa_, 6); __builtin_amdgcn_sched_barrier(0); \
        SA_VMM(fb_, 5); __builtin_amdgcn_sched_barrier(0); SA_VLD(fb_, 7); __builtin_amdgcn_sched_barrier(0); \
        SA_VMM(fa_, 6); __builtin_amdgcn_sched_barrier(0); \
        SA_VMM(fb_, 7); } while (0)
#define SA_LOADER(j, SX, SY, bufn) do { const int h0_ = 2 * (j) + 6 < 127 ? 2 * (j) + 6 : 127, h1_ = 2 * (j) + 7 < 127 ? 2 * (j) + 7 : 127; \
        __builtin_amdgcn_sched_barrier(0); SA_WRITE(SX, bufn, 0); SA_LOAD(SX, h0_); __builtin_amdgcn_sched_barrier(0); SA_WRITE(SY, bufn, 1); SA_LOAD(SY, h1_); __builtin_amdgcn_sched_barrier(0); } while (0)
#define SA_TAIL64(bufn) do { if (half == 1) { \
            const char* cbn = (const char*)((const bf16_t*)(ws + WS_CB) + (size_t)(MP + b * DS) * KVR); const char* krn = (const char*)((const bf16_t*)(ws + WS_KRBS) + (size_t)(MP + b * DS) * ROPE); \
            const int w4_ = wave - 4; \
            _Pragma("unroll") for (int hh = 0; hh < 2; ++hh) { \
                _Pragma("unroll") for (int e = 0; e < 8; ++e) { const int key = 8 * w4_ + e + 32 * hh; u32x2 z = {0u, 0u}; if (key < DS) z = *(const u32x2*)(cbn + key * (KVR * 2) + 8 * lane); *(LAS u32x2*)(lds + (bufn) + llb[e] + hh * 8192) = z; } \
                _Pragma("unroll") for (int e = 0; e < 2; ++e) { const int key = 8 * w4_ + 4 * e + (lane >> 4) + 32 * hh; u32x2 z = {0u, 0u}; if (key < DS) z = *(const u32x2*)(krn + key * (ROPE * 2) + 8 * (lane & 15)); *(LAS u32x2*)(lds + (bufn) + lrb[e] + hh * 4608) = z; } } } } while (0)
#define SA_BAR() do { asm volatile("s_waitcnt lgkmcnt(0)" ::: "memory"); __builtin_amdgcn_s_barrier(); asm volatile("" ::: "memory"); } while (0)
    float* ml = (float*)(ws + WS_ML) + (size_t)(b * 2 + half) * 64 * 2;
    if (is_cmp) {
        SA_BAR();
        f32x16 O[8];
#pragma unroll
        for (int vt = 0; vt < 8; ++vt)
#pragma unroll
            for (int i = 0; i < 16; ++i) O[vt][i] = 0.f;
        float mrun = -1e30f, lrun = 0.f;
        int bo = 0;
        for (int j = 0; j < 64; ++j) {
            SA_COMPUTE(j, bo);
            bo = SA_BUF - bo;
            SA_BAR();
        }
        if (half == 1) { SA_COMPUTE(64, bo); SA_BAR(); }
        LAS float* xo = (LAS float*)(lds + qt * 32768); LAS float* xm = (LAS float*)(lds + 65536 + qt * 512);
        if (kb == 1) { xm[2 * lane] = mrun; xm[2 * lane + 1] = lrun;
#pragma unroll
            for (int vt = 0; vt < 8; ++vt)
#pragma unroll
                for (int i = 0; i < 16; ++i) xo[(vt * 16 + i) * 64 + lane] = O[vt][i]; }
        SA_BAR();
        if (kb == 0) {
            const float m1 = xm[2 * lane], l1 = xm[2 * lane + 1], mm = fmaxf(mrun, m1);
            const float a0 = __builtin_amdgcn_exp2f(mrun - mm), a1 = __builtin_amdgcn_exp2f(m1 - mm);
            const float ll = lrun * a0 + l1 * a1, lt = ll + __shfl_xor(ll, 32);
            const int q = 32 * qt + r32;
            if (g == 0) { ml[q * 2] = mm; ml[q * 2 + 1] = lt; }
#pragma unroll
            for (int vt = 0; vt < 8; ++vt) {
                float o[16];
#pragma unroll
                for (int i = 0; i < 16; ++i) o[i] = O[vt][i] * a0 + xo[(vt * 16 + i) * 64 + lane] * a1;
#pragma unroll
                for (int jq = 0; jq < 4; ++jq) { u32x2 w; w.x = pk2(o[4 * jq], o[4 * jq + 1]); w.y = pk2(o[4 * jq + 2], o[4 * jq + 3]);
                    *(LAS u32x2*)(lds + SA_OI + q * SA_QI_PITCH + (32 * vt + 8 * jq + 4 * g) * 2) = w; }
            }
        }
    } else {
        unsigned glb, grb, llb[8], lrb[2];
        { const int w4_ = wave - 4;
          glb = (unsigned)(8 * w4_ * 1024 + 16 * lane); grb = (unsigned)(8 * w4_ * 256 + 16 * lane);
#pragma unroll
          for (int e = 0; e < 8; ++e) { const int x_ = ((e & 3) << 2) | ((2 * w4_ + (e >> 2)) & 3);
              llb[e] = (unsigned)((lane >> 5) * 16384 + 256 * (8 * w4_ + e) + 16 * ((((lane & 31) >> 1)) ^ x_) + 8 * (lane & 1)); }
#pragma unroll
          for (int e = 0; e < 2; ++e) lrb[e] = (unsigned)(SA_KR + (8 * w4_ + 4 * e + (lane >> 4)) * 144 + 8 * (lane & 15)); }
        f32x4 s0[10], s1[10], s2[10], s3[10];
        SA_LOAD(s0, 0); SA_LOAD(s1, 1); SA_LOAD(s2, 2); SA_LOAD(s3, 3);
        SA_WRITE(s0, 0, 0); SA_LOAD(s0, 4); SA_WRITE(s1, 0, 1); SA_LOAD(s1, 5);
        SA_BAR();
        for (int j = 0; j < 62; j += 2) {
            SA_LOADER(j, s2, s3, SA_BUF);
            SA_BAR();
            SA_LOADER(j + 1, s0, s1, 0);
            SA_BAR();
        }
        SA_LOADER(62, s2, s3, SA_BUF);
        SA_BAR();
        SA_TAIL64(0);
        SA_BAR();
        if (half == 1) SA_BAR();
        SA_BAR();
    }
#undef SA_BAR
#undef SA_LOAD
#undef SA_WRITE
#undef SA_PK4
#undef SA_COMPUTE
#undef SA_KLD
#undef SA_VLD
#undef SA_VMM
#undef SA_LOADER
#undef SA_TAIL64

    float* parto = (float*)(ws + WS_PART) + (size_t)(b * 2 + half) * 64 * 128;
    __syncthreads();
    { bf16x8 ao[16];
#pragma unroll
      for (int ks = 0; ks < 16; ++ks) { u32x4 z = {0u, 0u, 0u, 0u}; if (r32 < DS) z = *(const LAS u32x4*)(lds + SA_OI + (r32 * 8 + wave) * SA_QI_PITCH + (16 * ks + 8 * g) * 2); ao[ks] = __builtin_bit_cast(bf16x8, z); }
      const bf16_t* wv = (const bf16_t*)(ws + WS_WUVP) + (size_t)wave * (64 * 512) + lane * 8;
#pragma unroll 2
      for (int nt = 0; nt < 4; ++nt) {
          f32x16 acc;
#pragma unroll
          for (int i = 0; i < 16; ++i) acc[i] = 0.f;
#pragma unroll
          for (int ks = 0; ks < 16; ++ks) acc = __builtin_amdgcn_mfma_f32_32x32x16_bf16(ao[ks], *(const bf16x8*)(wv + (nt * 16 + ks) * 512), acc, 0, 0, 0);
#pragma unroll
          for (int i = 0; i < 4; ++i) parto[(size_t)((i + 4 * g) * 8 + wave) * 128 + 32 * nt + r32] = acc[i];
      } }
    volatile LAS unsigned* flag = (volatile LAS unsigned*)(lds + MISC_OFF) + 16;
    asm volatile("s_waitcnt vmcnt(0)" ::: "memory");
    __syncthreads();
    if (tid == 0) {
        __builtin_amdgcn_fence(__ATOMIC_RELEASE, "agent");
        asm volatile("s_waitcnt vmcnt(0)" ::: "memory");
        const unsigned old = __hip_atomic_fetch_add((unsigned*)(ws + WS_CTL) + CW_SCNT + 64 * b, 1u, __ATOMIC_RELAXED, __HIP_MEMORY_SCOPE_AGENT);
        if (old == 1u) { __builtin_amdgcn_fence(__ATOMIC_ACQUIRE, "agent"); asm volatile("s_waitcnt vmcnt(0)" ::: "memory"); }
        flag[0] = old;
    }
    __syncthreads();
    if (flag[0] == 1u) {
        const int q = tid >> 3, v0 = (tid & 7) * 16, tok = q >> 3, h = q & 7;
        const float* mlb = (const float*)(ws + WS_ML) + ((size_t)(b * 2) * 64 + q) * 2; const float* pab = (const float*)(ws + WS_PART) + ((size_t)(b * 2) * 64 + q) * 128 + v0;
        const float m0 = mlb[0], l0 = mlb[1], m1 = mlb[128], l1 = mlb[129], mx = fmaxf(m0, m1);
        float w0 = __builtin_amdgcn_exp2f(m0 - mx), w1 = __builtin_amdgcn_exp2f(m1 - mx); const float inv = 1.0f / (w0 * l0 + w1 * l1); w0 *= inv; w1 *= inv;
        f32x4 a[4];
#pragma unroll
        for (int c = 0; c < 4; ++c) a[c] = *(const f32x4*)(pab + 4 * c) * w0 + *(const f32x4*)(pab + 64 * 128 + 4 * c) * w1;
        bf16_t* od = (bf16_t*)(ws + WS_OBUF) + (size_t)(MP + b * DS + tok) * D + h * VD + v0;
        *(bf16x8*)od = pack8v(a[0], a[1]); *(bf16x8*)(od + 8) = pack8v(a[2], a[3]);
    }
}

template <int W>
__device__ __forceinline__ void pool_chunk(const float* __restrict__ xr, int rvb, f32x4 gn, int col, int t0, bf16_t* __restrict__ drow) {
    f32x4 ring[W - 1]; f32x4 sum = {0.f, 0.f, 0.f, 0.f};
#pragma unroll
    for (int i = W - 1; i >= 1; --i) { f32x4 u = {0.f, 0.f, 0.f, 0.f};
        if (t0 - i >= 0) u = *(const f32x4*)(xr - (size_t)i * D + col) * __builtin_bit_cast(float, __builtin_amdgcn_readlane(rvb, 15 - i));
        ring[(W - 1 - i) % (W - 1)] = u; sum += u; }
#pragma unroll
    for (int r = 0; r < 16; ++r) {
        const f32x4 u = *(const f32x4*)(xr + (size_t)r * D + col) * __builtin_bit_cast(float, __builtin_amdgcn_readlane(rvb, 15 + r));
        sum += u;
        const int t = t0 + r; const float icnt = 1.0f / (float)((t + 1) < W ? (t + 1) : W);
        const f32x4 dd = (sum * icnt - u) * gn;
        u32x2 o; o.x = pk2(dd.x, dd.y); o.y = pk2(dd.z, dd.w);
        *(u32x2*)(drow + (size_t)r * D + col) = o;
        sum -= ring[r % (W - 1)]; ring[r % (W - 1)] = u;
    }
}
constexpr int NPH = 17;
__global__ void __launch_bounds__(512, 2) yoco_fwd(Params P) {
    extern __shared__ __attribute__((aligned(16))) unsigned char lds_raw[];
    LAS unsigned char* lds = (LAS unsigned char*)lds_raw;
    volatile LAS unsigned* MISC = (volatile LAS unsigned*)(lds + MISC_OFF);
    const int tid = threadIdx.x, lane = tid & 63, wave = __builtin_amdgcn_readfirstlane(tid >> 6);
    const int G = gridDim.x; const int bx = blockIdx.x; const int vcu = (G % 8 == 0) ? (bx % 8) * (G / 8) + bx / 8 : bx;
    unsigned char* ws = P.ws; float* out = P.out;
    for (int u = tid; u < 64; u += 512) MISC[u] = 0u;
    __syncthreads();
    XcdBarrier bar; bar.bar = (unsigned*)(ws + WS_CTL) + CW_BAR; bar.x = 0; bar.st = nullptr;
    if (MK_N_LAUNCHES == 1) bar = xcd_barrier_post((unsigned*)(ws + WS_CTL) + CW_BAR, MISC + 8);
    const int lo = P.ph_lo, hi = P.ph_hi;
#ifndef PH_MASK
#define PH_MASK 0xFFFFFFFFu
#endif
#define IN(k) (((PH_MASK >> (k)) & 1u) && lo <= (k) && (k) < hi)
#define SEAM(k) do { if (IN(k) && IN((k) + 1)) xcd_barrier(bar); } while (0)
#define SEAM2(k, kn) do { if (IN(k) && IN(kn)) xcd_barrier(bar); } while (0)
    const int gw = vcu * 8 + wave, NGW = G * 8;
    const int gtid = vcu * 512 + tid, NGT = G * 512;

#define wpool ((bf16_t*)(ws + WS_WPOOL))
#define wup ((bf16_t*)(ws + WS_WUP))
#define wdown ((bf16_t*)(ws + WS_WDOWN))
#define wgate ((bf16_t*)(ws + WS_WGATE))
#define wproj ((bf16_t*)(ws + WS_WPROJ))
#define wdkvq ((bf16_t*)(ws + WS_WDKVQ))
#define wuq ((bf16_t*)(ws + WS_WUQ))
#define wukt ((bf16_t*)(ws + WS_WUKT))
#define wuvt ((bf16_t*)(ws + WS_WUVT))
#define wukb ((bf16_t*)(ws + WS_WUKB))
#define wo ((bf16_t*)(ws + WS_WO))
#define cs ((float*)(ws + WS_CS))
#define rstd0 ((float*)(ws + WS_RSTD0))
#define dbuf ((bf16_t*)(ws + WS_DBUF))
#define pb ((bf16_t*)(ws + WS_PB))
#define hbA ((bf16_t*)(ws + WS_HBA))
#define hbB ((bf16_t*)(ws + WS_HBB))
#define ssq ((float*)(ws + WS_SSQ))
#define abuf ((bf16_t*)(ws + WS_ABUF))
#define proj ((bf16_t*)(ws + WS_PROJ))
#define craw ((float*)(ws + WS_RAW))
#define ssqc ((float*)(ws + WS_RAW + (size_t)M * KVR * 4))
#define ssqq ((float*)(ws + WS_RAW + (size_t)M * KVR * 4 + (size_t)M * 16))
#define cb ((bf16_t*)(ws + WS_CB))
#define krbs ((bf16_t*)(ws + WS_KRBS))
#define cqb ((bf16_t*)(ws + WS_CQB))
#define qbuf ((bf16_t*)(ws + WS_QBUF))
#define qs ((bf16_t*)(ws + WS_QS))
#define kfull ((bf16_t*)(ws + WS_KFULL))
#define vt ((bf16_t*)(ws + WS_VT))
#define obuf ((bf16_t*)(ws + WS_OBUF))
    constexpr size_t SSQ_V = (size_t)M * 16;

    constexpr int NU6 = (M / 256) * (NDKVQ / 256);
    const bool defer_l1 = (MK_N_LAUNCHES == 1) && G >= NU6 + 32;
    if (IN(0)) {
        LAS float* scr = (LAS float*)(lds + wave * 16384);
        int it = gw;
#define TI(W_, ks_, K_, N_, WT_, ro_) { const int n_items = ((K_) / 64) * ((N_) / 32); for (; it < n_items; it += NGW) transpose_item(W_, ks_, K_, N_, WT_, ro_, scr, it, lane); it -= n_items; }
        TI(P.in[I_POOLW] + 0 * 65536, nullptr, 256, 256, wpool, 0) TI(P.in[I_POOLW] + 1 * 65536, nullptr, 256, 256, wpool, 256)
        TI(P.in[I_POOLW] + 2 * 65536, nullptr, 256, 256, wpool, 512) TI(P.in[I_POOLW] + 3 * 65536, nullptr, 256, 256, wpool, 768)
        TI(P.in[I_WUP], P.in[I_NMLP], D, FF, wup, 0) if (!defer_l1) TI(P.in[I_WUP] + (size_t)D * FF, P.in[I_NMLP] + D, D, FF, wup + (size_t)FF * D, 0)
        TI(P.in[I_WDOWN], nullptr, FF, D, wdown, 0) if (!defer_l1) TI(P.in[I_WDOWN] + (size_t)D * FF, nullptr, FF, D, wdown + (size_t)FF * D, 0)
        TI(P.in[I_WGATE], P.in[I_NPLE], D, D, wgate, 0) if (!defer_l1) TI(P.in[I_WGATE] + (size_t)D * D, P.in[I_NPLE] + D, D, D, wgate + (size_t)D * D, 0)
        TI(P.in[I_WPROJ], nullptr, PLE, D, wproj, 0) TI(P.in[I_WPROJ] + (size_t)PLE * D, nullptr, PLE, D, wproj + (size_t)PLE * D, 0)
        { const int n_items = (D / 64) * (320 / 32); for (; it < n_items; it += NGW) transpose_item<2>(P.in[I_WDKV], P.in[I_NKV], D, 320, wdkvq, 0, scr, it, lane); it -= n_items; }
        TI(P.in[I_WDQ], P.in[I_NMIX] + D, D, QR, wdkvq, 320)
        { const int n_items = (QR / 64) * (NH * QH / 32); for (; it < n_items; it += NGW) transpose_item<1>(P.in[I_WUQ], P.in[I_QN], QR, NH * QH, wuq, 0, scr, it, lane); it -= n_items; }
        TI(P.in[I_WUK], P.in[I_KVN], KVR, 1024, wukt, 0) TI(P.in[I_WUV], P.in[I_KVN], KVR, 1024, wuvt, 0)
        if (!defer_l1) TI(P.in[I_WO], nullptr, D, D, wo, 0)
#undef TI
        for (int i = gtid; i < 64 * D / 8; i += NGT) *(u32x4*)(wdkvq + (size_t)704 * D + (size_t)i * 8) = (u32x4){0u, 0u, 0u, 0u};
        for (int i = gtid; i < 256 * 1024 / 8; i += NGT) { const int ln = i & 63, ks = (i >> 6) & 7, nt = (i >> 9) & 7, h = i >> 12;
            const float* sp = P.in[I_WUK] + (size_t)(32 * nt + (ln & 31)) * 1024 + h * NOPE + 16 * ks + 8 * (ln >> 5);
            *(bf16x8*)(wukb + (size_t)i * 8) = pack8v(*(const f32x4*)sp, *(const f32x4*)(sp + 4)); }
        for (int i = gtid; i < 256 * 1024 / 8; i += NGT) { const int ln = i & 63, ks = (i >> 6) & 15, nt = (i >> 10) & 3, h = i >> 12;
            const float* sp = P.in[I_WUV] + (size_t)(16 * ks + 8 * (ln >> 5)) * 1024 + h * VD + 32 * nt + (ln & 31);
            float t[8];
#pragma unroll
            for (int e = 0; e < 8; ++e) t[e] = sp[(size_t)e * 1024];
            *(bf16x8*)((bf16_t*)(ws + WS_WUVP) + (size_t)i * 8) = pack8(t); }
        for (int i = gtid; i < NPOS * 32; i += NGT) { const int pos = i >> 5, f = i & 31; const double inv = exp2(-(double)f * (13.287712379549449 / 32.0)); const double ang = (double)pos * inv;
            double sn, cn; sincos(ang, &sn, &cn); cs[(size_t)pos * 64 + f] = (float)cn; cs[(size_t)pos * 64 + 32 + f] = (float)sn; }
        for (int i = gtid; i < 2 * M * PLE / 8; i += NGT) { const int li = i / (M * PLE / 8), r8 = i % (M * PLE / 8); const size_t e = (size_t)r8 * 8; const int row = (int)(e / PLE), c = (int)(e % PLE);
            const float* src = row < MP ? P.in[I_PP] + ((size_t)li * MP + row) * PLE + c : P.in[I_PS] + ((size_t)li * MS + (row - MP)) * PLE + c;
            *(bf16x8*)(pb + ((size_t)li * M + row) * PLE + c) = pack8v(*(const f32x4*)src, *(const f32x4*)(src + 4)); }
        for (int row0 = gw; row0 < M; row0 += 2 * NGW) {
            f32x4 v[2][4];
#pragma unroll
            for (int rr = 0; rr < 2; ++rr) { const int row = row0 + rr * NGW; if (row < M) { const float* xr = row < MP ? P.in[I_XP] + (size_t)row * D : P.in[I_XS] + (size_t)(row - MP) * D;
#pragma unroll
                for (int j = 0; j < 4; ++j) v[rr][j] = ((const f32x4*)xr)[lane + 64 * j]; } }
#pragma unroll
            for (int rr = 0; rr < 2; ++rr) { const int row = row0 + rr * NGW; if (row < M) {
                float s = 0.f;
#pragma unroll
                for (int j = 0; j < 4; ++j) s += (v[rr][j].x * v[rr][j].x + v[rr][j].y * v[rr][j].y) + (v[rr][j].z * v[rr][j].z + v[rr][j].w * v[rr][j].w);
                const float rstd = 1.0f / sqrtf(wave_sum(s) * (1.0f / D) + EPS);
                if (lane == 0) rstd0[row] = rstd;
                float* po = nullptr;
                if (row < MP) { const int b = row >> 13, t = row & (SEQ - 1); if (t >= SEQ - 15) po = out + O_PP + ((size_t)b * 15 + (t - (SEQ - 15))) * D; }
                else { const int rs_ = row - MP, b = rs_ >> 3, t = rs_ & 7; po = out + O_PS + ((size_t)b * 15 + 7 + t) * D; }
                if (po) {
#pragma unroll
                    for (int j = 0; j < 4; ++j) { const f32x4 gn = ((const f32x4*)P.in[I_NMIX])[lane + 64 * j]; ((f32x4*)po)[lane + 64 * j] = v[rr][j] * rstd * gn; } }
            } }
        }
        for (int i = gtid; i < DB * 7 * D / 4; i += NGT) { const int b = i / (7 * D / 4), r = (i / (D / 4)) % 7, c = i % (D / 4);
            ((f32x4*)(out + O_PS + ((size_t)b * 15 + r) * D))[c] = ((const f32x4*)(P.in[I_SPOOL] + ((size_t)b * 15 + 8 + r) * D))[c]; }
    }
    SEAM2(0, 2);
    if (IN(2)) {
#ifndef SUBM
#define SUBM 7
#endif
        { SgH<0> E{P.in[I_XS], P.in[I_POOLSC], nullptr, nullptr, nullptr, hbA, ssq + 0 * SSQ_V};
          for (int u = vcu; u < 256; u += G) {
              const int mt = u >> 4, gq = (u & 15) >> 2, w = 2 << gq, col = 256 * gq + 4 * lane, bs = mt * 8 + wave;
              const float* sp = P.in[I_SPOOL] + (size_t)bs * 15 * D; const float* xs0 = P.in[I_XS] + (size_t)(bs * DS) * D;
              const float rv = (lane < DS) ? rstd0[MP + bs * DS + lane] : 0.f;
              const f32x4 gn = *(const f32x4*)(P.in[I_NMIX] + col);
#pragma unroll
              for (int t = 0; t < DS; ++t) {
                  const f32x4 u0 = *(const f32x4*)(xs0 + (size_t)t * D + col) * __shfl(rv, t); f32x4 sum = u0, hist = {0.f, 0.f, 0.f, 0.f};
#pragma unroll
                  for (int i = 1; i < 16; ++i) if (i < w) { const int tt = t - i;
                      if (tt >= 0) sum += *(const f32x4*)(xs0 + (size_t)tt * D + col) * __shfl(rv, tt >= 0 ? tt : 0);
                      else hist += *(const f32x4*)(sp + (size_t)(15 + tt) * D + col); }
                  const f32x4 dd = (sum * gn + hist) / (float)w - u0 * gn;
                  u32x2 o; o.x = pk2(dd.x, dd.y); o.y = pk2(dd.z, dd.w);
                  *(u32x2*)(dbuf + (size_t)(MP + bs * DS + t) * D + col) = o;
              }
              asm volatile("s_waitcnt vmcnt(0)" ::: "memory"); __syncthreads();
              sk_gemm(lds, dbuf + (size_t)(MP + 64 * mt) * D + 256 * gq, D, wpool + (size_t)(64 * (u & 15)) * 256, 256, 64 * mt, 64 * (u & 15), u & 15, E, tid, wave, lane); } }
        { SgBf E{proj, D};
          for (int u = vcu; u < 256; u += G) sk_gemm(lds, pb + (size_t)(MP + 64 * (u >> 4)) * PLE, PLE, wproj + (size_t)(64 * (u & 15)) * PLE, PLE, 64 * (u >> 4), 64 * (u & 15), u & 15, E, tid, wave, lane); }
        { SgBf E{proj + (size_t)M * D, D};
          for (int u = vcu; u < 256; u += G) sk_gemm(lds, pb + (size_t)(M + MP + 64 * (u >> 4)) * PLE, PLE, wproj + (size_t)PLE * D + (size_t)(64 * (u & 15)) * PLE, PLE, 64 * (u >> 4), 64 * (u & 15), u & 15, E, tid, wave, lane); }
        if (SUBM & 1) { pg8::Gemm g{dbuf, wpool, MP, D, 256, D, 256}; pg8::StaticOrder S; S.init(MP, D, G, bx);
          {
            pg8::Unit uu;
            for (int i = 0; S.next(i, uu); ++i) {
#pragma unroll 1
                for (int cc = 0; cc < 2; ++cc) {
                    const int row0 = uu.pm * 256 + (2 * wave + cc) * 16, t0 = row0 & (SEQ - 1), col = 256 * uu.pn + 4 * lane;
                    const float rv = (lane < 31 && t0 - 15 + lane >= 0) ? rstd0[row0 - 15 + lane] : 0.f;
                    const int rvb = __builtin_bit_cast(int, rv);
                    const float* xr = P.in[I_XP] + (size_t)row0 * D; bf16_t* dr = dbuf + (size_t)row0 * D; const f32x4 gn = *(const f32x4*)(P.in[I_NMIX] + col);
                    if (uu.pn == 0) pool_chunk<2>(xr, rvb, gn, col, t0, dr); else if (uu.pn == 1) pool_chunk<4>(xr, rvb, gn, col, t0, dr);
                    else if (uu.pn == 2) pool_chunk<8>(xr, rvb, gn, col, t0, dr); else pool_chunk<16>(xr, rvb, gn, col, t0, dr);
                } }
            asm volatile("s_waitcnt vmcnt(0)" ::: "memory"); __syncthreads(); }
          EpiH<0> E{P.in[I_XP], P.in[I_XS], P.in[I_POOLSC], nullptr, nullptr, nullptr, hbA, ssq + 0 * SSQ_V};
          pg8::gemm_phase(lds, g, S, E); }
        if (SUBM & 2) { pg8::Gemm g{pb, wproj, MP, D, PLE, PLE, 0}; pg8::StaticOrder S; S.init(MP, D, G, bx);
          EpiBf E{proj, D};
          pg8::gemm_phase(lds, g, S, E); }
        if (SUBM & 4) { pg8::Gemm g{pb + (size_t)M * PLE, wproj + (size_t)PLE * D, MP, D, PLE, PLE, 0}; pg8::StaticOrder S; S.init(MP, D, G, bx);
          EpiBf E{proj + (size_t)M * D, D};
          pg8::gemm_phase(lds, g, S, E); }
    }
    SEAM(2);
    if (IN(3)) {
        { SgUp E{ssq + 0 * SSQ_V, abuf}; for (int u = vcu; u < 256; u += G) sk_gemm_w(lds, hbA + (size_t)(MP + 64 * (u & 15)) * D, D, wup + (size_t)(256 * (u >> 4)) * D, D, 64 * (u & 15), 256 * (u >> 4), E, tid, wave, lane); }
        pg8::Gemm g{hbA, wup, MP, FF, D, D, 0}; pg8::StaticOrder S; S.init(MP, FF, G, bx); EpiUp E{ssq + 0 * SSQ_V, abuf}; pg8::gemm_phase(lds, g, S, E); }
    SEAM(3);
    if (IN(4)) {
        { SgH<1> E{nullptr, nullptr, nullptr, nullptr, hbA, hbB, ssq + 1 * SSQ_V}; for (int u = vcu; u < 256; u += G) sk_gemm(lds, abuf + (size_t)(MP + 64 * (u >> 4)) * FF, FF, wdown + (size_t)(64 * (u & 15)) * FF, FF, 64 * (u >> 4), 64 * (u & 15), u & 15, E, tid, wave, lane); }
        pg8::Gemm g{abuf, wdown, MP, D, FF, FF, 0}; pg8::StaticOrder S; S.init(MP, D, G, bx);
        EpiH<1> E{nullptr, nullptr, nullptr, nullptr, nullptr, hbA, hbB, ssq + 1 * SSQ_V}; pg8::gemm_phase(lds, g, S, E); }
    SEAM(4);
    if (IN(5)) {
        { SgH<2> E{nullptr, nullptr, ssq + 1 * SSQ_V, proj, hbB, hbA, ssq + 2 * SSQ_V}; for (int u = vcu; u < 256; u += G) sk_gemm(lds, hbB + (size_t)(MP + 64 * (u >> 4)) * D, D, wgate + (size_t)(64 * (u & 15)) * D, D, 64 * (u >> 4), 64 * (u & 15), u & 15, E, tid, wave, lane); }
        pg8::Gemm g{hbB, wgate, MP, D, D, D, 0}; pg8::StaticOrder S; S.init(MP, D, G, bx);
        EpiH<2> E{nullptr, nullptr, nullptr, ssq + 1 * SSQ_V, proj, hbB, hbA, ssq + 2 * SSQ_V}; pg8::gemm_phase(lds, g, S, E); }
    SEAM(5);
    if (IN(6)) {
        if (defer_l1 && bx >= NU6) {
            LAS float* scr = (LAS float*)(lds + wave * 16384);
            const int nst = (G - NU6) * 8; int it = (bx - NU6) * 8 + wave;
#define TI(W_, ks_, K_, N_, WT_, ro_) { const int n_items = ((K_) / 64) * ((N_) / 32); for (; it < n_items; it += nst) transpose_item(W_, ks_, K_, N_, WT_, ro_, scr, it, lane); it -= n_items; }
            TI(P.in[I_WUP] + (size_t)D * FF, P.in[I_NMLP] + D, D, FF, wup + (size_t)FF * D, 0) TI(P.in[I_WDOWN] + (size_t)D * FF, nullptr, FF, D, wdown + (size_t)FF * D, 0)
            TI(P.in[I_WGATE] + (size_t)D * D, P.in[I_NPLE] + D, D, D, wgate + (size_t)D * D, 0) TI(P.in[I_WO], nullptr, D, D, wo, 0)
#undef TI
        }
        pg8::Gemm g{hbA, wdkvq, M, NDKVQ, D, D, 0}; pg8::StaticOrder S; S.init(M, NDKVQ, G, bx); EpiDkvq E{ssq + 2 * SSQ_V, cs, craw, cb, cqb, ssqc, ssqq, out, kfull, krbs}; pg8::gemm_phase(lds, g, S, E); }
    SEAM2(6, 8);
    if (IN(8)) {
        if (SUBM & 1) { pg8::Gemm g{cqb, wuq, M, NH * QH, QR, QR, 0}; pg8::StaticOrder S; S.init(M, NH * QH, G, bx); EpiQ E{ssqq, cs, qbuf, qs}; pg8::gemm_phase(lds, g, S, E); }
        if (SUBM & 2) { pg8::Gemm g{cb, wukt, MP, 1024, KVR, KVR, 0}; pg8::StaticOrder S; S.init(MP, 1024, G, (bx + 128) % G); EpiKup E{kfull, ssqc}; pg8::gemm_phase(lds, g, S, E); }
        if (SUBM & 4) { pg8::Gemm g{wuvt, cb, 1024, MP, KVR, KVR, 0}; pg8::StaticOrder S; S.init(1024, MP, G, (bx + 128) % G); EpiVup E{vt, ssqc}; pg8::gemm_phase(lds, g, S, E); }
        constexpr int NUQ = (M / 256) * (NH * QH / 256);
        const int nx = NUQ % G; const bool part = (nx >= 16 && G - nx >= 32);
        if (!part || bx >= nx) { const f32x4 kvn = ((const f32x4*)P.in[I_KVN])[lane];
          const int gw2 = part ? (bx - nx) * 8 + wave : gw, ngw2 = part ? (G - nx) * 8 : NGW;
          for (int row0 = 2 * gw2; row0 < M; row0 += 2 * ngw2) {
              f32x4 c4[2], p4[2];
#pragma unroll
              for (int e = 0; e < 2; ++e) { c4[e] = unpk4(((const u32x2*)(cb + (size_t)(row0 + e) * KVR))[lane]); p4[e] = *(const f32x4*)(ssqc + (size_t)(row0 + e) * 4); }
#pragma unroll
              for (int e = 0; e < 2; ++e) { const int row = row0 + e; const bool isp = row < MP;
                  const float rc = 1.0f / sqrtf(((p4[e].x + p4[e].y) + (p4[e].z + p4[e].w)) * (1.0f / KVR) + EPS);
                  const f32x4 cn = c4[e] * rc * kvn;
                  float* lo_ = isp ? out + O_LP + (size_t)row * KVR : out + O_LS + (size_t)(row - MP) * KVR;
                  ((f32x4*)lo_)[lane] = cn;
                  if (!isp) { u32x2 o; o.x = pk2(cn.x, cn.y); o.y = pk2(cn.z, cn.w); ((u32x2*)(cb + (size_t)row * KVR))[lane] = o; } } } }
    }
    SEAM2(8, 10);
    if (IN(10)) {
        const int sq_ = (bx >> 3) & 3;
        if (sq_ == 0) for (int it = vcu; it < 2 * DB; it += G) sattn_item(P, it >> 1, it & 1, lds, tid, wave, lane);
        for (int u = vcu; u < 256; u += G) { const int bh = u >> 4, p = u & 15; attn_prompt_unit(qbuf, kfull, krbs, vt, obuf, bh >> 3, bh & 7, sq_ == 1 ? p : 31 - p, lds, tid, wave, lane); }
        if (sq_ == 1 || sq_ == 2) for (int it = vcu; it < 2 * DB; it += G) sattn_item(P, it >> 1, it & 1, lds, tid, wave, lane);
        for (int u = vcu; u < 256; u += G) { const int bh = u >> 4, p = u & 15; attn_prompt_unit(qbuf, kfull, krbs, vt, obuf, bh >> 3, bh & 7, sq_ == 1 ? 31 - p : p, lds, tid, wave, lane); }
        if (sq_ == 3) for (int it = vcu; it < 2 * DB; it += G) sattn_item(P, it >> 1, it & 1, lds, tid, wave, lane);
    }
    SEAM2(10, 12);
    if (IN(12)) {
        { SgH<1> E{nullptr, nullptr, nullptr, nullptr, hbA, hbB, ssq + 3 * SSQ_V};
          for (int u = vcu; u < 256; u += G) sk_gemm(lds, obuf + (size_t)(MP + 64 * (u >> 4)) * D, D, wo + (size_t)(64 * (u & 15)) * D, D, 64 * (u >> 4), 64 * (u & 15), u & 15, E, tid, wave, lane); }
        pg8::Gemm g{obuf, wo, MP, D, D, D, 0}; pg8::StaticOrder S; S.init(MP, D, G, bx);
        EpiH<1> E{nullptr, nullptr, nullptr, nullptr, nullptr, hbA, hbB, ssq + 3 * SSQ_V}; pg8::gemm_phase(lds, g, S, E); }
    SEAM(12);
    if (IN(13)) {
        { SgUp E{ssq + 3 * SSQ_V, abuf}; for (int u = vcu; u < 256; u += G) sk_gemm_w(lds, hbB + (size_t)(MP + 64 * (u & 15)) * D, D, wup + (size_t)FF * D + (size_t)(256 * (u >> 4)) * D, D, 64 * (u & 15), 256 * (u >> 4), E, tid, wave, lane); }
        pg8::Gemm g{hbB, wup + (size_t)FF * D, MP, FF, D, D, 0}; pg8::StaticOrder S; S.init(MP, FF, G, bx); EpiUp E{ssq + 3 * SSQ_V, abuf}; pg8::gemm_phase(lds, g, S, E); }
    SEAM(13);
    if (IN(14)) {
        { SgH<1> E{nullptr, nullptr, nullptr, nullptr, hbB, hbA, ssq + 4 * SSQ_V}; for (int u = vcu; u < 256; u += G) sk_gemm(lds, abuf + (size_t)(MP + 64 * (u >> 4)) * FF, FF, wdown + (size_t)FF * D + (size_t)(64 * (u & 15)) * FF, FF, 64 * (u >> 4), 64 * (u & 15), u & 15, E, tid, wave, lane); }
        pg8::Gemm g{abuf, wdown + (size_t)FF * D, MP, D, FF, FF, 0}; pg8::StaticOrder S; S.init(MP, D, G, bx);
        EpiH<1> E{nullptr, nullptr, nullptr, nullptr, nullptr, hbB, hbA, ssq + 4 * SSQ_V}; pg8::gemm_phase(lds, g, S, E); }
    SEAM(14);
    if (IN(15)) {
        { SgH<2> E{nullptr, nullptr, ssq + 4 * SSQ_V, proj + (size_t)M * D, hbA, hbB, ssq + 5 * SSQ_V}; for (int u = vcu; u < 256; u += G) sk_gemm(lds, hbA + (size_t)(MP + 64 * (u >> 4)) * D, D, wgate + (size_t)D * D + (size_t)(64 * (u & 15)) * D, D, 64 * (u >> 4), 64 * (u & 15), u & 15, E, tid, wave, lane); }
        pg8::Gemm g{hbA, wgate + (size_t)D * D, MP, D, D, D, 0}; pg8::StaticOrder S; S.init(MP, D, G, bx);
        EpiH<2> E{nullptr, nullptr, nullptr, ssq + 4 * SSQ_V, proj + (size_t)M * D, hbA, hbB, ssq + 5 * SSQ_V}; pg8::gemm_phase(lds, g, S, E); }
    SEAM(15);
    if (IN(16)) {
        f32x4 gn[4];
#pragma unroll
        for (int j = 0; j < 4; ++j) gn[j] = ((const f32x4*)P.in[I_NFIN])[lane + 64 * j];
        for (int row0 = 4 * gw; row0 < M; row0 += 4 * NGW) {
            u32x2 hv[4][4]; float sp[4];
#pragma unroll
            for (int e = 0; e < 4; ++e) { sp[e] = (lane < 16) ? ssq[5 * SSQ_V + (size_t)(row0 + e) * 16 + lane] : 0.f;
#pragma unroll
                for (int j = 0; j < 4; ++j) hv[e][j] = ((const u32x2*)(hbB + (size_t)(row0 + e) * D))[lane + 64 * j]; }
#pragma unroll
            for (int e = 0; e < 4; ++e) { const float rstd = 1.0f / sqrtf(wave_sum(sp[e]) * (1.0f / D) + EPS);
#pragma unroll
                for (int j = 0; j < 4; ++j) ((f32x4*)(out + O_Y + (size_t)(row0 + e) * D))[lane + 64 * j] = unpk4(hv[e][j]) * rstd * gn[j]; }
        }
    }
#undef IN
#undef SEAM
#undef SEAM2
#undef wpool
#undef wup
#undef wdown
#undef wgate
#undef wproj
#undef wdkvq
#undef wuq
#undef wukt
#undef wuvt
#undef wukb
#undef wo
#undef cs
#undef rstd0
#undef dbuf
#undef pb
#undef hbA
#undef hbB
#undef ssq
#undef abuf
#undef proj
#undef craw
#undef ssqc
#undef ssqq
#undef cb
#undef krbs
#undef cqb
#undef qbuf
#undef qs
#undef kfull
#undef vt
#undef obuf
}

extern "C" void kernel_launch(void* const* d_in, const int* in_sizes, int n_in, void* d_out, int out_size, void* d_ws, size_t ws_size, hipStream_t stream) {
    static int grid = 0;
    if (grid == 0) {
        if (n_in != 27 || (size_t)out_size != O_END || ws_size < WS_END) { fprintf(stderr, "kernel_launch: shape mismatch (n_in %d, out %d, ws %zu; need 27, %zu, %zu)\n", n_in, out_size, ws_size, (size_t)O_END, (size_t)WS_END); grid = -1; return; }
        int dev = 0, cus = 0, per_cu = 0;
        if (hipGetDevice(&dev) != hipSuccess || hipDeviceGetAttribute(&cus, hipDeviceAttributeMultiprocessorCount, dev) != hipSuccess) { grid = -1; return; }
        if (hipFuncSetAttribute((const void*)yoco_fwd, hipFuncAttributeMaxDynamicSharedMemorySize, LDS_BYTES) != hipSuccess) { fprintf(stderr, "kernel_launch: hipFuncSetAttribute failed\n"); grid = -1; return; }
        if (hipOccupancyMaxActiveBlocksPerMultiprocessor(&per_cu, (const void*)yoco_fwd, 512, LDS_BYTES) != hipSuccess || per_cu < 1) fprintf(stderr, "kernel_launch: occupancy query reports %d\n", per_cu);
        (void)hipGetLastError();
        grid = cus;
    }
    if (grid < 0) return;
    (void)hipMemsetAsync((char*)d_ws + WS_CTL, 0, CTL_BYTES, stream);
    Params p{};
    for (int i = 0; i < 27; ++i) p.in[i] = (const float*)d_in[i];
    p.out = (float*)d_out; p.ws = (unsigned char*)d_ws;
#if MK_N_LAUNCHES == 1
    p.ph_lo = 0; p.ph_hi = NPH;
    hipLaunchKernelGGL(yoco_fwd, dim3(grid), dim3(512), LDS_BYTES, stream, p);
#else
    for (int k = 0; k < NPH; ++k) { p.ph_lo = k; p.ph_hi = k + 1; hipLaunchKernelGGL(yoco_fwd, dim3(grid), dim3(512), LDS_BYTES, stream, p); }
#endif
    const hipError_t le = hipPeekAtLastError();
    if (le != hipSuccess) fprintf(stderr, "kernel_launch: launch failed: %s\n", hipGetErrorName(le));
}
```
